# Optimizing an MI355X kernel written in HIP

```python
import math
import jax, jax.numpy as jnp
from jax import lax
import numpy as np

D_MODEL = 1024
BATCH = 8
SEQ = 4096
DEPTH = 2

HEAD_DIM = 64
A_HEADS_PER_GROUP = 16
DIL_PAIRS = ((128, 1), (512, 4), (2048, 16))
N_DIL_GROUPS = len(DIL_PAIRS)
DIL_BLOCK = 128
B_HEADS = D_MODEL // HEAD_DIM
Q_BLOCK = 128
NUM_BUCKETS = 32
MAX_DISTANCE = 2048
N_EXPERTS = 32
TOP_K = 4
D_FF = D_MODEL
SWIGLU_LIMIT = 7.0
SWIGLU_ALPHA = 1.702
MOE_BLOCK = 256
RMS_EPS = 1e-6
NEG = -1e30

kernel_name = 'yoco_dilated_fox_moe_block'


def rms_norm(x, g):
    xf = x.astype(jnp.float32)
    y = xf * lax.rsqrt(jnp.mean(xf * xf, axis=-1, keepdims=True) + RMS_EPS)
    return (y * g.astype(jnp.float32)).astype(x.dtype)


def modulate(h, shift, scale):
    return h * (1.0 + scale[:, None, :]) + shift[:, None, :]


def t5_bucket(n):
    max_exact = NUM_BUCKETS // 2
    nf = jnp.maximum(n, 1).astype(jnp.float32)
    large = max_exact + (jnp.log(nf / max_exact) / math.log(MAX_DISTANCE / max_exact)
                         * (NUM_BUCKETS - max_exact)).astype(jnp.int32)
    large = jnp.minimum(large, NUM_BUCKETS - 1)
    return jnp.where(n < max_exact, n, large)


def dilated_group_attention(q, k, v, bias_tab, dilation, window):
    Bq, S, H, dh = q.shape
    steps = window // dilation
    L = -(-S // dilation)
    nb = -(-L // DIL_BLOCK)
    Lp = nb * DIL_BLOCK
    Sp = Lp * dilation

    def to_blocks(t):
        t = jnp.pad(t, ((0, 0), (0, Sp - S), (0, 0), (0, 0)))
        t = t.reshape(Bq, Lp, dilation, H, dh).transpose(0, 2, 3, 1, 4)
        return t.reshape(Bq, dilation, H, nb, DIL_BLOCK, dh)

    def with_prev(t):
        prev = jnp.pad(t[:, :, :, :-1], ((0, 0), (0, 0), (0, 0), (1, 0), (0, 0), (0, 0)))
        return jnp.concatenate([prev, t], axis=4)

    qb = to_blocks(q)
    kk = with_prev(to_blocks(k))
    vv = with_prev(to_blocks(v))

    qi = jnp.arange(DIL_BLOCK, dtype=jnp.int32)[:, None]
    kj = jnp.arange(2 * DIL_BLOCK, dtype=jnp.int32)[None, :]
    delta = qi + DIL_BLOCK - kj
    blk = jnp.arange(nb, dtype=jnp.int32)[:, None, None]
    valid = (delta >= 0) & (delta <= steps) & (blk * DIL_BLOCK + kj - DIL_BLOCK >= 0)
    bucket = t5_bucket(jnp.clip(delta, 0, None) * dilation)
    bias = bias_tab[bucket].astype(jnp.float32).transpose(2, 0, 1)

    s = jnp.einsum('brhnqd,brhnkd->brhnqk', qb, kk).astype(jnp.float32) * (HEAD_DIM ** -0.5)
    s = jnp.where(valid, s + bias[:, None], NEG)
    m = jnp.max(s, axis=-1, keepdims=True)
    p = jnp.exp(s - m)
    den = jnp.sum(p, axis=-1, keepdims=True)
    o = jnp.einsum('brhnqk,brhnkd->brhnqd', (p / den).astype(v.dtype), vv)
    lse = (m + jnp.log(den))[..., 0]

    o = o.reshape(Bq, dilation, H, Lp, dh).transpose(0, 3, 1, 2, 4).reshape(Bq, Sp, H, dh)[:, :S]
    lse = lse.reshape(Bq, dilation, H, Lp).transpose(0, 3, 1, 2).reshape(Bq, Sp, H)[:, :S]
    return o, lse


def dilated_mixer(h, w_qkv, w_o, rel_bias):
    Bq, S, _ = h.shape
    qkv = (h @ w_qkv).reshape(Bq, S, N_DIL_GROUPS, 3, A_HEADS_PER_GROUP, HEAD_DIM)
    outs, lses = [], []
    for g, (window, dilation) in enumerate(DIL_PAIRS):
        tab = rel_bias[:, g * A_HEADS_PER_GROUP:(g + 1) * A_HEADS_PER_GROUP]
        o, lse = dilated_group_attention(qkv[:, :, g, 0], qkv[:, :, g, 1], qkv[:, :, g, 2],
                                         tab, dilation, window)
        outs.append(o)
        lses.append(lse)
    wts = jax.nn.softmax(jnp.stack(lses, axis=0), axis=0)
    o = jnp.sum(wts[..., None] * jnp.stack(outs, axis=0).astype(jnp.float32), axis=0)
    o = o.astype(h.dtype).reshape(Bq, S, A_HEADS_PER_GROUP * HEAD_DIM)
    return o @ w_o


def shared_kv(x, kv_norm_g, w_kvf, b_f):
    Bq, S, _ = x.shape
    z = rms_norm(x, kv_norm_g) @ w_kvf
    nkv = B_HEADS * HEAD_DIM
    k = z[..., :nkv].reshape(Bq, S, B_HEADS, HEAD_DIM)
    v = z[..., nkv:2 * nkv].reshape(Bq, S, B_HEADS, HEAD_DIM)
    log_f = jax.nn.log_sigmoid(z[..., 2 * nkv:].astype(jnp.float32) + b_f.astype(jnp.float32))
    fcum = jnp.cumsum(log_f, axis=1)
    return k, v, fcum


def forgetting_attention(q, k, v, fcum):
    Bq, S, H, dh = q.shape
    nb = S // Q_BLOCK
    qb = q.reshape(Bq, nb, Q_BLOCK, H, dh).transpose(1, 0, 3, 2, 4)
    fq = fcum.reshape(Bq, nb, Q_BLOCK, H).transpose(1, 0, 3, 2)
    kh = k.transpose(0, 2, 1, 3)
    vh = v.transpose(0, 2, 1, 3)
    fk = fcum.transpose(0, 2, 1)
    kpos = jnp.arange(S, dtype=jnp.int32)

    def block(args):
        q_i, f_i, i = args
        s = jnp.einsum('bhqd,bhkd->bhqk', q_i, kh).astype(jnp.float32) * (dh ** -0.5)
        s = s + f_i[..., None] - fk[:, :, None, :]
        qpos = i * Q_BLOCK + jnp.arange(Q_BLOCK, dtype=jnp.int32)
        s = jnp.where(kpos[None, :] <= qpos[:, None], s, NEG)
        p = jax.nn.softmax(s, axis=-1)
        return jnp.einsum('bhqk,bhkd->bhqd', p.astype(vh.dtype), vh)

    o = lax.map(block, (qb, fq, jnp.arange(nb, dtype=jnp.int32)))
    return o.transpose(1, 0, 3, 2, 4).reshape(Bq, S, H, dh)


def forgetting_mixer(h, w_q, w_o, k, v, fcum):
    Bq, S, _ = h.shape
    q = (h @ w_q).reshape(Bq, S, B_HEADS, HEAD_DIM)
    o = forgetting_attention(q, k, v, fcum).reshape(Bq, S, B_HEADS * HEAD_DIM)
    return o @ w_o


def moe_ffn(h, w_router, b_router, w_gu, b_gu, w_down, b_down):
    Bq, S, D = h.shape
    T = Bq * S
    n_slots = T * TOP_K
    xf = h.reshape(T, D)
    logits = (xf @ w_router).astype(jnp.float32) + b_router.astype(jnp.float32)
    top_val, top_idx = lax.top_k(logits, TOP_K)
    gates = jax.nn.softmax(top_val, axis=-1)

    e_flat = top_idx.reshape(-1).astype(jnp.int32)
    tok_flat = jnp.arange(n_slots, dtype=jnp.int32) // TOP_K
    order = jnp.argsort(e_flat)
    e_sorted = e_flat[order]
    tok_sorted = tok_flat[order]
    gate_sorted = gates.reshape(-1)[order]

    counts = jnp.bincount(e_flat, length=N_EXPERTS)
    starts = jnp.cumsum(counts) - counts
    padded = (counts + MOE_BLOCK - 1) // MOE_BLOCK * MOE_BLOCK
    pad_ends = jnp.cumsum(padded)
    pad_starts = pad_ends - padded
    dest = pad_starts[e_sorted] + (jnp.arange(n_slots, dtype=jnp.int32) - starts[e_sorted])

    n_rows = n_slots + N_EXPERTS * MOE_BLOCK
    n_blocks = n_rows // MOE_BLOCK
    xbuf = jnp.zeros((n_rows, D), h.dtype).at[dest].set(xf[tok_sorted])
    block_start = jnp.arange(n_blocks, dtype=jnp.int32) * MOE_BLOCK
    block_expert = jnp.minimum(jnp.searchsorted(pad_ends, block_start, side='right'), N_EXPERTS - 1)

    def expert_block(args):
        xb, e = args
        gu = xb @ w_gu[e] + b_gu[e]
        g, u = jnp.split(gu, 2, axis=-1)
        g = jnp.minimum(g, SWIGLU_LIMIT)
        u = jnp.clip(u, -SWIGLU_LIMIT, SWIGLU_LIMIT)
        act = (u + 1.0) * g * jax.nn.sigmoid(SWIGLU_ALPHA * g)
        return act @ w_down[e] + b_down[e]

    ybuf = lax.map(expert_block, (xbuf.reshape(n_blocks, MOE_BLOCK, D), block_expert))
    y_slots = ybuf.reshape(n_rows, D)[dest] * gate_sorted[:, None].astype(h.dtype)
    out = jnp.zeros((T, D), h.dtype).at[tok_sorted].add(y_slots)
    return out.reshape(Bq, S, D)


def setup_inputs(seed: int = 0) -> dict:
    key = jax.random.key(seed)
    ks = jax.random.split(key, 24)
    D = D_MODEL
    n_a = DEPTH // 2
    n_b = DEPTH - n_a

    def nrm(k, shape, scale):
        return jax.random.normal(k, shape, jnp.float32) * scale

    a_width = A_HEADS_PER_GROUP * HEAD_DIM
    b_width = B_HEADS * HEAD_DIM
    return {
        'x': nrm(ks[0], (BATCH, SEQ, D), 1.0),
        'c': nrm(ks[1], (BATCH, D), 1.0),
        'ada_w': nrm(ks[2], (DEPTH, D, 6 * D), 0.5 * D ** -0.5),
        'ada_b': nrm(ks[3], (DEPTH, 6 * D), 0.02),
        'norm_mix_g': 1.0 + nrm(ks[4], (DEPTH, D), 0.02),
        'norm_ffn_g': 1.0 + nrm(ks[5], (DEPTH, D), 0.02),
        'a_w_qkv': nrm(ks[6], (n_a, D, N_DIL_GROUPS * 3 * a_width), D ** -0.5),
        'a_w_o': nrm(ks[7], (n_a, a_width, D), a_width ** -0.5),
        'rel_bias': nrm(ks[8], (NUM_BUCKETS, N_DIL_GROUPS * A_HEADS_PER_GROUP), 0.5),
        'kv_norm_g': 1.0 + nrm(ks[9], (D,), 0.02),
        'w_kvf': nrm(ks[10], (D, 2 * b_width + B_HEADS), D ** -0.5),
        'b_f': jax.random.uniform(ks[11], (B_HEADS,), jnp.float32, 1.0, 5.0),
        'b_w_q': nrm(ks[12], (n_b, D, b_width), D ** -0.5),
        'b_w_o': nrm(ks[13], (n_b, b_width, D), b_width ** -0.5),
        'router_w': nrm(ks[14], (DEPTH, D, N_EXPERTS), D ** -0.5),
        'router_b': nrm(ks[15], (DEPTH, N_EXPERTS), 0.01),
        'w_gu': nrm(ks[16], (DEPTH, N_EXPERTS, D, 2 * D_FF), D ** -0.5),
        'b_gu': nrm(ks[17], (DEPTH, N_EXPERTS, 2 * D_FF), 0.01),
        'w_down': nrm(ks[18], (DEPTH, N_EXPERTS, D_FF, D), D_FF ** -0.5),
        'b_down': nrm(ks[19], (DEPTH, N_EXPERTS, D), 0.01),
        'final_norm_g': 1.0 + nrm(ks[20], (D,), 0.02),
    }


def reference(x, c, ada_w, ada_b, norm_mix_g, norm_ffn_g, a_w_qkv, a_w_o, rel_bias,
              kv_norm_g, w_kvf, b_f, b_w_q, b_w_o, router_w, router_b, w_gu, b_gu,
              w_down, b_down, final_norm_g):
    n_a = DEPTH // 2
    c_act = jax.nn.silu(c)
    k_sh = v_sh = f_sh = None
    for layer in range(DEPTH):
        ada = c_act @ ada_w[layer] + ada_b[layer]
        shift_m, scale_m, gate_m, shift_f, scale_f, gate_f = jnp.split(ada, 6, axis=-1)
        h = modulate(rms_norm(x, norm_mix_g[layer]), shift_m, scale_m)
        if layer < n_a:
            mix = dilated_mixer(h, a_w_qkv[layer], a_w_o[layer], rel_bias)
        else:
            if layer == n_a:
                k_sh, v_sh, f_sh = shared_kv(x, kv_norm_g, w_kvf, b_f)
            mix = forgetting_mixer(h, b_w_q[layer - n_a], b_w_o[layer - n_a], k_sh, v_sh, f_sh)
        x = x + gate_m[:, None, :] * mix
        h = modulate(rms_norm(x, norm_ffn_g[layer]), shift_f, scale_f)
        x = x + gate_f[:, None, :] * moe_ffn(h, router_w[layer], router_b[layer], w_gu[layer],
                                             b_gu[layer], w_down[layer], b_down[layer])
    return rms_norm(x, final_norm_g)
```

```cpp
#include <hip/hip_runtime.h>
#include <hip/hip_bf16.h>
#include <cstdio>
#include <cstdint>
#include <cmath>
#ifndef MK_ONE_LAUNCH
#define MK_ONE_LAUNCH 1
#endif
#ifndef PROBE_DUP
#define PROBE_DUP 0
#endif
#ifndef PG8_F8_SCALED
#define PG8_F8_SCALED 0
#endif
#ifndef QKV_FP8
#define QKV_FP8 1
#endif
#ifndef KVQ_FP8
#define KVQ_FP8 1
#endif
#ifndef PROBE_EPI
#define PROBE_EPI 0
#endif
#ifndef PROBE_FOX
#define PROBE_FOX 0
#endif
#ifndef PROBE_SANITIZE
#define PROBE_SANITIZE 0
#endif
#ifndef PROBE_BAND
#define PROBE_BAND 0
#endif
#ifndef Y_FP8
#define Y_FP8 1
#endif
#ifndef WO_FP8
#define WO_FP8 1
#endif
#ifndef MOE_GATHER
#define MOE_GATHER 1
#endif
#ifndef PROBE_QKV
#define PROBE_QKV 0
#endif
#ifndef PROBE_GU
#define PROBE_GU 0
#endif
#ifndef STAGGER_QKV
#define STAGGER_QKV 0
#endif
#ifndef NT_STORE
#define NT_STORE 0
#endif
#ifndef RELAX_STORES
#define RELAX_STORES 1
#endif
namespace pg8 {
#define PG8_LAS __attribute__((address_space(3)))
typedef unsigned short bf16_t;
typedef short bf16x8 __attribute__((ext_vector_type(8)));
typedef float f32x4 __attribute__((ext_vector_type(4)));
typedef unsigned u32x4 __attribute__((ext_vector_type(4)));
constexpr int BM = 256, BK = 64, HALF = 128, HTB = HALF * BK * 2  , STAGE_BYTES = 8 * HTB, NXCD = 8, WGM = 8;

__host__ __device__ __forceinline__ int lds_byte(int r, int c) { const int st = (r >> 4) * 2 + (c >> 5), rr = r & 15, cc = c & 31, ob = rr * 64 + cc * 2; return st * 1024 + (ob ^ (((ob >> 9) & 1) << 5)); }
__host__ __device__ __forceinline__ void stage_rc(int b, int& R, int& C) { const int st = b / 1024, sb = b % 1024, swz = sb ^ (((sb >> 9) & 1) << 5); R = (st >> 1) * 16 + swz / 64; C = (st & 1) * 32 + (swz % 64) / 2; }
__host__ __device__ __forceinline__ int perm32(int rho) { const int n = rho >> 4, i = rho & 15; return 8 * (i >> 2) + 4 * n + (i & 3); }

struct Unit { int pm, pn; };
struct Gemm { const bf16_t* A; const bf16_t* Bt; int M, N, K; const int* rows = nullptr; };

struct StaticOrder {
    int nM, nN, nwg, G, c;
    __host__ __device__ void init(int M, int N, int G_, int c_) { nM = M / BM; nN = N / BM; nwg = nM * nN; G = G_; c = c_; }
    __host__ __device__ bool next(int i, Unit& u) const {
        const long L = (long)i * G + c; if (L >= nwg) return false;
        int wgid = (int)L; { const int q = nwg / NXCD, r = nwg % NXCD, xcd = wgid % NXCD, off = wgid / NXCD; wgid = (xcd < r ? xcd * (q + 1) : r * (q + 1) + (xcd - r) * q) + off; }
        const int nig = WGM * nN, gid = wgid / nig, fm = gid * WGM, gsz = (nM - fm) < WGM ? (nM - fm) : WGM;
        u.pm = fm + ((wgid % nig) % gsz); u.pn = (wgid % nig) / gsz; return true;
    }
    __device__ __forceinline__ void a_ready(const Unit&) const {}
    __device__ __forceinline__ void done(const Unit&) const {}
};
__device__ __forceinline__ unsigned cvt_pk_bf16(float lo, float hi) { unsigned r; asm volatile("v_cvt_pk_bf16_f32 %0, %1, %2" : "=v"(r) : "v"(lo), "v"(hi)); return r; }
typedef float f32x2 __attribute__((ext_vector_type(2)));
typedef int i32x8 __attribute__((ext_vector_type(8))); typedef int i32x4p __attribute__((ext_vector_type(4)));
#ifndef PG8_F8_SCALE
#define PG8_F8_SCALE 0x7f7f7f7f
#endif
__device__ __forceinline__ i32x8 pg8_cat(bf16x8 lo, bf16x8 hi) { const i32x4p a = __builtin_bit_cast(i32x4p, lo), b = __builtin_bit_cast(i32x4p, hi); return (i32x8){a.x, a.y, a.z, a.w, b.x, b.y, b.z, b.w}; }
#if PG8_F8_SCALED
__device__ __forceinline__ void pg8_mma8(f32x4& acc, i32x8 b, i32x8 a) { asm volatile("v_mfma_scale_f32_16x16x128_f8f6f4 %0, %1, %2, %0, %3, %3 op_sel_hi:[0,0,0]" : "+v"(acc) : "v"(b), "v"(a), "v"(0x7f7f7f7f)); }
#else
__device__ __forceinline__ void pg8_mma8(f32x4& acc, i32x8 b, i32x8 a) { asm volatile("v_mfma_f32_16x16x128_f8f6f4 %0, %1, %2, %0" : "+v"(acc) : "v"(b), "v"(a)); }
#endif
__device__ __forceinline__ void pg8_mma16(f32x4& acc, bf16x8 b, bf16x8 a) { asm volatile("v_mfma_f32_16x16x32_bf16 %0, %1, %2, %0" : "+v"(acc) : "v"(b), "v"(a)); }
template <class Epi, class Sched, bool ALIGN_EPI = false, bool SP2 = false, int ES = 2  , bool GATHER = false  >
__device__ __forceinline__ void gemm_phase(PG8_LAS unsigned char* lds, const Gemm g, const Sched& S, const Epi& E) {
    const int tid = threadIdx.x, wid = __builtin_amdgcn_readfirstlane(tid >> 6), lane = tid & 63, wr = wid >> 2, wc = wid & 3, fr = lane & 15, fq = lane >> 4;
    const int K = g.K * ES / 2  , nt = K / BK;
    unsigned voffA[2], voffB[2];
#pragma unroll
    for (int i = 0; i < 2; ++i) { int R, C; stage_rc(tid * 16 + i * 8192, R, C); const int Rb = Epi::PERM ? ((R & ~31) + perm32(R & 31)) : R;
        voffA[i] = (unsigned)(R * K + C) * 2u; voffB[i] = (unsigned)(Rb * K + C) * 2u; }
    const size_t kstep = (size_t)(BK * 2);
    const size_t hstep = (size_t)HALF * K * 2;
    const size_t tstep = 2 * hstep;
    const size_t hstepA = GATHER ? 0 : hstep;
    unsigned cG0[2] = {voffA[0], voffA[1]}, cG1[2] = {voffA[0], voffA[1]}, nG0[2] = {voffA[0], voffA[1]}, nG1[2] = {voffA[0], voffA[1]};
#define PG8_GROWS(G0, G1, PM) do { if constexpr (GATHER) { _Pragma("unroll") for (int i_ = 0; i_ < 2; ++i_) { int R_, C_; stage_rc(tid * 16 + i_ * 8192, R_, C_); \
        const int* rp_ = g.rows + (size_t)(PM) * 256 + R_; G0[i_] = (unsigned)rp_[0] * (unsigned)(K * 2) + (unsigned)(C_ * 2); G1[i_] = (unsigned)rp_[128] * (unsigned)(K * 2) + (unsigned)(C_ * 2); } } } while (0)
    const unsigned ldsw = (unsigned)wid * 1024u;
    const int aoff = lds_byte(wr * 64 + fr, fq * 8), boff = lds_byte(wc * 32 + fr, fq * 8);
#define PG8_SA(b, h) (((b) * 2 + (h)) * HTB)
#define PG8_SB(b, h) ((4 + (b) * 2 + (h)) * HTB)
#define PG8_STAGE(bufoff, gbase, voff) do { _Pragma("unroll") for (int _i = 0; _i < 2; ++_i) \
        __builtin_amdgcn_global_load_lds((const unsigned*)((const char*)(gbase) + (voff)[_i]), (PG8_LAS unsigned*)(lds + (bufoff) + ldsw + _i * 8192), 16, 0, 0); } while (0)
#define PG8_LDA(dst, b, h) do { _Pragma("unroll") for (int m = 0; m < 4; ++m) _Pragma("unroll") for (int k = 0; k < 2; ++k) dst[m][k] = *(const PG8_LAS bf16x8*)(lds + PG8_SA(b, h) + aoff + m * 2048 + k * 1024); } while (0)
#define PG8_LDB(dst, b, h) do { _Pragma("unroll") for (int n = 0; n < 2; ++n) _Pragma("unroll") for (int k = 0; k < 2; ++k) dst[n][k] = *(const PG8_LAS bf16x8*)(lds + PG8_SB(b, h) + boff + n * 2048 + k * 1024); } while (0)
#define PG8_MMA(ai, bj, At, Bt) do { __builtin_amdgcn_s_setprio(1); _Pragma("unroll") for (int m = 0; m < 4; ++m) _Pragma("unroll") for (int n = 0; n < 2; ++n) { \
        if constexpr (ES == 2) { _Pragma("unroll") for (int k = 0; k < 2; ++k) acc[ai][bj][m][n] = __builtin_amdgcn_mfma_f32_16x16x32_bf16(Bt[n][k], At[m][k], acc[ai][bj][m][n], 0, 0, 0); } \
        else { pg8_mma8(acc[ai][bj][m][n], pg8_cat(Bt[n][0], Bt[n][1]), pg8_cat(At[m][0], At[m][1])); } } \
        __builtin_amdgcn_s_setprio(0); } while (0)
#define PG8_WAIT_V(n) asm volatile("s_waitcnt vmcnt(" #n ")" ::: "memory")
#define PG8_WAIT_L(n) asm volatile("s_waitcnt lgkmcnt(" #n ")" ::: "memory")
#define PG8_WAIT_V8R do { if (relax_st) { if constexpr (Epi::NSTORE == 16) asm volatile("s_waitcnt vmcnt(24)" ::: "memory"); else if constexpr (Epi::NSTORE == 8) asm volatile("s_waitcnt vmcnt(16)" ::: "memory"); else asm volatile("s_waitcnt vmcnt(8)" ::: "memory"); } \
        else asm volatile("s_waitcnt vmcnt(8)" ::: "memory"); } while (0)
#define PG8_BAR __builtin_amdgcn_s_barrier()
#define PG8_SCHED __builtin_amdgcn_sched_barrier(0)
    Unit cur, nxt; int ui = 0;
    if (!S.next(0, cur)) return;
    f32x4 acc[2][2][4][2];
#pragma unroll
    for (int a = 0; a < 2; ++a)
#pragma unroll
        for (int b = 0; b < 2; ++b)
#pragma unroll
            for (int m = 0; m < 4; ++m)
#pragma unroll
                for (int n = 0; n < 2; ++n) acc[a][b][m][n] = (f32x4){0.f, 0.f, 0.f, 0.f};
    bf16x8 At[4][2], B0[2][2], B1[2][2];
    const char* cA = (const char*)g.A + (GATHER ? (size_t)0 : (size_t)cur.pm * tstep); const char* cB = (const char*)g.Bt + (size_t)cur.pn * tstep;
    PG8_GROWS(cG0, cG1, cur.pm);
    S.a_ready(cur);
    if constexpr (SP2) {
        PG8_STAGE(PG8_SB(0, 0), cB, voffB); PG8_STAGE(PG8_SB(0, 1), cB + hstep, voffB); PG8_STAGE(PG8_SA(0, 0), cA, cG0); PG8_STAGE(PG8_SA(0, 1), cA + hstepA, cG1);
        if (wr == 1) PG8_BAR;
        PG8_WAIT_V(2); PG8_BAR;
        PG8_STAGE(PG8_SB(1, 0), cB + kstep, voffB); PG8_STAGE(PG8_SA(1, 0), cA + kstep, cG0); PG8_STAGE(PG8_SB(1, 1), cB + hstep + kstep, voffB);
        PG8_WAIT_V(6); PG8_BAR;
    } else {
        PG8_STAGE(PG8_SB(0, 0), cB, voffB); PG8_STAGE(PG8_SA(0, 0), cA, cG0); PG8_STAGE(PG8_SB(0, 1), cB + hstep, voffB); PG8_STAGE(PG8_SA(0, 1), cA + hstepA, cG1);
        if (wr == 1) PG8_BAR;
        PG8_WAIT_V(4); PG8_BAR;
        PG8_STAGE(PG8_SB(1, 0), cB + kstep, voffB); PG8_STAGE(PG8_SA(1, 0), cA + kstep, cG0); PG8_STAGE(PG8_SB(1, 1), cB + hstep + kstep, voffB);
        PG8_WAIT_V(6); PG8_BAR;
    }
    for (;;) {
        const bool has_next = S.next(ui + 1, nxt);
        const char* nA = (has_next && !GATHER) ? (const char*)g.A + (size_t)nxt.pm * tstep : cA; const char* nB = has_next ? (const char*)g.Bt + (size_t)nxt.pn * tstep : cB;
        if (has_next) PG8_GROWS(nG0, nG1, nxt.pm); else { nG0[0] = cG0[0]; nG0[1] = cG0[1]; nG1[0] = cG1[0]; nG1[1] = cG1[1]; }
#pragma unroll 1
        for (int t = 0; t < nt; t += 2) {
            const bool last = (t == nt - 2);
            const bool relax_st = RELAX_STORES && (t == 0) && (ui > 0);
            const char* a1 = cA + (size_t)(t + 1) * kstep;
            const char* a2 = last ? nA : cA + (size_t)(t + 2) * kstep; const char* b2 = last ? nB : cB + (size_t)(t + 2) * kstep;
            const char* a3 = a2 + kstep; const char* b3 = b2 + kstep;
            if (last && has_next) S.a_ready(nxt);
            const unsigned s0[2] = {last ? nG0[0] : cG0[0], last ? nG0[1] : cG0[1]}, s1[2] = {last ? nG1[0] : cG1[0], last ? nG1[1] : cG1[1]};
            if constexpr (SP2) {
            PG8_LDB(B0, 0, 0); PG8_LDB(B1, 0, 1); PG8_SCHED; PG8_LDA(At, 0, 0); PG8_STAGE(PG8_SA(1, 1), a1 + hstepA, cG1);
            PG8_WAIT_V8R; PG8_WAIT_L(0); PG8_BAR; PG8_MMA(0, 0, At, B0); PG8_MMA(0, 1, At, B1); PG8_BAR; PG8_SCHED;
            PG8_LDA(At, 0, 1); PG8_STAGE(PG8_SB(0, 0), b2, voffB); PG8_STAGE(PG8_SB(0, 1), b2 + hstep, voffB); PG8_STAGE(PG8_SA(0, 0), a2, s0);
            PG8_WAIT_V8R; PG8_WAIT_L(0); PG8_BAR; PG8_MMA(1, 0, At, B0); PG8_MMA(1, 1, At, B1); PG8_BAR; PG8_SCHED;
            PG8_LDB(B0, 1, 0); PG8_LDB(B1, 1, 1); PG8_SCHED; PG8_LDA(At, 1, 0); PG8_STAGE(PG8_SA(0, 1), a2 + hstepA, s1);
            PG8_WAIT_V(8); PG8_WAIT_L(0); PG8_BAR; PG8_MMA(0, 0, At, B0); PG8_MMA(0, 1, At, B1); PG8_BAR; PG8_SCHED;
            PG8_LDA(At, 1, 1); PG8_STAGE(PG8_SB(1, 0), b3, voffB); PG8_STAGE(PG8_SB(1, 1), b3 + hstep, voffB); PG8_STAGE(PG8_SA(1, 0), a3, s0);
            PG8_WAIT_V(8); PG8_WAIT_L(0); PG8_BAR; PG8_MMA(1, 0, At, B0); PG8_MMA(1, 1, At, B1); PG8_BAR; PG8_SCHED;
            } else {
            PG8_LDB(B0, 0, 0); PG8_SCHED; PG8_LDA(At, 0, 0); PG8_STAGE(PG8_SA(1, 1), a1 + hstepA, cG1);
            PG8_WAIT_L(8); PG8_BAR; PG8_WAIT_L(0); PG8_MMA(0, 0, At, B0); PG8_BAR; PG8_SCHED;
            PG8_LDB(B1, 0, 1); PG8_STAGE(PG8_SB(0, 0), b2, voffB);
            PG8_BAR; PG8_WAIT_L(0); PG8_MMA(0, 1, At, B1); PG8_BAR;
            PG8_LDA(At, 0, 1); PG8_STAGE(PG8_SA(0, 0), a2, s0);
            PG8_BAR; PG8_WAIT_L(0); PG8_MMA(1, 0, At, B0); PG8_BAR; PG8_SCHED;
            PG8_STAGE(PG8_SB(0, 1), b2 + hstep, voffB);
            PG8_WAIT_V(6); PG8_BAR; PG8_MMA(1, 1, At, B1); PG8_BAR;
            PG8_LDB(B0, 1, 0); PG8_SCHED; PG8_LDA(At, 1, 0); PG8_STAGE(PG8_SA(0, 1), a2 + hstepA, s1);
            PG8_WAIT_L(8); PG8_BAR; PG8_WAIT_L(0); PG8_MMA(0, 0, At, B0); PG8_BAR; PG8_SCHED;
            PG8_LDB(B1, 1, 1); PG8_STAGE(PG8_SB(1, 0), b3, voffB);
            PG8_BAR; PG8_WAIT_L(0); PG8_MMA(0, 1, At, B1); PG8_BAR;
            PG8_LDA(At, 1, 1); PG8_STAGE(PG8_SA(1, 0), a3, s0);
            PG8_BAR; PG8_WAIT_L(0); PG8_MMA(1, 0, At, B0); PG8_BAR; PG8_SCHED;
            PG8_STAGE(PG8_SB(1, 1), b3 + hstep, voffB);
            PG8_WAIT_V(6); PG8_BAR; PG8_MMA(1, 1, At, B1); PG8_BAR;
            }
        }
        if constexpr (ES == 1) asm volatile("s_nop 15\n\ts_nop 15" ::: "memory");
        if constexpr (ALIGN_EPI) { if (wr == 0) PG8_BAR; }
        if constexpr (!Epi::AFTER_DRAIN) { E(acc, cur, wr, wc, fr, fq); S.done(cur); }
        if (!has_next) break;
#pragma unroll
        for (int a = 0; a < 2; ++a)
#pragma unroll
            for (int b = 0; b < 2; ++b)
#pragma unroll
                for (int m = 0; m < 4; ++m)
#pragma unroll
                    for (int n = 0; n < 2; ++n) acc[a][b][m][n] = (f32x4){0.f, 0.f, 0.f, 0.f};
        cur = nxt; cA = nA; cB = nB; ++ui; cG0[0] = nG0[0]; cG0[1] = nG0[1]; cG1[0] = nG1[0]; cG1[1] = nG1[1];
        if constexpr (ALIGN_EPI) { if (wr == 1) PG8_BAR; }
    }
    PG8_WAIT_V(0);
    if constexpr (!ALIGN_EPI) { if (wr == 0) PG8_BAR; }
    PG8_BAR;
    if constexpr (Epi::AFTER_DRAIN) { E.fused(acc, cur, wr, wc, fr, fq, lds, wid, lane); S.done(cur); }
#undef PG8_GROWS
#undef PG8_SA
#undef PG8_SB
#undef PG8_STAGE
#undef PG8_LDA
#undef PG8_LDB
#undef PG8_MMA
#undef PG8_WAIT_V
#undef PG8_WAIT_L
#undef PG8_WAIT_V8R
#undef PG8_BAR
#undef PG8_SCHED
}
}
namespace attn_body {
using bf16=__hip_bfloat16;
using bf16x8=__attribute__((ext_vector_type(8)))short;
using s16x4=__attribute__((ext_vector_type(4)))short;
using f32x16=__attribute__((ext_vector_type(16)))float;
using u32x4=__attribute__((ext_vector_type(4)))unsigned;
__device__ __forceinline__ int crow(int r,int hi){return (r&3)+8*(r>>2)+4*hi;}
#define SBAR() __builtin_amdgcn_sched_barrier(0)
__device__ __forceinline__ void glds16(const void*gsrc,unsigned lds_dst){unsigned keep;
  asm volatile("s_mov_b32 %0, m0\n\ts_mov_b32 m0, %2\n\ts_nop 0\n\tglobal_load_lds_dwordx4 %1, off\n\ts_mov_b32 m0, %0":"=&s"(keep):"v"(gsrc),"s"(lds_dst):"memory");}
__device__ __forceinline__ float max3f(float a,float b,float c){float r;asm("v_max3_f32 %0, %1, %2, %3":"=v"(r):"v"(a),"v"(b),"v"(c));return r;}
__device__ __forceinline__ float max2f(float a,float b){float r;asm("v_max_f32_e32 %0, %1, %2":"=v"(r):"v"(a),"v"(b));return r;}
__device__ __forceinline__ float fadd_s(float a,float b){float r;asm("v_add_f32_e32 %0, %1, %2":"=v"(r):"v"(a),"v"(b));return r;}
__device__ __forceinline__ float fsub_s(float a,float b){float r;asm("v_sub_f32_e32 %0, %1, %2":"=v"(r):"v"(a),"v"(b));return r;}
typedef float f32x2_t __attribute__((ext_vector_type(2))); typedef __bf16 bf16x2_t __attribute__((ext_vector_type(2)));
__device__ __forceinline__ unsigned cvtpk_s(float lo,float hi){f32x2_t v={lo,hi};bf16x2_t b=__builtin_convertvector(v,bf16x2_t);return __builtin_bit_cast(unsigned,b);}
#define WAIT_BAR(N) asm volatile("s_waitcnt vmcnt(" #N ") lgkmcnt(0)\n\ts_barrier":::"memory")
typedef __attribute__((address_space(3))) const char* lds_cptr;
typedef short v4i16_t __attribute__((ext_vector_type(4)));
__device__ __forceinline__ void kload8(bf16x8*kf,lds_cptr kp){
  kf[0]=*(const __attribute__((address_space(3))) bf16x8*)(kp);      kf[1]=*(const __attribute__((address_space(3))) bf16x8*)(kp+512);
  kf[2]=*(const __attribute__((address_space(3))) bf16x8*)(kp+2048); kf[3]=*(const __attribute__((address_space(3))) bf16x8*)(kp+2560);
  kf[4]=*(const __attribute__((address_space(3))) bf16x8*)(kp+4096); kf[5]=*(const __attribute__((address_space(3))) bf16x8*)(kp+4608);
  kf[6]=*(const __attribute__((address_space(3))) bf16x8*)(kp+6144); kf[7]=*(const __attribute__((address_space(3))) bf16x8*)(kp+6656);
}
__device__ __forceinline__ void kload2(bf16x8*kf,lds_cptr kp,int j){ kf[2*j]=*(const __attribute__((address_space(3))) bf16x8*)(kp+j*2048); kf[2*j+1]=*(const __attribute__((address_space(3))) bf16x8*)(kp+j*2048+512); }
__device__ __forceinline__ s16x4 vtr(lds_cptr p){ return __builtin_bit_cast(s16x4,__builtin_amdgcn_ds_read_tr16_b64_v4i16((__attribute__((address_space(3))) v4i16_t*)p)); }
__device__ __forceinline__ float rowmax(const f32x16&p0,const f32x16&p1){
  float a=max3f(p0[0],p0[1],p1[0]),b=max3f(p0[2],p0[3],p1[1]);a=max3f(a,p1[2],p1[3]);
  #pragma unroll
  for(int r=4;r<16;r+=4){a=max3f(a,p0[r],p0[r+1]);b=max3f(b,p0[r+2],p0[r+3]);a=max3f(a,p1[r],p1[r+1]);b=max3f(b,p1[r+2],p1[r+3]);}
  const float m=max2f(a,b);
  auto rr=__builtin_amdgcn_permlane32_swap(__float_as_uint(m),__float_as_uint(m),false,false);
  return max2f(__uint_as_float(rr[0]),__uint_as_float(rr[1]));
}
__device__ __forceinline__ void pv(f32x16*o,int vb,bf16x8 pa0,bf16x8 pa1,bf16x8 pa2,bf16x8 pa3){
  #pragma unroll
  for(int d0=0;d0<2;++d0){s16x4 lo[4],hi[4];
    #pragma unroll
    for(int ks=0;ks<4;++ks){
      asm volatile("ds_read_b64_tr_b16 %0,%1 offset:%c2":"=&v"(lo[ks]):"v"(vb),"i"(d0*4096+ks*1024):"memory");
      asm volatile("ds_read_b64_tr_b16 %0,%1 offset:%c2":"=&v"(hi[ks]):"v"(vb),"i"(d0*4096+ks*1024+512):"memory");}
    asm volatile("s_waitcnt lgkmcnt(0)":::"memory");SBAR();
    #define PK(k) (bf16x8){lo[k][0],lo[k][1],lo[k][2],lo[k][3],hi[k][0],hi[k][1],hi[k][2],hi[k][3]}
    o[d0]=__builtin_amdgcn_mfma_f32_32x32x16_bf16(pa0,PK(0),o[d0],0,0,0);
    o[d0]=__builtin_amdgcn_mfma_f32_32x32x16_bf16(pa1,PK(1),o[d0],0,0,0);
    o[d0]=__builtin_amdgcn_mfma_f32_32x32x16_bf16(pa2,PK(2),o[d0],0,0,0);
    o[d0]=__builtin_amdgcn_mfma_f32_32x32x16_bf16(pa3,PK(3),o[d0],0,0,0);
    #undef PK
  }
}
}

constexpr int BATCH = 8, SEQ = 4096, T = BATCH * SEQ, D = 1024, NE = 32, TOPK = 4, NH = 16, HD = 64;
constexpr int NQKV = 9216;
constexpr int MAXROWS = T * TOPK + NE * 256;
constexpr int MAXTILES = MAXROWS / 256;
constexpr int NVB = T / 128;
constexpr float LOG2E = 1.4426950408889634f;
constexpr float QSCALE = 0.125f * LOG2E;
constexpr float RMS_EPS = 1e-6f;
constexpr int NWAVES = 8;

constexpr size_t MiB = 1ull << 20;
constexpr size_t WS_CTL = 0, CTL_ZERO_BYTES = 1 * MiB;
constexpr size_t WS_SM = 1 * MiB;
constexpr size_t SM_ADA = WS_SM;
constexpr size_t SM_GM = WS_SM + 512 * 1024;
constexpr size_t SM_CSH = WS_SM + 640 * 1024;
constexpr size_t SM_BIAST = WS_SM + 644 * 1024;
constexpr size_t SM_BLKCNT = WS_SM + 704 * 1024;
constexpr size_t SM_TILEEXP = WS_SM + 768 * 1024;
constexpr size_t SM_TOPI = WS_SM + 1 * MiB;
constexpr size_t SM_TOPG = SM_TOPI + 512 * 1024;
constexpr size_t SM_RANK = SM_TOPG + 512 * 1024;
constexpr size_t SM_SLOT = SM_RANK + 512 * 1024;
constexpr size_t SM_TOKSLOT = WS_SM + 3 * MiB;
constexpr size_t SM_LOGF = WS_SM + 4 * MiB;
constexpr size_t SM_FCUM = WS_SM + 6 * MiB;
constexpr size_t SM_LSE = WS_SM + 8 * MiB;
constexpr size_t WS_WQKV = 16 * MiB, WS_WO0 = 34 * MiB, WS_WKV = 36 * MiB, WS_WQ = 40 * MiB, WS_WO1 = 42 * MiB, WS_WGU = 44 * MiB, WS_WDN = 300 * MiB;
constexpr size_t WS_HKV = 428 * MiB, WS_H = 492 * MiB, WS_OG = 556 * MiB, WS_O = 748 * MiB;
constexpr size_t WS_QKV0 = 812 * MiB, WS_ACT = 812 * MiB, WS_Y = 1084 * MiB, WS_QKV1 = 1388 * MiB, WS_XB = 1388 * MiB, WS_H8 = 1524 * MiB, WS_END = 1660 * MiB, WS_XS = WS_H;
static_assert(WS_H == WS_HKV + (size_t)T * D * 2, "H must follow HKV (KVQ GEMM addresses both through one A pointer)");
static_assert(WS_WQ == WS_WKV + (size_t)2048 * 1024 * 2, "Wq_t must follow Wkv_t");
static_assert(SM_LSE + (size_t)3 * T * 16 * 4 <= WS_WQKV, "small region");
static_assert(WS_Y + (size_t)MAXROWS * D * 2 <= WS_QKV1 && WS_XB + (size_t)MAXROWS * D * 2 <= WS_END && WS_QKV0 + (size_t)BATCH * 9 * 16 * SEQ * 64 * 2 <= WS_QKV1, "ws map");
constexpr int CW_TMO = 0, CW_BAR = 4096, CW_QUEUE = 65536  , CW_NRM = 131072  ;

constexpr int RING_OFF = 0, RING_BYTES = 131072;
constexpr int SCR_OFF = RING_BYTES, SCR_BYTES = 16384;
constexpr int BLK_OFF = SCR_OFF + SCR_BYTES, BLK_BYTES = 12288;
constexpr int MISC_OFF = BLK_OFF + BLK_BYTES;
constexpr int LDS_BYTES = MISC_OFF + 256;
constexpr int BL_TILE = 0, BL_WCNT = 576, BL_WBASE = 832, BL_PARTA = 1088, BL_PARTB = 1600, BL_TOT = 2112, BL_BASE = 2144, BL_PADS = 2176;

#define LAS __attribute__((address_space(3)))
#define GAS __attribute__((address_space(1)))
typedef unsigned short bf16;
typedef float f32x4 __attribute__((ext_vector_type(4)));
typedef unsigned u32x4v __attribute__((ext_vector_type(4)));
typedef unsigned u32x2v __attribute__((ext_vector_type(2)));
typedef int i32x4v __attribute__((ext_vector_type(4)));
#define LDS_WAIT() asm volatile("s_waitcnt lgkmcnt(0)" ::: "memory")
#define VM_WAIT() asm volatile("s_waitcnt vmcnt(0)" ::: "memory")

__device__ __forceinline__ float bf2f(unsigned v) { return __uint_as_float(v << 16); }
__device__ __forceinline__ unsigned pkbf(float lo, float hi) { return attn_body::cvtpk_s(lo, hi); }
__device__ __forceinline__ float wave_sum(float v) {
#pragma unroll
    for (int o = 1; o < 64; o <<= 1) v += __shfl_xor(v, o);
    return v;
}

namespace pg8 {
struct EpiQKV0 {
    static constexpr bool PERM = true, AFTER_DRAIN = false; static constexpr int NSTORE = 16;
    bf16_t* O; float mul;
    __device__ __forceinline__ void operator()(const f32x4 (&acc)[2][2][4][2], const Unit& u, int wr, int wc, int fr, int fq) const {
        _Pragma("unroll") for (int rep_e = 0; rep_e < 1 + ((PROBE_EPI >> 0) & 1); ++rep_e) {
        asm volatile("" : "+v"(fr), "+v"(fq));
        const int g = u.pn / 12, rem = u.pn - g * 12, which = rem >> 2, h0 = (rem & 3) * 4, sh = 2 * g;
        const float sc = (which == 0 ? QSCALE : 1.f) * mul;
#pragma unroll
        for (int ai = 0; ai < 2; ++ai)
#pragma unroll
            for (int m = 0; m < 4; ++m) {
                const int tok = u.pm * BM + ai * HALF + wr * 64 + m * 16 + fr, b = tok >> 12, s = tok & 4095;
                const int subrow = (s & ((1 << sh) - 1)) * (4096 >> sh) + (s >> sh);
#pragma unroll
                for (int bj = 0; bj < 2; ++bj) {
                    const int head = h0 + 2 * bj + (wc >> 1), dcol = (wc & 1) * 32 + 8 * fq;
                    const size_t plane = (size_t)(((b * 3 + g) * 3 + which) * 16 + head);
                    const f32x4 v0 = acc[ai][bj][m][0] * sc, v1 = acc[ai][bj][m][1] * sc;
                    u32x4 w; w.x = cvt_pk_bf16(v0[0], v0[1]); w.y = cvt_pk_bf16(v0[2], v0[3]); w.z = cvt_pk_bf16(v1[0], v1[1]); w.w = cvt_pk_bf16(v1[2], v1[3]);
#if NT_STORE
                    __builtin_nontemporal_store(w, (u32x4*)(O + (plane * 4096 + subrow) * 64 + dcol));
#else
                    *(u32x4*)(O + (plane * 4096 + subrow) * 64 + dcol) = w;
#endif
                }
            }
        }
    }
};
struct EpiQKV0Probe {
    static constexpr bool PERM = true, AFTER_DRAIN = false; static constexpr int NSTORE = 16;
    bf16_t* O; float mul; int wide;
    __device__ __forceinline__ void operator()(const f32x4 (&acc)[2][2][4][2], const Unit& u, int wr, int wc, int fr, int fq) const {
        asm volatile("" : "+v"(fr), "+v"(fq));
        const int g = u.pn / 12, rem = u.pn - g * 12, which = rem >> 2, h0 = (rem & 3) * 4, sh = 2 * g;
        const float sc = (which == 0 ? QSCALE : 1.f) * mul;
#pragma unroll
        for (int ai = 0; ai < 2; ++ai)
#pragma unroll
            for (int m = 0; m < 4; ++m) {
                const int tok = u.pm * BM + ai * HALF + wr * 64 + m * 16 + fr, b = tok >> 12, s = tok & 4095;
                const int subrow = (s & ((1 << sh) - 1)) * (4096 >> sh) + (s >> sh);
                const int head = h0 + wc, dcol = 16 * fq;
                const size_t plane = (size_t)(((b * 3 + g) * 3 + which) * 16 + head);
#pragma unroll
                for (int bj = 0; bj < 2; ++bj) {
                    const f32x4 v0 = acc[ai][bj][m][0] * sc, v1 = acc[ai][bj][m][1] * sc;
                    u32x4 w; w.x = cvt_pk_bf16(v0[0], v0[1]); w.y = cvt_pk_bf16(v0[2], v0[3]); w.z = cvt_pk_bf16(v1[0], v1[1]); w.w = cvt_pk_bf16(v1[2], v1[3]);
                    *(u32x4*)(O + (plane * 4096 + subrow) * 64 + dcol + 8 * bj) = w;
                }
            }
    }
};
struct EpiKVQ {
    static constexpr bool PERM = true, AFTER_DRAIN = false; static constexpr int NSTORE = 16;
    bf16_t* O; float mul; unsigned* nrm;
    __device__ __forceinline__ void operator()(const f32x4 (&acc)[2][2][4][2], const Unit& u, int wr, int wc, int fr, int fq) const {
        asm volatile("" : "+v"(fr), "+v"(fq));
        const int which = u.pn < 4 ? 1 : (u.pn < 8 ? 2 : 0), h0 = (u.pn & 3) * 4, pm = u.pm & 127;
        const float sc = (which == 0 ? QSCALE : 1.f) * mul;
        float nmax[2] = {0.f, 0.f};
#pragma unroll
        for (int ai = 0; ai < 2; ++ai)
#pragma unroll
            for (int m = 0; m < 4; ++m) {
                const int tok = pm * BM + ai * HALF + wr * 64 + m * 16 + fr, b = tok >> 12, s = tok & 4095;
#pragma unroll
                for (int bj = 0; bj < 2; ++bj) {
                    const int head = h0 + 2 * bj + (wc >> 1), dcol = (wc & 1) * 32 + 8 * fq;
                    const size_t plane = (size_t)((b * 3 + which) * 16 + head);
                    const f32x4 v0 = acc[ai][bj][m][0] * sc, v1 = acc[ai][bj][m][1] * sc;
                    u32x4 w; w.x = cvt_pk_bf16(v0[0], v0[1]); w.y = cvt_pk_bf16(v0[2], v0[3]); w.z = cvt_pk_bf16(v1[0], v1[1]); w.w = cvt_pk_bf16(v1[2], v1[3]);
                    *(u32x4*)(O + (plane * 4096 + s) * 64 + dcol) = w;
                    if (which != 2) {
                        float ss = 0.f;
#pragma unroll
                        for (int k4 = 0; k4 < 4; ++k4) { const unsigned pw_ = k4 == 0 ? w.x : (k4 == 1 ? w.y : (k4 == 2 ? w.z : w.w)); const float lo_ = __uint_as_float(pw_ << 16), hi_ = __uint_as_float(pw_ & 0xffff0000u); ss += lo_ * lo_ + hi_ * hi_; }
                        ss += __shfl_xor(ss, 16); ss += __shfl_xor(ss, 32);
                        nmax[bj] = fmaxf(nmax[bj], ss);
                    }
                }
            }
        if (which != 2) {
#pragma unroll
            for (int bj = 0; bj < 2; ++bj) { float v = nmax[bj];
                v = fmaxf(v, __shfl_xor(v, 1)); v = fmaxf(v, __shfl_xor(v, 2)); v = fmaxf(v, __shfl_xor(v, 4)); v = fmaxf(v, __shfl_xor(v, 8));
                if (fr == 0 && fq == 0) { const int b0 = (pm * BM) >> 12, head = h0 + 2 * bj + (wc >> 1);
                    atomicMax(nrm + (((b0 * 2 + which) * 16 + head) * 2 + (wc & 1)), __float_as_uint(v)); } }
        }
    }
};
template <bool SRC_BF16> struct EpiResid {
    static constexpr bool PERM = true, AFTER_DRAIN = false; static constexpr int NSTORE = 16;
    const void* src; bf16_t* dst; const float* gate; float mul;
    __device__ __forceinline__ void operator()(const f32x4 (&acc)[2][2][4][2], const Unit& u, int wr, int wc, int fr, int fq) const {
        asm volatile("" : "+v"(fr), "+v"(fq));
#pragma unroll
        for (int ai = 0; ai < 2; ++ai)
#pragma unroll
            for (int m = 0; m < 4; ++m) {
                const int row = u.pm * BM + ai * HALF + wr * 64 + m * 16 + fr, b = row >> 12;
#pragma unroll
                for (int bj = 0; bj < 2; ++bj) {
                    const int col = u.pn * BM + bj * HALF + wc * 32 + 8 * fq;
                    f32x4 x0, x1;
                    if (SRC_BF16) { const u32x4 r = *(const u32x4*)((const bf16_t*)src + (size_t)row * D + col);
                        x0 = (f32x4){__uint_as_float(r.x << 16), __uint_as_float(r.x & 0xffff0000u), __uint_as_float(r.y << 16), __uint_as_float(r.y & 0xffff0000u)};
                        x1 = (f32x4){__uint_as_float(r.z << 16), __uint_as_float(r.z & 0xffff0000u), __uint_as_float(r.w << 16), __uint_as_float(r.w & 0xffff0000u)}; }
                    else { x0 = *(const f32x4*)((const float*)src + (size_t)row * D + col); x1 = *(const f32x4*)((const float*)src + (size_t)row * D + col + 4); }
                    const f32x4 g0 = *(const f32x4*)(gate + b * 6144 + col), g1 = *(const f32x4*)(gate + b * 6144 + col + 4);
                    const f32x4 v0 = x0 + (g0 * mul) * acc[ai][bj][m][0], v1 = x1 + (g1 * mul) * acc[ai][bj][m][1];
                    u32x4 w; w.x = cvt_pk_bf16(v0[0], v0[1]); w.y = cvt_pk_bf16(v0[2], v0[3]); w.z = cvt_pk_bf16(v1[0], v1[1]); w.w = cvt_pk_bf16(v1[2], v1[3]);
                    *(u32x4*)(dst + (size_t)row * D + col) = w;
                }
            }
    }
};
struct EpiSwiGLU {
    static constexpr bool PERM = true, AFTER_DRAIN = false; static constexpr int NSTORE = 0;
    bf16_t* ACT; const float* bgu;
    __device__ __forceinline__ void operator()(const f32x4 (&acc)[2][2][4][2], const Unit& u, int wr, int wc, int fr, int fq) const {
        const int e = u.pn >> 3, pnl = u.pn & 7, j0 = pnl * 128 + wc * 32 + 8 * fq;
        f32x4 bg[2], bu[2];
#pragma unroll
        for (int n = 0; n < 2; ++n) { bg[n] = *(const f32x4*)(bgu + e * 2048 + j0 + 4 * n); bu[n] = *(const f32x4*)(bgu + e * 2048 + 1024 + j0 + 4 * n); }
#pragma unroll
        for (int ai = 0; ai < 2; ++ai)
#pragma unroll
            for (int m = 0; m < 4; ++m) {
                const int row = u.pm * BM + ai * HALF + wr * 64 + m * 16 + fr;
                float a[8];
#pragma unroll
                for (int n = 0; n < 2; ++n) {
                    const f32x4 gv = acc[ai][0][m][n] + bg[n], uv = acc[ai][1][m][n] + bu[n];
#pragma unroll
                    for (int i = 0; i < 4; ++i) {
                        const float gg = fminf(gv[i], 7.f), uu = fminf(fmaxf(uv[i], -7.f), 7.f);
                        const float sg = __builtin_amdgcn_rcpf(1.f + __builtin_amdgcn_exp2f(-1.702f * LOG2E * gg));
                        a[4 * n + i] = (uu + 1.f) * gg * sg;
                    }
                }
                u32x4 w; w.x = cvt_pk_bf16(a[0], a[1]); w.y = cvt_pk_bf16(a[2], a[3]); w.z = cvt_pk_bf16(a[4], a[5]); w.w = cvt_pk_bf16(a[6], a[7]);
                *(u32x4*)(ACT + (size_t)row * D + j0) = w;
            }
    }
};
struct EpiDown {
    static constexpr bool PERM = true, AFTER_DRAIN = false; static constexpr int NSTORE = 0;
    bf16_t* Y; const float* bdn;
    __device__ __forceinline__ void operator()(const f32x4 (&acc)[2][2][4][2], const Unit& u, int wr, int wc, int fr, int fq) const {
        const int e = u.pn >> 2, pnl = u.pn & 3;
#pragma unroll
        for (int ai = 0; ai < 2; ++ai)
#pragma unroll
            for (int m = 0; m < 4; ++m) {
                const int row = u.pm * BM + ai * HALF + wr * 64 + m * 16 + fr;
#pragma unroll
                for (int bj = 0; bj < 2; ++bj) {
                    const int col = pnl * BM + bj * HALF + wc * 32 + 8 * fq;
                    const f32x4 b0 = *(const f32x4*)(bdn + e * 1024 + col), b1 = *(const f32x4*)(bdn + e * 1024 + col + 4);
                    const f32x4 v0 = acc[ai][bj][m][0] + b0, v1 = acc[ai][bj][m][1] + b1;
                    u32x4 w; w.x = cvt_pk_bf16(v0[0], v0[1]); w.y = cvt_pk_bf16(v0[2], v0[3]); w.z = cvt_pk_bf16(v1[0], v1[1]); w.w = cvt_pk_bf16(v1[2], v1[3]);
                    *(u32x4*)(Y + (size_t)row * D + col) = w;
                }
            }
    }
};
__device__ __forceinline__ unsigned pk4_fp8(float a, float b, float c, float d) { int v = __builtin_amdgcn_cvt_pk_fp8_f32(a, b, 0, false); v = __builtin_amdgcn_cvt_pk_fp8_f32(c, d, v, true); return (unsigned)v; }
struct EpiSwiGLU8 {
    static constexpr bool PERM = true, AFTER_DRAIN = false; static constexpr int NSTORE = 8;
    unsigned char* ACT; const float* bgu;
    __device__ __forceinline__ void operator()(const f32x4 (&acc)[2][2][4][2], const Unit& u, int wr, int wc, int fr, int fq) const {
        _Pragma("unroll") for (int rep_e = 0; rep_e < 1 + ((PROBE_EPI >> 1) & 1); ++rep_e) {
        asm volatile("" : "+v"(fr), "+v"(fq));
        const int e = u.pn >> 3, pnl = u.pn & 7, j0 = pnl * 128 + wc * 32 + 8 * fq;
        f32x4 bg[2], bu[2];
#pragma unroll
        for (int n = 0; n < 2; ++n) { bg[n] = *(const f32x4*)(bgu + e * 2048 + j0 + 4 * n) * 64.f; bu[n] = *(const f32x4*)(bgu + e * 2048 + 1024 + j0 + 4 * n) * 64.f + 64.f; }
#pragma unroll
        for (int ai = 0; ai < 2; ++ai)
#pragma unroll
            for (int m = 0; m < 4; ++m) {
                const int row = u.pm * BM + ai * HALF + wr * 64 + m * 16 + fr;
                float a[8];
#pragma unroll
                for (int n = 0; n < 2; ++n) {
                    const f32x4 gv = acc[ai][0][m][n] + bg[n], uv = acc[ai][1][m][n] + bu[n];
#pragma unroll
                    for (int i = 0; i < 4; ++i) {
                        const float gg = fminf(gv[i], 448.f), uu = fminf(fmaxf(uv[i], -384.f), 512.f);
                        const float t = __builtin_amdgcn_exp2f((-1.702f * LOG2E * 0.015625f) * gg);
                        const float sg = __builtin_amdgcn_rcpf(__builtin_fmaf(t, 4096.f, 4096.f));
                        a[4 * n + i] = (uu * gg) * sg;
                    }
                }
                typedef unsigned u32x2e __attribute__((ext_vector_type(2)));
                u32x2e w; w.x = pk4_fp8(a[0], a[1], a[2], a[3]); w.y = pk4_fp8(a[4], a[5], a[6], a[7]);
                *(u32x2e*)(ACT + (size_t)row * D + j0) = w;
            }
        }
    }
};
template <int VAR> struct EpiProbeGU {
    static constexpr bool PERM = true, AFTER_DRAIN = false; static constexpr int NSTORE = 0;
    unsigned char* ACT; const float* bgu;
    __device__ __forceinline__ void operator()(const f32x4 (&acc)[2][2][4][2], const Unit& u, int wr, int wc, int fr, int fq) const {
        if (VAR == 2) { if (acc[0][0][0][0][0] == 12345.678f) ACT[0] = 1; return; }
        asm volatile("" : "+v"(fr), "+v"(fq));
        const int pnl = u.pn & 7, j0 = pnl * 128 + wc * 32 + 8 * fq;
#pragma unroll
        for (int ai = 0; ai < 2; ++ai)
#pragma unroll
            for (int m = 0; m < 4; ++m) {
                const int row = u.pm * BM + ai * HALF + wr * 64 + m * 16 + fr;
                const f32x4 g0 = acc[ai][0][m][0] + acc[ai][1][m][0], g1 = acc[ai][0][m][1] + acc[ai][1][m][1];
                typedef unsigned u32x2e __attribute__((ext_vector_type(2)));
                u32x2e w; w.x = pk4_fp8(g0[0], g0[1], g0[2], g0[3]); w.y = pk4_fp8(g1[0], g1[1], g1[2], g1[3]);
                *(u32x2e*)(ACT + (size_t)row * D + j0) = w;
            }
    }
};
struct EpiNone { static constexpr bool PERM = true, AFTER_DRAIN = false; static constexpr int NSTORE = 0; unsigned char* P;
    __device__ __forceinline__ void operator()(const f32x4 (&acc)[2][2][4][2], const Unit& u, int wr, int wc, int fr, int fq) const { if (acc[0][0][0][0][0] == 12345.678f) P[0] = 1; } };
struct EpiDown8 {
    static constexpr bool PERM = true, AFTER_DRAIN = false; static constexpr int NSTORE = 16;
    bf16_t* Y; const float* bdn;
    __device__ __forceinline__ void operator()(const f32x4 (&acc)[2][2][4][2], const Unit& u, int wr, int wc, int fr, int fq) const {
        _Pragma("unroll") for (int rep_e = 0; rep_e < 1 + ((PROBE_EPI >> 2) & 1); ++rep_e) {
        asm volatile("" : "+v"(fr), "+v"(fq));
        const int e = u.pn >> 2, pnl = u.pn & 3;
#pragma unroll
        for (int ai = 0; ai < 2; ++ai)
#pragma unroll
            for (int m = 0; m < 4; ++m) {
                const int row = u.pm * BM + ai * HALF + wr * 64 + m * 16 + fr;
#pragma unroll
                for (int bj = 0; bj < 2; ++bj) {
                    const int col = pnl * BM + bj * HALF + wc * 32 + 8 * fq;
                    const f32x4 b0 = *(const f32x4*)(bdn + e * 1024 + col), b1 = *(const f32x4*)(bdn + e * 1024 + col + 4);
                    const f32x4 v0 = acc[ai][bj][m][0] * 0.015625f + b0, v1 = acc[ai][bj][m][1] * 0.015625f + b1;
                    if (Y_FP8) { typedef unsigned u32x2e __attribute__((ext_vector_type(2))); u32x2e w8; w8.x = pk4_fp8(v0[0], v0[1], v0[2], v0[3]); w8.y = pk4_fp8(v1[0], v1[1], v1[2], v1[3]);
                        *(u32x2e*)((unsigned char*)Y + (size_t)row * D + col) = w8; }
                    else { u32x4 w; w.x = cvt_pk_bf16(v0[0], v0[1]); w.y = cvt_pk_bf16(v0[2], v0[3]); w.z = cvt_pk_bf16(v1[0], v1[1]); w.w = cvt_pk_bf16(v1[2], v1[3]);
                        *(u32x4*)(Y + (size_t)row * D + col) = w; }
                }
            }
        }
    }
};
struct KVQOrder : StaticOrder {
    __device__ bool next(int i, Unit& u) const { if (!StaticOrder::next(i, u)) return false; if (u.pn >= 8) u.pm += 128; return true; }
};
template <int NN> struct MoeOrder {
    static constexpr int TR = 32 / NN;
    const LAS int* tile_exp; int n_tiles, c, G;
    __device__ __forceinline__ bool next(int i, Unit& u) const {
        int st, j;
        if (G == 256) { st = i * 8 + (c & 7); j = c >> 3; } else { const int L = i * G + c; st = L >> 5; j = L & 31; }
        const int tile = st * TR + (j % TR);
        if (tile >= n_tiles) return false;
        u.pm = tile; u.pn = tile_exp[tile] * NN + j / TR; return true;
    }
    __device__ __forceinline__ void a_ready(const Unit&) const {}
    __device__ __forceinline__ void done(const Unit&) const {}
};
}

namespace attn_body {
constexpr int KSLOT = 8192;
constexpr int L_K = 0, L_V = 2 * KSLOT, L_WS = 4 * KSLOT, L_OST = L_WS + 8 * 256, L_TAB = L_OST + 8 * 4096, L_ATT_END = L_TAB + 1024;
__device__ __forceinline__ void qkt2(f32x16& p0, f32x16& p1, const char* Kslot, const bf16x8* qr, const f32x16& c0, const f32x16& c1, int r32, int hi) {
  const char* kb = Kslot + hi * 1024 + r32 * 16;
  #pragma unroll
  for (int d0 = 0; d0 < 4; ++d0) {
    const bf16x8 b0 = *reinterpret_cast<const bf16x8*>(kb + d0 * 2048);
    const bf16x8 b1 = *reinterpret_cast<const bf16x8*>(kb + d0 * 2048 + 512);
    if (d0 == 0) { p0 = __builtin_amdgcn_mfma_f32_32x32x16_bf16(b0, qr[0], c0, 0, 0, 0); p1 = __builtin_amdgcn_mfma_f32_32x32x16_bf16(b1, qr[0], c1, 0, 0, 0); }
    else { p0 = __builtin_amdgcn_mfma_f32_32x32x16_bf16(b0, qr[d0], p0, 0, 0, 0); p1 = __builtin_amdgcn_mfma_f32_32x32x16_bf16(b1, qr[d0], p1, 0, 0, 0); } }
}
template <int MODE> __device__ __forceinline__ void attn_unit(const bf16* Qp, const bf16* __restrict__ Kp, const bf16* __restrict__ Vp, int q0, bf16* Ob, long ostride,
                                                               float* lse, long lstride, const float* __restrict__ F2, const float* __restrict__ tabg, char* shm) {
  const int tid = threadIdx.x, lane = tid & 63, r32 = lane & 31, hi = lane >> 5; const int wid = __builtin_amdgcn_readfirstlane(tid >> 6);
  const unsigned lds0 = (unsigned)(uintptr_t)shm;
  float* wsf = (float*)(shm + L_WS) + wid * 64;
  const int tq = q0 >> 6, t_hi = tq + 4;
  const int t_lo = (MODE == 0) ? (tq >= 2 ? tq - 2 : 0) : 0;
  const int w_hi = tq + (wid >> 1);
  const int w_lo = (MODE == 0) ? (w_hi >= 2 ? w_hi - 2 : 0) : 0;
  const bf16* ksrc = Kp + (long)lane * 64 + wid * 8;
  const bf16* vsrc = Vp + (long)(16 * (wid & 3) + (lane >> 2)) * 64 + (wid >> 2) * 32 + (lane & 3) * 8;
  const unsigned kdst = lds0 + L_K + wid * 1024, vdst = lds0 + L_V + wid * 1024;
  #define DMA_KV(t, slot) do { glds16(ksrc + (long)(t) * 4096, (unsigned)__builtin_amdgcn_readfirstlane(kdst + (slot) * KSLOT)); glds16(vsrc + (long)(t) * 4096, (unsigned)__builtin_amdgcn_readfirstlane(vdst + (slot) * KSLOT)); } while (0)
  if (MODE == 0) { float* tab = (float*)(shm + L_TAB); if (tid < 129) tab[tid] = tabg[tid]; }
  const int qi = q0 + wid * 32 + r32;
  f32x4 fk[8];
  #pragma unroll
  for (int g4 = 0; g4 < 8; ++g4) fk[g4] = (f32x4){0.f, 0.f, 0.f, 0.f};
  float Fq = 0.f;
  if (MODE == 1) { Fq = F2[qi];
    #pragma unroll
    for (int g4 = 0; g4 < 4; ++g4) { fk[g4] = *(const f32x4*)(F2 + 64 * t_lo + 4 * hi + 8 * g4); fk[4 + g4] = *(const f32x4*)(F2 + 64 * t_lo + 32 + 4 * hi + 8 * g4); } }
  bf16x8 qr[4];
  { const bf16* Qw = Qp + (long)(q0 + wid * 32) * 64;
    #pragma unroll
    for (int d0 = 0; d0 < 4; ++d0) qr[d0] = *reinterpret_cast<const bf16x8*>(&Qw[(long)r32 * 64 + d0 * 16 + hi * 8]); }
  DMA_KV(t_lo, 0);
  float m_run = -INFINITY, l_run = 0.f; f32x16 o[2]; o[0] = f32x16{}; o[1] = f32x16{};
  const int vb0 = (int)(lds0 + L_V) + ((lane >> 4) & 1) * 32 + (lane & 3) * 8 + (4 * hi + ((lane & 15) >> 2)) * 64;
  for (int t = t_lo; t < t_hi; ++t) {
    const int s = (t - t_lo) & 1;
    asm volatile("s_waitcnt vmcnt(0) lgkmcnt(0)\n\ts_barrier" ::: "memory");
    f32x4 fn[8];
    #pragma unroll
    for (int g4 = 0; g4 < 8; ++g4) fn[g4] = fk[g4];
    if (t + 1 < t_hi) {
      if (MODE == 1) {
        #pragma unroll
        for (int g4 = 0; g4 < 4; ++g4) { fn[g4] = *(const f32x4*)(F2 + 64 * (t + 1) + 4 * hi + 8 * g4); fn[4 + g4] = *(const f32x4*)(F2 + 64 * (t + 1) + 32 + 4 * hi + 8 * g4); } }
      DMA_KV(t + 1, s ^ 1);
    }
    if (t >= w_lo && t <= w_hi) {
      f32x16 c0, c1, p0, p1;
      if (MODE == 1) {
        #pragma unroll
        for (int r = 0; r < 16; ++r) { c0[r] = Fq - fk[r >> 2][r & 3]; c1[r] = Fq - fk[4 + (r >> 2)][r & 3]; }
      } else {
        const float* tab = (const float*)(shm + L_TAB);
        #pragma unroll
        for (int r = 0; r < 16; ++r) { const int d0_ = qi - (64 * t + crow(r, hi)), d1_ = d0_ - 32;
          c0[r] = tab[d0_ < 0 ? 0 : (d0_ > 128 ? 128 : d0_)]; c1[r] = tab[d1_ < 0 ? 0 : (d1_ > 128 ? 128 : d1_)]; }
      }
      qkt2(p0, p1, shm + L_K + s * KSLOT, qr, c0, c1, r32, hi);
      if (MODE == 1) {
        if (t == w_hi) {
          #pragma unroll
          for (int r = 0; r < 16; ++r) { const int kv = 64 * t + crow(r, hi); if (kv > qi) p0[r] = -INFINITY; if (kv + 32 > qi) p1[r] = -INFINITY; } }
      } else {
        #pragma unroll
        for (int r = 0; r < 16; ++r) { const int d0_ = qi - (64 * t + crow(r, hi)), d1_ = d0_ - 32;
          if ((unsigned)d0_ > 128u) p0[r] = -INFINITY; if ((unsigned)d1_ > 128u) p1[r] = -INFINITY; }
      }
      const float rm = rowmax(p0, p1), mnew = fmaxf(m_run, rm), msub = (mnew == -INFINITY) ? 0.f : mnew;
      const float f = __builtin_amdgcn_exp2f(m_run - msub);
      m_run = mnew;
      float sacc = 0.f;
      #pragma unroll
      for (int r = 0; r < 16; ++r) { p0[r] = __builtin_amdgcn_exp2f(p0[r] - msub); p1[r] = __builtin_amdgcn_exp2f(p1[r] - msub); sacc += p0[r] + p1[r]; }
      l_run = l_run * f + sacc;
      if (__any(f != 1.f)) {
        if (hi == 0) wsf[r32] = f;
        asm volatile("s_waitcnt lgkmcnt(0)" ::: "memory");
        #pragma unroll
        for (int r = 0; r < 16; ++r) { const float ff = wsf[crow(r, hi)]; o[0][r] *= ff; o[1][r] *= ff; }
      }
      u32x4 pw0, pw1, pw2, pw3;
      pw0 = (u32x4){cvtpk_s(p0[0], p0[1]), cvtpk_s(p0[2], p0[3]), cvtpk_s(p0[4], p0[5]), cvtpk_s(p0[6], p0[7])};
      pw1 = (u32x4){cvtpk_s(p0[8], p0[9]), cvtpk_s(p0[10], p0[11]), cvtpk_s(p0[12], p0[13]), cvtpk_s(p0[14], p0[15])};
      pw2 = (u32x4){cvtpk_s(p1[0], p1[1]), cvtpk_s(p1[2], p1[3]), cvtpk_s(p1[4], p1[5]), cvtpk_s(p1[6], p1[7])};
      pw3 = (u32x4){cvtpk_s(p1[8], p1[9]), cvtpk_s(p1[10], p1[11]), cvtpk_s(p1[12], p1[13]), cvtpk_s(p1[14], p1[15])};
      SBAR();
      pv(o, vb0 + s * KSLOT, __builtin_bit_cast(bf16x8, pw0), __builtin_bit_cast(bf16x8, pw1), __builtin_bit_cast(bf16x8, pw2), __builtin_bit_cast(bf16x8, pw3));
    }
    #pragma unroll
    for (int g4 = 0; g4 < 8; ++g4) fk[g4] = fn[g4];
  }
  { auto rr = __builtin_amdgcn_permlane32_swap(__float_as_uint(l_run), __float_as_uint(l_run), false, false); l_run = __uint_as_float(rr[0]) + __uint_as_float(rr[1]); }
  if (hi == 0) { wsf[32 + r32] = l_run; if (MODE == 0) lse[(long)qi * lstride] = m_run + __builtin_amdgcn_logf(l_run); }
  asm volatile("s_waitcnt lgkmcnt(0)" ::: "memory");
  float rli[16];
  #pragma unroll
  for (int r = 0; r < 16; ++r) rli[r] = __builtin_amdgcn_rcpf(wsf[32 + crow(r, hi)]);
  { bf16* stg = (bf16*)(shm + L_OST) + wid * 2048;
    #pragma unroll
    for (int r = 0; r < 16; ++r) { const int orow = crow(r, hi);
      #pragma unroll
      for (int d0 = 0; d0 < 2; ++d0) stg[orow * 64 + d0 * 32 + r32] = __float2bfloat16(o[d0][r] * rli[r]); }
    asm volatile("s_waitcnt lgkmcnt(0)" ::: "memory");
    bf16* Ow = Ob + (long)(q0 + wid * 32) * ostride;
    #pragma unroll
    for (int i = 0; i < 4; ++i) { const int row = i * 8 + (lane >> 3), ch = lane & 7; const u32x4 v = *(const u32x4*)(stg + row * 64 + ch * 8); *(u32x4*)(Ow + (long)row * ostride + ch * 8) = v; } }
  asm volatile("s_waitcnt lgkmcnt(0)\n\ts_barrier" ::: "memory");
  #undef DMA_KV
}
#undef SBAR
#undef WAIT_BAR
}

namespace attn_body {
constexpr int NSLOT = 3, SLOTB = 8192;
constexpr int T_K = 0, T_V = NSLOT * SLOTB, T_WS = 2 * NSLOT * SLOTB, T_OST = T_WS + 8 * 256, T_END = T_OST + 8 * 4096;
constexpr int T_F = 90112;
__device__ __forceinline__ void glds16s(unsigned voff,const void*sbase,unsigned lds_dst){unsigned keep;
  asm volatile("s_mov_b32 %0, m0\n\ts_mov_b32 m0, %3\n\ts_nop 0\n\tglobal_load_lds_dwordx4 %1, %2\n\ts_mov_b32 m0, %0":"=&s"(keep):"v"(voff),"s"(sbase),"s"(lds_dst):"memory");}
#define SBAR() __builtin_amdgcn_sched_barrier(0)
#define WAIT_BAR(N) asm volatile("s_waitcnt vmcnt(" #N ") lgkmcnt(0)\n\ts_barrier":::"memory")
template<int MODE, int THRL> __device__ __forceinline__ void attn_unit_t(const bf16* Qw0, const bf16* __restrict__ Kb, const bf16* __restrict__ Vb, const int NT, const int qoff,
                                                                         bf16* Ob, long ostride, float* lse, long lstride, char* shm) {
  const int tid=threadIdx.x,lane=tid&63,r32=lane&31,hi=lane>>5; const int wid=__builtin_amdgcn_readfirstlane(tid>>6);
  const unsigned lds0=(unsigned)(uintptr_t)shm;
  float*wsf=(float*)(shm+T_WS)+wid*64;
  typedef __attribute__((address_space(3))) const float* lds_f;
  const lds_f Fl=(lds_f)(shm+T_F)+((MODE==1)?qoff:0);
  const unsigned koff_=(unsigned)(lane*128+wid*16), voff_=(unsigned)((16*(wid&3)+(lane>>2))*128+(wid>>2)*64+(lane&3)*16);
  #define KOFF() koff_
  #define VOFF() voff_
  const unsigned kdst=lds0+T_K+wid*1024, vdst=lds0+T_V+wid*1024;
  #define DMA_K(t,slot) glds16s(KOFF(),(const char*)Kb+(long)(t)*8192,(unsigned)__builtin_amdgcn_readfirstlane(kdst+(slot)))
  #define DMA_V(t,slot) glds16s(VOFF(),(const char*)Vb+(long)(t)*8192,(unsigned)__builtin_amdgcn_readfirstlane(vdst+(slot)))
  const char*Kbase=shm+T_K; bf16x8 kf[8];
  const lds_cptr shm3=(lds_cptr)shm; const lds_cptr kp0=shm3+T_K+hi*1024+r32*16; const lds_cptr vp0=shm3+T_V+((lane>>4)&1)*32+(lane&3)*8+(4*hi+((lane&15)>>2))*64;
  DMA_K(0,0);DMA_V(0,0);DMA_K(1,SLOTB);
  bf16x8 qr[4];
  { const bf16*Qw=Qw0+(long)(wid*32)*64;
    #pragma unroll
    for(int d0=0;d0<4;++d0)qr[d0]=*reinterpret_cast<const bf16x8*>(&Qw[(long)r32*64+d0*16+hi*8]); }
  float mhat=0.f,l_reg=0.f;f32x16 o[2];o[0]=f32x16{};o[1]=f32x16{};
  const int qrel=wid*32+r32;
  const int qpos=(MODE>=1)?(64*(NT-4)+qrel):(qoff+qrel);
  #define FQ() ((MODE==1)?Fl[64*(NT-4)+wid*32+r32]:0.f)
  const int jb0=384-qpos+4*hi;
  #define CINIT(C0,C1,t,MASKED) do{ \
    if(MODE==2){ _Pragma("unroll") for(int r=0;r<16;++r){ C0[r]=-mhat; C1[r]=-mhat; } \
      if(MASKED){ const int jb_=(t)-(NT-4); if(jb_>=0){ const int kb_=64*jb_+4*hi; \
        _Pragma("unroll") for(int r=0;r<16;++r){ const int kv_=kb_+(r&3)+8*(r>>2); if(kv_>qrel)C0[r]=-INFINITY; if(kv_+32>qrel)C1[r]=-INFINITY; } } } \
    } else if(MODE==1){ const float fqm=FQ()-mhat; const lds_f fp_=Fl+64*(t)+4*hi; \
      _Pragma("unroll") for(int g4=0;g4<4;++g4){ const f32x4 a_=*(const __attribute__((address_space(3))) f32x4*)(fp_+8*g4), b_=*(const __attribute__((address_space(3))) f32x4*)(fp_+32+8*g4); \
        _Pragma("unroll") for(int i_=0;i_<4;++i_){ C0[4*g4+i_]=fqm-a_[i_]; C1[4*g4+i_]=fqm-b_[i_]; } } \
      if(MASKED){ const int jb_=(t)-(NT-4); if(jb_>=0){ const int kb_=64*jb_+4*hi; \
        _Pragma("unroll") for(int r=0;r<16;++r){ const int kv_=kb_+(r&3)+8*(r>>2); if(kv_>qrel)C0[r]=-INFINITY; if(kv_+32>qrel)C1[r]=-INFINITY; } } } \
    } else { const lds_f tp_=Fl+jb0+64*(t); \
      _Pragma("unroll") for(int r=0;r<16;++r){ C0[r]=tp_[(r&3)+8*(r>>2)]-mhat; C1[r]=tp_[32+(r&3)+8*(r>>2)]-mhat; } } \
  }while(0)
  bool resc=false;
  #define START(P0,P1) do{ const float rm=rowmax(P0,P1); resc=false; \
    { const float dl=(rm==-INFINITY)?0.f:rm; mhat=fadd_s(mhat,dl); \
      _Pragma("unroll") for(int r=0;r<16;++r){P0[r]=fsub_s(P0[r],dl);P1[r]=fsub_s(P1[r],dl);} } \
    _Pragma("unroll") for(int r=0;r<16;++r)P0[r]=__builtin_amdgcn_exp2f(P0[r]); }while(0)
  #define RESC() do{ if(resc){ asm volatile("s_waitcnt lgkmcnt(0)":::"memory"); \
      _Pragma("unroll") for(int d_=0;d_<2;++d_) _Pragma("unroll") for(int r=0;r<16;++r)o[d_][r]*=wsf[crow(r,hi)]; } }while(0)
  f32x16 pA0,pA1,pB0,pB1;
  int sl_prev=0,sl_cur=0,sl_next=SLOTB;
  #define ROT() do{sl_prev=sl_cur;sl_cur=sl_next;sl_next=(sl_next==(NSLOT-1)*SLOTB)?0:sl_next+SLOTB;}while(0)
  DMA_K(2,2*SLOTB);
  WAIT_BAR(3);
  CINIT(pA0,pA1,0,true);
  qkt2(pA0,pA1,Kbase,qr,pA0,pA1,r32,hi);asm volatile("s_nop 15\n\ts_nop 7":"+v"(pA0),"+v"(pA1));
  START(pA0,pA1);
  _Pragma("unroll") for(int r=0;r<16;++r)pA1[r]=__builtin_amdgcn_exp2f(pA1[r]);
  WAIT_BAR(0);
  DMA_K(3,0);DMA_V(1,SLOTB);
  ROT();
  kload8(kf,kp0+sl_cur);
  WAIT_BAR(2);
  s16x4 vlo[8],vhi[8]; u32x4 pw0,pw1,pw2,pw3;
  #define PKW(P,B) cvtpk_s(P[B],P[B+1])
  #define PAF(k) __builtin_bit_cast(bf16x8,pw##k)
  #define VFR(i) (bf16x8){vlo[i][0],vlo[i][1],vlo[i][2],vlo[i][3],vhi[i][0],vhi[i][1],vhi[i][2],vhi[i][3]}
  #define PIN(x) asm volatile("":"+v"(x))
  #define MX3(a,b,c) __builtin_fmaxf(__builtin_fmaxf((a),(b)),(c))
  #define GAPA(MF,A0,A1,A2,A3,W0,W1,PW) do{ MF; sacc+=A0; sacc+=A1; sacc+=A2; sacc+=A3; PIN(sacc); W0; W1; PIN(PW); SBAR(); }while(0)
  #define EX(v) __builtin_amdgcn_exp2f(v)
  #define GAPB(MF,X,B) do{ MF; X[B]=EX(X[B]); X[B+1]=EX(X[B+1]); X[B+2]=EX(X[B+2]); X[B+3]=EX(X[B+3]); PIN(X); SBAR(); }while(0)
  #define VRD(i) do{ vlo[i]=vtr(vp_+(((i)>>2)*4096+((i)&3)*1024)); vhi[i]=vtr(vp_+(((i)>>2)*4096+((i)&3)*1024+512)); }while(0)
  #define KRD(G,j) do{ if(G){ kload2(kf,kp0+sl_next,j); SBAR(); } }while(0)
  #define STEP(C0,C1,P0,P1,t,GK,GV,GL,MASKED) do{ SBAR(); \
    CINIT(C0,C1,t,MASKED); \
    const lds_cptr vp_=vp0+sl_prev; \
    VRD(0); SBAR(); float sacc=(P0[0]+P0[1]); \
    GAPA(C0=__builtin_amdgcn_mfma_f32_32x32x16_bf16(kf[0],qr[0],C0,0,0,0), P0[2],P0[3],P0[4],P0[5],     pw0[0]=PKW(P0,0), pw0[1]=PKW(P0,2), pw0); \
    VRD(4); SBAR(); GAPA(C1=__builtin_amdgcn_mfma_f32_32x32x16_bf16(kf[1],qr[0],C1,0,0,0), P0[6],P0[7],P0[8],P0[9],     pw0[2]=PKW(P0,4), pw0[3]=PKW(P0,6), pw0); \
    VRD(1); SBAR(); GAPA(C0=__builtin_amdgcn_mfma_f32_32x32x16_bf16(kf[2],qr[1],C0,0,0,0),   P0[10],P0[11],P0[12],P0[13], pw1[0]=PKW(P0,8), pw1[1]=PKW(P0,10), pw1); \
    VRD(5); SBAR(); GAPA(C1=__builtin_amdgcn_mfma_f32_32x32x16_bf16(kf[3],qr[1],C1,0,0,0),   P0[14],P0[15],P1[0],P1[1],   pw1[2]=PKW(P0,12),pw1[3]=PKW(P0,14), pw1); \
    VRD(2); SBAR(); GAPA(C0=__builtin_amdgcn_mfma_f32_32x32x16_bf16(kf[4],qr[2],C0,0,0,0),   P1[2],P1[3],P1[4],P1[5],     pw2[0]=PKW(P1,0), pw2[1]=PKW(P1,2), pw2); \
    VRD(6); SBAR(); GAPA(C1=__builtin_amdgcn_mfma_f32_32x32x16_bf16(kf[5],qr[2],C1,0,0,0),   P1[6],P1[7],P1[8],P1[9],     pw2[2]=PKW(P1,4), pw2[3]=PKW(P1,6), pw2); \
    VRD(3); SBAR(); GAPA(C0=__builtin_amdgcn_mfma_f32_32x32x16_bf16(kf[6],qr[3],C0,0,0,0),   P1[10],P1[11],P1[12],P1[13], pw3[0]=PKW(P1,8), pw3[1]=PKW(P1,10), pw3); \
    VRD(7); SBAR(); GAPA(C1=__builtin_amdgcn_mfma_f32_32x32x16_bf16(kf[7],qr[3],C1,0,0,0),   P1[14],P1[15],0.f,0.f,       pw3[2]=PKW(P1,12),pw3[3]=PKW(P1,14), pw3); \
    l_reg+=sacc; \
    if(GK){DMA_K((t)+3,sl_cur);} if(GV){DMA_V((t)+1,sl_next);} \
    { float a=MX3(C0[0],C0[1],C1[0]),b=MX3(C0[2],C0[3],C1[1]); a=MX3(a,C1[2],C1[3]); \
      _Pragma("unroll") for(int r=4;r<16;r+=4){a=MX3(a,C0[r],C0[r+1]);b=MX3(b,C0[r+2],C0[r+3]);a=MX3(a,C1[r],C1[r+1]);b=MX3(b,C1[r+2],C1[r+3]);} \
      float rm=__builtin_fmaxf(a,b); { auto rr=__builtin_amdgcn_permlane32_swap(__float_as_uint(rm),__float_as_uint(rm),false,false); rm=__builtin_fmaxf(__uint_as_float(rr[0]),__uint_as_float(rr[1])); } \
      resc=false; \
      if(__builtin_expect(__any(rm>(float)THRL),0)){ const float dl=__builtin_fmaxf(rm,0.f); mhat+=dl; \
        _Pragma("unroll") for(int r=0;r<16;++r){C0[r]-=dl;C1[r]-=dl;} \
        const float f=__builtin_amdgcn_exp2f(-dl); l_reg*=f; if(hi==0)wsf[r32]=f; resc=true; } } \
    SBAR(); \
    GAPB(o[0]=__builtin_amdgcn_mfma_f32_32x32x16_bf16(PAF(0),VFR(0),o[0],0,0,0), C0,0); \
    GAPB(o[1]=__builtin_amdgcn_mfma_f32_32x32x16_bf16(PAF(0),VFR(4),o[1],0,0,0), C0,4); \
    KRD(GL,0); GAPB(o[0]=__builtin_amdgcn_mfma_f32_32x32x16_bf16(PAF(1),VFR(1),o[0],0,0,0), C0,8); \
    KRD(GL,1); GAPB(o[1]=__builtin_amdgcn_mfma_f32_32x32x16_bf16(PAF(1),VFR(5),o[1],0,0,0), C0,12); \
    KRD(GL,2); GAPB(o[0]=__builtin_amdgcn_mfma_f32_32x32x16_bf16(PAF(2),VFR(2),o[0],0,0,0), C1,0); \
    KRD(GL,3); GAPB(o[1]=__builtin_amdgcn_mfma_f32_32x32x16_bf16(PAF(2),VFR(6),o[1],0,0,0), C1,4); \
    GAPB(o[0]=__builtin_amdgcn_mfma_f32_32x32x16_bf16(PAF(3),VFR(3),o[0],0,0,0), C1,8); \
    GAPB(o[1]=__builtin_amdgcn_mfma_f32_32x32x16_bf16(PAF(3),VFR(7),o[1],0,0,0), C1,12); \
    }while(0)
  int t=1;
  for(;t+5<NT;t+=2){
    STEP(pB0,pB1,pA0,pA1,t,true,true,true,false);     WAIT_BAR(2); RESC(); ROT();
    STEP(pA0,pA1,pB0,pB1,t+1,true,true,true,false);   WAIT_BAR(2); RESC(); ROT();
  }
  #define ENDW(tt) do{ if((tt)+3<NT){WAIT_BAR(2);} else if((tt)+2<NT){WAIT_BAR(1);} else {WAIT_BAR(0);} }while(0)
  for(;t+1<NT;t+=2){
    STEP(pB0,pB1,pA0,pA1,t,(t+3<NT),(t+1<NT),(t+1<NT),true);       ENDW(t);   RESC(); ROT();
    STEP(pA0,pA1,pB0,pB1,t+1,(t+4<NT),(t+2<NT),(t+2<NT),true);     ENDW(t+1); RESC(); ROT();
  }
  STEP(pB0,pB1,pA0,pA1,NT-1,false,false,false,true); RESC();
  { float sacc=pB0[0]+pB0[1]; _Pragma("unroll") for(int r=2;r<16;++r)sacc+=pB0[r]; _Pragma("unroll") for(int r=0;r<16;++r)sacc+=pB1[r]; l_reg+=sacc;
    pw0=(u32x4){PKW(pB0,0),PKW(pB0,2),PKW(pB0,4),PKW(pB0,6)};pw1=(u32x4){PKW(pB0,8),PKW(pB0,10),PKW(pB0,12),PKW(pB0,14)};pw2=(u32x4){PKW(pB1,0),PKW(pB1,2),PKW(pB1,4),PKW(pB1,6)};pw3=(u32x4){PKW(pB1,8),PKW(pB1,10),PKW(pB1,12),PKW(pB1,14)};
    int ln_=lane; asm volatile("":"+v"(ln_)); const int hi_=ln_>>5; const int vb0=(int)(lds0+T_V)+((ln_>>4)&1)*32+(ln_&3)*8+(4*hi_+((ln_&15)>>2))*64;
    SBAR(); pv(o,vb0+sl_cur,PAF(0),PAF(1),PAF(2),PAF(3)); }
  #undef PKW
  #undef PAF
  #undef VFR
  #undef PIN
  #undef MX3
  #undef GAPA
  #undef GAPB
  #undef EX
  #undef VRD
  #undef KRD
  #undef STEP
  #undef ENDW
  #undef CINIT
  {auto rr=__builtin_amdgcn_permlane32_swap(__float_as_uint(l_reg),__float_as_uint(l_reg),false,false);l_reg=__uint_as_float(rr[0])+__uint_as_float(rr[1]);}
  int r32e=r32,hie=hi; asm volatile("":"+v"(r32e),"+v"(hie));
  if(hie==0){ wsf[32+r32e]=l_reg; if(MODE==0) lse[(long)(wid*32+r32e)*lstride]=mhat+__builtin_amdgcn_logf(l_reg); }
  asm volatile("s_waitcnt lgkmcnt(0)":::"memory");
  float rli[16];
  #pragma unroll
  for(int r=0;r<16;++r)rli[r]=__builtin_amdgcn_rcpf(wsf[32+crow(r,hie)]);
  { bf16*stg=(bf16*)(shm+T_OST)+wid*2048;
    #pragma unroll
    for(int r=0;r<16;++r){const int orow=crow(r,hie);
      #pragma unroll
      for(int d0=0;d0<2;++d0)stg[orow*64+d0*32+r32e]=__float2bfloat16(o[d0][r]*rli[r]);}
    asm volatile("s_waitcnt lgkmcnt(0)":::"memory");
    bf16*Ow=Ob+(long)(wid*32)*ostride;
    int le_=lane; asm volatile("":"+v"(le_));
    #pragma unroll
    for(int i=0;i<4;++i){const int row=i*8+(le_>>3),ch=le_&7; const u32x4 v=*(const u32x4*)(stg+row*64+ch*8);
      if(WO_FP8&&MODE==1){ typedef unsigned u32x2o __attribute__((ext_vector_type(2))); u32x2o w8;
        w8.x=pg8::pk4_fp8(__uint_as_float(v.x<<16),__uint_as_float(v.x&0xffff0000u),__uint_as_float(v.y<<16),__uint_as_float(v.y&0xffff0000u));
        w8.y=pg8::pk4_fp8(__uint_as_float(v.z<<16),__uint_as_float(v.z&0xffff0000u),__uint_as_float(v.w<<16),__uint_as_float(v.w&0xffff0000u));
        *(u32x2o*)((unsigned char*)Ob+(long)(wid*32+row)*ostride+ch*8)=w8; }
      else *(u32x4*)(Ow+(long)row*ostride+ch*8)=v;} }
  asm volatile("s_waitcnt lgkmcnt(0)\n\ts_barrier":::"memory");
  #undef DMA_K
  #undef DMA_V
  #undef KOFF
  #undef FQ
  #undef VOFF
  #undef START
  #undef RESC
  #undef ROT
}
#undef SBAR
#undef WAIT_BAR
}

namespace attn_body {
constexpr int B_V = 0, B_VBUF = 49152, B_K = B_VBUF, B_WS = 2 * B_VBUF, B_OST = B_WS + 2048, B_TAB = B_OST + 32768, B_END = B_TAB + 2 * 1024;
struct BandUnit { const bf16* Q; const bf16* K; const bf16* V; bf16* O; float* L; const float* tab; int q0; int sh; };
__device__ __forceinline__ void band_decode(int L, BandUnit& u, const bf16* QKV, bf16* OG, float* LSE, const float* BT) {
    const int tri = L >> 4, u16 = L & 15, b = tri / 48, gh = tri % 48, g = gh >> 4, h = gh & 15;
    const int sh = 2 * g, Ls = 4096 >> sh;
    const int r = (g == 0) ? 0 : (g == 1 ? (u16 >> 2) : u16), uq = (g == 0) ? u16 : (g == 1 ? (u16 & 3) : 0);
    const size_t pl = (size_t)((b * 3 + g) * 3) * 16 + h;
    u.Q = QKV + (pl * 4096 + (size_t)r * Ls) * 64; u.K = u.Q + (size_t)16 * 4096 * 64; u.V = u.Q + (size_t)32 * 4096 * 64;
    const size_t tok0 = (size_t)b * 4096 + r;
    u.O = OG + ((size_t)g * 32768 + tok0) * 1024 + h * 64; u.L = LSE + ((size_t)g * 32768 + tok0) * 16 + h;
    u.tab = BT + gh * 132; u.q0 = uq * 256; u.sh = sh;
}
__device__ __forceinline__ void band_issue_v(const BandUnit& u, unsigned lds0, int lane, int wid) {
    const unsigned voff = (unsigned)((16 * (wid & 3) + (lane >> 2)) * 128 + (wid >> 2) * 64 + (lane & 3) * 16);
    const int w0 = u.q0 - 128;
    #pragma unroll
    for (int t = 0; t < 6; ++t) { const int k0 = w0 + 64 * t;
        if (k0 >= 0) glds16s(voff, (const char*)u.V + (long)k0 * 128, (unsigned)__builtin_amdgcn_readfirstlane(lds0 + B_V + t * 8192 + wid * 1024)); }
}
__device__ __forceinline__ void band_issue_k(const BandUnit& u, int tbuf, unsigned lds0, int tid, int lane, int wid) {
    const unsigned koff = (unsigned)(lane * 128 + wid * 16);
    const int w0 = u.q0 - 128;
    #pragma unroll
    for (int t = 0; t < 6; ++t) { const int k0 = w0 + 64 * t;
        if (k0 >= 0) glds16s(koff, (const char*)u.K + (long)k0 * 128, (unsigned)__builtin_amdgcn_readfirstlane(lds0 + B_K + t * 8192 + wid * 1024)); }
    if (tid < 192) { __attribute__((address_space(3))) float* tb = (__attribute__((address_space(3))) float*)(uintptr_t)(lds0 + B_TAB + tbuf * 1024);
        tb[tid] = (tid >= 32 && tid <= 160) ? u.tab[tid - 32] : -INFINITY; }
}
template <int VAR> __device__ __forceinline__ void band_phase(const bf16* QKV, bf16* OG, float* LSE, const float* BT, int first, int step, int NU, char* shm) {
    const int tid = threadIdx.x, lane = tid & 63, r32 = lane & 31, hi = lane >> 5; const int wid = __builtin_amdgcn_readfirstlane(tid >> 6);
    const unsigned lds0 = (unsigned)(uintptr_t)shm;
    float* wsf = (float*)(shm + B_WS) + wid * 64;
    typedef __attribute__((address_space(3))) const float* lds_f;
    BandUnit cur, nxt;
    int L = first, buf = 0;
#define BAND_LOADQ(U) do { const bf16* Qw_ = (U).Q + (long)((U).q0 + 32 * wid) * 64; \
        _Pragma("unroll") for (int d0 = 0; d0 < 4; ++d0) qn[d0] = *reinterpret_cast<const bf16x8*>(&Qw_[(long)r32 * 64 + d0 * 16 + hi * 8]); } while (0)
    bf16x8 qn[4];
    #pragma unroll
    for (int d0 = 0; d0 < 4; ++d0) qn[d0] = (bf16x8){0, 0, 0, 0, 0, 0, 0, 0};
    if (L < NU) { band_decode(L, cur, QKV, OG, LSE, BT); band_issue_k(cur, 0, lds0, tid, lane, wid); BAND_LOADQ(cur); }
    for (; L < NU; L += step, buf ^= 1) {
        const bool has_next = (L + step) < NU;
        if (has_next) band_decode(L + step, nxt, QKV, OG, LSE, BT); else nxt = cur;
        const int qw = cur.q0 + 32 * wid;
        const int jlo = (qw >= 128) ? 0 : ((128 - qw) >> 5);
        if (L == first) asm volatile("s_waitcnt vmcnt(0) lgkmcnt(0)\n\ts_barrier" ::: "memory");
        else asm volatile("s_waitcnt vmcnt(5) lgkmcnt(0)\n\ts_barrier" ::: "memory");
        bf16x8 qr[4];
        #pragma unroll
        for (int d0 = 0; d0 < 4; ++d0) qr[d0] = qn[d0];
        band_issue_v(cur, lds0, lane, wid);
        f32x16 S[5];
        { const lds_f tb = (lds_f)(uintptr_t)(lds0 + B_TAB + buf * 1024) + (5 + r32 - 4 * hi);
          #pragma unroll
          for (int j = 0; j < 5; ++j) {
              #pragma unroll
              for (int r = 0; r < 16; ++r) S[j][r] = (j >= jlo) ? tb[(128 - 32 * j) + 27 - ((r & 3) + 8 * (r >> 2))] : -INFINITY;
              if (j >= jlo) { const int wj = wid + j;
                  const __attribute__((address_space(3))) char* kp = (const __attribute__((address_space(3))) char*)(uintptr_t)(lds0 + B_K + (wj >> 1) * 8192 + hi * 1024 + ((wj & 1) * 32 + r32) * 16);
                  #pragma unroll
                  for (int d0 = 0; d0 < 4; ++d0) { const bf16x8 kf = *(const __attribute__((address_space(3))) bf16x8*)(kp + d0 * 2048);
                      S[j] = __builtin_amdgcn_mfma_f32_32x32x16_bf16(kf, qr[d0], S[j], 0, 0, 0); } } } }
        asm volatile("s_waitcnt vmcnt(0) lgkmcnt(0)\n\ts_barrier" ::: "memory");
        if (has_next) { band_issue_k(nxt, buf ^ 1, lds0, tid, lane, wid); BAND_LOADQ(nxt); }
        float mx = -INFINITY;
        #pragma unroll
        for (int j = 0; j < 5; ++j)
            #pragma unroll
            for (int r = 0; r < 16; ++r) mx = fmaxf(mx, S[j][r]);
        { auto rr = __builtin_amdgcn_permlane32_swap(__float_as_uint(mx), __float_as_uint(mx), false, false); mx = fmaxf(__uint_as_float(rr[0]), __uint_as_float(rr[1])); }
        float lsum = 0.f; u32x4 pw[5][2];
        #pragma unroll
        for (int j = 0; j < 5; ++j) {
            #pragma unroll
            for (int r = 0; r < 16; ++r) { S[j][r] = __builtin_amdgcn_exp2f(S[j][r] - mx); lsum += S[j][r]; }
            pw[j][0] = (u32x4){cvtpk_s(S[j][0], S[j][1]), cvtpk_s(S[j][2], S[j][3]), cvtpk_s(S[j][4], S[j][5]), cvtpk_s(S[j][6], S[j][7])};
            pw[j][1] = (u32x4){cvtpk_s(S[j][8], S[j][9]), cvtpk_s(S[j][10], S[j][11]), cvtpk_s(S[j][12], S[j][13]), cvtpk_s(S[j][14], S[j][15])}; }
        { auto rr = __builtin_amdgcn_permlane32_swap(__float_as_uint(lsum), __float_as_uint(lsum), false, false); lsum = __uint_as_float(rr[0]) + __uint_as_float(rr[1]); }
        f32x16 o[2]; o[0] = f32x16{}; o[1] = f32x16{};
        const int vlane = ((lane >> 4) & 1) * 32 + (lane & 3) * 8 + (4 * hi + ((lane & 15) >> 2)) * 64;
        #pragma unroll
        for (int j = 0; j < 5; ++j) if (j >= jlo) {
            const int wj = wid + j;
            const int vb = (int)(lds0 + B_V) + (wj >> 1) * 8192 + (wj & 1) * 2048 + vlane;
            s16x4 l0[2], h0[2], l1[2], h1[2];
            #pragma unroll
            for (int d0 = 0; d0 < 2; ++d0) {
                asm volatile("ds_read_b64_tr_b16 %0,%1 offset:%c2" : "=&v"(l0[d0]) : "v"(vb), "i"(d0 * 4096) : "memory");
                asm volatile("ds_read_b64_tr_b16 %0,%1 offset:%c2" : "=&v"(h0[d0]) : "v"(vb), "i"(d0 * 4096 + 512) : "memory");
                asm volatile("ds_read_b64_tr_b16 %0,%1 offset:%c2" : "=&v"(l1[d0]) : "v"(vb), "i"(d0 * 4096 + 1024) : "memory");
                asm volatile("ds_read_b64_tr_b16 %0,%1 offset:%c2" : "=&v"(h1[d0]) : "v"(vb), "i"(d0 * 4096 + 1536) : "memory"); }
            asm volatile("s_waitcnt lgkmcnt(0)" : "+v"(l0[0]), "+v"(h0[0]), "+v"(l1[0]), "+v"(h1[0]), "+v"(l0[1]), "+v"(h0[1]), "+v"(l1[1]), "+v"(h1[1]) :: "memory"); __builtin_amdgcn_sched_barrier(0);
            #pragma unroll
            for (int d0 = 0; d0 < 2; ++d0) {
                o[d0] = __builtin_amdgcn_mfma_f32_32x32x16_bf16(__builtin_bit_cast(bf16x8, pw[j][0]), (bf16x8){l0[d0][0], l0[d0][1], l0[d0][2], l0[d0][3], h0[d0][0], h0[d0][1], h0[d0][2], h0[d0][3]}, o[d0], 0, 0, 0);
                o[d0] = __builtin_amdgcn_mfma_f32_32x32x16_bf16(__builtin_bit_cast(bf16x8, pw[j][1]), (bf16x8){l1[d0][0], l1[d0][1], l1[d0][2], l1[d0][3], h1[d0][0], h1[d0][1], h1[d0][2], h1[d0][3]}, o[d0], 0, 0, 0); } }
        const long ostride = 1024L << cur.sh, lstride = 16L << cur.sh;
        if (hi == 0) { wsf[32 + r32] = lsum; cur.L[(long)(qw + r32) * lstride] = mx + __builtin_amdgcn_logf(lsum); }
        asm volatile("s_waitcnt lgkmcnt(0)" ::: "memory");
        float rli[16];
        #pragma unroll
        for (int r = 0; r < 16; ++r) rli[r] = __builtin_amdgcn_rcpf(wsf[32 + crow(r, hi)]);
        { bf16* stg = (bf16*)(shm + B_OST) + wid * 2048;
          #pragma unroll
          for (int r = 0; r < 16; ++r) { const int orow = crow(r, hi);
            #pragma unroll
            for (int d0 = 0; d0 < 2; ++d0) stg[orow * 64 + d0 * 32 + r32] = __float2bfloat16(o[d0][r] * rli[r]); }
          asm volatile("s_waitcnt lgkmcnt(0)" ::: "memory");
          bf16* Ow = cur.O + (long)qw * ostride;
          #pragma unroll
          for (int i = 0; i < 4; ++i) { const int row = i * 8 + (lane >> 3), ch = lane & 7; const u32x4 v = *(const u32x4*)(stg + row * 64 + ch * 8); *(u32x4*)(Ow + (long)row * ostride + ch * 8) = v; } }
        cur = nxt;
    }
    asm volatile("s_waitcnt vmcnt(0) lgkmcnt(0)\n\ts_barrier" ::: "memory");
#undef BAND_LOADQ
}
}
#define XB_TMO      128
#define XB_XCNT(j)  (256  + 64 * (j))
#define XB_XSUB(j)  (1280 + 64 * (j))
#define XB_XGEN(j)  (2304 + 64 * (j))
#define XB_TOP      3328
#define XB_TOPGEN   3392
#define XCD_BAR_WORDS 3456
#define XB_SPIN_CAP (1u << 18)

__device__ __forceinline__ unsigned xb_ld(unsigned* p)              { return __hip_atomic_load(p, __ATOMIC_RELAXED, __HIP_MEMORY_SCOPE_AGENT); }
__device__ __forceinline__ unsigned xb_add(unsigned* p, unsigned v) { return __hip_atomic_fetch_add(p, v, __ATOMIC_RELAXED, __HIP_MEMORY_SCOPE_AGENT); }
__device__ __forceinline__ unsigned xb_xcc_id() { return (unsigned)__builtin_amdgcn_s_getreg((3 << 11) | 20) & 0xFu; }
#define XB_SPIN(cond, bar) do { unsigned _sp = 0; while (cond) { __builtin_amdgcn_s_sleep(1); \
    if ((++_sp & 255u) == 0u) { if (xb_ld(&(bar)[XB_TMO])) break; if (_sp > XB_SPIN_CAP) { atomicAdd(&(bar)[XB_TMO], 1u); break; } } } } while (0)

struct XcdBarrier {
    unsigned* bar; unsigned x;
    volatile LAS unsigned* st;
};

__device__ __forceinline__ XcdBarrier xcd_barrier_post(unsigned* bar, volatile LAS unsigned* st) {
    XcdBarrier b; b.bar = bar; b.x = xb_xcc_id(); b.st = st;
    if (threadIdx.x == 0) (void)xb_add(&bar[XB_XCNT(b.x)], 1u);
    return b;
}
__device__ __forceinline__ void xcd_barrier_complete(unsigned* bar, unsigned x, unsigned& nloc, unsigned& nx) {
    const unsigned G = gridDim.x * gridDim.y * gridDim.z;
    unsigned sum, cnt, mine, sp = 0u;
    for (;;) {
        sum = 0u; cnt = 0u; mine = 0u;
#pragma unroll
        for (unsigned j = 0; j < 16; ++j) { const unsigned c = xb_ld(&bar[XB_XCNT(j)]); sum += c; cnt += (c > 0u) ? 1u : 0u; mine = (j == x) ? c : mine; }
        if (sum == G) break;
        __builtin_amdgcn_s_sleep(1);
        if ((++sp & 255u) == 0u) { if (xb_ld(&bar[XB_TMO])) break; if (sp > XB_SPIN_CAP) { atomicAdd(&bar[XB_TMO], 1u); break; } }
    }
    nloc = mine > 0u ? mine : 1u; nx = cnt > 0u ? cnt : 1u;
}

__device__ __forceinline__ void xcd_barrier(const XcdBarrier& b) {
    asm volatile("s_waitcnt vmcnt(0)" ::: "memory");
    __syncthreads();
    if (threadIdx.x == 0) {
        unsigned* bar = b.bar;
        __builtin_amdgcn_s_waitcnt(0);
        unsigned nloc = b.st[0], nx = b.st[1];
        if (nloc == 0u) { xcd_barrier_complete(bar, b.x, nloc, nx); b.st[0] = nloc; b.st[1] = nx; }
        const unsigned old = xb_add(&bar[XB_XSUB(b.x)], 1u);
        const unsigned gen = old / nloc;
        if (old + 1u == (gen + 1u) * nloc) {
            __builtin_amdgcn_fence(__ATOMIC_RELEASE, "agent");
            asm volatile("s_waitcnt vmcnt(0)" ::: "memory");
            const unsigned og = xb_add(&bar[XB_TOP], 1u);
            const unsigned tg = og / nx;
            if (og + 1u == (tg + 1u) * nx) xb_add(&bar[XB_TOPGEN], 1u);
            else XB_SPIN(xb_ld(&bar[XB_TOPGEN]) == tg, bar);
            __builtin_amdgcn_fence(__ATOMIC_ACQUIRE, "agent");
            xb_add(&bar[XB_XGEN(b.x)], 1u);
            asm volatile("s_waitcnt vmcnt(0)" ::: "memory");
        } else {
            XB_SPIN(xb_ld(&bar[XB_XGEN(b.x)]) == gen, bar);
            __builtin_amdgcn_fence(__ATOMIC_ACQUIRE, "agent");
            asm volatile("s_waitcnt vmcnt(0)" ::: "memory");
        }
    }
    __syncthreads();
}

struct Args { const float* in[21]; float* out; unsigned char* ws; int ph_lo, ph_hi; };
enum { IN_X = 0, IN_C, IN_ADAW, IN_ADAB, IN_NMIX, IN_NFFN, IN_AWQKV, IN_AWO, IN_RELB, IN_KVNG, IN_WKVF, IN_BF, IN_BWQ, IN_BWO, IN_RW, IN_RB, IN_WGU, IN_BGU, IN_WDN, IN_BDN, IN_FNG };

struct Ctx {
    LAS unsigned char* lds; unsigned char* ws; int tid, lane, wave, vcu, G;
};

__device__ __forceinline__ void transpose_item(const float* __restrict__ W, int pitch, int Kd, bf16* WT, int k0, int n0, int row_off, LAS float* scr, int lane) {
#pragma unroll
    for (int i = 0; i < 8; ++i) { const int kk = 8 * i + (lane >> 3), c4 = (lane & 7) * 4;
        const f32x4 v = *(const f32x4*)(W + (size_t)(k0 + kk) * pitch + n0 + c4);
        scr[kk * 33 + c4] = v[0]; scr[kk * 33 + c4 + 1] = v[1]; scr[kk * 33 + c4 + 2] = v[2]; scr[kk * 33 + c4 + 3] = v[3]; }
    LDS_WAIT(); asm volatile("" ::: "memory");
    const int c = lane & 7;
#pragma unroll
    for (int j = 0; j < 4; ++j) { const int n = (lane >> 3) + 8 * j; const LAS float* s = scr + (8 * c) * 33 + n;
        u32x4v o; o.x = pkbf(s[0 * 33], s[1 * 33]); o.y = pkbf(s[2 * 33], s[3 * 33]); o.z = pkbf(s[4 * 33], s[5 * 33]); o.w = pkbf(s[6 * 33], s[7 * 33]);
        *(u32x4v*)(WT + (size_t)(row_off + n0 + n) * Kd + k0 + 8 * c) = o; }
    LDS_WAIT(); asm volatile("" ::: "memory");
}

__device__ __forceinline__ void transpose_item8(const float* __restrict__ W, int pitch, int Kd, unsigned char* WT, int k0, int n0, int row_off, LAS float* scr, int lane) {
#pragma unroll
    for (int i = 0; i < 8; ++i) { const int kk = 8 * i + (lane >> 3), c4 = (lane & 7) * 4;
        const f32x4 v = *(const f32x4*)(W + (size_t)(k0 + kk) * pitch + n0 + c4) * 64.f;
        scr[kk * 33 + c4] = v[0]; scr[kk * 33 + c4 + 1] = v[1]; scr[kk * 33 + c4 + 2] = v[2]; scr[kk * 33 + c4 + 3] = v[3]; }
    LDS_WAIT(); asm volatile("" ::: "memory");
    const int c = lane & 7;
#pragma unroll
    for (int j = 0; j < 4; ++j) { const int n = (lane >> 3) + 8 * j; const LAS float* s = scr + (8 * c) * 33 + n;
        u32x2v o; o.x = pg8::pk4_fp8(s[0 * 33], s[1 * 33], s[2 * 33], s[3 * 33]); o.y = pg8::pk4_fp8(s[4 * 33], s[5 * 33], s[6 * 33], s[7 * 33]);
        *(u32x2v*)(WT + (size_t)(row_off + n0 + n) * Kd + k0 + 8 * c) = o; }
    LDS_WAIT(); asm volatile("" ::: "memory");
}

__device__ __forceinline__ void p0_prologue(const Ctx& C, const Args& a) {
    LAS float* scr = (LAS float*)(C.lds + RING_OFF + C.wave * 8704);
    const int gw = C.vcu * NWAVES + C.wave, NGW = C.G * NWAVES;
    constexpr int I_QKV = 16 * 288, I_SQ = 16 * 32, I_KV = 16 * 64, I_GU1 = 16 * 64, I_DN1 = 16 * 32;
    constexpr int O_WO0 = I_QKV, O_KV = O_WO0 + I_SQ, O_WQ = O_KV + I_KV, O_WO1 = O_WQ + I_SQ, O_GU = O_WO1 + I_SQ, O_DN = O_GU + 64 * I_GU1, NITEMS = O_DN + 64 * I_DN1;
    static_assert(QKV_FP8 && KVQ_FP8 && WO_FP8, "the pipelined prologue converts every weight to fp8");
    struct Item { const float* W; unsigned char* WT; int pitch, k0, n0, row_off; };
    auto decode = [&](int it, Item& I) {
        if (it < O_WO0) { const int r = it, kb = r / 288, nb = r % 288; I = {a.in[IN_AWQKV], (unsigned char*)(C.ws + WS_WQKV), NQKV, 64 * kb, 32 * nb, 0}; }
        else if (it < O_KV) { const int r = it - O_WO0, kb = r / 32, nb = r % 32; I = {a.in[IN_AWO], (unsigned char*)(C.ws + WS_WO0), D, 64 * kb, 32 * nb, 0}; }
        else if (it < O_WQ) { const int r = it - O_KV, kb = r / 64, nb = r % 64; I = {a.in[IN_WKVF], (unsigned char*)(C.ws + WS_WKV), 2064, 64 * kb, 32 * nb, 0}; }
        else if (it < O_WO1) { const int r = it - O_WQ, kb = r / 32, nb = r % 32; I = {a.in[IN_BWQ], (unsigned char*)(C.ws + WS_WKV) + (size_t)2048 * D, D, 64 * kb, 32 * nb, 0}; }
        else if (it < O_GU) { const int r = it - O_WO1, kb = r / 32, nb = r % 32; I = {a.in[IN_BWO], (unsigned char*)(C.ws + WS_WO1), D, 64 * kb, 32 * nb, 0}; }
        else if (it < O_DN) { const int r = it - O_GU, mat = r / I_GU1, q = r % I_GU1, kb = q / 64, nb = q % 64;
            const int n0 = 32 * nb, which = n0 >> 10, j0 = n0 & 1023, drow0 = (j0 >> 7) * 256 + which * 128 + (j0 & 127);
            I = {a.in[IN_WGU] + (size_t)mat * D * 2048, (unsigned char*)(C.ws + WS_WGU) + (size_t)mat * 2048 * D, 2048, 64 * kb, n0, drow0 - n0}; }
        else { const int r = it - O_DN, mat = r / I_DN1, q = r % I_DN1, kb = q / 32, nb = q % 32;
            I = {a.in[IN_WDN] + (size_t)mat * D * D, (unsigned char*)(C.ws + WS_WDN) + (size_t)mat * D * D, D, 64 * kb, 32 * nb, 0}; }
    };
    const int lr = C.lane >> 3, c4 = (C.lane & 7) * 4;
#define P0_LOAD(V, I) do { _Pragma("unroll") for (int i = 0; i < 8; ++i) V[i] = *(const f32x4*)((I).W + (size_t)((I).k0 + 8 * i + lr) * (I).pitch + (I).n0 + c4); } while (0)
    f32x4 vc[8], vn[8]; Item Ic, In;
    if (gw < NITEMS) { decode(gw, Ic); P0_LOAD(vc, Ic); }
    for (int it = gw; it < NITEMS; it += NGW) {
        const bool hn = (it + NGW) < NITEMS;
        if (hn) { decode(it + NGW, In); P0_LOAD(vn, In); }
#pragma unroll
        for (int i = 0; i < 8; ++i) { const int kk = 8 * i + lr; const f32x4 v = vc[i] * 64.f;
            scr[kk * 33 + c4] = v[0]; scr[kk * 33 + c4 + 1] = v[1]; scr[kk * 33 + c4 + 2] = v[2]; scr[kk * 33 + c4 + 3] = v[3]; }
        LDS_WAIT(); asm volatile("" ::: "memory");
        { const int cc = C.lane & 7;
#pragma unroll
          for (int j = 0; j < 4; ++j) { const int n = lr + 8 * j; const LAS float* s = scr + (8 * cc) * 33 + n;
              u32x2v o; o.x = pg8::pk4_fp8(s[0 * 33], s[1 * 33], s[2 * 33], s[3 * 33]); o.y = pg8::pk4_fp8(s[4 * 33], s[5 * 33], s[6 * 33], s[7 * 33]);
              *(u32x2v*)(Ic.WT + (size_t)(Ic.row_off + Ic.n0 + n) * D + Ic.k0 + 8 * cc) = o; } }
        LDS_WAIT(); asm volatile("" ::: "memory");
        if (hn) { Ic = In;
#pragma unroll
            for (int i = 0; i < 8; ++i) vc[i] = vn[i]; }
    }
#undef P0_LOAD
    __syncthreads();
    LAS float* cs = (LAS float*)(C.lds + RING_OFF);
    LAS float* red = (LAS float*)(C.lds + RING_OFF + 32768);
    for (int i = C.tid; i < 8192; i += 512) { const float v = a.in[IN_C][i]; cs[i] = v / (1.f + __expf(-v)); }
    __syncthreads();
    float* ADA = (float*)(C.ws + SM_ADA);
    for (int grp = C.vcu; grp < 192; grp += C.G) {
        const int l = grp / 96, col = (grp % 96) * 64 + C.lane;
        const float* w = a.in[IN_ADAW] + (size_t)l * D * 6144 + col;
        float acc[8];
#pragma unroll
        for (int b = 0; b < 8; ++b) acc[b] = 0.f;
        const int kbeg = C.wave * 128;
#pragma unroll 4
        for (int k = kbeg; k < kbeg + 128; k += 4) {
            float wv[4];
#pragma unroll
            for (int j = 0; j < 4; ++j) wv[j] = w[(size_t)(k + j) * 6144];
#pragma unroll
            for (int b = 0; b < 8; ++b) { const f32x4 cv = *(const LAS f32x4*)(cs + b * 1024 + k); acc[b] += cv[0] * wv[0] + cv[1] * wv[1] + cv[2] * wv[2] + cv[3] * wv[3]; }
        }
#pragma unroll
        for (int b = 0; b < 8; ++b) red[(C.wave * 8 + b) * 64 + C.lane] = acc[b];
        __syncthreads();
        { const int b = C.wave; float s = 0.f;
#pragma unroll
          for (int w8 = 0; w8 < 8; ++w8) s += red[(w8 * 8 + b) * 64 + C.lane];
          ADA[(size_t)(l * 8 + b) * 6144 + col] = s + a.in[IN_ADAB][l * 6144 + col]; }
        __syncthreads();
    }
    if (C.vcu == C.G - 1) {
        float* BT = (float*)(C.ws + SM_BIAST);
        for (int i = C.tid; i < 48 * 129; i += 512) { const int gh = i / 129, dl = i % 129, g = gh >> 4, n = dl << (2 * g);
            int bk = n;
            if (n >= 16) { const float nf = (float)n; bk = 16 + (int)(logf(nf / 16.f) / 4.852030263919617f * 16.f); bk = bk > 31 ? 31 : bk; }
            BT[gh * 132 + dl] = a.in[IN_RELB][bk * 48 + gh] * LOG2E; }
    }
}

__device__ __forceinline__ void p1_rows0(const Ctx& C, const Args& a) {
    const float* ADA = (const float*)(C.ws + SM_ADA);
    float* GM = (float*)(C.ws + SM_GM); float* CSH = (float*)(C.ws + SM_CSH);
    const int gt = C.vcu * 512 + C.tid, NGT = C.G * 512;
    for (int i = gt; i < 2 * 2 * 8 * 1024; i += NGT) { const int d = i & 1023, b = (i >> 10) & 7, kind = (i >> 13) & 1, l = i >> 14;
        const float g = kind ? a.in[IN_NFFN][l * D + d] : a.in[IN_NMIX][l * D + d];
        GM[i] = g * (1.f + ADA[(size_t)(l * 8 + b) * 6144 + (kind ? 4 : 1) * 1024 + d]); }
    const int gw = C.vcu * NWAVES + C.wave, NGW = C.G * NWAVES;
    for (int o = gw; o < 512; o += NGW) { const int e = o & 31, b = (o >> 5) & 7, l = o >> 8; float s = 0.f;
        for (int d = C.lane; d < D; d += 64) s += ADA[(size_t)(l * 8 + b) * 6144 + 3 * 1024 + d] * a.in[IN_RW][(size_t)l * D * 32 + d * 32 + e];
        s = wave_sum(s); if (C.lane == 0) CSH[o] = s + a.in[IN_RB][l * 32 + e]; }
    bf16* H = (bf16*)(C.ws + WS_H);
    for (int m = gw; m < T; m += NGW) {
        const int b = m >> 12;
        const f32x4* xr = (const f32x4*)(a.in[IN_X] + (size_t)m * D) + C.lane;
        const f32x4* gr = (const f32x4*)(a.in[IN_NMIX]) + C.lane;
        const f32x4* sc = (const f32x4*)(ADA + (size_t)b * 6144 + 1024) + C.lane;
        const f32x4* sh = (const f32x4*)(ADA + (size_t)b * 6144) + C.lane;
        f32x4 v[4]; float s = 0.f;
#pragma unroll
        for (int j = 0; j < 4; ++j) { v[j] = xr[64 * j]; s += (v[j].x * v[j].x + v[j].y * v[j].y) + (v[j].z * v[j].z + v[j].w * v[j].w); }
        const float rstd = 1.f / sqrtf(wave_sum(s) * (1.f / D) + RMS_EPS);
        unsigned long long* o8 = (unsigned long long*)(H + (size_t)m * D) + C.lane; unsigned* o4 = (unsigned*)(C.ws + WS_H8 + (size_t)m * D) + C.lane;
#pragma unroll
        for (int j = 0; j < 4; ++j) { const f32x4 h = v[j] * rstd * gr[64 * j] * (sc[64 * j] + 1.f) + sh[64 * j];
            if (QKV_FP8) o4[64 * j] = pg8::pk4_fp8(h.x, h.y, h.z, h.w);
            else o8[64 * j] = (unsigned long long)pkbf(h.x, h.y) | ((unsigned long long)pkbf(h.z, h.w) << 32); }
    }
}

__device__ __forceinline__ void p3_dilated(const Ctx& C) {
    attn_body::band_phase<0>((const attn_body::bf16*)(C.ws + WS_QKV0), (attn_body::bf16*)(C.ws + WS_OG), (float*)(C.ws + SM_LSE), (const float*)(C.ws + SM_BIAST), C.vcu, C.G, 384 * 16, (char*)C.lds + RING_OFF);
}
template <int MODE> __device__ __forceinline__ void p12_fox(const Ctx& C, size_t o_off) {
    const attn_body::bf16* QKV = (const attn_body::bf16*)(C.ws + WS_QKV1);
    attn_body::bf16* O = (attn_body::bf16*)(C.ws + o_off); const float* FC = (const float*)(C.ws + SM_FCUM);
    LAS float* Fl = (LAS float*)(C.lds + RING_OFF + attn_body::T_F);
    LAS int* qslot = (LAS int*)(C.lds + BLK_OFF);
    unsigned* qhead = (unsigned*)(C.ws + WS_CTL) + CW_QUEUE; const unsigned* NRM = (const unsigned*)(C.ws + WS_CTL) + CW_NRM;
    int cur_bh = -1; float thr = 0.f;
    for (;;) {
        int l_; asm volatile("v_mbcnt_lo_u32_b32 %0, -1, 0\n\tv_mbcnt_hi_u32_b32 %0, -1, %0" : "=v"(l_)); const int t_ = C.wave * 64 + l_;
        __syncthreads();
        if (t_ == 0) qslot[0] = (int)__hip_atomic_fetch_add(qhead, 1u, __ATOMIC_RELAXED, __HIP_MEMORY_SCOPE_AGENT);
        __syncthreads();
        const int idx = qslot[0];
        if (idx >= 2048) break;
        const int qb = 15 - (idx >> 7), bh = idx & 127, b = bh >> 4, h = bh & 15, q0 = qb * 256;
        const attn_body::bf16* Qp = QKV + ((size_t)(b * 3 + 0) * 16 + h) * 4096 * 64;
        const attn_body::bf16* Kp = QKV + ((size_t)(b * 3 + 1) * 16 + h) * 4096 * 64;
        const attn_body::bf16* Vp = QKV + ((size_t)(b * 3 + 2) * 16 + h) * 4096 * 64;
        if (bh != cur_bh) {
            { const f32x4* src = (const f32x4*)(FC + (size_t)bh * 4096); LAS f32x4* dst = (LAS f32x4*)Fl; dst[t_] = src[t_]; dst[512 + t_] = src[512 + t_]; }
            const float gq = __uint_as_float(NRM[((b * 2 + 0) * 16 + h) * 2]) + __uint_as_float(NRM[((b * 2 + 0) * 16 + h) * 2 + 1]);
            const float gk = __uint_as_float(NRM[((b * 2 + 1) * 16 + h) * 2]) + __uint_as_float(NRM[((b * 2 + 1) * 16 + h) * 2 + 1]);
            thr = 2.f * (sqrtf(gq) * sqrtf(gk) * 1.001f + 1e-3f) + 152.f;
            cur_bh = bh;
            __syncthreads();
        }
        int tlo = 0;
        if (MODE == 1) {
            const int NTq = 4 * qb;
            const bool dead = (l_ < NTq) && (Fl[q0] - Fl[64 * l_ + 63] <= -thr);
            tlo = __popcll(__ballot(dead)) & ~1;
        }
        attn_body::attn_unit_t<MODE, 64>(Qp + (size_t)q0 * 64, Kp + (size_t)tlo * 4096, Vp + (size_t)tlo * 4096, 4 * qb + 4 - tlo, 64 * tlo, (WO_FP8 && MODE == 1) ? (attn_body::bf16*)((unsigned char*)O + ((size_t)b * 4096 + q0) * D + h * 64) : O + ((size_t)b * 4096 + q0) * D + h * 64, (long)D, nullptr, 0, (char*)C.lds + RING_OFF);
    }
}
__device__ __forceinline__ void p4_merge(const Ctx& C) {
    const bf16* OG = (const bf16*)(C.ws + WS_OG); const float* LSE = (const float*)(C.ws + SM_LSE); bf16* O = (bf16*)(C.ws + WS_O);
    const int gt = C.vcu * 512 + C.tid, NGT = C.G * 512;
    for (int i = gt; i < T * 128; i += NGT) { const int tok = i >> 7, c8 = i & 127, hd = c8 >> 3;
        const float l0 = LSE[(size_t)tok * 16 + hd], l1 = LSE[((size_t)T + tok) * 16 + hd], l2 = LSE[((size_t)2 * T + tok) * 16 + hd];
        const float mx = fmaxf(l0, fmaxf(l1, l2)); float w0 = __builtin_amdgcn_exp2f(l0 - mx), w1 = __builtin_amdgcn_exp2f(l1 - mx), w2 = __builtin_amdgcn_exp2f(l2 - mx);
        const float inv = 1.f / (w0 + w1 + w2); w0 *= inv; w1 *= inv; w2 *= inv;
        const u32x4v a0 = *(const u32x4v*)(OG + (size_t)tok * D + c8 * 8), a1 = *(const u32x4v*)(OG + ((size_t)T + tok) * D + c8 * 8), a2 = *(const u32x4v*)(OG + ((size_t)2 * T + tok) * D + c8 * 8);
        u32x4v o;
#pragma unroll
        for (int k = 0; k < 4; ++k) { const float lo = w0 * bf2f(a0[k] & 0xffffu) + w1 * bf2f(a1[k] & 0xffffu) + w2 * bf2f(a2[k] & 0xffffu);
            float hi = w0 * bf2f(a0[k] >> 16) + w1 * bf2f(a1[k] >> 16) + w2 * bf2f(a2[k] >> 16); float lo2 = lo;
#if PROBE_SANITIZE
            if (!(fabsf(lo2) < 1e30f)) lo2 = 0.f; if (!(fabsf(hi) < 1e30f)) hi = 0.f;
#endif
            o[k] = pkbf(lo2, hi); }
        if (WO_FP8) { u32x2v o8; o8.x = pg8::pk4_fp8(bf2f(o[0] & 0xffffu), bf2f(o[0] >> 16), bf2f(o[1] & 0xffffu), bf2f(o[1] >> 16)); o8.y = pg8::pk4_fp8(bf2f(o[2] & 0xffffu), bf2f(o[2] >> 16), bf2f(o[3] & 0xffffu), bf2f(o[3] >> 16));
            *(u32x2v*)((unsigned char*)O + (size_t)tok * D + c8 * 8) = o8; }
        else *(u32x4v*)(O + (size_t)tok * D + c8 * 8) = o; }
}

__device__ __forceinline__ f32x4 bf4_to_f32(u32x2v v) { return (f32x4){bf2f(v.x & 0xffffu), bf2f(v.x >> 16), bf2f(v.y & 0xffffu), bf2f(v.y >> 16)}; }
typedef u32x2v xs4_t;
__device__ __forceinline__ f32x4 xs4_to_f32(xs4_t v) { return bf4_to_f32(v); }
__device__ __forceinline__ xs4_t f32_to_xs4(f32x4 v) { xs4_t r; r.x = pkbf(v.x, v.y); r.y = pkbf(v.z, v.w); return r; }
#if Y_FP8
typedef unsigned yraw4_t;
__device__ __forceinline__ f32x4 y4_to_f32(yraw4_t v) { const auto lo = __builtin_amdgcn_cvt_pk_f32_fp8((int)v, false), hi = __builtin_amdgcn_cvt_pk_f32_fp8((int)v, true); return (f32x4){lo[0], lo[1], hi[0], hi[1]}; }
#define Y_ROWPTR(Yb, slot) ((const yraw4_t*)((const unsigned char*)(Yb) + (size_t)(slot) * D) + C.lane)
#else
typedef u32x2v yraw4_t;
__device__ __forceinline__ f32x4 y4_to_f32(yraw4_t v) { return bf4_to_f32(v); }
#define Y_ROWPTR(Yb, slot) ((const yraw4_t*)((Yb) + (size_t)(slot) * D) + C.lane)
#endif

__device__ __forceinline__ void r1_router(const Ctx& C, const Args& a, int l) {
    LAS float* scrf = (LAS float*)(C.lds + SCR_OFF + C.wave * 2048);
    LAS int* scri = (LAS int*)scrf;
    LAS int* blk = (LAS int*)(C.lds + BLK_OFF);
    const float* rw = a.in[IN_RW] + (size_t)l * D * 32;
    LAS unsigned short* wh = (LAS unsigned short*)(C.lds + RING_OFF); LAS unsigned short* wlo = (LAS unsigned short*)(C.lds + RING_OFF + 65536);
    int tab_b = -1;
    const bf16* XS = (const bf16*)(C.ws + WS_XS); unsigned char* H8 = (unsigned char*)(C.ws + WS_H8);
    const float* ADA = (const float*)(C.ws + SM_ADA) + (size_t)l * 8 * 6144;
    const float* GM = (const float*)(C.ws + SM_GM) + (size_t)(l * 2 + 1) * 8 * 1024;
    const float* CSH = (const float*)(C.ws + SM_CSH) + l * 256;
    int* TOPI = (int*)(C.ws + SM_TOPI); float* TOPG = (float*)(C.ws + SM_TOPG); int* RANK = (int*)(C.ws + SM_RANK); int* BLKCNT = (int*)(C.ws + SM_BLKCNT);
    const int tk = C.lane & 15, q = C.lane >> 4;
    for (int vb = C.vcu; vb < NVB; vb += C.G) {
        const int tok0 = vb * 128 + C.wave * 16, b = tok0 >> 12, tok = tok0 + tk;
        if (b != tab_b) {
            __syncthreads();
            const float* gmb = GM + b * 1024;
            for (int i = C.tid; i < D * 32; i += 512) { const int dd = i >> 5, e = i & 31; const float w = rw[i] * gmb[dd];
                const unsigned hb = pkbf(w, 0.f) & 0xffffu; const float hf = bf2f(hb); const unsigned lb = pkbf(w - hf, 0.f) & 0xffffu;
                const int pos = ((((dd >> 5) * 4 + ((dd >> 3) & 3)) * 32 + e) << 3) + (dd & 7);
                wh[pos] = (unsigned short)hb; wlo[pos] = (unsigned short)lb; }
            __syncthreads();
            tab_b = b;
        }
        const bf16* xrow = XS + (size_t)tok * D + 8 * q;
        f32x4 acc0 = {0.f, 0.f, 0.f, 0.f}, acc1 = {0.f, 0.f, 0.f, 0.f}; float ssq = 0.f;
        typedef short bf16x8r __attribute__((ext_vector_type(8)));
#pragma unroll 4
        for (int kk = 0; kk < 32; ++kk) {
            const u32x4v xr8 = *(const u32x4v*)(xrow + 32 * kk);
#pragma unroll
            for (int e2 = 0; e2 < 4; ++e2) { const float x0 = bf2f(xr8[e2] & 0xffffu), x1 = bf2f(xr8[e2] >> 16); ssq += x0 * x0 + x1 * x1; }
            const bf16x8r xb = __builtin_bit_cast(bf16x8r, xr8);
            const int fo = ((kk * 4 + q) * 32 + tk) << 3;
            const bf16x8r h0 = *(const LAS bf16x8r*)(wh + fo), h1 = *(const LAS bf16x8r*)(wh + fo + 128), l0 = *(const LAS bf16x8r*)(wlo + fo), l1 = *(const LAS bf16x8r*)(wlo + fo + 128);
            acc0 = __builtin_amdgcn_mfma_f32_16x16x32_bf16(h0, xb, acc0, 0, 0, 0); acc1 = __builtin_amdgcn_mfma_f32_16x16x32_bf16(h1, xb, acc1, 0, 0, 0);
            acc0 = __builtin_amdgcn_mfma_f32_16x16x32_bf16(l0, xb, acc0, 0, 0, 0); acc1 = __builtin_amdgcn_mfma_f32_16x16x32_bf16(l1, xb, acc1, 0, 0, 0);
        }
        ssq += __shfl_xor(ssq, 16); ssq += __shfl_xor(ssq, 32);
        const float rstd = 1.f / sqrtf(ssq * (1.f / D) + RMS_EPS);
        { const f32x4 c0 = *(const f32x4*)(CSH + b * 32 + 4 * q), c1 = *(const f32x4*)(CSH + b * 32 + 16 + 4 * q);
          *(LAS f32x4*)(scrf + tk * 32 + 4 * q) = acc0 * rstd + c0; *(LAS f32x4*)(scrf + tk * 32 + 16 + 4 * q) = acc1 * rstd + c1; }
        LDS_WAIT();
        int myidx[4] = {0, 0, 0, 0};
        if (C.lane < 16) {
            float v[32];
#pragma unroll
            for (int j = 0; j < 8; ++j) { const f32x4 t4 = *(const LAS f32x4*)(scrf + C.lane * 32 + 4 * j); v[4 * j] = t4.x; v[4 * j + 1] = t4.y; v[4 * j + 2] = t4.z; v[4 * j + 3] = t4.w; }
            float val[4];
#pragma unroll
            for (int k = 0; k < 4; ++k) { float best = v[0]; int bi = 0;
#pragma unroll
                for (int e = 1; e < 32; ++e) { if (v[e] > best) { best = v[e]; bi = e; } }
                val[k] = best; myidx[k] = bi;
#pragma unroll
                for (int e = 0; e < 32; ++e) v[e] = (e == bi) ? -INFINITY : v[e]; }
            const float e1 = __expf(val[1] - val[0]), e2 = __expf(val[2] - val[0]), e3 = __expf(val[3] - val[0]), inv = 1.f / (1.f + e1 + e2 + e3);
            *(i32x4v*)(TOPI + (size_t)(tok0 + C.lane) * 4) = (i32x4v){myidx[0], myidx[1], myidx[2], myidx[3]};
            *(f32x4*)(TOPG + (size_t)(tok0 + C.lane) * 4) = (f32x4){inv, e1 * inv, e2 * inv, e3 * inv};
        }
        LDS_WAIT();
        if (C.lane < 16) *(LAS i32x4v*)(scri + C.lane * 4) = (i32x4v){myidx[0], myidx[1], myidx[2], myidx[3]};
        LDS_WAIT();
        const int e = scri[C.lane];
        const unsigned long long lt = (1ull << C.lane) - 1ull;
        int rank = 0, mycnt = 0;
#pragma unroll 4
        for (int j = 0; j < 32; ++j) { const unsigned long long mk = __ballot(e == j); if (e == j) rank = __popcll(mk & lt); if (C.lane == j) mycnt = __popcll(mk); }
        if (C.lane < 32) blk[BL_WCNT + C.wave * 32 + C.lane] = mycnt;
        __syncthreads();
        if (C.lane < 32) { int wb = 0;
            for (int w8 = 0; w8 < C.wave; ++w8) wb += blk[BL_WCNT + w8 * 32 + C.lane];
            blk[BL_WBASE + C.wave * 32 + C.lane] = wb;
            if (C.wave == NWAVES - 1) BLKCNT[vb * 32 + C.lane] = wb + mycnt; }
        LDS_WAIT();
        RANK[(size_t)tok0 * 4 + C.lane] = blk[BL_WBASE + C.wave * 32 + e] + rank;
        const f32x4* shf = (const f32x4*)(ADA + (size_t)b * 6144 + 3 * 1024) + C.lane; const f32x4* gm4 = (const f32x4*)(GM + b * 1024) + C.lane;
#pragma unroll 2
        for (int tt = 0; tt < 16; ++tt) { const float rs = __shfl(rstd, tt); const int tkn = tok0 + tt;
            const xs4_t* xr = (const xs4_t*)(XS + (size_t)tkn * D) + C.lane; unsigned* o4 = (unsigned*)(H8 + (size_t)tkn * D) + C.lane;
#pragma unroll
            for (int j = 0; j < 4; ++j) { const f32x4 h = xs4_to_f32(xr[64 * j]) * rs * gm4[64 * j] + shf[64 * j];
                o4[64 * j] = pg8::pk4_fp8(h.x, h.y, h.z, h.w); } }
        __syncthreads();
    }
}

__device__ __forceinline__ void p7_route(const Ctx& C) {
    LAS int* blk = (LAS int*)(C.lds + BLK_OFF);
    const int* BLKCNT = (const int*)(C.ws + SM_BLKCNT); const int* TOPI = (const int*)(C.ws + SM_TOPI); const int* RANK = (const int*)(C.ws + SM_RANK);
    int* SLOT = (int*)(C.ws + SM_SLOT); int* TILEEXP = (int*)(C.ws + SM_TILEEXP); int* TOKSLOT = (int*)(C.ws + SM_TOKSLOT);
    const unsigned char* H8 = (const unsigned char*)(C.ws + WS_H8); unsigned char* XB = (unsigned char*)(C.ws + WS_XB);
    const int e = C.tid & 31, part = C.tid >> 5;
    { int s = 0; for (int k = 0; k < 16; ++k) s += BLKCNT[(part * 16 + k) * 32 + e]; blk[BL_PARTA + part * 32 + e] = s; }
    __syncthreads();
    if (C.tid < 32) { int tot = 0; for (int p = 0; p < 16; ++p) tot += blk[BL_PARTA + p * 32 + C.tid]; blk[BL_TOT + C.tid] = tot; }
    __syncthreads();
    if (C.tid == 0) { int run = 0; for (int k = 0; k < 32; ++k) { blk[BL_PADS + k] = run; run += (blk[BL_TOT + k] + 255) & ~255; } blk[BL_PADS + 32] = run; }
    __syncthreads();
    if (C.vcu == 0) {
        const int nt = blk[BL_PADS + 32] >> 8;
        if (C.tid == 0) TILEEXP[0] = nt;
        for (int i = C.tid; i < nt; i += 512) { int ex = 0; for (int k = 1; k < 32; ++k) ex += (blk[BL_PADS + k] <= i * 256) ? 1 : 0; TILEEXP[16 + i] = ex; }
    }
    for (int vb = C.vcu; vb < NVB; vb += C.G) {
        __syncthreads();
        { int s = 0; for (int k = 0; k < 16; ++k) { const int bb = part * 16 + k; s += (bb < vb) ? BLKCNT[bb * 32 + e] : 0; } blk[BL_PARTB + part * 32 + e] = s; }
        __syncthreads();
        if (C.tid < 32) { int bs = 0; for (int p = 0; p < 16; ++p) bs += blk[BL_PARTB + p * 32 + C.tid]; blk[BL_BASE + C.tid] = bs + blk[BL_PADS + C.tid]; }
        __syncthreads();
        { const int i = vb * 512 + C.tid; const int ex = TOPI[i]; SLOT[i] = blk[BL_BASE + ex] + RANK[i]; }
        VM_WAIT(); __syncthreads();
#if MOE_GATHER
        { const int i = vb * 512 + C.tid; TOKSLOT[SLOT[i]] = i >> 2; }
#else
        for (int tt = 0; tt < 16; ++tt) { const int tok = vb * 128 + C.wave * 16 + tt;
            const i32x4v sl = *(const i32x4v*)(SLOT + (size_t)tok * 4);
            const u32x4v v0 = *((const u32x4v*)(H8 + (size_t)tok * D) + C.lane);
#pragma unroll
            for (int k = 0; k < 4; ++k) { u32x4v* dst = (u32x4v*)(XB + (size_t)sl[k] * D); dst[C.lane] = v0; } }
#endif
    }
#if MOE_GATHER
    for (int ex = C.vcu; ex < 32; ex += C.G) { const int beg = blk[BL_PADS + ex] + blk[BL_TOT + ex], end = blk[BL_PADS + ex + 1];
        for (int s = beg + C.tid; s < end; s += 512) TOKSLOT[s] = 0; }
#endif
}
__device__ __forceinline__ int load_tile_table(const Ctx& C) {
    LAS int* blk = (LAS int*)(C.lds + BLK_OFF); const int* TILEEXP = (const int*)(C.ws + SM_TILEEXP);
    const int nt = TILEEXP[0];
    __syncthreads();
    for (int i = C.tid; i < MAXTILES; i += 512) blk[BL_TILE + i] = (i < nt) ? TILEEXP[16 + i] : 0;
    __syncthreads();
    return __builtin_amdgcn_readfirstlane(nt);
}


__device__ __forceinline__ void r2_seam(const Ctx& C, const Args& a) {
    LAS float* wl = (LAS float*)(C.lds + RING_OFF);
    { const float* wf = a.in[IN_WKVF]; const float* gkv0 = a.in[IN_KVNG];
      for (int i = C.tid; i < D * 16; i += 512) { const int d = i >> 4, h = i & 15, jj = d >> 8, ln = (d >> 2) & 63, c = d & 3;
          wl[((((jj * 4 + c) * 4 + (h >> 2)) * 64 + ln) << 2) + (h & 3)] = wf[(size_t)d * 2064 + 2048 + h] * gkv0[d]; } }
    __syncthreads();
    bf16* XS = (bf16*)(C.ws + WS_XS); bf16* HKV = (bf16*)(C.ws + WS_HKV); const bf16* Y = (const bf16*)(C.ws + WS_Y);
    const float* ADA0 = (const float*)(C.ws + SM_ADA); const float* ADA1 = ADA0 + (size_t)8 * 6144;
    const float* GM1 = (const float*)(C.ws + SM_GM) + (size_t)(1 * 2 + 0) * 8 * 1024;
    const int* SLOT = (const int*)(C.ws + SM_SLOT); const float* TOPG = (const float*)(C.ws + SM_TOPG); float* LOGF = (float*)(C.ws + SM_LOGF);
    const f32x4* gk4 = (const f32x4*)a.in[IN_KVNG] + C.lane;
    const int gw = C.vcu * NWAVES + C.wave, NGW = C.G * NWAVES;
    const float bfh = a.in[IN_BF][(C.lane >> 2) & 15];
    typedef yraw4_t yraw_t;
#define R2_LOADRAW(XR, Y0, Y1, Y2, Y3, MM, SS) do { const xs4_t* xr_ = (const xs4_t*)(XS + (size_t)(MM) * D) + C.lane; \
        const yraw4_t* z0_ = Y_ROWPTR(Y, (SS)[0]); const yraw4_t* z1_ = Y_ROWPTR(Y, (SS)[1]); \
        const yraw4_t* z2_ = Y_ROWPTR(Y, (SS)[2]); const yraw4_t* z3_ = Y_ROWPTR(Y, (SS)[3]); \
        _Pragma("unroll") for (int j = 0; j < 4; ++j) { XR[j] = xr_[64 * j]; Y0[j] = z0_[64 * j]; Y1[j] = z1_[64 * j]; Y2[j] = z2_[64 * j]; Y3[j] = z3_[64 * j]; } } while (0)
    xs4_t xc[4], xn[4]; yraw_t y0c[4], y1c[4], y2c[4], y3c[4], y0n[4], y1n[4], y2n[4], y3n[4];
    i32x4v s_cur = *(const i32x4v*)(SLOT + (size_t)gw * 4); f32x4 g_cur = *(const f32x4*)(TOPG + (size_t)gw * 4);
    i32x4v s_nxt = s_cur; f32x4 g_nxt = g_cur;
    if (gw + NGW < T) { s_nxt = *(const i32x4v*)(SLOT + (size_t)(gw + NGW) * 4); g_nxt = *(const f32x4*)(TOPG + (size_t)(gw + NGW) * 4); }
    R2_LOADRAW(xc, y0c, y1c, y2c, y3c, gw, s_cur);
    for (int m = gw; m < T; m += NGW) { const int b = m >> 12;
        const int mn = m + NGW, mnn = m + 2 * NGW;
        i32x4v s_nn = s_nxt; f32x4 g_nn = g_nxt;
        if (mnn < T) { s_nn = *(const i32x4v*)(SLOT + (size_t)mnn * 4); g_nn = *(const f32x4*)(TOPG + (size_t)mnn * 4); }
        if (mn < T) R2_LOADRAW(xn, y0n, y1n, y2n, y3n, mn, s_nxt);
        const f32x4* gf4 = (const f32x4*)(ADA0 + (size_t)b * 6144 + 5 * 1024) + C.lane;
        const f32x4* gm4 = (const f32x4*)(GM1 + b * 1024) + C.lane; const f32x4* shm4 = (const f32x4*)(ADA1 + (size_t)b * 6144) + C.lane;
        xs4_t* xw = (xs4_t*)(XS + (size_t)m * D) + C.lane;
        f32x4 v[4]; float s = 0.f;
#pragma unroll
        for (int j = 0; j < 4; ++j) {
            const f32x4 ys = y4_to_f32(y0c[j]) * g_cur[0] + y4_to_f32(y1c[j]) * g_cur[1] + y4_to_f32(y2c[j]) * g_cur[2] + y4_to_f32(y3c[j]) * g_cur[3];
            v[j] = xs4_to_f32(xc[j]) + gf4[64 * j] * ys; xw[64 * j] = f32_to_xs4(v[j]); v[j] = xs4_to_f32(f32_to_xs4(v[j]));
            s += (v[j].x * v[j].x + v[j].y * v[j].y) + (v[j].z * v[j].z + v[j].w * v[j].w); }
        const float rstd = 1.f / sqrtf(wave_sum(s) * (1.f / D) + RMS_EPS);
        float acc[16];
#pragma unroll
        for (int h = 0; h < 16; ++h) acc[h] = 0.f;
#pragma unroll
        for (int j = 0; j < 4; ++j)
#pragma unroll
            for (int c = 0; c < 4; ++c) { const float xv = v[j][c];
#pragma unroll
                for (int h4 = 0; h4 < 4; ++h4) { const f32x4 w = *(const LAS f32x4*)(wl + ((((j * 4 + c) * 4 + h4) * 64 + C.lane) << 2));
                    acc[4 * h4] += xv * w[0]; acc[4 * h4 + 1] += xv * w[1]; acc[4 * h4 + 2] += xv * w[2]; acc[4 * h4 + 3] += xv * w[3]; }
                if (c == 3) __builtin_amdgcn_sched_barrier(0); }
#pragma unroll
        for (int j = 0; j < 4; ++j) { const f32x4 n = v[j] * rstd, h = n * gm4[64 * j] + shm4[64 * j], hk = n * gk4[64 * j];
            if (KVQ_FP8) { ((unsigned*)(C.ws + WS_HKV + (size_t)T * D + (size_t)m * D) + C.lane)[64 * j] = pg8::pk4_fp8(h.x, h.y, h.z, h.w);
                           ((unsigned*)(C.ws + WS_HKV + (size_t)m * D) + C.lane)[64 * j] = pg8::pk4_fp8(hk.x, hk.y, hk.z, hk.w); }
            else { ((unsigned long long*)(HKV + (size_t)T * D + (size_t)m * D) + C.lane)[64 * j] = (unsigned long long)pkbf(h.x, h.y) | ((unsigned long long)pkbf(h.z, h.w) << 32);
                   ((unsigned long long*)(HKV + (size_t)m * D) + C.lane)[64 * j] = (unsigned long long)pkbf(hk.x, hk.y) | ((unsigned long long)pkbf(hk.z, hk.w) << 32); } }
        __builtin_amdgcn_sched_barrier(0);
        float r8[8], r4[4], r2v[2], r1;
        { const bool up = (C.lane & 32) != 0;
#pragma unroll
          for (int i = 0; i < 8; ++i) { const float snd = up ? acc[i] : acc[i + 8], kp = up ? acc[i + 8] : acc[i]; r8[i] = kp + __shfl_xor(snd, 32); } }
        { const bool up = (C.lane & 16) != 0;
#pragma unroll
          for (int i = 0; i < 4; ++i) { const float snd = up ? r8[i] : r8[i + 4], kp = up ? r8[i + 4] : r8[i]; r4[i] = kp + __shfl_xor(snd, 16); } }
        { const bool up = (C.lane & 8) != 0;
#pragma unroll
          for (int i = 0; i < 2; ++i) { const float snd = up ? r4[i] : r4[i + 2], kp = up ? r4[i + 2] : r4[i]; r2v[i] = kp + __shfl_xor(snd, 8); } }
        { const bool up = (C.lane & 4) != 0; const float snd = up ? r2v[0] : r2v[1], kp = up ? r2v[1] : r2v[0]; r1 = kp + __shfl_xor(snd, 4); }
        r1 += __shfl_xor(r1, 2); r1 += __shfl_xor(r1, 1);
        if ((C.lane & 3) == 0) { const float z = r1 * rstd + bfh; LOGF[(size_t)m * 16 + ((C.lane >> 2) & 15)] = (fminf(z, 0.f) - log1pf(__expf(-fabsf(z)))) * LOG2E; }
#pragma unroll
        for (int j = 0; j < 4; ++j) { xc[j] = xn[j]; y0c[j] = y0n[j]; y1c[j] = y1n[j]; y2c[j] = y2n[j]; y3c[j] = y3n[j]; }
        s_cur = s_nxt; g_cur = g_nxt; s_nxt = s_nn; g_nxt = g_nn;
    }
#undef R2_LOADRAW
}
__device__ __forceinline__ void fcum_scan(const Ctx& C) {
    const float* LOGF = (const float*)(C.ws + SM_LOGF); float* FC = (float*)(C.ws + SM_FCUM);
    LAS float* wtot = (LAS float*)(C.lds + BLK_OFF);
    for (int sq = C.vcu; sq < 128; sq += C.G) { const int b = sq >> 4, h = sq & 15;
        const float* src = LOGF + ((size_t)b * 4096 + C.tid * 8) * 16 + h; float* dst = FC + (size_t)sq * 4096 + C.tid * 8;
        float v[8]; float tot = 0.f;
#pragma unroll
        for (int i = 0; i < 8; ++i) { v[i] = src[i * 16]; }
#pragma unroll
        for (int i = 0; i < 8; ++i) { tot += v[i]; v[i] = tot; }
        float inc = tot;
#pragma unroll
        for (int o = 1; o < 64; o <<= 1) { const float t = __shfl_up(inc, o); if (C.lane >= o) inc += t; }
        __syncthreads();
        if (C.lane == 63) wtot[C.wave] = inc;
        __syncthreads();
        float carry = inc - tot;
        for (int w8 = 0; w8 < C.wave; ++w8) carry += wtot[w8];
#pragma unroll
        for (int i = 0; i < 8; ++i) dst[i] = v[i] + carry;
    }
}
__device__ __forceinline__ void r3_final(const Ctx& C, const Args& a, float* XD) {
    const bf16* XS = (const bf16*)(C.ws + WS_XS); const bf16* Y = (const bf16*)(C.ws + WS_Y);
    const float* ADA1 = (const float*)(C.ws + SM_ADA) + (size_t)8 * 6144;
    const int* SLOT = (const int*)(C.ws + SM_SLOT); const float* TOPG = (const float*)(C.ws + SM_TOPG);
    const f32x4* fg4 = (const f32x4*)a.in[IN_FNG] + C.lane;
    const int gw = C.vcu * NWAVES + C.wave, NGW = C.G * NWAVES;
#define R3_LOADRAW(XR, Y0, Y1, Y2, Y3, MM, SS) do { const xs4_t* xr_ = (const xs4_t*)(XS + (size_t)(MM) * D) + C.lane; \
        const yraw4_t* z0_ = Y_ROWPTR(Y, (SS)[0]); const yraw4_t* z1_ = Y_ROWPTR(Y, (SS)[1]); \
        const yraw4_t* z2_ = Y_ROWPTR(Y, (SS)[2]); const yraw4_t* z3_ = Y_ROWPTR(Y, (SS)[3]); \
        _Pragma("unroll") for (int j = 0; j < 4; ++j) { XR[j] = xr_[64 * j]; Y0[j] = z0_[64 * j]; Y1[j] = z1_[64 * j]; Y2[j] = z2_[64 * j]; Y3[j] = z3_[64 * j]; } } while (0)
    xs4_t xc[4], xn[4]; yraw4_t y0c[4], y1c[4], y2c[4], y3c[4], y0n[4], y1n[4], y2n[4], y3n[4];
    i32x4v s_cur = *(const i32x4v*)(SLOT + (size_t)gw * 4); f32x4 g_cur = *(const f32x4*)(TOPG + (size_t)gw * 4);
    i32x4v s_nxt = s_cur; f32x4 g_nxt = g_cur;
    if (gw + NGW < T) { s_nxt = *(const i32x4v*)(SLOT + (size_t)(gw + NGW) * 4); g_nxt = *(const f32x4*)(TOPG + (size_t)(gw + NGW) * 4); }
    R3_LOADRAW(xc, y0c, y1c, y2c, y3c, gw, s_cur);
    for (int m = gw; m < T; m += NGW) { const int b = m >> 12;
        const int mn = m + NGW, mnn = m + 2 * NGW;
        i32x4v s_nn = s_nxt; f32x4 g_nn = g_nxt;
        if (mnn < T) { s_nn = *(const i32x4v*)(SLOT + (size_t)mnn * 4); g_nn = *(const f32x4*)(TOPG + (size_t)mnn * 4); }
        if (mn < T) R3_LOADRAW(xn, y0n, y1n, y2n, y3n, mn, s_nxt);
        const f32x4* gf4 = (const f32x4*)(ADA1 + (size_t)b * 6144 + 5 * 1024) + C.lane;
        f32x4* xw = (f32x4*)(XD + (size_t)m * D) + C.lane;
        f32x4 v[4]; float s = 0.f;
#pragma unroll
        for (int j = 0; j < 4; ++j) {
            const f32x4 ys = y4_to_f32(y0c[j]) * g_cur[0] + y4_to_f32(y1c[j]) * g_cur[1] + y4_to_f32(y2c[j]) * g_cur[2] + y4_to_f32(y3c[j]) * g_cur[3];
            v[j] = xs4_to_f32(xc[j]) + gf4[64 * j] * ys; s += (v[j].x * v[j].x + v[j].y * v[j].y) + (v[j].z * v[j].z + v[j].w * v[j].w); }
        const float rstd = 1.f / sqrtf(wave_sum(s) * (1.f / D) + RMS_EPS);
#pragma unroll
        for (int j = 0; j < 4; ++j) xw[64 * j] = v[j] * rstd * fg4[64 * j];
#pragma unroll
        for (int j = 0; j < 4; ++j) { xc[j] = xn[j]; y0c[j] = y0n[j]; y1c[j] = y1n[j]; y2c[j] = y2n[j]; y3c[j] = y3n[j]; }
        s_cur = s_nxt; g_cur = g_nxt; s_nxt = s_nn; g_nxt = g_nn;
    }
#undef R3_LOADRAW
}

constexpr int N_PHASES = 19;
__global__ void __launch_bounds__(NWAVES * 64, 2) yoco_fwd(Args args) {
    extern __shared__ __attribute__((aligned(16))) unsigned char lds[];
    Ctx C;
    C.lds = (LAS unsigned char*)lds; C.ws = args.ws;
    C.tid = threadIdx.x; C.lane = C.tid & 63; C.wave = __builtin_amdgcn_readfirstlane(C.tid >> 6);
    C.G = gridDim.x; { const int bx = blockIdx.x; C.vcu = (C.G % 8 == 0) ? (bx % 8) * (C.G / 8) + bx / 8 : bx; }
    volatile LAS unsigned* MISC = (volatile LAS unsigned*)(C.lds + MISC_OFF);
    if (C.tid < 64) MISC[C.tid] = 0u;
    __syncthreads();
    const int lo = args.ph_lo, hi = args.ph_hi;
    const bool one = (hi - lo) > 1;
    unsigned* ctl = (unsigned*)(args.ws + WS_CTL);
    XcdBarrier bar; bar.bar = ctl + CW_BAR; bar.x = 0; bar.st = nullptr;
    if (one) bar = xcd_barrier_post(ctl + CW_BAR, MISC + 8);
#define IN(k) (lo <= (k) && (k) < hi)
#define SEAM(k) do { if (IN(k) && IN((k) + 1)) xcd_barrier(bar); } while (0)
#define FRESH() do { int l_; asm volatile("v_mbcnt_lo_u32_b32 %0, -1, 0\n\tv_mbcnt_hi_u32_b32 %0, -1, %0" : "=v"(l_)); C.lane = l_; C.tid = C.wave * 64 + l_; } while (0)
#define REP(k) _Pragma("unroll") for (int rep_ = 0; rep_ < 1 + ((PROBE_DUP >> (k)) & 1); ++rep_)
    bf16* const Hb = (bf16*)(C.ws + WS_H);
    if (IN(0)) { FRESH(); REP(0) { p0_prologue(C, args); } SEAM(0); }
    if (IN(1)) { FRESH(); REP(1) { p1_rows0(C, args); } SEAM(1); }
    if (IN(2)) { FRESH();
#if PROBE_QKV
        { pg8::Gemm g{(const pg8::bf16_t*)(C.ws + WS_H8), (const pg8::bf16_t*)(C.ws + WS_WQKV), T, NQKV, D}; pg8::StaticOrder S; S.init(T, NQKV, C.G, (int)blockIdx.x);
#if PROBE_QKV == 1
          pg8::EpiQKV0 E{(pg8::bf16_t*)(C.ws + WS_QKV0), 0.015625f};
          pg8::gemm_phase<pg8::EpiQKV0, pg8::StaticOrder, true, true, 1>(C.lds + RING_OFF, g, S, E);
#elif PROBE_QKV == 2
          pg8::EpiQKV0Probe E{(pg8::bf16_t*)(C.ws + WS_QKV0), 0.015625f, 1};
          pg8::gemm_phase<pg8::EpiQKV0Probe, pg8::StaticOrder, true, true, 1>(C.lds + RING_OFF, g, S, E);
#else
          pg8::EpiNone E{(unsigned char*)(C.ws + WS_XB)};
          pg8::gemm_phase<pg8::EpiNone, pg8::StaticOrder, true, true, 1>(C.lds + RING_OFF, g, S, E);
#endif
        }
#endif
#if STAGGER_QKV
        { const unsigned long long t0 = __builtin_amdgcn_s_memrealtime(); const unsigned long long dl = (unsigned long long)(C.vcu & 7) * STAGGER_QKV;
          while (__builtin_amdgcn_s_memrealtime() - t0 < dl) __builtin_amdgcn_s_sleep(8); }
#endif
        REP(2) {
        pg8::Gemm g{QKV_FP8 ? (const pg8::bf16_t*)(C.ws + WS_H8) : (const pg8::bf16_t*)Hb, (const pg8::bf16_t*)(C.ws + WS_WQKV), T, NQKV, D}; pg8::StaticOrder S; S.init(T, NQKV, C.G, (int)blockIdx.x);
        pg8::EpiQKV0 E{(pg8::bf16_t*)(C.ws + WS_QKV0), QKV_FP8 ? 0.015625f : 1.f};
        pg8::gemm_phase<pg8::EpiQKV0, pg8::StaticOrder, true, true, QKV_FP8 ? 1 : 2>(C.lds + RING_OFF, g, S, E);
        } SEAM(2);
    }
    if (IN(3)) { FRESH(); REP(3) { p3_dilated(C); } SEAM(3); }
    if (IN(4)) { FRESH(); REP(4) { p4_merge(C); } SEAM(4); }
    if (IN(5)) { FRESH(); REP(5) {
        pg8::Gemm g{(const pg8::bf16_t*)(C.ws + WS_O), (const pg8::bf16_t*)(C.ws + WS_WO0), T, D, D}; pg8::StaticOrder S; S.init(T, D, C.G, (int)blockIdx.x);
        pg8::EpiResid<false> E{args.in[IN_X], (pg8::bf16_t*)(C.ws + WS_XS), (const float*)(C.ws + SM_ADA) + 2 * 1024, WO_FP8 ? 0.015625f : 1.f};
        pg8::gemm_phase<pg8::EpiResid<false>, pg8::StaticOrder, true, true, WO_FP8 ? 1 : 2>(C.lds + RING_OFF, g, S, E);
        } SEAM(5);
    }
    if (IN(6)) { FRESH(); REP(6) { r1_router(C, args, 0); } SEAM(6); }
    if (IN(7)) { FRESH(); REP(7) { p7_route(C); } SEAM(7); }
    if (IN(8)) { FRESH();
#if PROBE_GU
        { const int nt = load_tile_table(C);
          pg8::Gemm g{(const pg8::bf16_t*)(C.ws + WS_H8), (const pg8::bf16_t*)(C.ws + WS_WGU), MAXROWS, 32 * 2048, D, (const int*)(C.ws + SM_TOKSLOT)};
          pg8::MoeOrder<8> S{(const LAS int*)(C.lds + BLK_OFF) + BL_TILE, nt, (int)blockIdx.x, C.G};
#if PROBE_GU == 1
          pg8::EpiSwiGLU8 E{(unsigned char*)(C.ws + WS_XB), args.in[IN_BGU]};
          pg8::gemm_phase<pg8::EpiSwiGLU8, pg8::MoeOrder<8>, true, true, 1, true>(C.lds + RING_OFF, g, S, E);
#else
          pg8::EpiProbeGU<PROBE_GU - 2> E{(unsigned char*)(C.ws + WS_XB), args.in[IN_BGU]};
          pg8::gemm_phase<pg8::EpiProbeGU<PROBE_GU - 2>, pg8::MoeOrder<8>, true, true, 1, true>(C.lds + RING_OFF, g, S, E);
#endif
        }
#endif
        REP(8) {
        const int nt = load_tile_table(C);
        pg8::Gemm g{(const pg8::bf16_t*)(C.ws + (MOE_GATHER ? WS_H8 : WS_XB)), (const pg8::bf16_t*)(C.ws + WS_WGU), MAXROWS, 32 * 2048, D, (const int*)(C.ws + SM_TOKSLOT)};
        pg8::MoeOrder<8> S{(const LAS int*)(C.lds + BLK_OFF) + BL_TILE, nt, (int)blockIdx.x, C.G};
        pg8::EpiSwiGLU8 E{(unsigned char*)(C.ws + WS_ACT), args.in[IN_BGU]};
        pg8::gemm_phase<pg8::EpiSwiGLU8, pg8::MoeOrder<8>, true, true, 1, MOE_GATHER != 0>(C.lds + RING_OFF, g, S, E);
        } SEAM(8);
    }
    if (IN(9)) { FRESH(); REP(9) {
        const int nt = load_tile_table(C);
        pg8::Gemm g{(const pg8::bf16_t*)(C.ws + WS_ACT), (const pg8::bf16_t*)(C.ws + WS_WDN), MAXROWS, 32 * 1024, D};
        pg8::MoeOrder<4> S{(const LAS int*)(C.lds + BLK_OFF) + BL_TILE, nt, (int)blockIdx.x, C.G};
        pg8::EpiDown8 E{(pg8::bf16_t*)(C.ws + WS_Y), args.in[IN_BDN]};
        pg8::gemm_phase<pg8::EpiDown8, pg8::MoeOrder<4>, true, true, 1>(C.lds + RING_OFF, g, S, E);
        } SEAM(9);
    }
    if (IN(10)) { FRESH(); r2_seam(C, args); SEAM(10); }
    if (IN(11)) { FRESH(); REP(11) {
        fcum_scan(C);
        pg8::Gemm g{(const pg8::bf16_t*)(C.ws + WS_HKV), (const pg8::bf16_t*)(C.ws + WS_WKV), T, 3072, D}; pg8::KVQOrder S; S.init(T, 3072, C.G, (int)blockIdx.x);
        pg8::EpiKVQ E{(pg8::bf16_t*)(C.ws + WS_QKV1), KVQ_FP8 ? 0.015625f : 1.f, (unsigned*)(C.ws + WS_CTL) + CW_NRM};
        pg8::gemm_phase<pg8::EpiKVQ, pg8::KVQOrder, true, true, KVQ_FP8 ? 1 : 2>(C.lds + RING_OFF, g, S, E);
        } SEAM(11);
    }
    if (IN(12)) { FRESH(); if (PROBE_FOX == 2) p12_fox<2>(C, WS_OG); REP(12) { p12_fox<1>(C, WS_O); } SEAM(12); }
    if (IN(13)) { FRESH(); REP(13) {
        pg8::Gemm g{(const pg8::bf16_t*)(C.ws + WS_O), (const pg8::bf16_t*)(C.ws + WS_WO1), T, D, D}; pg8::StaticOrder S; S.init(T, D, C.G, (int)blockIdx.x);
        pg8::EpiResid<true> E{C.ws + WS_XS, (pg8::bf16_t*)(C.ws + WS_XS), (const float*)(C.ws + SM_ADA) + (size_t)8 * 6144 + 2 * 1024, WO_FP8 ? 0.015625f : 1.f};
        pg8::gemm_phase<pg8::EpiResid<true>, pg8::StaticOrder, true, true, WO_FP8 ? 1 : 2>(C.lds + RING_OFF, g, S, E);
        } SEAM(13);
    }
    if (IN(14)) { FRESH(); REP(14) { r1_router(C, args, 1); } SEAM(14); }
    if (IN(15)) { FRESH(); REP(15) { p7_route(C); } SEAM(15); }
    if (IN(16)) { FRESH(); REP(16) {
        const int nt = load_tile_table(C);
        pg8::Gemm g{(const pg8::bf16_t*)(C.ws + (MOE_GATHER ? WS_H8 : WS_XB)), (const pg8::bf16_t*)(C.ws + WS_WGU + (size_t)32 * 2048 * D), MAXROWS, 32 * 2048, D, (const int*)(C.ws + SM_TOKSLOT)};
        pg8::MoeOrder<8> S{(const LAS int*)(C.lds + BLK_OFF) + BL_TILE, nt, (int)blockIdx.x, C.G};
        pg8::EpiSwiGLU8 E{(unsigned char*)(C.ws + WS_ACT), args.in[IN_BGU] + 32 * 2048};
        pg8::gemm_phase<pg8::EpiSwiGLU8, pg8::MoeOrder<8>, true, true, 1, MOE_GATHER != 0>(C.lds + RING_OFF, g, S, E);
        } SEAM(16);
    }
    if (IN(17)) { FRESH(); REP(17) {
        const int nt = load_tile_table(C);
        pg8::Gemm g{(const pg8::bf16_t*)(C.ws + WS_ACT), (const pg8::bf16_t*)(C.ws + WS_WDN + (size_t)32 * 1024 * D), MAXROWS, 32 * 1024, D};
        pg8::MoeOrder<4> S{(const LAS int*)(C.lds + BLK_OFF) + BL_TILE, nt, (int)blockIdx.x, C.G};
        pg8::EpiDown8 E{(pg8::bf16_t*)(C.ws + WS_Y), args.in[IN_BDN] + 32 * 1024};
        pg8::gemm_phase<pg8::EpiDown8, pg8::MoeOrder<4>, true, true, 1>(C.lds + RING_OFF, g, S, E);
        } SEAM(17);
    }
    if (IN(18)) { FRESH(); r3_final(C, args, args.out); }
#undef IN
#undef SEAM
}

extern "C" void kernel_launch(void* const* d_in, const int* in_sizes, int n_in, void* d_out, int out_size, void* d_ws, size_t ws_size, hipStream_t stream) {
    static int grid = 0;
    if (grid == 0) {
        if (n_in != 21 || in_sizes[0] != T * D || out_size != T * D || ws_size < WS_END) { fprintf(stderr, "kernel_launch: unexpected shapes (n_in %d, in0 %d, out %d, ws %zu)\n", n_in, n_in > 0 ? in_sizes[0] : -1, out_size, ws_size); grid = -1; return; }
        int dev = 0, cus = 0, per_cu = 0;
        if (hipGetDevice(&dev) != hipSuccess || hipDeviceGetAttribute(&cus, hipDeviceAttributeMultiprocessorCount, dev) != hipSuccess) { grid = -1; return; }
        if (hipFuncSetAttribute((const void*)yoco_fwd, hipFuncAttributeMaxDynamicSharedMemorySize, LDS_BYTES) != hipSuccess) { fprintf(stderr, "kernel_launch: hipFuncSetAttribute failed\n"); grid = -1; return; }
        if (hipOccupancyMaxActiveBlocksPerMultiprocessor(&per_cu, (const void*)yoco_fwd, NWAVES * 64, LDS_BYTES) != hipSuccess || per_cu < 1) { fprintf(stderr, "kernel_launch: occupancy query reports %d blocks per CU\n", per_cu); }
        (void)hipGetLastError();
        grid = cus;
    }
    if (grid < 0) return;
    (void)hipMemsetAsync((char*)d_ws + WS_CTL, 0, CTL_ZERO_BYTES, stream);
    Args a{};
    for (int i = 0; i < 21; ++i) a.in[i] = (const float*)d_in[i];
    a.out = (float*)d_out; a.ws = (unsigned char*)d_ws;
#if MK_ONE_LAUNCH
    a.ph_lo = 0; a.ph_hi = N_PHASES;
    hipLaunchKernelGGL(yoco_fwd, dim3(grid), dim3(NWAVES * 64), LDS_BYTES, stream, a);
#else
    for (int p = 0; p < N_PHASES; ++p) { a.ph_lo = p; a.ph_hi = p + 1; hipLaunchKernelGGL(yoco_fwd, dim3(grid), dim3(NWAVES * 64), LDS_BYTES, stream, a); }
#endif
}
```

```cpp
#include <hip/hip_runtime.h>
#include <hip/hip_bf16.h>
#include <cstdio>
#include <cstdint>
#include <cmath>
#ifndef MK_ONE_LAUNCH
#define MK_ONE_LAUNCH 1
#endif
#ifndef PROBE_DUP
#define PROBE_DUP 0
#endif
#ifndef PG8_F8_SCALED
#define PG8_F8_SCALED 0
#endif
#ifndef QKV_FP8
#define QKV_FP8 1
#endif
#ifndef KVQ_FP8
#define KVQ_FP8 1
#endif
#ifndef PROBE_EPI
#define PROBE_EPI 0
#endif
#ifndef PROBE_FOX
#define PROBE_FOX 0
#endif
#ifndef PROBE_SANITIZE
#define PROBE_SANITIZE 0
#endif
#ifndef PROBE_BAND
#define PROBE_BAND 0
#endif
#ifndef Y_FP8
#define Y_FP8 1
#endif
#ifndef WO_FP8
#define WO_FP8 1
#endif
#ifndef MOE_GATHER
#define MOE_GATHER 1
#endif
#ifndef PROBE_QKV
#define PROBE_QKV 0
#endif
#ifndef PROBE_GU
#define PROBE_GU 0
#endif
#ifndef STAGGER_QKV
#define STAGGER_QKV 0
#endif
#ifndef NT_STORE
#define NT_STORE 0
#endif
#ifndef RELAX_STORES
#define RELAX_STORES 0
#endif
#ifndef PROBE_LATE_QKV
#define PROBE_LATE_QKV 0
#endif
#ifndef NT_P0
#define NT_P0 1
#endif
namespace pg8 {
#define PG8_LAS __attribute__((address_space(3)))
typedef unsigned short bf16_t;
typedef short bf16x8 __attribute__((ext_vector_type(8)));
typedef float f32x4 __attribute__((ext_vector_type(4)));
typedef unsigned u32x4 __attribute__((ext_vector_type(4)));
constexpr int BM = 256, BK = 64, HALF = 128, HTB = HALF * BK * 2  , STAGE_BYTES = 8 * HTB, NXCD = 8, WGM = 8;

__host__ __device__ __forceinline__ int lds_byte(int r, int c) { const int st = (r >> 4) * 2 + (c >> 5), rr = r & 15, cc = c & 31, ob = rr * 64 + cc * 2; return st * 1024 + (ob ^ (((ob >> 9) & 1) << 5)); }
__host__ __device__ __forceinline__ void stage_rc(int b, int& R, int& C) { const int st = b / 1024, sb = b % 1024, swz = sb ^ (((sb >> 9) & 1) << 5); R = (st >> 1) * 16 + swz / 64; C = (st & 1) * 32 + (swz % 64) / 2; }
__host__ __device__ __forceinline__ int perm32(int rho) { const int n = rho >> 4, i = rho & 15; return 8 * (i >> 2) + 4 * n + (i & 3); }

struct Unit { int pm, pn; };
struct Gemm { const bf16_t* A; const bf16_t* Bt; int M, N, K; const int* rows = nullptr; };

struct StaticOrder {
    int nM, nN, nwg, G, c;
    __host__ __device__ void init(int M, int N, int G_, int c_) { nM = M / BM; nN = N / BM; nwg = nM * nN; G = G_; c = c_; }
    __host__ __device__ bool next(int i, Unit& u) const {
        const long L = (long)i * G + c; if (L >= nwg) return false;
        int wgid = (int)L; { const int q = nwg / NXCD, r = nwg % NXCD, xcd = wgid % NXCD, off = wgid / NXCD; wgid = (xcd < r ? xcd * (q + 1) : r * (q + 1) + (xcd - r) * q) + off; }
        const int nig = WGM * nN, gid = wgid / nig, fm = gid * WGM, gsz = (nM - fm) < WGM ? (nM - fm) : WGM;
        u.pm = fm + ((wgid % nig) % gsz); u.pn = (wgid % nig) / gsz; return true;
    }
    __device__ __forceinline__ void a_ready(const Unit&) const {}
    __device__ __forceinline__ void done(const Unit&) const {}
};
__device__ __forceinline__ unsigned cvt_pk_bf16(float lo, float hi) { unsigned r; asm volatile("v_cvt_pk_bf16_f32 %0, %1, %2" : "=v"(r) : "v"(lo), "v"(hi)); return r; }
typedef float f32x2 __attribute__((ext_vector_type(2)));
typedef int i32x8 __attribute__((ext_vector_type(8))); typedef int i32x4p __attribute__((ext_vector_type(4)));
#ifndef PG8_F8_SCALE
#define PG8_F8_SCALE 0x7f7f7f7f
#endif
__device__ __forceinline__ i32x8 pg8_cat(bf16x8 lo, bf16x8 hi) { const i32x4p a = __builtin_bit_cast(i32x4p, lo), b = __builtin_bit_cast(i32x4p, hi); return (i32x8){a.x, a.y, a.z, a.w, b.x, b.y, b.z, b.w}; }
#if PG8_F8_SCALED
__device__ __forceinline__ void pg8_mma8(f32x4& acc, i32x8 b, i32x8 a) { asm volatile("v_mfma_scale_f32_16x16x128_f8f6f4 %0, %1, %2, %0, %3, %3 op_sel_hi:[0,0,0]" : "+v"(acc) : "v"(b), "v"(a), "v"(0x7f7f7f7f)); }
#else
__device__ __forceinline__ void pg8_mma8(f32x4& acc, i32x8 b, i32x8 a) { asm volatile("v_mfma_f32_16x16x128_f8f6f4 %0, %1, %2, %0" : "+v"(acc) : "v"(b), "v"(a)); }
#endif
__device__ __forceinline__ void pg8_mma16(f32x4& acc, bf16x8 b, bf16x8 a) { asm volatile("v_mfma_f32_16x16x32_bf16 %0, %1, %2, %0" : "+v"(acc) : "v"(b), "v"(a)); }
template <class Epi, class Sched, bool ALIGN_EPI = false, bool SP2 = false, int ES = 2  , bool GATHER = false  >
__device__ __forceinline__ void gemm_phase(PG8_LAS unsigned char* lds, const Gemm g, const Sched& S, const Epi& E) {
    const int tid = threadIdx.x, wid = __builtin_amdgcn_readfirstlane(tid >> 6), lane = tid & 63, wr = wid >> 2, wc = wid & 3, fr = lane & 15, fq = lane >> 4;
    const int K = g.K * ES / 2  , nt = K / BK;
    unsigned voffA[2], voffB[2];
#pragma unroll
    for (int i = 0; i < 2; ++i) { int R, C; stage_rc(tid * 16 + i * 8192, R, C); const int Rb = Epi::PERM ? ((R & ~31) + perm32(R & 31)) : R;
        voffA[i] = (unsigned)(R * K + C) * 2u; voffB[i] = (unsigned)(Rb * K + C) * 2u; }
    const size_t kstep = (size_t)(BK * 2);
    const size_t hstep = (size_t)HALF * K * 2;
    const size_t tstep = 2 * hstep;
    const size_t hstepA = GATHER ? 0 : hstep;
    unsigned cG0[2] = {voffA[0], voffA[1]}, cG1[2] = {voffA[0], voffA[1]}, nG0[2] = {voffA[0], voffA[1]}, nG1[2] = {voffA[0], voffA[1]};
#define PG8_GROWS(G0, G1, PM) do { if constexpr (GATHER) { _Pragma("unroll") for (int i_ = 0; i_ < 2; ++i_) { int R_, C_; stage_rc(tid * 16 + i_ * 8192, R_, C_); \
        const int* rp_ = g.rows + (size_t)(PM) * 256 + R_; G0[i_] = (unsigned)rp_[0] * (unsigned)(K * 2) + (unsigned)(C_ * 2); G1[i_] = (unsigned)rp_[128] * (unsigned)(K * 2) + (unsigned)(C_ * 2); } } } while (0)
    const unsigned ldsw = (unsigned)wid * 1024u;
    const int aoff = lds_byte(wr * 64 + fr, fq * 8), boff = lds_byte(wc * 32 + fr, fq * 8);
#define PG8_SA(b, h) (((b) * 2 + (h)) * HTB)
#define PG8_SB(b, h) ((4 + (b) * 2 + (h)) * HTB)
#define PG8_STAGE(bufoff, gbase, voff) do { _Pragma("unroll") for (int _i = 0; _i < 2; ++_i) \
        __builtin_amdgcn_global_load_lds((const unsigned*)((const char*)(gbase) + (voff)[_i]), (PG8_LAS unsigned*)(lds + (bufoff) + ldsw + _i * 8192), 16, 0, 0); } while (0)
#define PG8_LDA(dst, b, h) do { _Pragma("unroll") for (int m = 0; m < 4; ++m) _Pragma("unroll") for (int k = 0; k < 2; ++k) dst[m][k] = *(const PG8_LAS bf16x8*)(lds + PG8_SA(b, h) + aoff + m * 2048 + k * 1024); } while (0)
#define PG8_LDB(dst, b, h) do { _Pragma("unroll") for (int n = 0; n < 2; ++n) _Pragma("unroll") for (int k = 0; k < 2; ++k) dst[n][k] = *(const PG8_LAS bf16x8*)(lds + PG8_SB(b, h) + boff + n * 2048 + k * 1024); } while (0)
#define PG8_MMA(ai, bj, At, Bt) do { __builtin_amdgcn_s_setprio(1); _Pragma("unroll") for (int m = 0; m < 4; ++m) _Pragma("unroll") for (int n = 0; n < 2; ++n) { \
        if constexpr (ES == 2) { _Pragma("unroll") for (int k = 0; k < 2; ++k) acc[ai][bj][m][n] = __builtin_amdgcn_mfma_f32_16x16x32_bf16(Bt[n][k], At[m][k], acc[ai][bj][m][n], 0, 0, 0); } \
        else { pg8_mma8(acc[ai][bj][m][n], pg8_cat(Bt[n][0], Bt[n][1]), pg8_cat(At[m][0], At[m][1])); } } \
        __builtin_amdgcn_s_setprio(0); } while (0)
#define PG8_WAIT_V(n) asm volatile("s_waitcnt vmcnt(" #n ")" ::: "memory")
#define PG8_WAIT_L(n) asm volatile("s_waitcnt lgkmcnt(" #n ")" ::: "memory")
#define PG8_WAIT_V8R do { if (relax_st) { if constexpr (Epi::NSTORE == 16) asm volatile("s_waitcnt vmcnt(24)" ::: "memory"); else if constexpr (Epi::NSTORE == 8) asm volatile("s_waitcnt vmcnt(16)" ::: "memory"); else asm volatile("s_waitcnt vmcnt(8)" ::: "memory"); } \
        else asm volatile("s_waitcnt vmcnt(8)" ::: "memory"); } while (0)
#define PG8_BAR __builtin_amdgcn_s_barrier()
#define PG8_SCHED __builtin_amdgcn_sched_barrier(0)
    Unit cur, nxt; int ui = 0;
    if (!S.next(0, cur)) return;
    f32x4 acc[2][2][4][2];
#pragma unroll
    for (int a = 0; a < 2; ++a)
#pragma unroll
        for (int b = 0; b < 2; ++b)
#pragma unroll
            for (int m = 0; m < 4; ++m)
#pragma unroll
                for (int n = 0; n < 2; ++n) acc[a][b][m][n] = (f32x4){0.f, 0.f, 0.f, 0.f};
    bf16x8 At[4][2], B0[2][2], B1[2][2];
    const char* cA = (const char*)g.A + (GATHER ? (size_t)0 : (size_t)cur.pm * tstep); const char* cB = (const char*)g.Bt + (size_t)cur.pn * tstep;
    PG8_GROWS(cG0, cG1, cur.pm);
    S.a_ready(cur);
    if constexpr (SP2) {
        PG8_STAGE(PG8_SB(0, 0), cB, voffB); PG8_STAGE(PG8_SB(0, 1), cB + hstep, voffB); PG8_STAGE(PG8_SA(0, 0), cA, cG0); PG8_STAGE(PG8_SA(0, 1), cA + hstepA, cG1);
        if (wr == 1) PG8_BAR;
        PG8_WAIT_V(2); PG8_BAR;
        PG8_STAGE(PG8_SB(1, 0), cB + kstep, voffB); PG8_STAGE(PG8_SA(1, 0), cA + kstep, cG0); PG8_STAGE(PG8_SB(1, 1), cB + hstep + kstep, voffB);
        PG8_WAIT_V(6); PG8_BAR;
    } else {
        PG8_STAGE(PG8_SB(0, 0), cB, voffB); PG8_STAGE(PG8_SA(0, 0), cA, cG0); PG8_STAGE(PG8_SB(0, 1), cB + hstep, voffB); PG8_STAGE(PG8_SA(0, 1), cA + hstepA, cG1);
        if (wr == 1) PG8_BAR;
        PG8_WAIT_V(4); PG8_BAR;
        PG8_STAGE(PG8_SB(1, 0), cB + kstep, voffB); PG8_STAGE(PG8_SA(1, 0), cA + kstep, cG0); PG8_STAGE(PG8_SB(1, 1), cB + hstep + kstep, voffB);
        PG8_WAIT_V(6); PG8_BAR;
    }
    for (;;) {
        const bool has_next = S.next(ui + 1, nxt);
        const char* nA = (has_next && !GATHER) ? (const char*)g.A + (size_t)nxt.pm * tstep : cA; const char* nB = has_next ? (const char*)g.Bt + (size_t)nxt.pn * tstep : cB;
        if (has_next) PG8_GROWS(nG0, nG1, nxt.pm); else { nG0[0] = cG0[0]; nG0[1] = cG0[1]; nG1[0] = cG1[0]; nG1[1] = cG1[1]; }
#pragma unroll 1
        for (int t = 0; t < nt; t += 2) {
            const bool last = (t == nt - 2);
            const bool relax_st = RELAX_STORES && (t == 0) && (ui > 0);
            const char* a1 = cA + (size_t)(t + 1) * kstep;
            const char* a2 = last ? nA : cA + (size_t)(t + 2) * kstep; const char* b2 = last ? nB : cB + (size_t)(t + 2) * kstep;
            const char* a3 = a2 + kstep; const char* b3 = b2 + kstep;
            if (last && has_next) S.a_ready(nxt);
            const unsigned s0[2] = {last ? nG0[0] : cG0[0], last ? nG0[1] : cG0[1]}, s1[2] = {last ? nG1[0] : cG1[0], last ? nG1[1] : cG1[1]};
            if constexpr (SP2) {
            PG8_LDB(B0, 0, 0); PG8_LDB(B1, 0, 1); PG8_SCHED; PG8_LDA(At, 0, 0); PG8_STAGE(PG8_SA(1, 1), a1 + hstepA, cG1);
            PG8_WAIT_V8R; PG8_WAIT_L(0); PG8_BAR; PG8_MMA(0, 0, At, B0); PG8_MMA(0, 1, At, B1); PG8_BAR; PG8_SCHED;
            PG8_LDA(At, 0, 1); PG8_STAGE(PG8_SB(0, 0), b2, voffB); PG8_STAGE(PG8_SB(0, 1), b2 + hstep, voffB); PG8_STAGE(PG8_SA(0, 0), a2, s0);
            PG8_WAIT_V8R; PG8_WAIT_L(0); PG8_BAR; PG8_MMA(1, 0, At, B0); PG8_MMA(1, 1, At, B1); PG8_BAR; PG8_SCHED;
            PG8_LDB(B0, 1, 0); PG8_LDB(B1, 1, 1); PG8_SCHED; PG8_LDA(At, 1, 0); PG8_STAGE(PG8_SA(0, 1), a2 + hstepA, s1);
            PG8_WAIT_V(8); PG8_WAIT_L(0); PG8_BAR; PG8_MMA(0, 0, At, B0); PG8_MMA(0, 1, At, B1); PG8_BAR; PG8_SCHED;
            PG8_LDA(At, 1, 1); PG8_STAGE(PG8_SB(1, 0), b3, voffB); PG8_STAGE(PG8_SB(1, 1), b3 + hstep, voffB); PG8_STAGE(PG8_SA(1, 0), a3, s0);
            PG8_WAIT_V(8); PG8_WAIT_L(0); PG8_BAR; PG8_MMA(1, 0, At, B0); PG8_MMA(1, 1, At, B1); PG8_BAR; PG8_SCHED;
            } else {
            PG8_LDB(B0, 0, 0); PG8_SCHED; PG8_LDA(At, 0, 0); PG8_STAGE(PG8_SA(1, 1), a1 + hstepA, cG1);
            PG8_WAIT_L(8); PG8_BAR; PG8_WAIT_L(0); PG8_MMA(0, 0, At, B0); PG8_BAR; PG8_SCHED;
            PG8_LDB(B1, 0, 1); PG8_STAGE(PG8_SB(0, 0), b2, voffB);
            PG8_BAR; PG8_WAIT_L(0); PG8_MMA(0, 1, At, B1); PG8_BAR;
            PG8_LDA(At, 0, 1); PG8_STAGE(PG8_SA(0, 0), a2, s0);
            PG8_BAR; PG8_WAIT_L(0); PG8_MMA(1, 0, At, B0); PG8_BAR; PG8_SCHED;
            PG8_STAGE(PG8_SB(0, 1), b2 + hstep, voffB);
            PG8_WAIT_V(6); PG8_BAR; PG8_MMA(1, 1, At, B1); PG8_BAR;
            PG8_LDB(B0, 1, 0); PG8_SCHED; PG8_LDA(At, 1, 0); PG8_STAGE(PG8_SA(0, 1), a2 + hstepA, s1);
            PG8_WAIT_L(8); PG8_BAR; PG8_WAIT_L(0); PG8_MMA(0, 0, At, B0); PG8_BAR; PG8_SCHED;
            PG8_LDB(B1, 1, 1); PG8_STAGE(PG8_SB(1, 0), b3, voffB);
            PG8_BAR; PG8_WAIT_L(0); PG8_MMA(0, 1, At, B1); PG8_BAR;
            PG8_LDA(At, 1, 1); PG8_STAGE(PG8_SA(1, 0), a3, s0);
            PG8_BAR; PG8_WAIT_L(0); PG8_MMA(1, 0, At, B0); PG8_BAR; PG8_SCHED;
            PG8_STAGE(PG8_SB(1, 1), b3 + hstep, voffB);
            PG8_WAIT_V(6); PG8_BAR; PG8_MMA(1, 1, At, B1); PG8_BAR;
            }
        }
        if constexpr (ES == 1) asm volatile("s_nop 15\n\ts_nop 15" ::: "memory");
        if constexpr (ALIGN_EPI) { if (wr == 0) PG8_BAR; }
        if constexpr (!Epi::AFTER_DRAIN) { E(acc, cur, wr, wc, fr, fq); S.done(cur); }
        if (!has_next) break;
#pragma unroll
        for (int a = 0; a < 2; ++a)
#pragma unroll
            for (int b = 0; b < 2; ++b)
#pragma unroll
                for (int m = 0; m < 4; ++m)
#pragma unroll
                    for (int n = 0; n < 2; ++n) acc[a][b][m][n] = (f32x4){0.f, 0.f, 0.f, 0.f};
        cur = nxt; cA = nA; cB = nB; ++ui; cG0[0] = nG0[0]; cG0[1] = nG0[1]; cG1[0] = nG1[0]; cG1[1] = nG1[1];
        if constexpr (ALIGN_EPI) { if (wr == 1) PG8_BAR; }
    }
    PG8_WAIT_V(0);
    if constexpr (!ALIGN_EPI) { if (wr == 0) PG8_BAR; }
    PG8_BAR;
    if constexpr (Epi::AFTER_DRAIN) { E.fused(acc, cur, wr, wc, fr, fq, lds, wid, lane); S.done(cur); }
#undef PG8_GROWS
#undef PG8_SA
#undef PG8_SB
#undef PG8_STAGE
#undef PG8_LDA
#undef PG8_LDB
#undef PG8_MMA
#undef PG8_WAIT_V
#undef PG8_WAIT_L
#undef PG8_WAIT_V8R
#undef PG8_BAR
#undef PG8_SCHED
}
}
namespace attn_body {
using bf16=__hip_bfloat16;
using bf16x8=__attribute__((ext_vector_type(8)))short;
using s16x4=__attribute__((ext_vector_type(4)))short;
using f32x16=__attribute__((ext_vector_type(16)))float;
using u32x4=__attribute__((ext_vector_type(4)))unsigned;
__device__ __forceinline__ int crow(int r,int hi){return (r&3)+8*(r>>2)+4*hi;}
#define SBAR() __builtin_amdgcn_sched_barrier(0)
__device__ __forceinline__ void glds16(const void*gsrc,unsigned lds_dst){unsigned keep;
  asm volatile("s_mov_b32 %0, m0\n\ts_mov_b32 m0, %2\n\ts_nop 0\n\tglobal_load_lds_dwordx4 %1, off\n\ts_mov_b32 m0, %0":"=&s"(keep):"v"(gsrc),"s"(lds_dst):"memory");}
__device__ __forceinline__ float max3f(float a,float b,float c){float r;asm("v_max3_f32 %0, %1, %2, %3":"=v"(r):"v"(a),"v"(b),"v"(c));return r;}
__device__ __forceinline__ float max2f(float a,float b){float r;asm("v_max_f32_e32 %0, %1, %2":"=v"(r):"v"(a),"v"(b));return r;}
__device__ __forceinline__ float fadd_s(float a,float b){float r;asm("v_add_f32_e32 %0, %1, %2":"=v"(r):"v"(a),"v"(b));return r;}
__device__ __forceinline__ float fsub_s(float a,float b){float r;asm("v_sub_f32_e32 %0, %1, %2":"=v"(r):"v"(a),"v"(b));return r;}
typedef float f32x2_t __attribute__((ext_vector_type(2))); typedef __bf16 bf16x2_t __attribute__((ext_vector_type(2)));
__device__ __forceinline__ unsigned cvtpk_s(float lo,float hi){f32x2_t v={lo,hi};bf16x2_t b=__builtin_convertvector(v,bf16x2_t);return __builtin_bit_cast(unsigned,b);}
#define WAIT_BAR(N) asm volatile("s_waitcnt vmcnt(" #N ") lgkmcnt(0)\n\ts_barrier":::"memory")
typedef __attribute__((address_space(3))) const char* lds_cptr;
typedef short v4i16_t __attribute__((ext_vector_type(4)));
__device__ __forceinline__ void kload8(bf16x8*kf,lds_cptr kp){
  kf[0]=*(const __attribute__((address_space(3))) bf16x8*)(kp);      kf[1]=*(const __attribute__((address_space(3))) bf16x8*)(kp+512);
  kf[2]=*(const __attribute__((address_space(3))) bf16x8*)(kp+2048); kf[3]=*(const __attribute__((address_space(3))) bf16x8*)(kp+2560);
  kf[4]=*(const __attribute__((address_space(3))) bf16x8*)(kp+4096); kf[5]=*(const __attribute__((address_space(3))) bf16x8*)(kp+4608);
  kf[6]=*(const __attribute__((address_space(3))) bf16x8*)(kp+6144); kf[7]=*(const __attribute__((address_space(3))) bf16x8*)(kp+6656);
}
__device__ __forceinline__ void kload2(bf16x8*kf,lds_cptr kp,int j){ kf[2*j]=*(const __attribute__((address_space(3))) bf16x8*)(kp+j*2048); kf[2*j+1]=*(const __attribute__((address_space(3))) bf16x8*)(kp+j*2048+512); }
__device__ __forceinline__ s16x4 vtr(lds_cptr p){ return __builtin_bit_cast(s16x4,__builtin_amdgcn_ds_read_tr16_b64_v4i16((__attribute__((address_space(3))) v4i16_t*)p)); }
__device__ __forceinline__ float rowmax(const f32x16&p0,const f32x16&p1){
  float a=max3f(p0[0],p0[1],p1[0]),b=max3f(p0[2],p0[3],p1[1]);a=max3f(a,p1[2],p1[3]);
  #pragma unroll
  for(int r=4;r<16;r+=4){a=max3f(a,p0[r],p0[r+1]);b=max3f(b,p0[r+2],p0[r+3]);a=max3f(a,p1[r],p1[r+1]);b=max3f(b,p1[r+2],p1[r+3]);}
  const float m=max2f(a,b);
  auto rr=__builtin_amdgcn_permlane32_swap(__float_as_uint(m),__float_as_uint(m),false,false);
  return max2f(__uint_as_float(rr[0]),__uint_as_float(rr[1]));
}
__device__ __forceinline__ void pv(f32x16*o,int vb,bf16x8 pa0,bf16x8 pa1,bf16x8 pa2,bf16x8 pa3){
  #pragma unroll
  for(int d0=0;d0<2;++d0){s16x4 lo[4],hi[4];
    #pragma unroll
    for(int ks=0;ks<4;++ks){
      asm volatile("ds_read_b64_tr_b16 %0,%1 offset:%c2":"=&v"(lo[ks]):"v"(vb),"i"(d0*4096+ks*1024):"memory");
      asm volatile("ds_read_b64_tr_b16 %0,%1 offset:%c2":"=&v"(hi[ks]):"v"(vb),"i"(d0*4096+ks*1024+512):"memory");}
    asm volatile("s_waitcnt lgkmcnt(0)":::"memory");SBAR();
    #define PK(k) (bf16x8){lo[k][0],lo[k][1],lo[k][2],lo[k][3],hi[k][0],hi[k][1],hi[k][2],hi[k][3]}
    o[d0]=__builtin_amdgcn_mfma_f32_32x32x16_bf16(pa0,PK(0),o[d0],0,0,0);
    o[d0]=__builtin_amdgcn_mfma_f32_32x32x16_bf16(pa1,PK(1),o[d0],0,0,0);
    o[d0]=__builtin_amdgcn_mfma_f32_32x32x16_bf16(pa2,PK(2),o[d0],0,0,0);
    o[d0]=__builtin_amdgcn_mfma_f32_32x32x16_bf16(pa3,PK(3),o[d0],0,0,0);
    #undef PK
  }
}
}

constexpr int BATCH = 8, SEQ = 4096, T = BATCH * SEQ, D = 1024, NE = 32, TOPK = 4, NH = 16, HD = 64;
constexpr int NQKV = 9216;
constexpr int MAXROWS = T * TOPK + NE * 256;
constexpr int MAXTILES = MAXROWS / 256;
constexpr int NVB = T / 128;
constexpr float LOG2E = 1.4426950408889634f;
constexpr float QSCALE = 0.125f * LOG2E;
constexpr float RMS_EPS = 1e-6f;
constexpr int NWAVES = 8;

constexpr size_t MiB = 1ull << 20;
constexpr size_t WS_CTL = 0, CTL_ZERO_BYTES = 1 * MiB;
constexpr size_t WS_SM = 1 * MiB;
constexpr size_t SM_ADA = WS_SM;
constexpr size_t SM_GM = WS_SM + 512 * 1024;
constexpr size_t SM_CSH = WS_SM + 640 * 1024;
constexpr size_t SM_BIAST = WS_SM + 644 * 1024;
constexpr size_t SM_BLKCNT = WS_SM + 704 * 1024;
constexpr size_t SM_TILEEXP = WS_SM + 768 * 1024;
constexpr size_t SM_TOPI = WS_SM + 1 * MiB;
constexpr size_t SM_TOPG = SM_TOPI + 512 * 1024;
constexpr size_t SM_RANK = SM_TOPG + 512 * 1024;
constexpr size_t SM_SLOT = SM_RANK + 512 * 1024;
constexpr size_t SM_TOKSLOT = WS_SM + 3 * MiB;
constexpr size_t SM_LOGF = WS_SM + 4 * MiB;
constexpr size_t SM_FCUM = WS_SM + 6 * MiB;
constexpr size_t SM_LSE = WS_SM + 8 * MiB;
constexpr size_t WS_WQKV = 16 * MiB, WS_WO0 = 34 * MiB, WS_WKV = 36 * MiB, WS_WQ = 40 * MiB, WS_WO1 = 42 * MiB, WS_WGU = 44 * MiB, WS_WDN = 300 * MiB;
constexpr size_t WS_HKV = 428 * MiB, WS_H = 492 * MiB, WS_OG = 556 * MiB, WS_O = 748 * MiB;
constexpr size_t WS_QKV0 = 812 * MiB, WS_ACT = 812 * MiB, WS_Y = 1084 * MiB, WS_QKV1 = 1388 * MiB, WS_XB = 1388 * MiB, WS_H8 = 1524 * MiB, WS_END = 1660 * MiB, WS_XS = WS_H;
static_assert(WS_H == WS_HKV + (size_t)T * D * 2, "H must follow HKV (KVQ GEMM addresses both through one A pointer)");
static_assert(WS_WQ == WS_WKV + (size_t)2048 * 1024 * 2, "Wq_t must follow Wkv_t");
static_assert(SM_LSE + (size_t)3 * T * 16 * 4 <= WS_WQKV, "small region");
static_assert(WS_Y + (size_t)MAXROWS * D * 2 <= WS_QKV1 && WS_XB + (size_t)MAXROWS * D * 2 <= WS_END && WS_QKV0 + (size_t)BATCH * 9 * 16 * SEQ * 64 * 2 <= WS_QKV1, "ws map");
constexpr int CW_TMO = 0, CW_BAR = 4096, CW_QUEUE = 65536  , CW_NRM = 131072  ;

constexpr int RING_OFF = 0, RING_BYTES = 131072;
constexpr int SCR_OFF = RING_BYTES, SCR_BYTES = 16384;
constexpr int BLK_OFF = SCR_OFF + SCR_BYTES, BLK_BYTES = 12288;
constexpr int MISC_OFF = BLK_OFF + BLK_BYTES;
constexpr int LDS_BYTES = MISC_OFF + 256;
constexpr int BL_TILE = 0, BL_WCNT = 576, BL_WBASE = 832, BL_PARTA = 1088, BL_PARTB = 1600, BL_TOT = 2112, BL_BASE = 2144, BL_PADS = 2176;

#define LAS __attribute__((address_space(3)))
#define GAS __attribute__((address_space(1)))
typedef unsigned short bf16;
typedef float f32x4 __attribute__((ext_vector_type(4)));
typedef unsigned u32x4v __attribute__((ext_vector_type(4)));
typedef unsigned u32x2v __attribute__((ext_vector_type(2)));
typedef int i32x4v __attribute__((ext_vector_type(4)));
#define LDS_WAIT() asm volatile("s_waitcnt lgkmcnt(0)" ::: "memory")
#define VM_WAIT() asm volatile("s_waitcnt vmcnt(0)" ::: "memory")

__device__ __forceinline__ float bf2f(unsigned v) { return __uint_as_float(v << 16); }
__device__ __forceinline__ unsigned pkbf(float lo, float hi) { return attn_body::cvtpk_s(lo, hi); }
__device__ __forceinline__ float wave_sum(float v) {
#pragma unroll
    for (int o = 1; o < 64; o <<= 1) v += __shfl_xor(v, o);
    return v;
}

namespace pg8 {
struct EpiQKV0 {
    static constexpr bool PERM = true, AFTER_DRAIN = false; static constexpr int NSTORE = 16;
    bf16_t* O; float mul;
    __device__ __forceinline__ void operator()(const f32x4 (&acc)[2][2][4][2], const Unit& u, int wr, int wc, int fr, int fq) const {
        _Pragma("unroll") for (int rep_e = 0; rep_e < 1 + ((PROBE_EPI >> 0) & 1); ++rep_e) {
        asm volatile("" : "+v"(fr), "+v"(fq));
        const int g = u.pn / 12, rem = u.pn - g * 12, which = rem >> 2, h0 = (rem & 3) * 4, sh = 2 * g;
        const float sc = (which == 0 ? QSCALE : 1.f) * mul;
#pragma unroll
        for (int ai = 0; ai < 2; ++ai)
#pragma unroll
            for (int m = 0; m < 4; ++m) {
                const int tok = u.pm * BM + ai * HALF + wr * 64 + m * 16 + fr, b = tok >> 12, s = tok & 4095;
                const int subrow = (s & ((1 << sh) - 1)) * (4096 >> sh) + (s >> sh);
#pragma unroll
                for (int bj = 0; bj < 2; ++bj) {
                    const int head = h0 + 2 * bj + (wc >> 1), dcol = (wc & 1) * 32 + 8 * fq;
                    const size_t plane = (size_t)(((b * 3 + g) * 3 + which) * 16 + head);
                    const f32x4 v0 = acc[ai][bj][m][0] * sc, v1 = acc[ai][bj][m][1] * sc;
                    u32x4 w; w.x = cvt_pk_bf16(v0[0], v0[1]); w.y = cvt_pk_bf16(v0[2], v0[3]); w.z = cvt_pk_bf16(v1[0], v1[1]); w.w = cvt_pk_bf16(v1[2], v1[3]);
#if NT_STORE
                    __builtin_nontemporal_store(w, (u32x4*)(O + (plane * 4096 + subrow) * 64 + dcol));
#else
                    *(u32x4*)(O + (plane * 4096 + subrow) * 64 + dcol) = w;
#endif
                }
            }
        }
    }
};
struct EpiQKV0Probe {
    static constexpr bool PERM = true, AFTER_DRAIN = false; static constexpr int NSTORE = 16;
    bf16_t* O; float mul; int wide;
    __device__ __forceinline__ void operator()(const f32x4 (&acc)[2][2][4][2], const Unit& u, int wr, int wc, int fr, int fq) const {
        asm volatile("" : "+v"(fr), "+v"(fq));
        const int g = u.pn / 12, rem = u.pn - g * 12, which = rem >> 2, h0 = (rem & 3) * 4, sh = 2 * g;
        const float sc = (which == 0 ? QSCALE : 1.f) * mul;
#pragma unroll
        for (int ai = 0; ai < 2; ++ai)
#pragma unroll
            for (int m = 0; m < 4; ++m) {
                const int tok = u.pm * BM + ai * HALF + wr * 64 + m * 16 + fr, b = tok >> 12, s = tok & 4095;
                const int subrow = (s & ((1 << sh) - 1)) * (4096 >> sh) + (s >> sh);
                const int head = h0 + wc, dcol = 16 * fq;
                const size_t plane = (size_t)(((b * 3 + g) * 3 + which) * 16 + head);
#pragma unroll
                for (int bj = 0; bj < 2; ++bj) {
                    const f32x4 v0 = acc[ai][bj][m][0] * sc, v1 = acc[ai][bj][m][1] * sc;
                    u32x4 w; w.x = cvt_pk_bf16(v0[0], v0[1]); w.y = cvt_pk_bf16(v0[2], v0[3]); w.z = cvt_pk_bf16(v1[0], v1[1]); w.w = cvt_pk_bf16(v1[2], v1[3]);
                    if (wide == 4) { const size_t off_ = ((size_t)(u.pm * 36 + u.pn) * 131072 + (size_t)(wr * 4 + wc) * 16384 + (size_t)((ai * 4 + m) * 2 + bj) * 1024 + fr * 64 + fq * 16) & (size_t)0x7fffff;
                        *(u32x4*)((unsigned char*)O + off_) = w; }
                    else if (wide != 3 || m == 0) *(u32x4*)(O + (((plane * 4096 + subrow) * 64 + dcol + 8 * bj) & (size_t)(wide == 2 ? 0x3fffff : 0x7fffffffff)) ) = w; else if (w.x == 0x12345678u) O[0] = 1;
                }
            }
    }
};
struct EpiKVQ {
    static constexpr bool PERM = true, AFTER_DRAIN = false; static constexpr int NSTORE = 16;
    bf16_t* O; float mul; unsigned* nrm;
    __device__ __forceinline__ void operator()(const f32x4 (&acc)[2][2][4][2], const Unit& u, int wr, int wc, int fr, int fq) const {
        asm volatile("" : "+v"(fr), "+v"(fq));
        const int which = u.pn < 4 ? 1 : (u.pn < 8 ? 2 : 0), h0 = (u.pn & 3) * 4, pm = u.pm & 127;
        const float sc = (which == 0 ? QSCALE : 1.f) * mul;
        float nmax[2] = {0.f, 0.f};
#pragma unroll
        for (int ai = 0; ai < 2; ++ai)
#pragma unroll
            for (int m = 0; m < 4; ++m) {
                const int tok = pm * BM + ai * HALF + wr * 64 + m * 16 + fr, b = tok >> 12, s = tok & 4095;
#pragma unroll
                for (int bj = 0; bj < 2; ++bj) {
                    const int head = h0 + 2 * bj + (wc >> 1), dcol = (wc & 1) * 32 + 8 * fq;
                    const size_t plane = (size_t)((b * 3 + which) * 16 + head);
                    const f32x4 v0 = acc[ai][bj][m][0] * sc, v1 = acc[ai][bj][m][1] * sc;
                    u32x4 w; w.x = cvt_pk_bf16(v0[0], v0[1]); w.y = cvt_pk_bf16(v0[2], v0[3]); w.z = cvt_pk_bf16(v1[0], v1[1]); w.w = cvt_pk_bf16(v1[2], v1[3]);
                    *(u32x4*)(O + (plane * 4096 + s) * 64 + dcol) = w;
                    if (which != 2) {
                        float ss = 0.f;
#pragma unroll
                        for (int k4 = 0; k4 < 4; ++k4) { const unsigned pw_ = k4 == 0 ? w.x : (k4 == 1 ? w.y : (k4 == 2 ? w.z : w.w)); const float lo_ = __uint_as_float(pw_ << 16), hi_ = __uint_as_float(pw_ & 0xffff0000u); ss += lo_ * lo_ + hi_ * hi_; }
                        ss += __shfl_xor(ss, 16); ss += __shfl_xor(ss, 32);
                        nmax[bj] = fmaxf(nmax[bj], ss);
                    }
                }
            }
        if (which != 2) {
#pragma unroll
            for (int bj = 0; bj < 2; ++bj) { float v = nmax[bj];
                v = fmaxf(v, __shfl_xor(v, 1)); v = fmaxf(v, __shfl_xor(v, 2)); v = fmaxf(v, __shfl_xor(v, 4)); v = fmaxf(v, __shfl_xor(v, 8));
                if (fr == 0 && fq == 0) { const int b0 = (pm * BM) >> 12, head = h0 + 2 * bj + (wc >> 1);
                    atomicMax(nrm + (((b0 * 2 + which) * 16 + head) * 2 + (wc & 1)), __float_as_uint(v)); } }
        }
    }
};
template <bool SRC_BF16> struct EpiResid {
    static constexpr bool PERM = true, AFTER_DRAIN = false; static constexpr int NSTORE = 16;
    const void* src; bf16_t* dst; const float* gate; float mul;
    __device__ __forceinline__ void operator()(const f32x4 (&acc)[2][2][4][2], const Unit& u, int wr, int wc, int fr, int fq) const {
        asm volatile("" : "+v"(fr), "+v"(fq));
#pragma unroll
        for (int ai = 0; ai < 2; ++ai)
#pragma unroll
            for (int m = 0; m < 4; ++m) {
                const int row = u.pm * BM + ai * HALF + wr * 64 + m * 16 + fr, b = row >> 12;
#pragma unroll
                for (int bj = 0; bj < 2; ++bj) {
                    const int col = u.pn * BM + bj * HALF + wc * 32 + 8 * fq;
                    f32x4 x0, x1;
                    if (SRC_BF16) { const u32x4 r = *(const u32x4*)((const bf16_t*)src + (size_t)row * D + col);
                        x0 = (f32x4){__uint_as_float(r.x << 16), __uint_as_float(r.x & 0xffff0000u), __uint_as_float(r.y << 16), __uint_as_float(r.y & 0xffff0000u)};
                        x1 = (f32x4){__uint_as_float(r.z << 16), __uint_as_float(r.z & 0xffff0000u), __uint_as_float(r.w << 16), __uint_as_float(r.w & 0xffff0000u)}; }
                    else { x0 = *(const f32x4*)((const float*)src + (size_t)row * D + col); x1 = *(const f32x4*)((const float*)src + (size_t)row * D + col + 4); }
                    const f32x4 g0 = *(const f32x4*)(gate + b * 6144 + col), g1 = *(const f32x4*)(gate + b * 6144 + col + 4);
                    const f32x4 v0 = x0 + (g0 * mul) * acc[ai][bj][m][0], v1 = x1 + (g1 * mul) * acc[ai][bj][m][1];
                    u32x4 w; w.x = cvt_pk_bf16(v0[0], v0[1]); w.y = cvt_pk_bf16(v0[2], v0[3]); w.z = cvt_pk_bf16(v1[0], v1[1]); w.w = cvt_pk_bf16(v1[2], v1[3]);
                    *(u32x4*)(dst + (size_t)row * D + col) = w;
                }
            }
    }
};
struct EpiSwiGLU {
    static constexpr bool PERM = true, AFTER_DRAIN = false; static constexpr int NSTORE = 0;
    bf16_t* ACT; const float* bgu;
    __device__ __forceinline__ void operator()(const f32x4 (&acc)[2][2][4][2], const Unit& u, int wr, int wc, int fr, int fq) const {
        const int e = u.pn >> 3, pnl = u.pn & 7, j0 = pnl * 128 + wc * 32 + 8 * fq;
        f32x4 bg[2], bu[2];
#pragma unroll
        for (int n = 0; n < 2; ++n) { bg[n] = *(const f32x4*)(bgu + e * 2048 + j0 + 4 * n); bu[n] = *(const f32x4*)(bgu + e * 2048 + 1024 + j0 + 4 * n); }
#pragma unroll
        for (int ai = 0; ai < 2; ++ai)
#pragma unroll
            for (int m = 0; m < 4; ++m) {
                const int row = u.pm * BM + ai * HALF + wr * 64 + m * 16 + fr;
                float a[8];
#pragma unroll
                for (int n = 0; n < 2; ++n) {
                    const f32x4 gv = acc[ai][0][m][n] + bg[n], uv = acc[ai][1][m][n] + bu[n];
#pragma unroll
                    for (int i = 0; i < 4; ++i) {
                        const float gg = fminf(gv[i], 7.f), uu = fminf(fmaxf(uv[i], -7.f), 7.f);
                        const float sg = __builtin_amdgcn_rcpf(1.f + __builtin_amdgcn_exp2f(-1.702f * LOG2E * gg));
                        a[4 * n + i] = (uu + 1.f) * gg * sg;
                    }
                }
                u32x4 w; w.x = cvt_pk_bf16(a[0], a[1]); w.y = cvt_pk_bf16(a[2], a[3]); w.z = cvt_pk_bf16(a[4], a[5]); w.w = cvt_pk_bf16(a[6], a[7]);
                *(u32x4*)(ACT + (size_t)row * D + j0) = w;
            }
    }
};
struct EpiDown {
    static constexpr bool PERM = true, AFTER_DRAIN = false; static constexpr int NSTORE = 0;
    bf16_t* Y; const float* bdn;
    __device__ __forceinline__ void operator()(const f32x4 (&acc)[2][2][4][2], const Unit& u, int wr, int wc, int fr, int fq) const {
        const int e = u.pn >> 2, pnl = u.pn & 3;
#pragma unroll
        for (int ai = 0; ai < 2; ++ai)
#pragma unroll
            for (int m = 0; m < 4; ++m) {
                const int row = u.pm * BM + ai * HALF + wr * 64 + m * 16 + fr;
#pragma unroll
                for (int bj = 0; bj < 2; ++bj) {
                    const int col = pnl * BM + bj * HALF + wc * 32 + 8 * fq;
                    const f32x4 b0 = *(const f32x4*)(bdn + e * 1024 + col), b1 = *(const f32x4*)(bdn + e * 1024 + col + 4);
                    const f32x4 v0 = acc[ai][bj][m][0] + b0, v1 = acc[ai][bj][m][1] + b1;
                    u32x4 w; w.x = cvt_pk_bf16(v0[0], v0[1]); w.y = cvt_pk_bf16(v0[2], v0[3]); w.z = cvt_pk_bf16(v1[0], v1[1]); w.w = cvt_pk_bf16(v1[2], v1[3]);
                    *(u32x4*)(Y + (size_t)row * D + col) = w;
                }
            }
    }
};
__device__ __forceinline__ unsigned pk4_fp8(float a, float b, float c, float d) { int v = __builtin_amdgcn_cvt_pk_fp8_f32(a, b, 0, false); v = __builtin_amdgcn_cvt_pk_fp8_f32(c, d, v, true); return (unsigned)v; }
struct EpiSwiGLU8 {
    static constexpr bool PERM = true, AFTER_DRAIN = false; static constexpr int NSTORE = 8;
    unsigned char* ACT; const float* bgu;
    __device__ __forceinline__ void operator()(const f32x4 (&acc)[2][2][4][2], const Unit& u, int wr, int wc, int fr, int fq) const {
        _Pragma("unroll") for (int rep_e = 0; rep_e < 1 + ((PROBE_EPI >> 1) & 1); ++rep_e) {
        asm volatile("" : "+v"(fr), "+v"(fq));
        const int e = u.pn >> 3, pnl = u.pn & 7, j0 = pnl * 128 + wc * 32 + 8 * fq;
        f32x4 bg[2], bu[2];
#pragma unroll
        for (int n = 0; n < 2; ++n) { bg[n] = *(const f32x4*)(bgu + e * 2048 + j0 + 4 * n) * 64.f; bu[n] = *(const f32x4*)(bgu + e * 2048 + 1024 + j0 + 4 * n) * 64.f + 64.f; }
#pragma unroll
        for (int ai = 0; ai < 2; ++ai)
#pragma unroll
            for (int m = 0; m < 4; ++m) {
                const int row = u.pm * BM + ai * HALF + wr * 64 + m * 16 + fr;
                float a[8];
#pragma unroll
                for (int n = 0; n < 2; ++n) {
                    const f32x4 gv = acc[ai][0][m][n] + bg[n], uv = acc[ai][1][m][n] + bu[n];
#pragma unroll
                    for (int i = 0; i < 4; ++i) {
                        const float gg = fminf(gv[i], 448.f), uu = fminf(fmaxf(uv[i], -384.f), 512.f);
                        const float t = __builtin_amdgcn_exp2f((-1.702f * LOG2E * 0.015625f) * gg);
                        const float sg = __builtin_amdgcn_rcpf(__builtin_fmaf(t, 4096.f, 4096.f));
                        a[4 * n + i] = (uu * gg) * sg;
                    }
                }
                typedef unsigned u32x2e __attribute__((ext_vector_type(2)));
                u32x2e w; w.x = pk4_fp8(a[0], a[1], a[2], a[3]); w.y = pk4_fp8(a[4], a[5], a[6], a[7]);
                *(u32x2e*)(ACT + (size_t)row * D + j0) = w;
            }
        }
    }
};
template <int VAR> struct EpiProbeGU {
    static constexpr bool PERM = true, AFTER_DRAIN = false; static constexpr int NSTORE = 0;
    unsigned char* ACT; const float* bgu;
    __device__ __forceinline__ void operator()(const f32x4 (&acc)[2][2][4][2], const Unit& u, int wr, int wc, int fr, int fq) const {
        if (VAR == 2) { if (acc[0][0][0][0][0] == 12345.678f) ACT[0] = 1; return; }
        asm volatile("" : "+v"(fr), "+v"(fq));
        const int pnl = u.pn & 7, j0 = pnl * 128 + wc * 32 + 8 * fq;
#pragma unroll
        for (int ai = 0; ai < 2; ++ai)
#pragma unroll
            for (int m = 0; m < 4; ++m) {
                const int row = u.pm * BM + ai * HALF + wr * 64 + m * 16 + fr;
                const f32x4 g0 = acc[ai][0][m][0] + acc[ai][1][m][0], g1 = acc[ai][0][m][1] + acc[ai][1][m][1];
                typedef unsigned u32x2e __attribute__((ext_vector_type(2)));
                u32x2e w; w.x = pk4_fp8(g0[0], g0[1], g0[2], g0[3]); w.y = pk4_fp8(g1[0], g1[1], g1[2], g1[3]);
                *(u32x2e*)(ACT + (size_t)row * D + j0) = w;
            }
    }
};
struct EpiNone { static constexpr bool PERM = true, AFTER_DRAIN = false; static constexpr int NSTORE = 0; unsigned char* P;
    __device__ __forceinline__ void operator()(const f32x4 (&acc)[2][2][4][2], const Unit& u, int wr, int wc, int fr, int fq) const { if (acc[0][0][0][0][0] == 12345.678f) P[0] = 1; } };
struct EpiDown8 {
    static constexpr bool PERM = true, AFTER_DRAIN = false; static constexpr int NSTORE = 16;
    bf16_t* Y; const float* bdn;
    __device__ __forceinline__ void operator()(const f32x4 (&acc)[2][2][4][2], const Unit& u, int wr, int wc, int fr, int fq) const {
        _Pragma("unroll") for (int rep_e = 0; rep_e < 1 + ((PROBE_EPI >> 2) & 1); ++rep_e) {
        asm volatile("" : "+v"(fr), "+v"(fq));
        const int e = u.pn >> 2, pnl = u.pn & 3;
#pragma unroll
        for (int ai = 0; ai < 2; ++ai)
#pragma unroll
            for (int m = 0; m < 4; ++m) {
                const int row = u.pm * BM + ai * HALF + wr * 64 + m * 16 + fr;
#pragma unroll
                for (int bj = 0; bj < 2; ++bj) {
                    const int col = pnl * BM + bj * HALF + wc * 32 + 8 * fq;
                    const f32x4 b0 = *(const f32x4*)(bdn + e * 1024 + col), b1 = *(const f32x4*)(bdn + e * 1024 + col + 4);
                    const f32x4 v0 = acc[ai][bj][m][0] * 0.015625f + b0, v1 = acc[ai][bj][m][1] * 0.015625f + b1;
                    if (Y_FP8) { typedef unsigned u32x2e __attribute__((ext_vector_type(2))); u32x2e w8; w8.x = pk4_fp8(v0[0], v0[1], v0[2], v0[3]); w8.y = pk4_fp8(v1[0], v1[1], v1[2], v1[3]);
                        *(u32x2e*)((unsigned char*)Y + (size_t)row * D + col) = w8; }
                    else { u32x4 w; w.x = cvt_pk_bf16(v0[0], v0[1]); w.y = cvt_pk_bf16(v0[2], v0[3]); w.z = cvt_pk_bf16(v1[0], v1[1]); w.w = cvt_pk_bf16(v1[2], v1[3]);
                        *(u32x4*)(Y + (size_t)row * D + col) = w; }
                }
            }
        }
    }
};
struct KVQOrder : StaticOrder {
    __device__ bool next(int i, Unit& u) const { if (!StaticOrder::next(i, u)) return false; if (u.pn >= 8) u.pm += 128; return true; }
};
template <int NN> struct MoeOrder {
    static constexpr int TR = 32 / NN;
    const LAS int* tile_exp; int n_tiles, c, G;
    __device__ __forceinline__ bool next(int i, Unit& u) const {
        int st, j;
        if (G == 256) { st = i * 8 + (c & 7); j = c >> 3; } else { const int L = i * G + c; st = L >> 5; j = L & 31; }
        const int tile = st * TR + (j % TR);
        if (tile >= n_tiles) return false;
        u.pm = tile; u.pn = tile_exp[tile] * NN + j / TR; return true;
    }
    __device__ __forceinline__ void a_ready(const Unit&) const {}
    __device__ __forceinline__ void done(const Unit&) const {}
};
struct MoeOrderProbe { const LAS int* tile_exp; int n_tiles, c, G;
    __device__ __forceinline__ bool next(int i, Unit& u) const { int st, j; if (G == 256) { st = i * 8 + (c & 7); j = c >> 3; } else { const int L = i * G + c; st = L >> 5; j = L & 31; }
        const int tile = st * 4 + (j % 4); if (tile >= n_tiles) return false; u.pm = tile; u.pn = j / 4; return true; }
    __device__ __forceinline__ void a_ready(const Unit&) const {}
    __device__ __forceinline__ void done(const Unit&) const {} };
}

namespace attn_body {
constexpr int KSLOT = 8192;
constexpr int L_K = 0, L_V = 2 * KSLOT, L_WS = 4 * KSLOT, L_OST = L_WS + 8 * 256, L_TAB = L_OST + 8 * 4096, L_ATT_END = L_TAB + 1024;
__device__ __forceinline__ void qkt2(f32x16& p0, f32x16& p1, const char* Kslot, const bf16x8* qr, const f32x16& c0, const f32x16& c1, int r32, int hi) {
  const char* kb = Kslot + hi * 1024 + r32 * 16;
  #pragma unroll
  for (int d0 = 0; d0 < 4; ++d0) {
    const bf16x8 b0 = *reinterpret_cast<const bf16x8*>(kb + d0 * 2048);
    const bf16x8 b1 = *reinterpret_cast<const bf16x8*>(kb + d0 * 2048 + 512);
    if (d0 == 0) { p0 = __builtin_amdgcn_mfma_f32_32x32x16_bf16(b0, qr[0], c0, 0, 0, 0); p1 = __builtin_amdgcn_mfma_f32_32x32x16_bf16(b1, qr[0], c1, 0, 0, 0); }
    else { p0 = __builtin_amdgcn_mfma_f32_32x32x16_bf16(b0, qr[d0], p0, 0, 0, 0); p1 = __builtin_amdgcn_mfma_f32_32x32x16_bf16(b1, qr[d0], p1, 0, 0, 0); } }
}
template <int MODE> __device__ __forceinline__ void attn_unit(const bf16* Qp, const bf16* __restrict__ Kp, const bf16* __restrict__ Vp, int q0, bf16* Ob, long ostride,
                                                               float* lse, long lstride, const float* __restrict__ F2, const float* __restrict__ tabg, char* shm) {
  const int tid = threadIdx.x, lane = tid & 63, r32 = lane & 31, hi = lane >> 5; const int wid = __builtin_amdgcn_readfirstlane(tid >> 6);
  const unsigned lds0 = (unsigned)(uintptr_t)shm;
  float* wsf = (float*)(shm + L_WS) + wid * 64;
  const int tq = q0 >> 6, t_hi = tq + 4;
  const int t_lo = (MODE == 0) ? (tq >= 2 ? tq - 2 : 0) : 0;
  const int w_hi = tq + (wid >> 1);
  const int w_lo = (MODE == 0) ? (w_hi >= 2 ? w_hi - 2 : 0) : 0;
  const bf16* ksrc = Kp + (long)lane * 64 + wid * 8;
  const bf16* vsrc = Vp + (long)(16 * (wid & 3) + (lane >> 2)) * 64 + (wid >> 2) * 32 + (lane & 3) * 8;
  const unsigned kdst = lds0 + L_K + wid * 1024, vdst = lds0 + L_V + wid * 1024;
  #define DMA_KV(t, slot) do { glds16(ksrc + (long)(t) * 4096, (unsigned)__builtin_amdgcn_readfirstlane(kdst + (slot) * KSLOT)); glds16(vsrc + (long)(t) * 4096, (unsigned)__builtin_amdgcn_readfirstlane(vdst + (slot) * KSLOT)); } while (0)
  if (MODE == 0) { float* tab = (float*)(shm + L_TAB); if (tid < 129) tab[tid] = tabg[tid]; }
  const int qi = q0 + wid * 32 + r32;
  f32x4 fk[8];
  #pragma unroll
  for (int g4 = 0; g4 < 8; ++g4) fk[g4] = (f32x4){0.f, 0.f, 0.f, 0.f};
  float Fq = 0.f;
  if (MODE == 1) { Fq = F2[qi];
    #pragma unroll
    for (int g4 = 0; g4 < 4; ++g4) { fk[g4] = *(const f32x4*)(F2 + 64 * t_lo + 4 * hi + 8 * g4); fk[4 + g4] = *(const f32x4*)(F2 + 64 * t_lo + 32 + 4 * hi + 8 * g4); } }
  bf16x8 qr[4];
  { const bf16* Qw = Qp + (long)(q0 + wid * 32) * 64;
    #pragma unroll
    for (int d0 = 0; d0 < 4; ++d0) qr[d0] = *reinterpret_cast<const bf16x8*>(&Qw[(long)r32 * 64 + d0 * 16 + hi * 8]); }
  DMA_KV(t_lo, 0);
  float m_run = -INFINITY, l_run = 0.f; f32x16 o[2]; o[0] = f32x16{}; o[1] = f32x16{};
  const int vb0 = (int)(lds0 + L_V) + ((lane >> 4) & 1) * 32 + (lane & 3) * 8 + (4 * hi + ((lane & 15) >> 2)) * 64;
  for (int t = t_lo; t < t_hi; ++t) {
    const int s = (t - t_lo) & 1;
    asm volatile("s_waitcnt vmcnt(0) lgkmcnt(0)\n\ts_barrier" ::: "memory");
    f32x4 fn[8];
    #pragma unroll
    for (int g4 = 0; g4 < 8; ++g4) fn[g4] = fk[g4];
    if (t + 1 < t_hi) {
      if (MODE == 1) {
        #pragma unroll
        for (int g4 = 0; g4 < 4; ++g4) { fn[g4] = *(const f32x4*)(F2 + 64 * (t + 1) + 4 * hi + 8 * g4); fn[4 + g4] = *(const f32x4*)(F2 + 64 * (t + 1) + 32 + 4 * hi + 8 * g4); } }
      DMA_KV(t + 1, s ^ 1);
    }
    if (t >= w_lo && t <= w_hi) {
      f32x16 c0, c1, p0, p1;
      if (MODE == 1) {
        #pragma unroll
        for (int r = 0; r < 16; ++r) { c0[r] = Fq - fk[r >> 2][r & 3]; c1[r] = Fq - fk[4 + (r >> 2)][r & 3]; }
      } else {
        const float* tab = (const float*)(shm + L_TAB);
        #pragma unroll
        for (int r = 0; r < 16; ++r) { const int d0_ = qi - (64 * t + crow(r, hi)), d1_ = d0_ - 32;
          c0[r] = tab[d0_ < 0 ? 0 : (d0_ > 128 ? 128 : d0_)]; c1[r] = tab[d1_ < 0 ? 0 : (d1_ > 128 ? 128 : d1_)]; }
      }
      qkt2(p0, p1, shm + L_K + s * KSLOT, qr, c0, c1, r32, hi);
      if (MODE == 1) {
        if (t == w_hi) {
          #pragma unroll
          for (int r = 0; r < 16; ++r) { const int kv = 64 * t + crow(r, hi); if (kv > qi) p0[r] = -INFINITY; if (kv + 32 > qi) p1[r] = -INFINITY; } }
      } else {
        #pragma unroll
        for (int r = 0; r < 16; ++r) { const int d0_ = qi - (64 * t + crow(r, hi)), d1_ = d0_ - 32;
          if ((unsigned)d0_ > 128u) p0[r] = -INFINITY; if ((unsigned)d1_ > 128u) p1[r] = -INFINITY; }
      }
      const float rm = rowmax(p0, p1), mnew = fmaxf(m_run, rm), msub = (mnew == -INFINITY) ? 0.f : mnew;
      const float f = __builtin_amdgcn_exp2f(m_run - msub);
      m_run = mnew;
      float sacc = 0.f;
      #pragma unroll
      for (int r = 0; r < 16; ++r) { p0[r] = __builtin_amdgcn_exp2f(p0[r] - msub); p1[r] = __builtin_amdgcn_exp2f(p1[r] - msub); sacc += p0[r] + p1[r]; }
      l_run = l_run * f + sacc;
      if (__any(f != 1.f)) {
        if (hi == 0) wsf[r32] = f;
        asm volatile("s_waitcnt lgkmcnt(0)" ::: "memory");
        #pragma unroll
        for (int r = 0; r < 16; ++r) { const float ff = wsf[crow(r, hi)]; o[0][r] *= ff; o[1][r] *= ff; }
      }
      u32x4 pw0, pw1, pw2, pw3;
      pw0 = (u32x4){cvtpk_s(p0[0], p0[1]), cvtpk_s(p0[2], p0[3]), cvtpk_s(p0[4], p0[5]), cvtpk_s(p0[6], p0[7])};
      pw1 = (u32x4){cvtpk_s(p0[8], p0[9]), cvtpk_s(p0[10], p0[11]), cvtpk_s(p0[12], p0[13]), cvtpk_s(p0[14], p0[15])};
      pw2 = (u32x4){cvtpk_s(p1[0], p1[1]), cvtpk_s(p1[2], p1[3]), cvtpk_s(p1[4], p1[5]), cvtpk_s(p1[6], p1[7])};
      pw3 = (u32x4){cvtpk_s(p1[8], p1[9]), cvtpk_s(p1[10], p1[11]), cvtpk_s(p1[12], p1[13]), cvtpk_s(p1[14], p1[15])};
      SBAR();
      pv(o, vb0 + s * KSLOT, __builtin_bit_cast(bf16x8, pw0), __builtin_bit_cast(bf16x8, pw1), __builtin_bit_cast(bf16x8, pw2), __builtin_bit_cast(bf16x8, pw3));
    }
    #pragma unroll
    for (int g4 = 0; g4 < 8; ++g4) fk[g4] = fn[g4];
  }
  { auto rr = __builtin_amdgcn_permlane32_swap(__float_as_uint(l_run), __float_as_uint(l_run), false, false); l_run = __uint_as_float(rr[0]) + __uint_as_float(rr[1]); }
  if (hi == 0) { wsf[32 + r32] = l_run; if (MODE == 0) lse[(long)qi * lstride] = m_run + __builtin_amdgcn_logf(l_run); }
  asm volatile("s_waitcnt lgkmcnt(0)" ::: "memory");
  float rli[16];
  #pragma unroll
  for (int r = 0; r < 16; ++r) rli[r] = __builtin_amdgcn_rcpf(wsf[32 + crow(r, hi)]);
  { bf16* stg = (bf16*)(shm + L_OST) + wid * 2048;
    #pragma unroll
    for (int r = 0; r < 16; ++r) { const int orow = crow(r, hi);
      #pragma unroll
      for (int d0 = 0; d0 < 2; ++d0) stg[orow * 64 + d0 * 32 + r32] = __float2bfloat16(o[d0][r] * rli[r]); }
    asm volatile("s_waitcnt lgkmcnt(0)" ::: "memory");
    bf16* Ow = Ob + (long)(q0 + wid * 32) * ostride;
    #pragma unroll
    for (int i = 0; i < 4; ++i) { const int row = i * 8 + (lane >> 3), ch = lane & 7; const u32x4 v = *(const u32x4*)(stg + row * 64 + ch * 8); *(u32x4*)(Ow + (long)row * ostride + ch * 8) = v; } }
  asm volatile("s_waitcnt lgkmcnt(0)\n\ts_barrier" ::: "memory");
  #undef DMA_KV
}
#undef SBAR
#undef WAIT_BAR
}

namespace attn_body {
constexpr int NSLOT = 3, SLOTB = 8192;
constexpr int T_K = 0, T_V = NSLOT * SLOTB, T_WS = 2 * NSLOT * SLOTB, T_OST = T_WS + 8 * 256, T_END = T_OST + 8 * 4096;
constexpr int T_F = 90112;
__device__ __forceinline__ void glds16s(unsigned voff,const void*sbase,unsigned lds_dst){unsigned keep;
  asm volatile("s_mov_b32 %0, m0\n\ts_mov_b32 m0, %3\n\ts_nop 0\n\tglobal_load_lds_dwordx4 %1, %2\n\ts_mov_b32 m0, %0":"=&s"(keep):"v"(voff),"s"(sbase),"s"(lds_dst):"memory");}
#define SBAR() __builtin_amdgcn_sched_barrier(0)
#define WAIT_BAR(N) asm volatile("s_waitcnt vmcnt(" #N ") lgkmcnt(0)\n\ts_barrier":::"memory")
template<int MODE, int THRL> __device__ __forceinline__ void attn_unit_t(const bf16* Qw0, const bf16* __restrict__ Kb, const bf16* __restrict__ Vb, const int NT, const int qoff,
                                                                         bf16* Ob, long ostride, float* lse, long lstride, char* shm) {
  const int tid=threadIdx.x,lane=tid&63,r32=lane&31,hi=lane>>5; const int wid=__builtin_amdgcn_readfirstlane(tid>>6);
  const unsigned lds0=(unsigned)(uintptr_t)shm;
  float*wsf=(float*)(shm+T_WS)+wid*64;
  typedef __attribute__((address_space(3))) const float* lds_f;
  const lds_f Fl=(lds_f)(shm+T_F)+((MODE==1)?qoff:0);
  const unsigned koff_=(unsigned)(lane*128+wid*16), voff_=(unsigned)((16*(wid&3)+(lane>>2))*128+(wid>>2)*64+(lane&3)*16);
  #define KOFF() koff_
  #define VOFF() voff_
  const unsigned kdst=lds0+T_K+wid*1024, vdst=lds0+T_V+wid*1024;
  #define DMA_K(t,slot) glds16s(KOFF(),(const char*)Kb+(long)(t)*8192,(unsigned)__builtin_amdgcn_readfirstlane(kdst+(slot)))
  #define DMA_V(t,slot) glds16s(VOFF(),(const char*)Vb+(long)(t)*8192,(unsigned)__builtin_amdgcn_readfirstlane(vdst+(slot)))
  const char*Kbase=shm+T_K; bf16x8 kf[8];
  const lds_cptr shm3=(lds_cptr)shm; const lds_cptr kp0=shm3+T_K+hi*1024+r32*16; const lds_cptr vp0=shm3+T_V+((lane>>4)&1)*32+(lane&3)*8+(4*hi+((lane&15)>>2))*64;
  DMA_K(0,0);DMA_V(0,0);DMA_K(1,SLOTB);
  bf16x8 qr[4];
  { const bf16*Qw=Qw0+(long)(wid*32)*64;
    #pragma unroll
    for(int d0=0;d0<4;++d0)qr[d0]=*reinterpret_cast<const bf16x8*>(&Qw[(long)r32*64+d0*16+hi*8]); }
  float mhat=0.f,l_reg=0.f;f32x16 o[2];o[0]=f32x16{};o[1]=f32x16{};
  const int qrel=wid*32+r32;
  const int qpos=(MODE>=1)?(64*(NT-4)+qrel):(qoff+qrel);
  #define FQ() ((MODE==1)?Fl[64*(NT-4)+wid*32+r32]:0.f)
  const int jb0=384-qpos+4*hi;
  #define CINIT(C0,C1,t,MASKED) do{ \
    if(MODE==2){ _Pragma("unroll") for(int r=0;r<16;++r){ C0[r]=-mhat; C1[r]=-mhat; } \
      if(MASKED){ const int jb_=(t)-(NT-4); if(jb_>=0){ const int kb_=64*jb_+4*hi; \
        _Pragma("unroll") for(int r=0;r<16;++r){ const int kv_=kb_+(r&3)+8*(r>>2); if(kv_>qrel)C0[r]=-INFINITY; if(kv_+32>qrel)C1[r]=-INFINITY; } } } \
    } else if(MODE==1){ const float fqm=FQ()-mhat; const lds_f fp_=Fl+64*(t)+4*hi; \
      _Pragma("unroll") for(int g4=0;g4<4;++g4){ const f32x4 a_=*(const __attribute__((address_space(3))) f32x4*)(fp_+8*g4), b_=*(const __attribute__((address_space(3))) f32x4*)(fp_+32+8*g4); \
        _Pragma("unroll") for(int i_=0;i_<4;++i_){ C0[4*g4+i_]=fqm-a_[i_]; C1[4*g4+i_]=fqm-b_[i_]; } } \
      if(MASKED){ const int jb_=(t)-(NT-4); if(jb_>=0){ const int kb_=64*jb_+4*hi; \
        _Pragma("unroll") for(int r=0;r<16;++r){ const int kv_=kb_+(r&3)+8*(r>>2); if(kv_>qrel)C0[r]=-INFINITY; if(kv_+32>qrel)C1[r]=-INFINITY; } } } \
    } else { const lds_f tp_=Fl+jb0+64*(t); \
      _Pragma("unroll") for(int r=0;r<16;++r){ C0[r]=tp_[(r&3)+8*(r>>2)]-mhat; C1[r]=tp_[32+(r&3)+8*(r>>2)]-mhat; } } \
  }while(0)
  bool resc=false;
  #define START(P0,P1) do{ const float rm=rowmax(P0,P1); resc=false; \
    { const float dl=(rm==-INFINITY)?0.f:rm; mhat=fadd_s(mhat,dl); \
      _Pragma("unroll") for(int r=0;r<16;++r){P0[r]=fsub_s(P0[r],dl);P1[r]=fsub_s(P1[r],dl);} } \
    _Pragma("unroll") for(int r=0;r<16;++r)P0[r]=__builtin_amdgcn_exp2f(P0[r]); }while(0)
  #define RESC() do{ if(resc){ asm volatile("s_waitcnt lgkmcnt(0)":::"memory"); \
      _Pragma("unroll") for(int d_=0;d_<2;++d_) _Pragma("unroll") for(int r=0;r<16;++r)o[d_][r]*=wsf[crow(r,hi)]; } }while(0)
  f32x16 pA0,pA1,pB0,pB1;
  int sl_prev=0,sl_cur=0,sl_next=SLOTB;
  #define ROT() do{sl_prev=sl_cur;sl_cur=sl_next;sl_next=(sl_next==(NSLOT-1)*SLOTB)?0:sl_next+SLOTB;}while(0)
  DMA_K(2,2*SLOTB);
  WAIT_BAR(3);
  CINIT(pA0,pA1,0,true);
  qkt2(pA0,pA1,Kbase,qr,pA0,pA1,r32,hi);asm volatile("s_nop 15\n\ts_nop 7":"+v"(pA0),"+v"(pA1));
  START(pA0,pA1);
  _Pragma("unroll") for(int r=0;r<16;++r)pA1[r]=__builtin_amdgcn_exp2f(pA1[r]);
  WAIT_BAR(0);
  DMA_K(3,0);DMA_V(1,SLOTB);
  ROT();
  kload8(kf,kp0+sl_cur);
  WAIT_BAR(2);
  s16x4 vlo[8],vhi[8]; u32x4 pw0,pw1,pw2,pw3;
  #define PKW(P,B) cvtpk_s(P[B],P[B+1])
  #define PAF(k) __builtin_bit_cast(bf16x8,pw##k)
  #define VFR(i) (bf16x8){vlo[i][0],vlo[i][1],vlo[i][2],vlo[i][3],vhi[i][0],vhi[i][1],vhi[i][2],vhi[i][3]}
  #define PIN(x) asm volatile("":"+v"(x))
  #define MX3(a,b,c) __builtin_fmaxf(__builtin_fmaxf((a),(b)),(c))
  #define GAPA(MF,A0,A1,A2,A3,W0,W1,PW) do{ MF; sacc+=A0; sacc+=A1; sacc+=A2; sacc+=A3; PIN(sacc); W0; W1; PIN(PW); SBAR(); }while(0)
  #define EX(v) __builtin_amdgcn_exp2f(v)
  #define GAPB(MF,X,B) do{ MF; X[B]=EX(X[B]); X[B+1]=EX(X[B+1]); X[B+2]=EX(X[B+2]); X[B+3]=EX(X[B+3]); PIN(X); SBAR(); }while(0)
  #define VRD(i) do{ vlo[i]=vtr(vp_+(((i)>>2)*4096+((i)&3)*1024)); vhi[i]=vtr(vp_+(((i)>>2)*4096+((i)&3)*1024+512)); }while(0)
  #define KRD(G,j) do{ if(G){ kload2(kf,kp0+sl_next,j); SBAR(); } }while(0)
  #define STEP(C0,C1,P0,P1,t,GK,GV,GL,MASKED) do{ SBAR(); \
    CINIT(C0,C1,t,MASKED); \
    const lds_cptr vp_=vp0+sl_prev; \
    VRD(0); SBAR(); float sacc=(P0[0]+P0[1]); \
    GAPA(C0=__builtin_amdgcn_mfma_f32_32x32x16_bf16(kf[0],qr[0],C0,0,0,0), P0[2],P0[3],P0[4],P0[5],     pw0[0]=PKW(P0,0), pw0[1]=PKW(P0,2), pw0); \
    VRD(4); SBAR(); GAPA(C1=__builtin_amdgcn_mfma_f32_32x32x16_bf16(kf[1],qr[0],C1,0,0,0), P0[6],P0[7],P0[8],P0[9],     pw0[2]=PKW(P0,4), pw0[3]=PKW(P0,6), pw0); \
    VRD(1); SBAR(); GAPA(C0=__builtin_amdgcn_mfma_f32_32x32x16_bf16(kf[2],qr[1],C0,0,0,0),   P0[10],P0[11],P0[12],P0[13], pw1[0]=PKW(P0,8), pw1[1]=PKW(P0,10), pw1); \
    VRD(5); SBAR(); GAPA(C1=__builtin_amdgcn_mfma_f32_32x32x16_bf16(kf[3],qr[1],C1,0,0,0),   P0[14],P0[15],P1[0],P1[1],   pw1[2]=PKW(P0,12),pw1[3]=PKW(P0,14), pw1); \
    VRD(2); SBAR(); GAPA(C0=__builtin_amdgcn_mfma_f32_32x32x16_bf16(kf[4],qr[2],C0,0,0,0),   P1[2],P1[3],P1[4],P1[5],     pw2[0]=PKW(P1,0), pw2[1]=PKW(P1,2), pw2); \
    VRD(6); SBAR(); GAPA(C1=__builtin_amdgcn_mfma_f32_32x32x16_bf16(kf[5],qr[2],C1,0,0,0),   P1[6],P1[7],P1[8],P1[9],     pw2[2]=PKW(P1,4), pw2[3]=PKW(P1,6), pw2); \
    VRD(3); SBAR(); GAPA(C0=__builtin_amdgcn_mfma_f32_32x32x16_bf16(kf[6],qr[3],C0,0,0,0),   P1[10],P1[11],P1[12],P1[13], pw3[0]=PKW(P1,8), pw3[1]=PKW(P1,10), pw3); \
    VRD(7); SBAR(); GAPA(C1=__builtin_amdgcn_mfma_f32_32x32x16_bf16(kf[7],qr[3],C1,0,0,0),   P1[14],P1[15],0.f,0.f,       pw3[2]=PKW(P1,12),pw3[3]=PKW(P1,14), pw3); \
    l_reg+=sacc; \
    if(GK){DMA_K((t)+3,sl_cur);} if(GV){DMA_V((t)+1,sl_next);} \
    { float a=MX3(C0[0],C0[1],C1[0]),b=MX3(C0[2],C0[3],C1[1]); a=MX3(a,C1[2],C1[3]); \
      _Pragma("unroll") for(int r=4;r<16;r+=4){a=MX3(a,C0[r],C0[r+1]);b=MX3(b,C0[r+2],C0[r+3]);a=MX3(a,C1[r],C1[r+1]);b=MX3(b,C1[r+2],C1[r+3]);} \
      float rm=__builtin_fmaxf(a,b); { auto rr=__builtin_amdgcn_permlane32_swap(__float_as_uint(rm),__float_as_uint(rm),false,false); rm=__builtin_fmaxf(__uint_as_float(rr[0]),__uint_as_float(rr[1])); } \
      resc=false; \
      if(__builtin_expect(__any(rm>(float)THRL),0)){ const float dl=__builtin_fmaxf(rm,0.f); mhat+=dl; \
        _Pragma("unroll") for(int r=0;r<16;++r){C0[r]-=dl;C1[r]-=dl;} \
        const float f=__builtin_amdgcn_exp2f(-dl); l_reg*=f; if(hi==0)wsf[r32]=f; resc=true; } } \
    SBAR(); \
    GAPB(o[0]=__builtin_amdgcn_mfma_f32_32x32x16_bf16(PAF(0),VFR(0),o[0],0,0,0), C0,0); \
    GAPB(o[1]=__builtin_amdgcn_mfma_f32_32x32x16_bf16(PAF(0),VFR(4),o[1],0,0,0), C0,4); \
    KRD(GL,0); GAPB(o[0]=__builtin_amdgcn_mfma_f32_32x32x16_bf16(PAF(1),VFR(1),o[0],0,0,0), C0,8); \
    KRD(GL,1); GAPB(o[1]=__builtin_amdgcn_mfma_f32_32x32x16_bf16(PAF(1),VFR(5),o[1],0,0,0), C0,12); \
    KRD(GL,2); GAPB(o[0]=__builtin_amdgcn_mfma_f32_32x32x16_bf16(PAF(2),VFR(2),o[0],0,0,0), C1,0); \
    KRD(GL,3); GAPB(o[1]=__builtin_amdgcn_mfma_f32_32x32x16_bf16(PAF(2),VFR(6),o[1],0,0,0), C1,4); \
    GAPB(o[0]=__builtin_amdgcn_mfma_f32_32x32x16_bf16(PAF(3),VFR(3),o[0],0,0,0), C1,8); \
    GAPB(o[1]=__builtin_amdgcn_mfma_f32_32x32x16_bf16(PAF(3),VFR(7),o[1],0,0,0), C1,12); \
    }while(0)
  int t=1;
  for(;t+5<NT;t+=2){
    STEP(pB0,pB1,pA0,pA1,t,true,true,true,false);     WAIT_BAR(2); RESC(); ROT();
    STEP(pA0,pA1,pB0,pB1,t+1,true,true,true,false);   WAIT_BAR(2); RESC(); ROT();
  }
  #define ENDW(tt) do{ if((tt)+3<NT){WAIT_BAR(2);} else if((tt)+2<NT){WAIT_BAR(1);} else {WAIT_BAR(0);} }while(0)
  for(;t+1<NT;t+=2){
    STEP(pB0,pB1,pA0,pA1,t,(t+3<NT),(t+1<NT),(t+1<NT),true);       ENDW(t);   RESC(); ROT();
    STEP(pA0,pA1,pB0,pB1,t+1,(t+4<NT),(t+2<NT),(t+2<NT),true);     ENDW(t+1); RESC(); ROT();
  }
  STEP(pB0,pB1,pA0,pA1,NT-1,false,false,false,true); RESC();
  { float sacc=pB0[0]+pB0[1]; _Pragma("unroll") for(int r=2;r<16;++r)sacc+=pB0[r]; _Pragma("unroll") for(int r=0;r<16;++r)sacc+=pB1[r]; l_reg+=sacc;
    pw0=(u32x4){PKW(pB0,0),PKW(pB0,2),PKW(pB0,4),PKW(pB0,6)};pw1=(u32x4){PKW(pB0,8),PKW(pB0,10),PKW(pB0,12),PKW(pB0,14)};pw2=(u32x4){PKW(pB1,0),PKW(pB1,2),PKW(pB1,4),PKW(pB1,6)};pw3=(u32x4){PKW(pB1,8),PKW(pB1,10),PKW(pB1,12),PKW(pB1,14)};
    int ln_=lane; asm volatile("":"+v"(ln_)); const int hi_=ln_>>5; const int vb0=(int)(lds0+T_V)+((ln_>>4)&1)*32+(ln_&3)*8+(4*hi_+((ln_&15)>>2))*64;
    SBAR(); pv(o,vb0+sl_cur,PAF(0),PAF(1),PAF(2),PAF(3)); }
  #undef PKW
  #undef PAF
  #undef VFR
  #undef PIN
  #undef MX3
  #undef GAPA
  #undef GAPB
  #undef EX
  #undef VRD
  #undef KRD
  #undef STEP
  #undef ENDW
  #undef CINIT
  {auto rr=__builtin_amdgcn_permlane32_swap(__float_as_uint(l_reg),__float_as_uint(l_reg),false,false);l_reg=__uint_as_float(rr[0])+__uint_as_float(rr[1]);}
  int r32e=r32,hie=hi; asm volatile("":"+v"(r32e),"+v"(hie));
  if(hie==0){ wsf[32+r32e]=l_reg; if(MODE==0) lse[(long)(wid*32+r32e)*lstride]=mhat+__builtin_amdgcn_logf(l_reg); }
  asm volatile("s_waitcnt lgkmcnt(0)":::"memory");
  float rli[16];
  #pragma unroll
  for(int r=0;r<16;++r)rli[r]=__builtin_amdgcn_rcpf(wsf[32+crow(r,hie)]);
  { bf16*stg=(bf16*)(shm+T_OST)+wid*2048;
    #pragma unroll
    for(int r=0;r<16;++r){const int orow=crow(r,hie);
      #pragma unroll
      for(int d0=0;d0<2;++d0)stg[orow*64+d0*32+r32e]=__float2bfloat16(o[d0][r]*rli[r]);}
    asm volatile("s_waitcnt lgkmcnt(0)":::"memory");
    bf16*Ow=Ob+(long)(wid*32)*ostride;
    int le_=lane; asm volatile("":"+v"(le_));
    #pragma unroll
    for(int i=0;i<4;++i){const int row=i*8+(le_>>3),ch=le_&7; const u32x4 v=*(const u32x4*)(stg+row*64+ch*8);
      if(WO_FP8&&MODE==1){ typedef unsigned u32x2o __attribute__((ext_vector_type(2))); u32x2o w8;
        w8.x=pg8::pk4_fp8(__uint_as_float(v.x<<16),__uint_as_float(v.x&0xffff0000u),__uint_as_float(v.y<<16),__uint_as_float(v.y&0xffff0000u));
        w8.y=pg8::pk4_fp8(__uint_as_float(v.z<<16),__uint_as_float(v.z&0xffff0000u),__uint_as_float(v.w<<16),__uint_as_float(v.w&0xffff0000u));
        *(u32x2o*)((unsigned char*)Ob+(long)(wid*32+row)*ostride+ch*8)=w8; }
      else *(u32x4*)(Ow+(long)row*ostride+ch*8)=v;} }
  asm volatile("s_waitcnt lgkmcnt(0)\n\ts_barrier":::"memory");
  #undef DMA_K
  #undef DMA_V
  #undef KOFF
  #undef FQ
  #undef VOFF
  #undef START
  #undef RESC
  #undef ROT
}
#undef SBAR
#undef WAIT_BAR
}

namespace attn_body {
constexpr int B_V = 0, B_VBUF = 49152, B_K = B_VBUF, B_WS = 2 * B_VBUF, B_OST = B_WS + 2048, B_TAB = B_OST + 32768, B_END = B_TAB + 2 * 1024;
struct BandUnit { const bf16* Q; const bf16* K; const bf16* V; bf16* O; float* L; const float* tab; int q0; int sh; };
__device__ __forceinline__ void band_decode(int L, BandUnit& u, const bf16* QKV, bf16* OG, float* LSE, const float* BT) {
    const int tri = L >> 4, u16 = L & 15, b = tri / 48, gh = tri % 48, g = gh >> 4, h = gh & 15;
    const int sh = 2 * g, Ls = 4096 >> sh;
    const int r = (g == 0) ? 0 : (g == 1 ? (u16 >> 2) : u16), uq = (g == 0) ? u16 : (g == 1 ? (u16 & 3) : 0);
    const size_t pl = (size_t)((b * 3 + g) * 3) * 16 + h;
    u.Q = QKV + (pl * 4096 + (size_t)r * Ls) * 64; u.K = u.Q + (size_t)16 * 4096 * 64; u.V = u.Q + (size_t)32 * 4096 * 64;
    const size_t tok0 = (size_t)b * 4096 + r;
    u.O = OG + ((size_t)g * 32768 + tok0) * 1024 + h * 64; u.L = LSE + ((size_t)g * 32768 + tok0) * 16 + h;
    u.tab = BT + gh * 132; u.q0 = uq * 256; u.sh = sh;
}
__device__ __forceinline__ void band_issue_v(const BandUnit& u, unsigned lds0, int lane, int wid) {
    const unsigned voff = (unsigned)((16 * (wid & 3) + (lane >> 2)) * 128 + (wid >> 2) * 64 + (lane & 3) * 16);
    const int w0 = u.q0 - 128;
    #pragma unroll
    for (int t = 0; t < 6; ++t) { const int k0 = w0 + 64 * t;
        if (k0 >= 0) glds16s(voff, (const char*)u.V + (long)k0 * 128, (unsigned)__builtin_amdgcn_readfirstlane(lds0 + B_V + t * 8192 + wid * 1024)); }
}
__device__ __forceinline__ void band_issue_k(const BandUnit& u, int tbuf, unsigned lds0, int tid, int lane, int wid) {
    const unsigned koff = (unsigned)(lane * 128 + wid * 16);
    const int w0 = u.q0 - 128;
    #pragma unroll
    for (int t = 0; t < 6; ++t) { const int k0 = w0 + 64 * t;
        if (k0 >= 0) glds16s(koff, (const char*)u.K + (long)k0 * 128, (unsigned)__builtin_amdgcn_readfirstlane(lds0 + B_K + t * 8192 + wid * 1024)); }
    if (tid < 192) { __attribute__((address_space(3))) float* tb = (__attribute__((address_space(3))) float*)(uintptr_t)(lds0 + B_TAB + tbuf * 1024);
        tb[tid] = (tid >= 32 && tid <= 160) ? u.tab[tid - 32] : -INFINITY; }
}
template <int VAR> __device__ __forceinline__ void band_phase(const bf16* QKV, bf16* OG, float* LSE, const float* BT, int first, int step, int NU, char* shm) {
    const int tid = threadIdx.x, lane = tid & 63, r32 = lane & 31, hi = lane >> 5; const int wid = __builtin_amdgcn_readfirstlane(tid >> 6);
    const unsigned lds0 = (unsigned)(uintptr_t)shm;
    float* wsf = (float*)(shm + B_WS) + wid * 64;
    typedef __attribute__((address_space(3))) const float* lds_f;
    BandUnit cur, nxt;
    int L = first, buf = 0;
#define BAND_LOADQ(U) do { const bf16* Qw_ = (U).Q + (long)((U).q0 + 32 * wid) * 64; \
        _Pragma("unroll") for (int d0 = 0; d0 < 4; ++d0) qn[d0] = *reinterpret_cast<const bf16x8*>(&Qw_[(long)r32 * 64 + d0 * 16 + hi * 8]); } while (0)
    bf16x8 qn[4];
    #pragma unroll
    for (int d0 = 0; d0 < 4; ++d0) qn[d0] = (bf16x8){0, 0, 0, 0, 0, 0, 0, 0};
    if (L < NU) { band_decode(L, cur, QKV, OG, LSE, BT); band_issue_k(cur, 0, lds0, tid, lane, wid); BAND_LOADQ(cur); }
    for (; L < NU; L += step, buf ^= 1) {
        const bool has_next = (L + step) < NU;
        if (has_next) band_decode(L + step, nxt, QKV, OG, LSE, BT); else nxt = cur;
        const int qw = cur.q0 + 32 * wid;
        const int jlo = (qw >= 128) ? 0 : ((128 - qw) >> 5);
        if (L == first) asm volatile("s_waitcnt vmcnt(0) lgkmcnt(0)\n\ts_barrier" ::: "memory");
        else asm volatile("s_waitcnt vmcnt(5) lgkmcnt(0)\n\ts_barrier" ::: "memory");
        bf16x8 qr[4];
        #pragma unroll
        for (int d0 = 0; d0 < 4; ++d0) qr[d0] = qn[d0];
        band_issue_v(cur, lds0, lane, wid);
        f32x16 S[5];
        { const lds_f tb = (lds_f)(uintptr_t)(lds0 + B_TAB + buf * 1024) + (5 + r32 - 4 * hi);
          #pragma unroll
          for (int j = 0; j < 5; ++j) {
              #pragma unroll
              for (int r = 0; r < 16; ++r) S[j][r] = (j >= jlo) ? tb[(128 - 32 * j) + 27 - ((r & 3) + 8 * (r >> 2))] : -INFINITY;
              if (j >= jlo) { const int wj = wid + j;
                  const __attribute__((address_space(3))) char* kp = (const __attribute__((address_space(3))) char*)(uintptr_t)(lds0 + B_K + (wj >> 1) * 8192 + hi * 1024 + ((wj & 1) * 32 + r32) * 16);
                  #pragma unroll
                  for (int d0 = 0; d0 < 4; ++d0) { const bf16x8 kf = *(const __attribute__((address_space(3))) bf16x8*)(kp + d0 * 2048);
                      S[j] = __builtin_amdgcn_mfma_f32_32x32x16_bf16(kf, qr[d0], S[j], 0, 0, 0); } } } }
        asm volatile("s_waitcnt vmcnt(0) lgkmcnt(0)\n\ts_barrier" ::: "memory");
        if (has_next) { band_issue_k(nxt, buf ^ 1, lds0, tid, lane, wid); BAND_LOADQ(nxt); }
        float mx = -INFINITY;
        #pragma unroll
        for (int j = 0; j < 5; ++j)
            #pragma unroll
            for (int r = 0; r < 16; ++r) mx = fmaxf(mx, S[j][r]);
        { auto rr = __builtin_amdgcn_permlane32_swap(__float_as_uint(mx), __float_as_uint(mx), false, false); mx = fmaxf(__uint_as_float(rr[0]), __uint_as_float(rr[1])); }
        float lsum = 0.f; u32x4 pw[5][2];
        #pragma unroll
        for (int j = 0; j < 5; ++j) {
            #pragma unroll
            for (int r = 0; r < 16; ++r) { S[j][r] = __builtin_amdgcn_exp2f(S[j][r] - mx); lsum += S[j][r]; }
            pw[j][0] = (u32x4){cvtpk_s(S[j][0], S[j][1]), cvtpk_s(S[j][2], S[j][3]), cvtpk_s(S[j][4], S[j][5]), cvtpk_s(S[j][6], S[j][7])};
            pw[j][1] = (u32x4){cvtpk_s(S[j][8], S[j][9]), cvtpk_s(S[j][10], S[j][11]), cvtpk_s(S[j][12], S[j][13]), cvtpk_s(S[j][14], S[j][15])}; }
        { auto rr = __builtin_amdgcn_permlane32_swap(__float_as_uint(lsum), __float_as_uint(lsum), false, false); lsum = __uint_as_float(rr[0]) + __uint_as_float(rr[1]); }
        f32x16 o[2]; o[0] = f32x16{}; o[1] = f32x16{};
        const int vlane = ((lane >> 4) & 1) * 32 + (lane & 3) * 8 + (4 * hi + ((lane & 15) >> 2)) * 64;
        #pragma unroll
        for (int j = 0; j < 5; ++j) if (j >= jlo) {
            const int wj = wid + j;
            const int vb = (int)(lds0 + B_V) + (wj >> 1) * 8192 + (wj & 1) * 2048 + vlane;
            s16x4 l0[2], h0[2], l1[2], h1[2];
            #pragma unroll
            for (int d0 = 0; d0 < 2; ++d0) {
                asm volatile("ds_read_b64_tr_b16 %0,%1 offset:%c2" : "=&v"(l0[d0]) : "v"(vb), "i"(d0 * 4096) : "memory");
                asm volatile("ds_read_b64_tr_b16 %0,%1 offset:%c2" : "=&v"(h0[d0]) : "v"(vb), "i"(d0 * 4096 + 512) : "memory");
                asm volatile("ds_read_b64_tr_b16 %0,%1 offset:%c2" : "=&v"(l1[d0]) : "v"(vb), "i"(d0 * 4096 + 1024) : "memory");
                asm volatile("ds_read_b64_tr_b16 %0,%1 offset:%c2" : "=&v"(h1[d0]) : "v"(vb), "i"(d0 * 4096 + 1536) : "memory"); }
            asm volatile("s_waitcnt lgkmcnt(0)" : "+v"(l0[0]), "+v"(h0[0]), "+v"(l1[0]), "+v"(h1[0]), "+v"(l0[1]), "+v"(h0[1]), "+v"(l1[1]), "+v"(h1[1]) :: "memory"); __builtin_amdgcn_sched_barrier(0);
            #pragma unroll
            for (int d0 = 0; d0 < 2; ++d0) {
                o[d0] = __builtin_amdgcn_mfma_f32_32x32x16_bf16(__builtin_bit_cast(bf16x8, pw[j][0]), (bf16x8){l0[d0][0], l0[d0][1], l0[d0][2], l0[d0][3], h0[d0][0], h0[d0][1], h0[d0][2], h0[d0][3]}, o[d0], 0, 0, 0);
                o[d0] = __builtin_amdgcn_mfma_f32_32x32x16_bf16(__builtin_bit_cast(bf16x8, pw[j][1]), (bf16x8){l1[d0][0], l1[d0][1], l1[d0][2], l1[d0][3], h1[d0][0], h1[d0][1], h1[d0][2], h1[d0][3]}, o[d0], 0, 0, 0); } }
        const long ostride = 1024L << cur.sh, lstride = 16L << cur.sh;
        if (hi == 0) { wsf[32 + r32] = lsum; cur.L[(long)(qw + r32) * lstride] = mx + __builtin_amdgcn_logf(lsum); }
        asm volatile("s_waitcnt lgkmcnt(0)" ::: "memory");
        float rli[16];
        #pragma unroll
        for (int r = 0; r < 16; ++r) rli[r] = __builtin_amdgcn_rcpf(wsf[32 + crow(r, hi)]);
        { bf16* stg = (bf16*)(shm + B_OST) + wid * 2048;
          #pragma unroll
          for (int r = 0; r < 16; ++r) { const int orow = crow(r, hi);
            #pragma unroll
            for (int d0 = 0; d0 < 2; ++d0) stg[orow * 64 + d0 * 32 + r32] = __float2bfloat16(o[d0][r] * rli[r]); }
          asm volatile("s_waitcnt lgkmcnt(0)" ::: "memory");
          bf16* Ow = cur.O + (long)qw * ostride;
          #pragma unroll
          for (int i = 0; i < 4; ++i) { const int row = i * 8 + (lane >> 3), ch = lane & 7; const u32x4 v = *(const u32x4*)(stg + row * 64 + ch * 8); *(u32x4*)(Ow + (long)row * ostride + ch * 8) = v; } }
        cur = nxt;
    }
    asm volatile("s_waitcnt vmcnt(0) lgkmcnt(0)\n\ts_barrier" ::: "memory");
#undef BAND_LOADQ
}
}
#define XB_TMO      128
#define XB_XCNT(j)  (256  + 64 * (j))
#define XB_XSUB(j)  (1280 + 64 * (j))
#define XB_XGEN(j)  (2304 + 64 * (j))
#define XB_TOP      3328
#define XB_TOPGEN   3392
#define XCD_BAR_WORDS 3456
#define XB_SPIN_CAP (1u << 18)

__device__ __forceinline__ unsigned xb_ld(unsigned* p)              { return __hip_atomic_load(p, __ATOMIC_RELAXED, __HIP_MEMORY_SCOPE_AGENT); }
__device__ __forceinline__ unsigned xb_add(unsigned* p, unsigned v) { return __hip_atomic_fetch_add(p, v, __ATOMIC_RELAXED, __HIP_MEMORY_SCOPE_AGENT); }
__device__ __forceinline__ unsigned xb_xcc_id() { return (unsigned)__builtin_amdgcn_s_getreg((3 << 11) | 20) & 0xFu; }
#define XB_SPIN(cond, bar) do { unsigned _sp = 0; while (cond) { __builtin_amdgcn_s_sleep(1); \
    if ((++_sp & 255u) == 0u) { if (xb_ld(&(bar)[XB_TMO])) break; if (_sp > XB_SPIN_CAP) { atomicAdd(&(bar)[XB_TMO], 1u); break; } } } } while (0)

struct XcdBarrier {
    unsigned* bar; unsigned x;
    volatile LAS unsigned* st;
};

__device__ __forceinline__ XcdBarrier xcd_barrier_post(unsigned* bar, volatile LAS unsigned* st) {
    XcdBarrier b; b.bar = bar; b.x = xb_xcc_id(); b.st = st;
    if (threadIdx.x == 0) (void)xb_add(&bar[XB_XCNT(b.x)], 1u);
    return b;
}
__device__ __forceinline__ void xcd_barrier_complete(unsigned* bar, unsigned x, unsigned& nloc, unsigned& nx) {
    const unsigned G = gridDim.x * gridDim.y * gridDim.z;
    unsigned sum, cnt, mine, sp = 0u;
    for (;;) {
        sum = 0u; cnt = 0u; mine = 0u;
#pragma unroll
        for (unsigned j = 0; j < 16; ++j) { const unsigned c = xb_ld(&bar[XB_XCNT(j)]); sum += c; cnt += (c > 0u) ? 1u : 0u; mine = (j == x) ? c : mine; }
        if (sum == G) break;
        __builtin_amdgcn_s_sleep(1);
        if ((++sp & 255u) == 0u) { if (xb_ld(&bar[XB_TMO])) break; if (sp > XB_SPIN_CAP) { atomicAdd(&bar[XB_TMO], 1u); break; } }
    }
    nloc = mine > 0u ? mine : 1u; nx = cnt > 0u ? cnt : 1u;
}

__device__ __forceinline__ void xcd_barrier(const XcdBarrier& b) {
    asm volatile("s_waitcnt vmcnt(0)" ::: "memory");
    __syncthreads();
    if (threadIdx.x == 0) {
        unsigned* bar = b.bar;
        __builtin_amdgcn_s_waitcnt(0);
        unsigned nloc = b.st[0], nx = b.st[1];
        if (nloc == 0u) { xcd_barrier_complete(bar, b.x, nloc, nx); b.st[0] = nloc; b.st[1] = nx; }
        const unsigned old = xb_add(&bar[XB_XSUB(b.x)], 1u);
        const unsigned gen = old / nloc;
        if (old + 1u == (gen + 1u) * nloc) {
            __builtin_amdgcn_fence(__ATOMIC_RELEASE, "agent");
            asm volatile("s_waitcnt vmcnt(0)" ::: "memory");
            const unsigned og = xb_add(&bar[XB_TOP], 1u);
            const unsigned tg = og / nx;
            if (og + 1u == (tg + 1u) * nx) xb_add(&bar[XB_TOPGEN], 1u);
            else XB_SPIN(xb_ld(&bar[XB_TOPGEN]) == tg, bar);
            __builtin_amdgcn_fence(__ATOMIC_ACQUIRE, "agent");
            xb_add(&bar[XB_XGEN(b.x)], 1u);
            asm volatile("s_waitcnt vmcnt(0)" ::: "memory");
        } else {
            XB_SPIN(xb_ld(&bar[XB_XGEN(b.x)]) == gen, bar);
            __builtin_amdgcn_fence(__ATOMIC_ACQUIRE, "agent");
            asm volatile("s_waitcnt vmcnt(0)" ::: "memory");
        }
    }
    __syncthreads();
}

struct Args { const float* in[21]; float* out; unsigned char* ws; int ph_lo, ph_hi; };
enum { IN_X = 0, IN_C, IN_ADAW, IN_ADAB, IN_NMIX, IN_NFFN, IN_AWQKV, IN_AWO, IN_RELB, IN_KVNG, IN_WKVF, IN_BF, IN_BWQ, IN_BWO, IN_RW, IN_RB, IN_WGU, IN_BGU, IN_WDN, IN_BDN, IN_FNG };

struct Ctx {
    LAS unsigned char* lds; unsigned char* ws; int tid, lane, wave, vcu, G;
};

__device__ __forceinline__ void transpose_item(const float* __restrict__ W, int pitch, int Kd, bf16* WT, int k0, int n0, int row_off, LAS float* scr, int lane) {
#pragma unroll
    for (int i = 0; i < 8; ++i) { const int kk = 8 * i + (lane >> 3), c4 = (lane & 7) * 4;
        const f32x4 v = *(const f32x4*)(W + (size_t)(k0 + kk) * pitch + n0 + c4);
        scr[kk * 33 + c4] = v[0]; scr[kk * 33 + c4 + 1] = v[1]; scr[kk * 33 + c4 + 2] = v[2]; scr[kk * 33 + c4 + 3] = v[3]; }
    LDS_WAIT(); asm volatile("" ::: "memory");
    const int c = lane & 7;
#pragma unroll
    for (int j = 0; j < 4; ++j) { const int n = (lane >> 3) + 8 * j; const LAS float* s = scr + (8 * c) * 33 + n;
        u32x4v o; o.x = pkbf(s[0 * 33], s[1 * 33]); o.y = pkbf(s[2 * 33], s[3 * 33]); o.z = pkbf(s[4 * 33], s[5 * 33]); o.w = pkbf(s[6 * 33], s[7 * 33]);
        *(u32x4v*)(WT + (size_t)(row_off + n0 + n) * Kd + k0 + 8 * c) = o; }
    LDS_WAIT(); asm volatile("" ::: "memory");
}

__device__ __forceinline__ void transpose_item8(const float* __restrict__ W, int pitch, int Kd, unsigned char* WT, int k0, int n0, int row_off, LAS float* scr, int lane) {
#pragma unroll
    for (int i = 0; i < 8; ++i) { const int kk = 8 * i + (lane >> 3), c4 = (lane & 7) * 4;
        const f32x4 v = *(const f32x4*)(W + (size_t)(k0 + kk) * pitch + n0 + c4) * 64.f;
        scr[kk * 33 + c4] = v[0]; scr[kk * 33 + c4 + 1] = v[1]; scr[kk * 33 + c4 + 2] = v[2]; scr[kk * 33 + c4 + 3] = v[3]; }
    LDS_WAIT(); asm volatile("" ::: "memory");
    const int c = lane & 7;
#pragma unroll
    for (int j = 0; j < 4; ++j) { const int n = (lane >> 3) + 8 * j; const LAS float* s = scr + (8 * c) * 33 + n;
        u32x2v o; o.x = pg8::pk4_fp8(s[0 * 33], s[1 * 33], s[2 * 33], s[3 * 33]); o.y = pg8::pk4_fp8(s[4 * 33], s[5 * 33], s[6 * 33], s[7 * 33]);
        *(u32x2v*)(WT + (size_t)(row_off + n0 + n) * Kd + k0 + 8 * c) = o; }
    LDS_WAIT(); asm volatile("" ::: "memory");
}

__device__ __forceinline__ void p0_prologue(const Ctx& C, const Args& a) {
    LAS float* scr = (LAS float*)(C.lds + RING_OFF + C.wave * 8704);
    const int gw = C.vcu * NWAVES + C.wave, NGW = C.G * NWAVES;
    constexpr int I_QKV = 16 * 288, I_SQ = 16 * 32, I_KV = 16 * 64, I_GU1 = 16 * 64, I_DN1 = 16 * 32;
    constexpr int O_WO0 = I_QKV, O_KV = O_WO0 + I_SQ, O_WQ = O_KV + I_KV, O_WO1 = O_WQ + I_SQ, O_GU = O_WO1 + I_SQ, O_DN = O_GU + 64 * I_GU1, NITEMS = O_DN + 64 * I_DN1;
    static_assert(QKV_FP8 && KVQ_FP8 && WO_FP8, "the pipelined prologue converts every weight to fp8");
    struct Item { const float* W; unsigned char* WT; int pitch, k0, n0, row_off; };
    auto decode = [&](int it, Item& I) {
        if (it < O_WO0) { const int r = it, kb = r / 288, nb = r % 288; I = {a.in[IN_AWQKV], (unsigned char*)(C.ws + WS_WQKV), NQKV, 64 * kb, 32 * nb, 0}; }
        else if (it < O_KV) { const int r = it - O_WO0, kb = r / 32, nb = r % 32; I = {a.in[IN_AWO], (unsigned char*)(C.ws + WS_WO0), D, 64 * kb, 32 * nb, 0}; }
        else if (it < O_WQ) { const int r = it - O_KV, kb = r / 64, nb = r % 64; I = {a.in[IN_WKVF], (unsigned char*)(C.ws + WS_WKV), 2064, 64 * kb, 32 * nb, 0}; }
        else if (it < O_WO1) { const int r = it - O_WQ, kb = r / 32, nb = r % 32; I = {a.in[IN_BWQ], (unsigned char*)(C.ws + WS_WKV) + (size_t)2048 * D, D, 64 * kb, 32 * nb, 0}; }
        else if (it < O_GU) { const int r = it - O_WO1, kb = r / 32, nb = r % 32; I = {a.in[IN_BWO], (unsigned char*)(C.ws + WS_WO1), D, 64 * kb, 32 * nb, 0}; }
        else if (it < O_DN) { const int r = it - O_GU, mat = r / I_GU1, q = r % I_GU1, kb = q / 64, nb = q % 64;
            const int n0 = 32 * nb, which = n0 >> 10, j0 = n0 & 1023, drow0 = (j0 >> 7) * 256 + which * 128 + (j0 & 127);
            I = {a.in[IN_WGU] + (size_t)mat * D * 2048, (unsigned char*)(C.ws + WS_WGU) + (size_t)mat * 2048 * D, 2048, 64 * kb, n0, drow0 - n0}; }
        else { const int r = it - O_DN, mat = r / I_DN1, q = r % I_DN1, kb = q / 32, nb = q % 32;
            I = {a.in[IN_WDN] + (size_t)mat * D * D, (unsigned char*)(C.ws + WS_WDN) + (size_t)mat * D * D, D, 64 * kb, 32 * nb, 0}; }
    };
    const int lr = C.lane >> 3, c4 = (C.lane & 7) * 4;
#define P0_LOAD(V, I) do { _Pragma("unroll") for (int i = 0; i < 8; ++i) V[i] = NT_P0 ? __builtin_nontemporal_load((const f32x4*)((I).W + (size_t)((I).k0 + 8 * i + lr) * (I).pitch + (I).n0 + c4)) : *(const f32x4*)((I).W + (size_t)((I).k0 + 8 * i + lr) * (I).pitch + (I).n0 + c4); } while (0)
    f32x4 vc[8], vn[8]; Item Ic, In;
    if (gw < NITEMS) { decode(gw, Ic); P0_LOAD(vc, Ic); }
    for (int it = gw; it < NITEMS; it += NGW) {
        const bool hn = (it + NGW) < NITEMS;
        if (hn) { decode(it + NGW, In); P0_LOAD(vn, In); }
#pragma unroll
        for (int i = 0; i < 8; ++i) { const int kk = 8 * i + lr; const f32x4 v = vc[i] * 64.f;
            scr[kk * 33 + c4] = v[0]; scr[kk * 33 + c4 + 1] = v[1]; scr[kk * 33 + c4 + 2] = v[2]; scr[kk * 33 + c4 + 3] = v[3]; }
        LDS_WAIT(); asm volatile("" ::: "memory");
        { const int cc = C.lane & 7;
#pragma unroll
          for (int j = 0; j < 4; ++j) { const int n = lr + 8 * j; const LAS float* s = scr + (8 * cc) * 33 + n;
              u32x2v o; o.x = pg8::pk4_fp8(s[0 * 33], s[1 * 33], s[2 * 33], s[3 * 33]); o.y = pg8::pk4_fp8(s[4 * 33], s[5 * 33], s[6 * 33], s[7 * 33]);
              *(u32x2v*)(Ic.WT + (size_t)(Ic.row_off + Ic.n0 + n) * D + Ic.k0 + 8 * cc) = o; } }
        LDS_WAIT(); asm volatile("" ::: "memory");
        if (hn) { Ic = In;
#pragma unroll
            for (int i = 0; i < 8; ++i) vc[i] = vn[i]; }
    }
#undef P0_LOAD
    __syncthreads();
    LAS float* cs = (LAS float*)(C.lds + RING_OFF);
    LAS float* red = (LAS float*)(C.lds + RING_OFF + 32768);
    for (int i = C.tid; i < 8192; i += 512) { const float v = a.in[IN_C][i]; cs[i] = v / (1.f + __expf(-v)); }
    __syncthreads();
    float* ADA = (float*)(C.ws + SM_ADA);
    for (int grp = C.vcu; grp < 192; grp += C.G) {
        const int l = grp / 96, col = (grp % 96) * 64 + C.lane;
        const float* w = a.in[IN_ADAW] + (size_t)l * D * 6144 + col;
        float acc[8];
#pragma unroll
        for (int b = 0; b < 8; ++b) acc[b] = 0.f;
        const int kbeg = C.wave * 128;
#pragma unroll 4
        for (int k = kbeg; k < kbeg + 128; k += 4) {
            float wv[4];
#pragma unroll
            for (int j = 0; j < 4; ++j) wv[j] = w[(size_t)(k + j) * 6144];
#pragma unroll
            for (int b = 0; b < 8; ++b) { const f32x4 cv = *(const LAS f32x4*)(cs + b * 1024 + k); acc[b] += cv[0] * wv[0] + cv[1] * wv[1] + cv[2] * wv[2] + cv[3] * wv[3]; }
        }
#pragma unroll
        for (int b = 0; b < 8; ++b) red[(C.wave * 8 + b) * 64 + C.lane] = acc[b];
        __syncthreads();
        { const int b = C.wave; float s = 0.f;
#pragma unroll
          for (int w8 = 0; w8 < 8; ++w8) s += red[(w8 * 8 + b) * 64 + C.lane];
          ADA[(size_t)(l * 8 + b) * 6144 + col] = s + a.in[IN_ADAB][l * 6144 + col]; }
        __syncthreads();
    }
    if (C.vcu == C.G - 1) {
        float* BT = (float*)(C.ws + SM_BIAST);
        for (int i = C.tid; i < 48 * 129; i += 512) { const int gh = i / 129, dl = i % 129, g = gh >> 4, n = dl << (2 * g);
            int bk = n;
            if (n >= 16) { const float nf = (float)n; bk = 16 + (int)(logf(nf / 16.f) / 4.852030263919617f * 16.f); bk = bk > 31 ? 31 : bk; }
            BT[gh * 132 + dl] = a.in[IN_RELB][bk * 48 + gh] * LOG2E; }
    }
}

__device__ __forceinline__ void p1_rows0(const Ctx& C, const Args& a) {
    const float* ADA = (const float*)(C.ws + SM_ADA);
    float* GM = (float*)(C.ws + SM_GM); float* CSH = (float*)(C.ws + SM_CSH);
    const int gt = C.vcu * 512 + C.tid, NGT = C.G * 512;
    for (int i = gt; i < 2 * 2 * 8 * 1024; i += NGT) { const int d = i & 1023, b = (i >> 10) & 7, kind = (i >> 13) & 1, l = i >> 14;
        const float g = kind ? a.in[IN_NFFN][l * D + d] : a.in[IN_NMIX][l * D + d];
        GM[i] = g * (1.f + ADA[(size_t)(l * 8 + b) * 6144 + (kind ? 4 : 1) * 1024 + d]); }
    const int gw = C.vcu * NWAVES + C.wave, NGW = C.G * NWAVES;
    for (int o = gw; o < 512; o += NGW) { const int e = o & 31, b = (o >> 5) & 7, l = o >> 8; float s = 0.f;
        for (int d = C.lane; d < D; d += 64) s += ADA[(size_t)(l * 8 + b) * 6144 + 3 * 1024 + d] * a.in[IN_RW][(size_t)l * D * 32 + d * 32 + e];
        s = wave_sum(s); if (C.lane == 0) CSH[o] = s + a.in[IN_RB][l * 32 + e]; }
    bf16* H = (bf16*)(C.ws + WS_H);
    for (int m = gw; m < T; m += NGW) {
        const int b = m >> 12;
        const f32x4* xr = (const f32x4*)(a.in[IN_X] + (size_t)m * D) + C.lane;
        const f32x4* gr = (const f32x4*)(a.in[IN_NMIX]) + C.lane;
        const f32x4* sc = (const f32x4*)(ADA + (size_t)b * 6144 + 1024) + C.lane;
        const f32x4* sh = (const f32x4*)(ADA + (size_t)b * 6144) + C.lane;
        f32x4 v[4]; float s = 0.f;
#pragma unroll
        for (int j = 0; j < 4; ++j) { v[j] = xr[64 * j]; s += (v[j].x * v[j].x + v[j].y * v[j].y) + (v[j].z * v[j].z + v[j].w * v[j].w); }
        const float rstd = 1.f / sqrtf(wave_sum(s) * (1.f / D) + RMS_EPS);
        unsigned long long* o8 = (unsigned long long*)(H + (size_t)m * D) + C.lane; unsigned* o4 = (unsigned*)(C.ws + WS_H8 + (size_t)m * D) + C.lane;
#pragma unroll
        for (int j = 0; j < 4; ++j) { const f32x4 h = v[j] * rstd * gr[64 * j] * (sc[64 * j] + 1.f) + sh[64 * j];
            if (QKV_FP8) o4[64 * j] = pg8::pk4_fp8(h.x, h.y, h.z, h.w);
            else o8[64 * j] = (unsigned long long)pkbf(h.x, h.y) | ((unsigned long long)pkbf(h.z, h.w) << 32); }
    }
}

__device__ __forceinline__ void p3_dilated(const Ctx& C) {
    attn_body::band_phase<0>((const attn_body::bf16*)(C.ws + WS_QKV0), (attn_body::bf16*)(C.ws + WS_OG), (float*)(C.ws + SM_LSE), (const float*)(C.ws + SM_BIAST), C.vcu, C.G, 384 * 16, (char*)C.lds + RING_OFF);
}
template <int MODE> __device__ __forceinline__ void p12_fox(const Ctx& C, size_t o_off) {
    const attn_body::bf16* QKV = (const attn_body::bf16*)(C.ws + WS_QKV1);
    attn_body::bf16* O = (attn_body::bf16*)(C.ws + o_off); const float* FC = (const float*)(C.ws + SM_FCUM);
    LAS float* Fl = (LAS float*)(C.lds + RING_OFF + attn_body::T_F);
    LAS int* qslot = (LAS int*)(C.lds + BLK_OFF);
    unsigned* qhead = (unsigned*)(C.ws + WS_CTL) + CW_QUEUE; const unsigned* NRM = (const unsigned*)(C.ws + WS_CTL) + CW_NRM;
    int cur_bh = -1; float thr = 0.f;
    for (;;) {
        int l_; asm volatile("v_mbcnt_lo_u32_b32 %0, -1, 0\n\tv_mbcnt_hi_u32_b32 %0, -1, %0" : "=v"(l_)); const int t_ = C.wave * 64 + l_;
        __syncthreads();
        if (t_ == 0) qslot[0] = (int)__hip_atomic_fetch_add(qhead, 1u, __ATOMIC_RELAXED, __HIP_MEMORY_SCOPE_AGENT);
        __syncthreads();
        const int idx = qslot[0];
        if (idx >= 2048) break;
        const int qb = 15 - (idx >> 7), bh = idx & 127, b = bh >> 4, h = bh & 15, q0 = qb * 256;
        const attn_body::bf16* Qp = QKV + ((size_t)(b * 3 + 0) * 16 + h) * 4096 * 64;
        const attn_body::bf16* Kp = QKV + ((size_t)(b * 3 + 1) * 16 + h) * 4096 * 64;
        const attn_body::bf16* Vp = QKV + ((size_t)(b * 3 + 2) * 16 + h) * 4096 * 64;
        if (bh != cur_bh) {
            { const f32x4* src = (const f32x4*)(FC + (size_t)bh * 4096); LAS f32x4* dst = (LAS f32x4*)Fl; dst[t_] = src[t_]; dst[512 + t_] = src[512 + t_]; }
            const float gq = __uint_as_float(NRM[((b * 2 + 0) * 16 + h) * 2]) + __uint_as_float(NRM[((b * 2 + 0) * 16 + h) * 2 + 1]);
            const float gk = __uint_as_float(NRM[((b * 2 + 1) * 16 + h) * 2]) + __uint_as_float(NRM[((b * 2 + 1) * 16 + h) * 2 + 1]);
            thr = 2.f * (sqrtf(gq) * sqrtf(gk) * 1.001f + 1e-3f) + 152.f;
            cur_bh = bh;
            __syncthreads();
        }
        int tlo = 0;
        if (MODE == 1) {
            const int NTq = 4 * qb;
            const bool dead = (l_ < NTq) && (Fl[q0] - Fl[64 * l_ + 63] <= -thr);
            tlo = __popcll(__ballot(dead)) & ~1;
        }
        attn_body::attn_unit_t<MODE, 64>(Qp + (size_t)q0 * 64, Kp + (size_t)tlo * 4096, Vp + (size_t)tlo * 4096, 4 * qb + 4 - tlo, 64 * tlo, (WO_FP8 && MODE == 1) ? (attn_body::bf16*)((unsigned char*)O + ((size_t)b * 4096 + q0) * D + h * 64) : O + ((size_t)b * 4096 + q0) * D + h * 64, (long)D, nullptr, 0, (char*)C.lds + RING_OFF);
    }
}
__device__ __forceinline__ void p4_merge(const Ctx& C) {
    const bf16* OG = (const bf16*)(C.ws + WS_OG); const float* LSE = (const float*)(C.ws + SM_LSE); bf16* O = (bf16*)(C.ws + WS_O);
    const int gt = C.vcu * 512 + C.tid, NGT = C.G * 512;
    for (int i = gt; i < T * 128; i += NGT) { const int tok = i >> 7, c8 = i & 127, hd = c8 >> 3;
        const float l0 = LSE[(size_t)tok * 16 + hd], l1 = LSE[((size_t)T + tok) * 16 + hd], l2 = LSE[((size_t)2 * T + tok) * 16 + hd];
        const float mx = fmaxf(l0, fmaxf(l1, l2)); float w0 = __builtin_amdgcn_exp2f(l0 - mx), w1 = __builtin_amdgcn_exp2f(l1 - mx), w2 = __builtin_amdgcn_exp2f(l2 - mx);
        const float inv = 1.f / (w0 + w1 + w2); w0 *= inv; w1 *= inv; w2 *= inv;
        const u32x4v a0 = *(const u32x4v*)(OG + (size_t)tok * D + c8 * 8), a1 = *(const u32x4v*)(OG + ((size_t)T + tok) * D + c8 * 8), a2 = *(const u32x4v*)(OG + ((size_t)2 * T + tok) * D + c8 * 8);
        u32x4v o;
#pragma unroll
        for (int k = 0; k < 4; ++k) { const float lo = w0 * bf2f(a0[k] & 0xffffu) + w1 * bf2f(a1[k] & 0xffffu) + w2 * bf2f(a2[k] & 0xffffu);
            float hi = w0 * bf2f(a0[k] >> 16) + w1 * bf2f(a1[k] >> 16) + w2 * bf2f(a2[k] >> 16); float lo2 = lo;
#if PROBE_SANITIZE
            if (!(fabsf(lo2) < 1e30f)) lo2 = 0.f; if (!(fabsf(hi) < 1e30f)) hi = 0.f;
#endif
            o[k] = pkbf(lo2, hi); }
        if (WO_FP8) { u32x2v o8; o8.x = pg8::pk4_fp8(bf2f(o[0] & 0xffffu), bf2f(o[0] >> 16), bf2f(o[1] & 0xffffu), bf2f(o[1] >> 16)); o8.y = pg8::pk4_fp8(bf2f(o[2] & 0xffffu), bf2f(o[2] >> 16), bf2f(o[3] & 0xffffu), bf2f(o[3] >> 16));
            *(u32x2v*)((unsigned char*)O + (size_t)tok * D + c8 * 8) = o8; }
        else *(u32x4v*)(O + (size_t)tok * D + c8 * 8) = o; }
}

__device__ __forceinline__ f32x4 bf4_to_f32(u32x2v v) { return (f32x4){bf2f(v.x & 0xffffu), bf2f(v.x >> 16), bf2f(v.y & 0xffffu), bf2f(v.y >> 16)}; }
typedef u32x2v xs4_t;
__device__ __forceinline__ f32x4 xs4_to_f32(xs4_t v) { return bf4_to_f32(v); }
__device__ __forceinline__ xs4_t f32_to_xs4(f32x4 v) { xs4_t r; r.x = pkbf(v.x, v.y); r.y = pkbf(v.z, v.w); return r; }
#if Y_FP8
typedef unsigned yraw4_t;
__device__ __forceinline__ f32x4 y4_to_f32(yraw4_t v) { const auto lo = __builtin_amdgcn_cvt_pk_f32_fp8((int)v, false), hi = __builtin_amdgcn_cvt_pk_f32_fp8((int)v, true); return (f32x4){lo[0], lo[1], hi[0], hi[1]}; }
#define Y_ROWPTR(Yb, slot) ((const yraw4_t*)((const unsigned char*)(Yb) + (size_t)(slot) * D) + C.lane)
#else
typedef u32x2v yraw4_t;
__device__ __forceinline__ f32x4 y4_to_f32(yraw4_t v) { return bf4_to_f32(v); }
#define Y_ROWPTR(Yb, slot) ((const yraw4_t*)((Yb) + (size_t)(slot) * D) + C.lane)
#endif

__device__ __forceinline__ void r1_router(const Ctx& C, const Args& a, int l) {
    LAS float* scrf = (LAS float*)(C.lds + SCR_OFF + C.wave * 2048);
    LAS int* scri = (LAS int*)scrf;
    LAS int* blk = (LAS int*)(C.lds + BLK_OFF);
    const float* rw = a.in[IN_RW] + (size_t)l * D * 32;
    LAS unsigned short* wh = (LAS unsigned short*)(C.lds + RING_OFF); LAS unsigned short* wlo = (LAS unsigned short*)(C.lds + RING_OFF + 65536);
    int tab_b = -1;
    const bf16* XS = (const bf16*)(C.ws + WS_XS); unsigned char* H8 = (unsigned char*)(C.ws + WS_H8);
    const float* ADA = (const float*)(C.ws + SM_ADA) + (size_t)l * 8 * 6144;
    const float* GM = (const float*)(C.ws + SM_GM) + (size_t)(l * 2 + 1) * 8 * 1024;
    const float* CSH = (const float*)(C.ws + SM_CSH) + l * 256;
    int* TOPI = (int*)(C.ws + SM_TOPI); float* TOPG = (float*)(C.ws + SM_TOPG); int* RANK = (int*)(C.ws + SM_RANK); int* BLKCNT = (int*)(C.ws + SM_BLKCNT);
    const int tk = C.lane & 15, q = C.lane >> 4;
    for (int vb = C.vcu; vb < NVB; vb += C.G) {
        const int tok0 = vb * 128 + C.wave * 16, b = tok0 >> 12, tok = tok0 + tk;
        if (b != tab_b) {
            __syncthreads();
            const float* gmb = GM + b * 1024;
            for (int i = C.tid; i < D * 32; i += 512) { const int dd = i >> 5, e = i & 31; const float w = rw[i] * gmb[dd];
                const unsigned hb = pkbf(w, 0.f) & 0xffffu; const float hf = bf2f(hb); const unsigned lb = pkbf(w - hf, 0.f) & 0xffffu;
                const int pos = ((((dd >> 5) * 4 + ((dd >> 3) & 3)) * 32 + e) << 3) + (dd & 7);
                wh[pos] = (unsigned short)hb; wlo[pos] = (unsigned short)lb; }
            __syncthreads();
            tab_b = b;
        }
        const bf16* xrow = XS + (size_t)tok * D + 8 * q;
        f32x4 acc0 = {0.f, 0.f, 0.f, 0.f}, acc1 = {0.f, 0.f, 0.f, 0.f}; float ssq = 0.f;
        typedef short bf16x8r __attribute__((ext_vector_type(8)));
#pragma unroll 4
        for (int kk = 0; kk < 32; ++kk) {
            const u32x4v xr8 = *(const u32x4v*)(xrow + 32 * kk);
#pragma unroll
            for (int e2 = 0; e2 < 4; ++e2) { const float x0 = bf2f(xr8[e2] & 0xffffu), x1 = bf2f(xr8[e2] >> 16); ssq += x0 * x0 + x1 * x1; }
            const bf16x8r xb = __builtin_bit_cast(bf16x8r, xr8);
            const int fo = ((kk * 4 + q) * 32 + tk) << 3;
            const bf16x8r h0 = *(const LAS bf16x8r*)(wh + fo), h1 = *(const LAS bf16x8r*)(wh + fo + 128), l0 = *(const LAS bf16x8r*)(wlo + fo), l1 = *(const LAS bf16x8r*)(wlo + fo + 128);
            acc0 = __builtin_amdgcn_mfma_f32_16x16x32_bf16(h0, xb, acc0, 0, 0, 0); acc1 = __builtin_amdgcn_mfma_f32_16x16x32_bf16(h1, xb, acc1, 0, 0, 0);
            acc0 = __builtin_amdgcn_mfma_f32_16x16x32_bf16(l0, xb, acc0, 0, 0, 0); acc1 = __builtin_amdgcn_mfma_f32_16x16x32_bf16(l1, xb, acc1, 0, 0, 0);
        }
        ssq += __shfl_xor(ssq, 16); ssq += __shfl_xor(ssq, 32);
        const float rstd = 1.f / sqrtf(ssq * (1.f / D) + RMS_EPS);
        { const f32x4 c0 = *(const f32x4*)(CSH + b * 32 + 4 * q), c1 = *(const f32x4*)(CSH + b * 32 + 16 + 4 * q);
          *(LAS f32x4*)(scrf + tk * 32 + 4 * q) = acc0 * rstd + c0; *(LAS f32x4*)(scrf + tk * 32 + 16 + 4 * q) = acc1 * rstd + c1; }
        LDS_WAIT();
        int myidx[4] = {0, 0, 0, 0};
        if (C.lane < 16) {
            float v[32];
#pragma unroll
            for (int j = 0; j < 8; ++j) { const f32x4 t4 = *(const LAS f32x4*)(scrf + C.lane * 32 + 4 * j); v[4 * j] = t4.x; v[4 * j + 1] = t4.y; v[4 * j + 2] = t4.z; v[4 * j + 3] = t4.w; }
            float val[4];
#pragma unroll
            for (int k = 0; k < 4; ++k) { float best = v[0]; int bi = 0;
#pragma unroll
                for (int e = 1; e < 32; ++e) { if (v[e] > best) { best = v[e]; bi = e; } }
                val[k] = best; myidx[k] = bi;
#pragma unroll
                for (int e = 0; e < 32; ++e) v[e] = (e == bi) ? -INFINITY : v[e]; }
            const float e1 = __expf(val[1] - val[0]), e2 = __expf(val[2] - val[0]), e3 = __expf(val[3] - val[0]), inv = 1.f / (1.f + e1 + e2 + e3);
            *(i32x4v*)(TOPI + (size_t)(tok0 + C.lane) * 4) = (i32x4v){myidx[0], myidx[1], myidx[2], myidx[3]};
            *(f32x4*)(TOPG + (size_t)(tok0 + C.lane) * 4) = (f32x4){inv, e1 * inv, e2 * inv, e3 * inv};
        }
        LDS_WAIT();
        if (C.lane < 16) *(LAS i32x4v*)(scri + C.lane * 4) = (i32x4v){myidx[0], myidx[1], myidx[2], myidx[3]};
        LDS_WAIT();
        const int e = scri[C.lane];
        const unsigned long long lt = (1ull << C.lane) - 1ull;
        int rank = 0, mycnt = 0;
#pragma unroll 4
        for (int j = 0; j < 32; ++j) { const unsigned long long mk = __ballot(e == j); if (e == j) rank = __popcll(mk & lt); if (C.lane == j) mycnt = __popcll(mk); }
        if (C.lane < 32) blk[BL_WCNT + C.wave * 32 + C.lane] = mycnt;
        __syncthreads();
        if (C.lane < 32) { int wb = 0;
            for (int w8 = 0; w8 < C.wave; ++w8) wb += blk[BL_WCNT + w8 * 32 + C.lane];
            blk[BL_WBASE + C.wave * 32 + C.lane] = wb;
            if (C.wave == NWAVES - 1) BLKCNT[vb * 32 + C.lane] = wb + mycnt; }
        LDS_WAIT();
        RANK[(size_t)tok0 * 4 + C.lane] = blk[BL_WBASE + C.wave * 32 + e] + rank;
        const f32x4* shf = (const f32x4*)(ADA + (size_t)b * 6144 + 3 * 1024) + C.lane; const f32x4* gm4 = (const f32x4*)(GM + b * 1024) + C.lane;
#pragma unroll 2
        for (int tt = 0; tt < 16; ++tt) { const float rs = __shfl(rstd, tt); const int tkn = tok0 + tt;
            const xs4_t* xr = (const xs4_t*)(XS + (size_t)tkn * D) + C.lane; unsigned* o4 = (unsigned*)(H8 + (size_t)tkn * D) + C.lane;
#pragma unroll
            for (int j = 0; j < 4; ++j) { const f32x4 h = xs4_to_f32(xr[64 * j]) * rs * gm4[64 * j] + shf[64 * j];
                o4[64 * j] = pg8::pk4_fp8(h.x, h.y, h.z, h.w); } }
        __syncthreads();
    }
}

__device__ __forceinline__ void p7_route(const Ctx& C) {
    LAS int* blk = (LAS int*)(C.lds + BLK_OFF);
    const int* BLKCNT = (const int*)(C.ws + SM_BLKCNT); const int* TOPI = (const int*)(C.ws + SM_TOPI); const int* RANK = (const int*)(C.ws + SM_RANK);
    int* SLOT = (int*)(C.ws + SM_SLOT); int* TILEEXP = (int*)(C.ws + SM_TILEEXP); int* TOKSLOT = (int*)(C.ws + SM_TOKSLOT);
    const unsigned char* H8 = (const unsigned char*)(C.ws + WS_H8); unsigned char* XB = (unsigned char*)(C.ws + WS_XB);
    const int e = C.tid & 31, part = C.tid >> 5;
    { int s = 0; for (int k = 0; k < 16; ++k) s += BLKCNT[(part * 16 + k) * 32 + e]; blk[BL_PARTA + part * 32 + e] = s; }
    __syncthreads();
    if (C.tid < 32) { int tot = 0; for (int p = 0; p < 16; ++p) tot += blk[BL_PARTA + p * 32 + C.tid]; blk[BL_TOT + C.tid] = tot; }
    __syncthreads();
    if (C.tid == 0) { int run = 0; for (int k = 0; k < 32; ++k) { blk[BL_PADS + k] = run; run += (blk[BL_TOT + k] + 255) & ~255; } blk[BL_PADS + 32] = run; }
    __syncthreads();
    if (C.vcu == 0) {
        const int nt = blk[BL_PADS + 32] >> 8;
        if (C.tid == 0) TILEEXP[0] = nt;
        for (int i = C.tid; i < nt; i += 512) { int ex = 0; for (int k = 1; k < 32; ++k) ex += (blk[BL_PADS + k] <= i * 256) ? 1 : 0; TILEEXP[16 + i] = ex; }
        if (C.tid < 33) TILEEXP[640 + C.tid] = blk[BL_PADS + C.tid] >> 8;
    }
    for (int vb = C.vcu; vb < NVB; vb += C.G) {
        __syncthreads();
        { int s = 0; for (int k = 0; k < 16; ++k) { const int bb = part * 16 + k; s += (bb < vb) ? BLKCNT[bb * 32 + e] : 0; } blk[BL_PARTB + part * 32 + e] = s; }
        __syncthreads();
        if (C.tid < 32) { int bs = 0; for (int p = 0; p < 16; ++p) bs += blk[BL_PARTB + p * 32 + C.tid]; blk[BL_BASE + C.tid] = bs + blk[BL_PADS + C.tid]; }
        __syncthreads();
        { const int i = vb * 512 + C.tid; const int ex = TOPI[i]; SLOT[i] = blk[BL_BASE + ex] + RANK[i]; }
        VM_WAIT(); __syncthreads();
#if MOE_GATHER
        { const int i = vb * 512 + C.tid; TOKSLOT[SLOT[i]] = i >> 2; }
#else
        for (int tt = 0; tt < 16; ++tt) { const int tok = vb * 128 + C.wave * 16 + tt;
            const i32x4v sl = *(const i32x4v*)(SLOT + (size_t)tok * 4);
            const u32x4v v0 = *((const u32x4v*)(H8 + (size_t)tok * D) + C.lane);
#pragma unroll
            for (int k = 0; k < 4; ++k) { u32x4v* dst = (u32x4v*)(XB + (size_t)sl[k] * D); dst[C.lane] = v0; } }
#endif
    }
#if MOE_GATHER
    for (int ex = C.vcu; ex < 32; ex += C.G) { const int beg = blk[BL_PADS + ex] + blk[BL_TOT + ex], end = blk[BL_PADS + ex + 1];
        for (int s = beg + C.tid; s < end; s += 512) TOKSLOT[s] = 0; }
#endif
}
__device__ __forceinline__ int load_tile_table(const Ctx& C) {
    LAS int* blk = (LAS int*)(C.lds + BLK_OFF); const int* TILEEXP = (const int*)(C.ws + SM_TILEEXP);
    const int nt = TILEEXP[0];
    __syncthreads();
    for (int i = C.tid; i < MAXTILES; i += 512) blk[BL_TILE + i] = (i < nt) ? TILEEXP[16 + i] : 0;
    __syncthreads();
    return __builtin_amdgcn_readfirstlane(nt);
}


__device__ __forceinline__ void r2_seam(const Ctx& C, const Args& a) {
    LAS float* wl = (LAS float*)(C.lds + RING_OFF);
    { const float* wf = a.in[IN_WKVF]; const float* gkv0 = a.in[IN_KVNG];
      for (int i = C.tid; i < D * 16; i += 512) { const int d = i >> 4, h = i & 15, jj = d >> 8, ln = (d >> 2) & 63, c = d & 3;
          wl[((((jj * 4 + c) * 4 + (h >> 2)) * 64 + ln) << 2) + (h & 3)] = wf[(size_t)d * 2064 + 2048 + h] * gkv0[d]; } }
    __syncthreads();
    bf16* XS = (bf16*)(C.ws + WS_XS); bf16* HKV = (bf16*)(C.ws + WS_HKV); const bf16* Y = (const bf16*)(C.ws + WS_Y);
    const float* ADA0 = (const float*)(C.ws + SM_ADA); const float* ADA1 = ADA0 + (size_t)8 * 6144;
    const float* GM1 = (const float*)(C.ws + SM_GM) + (size_t)(1 * 2 + 0) * 8 * 1024;
    const int* SLOT = (const int*)(C.ws + SM_SLOT); const float* TOPG = (const float*)(C.ws + SM_TOPG); float* LOGF = (float*)(C.ws + SM_LOGF);
    const f32x4* gk4 = (const f32x4*)a.in[IN_KVNG] + C.lane;
    const int gw = C.vcu * NWAVES + C.wave, NGW = C.G * NWAVES;
    const float bfh = a.in[IN_BF][(C.lane >> 2) & 15];
    typedef yraw4_t yraw_t;
#define R2_LOADRAW(XR, Y0, Y1, Y2, Y3, MM, SS) do { const xs4_t* xr_ = (const xs4_t*)(XS + (size_t)(MM) * D) + C.lane; \
        const yraw4_t* z0_ = Y_ROWPTR(Y, (SS)[0]); const yraw4_t* z1_ = Y_ROWPTR(Y, (SS)[1]); \
        const yraw4_t* z2_ = Y_ROWPTR(Y, (SS)[2]); const yraw4_t* z3_ = Y_ROWPTR(Y, (SS)[3]); \
        _Pragma("unroll") for (int j = 0; j < 4; ++j) { XR[j] = xr_[64 * j]; Y0[j] = z0_[64 * j]; Y1[j] = z1_[64 * j]; Y2[j] = z2_[64 * j]; Y3[j] = z3_[64 * j]; } } while (0)
    xs4_t xc[4], xn[4]; yraw_t y0c[4], y1c[4], y2c[4], y3c[4], y0n[4], y1n[4], y2n[4], y3n[4];
    i32x4v s_cur = *(const i32x4v*)(SLOT + (size_t)gw * 4); f32x4 g_cur = *(const f32x4*)(TOPG + (size_t)gw * 4);
    i32x4v s_nxt = s_cur; f32x4 g_nxt = g_cur;
    if (gw + NGW < T) { s_nxt = *(const i32x4v*)(SLOT + (size_t)(gw + NGW) * 4); g_nxt = *(const f32x4*)(TOPG + (size_t)(gw + NGW) * 4); }
    R2_LOADRAW(xc, y0c, y1c, y2c, y3c, gw, s_cur);
    for (int m = gw; m < T; m += NGW) { const int b = m >> 12;
        const int mn = m + NGW, mnn = m + 2 * NGW;
        i32x4v s_nn = s_nxt; f32x4 g_nn = g_nxt;
        if (mnn < T) { s_nn = *(const i32x4v*)(SLOT + (size_t)mnn * 4); g_nn = *(const f32x4*)(TOPG + (size_t)mnn * 4); }
        if (mn < T) R2_LOADRAW(xn, y0n, y1n, y2n, y3n, mn, s_nxt);
        const f32x4* gf4 = (const f32x4*)(ADA0 + (size_t)b * 6144 + 5 * 1024) + C.lane;
        const f32x4* gm4 = (const f32x4*)(GM1 + b * 1024) + C.lane; const f32x4* shm4 = (const f32x4*)(ADA1 + (size_t)b * 6144) + C.lane;
        xs4_t* xw = (xs4_t*)(XS + (size_t)m * D) + C.lane;
        f32x4 v[4]; float s = 0.f;
#pragma unroll
        for (int j = 0; j < 4; ++j) {
            const f32x4 ys = y4_to_f32(y0c[j]) * g_cur[0] + y4_to_f32(y1c[j]) * g_cur[1] + y4_to_f32(y2c[j]) * g_cur[2] + y4_to_f32(y3c[j]) * g_cur[3];
            v[j] = xs4_to_f32(xc[j]) + gf4[64 * j] * ys; xw[64 * j] = f32_to_xs4(v[j]); v[j] = xs4_to_f32(f32_to_xs4(v[j]));
            s += (v[j].x * v[j].x + v[j].y * v[j].y) + (v[j].z * v[j].z + v[j].w * v[j].w); }
        const float rstd = 1.f / sqrtf(wave_sum(s) * (1.f / D) + RMS_EPS);
        float acc[16];
#pragma unroll
        for (int h = 0; h < 16; ++h) acc[h] = 0.f;
#pragma unroll
        for (int j = 0; j < 4; ++j)
#pragma unroll
            for (int c = 0; c < 4; ++c) { const float xv = v[j][c];
#pragma unroll
                for (int h4 = 0; h4 < 4; ++h4) { const f32x4 w = *(const LAS f32x4*)(wl + ((((j * 4 + c) * 4 + h4) * 64 + C.lane) << 2));
                    acc[4 * h4] += xv * w[0]; acc[4 * h4 + 1] += xv * w[1]; acc[4 * h4 + 2] += xv * w[2]; acc[4 * h4 + 3] += xv * w[3]; }
                if (c == 3) __builtin_amdgcn_sched_barrier(0); }
#pragma unroll
        for (int j = 0; j < 4; ++j) { const f32x4 n = v[j] * rstd, h = n * gm4[64 * j] + shm4[64 * j], hk = n * gk4[64 * j];
            if (KVQ_FP8) { ((unsigned*)(C.ws + WS_HKV + (size_t)T * D + (size_t)m * D) + C.lane)[64 * j] = pg8::pk4_fp8(h.x, h.y, h.z, h.w);
                           ((unsigned*)(C.ws + WS_HKV + (size_t)m * D) + C.lane)[64 * j] = pg8::pk4_fp8(hk.x, hk.y, hk.z, hk.w); }
            else { ((unsigned long long*)(HKV + (size_t)T * D + (size_t)m * D) + C.lane)[64 * j] = (unsigned long long)pkbf(h.x, h.y) | ((unsigned long long)pkbf(h.z, h.w) << 32);
                   ((unsigned long long*)(HKV + (size_t)m * D) + C.lane)[64 * j] = (unsigned long long)pkbf(hk.x, hk.y) | ((unsigned long long)pkbf(hk.z, hk.w) << 32); } }
        __builtin_amdgcn_sched_barrier(0);
        float r8[8], r4[4], r2v[2], r1;
        { const bool up = (C.lane & 32) != 0;
#pragma unroll
          for (int i = 0; i < 8; ++i) { const float snd = up ? acc[i] : acc[i + 8], kp = up ? acc[i + 8] : acc[i]; r8[i] = kp + __shfl_xor(snd, 32); } }
        { const bool up = (C.lane & 16) != 0;
#pragma unroll
          for (int i = 0; i < 4; ++i) { const float snd = up ? r8[i] : r8[i + 4], kp = up ? r8[i + 4] : r8[i]; r4[i] = kp + __shfl_xor(snd, 16); } }
        { const bool up = (C.lane & 8) != 0;
#pragma unroll
          for (int i = 0; i < 2; ++i) { const float snd = up ? r4[i] : r4[i + 2], kp = up ? r4[i + 2] : r4[i]; r2v[i] = kp + __shfl_xor(snd, 8); } }
        { const bool up = (C.lane & 4) != 0; const float snd = up ? r2v[0] : r2v[1], kp = up ? r2v[1] : r2v[0]; r1 = kp + __shfl_xor(snd, 4); }
        r1 += __shfl_xor(r1, 2); r1 += __shfl_xor(r1, 1);
        if ((C.lane & 3) == 0) { const float z = r1 * rstd + bfh; LOGF[(size_t)m * 16 + ((C.lane >> 2) & 15)] = (fminf(z, 0.f) - log1pf(__expf(-fabsf(z)))) * LOG2E; }
#pragma unroll
        for (int j = 0; j < 4; ++j) { xc[j] = xn[j]; y0c[j] = y0n[j]; y1c[j] = y1n[j]; y2c[j] = y2n[j]; y3c[j] = y3n[j]; }
        s_cur = s_nxt; g_cur = g_nxt; s_nxt = s_nn; g_nxt = g_nn;
    }
#undef R2_LOADRAW
}
__device__ __forceinline__ void fcum_scan(const Ctx& C) {
    const float* LOGF = (const float*)(C.ws + SM_LOGF); float* FC = (float*)(C.ws + SM_FCUM);
    LAS float* wtot = (LAS float*)(C.lds + BLK_OFF);
    for (int sq = C.vcu; sq < 128; sq += C.G) { const int b = sq >> 4, h = sq & 15;
        const float* src = LOGF + ((size_t)b * 4096 + C.tid * 8) * 16 + h; float* dst = FC + (size_t)sq * 4096 + C.tid * 8;
        float v[8]; float tot = 0.f;
#pragma unroll
        for (int i = 0; i < 8; ++i) { v[i] = src[i * 16]; }
#pragma unroll
        for (int i = 0; i < 8; ++i) { tot += v[i]; v[i] = tot; }
        float inc = tot;
#pragma unroll
        for (int o = 1; o < 64; o <<= 1) { const float t = __shfl_up(inc, o); if (C.lane >= o) inc += t; }
        __syncthreads();
        if (C.lane == 63) wtot[C.wave] = inc;
        __syncthreads();
        float carry = inc - tot;
        for (int w8 = 0; w8 < C.wave; ++w8) carry += wtot[w8];
#pragma unroll
        for (int i = 0; i < 8; ++i) dst[i] = v[i] + carry;
    }
}
__device__ __forceinline__ void r3_final(const Ctx& C, const Args& a, float* XD) {
    const bf16* XS = (const bf16*)(C.ws + WS_XS); const bf16* Y = (const bf16*)(C.ws + WS_Y);
    const float* ADA1 = (const float*)(C.ws + SM_ADA) + (size_t)8 * 6144;
    const int* SLOT = (const int*)(C.ws + SM_SLOT); const float* TOPG = (const float*)(C.ws + SM_TOPG);
    const f32x4* fg4 = (const f32x4*)a.in[IN_FNG] + C.lane;
    const int gw = C.vcu * NWAVES + C.wave, NGW = C.G * NWAVES;
#define R3_LOADRAW(XR, Y0, Y1, Y2, Y3, MM, SS) do { const xs4_t* xr_ = (const xs4_t*)(XS + (size_t)(MM) * D) + C.lane; \
        const yraw4_t* z0_ = Y_ROWPTR(Y, (SS)[0]); const yraw4_t* z1_ = Y_ROWPTR(Y, (SS)[1]); \
        const yraw4_t* z2_ = Y_ROWPTR(Y, (SS)[2]); const yraw4_t* z3_ = Y_ROWPTR(Y, (SS)[3]); \
        _Pragma("unroll") for (int j = 0; j < 4; ++j) { XR[j] = xr_[64 * j]; Y0[j] = z0_[64 * j]; Y1[j] = z1_[64 * j]; Y2[j] = z2_[64 * j]; Y3[j] = z3_[64 * j]; } } while (0)
    xs4_t xc[4], xn[4]; yraw4_t y0c[4], y1c[4], y2c[4], y3c[4], y0n[4], y1n[4], y2n[4], y3n[4];
    i32x4v s_cur = *(const i32x4v*)(SLOT + (size_t)gw * 4); f32x4 g_cur = *(const f32x4*)(TOPG + (size_t)gw * 4);
    i32x4v s_nxt = s_cur; f32x4 g_nxt = g_cur;
    if (gw + NGW < T) { s_nxt = *(const i32x4v*)(SLOT + (size_t)(gw + NGW) * 4); g_nxt = *(const f32x4*)(TOPG + (size_t)(gw + NGW) * 4); }
    R3_LOADRAW(xc, y0c, y1c, y2c, y3c, gw, s_cur);
    for (int m = gw; m < T; m += NGW) { const int b = m >> 12;
        const int mn = m + NGW, mnn = m + 2 * NGW;
        i32x4v s_nn = s_nxt; f32x4 g_nn = g_nxt;
        if (mnn < T) { s_nn = *(const i32x4v*)(SLOT + (size_t)mnn * 4); g_nn = *(const f32x4*)(TOPG + (size_t)mnn * 4); }
        if (mn < T) R3_LOADRAW(xn, y0n, y1n, y2n, y3n, mn, s_nxt);
        const f32x4* gf4 = (const f32x4*)(ADA1 + (size_t)b * 6144 + 5 * 1024) + C.lane;
        f32x4* xw = (f32x4*)(XD + (size_t)m * D) + C.lane;
        f32x4 v[4]; float s = 0.f;
#pragma unroll
        for (int j = 0; j < 4; ++j) {
            const f32x4 ys = y4_to_f32(y0c[j]) * g_cur[0] + y4_to_f32(y1c[j]) * g_cur[1] + y4_to_f32(y2c[j]) * g_cur[2] + y4_to_f32(y3c[j]) * g_cur[3];
            v[j] = xs4_to_f32(xc[j]) + gf4[64 * j] * ys; s += (v[j].x * v[j].x + v[j].y * v[j].y) + (v[j].z * v[j].z + v[j].w * v[j].w); }
        const float rstd = 1.f / sqrtf(wave_sum(s) * (1.f / D) + RMS_EPS);
#pragma unroll
        for (int j = 0; j < 4; ++j) xw[64 * j] = v[j] * rstd * fg4[64 * j];
#pragma unroll
        for (int j = 0; j < 4; ++j) { xc[j] = xn[j]; y0c[j] = y0n[j]; y1c[j] = y1n[j]; y2c[j] = y2n[j]; y3c[j] = y3n[j]; }
        s_cur = s_nxt; g_cur = g_nxt; s_nxt = s_nn; g_nxt = g_nn;
    }
#undef R3_LOADRAW
}

constexpr int N_PHASES = 19;
__global__ void __launch_bounds__(NWAVES * 64, 2) yoco_fwd(Args args) {
    extern __shared__ __attribute__((aligned(16))) unsigned char lds[];
    Ctx C;
    C.lds = (LAS unsigned char*)lds; C.ws = args.ws;
    C.tid = threadIdx.x; C.lane = C.tid & 63; C.wave = __builtin_amdgcn_readfirstlane(C.tid >> 6);
    C.G = gridDim.x; { const int bx = blockIdx.x; C.vcu = (C.G % 8 == 0) ? (bx % 8) * (C.G / 8) + bx / 8 : bx; }
    volatile LAS unsigned* MISC = (volatile LAS unsigned*)(C.lds + MISC_OFF);
    if (C.tid < 64) MISC[C.tid] = 0u;
    __syncthreads();
    const int lo = args.ph_lo, hi = args.ph_hi;
    const bool one = (hi - lo) > 1;
    unsigned* ctl = (unsigned*)(args.ws + WS_CTL);
    XcdBarrier bar; bar.bar = ctl + CW_BAR; bar.x = 0; bar.st = nullptr;
    if (one) bar = xcd_barrier_post(ctl + CW_BAR, MISC + 8);
#define IN(k) (lo <= (k) && (k) < hi)
#define SEAM(k) do { if (IN(k) && IN((k) + 1)) xcd_barrier(bar); } while (0)
#define FRESH() do { int l_; asm volatile("v_mbcnt_lo_u32_b32 %0, -1, 0\n\tv_mbcnt_hi_u32_b32 %0, -1, %0" : "=v"(l_)); C.lane = l_; C.tid = C.wave * 64 + l_; } while (0)
#define REP(k) _Pragma("unroll") for (int rep_ = 0; rep_ < 1 + ((PROBE_DUP >> (k)) & 1); ++rep_)
    bf16* const Hb = (bf16*)(C.ws + WS_H);
    if (IN(0)) { FRESH(); REP(0) { p0_prologue(C, args); } SEAM(0); }
    if (IN(1)) { FRESH(); REP(1) { p1_rows0(C, args); } SEAM(1); }
    if (IN(2)) { FRESH();
#if PROBE_QKV
        { pg8::Gemm g{(const pg8::bf16_t*)(C.ws + WS_H8), (const pg8::bf16_t*)(C.ws + WS_WQKV), T, NQKV, D}; pg8::StaticOrder S; S.init(T, NQKV, C.G, (int)blockIdx.x);
#if PROBE_QKV == 1
          pg8::EpiQKV0 E{(pg8::bf16_t*)(C.ws + WS_QKV0), 0.015625f};
          pg8::gemm_phase<pg8::EpiQKV0, pg8::StaticOrder, true, true, 1>(C.lds + RING_OFF, g, S, E);
#elif PROBE_QKV == 2
          pg8::EpiQKV0Probe E{(pg8::bf16_t*)(C.ws + WS_XB), 0.015625f, 4};
          pg8::gemm_phase<pg8::EpiQKV0Probe, pg8::StaticOrder, true, true, 1>(C.lds + RING_OFF, g, S, E);
#else
          pg8::EpiNone E{(unsigned char*)(C.ws + WS_XB)};
          pg8::gemm_phase<pg8::EpiNone, pg8::StaticOrder, true, true, 1>(C.lds + RING_OFF, g, S, E);
#endif
        }
#endif
#if STAGGER_QKV
        { const unsigned long long t0 = __builtin_amdgcn_s_memrealtime(); const unsigned long long dl = (unsigned long long)(C.vcu & 7) * STAGGER_QKV;
          while (__builtin_amdgcn_s_memrealtime() - t0 < dl) __builtin_amdgcn_s_sleep(8); }
#endif
        REP(2) {
        pg8::Gemm g{QKV_FP8 ? (const pg8::bf16_t*)(C.ws + WS_H8) : (const pg8::bf16_t*)Hb, (const pg8::bf16_t*)(C.ws + WS_WQKV), T, NQKV, D}; pg8::StaticOrder S; S.init(T, NQKV, C.G, (int)blockIdx.x);
        pg8::EpiQKV0 E{(pg8::bf16_t*)(C.ws + WS_QKV0), QKV_FP8 ? 0.015625f : 1.f};
        pg8::gemm_phase<pg8::EpiQKV0, pg8::StaticOrder, true, true, QKV_FP8 ? 1 : 2>(C.lds + RING_OFF, g, S, E);
        } SEAM(2);
    }
    if (IN(3)) { FRESH(); REP(3) { p3_dilated(C); } SEAM(3); }
    if (IN(4)) { FRESH(); REP(4) { p4_merge(C); } SEAM(4); }
    if (IN(5)) { FRESH(); REP(5) {
        pg8::Gemm g{(const pg8::bf16_t*)(C.ws + WS_O), (const pg8::bf16_t*)(C.ws + WS_WO0), T, D, D}; pg8::StaticOrder S; S.init(T, D, C.G, (int)blockIdx.x);
        pg8::EpiResid<false> E{args.in[IN_X], (pg8::bf16_t*)(C.ws + WS_XS), (const float*)(C.ws + SM_ADA) + 2 * 1024, WO_FP8 ? 0.015625f : 1.f};
        pg8::gemm_phase<pg8::EpiResid<false>, pg8::StaticOrder, true, true, WO_FP8 ? 1 : 2>(C.lds + RING_OFF, g, S, E);
        } SEAM(5);
    }
    if (IN(6)) { FRESH(); REP(6) { r1_router(C, args, 0); } SEAM(6); }
    if (IN(7)) { FRESH(); REP(7) { p7_route(C); } SEAM(7); }
    if (IN(8)) { FRESH();
#if PROBE_GU
        { const int nt = load_tile_table(C);
          pg8::Gemm g{(const pg8::bf16_t*)(C.ws + WS_H8), (const pg8::bf16_t*)(C.ws + WS_WGU), MAXROWS, 32 * 2048, D, (const int*)(C.ws + SM_TOKSLOT)};
          pg8::MoeOrder<8> S{(const LAS int*)(C.lds + BLK_OFF) + BL_TILE, nt, (int)blockIdx.x, C.G};
#if PROBE_GU == 1
          pg8::EpiSwiGLU8 E{(unsigned char*)(C.ws + WS_XB), args.in[IN_BGU]};
          pg8::gemm_phase<pg8::EpiSwiGLU8, pg8::MoeOrder<8>, true, true, 1, true>(C.lds + RING_OFF, g, S, E);
#elif PROBE_GU == 6
          { pg8::MoeOrderProbe S2{(const LAS int*)(C.lds + BLK_OFF) + BL_TILE, nt, (int)blockIdx.x, C.G};
            pg8::EpiProbeGU<2> E{(unsigned char*)(C.ws + WS_XB), args.in[IN_BGU]};
            pg8::gemm_phase<pg8::EpiProbeGU<2>, pg8::MoeOrderProbe, true, true, 1, true>(C.lds + RING_OFF, g, S2, E); }
#else
          pg8::EpiProbeGU<PROBE_GU - 2> E{(unsigned char*)(C.ws + WS_XB), args.in[IN_BGU]};
          pg8::gemm_phase<pg8::EpiProbeGU<PROBE_GU - 2>, pg8::MoeOrder<8>, true, true, 1, true>(C.lds + RING_OFF, g, S, E);
#endif
        }
#endif
        REP(8) {
        const int nt = load_tile_table(C);
        pg8::Gemm g{(const pg8::bf16_t*)(C.ws + (MOE_GATHER ? WS_H8 : WS_XB)), (const pg8::bf16_t*)(C.ws + WS_WGU), MAXROWS, 32 * 2048, D, (const int*)(C.ws + SM_TOKSLOT)};
        pg8::MoeOrder<8> S{(const LAS int*)(C.lds + BLK_OFF) + BL_TILE, nt, (int)blockIdx.x, C.G};
        pg8::EpiSwiGLU8 E{(unsigned char*)(C.ws + WS_ACT), args.in[IN_BGU]};
        pg8::gemm_phase<pg8::EpiSwiGLU8, pg8::MoeOrder<8>, true, true, 1, MOE_GATHER != 0>(C.lds + RING_OFF, g, S, E);
        } SEAM(8);
    }
    if (IN(9)) { FRESH(); REP(9) {
        const int nt = load_tile_table(C);
        pg8::Gemm g{(const pg8::bf16_t*)(C.ws + WS_ACT), (const pg8::bf16_t*)(C.ws + WS_WDN), MAXROWS, 32 * 1024, D};
        pg8::MoeOrder<4> S{(const LAS int*)(C.lds + BLK_OFF) + BL_TILE, nt, (int)blockIdx.x, C.G};
        pg8::EpiDown8 E{(pg8::bf16_t*)(C.ws + WS_Y), args.in[IN_BDN]};
        pg8::gemm_phase<pg8::EpiDown8, pg8::MoeOrder<4>, true, true, 1>(C.lds + RING_OFF, g, S, E);
        } SEAM(9);
    }
    if (IN(10)) { FRESH(); r2_seam(C, args); SEAM(10); }
    if (IN(11)) { FRESH(); REP(11) {
        fcum_scan(C);
        pg8::Gemm g{(const pg8::bf16_t*)(C.ws + WS_HKV), (const pg8::bf16_t*)(C.ws + WS_WKV), T, 3072, D}; pg8::KVQOrder S; S.init(T, 3072, C.G, (int)blockIdx.x);
        pg8::EpiKVQ E{(pg8::bf16_t*)(C.ws + WS_QKV1), KVQ_FP8 ? 0.015625f : 1.f, (unsigned*)(C.ws + WS_CTL) + CW_NRM};
        pg8::gemm_phase<pg8::EpiKVQ, pg8::KVQOrder, true, true, KVQ_FP8 ? 1 : 2>(C.lds + RING_OFF, g, S, E);
        } SEAM(11);
    }
    if (IN(12)) { FRESH(); if (PROBE_FOX == 2) p12_fox<2>(C, WS_OG); REP(12) { p12_fox<1>(C, WS_O); } SEAM(12); }
    if (IN(13)) { FRESH(); REP(13) {
        pg8::Gemm g{(const pg8::bf16_t*)(C.ws + WS_O), (const pg8::bf16_t*)(C.ws + WS_WO1), T, D, D}; pg8::StaticOrder S; S.init(T, D, C.G, (int)blockIdx.x);
        pg8::EpiResid<true> E{C.ws + WS_XS, (pg8::bf16_t*)(C.ws + WS_XS), (const float*)(C.ws + SM_ADA) + (size_t)8 * 6144 + 2 * 1024, WO_FP8 ? 0.015625f : 1.f};
        pg8::gemm_phase<pg8::EpiResid<true>, pg8::StaticOrder, true, true, WO_FP8 ? 1 : 2>(C.lds + RING_OFF, g, S, E);
        } SEAM(13);
    }
    if (IN(14)) { FRESH(); REP(14) { r1_router(C, args, 1); } SEAM(14); }
    if (IN(15)) { FRESH(); REP(15) { p7_route(C); } SEAM(15); }
    if (IN(16)) { FRESH();
#if PROBE_LATE_QKV
        { pg8::Gemm g{(const pg8::bf16_t*)(C.ws + WS_ACT), (const pg8::bf16_t*)(C.ws + WS_WQKV), T, NQKV, D}; pg8::StaticOrder S; S.init(T, NQKV, C.G, (int)blockIdx.x);
          pg8::EpiNone E{(unsigned char*)(C.ws + WS_XB)};
          pg8::gemm_phase<pg8::EpiNone, pg8::StaticOrder, true, true, 1>(C.lds + RING_OFF, g, S, E); }
#endif
        REP(16) {
        const int nt = load_tile_table(C);
        pg8::Gemm g{(const pg8::bf16_t*)(C.ws + (MOE_GATHER ? WS_H8 : WS_XB)), (const pg8::bf16_t*)(C.ws + WS_WGU + (size_t)32 * 2048 * D), MAXROWS, 32 * 2048, D, (const int*)(C.ws + SM_TOKSLOT)};
        pg8::MoeOrder<8> S{(const LAS int*)(C.lds + BLK_OFF) + BL_TILE, nt, (int)blockIdx.x, C.G};
        pg8::EpiSwiGLU8 E{(unsigned char*)(C.ws + WS_ACT), args.in[IN_BGU] + 32 * 2048};
        pg8::gemm_phase<pg8::EpiSwiGLU8, pg8::MoeOrder<8>, true, true, 1, MOE_GATHER != 0>(C.lds + RING_OFF, g, S, E);
        } SEAM(16);
    }
    if (IN(17)) { FRESH(); REP(17) {
        const int nt = load_tile_table(C);
        pg8::Gemm g{(const pg8::bf16_t*)(C.ws + WS_ACT), (const pg8::bf16_t*)(C.ws + WS_WDN + (size_t)32 * 1024 * D), MAXROWS, 32 * 1024, D};
        pg8::MoeOrder<4> S{(const LAS int*)(C.lds + BLK_OFF) + BL_TILE, nt, (int)blockIdx.x, C.G};
        pg8::EpiDown8 E{(pg8::bf16_t*)(C.ws + WS_Y), args.in[IN_BDN] + 32 * 1024};
        pg8::gemm_phase<pg8::EpiDown8, pg8::MoeOrder<4>, true, true, 1>(C.lds + RING_OFF, g, S, E);
        } SEAM(17);
    }
    if (IN(18)) { FRESH(); r3_final(C, args, args.out); }
#undef IN
#undef SEAM
}

extern "C" void kernel_launch(void* const* d_in, const int* in_sizes, int n_in, void* d_out, int out_size, void* d_ws, size_t ws_size, hipStream_t stream) {
    static int grid = 0;
    if (grid == 0) {
        if (n_in != 21 || in_sizes[0] != T * D || out_size != T * D || ws_size < WS_END) { fprintf(stderr, "kernel_launch: unexpected shapes (n_in %d, in0 %d, out %d, ws %zu)\n", n_in, n_in > 0 ? in_sizes[0] : -1, out_size, ws_size); grid = -1; return; }
        int dev = 0, cus = 0, per_cu = 0;
        if (hipGetDevice(&dev) != hipSuccess || hipDeviceGetAttribute(&cus, hipDeviceAttributeMultiprocessorCount, dev) != hipSuccess) { grid = -1; return; }
        if (hipFuncSetAttribute((const void*)yoco_fwd, hipFuncAttributeMaxDynamicSharedMemorySize, LDS_BYTES) != hipSuccess) { fprintf(stderr, "kernel_launch: hipFuncSetAttribute failed\n"); grid = -1; return; }
        if (hipOccupancyMaxActiveBlocksPerMultiprocessor(&per_cu, (const void*)yoco_fwd, NWAVES * 64, LDS_BYTES) != hipSuccess || per_cu < 1) { fprintf(stderr, "kernel_launch: occupancy query reports %d blocks per CU\n", per_cu); }
        (void)hipGetLastError();
        grid = cus;
    }
    if (grid < 0) return;
    (void)hipMemsetAsync((char*)d_ws + WS_CTL, 0, CTL_ZERO_BYTES, stream);
    Args a{};
    for (int i = 0; i < 21; ++i) a.in[i] = (const float*)d_in[i];
    a.out = (float*)d_out; a.ws = (unsigned char*)d_ws;
#if MK_ONE_LAUNCH
    a.ph_lo = 0; a.ph_hi = N_PHASES;
    hipLaunchKernelGGL(yoco_fwd, dim3(grid), dim3(NWAVES * 64), LDS_BYTES, stream, a);
#else
    for (int p = 0; p < N_PHASES; ++p) { a.ph_lo = p; a.ph_hi = p + 1; hipLaunchKernelGGL(yoco_fwd, dim3(grid), dim3(NWAVES * 64), LDS_BYTES, stream, a); }
#endif
}
```

```cpp
#include <hip/hip_runtime.h>
#include <hip/hip_bf16.h>
#include <cstdio>
#include <cstdint>
#include <cmath>
#ifndef MK_ONE_LAUNCH
#define MK_ONE_LAUNCH 1
#endif
#ifndef PROBE_DUP
#define PROBE_DUP 0
#endif
#ifndef PG8_F8_SCALED
#define PG8_F8_SCALED 0
#endif
#ifndef QKV_FP8
#define QKV_FP8 1
#endif
#ifndef KVQ_FP8
#define KVQ_FP8 1
#endif
#ifndef PROBE_EPI
#define PROBE_EPI 0
#endif
#ifndef PROBE_FOX
#define PROBE_FOX 0
#endif
#ifndef PROBE_SANITIZE
#define PROBE_SANITIZE 0
#endif
#ifndef PROBE_BAND
#define PROBE_BAND 0
#endif
#ifndef Y_FP8
#define Y_FP8 1
#endif
#ifndef WO_FP8
#define WO_FP8 1
#endif
#ifndef MOE_GATHER
#define MOE_GATHER 1
#endif
#ifndef PROBE_QKV
#define PROBE_QKV 0
#endif
#ifndef PROBE_GU
#define PROBE_GU 0
#endif
#ifndef STAGGER_QKV
#define STAGGER_QKV 0
#endif
#ifndef NT_STORE
#define NT_STORE 0
#endif
#ifndef RELAX_STORES
#define RELAX_STORES 0
#endif
#ifndef PROBE_LATE_QKV
#define PROBE_LATE_QKV 0
#endif
#ifndef NT_P0
#define NT_P0 1
#endif
#ifndef NT_ROWS
#define NT_ROWS 1
#endif
namespace pg8 {
#define PG8_LAS __attribute__((address_space(3)))
typedef unsigned short bf16_t;
typedef short bf16x8 __attribute__((ext_vector_type(8)));
typedef float f32x4 __attribute__((ext_vector_type(4)));
typedef unsigned u32x4 __attribute__((ext_vector_type(4)));
constexpr int BM = 256, BK = 64, HALF = 128, HTB = HALF * BK * 2  , STAGE_BYTES = 8 * HTB, NXCD = 8, WGM = 8;

__host__ __device__ __forceinline__ int lds_byte(int r, int c) { const int st = (r >> 4) * 2 + (c >> 5), rr = r & 15, cc = c & 31, ob = rr * 64 + cc * 2; return st * 1024 + (ob ^ (((ob >> 9) & 1) << 5)); }
__host__ __device__ __forceinline__ void stage_rc(int b, int& R, int& C) { const int st = b / 1024, sb = b % 1024, swz = sb ^ (((sb >> 9) & 1) << 5); R = (st >> 1) * 16 + swz / 64; C = (st & 1) * 32 + (swz % 64) / 2; }
__host__ __device__ __forceinline__ int perm32(int rho) { const int n = rho >> 4, i = rho & 15; return 8 * (i >> 2) + 4 * n + (i & 3); }

struct Unit { int pm, pn; };
struct Gemm { const bf16_t* A; const bf16_t* Bt; int M, N, K; const int* rows = nullptr; };

struct StaticOrder {
    int nM, nN, nwg, G, c;
    __host__ __device__ void init(int M, int N, int G_, int c_) { nM = M / BM; nN = N / BM; nwg = nM * nN; G = G_; c = c_; }
    __host__ __device__ bool next(int i, Unit& u) const {
        const long L = (long)i * G + c; if (L >= nwg) return false;
        int wgid = (int)L; { const int q = nwg / NXCD, r = nwg % NXCD, xcd = wgid % NXCD, off = wgid / NXCD; wgid = (xcd < r ? xcd * (q + 1) : r * (q + 1) + (xcd - r) * q) + off; }
        const int nig = WGM * nN, gid = wgid / nig, fm = gid * WGM, gsz = (nM - fm) < WGM ? (nM - fm) : WGM;
        u.pm = fm + ((wgid % nig) % gsz); u.pn = (wgid % nig) / gsz; return true;
    }
    __device__ __forceinline__ void a_ready(const Unit&) const {}
    __device__ __forceinline__ void done(const Unit&) const {}
};
__device__ __forceinline__ unsigned cvt_pk_bf16(float lo, float hi) { unsigned r; asm volatile("v_cvt_pk_bf16_f32 %0, %1, %2" : "=v"(r) : "v"(lo), "v"(hi)); return r; }
typedef float f32x2 __attribute__((ext_vector_type(2)));
typedef int i32x8 __attribute__((ext_vector_type(8))); typedef int i32x4p __attribute__((ext_vector_type(4)));
#ifndef PG8_F8_SCALE
#define PG8_F8_SCALE 0x7f7f7f7f
#endif
__device__ __forceinline__ i32x8 pg8_cat(bf16x8 lo, bf16x8 hi) { const i32x4p a = __builtin_bit_cast(i32x4p, lo), b = __builtin_bit_cast(i32x4p, hi); return (i32x8){a.x, a.y, a.z, a.w, b.x, b.y, b.z, b.w}; }
#if PG8_F8_SCALED
__device__ __forceinline__ void pg8_mma8(f32x4& acc, i32x8 b, i32x8 a) { asm volatile("v_mfma_scale_f32_16x16x128_f8f6f4 %0, %1, %2, %0, %3, %3 op_sel_hi:[0,0,0]" : "+v"(acc) : "v"(b), "v"(a), "v"(0x7f7f7f7f)); }
#else
__device__ __forceinline__ void pg8_mma8(f32x4& acc, i32x8 b, i32x8 a) { asm volatile("v_mfma_f32_16x16x128_f8f6f4 %0, %1, %2, %0" : "+v"(acc) : "v"(b), "v"(a)); }
#endif
__device__ __forceinline__ void pg8_mma16(f32x4& acc, bf16x8 b, bf16x8 a) { asm volatile("v_mfma_f32_16x16x32_bf16 %0, %1, %2, %0" : "+v"(acc) : "v"(b), "v"(a)); }
template <class Epi, class Sched, bool ALIGN_EPI = false, bool SP2 = false, int ES = 2  , bool GATHER = false  >
__device__ __forceinline__ void gemm_phase(PG8_LAS unsigned char* lds, const Gemm g, const Sched& S, const Epi& E) {
    const int tid = threadIdx.x, wid = __builtin_amdgcn_readfirstlane(tid >> 6), lane = tid & 63, wr = wid >> 2, wc = wid & 3, fr = lane & 15, fq = lane >> 4;
    const int K = g.K * ES / 2  , nt = K / BK;
    unsigned voffA[2], voffB[2];
#pragma unroll
    for (int i = 0; i < 2; ++i) { int R, C; stage_rc(tid * 16 + i * 8192, R, C); const int Rb = Epi::PERM ? ((R & ~31) + perm32(R & 31)) : R;
        voffA[i] = (unsigned)(R * K + C) * 2u; voffB[i] = (unsigned)(Rb * K + C) * 2u; }
    const size_t kstep = (size_t)(BK * 2);
    const size_t hstep = (size_t)HALF * K * 2;
    const size_t tstep = 2 * hstep;
    const size_t hstepA = GATHER ? 0 : hstep;
    unsigned cG0[2] = {voffA[0], voffA[1]}, cG1[2] = {voffA[0], voffA[1]}, nG0[2] = {voffA[0], voffA[1]}, nG1[2] = {voffA[0], voffA[1]};
#define PG8_GROWS(G0, G1, PM) do { if constexpr (GATHER) { _Pragma("unroll") for (int i_ = 0; i_ < 2; ++i_) { int R_, C_; stage_rc(tid * 16 + i_ * 8192, R_, C_); \
        const int* rp_ = g.rows + (size_t)(PM) * 256 + R_; G0[i_] = (unsigned)rp_[0] * (unsigned)(K * 2) + (unsigned)(C_ * 2); G1[i_] = (unsigned)rp_[128] * (unsigned)(K * 2) + (unsigned)(C_ * 2); } } } while (0)
    const unsigned ldsw = (unsigned)wid * 1024u;
    const int aoff = lds_byte(wr * 64 + fr, fq * 8), boff = lds_byte(wc * 32 + fr, fq * 8);
#define PG8_SA(b, h) (((b) * 2 + (h)) * HTB)
#define PG8_SB(b, h) ((4 + (b) * 2 + (h)) * HTB)
#define PG8_STAGE(bufoff, gbase, voff) do { _Pragma("unroll") for (int _i = 0; _i < 2; ++_i) \
        __builtin_amdgcn_global_load_lds((const unsigned*)((const char*)(gbase) + (voff)[_i]), (PG8_LAS unsigned*)(lds + (bufoff) + ldsw + _i * 8192), 16, 0, 0); } while (0)
#define PG8_LDA(dst, b, h) do { _Pragma("unroll") for (int m = 0; m < 4; ++m) _Pragma("unroll") for (int k = 0; k < 2; ++k) dst[m][k] = *(const PG8_LAS bf16x8*)(lds + PG8_SA(b, h) + aoff + m * 2048 + k * 1024); } while (0)
#define PG8_LDB(dst, b, h) do { _Pragma("unroll") for (int n = 0; n < 2; ++n) _Pragma("unroll") for (int k = 0; k < 2; ++k) dst[n][k] = *(const PG8_LAS bf16x8*)(lds + PG8_SB(b, h) + boff + n * 2048 + k * 1024); } while (0)
#define PG8_MMA(ai, bj, At, Bt) do { __builtin_amdgcn_s_setprio(1); _Pragma("unroll") for (int m = 0; m < 4; ++m) _Pragma("unroll") for (int n = 0; n < 2; ++n) { \
        if constexpr (ES == 2) { _Pragma("unroll") for (int k = 0; k < 2; ++k) acc[ai][bj][m][n] = __builtin_amdgcn_mfma_f32_16x16x32_bf16(Bt[n][k], At[m][k], acc[ai][bj][m][n], 0, 0, 0); } \
        else { pg8_mma8(acc[ai][bj][m][n], pg8_cat(Bt[n][0], Bt[n][1]), pg8_cat(At[m][0], At[m][1])); } } \
        __builtin_amdgcn_s_setprio(0); } while (0)
#define PG8_WAIT_V(n) asm volatile("s_waitcnt vmcnt(" #n ")" ::: "memory")
#define PG8_WAIT_L(n) asm volatile("s_waitcnt lgkmcnt(" #n ")" ::: "memory")
#define PG8_WAIT_V8R do { if (relax_st) { if constexpr (Epi::NSTORE == 16) asm volatile("s_waitcnt vmcnt(24)" ::: "memory"); else if constexpr (Epi::NSTORE == 8) asm volatile("s_waitcnt vmcnt(16)" ::: "memory"); else asm volatile("s_waitcnt vmcnt(8)" ::: "memory"); } \
        else asm volatile("s_waitcnt vmcnt(8)" ::: "memory"); } while (0)
#define PG8_BAR __builtin_amdgcn_s_barrier()
#define PG8_SCHED __builtin_amdgcn_sched_barrier(0)
    Unit cur, nxt; int ui = 0;
    if (!S.next(0, cur)) return;
    f32x4 acc[2][2][4][2];
#pragma unroll
    for (int a = 0; a < 2; ++a)
#pragma unroll
        for (int b = 0; b < 2; ++b)
#pragma unroll
            for (int m = 0; m < 4; ++m)
#pragma unroll
                for (int n = 0; n < 2; ++n) acc[a][b][m][n] = (f32x4){0.f, 0.f, 0.f, 0.f};
    bf16x8 At[4][2], B0[2][2], B1[2][2];
    const char* cA = (const char*)g.A + (GATHER ? (size_t)0 : (size_t)cur.pm * tstep); const char* cB = (const char*)g.Bt + (size_t)cur.pn * tstep;
    PG8_GROWS(cG0, cG1, cur.pm);
    S.a_ready(cur);
    if constexpr (SP2) {
        PG8_STAGE(PG8_SB(0, 0), cB, voffB); PG8_STAGE(PG8_SB(0, 1), cB + hstep, voffB); PG8_STAGE(PG8_SA(0, 0), cA, cG0); PG8_STAGE(PG8_SA(0, 1), cA + hstepA, cG1);
        if (wr == 1) PG8_BAR;
        PG8_WAIT_V(2); PG8_BAR;
        PG8_STAGE(PG8_SB(1, 0), cB + kstep, voffB); PG8_STAGE(PG8_SA(1, 0), cA + kstep, cG0); PG8_STAGE(PG8_SB(1, 1), cB + hstep + kstep, voffB);
        PG8_WAIT_V(6); PG8_BAR;
    } else {
        PG8_STAGE(PG8_SB(0, 0), cB, voffB); PG8_STAGE(PG8_SA(0, 0), cA, cG0); PG8_STAGE(PG8_SB(0, 1), cB + hstep, voffB); PG8_STAGE(PG8_SA(0, 1), cA + hstepA, cG1);
        if (wr == 1) PG8_BAR;
        PG8_WAIT_V(4); PG8_BAR;
        PG8_STAGE(PG8_SB(1, 0), cB + kstep, voffB); PG8_STAGE(PG8_SA(1, 0), cA + kstep, cG0); PG8_STAGE(PG8_SB(1, 1), cB + hstep + kstep, voffB);
        PG8_WAIT_V(6); PG8_BAR;
    }
    for (;;) {
        const bool has_next = S.next(ui + 1, nxt);
        const char* nA = (has_next && !GATHER) ? (const char*)g.A + (size_t)nxt.pm * tstep : cA; const char* nB = has_next ? (const char*)g.Bt + (size_t)nxt.pn * tstep : cB;
        if (has_next) PG8_GROWS(nG0, nG1, nxt.pm); else { nG0[0] = cG0[0]; nG0[1] = cG0[1]; nG1[0] = cG1[0]; nG1[1] = cG1[1]; }
#pragma unroll 1
        for (int t = 0; t < nt; t += 2) {
            const bool last = (t == nt - 2);
            const bool relax_st = RELAX_STORES && (t == 0) && (ui > 0);
            const char* a1 = cA + (size_t)(t + 1) * kstep;
            const char* a2 = last ? nA : cA + (size_t)(t + 2) * kstep; const char* b2 = last ? nB : cB + (size_t)(t + 2) * kstep;
            const char* a3 = a2 + kstep; const char* b3 = b2 + kstep;
            if (last && has_next) S.a_ready(nxt);
            const unsigned s0[2] = {last ? nG0[0] : cG0[0], last ? nG0[1] : cG0[1]}, s1[2] = {last ? nG1[0] : cG1[0], last ? nG1[1] : cG1[1]};
            if constexpr (SP2) {
            PG8_LDB(B0, 0, 0); PG8_LDB(B1, 0, 1); PG8_SCHED; PG8_LDA(At, 0, 0); PG8_STAGE(PG8_SA(1, 1), a1 + hstepA, cG1);
            PG8_WAIT_V8R; PG8_WAIT_L(0); PG8_BAR; PG8_MMA(0, 0, At, B0); PG8_MMA(0, 1, At, B1); PG8_BAR; PG8_SCHED;
            PG8_LDA(At, 0, 1); PG8_STAGE(PG8_SB(0, 0), b2, voffB); PG8_STAGE(PG8_SB(0, 1), b2 + hstep, voffB); PG8_STAGE(PG8_SA(0, 0), a2, s0);
            PG8_WAIT_V8R; PG8_WAIT_L(0); PG8_BAR; PG8_MMA(1, 0, At, B0); PG8_MMA(1, 1, At, B1); PG8_BAR; PG8_SCHED;
            PG8_LDB(B0, 1, 0); PG8_LDB(B1, 1, 1); PG8_SCHED; PG8_LDA(At, 1, 0); PG8_STAGE(PG8_SA(0, 1), a2 + hstepA, s1);
            PG8_WAIT_V(8); PG8_WAIT_L(0); PG8_BAR; PG8_MMA(0, 0, At, B0); PG8_MMA(0, 1, At, B1); PG8_BAR; PG8_SCHED;
            PG8_LDA(At, 1, 1); PG8_STAGE(PG8_SB(1, 0), b3, voffB); PG8_STAGE(PG8_SB(1, 1), b3 + hstep, voffB); PG8_STAGE(PG8_SA(1, 0), a3, s0);
            PG8_WAIT_V(8); PG8_WAIT_L(0); PG8_BAR; PG8_MMA(1, 0, At, B0); PG8_MMA(1, 1, At, B1); PG8_BAR; PG8_SCHED;
            } else {
            PG8_LDB(B0, 0, 0); PG8_SCHED; PG8_LDA(At, 0, 0); PG8_STAGE(PG8_SA(1, 1), a1 + hstepA, cG1);
            PG8_WAIT_L(8); PG8_BAR; PG8_WAIT_L(0); PG8_MMA(0, 0, At, B0); PG8_BAR; PG8_SCHED;
            PG8_LDB(B1, 0, 1); PG8_STAGE(PG8_SB(0, 0), b2, voffB);
            PG8_BAR; PG8_WAIT_L(0); PG8_MMA(0, 1, At, B1); PG8_BAR;
            PG8_LDA(At, 0, 1); PG8_STAGE(PG8_SA(0, 0), a2, s0);
            PG8_BAR; PG8_WAIT_L(0); PG8_MMA(1, 0, At, B0); PG8_BAR; PG8_SCHED;
            PG8_STAGE(PG8_SB(0, 1), b2 + hstep, voffB);
            PG8_WAIT_V(6); PG8_BAR; PG8_MMA(1, 1, At, B1); PG8_BAR;
            PG8_LDB(B0, 1, 0); PG8_SCHED; PG8_LDA(At, 1, 0); PG8_STAGE(PG8_SA(0, 1), a2 + hstepA, s1);
            PG8_WAIT_L(8); PG8_BAR; PG8_WAIT_L(0); PG8_MMA(0, 0, At, B0); PG8_BAR; PG8_SCHED;
            PG8_LDB(B1, 1, 1); PG8_STAGE(PG8_SB(1, 0), b3, voffB);
            PG8_BAR; PG8_WAIT_L(0); PG8_MMA(0, 1, At, B1); PG8_BAR;
            PG8_LDA(At, 1, 1); PG8_STAGE(PG8_SA(1, 0), a3, s0);
            PG8_BAR; PG8_WAIT_L(0); PG8_MMA(1, 0, At, B0); PG8_BAR; PG8_SCHED;
            PG8_STAGE(PG8_SB(1, 1), b3 + hstep, voffB);
            PG8_WAIT_V(6); PG8_BAR; PG8_MMA(1, 1, At, B1); PG8_BAR;
            }
        }
        if constexpr (ES == 1) asm volatile("s_nop 15\n\ts_nop 15" ::: "memory");
        if constexpr (ALIGN_EPI) { if (wr == 0) PG8_BAR; }
        if constexpr (!Epi::AFTER_DRAIN) { E(acc, cur, wr, wc, fr, fq); S.done(cur); }
        if (!has_next) break;
#pragma unroll
        for (int a = 0; a < 2; ++a)
#pragma unroll
            for (int b = 0; b < 2; ++b)
#pragma unroll
                for (int m = 0; m < 4; ++m)
#pragma unroll
                    for (int n = 0; n < 2; ++n) acc[a][b][m][n] = (f32x4){0.f, 0.f, 0.f, 0.f};
        cur = nxt; cA = nA; cB = nB; ++ui; cG0[0] = nG0[0]; cG0[1] = nG0[1]; cG1[0] = nG1[0]; cG1[1] = nG1[1];
        if constexpr (ALIGN_EPI) { if (wr == 1) PG8_BAR; }
    }
    PG8_WAIT_V(0);
    if constexpr (!ALIGN_EPI) { if (wr == 0) PG8_BAR; }
    PG8_BAR;
    if constexpr (Epi::AFTER_DRAIN) { E.fused(acc, cur, wr, wc, fr, fq, lds, wid, lane); S.done(cur); }
#undef PG8_GROWS
#undef PG8_SA
#undef PG8_SB
#undef PG8_STAGE
#undef PG8_LDA
#undef PG8_LDB
#undef PG8_MMA
#undef PG8_WAIT_V
#undef PG8_WAIT_L
#undef PG8_WAIT_V8R
#undef PG8_BAR
#undef PG8_SCHED
}
}
namespace attn_body {
using bf16=__hip_bfloat16;
using bf16x8=__attribute__((ext_vector_type(8)))short;
using s16x4=__attribute__((ext_vector_type(4)))short;
using f32x16=__attribute__((ext_vector_type(16)))float;
using u32x4=__attribute__((ext_vector_type(4)))unsigned;
__device__ __forceinline__ int crow(int r,int hi){return (r&3)+8*(r>>2)+4*hi;}
#define SBAR() __builtin_amdgcn_sched_barrier(0)
__device__ __forceinline__ void glds16(const void*gsrc,unsigned lds_dst){unsigned keep;
  asm volatile("s_mov_b32 %0, m0\n\ts_mov_b32 m0, %2\n\ts_nop 0\n\tglobal_load_lds_dwordx4 %1, off\n\ts_mov_b32 m0, %0":"=&s"(keep):"v"(gsrc),"s"(lds_dst):"memory");}
__device__ __forceinline__ float max3f(float a,float b,float c){float r;asm("v_max3_f32 %0, %1, %2, %3":"=v"(r):"v"(a),"v"(b),"v"(c));return r;}
__device__ __forceinline__ float max2f(float a,float b){float r;asm("v_max_f32_e32 %0, %1, %2":"=v"(r):"v"(a),"v"(b));return r;}
__device__ __forceinline__ float fadd_s(float a,float b){float r;asm("v_add_f32_e32 %0, %1, %2":"=v"(r):"v"(a),"v"(b));return r;}
__device__ __forceinline__ float fsub_s(float a,float b){float r;asm("v_sub_f32_e32 %0, %1, %2":"=v"(r):"v"(a),"v"(b));return r;}
typedef float f32x2_t __attribute__((ext_vector_type(2))); typedef __bf16 bf16x2_t __attribute__((ext_vector_type(2)));
__device__ __forceinline__ unsigned cvtpk_s(float lo,float hi){f32x2_t v={lo,hi};bf16x2_t b=__builtin_convertvector(v,bf16x2_t);return __builtin_bit_cast(unsigned,b);}
#define WAIT_BAR(N) asm volatile("s_waitcnt vmcnt(" #N ") lgkmcnt(0)\n\ts_barrier":::"memory")
typedef __attribute__((address_space(3))) const char* lds_cptr;
typedef short v4i16_t __attribute__((ext_vector_type(4)));
__device__ __forceinline__ void kload8(bf16x8*kf,lds_cptr kp){
  kf[0]=*(const __attribute__((address_space(3))) bf16x8*)(kp);      kf[1]=*(const __attribute__((address_space(3))) bf16x8*)(kp+512);
  kf[2]=*(const __attribute__((address_space(3))) bf16x8*)(kp+2048); kf[3]=*(const __attribute__((address_space(3))) bf16x8*)(kp+2560);
  kf[4]=*(const __attribute__((address_space(3))) bf16x8*)(kp+4096); kf[5]=*(const __attribute__((address_space(3))) bf16x8*)(kp+4608);
  kf[6]=*(const __attribute__((address_space(3))) bf16x8*)(kp+6144); kf[7]=*(const __attribute__((address_space(3))) bf16x8*)(kp+6656);
}
__device__ __forceinline__ void kload2(bf16x8*kf,lds_cptr kp,int j){ kf[2*j]=*(const __attribute__((address_space(3))) bf16x8*)(kp+j*2048); kf[2*j+1]=*(const __attribute__((address_space(3))) bf16x8*)(kp+j*2048+512); }
__device__ __forceinline__ s16x4 vtr(lds_cptr p){ return __builtin_bit_cast(s16x4,__builtin_amdgcn_ds_read_tr16_b64_v4i16((__attribute__((address_space(3))) v4i16_t*)p)); }
__device__ __forceinline__ float rowmax(const f32x16&p0,const f32x16&p1){
  float a=max3f(p0[0],p0[1],p1[0]),b=max3f(p0[2],p0[3],p1[1]);a=max3f(a,p1[2],p1[3]);
  #pragma unroll
  for(int r=4;r<16;r+=4){a=max3f(a,p0[r],p0[r+1]);b=max3f(b,p0[r+2],p0[r+3]);a=max3f(a,p1[r],p1[r+1]);b=max3f(b,p1[r+2],p1[r+3]);}
  const float m=max2f(a,b);
  auto rr=__builtin_amdgcn_permlane32_swap(__float_as_uint(m),__float_as_uint(m),false,false);
  return max2f(__uint_as_float(rr[0]),__uint_as_float(rr[1]));
}
__device__ __forceinline__ void pv(f32x16*o,int vb,bf16x8 pa0,bf16x8 pa1,bf16x8 pa2,bf16x8 pa3){
  #pragma unroll
  for(int d0=0;d0<2;++d0){s16x4 lo[4],hi[4];
    #pragma unroll
    for(int ks=0;ks<4;++ks){
      asm volatile("ds_read_b64_tr_b16 %0,%1 offset:%c2":"=&v"(lo[ks]):"v"(vb),"i"(d0*4096+ks*1024):"memory");
      asm volatile("ds_read_b64_tr_b16 %0,%1 offset:%c2":"=&v"(hi[ks]):"v"(vb),"i"(d0*4096+ks*1024+512):"memory");}
    asm volatile("s_waitcnt lgkmcnt(0)":::"memory");SBAR();
    #define PK(k) (bf16x8){lo[k][0],lo[k][1],lo[k][2],lo[k][3],hi[k][0],hi[k][1],hi[k][2],hi[k][3]}
    o[d0]=__builtin_amdgcn_mfma_f32_32x32x16_bf16(pa0,PK(0),o[d0],0,0,0);
    o[d0]=__builtin_amdgcn_mfma_f32_32x32x16_bf16(pa1,PK(1),o[d0],0,0,0);
    o[d0]=__builtin_amdgcn_mfma_f32_32x32x16_bf16(pa2,PK(2),o[d0],0,0,0);
    o[d0]=__builtin_amdgcn_mfma_f32_32x32x16_bf16(pa3,PK(3),o[d0],0,0,0);
    #undef PK
  }
}
}

constexpr int BATCH = 8, SEQ = 4096, T = BATCH * SEQ, D = 1024, NE = 32, TOPK = 4, NH = 16, HD = 64;
constexpr int NQKV = 9216;
constexpr int MAXROWS = T * TOPK + NE * 256;
constexpr int MAXTILES = MAXROWS / 256;
constexpr int NVB = T / 128;
constexpr float LOG2E = 1.4426950408889634f;
constexpr float QSCALE = 0.125f * LOG2E;
constexpr float RMS_EPS = 1e-6f;
constexpr int NWAVES = 8;

constexpr size_t MiB = 1ull << 20;
constexpr size_t WS_CTL = 0, CTL_ZERO_BYTES = 1 * MiB;
constexpr size_t WS_SM = 1 * MiB;
constexpr size_t SM_ADA = WS_SM;
constexpr size_t SM_GM = WS_SM + 512 * 1024;
constexpr size_t SM_CSH = WS_SM + 640 * 1024;
constexpr size_t SM_BIAST = WS_SM + 644 * 1024;
constexpr size_t SM_BLKCNT = WS_SM + 704 * 1024;
constexpr size_t SM_TILEEXP = WS_SM + 768 * 1024;
constexpr size_t SM_TOPI = WS_SM + 1 * MiB;
constexpr size_t SM_TOPG = SM_TOPI + 512 * 1024;
constexpr size_t SM_RANK = SM_TOPG + 512 * 1024;
constexpr size_t SM_SLOT = SM_RANK + 512 * 1024;
constexpr size_t SM_TOKSLOT = WS_SM + 3 * MiB;
constexpr size_t SM_LOGF = WS_SM + 4 * MiB;
constexpr size_t SM_FCUM = WS_SM + 6 * MiB;
constexpr size_t SM_LSE = WS_SM + 8 * MiB;
constexpr size_t WS_WQKV = 16 * MiB, WS_WO0 = 34 * MiB, WS_WKV = 36 * MiB, WS_WQ = 40 * MiB, WS_WO1 = 42 * MiB, WS_WGU = 44 * MiB, WS_WDN = 300 * MiB;
constexpr size_t WS_HKV = 428 * MiB, WS_H = 492 * MiB, WS_OG = 556 * MiB, WS_O = 748 * MiB;
constexpr size_t WS_QKV0 = 812 * MiB, WS_ACT = 812 * MiB, WS_Y = 1084 * MiB, WS_QKV1 = 1388 * MiB, WS_XB = 1388 * MiB, WS_H8 = 1524 * MiB, WS_END = 1660 * MiB, WS_XS = WS_H;
static_assert(WS_H == WS_HKV + (size_t)T * D * 2, "H must follow HKV (KVQ GEMM addresses both through one A pointer)");
static_assert(WS_WQ == WS_WKV + (size_t)2048 * 1024 * 2, "Wq_t must follow Wkv_t");
static_assert(SM_LSE + (size_t)3 * T * 16 * 4 <= WS_WQKV, "small region");
static_assert(WS_Y + (size_t)MAXROWS * D * 2 <= WS_QKV1 && WS_XB + (size_t)MAXROWS * D * 2 <= WS_END && WS_QKV0 + (size_t)BATCH * 9 * 16 * SEQ * 64 * 2 <= WS_QKV1, "ws map");
constexpr int CW_TMO = 0, CW_BAR = 4096, CW_QUEUE = 65536  , CW_NRM = 131072  ;

constexpr int RING_OFF = 0, RING_BYTES = 131072;
constexpr int SCR_OFF = RING_BYTES, SCR_BYTES = 16384;
constexpr int BLK_OFF = SCR_OFF + SCR_BYTES, BLK_BYTES = 12288;
constexpr int MISC_OFF = BLK_OFF + BLK_BYTES;
constexpr int LDS_BYTES = MISC_OFF + 256;
constexpr int BL_TILE = 0, BL_WCNT = 576, BL_WBASE = 832, BL_PARTA = 1088, BL_PARTB = 1600, BL_TOT = 2112, BL_BASE = 2144, BL_PADS = 2176;

#define LAS __attribute__((address_space(3)))
#define GAS __attribute__((address_space(1)))
typedef unsigned short bf16;
typedef float f32x4 __attribute__((ext_vector_type(4)));
typedef unsigned u32x4v __attribute__((ext_vector_type(4)));
typedef unsigned u32x2v __attribute__((ext_vector_type(2)));
typedef int i32x4v __attribute__((ext_vector_type(4)));
#define LDS_WAIT() asm volatile("s_waitcnt lgkmcnt(0)" ::: "memory")
#define VM_WAIT() asm volatile("s_waitcnt vmcnt(0)" ::: "memory")

__device__ __forceinline__ float bf2f(unsigned v) { return __uint_as_float(v << 16); }
__device__ __forceinline__ unsigned pkbf(float lo, float hi) { return attn_body::cvtpk_s(lo, hi); }
__device__ __forceinline__ float wave_sum(float v) {
#pragma unroll
    for (int o = 1; o < 64; o <<= 1) v += __shfl_xor(v, o);
    return v;
}

namespace pg8 {
struct EpiQKV0 {
    static constexpr bool PERM = true, AFTER_DRAIN = false; static constexpr int NSTORE = 16;
    bf16_t* O; float mul;
    __device__ __forceinline__ void operator()(const f32x4 (&acc)[2][2][4][2], const Unit& u, int wr, int wc, int fr, int fq) const {
        _Pragma("unroll") for (int rep_e = 0; rep_e < 1 + ((PROBE_EPI >> 0) & 1); ++rep_e) {
        asm volatile("" : "+v"(fr), "+v"(fq));
        const int g = u.pn / 12, rem = u.pn - g * 12, which = rem >> 2, h0 = (rem & 3) * 4, sh = 2 * g;
        const float sc = (which == 0 ? QSCALE : 1.f) * mul;
#pragma unroll
        for (int ai = 0; ai < 2; ++ai)
#pragma unroll
            for (int m = 0; m < 4; ++m) {
                const int tok = u.pm * BM + ai * HALF + wr * 64 + m * 16 + fr, b = tok >> 12, s = tok & 4095;
                const int subrow = (s & ((1 << sh) - 1)) * (4096 >> sh) + (s >> sh);
#pragma unroll
                for (int bj = 0; bj < 2; ++bj) {
                    const int head = h0 + 2 * bj + (wc >> 1), dcol = (wc & 1) * 32 + 8 * fq;
                    const size_t plane = (size_t)(((b * 3 + g) * 3 + which) * 16 + head);
                    const f32x4 v0 = acc[ai][bj][m][0] * sc, v1 = acc[ai][bj][m][1] * sc;
                    u32x4 w; w.x = cvt_pk_bf16(v0[0], v0[1]); w.y = cvt_pk_bf16(v0[2], v0[3]); w.z = cvt_pk_bf16(v1[0], v1[1]); w.w = cvt_pk_bf16(v1[2], v1[3]);
#if NT_STORE
                    __builtin_nontemporal_store(w, (u32x4*)(O + (plane * 4096 + subrow) * 64 + dcol));
#else
                    *(u32x4*)(O + (plane * 4096 + subrow) * 64 + dcol) = w;
#endif
                }
            }
        }
    }
};
struct EpiQKV0Probe {
    static constexpr bool PERM = true, AFTER_DRAIN = false; static constexpr int NSTORE = 16;
    bf16_t* O; float mul; int wide;
    __device__ __forceinline__ void operator()(const f32x4 (&acc)[2][2][4][2], const Unit& u, int wr, int wc, int fr, int fq) const {
        asm volatile("" : "+v"(fr), "+v"(fq));
        const int g = u.pn / 12, rem = u.pn - g * 12, which = rem >> 2, h0 = (rem & 3) * 4, sh = 2 * g;
        const float sc = (which == 0 ? QSCALE : 1.f) * mul;
#pragma unroll
        for (int ai = 0; ai < 2; ++ai)
#pragma unroll
            for (int m = 0; m < 4; ++m) {
                const int tok = u.pm * BM + ai * HALF + wr * 64 + m * 16 + fr, b = tok >> 12, s = tok & 4095;
                const int subrow = (s & ((1 << sh) - 1)) * (4096 >> sh) + (s >> sh);
                const int head = h0 + wc, dcol = 16 * fq;
                const size_t plane = (size_t)(((b * 3 + g) * 3 + which) * 16 + head);
#pragma unroll
                for (int bj = 0; bj < 2; ++bj) {
                    const f32x4 v0 = acc[ai][bj][m][0] * sc, v1 = acc[ai][bj][m][1] * sc;
                    u32x4 w; w.x = cvt_pk_bf16(v0[0], v0[1]); w.y = cvt_pk_bf16(v0[2], v0[3]); w.z = cvt_pk_bf16(v1[0], v1[1]); w.w = cvt_pk_bf16(v1[2], v1[3]);
                    if (wide == 4) { const size_t off_ = ((size_t)(u.pm * 36 + u.pn) * 131072 + (size_t)(wr * 4 + wc) * 16384 + (size_t)((ai * 4 + m) * 2 + bj) * 1024 + fr * 64 + fq * 16) & (size_t)0x7fffff;
                        *(u32x4*)((unsigned char*)O + off_) = w; }
                    else if (wide != 3 || m == 0) *(u32x4*)(O + (((plane * 4096 + subrow) * 64 + dcol + 8 * bj) & (size_t)(wide == 2 ? 0x3fffff : 0x7fffffffff)) ) = w; else if (w.x == 0x12345678u) O[0] = 1;
                }
            }
    }
};
struct EpiKVQ {
    static constexpr bool PERM = true, AFTER_DRAIN = false; static constexpr int NSTORE = 16;
    bf16_t* O; float mul; unsigned* nrm;
    __device__ __forceinline__ void operator()(const f32x4 (&acc)[2][2][4][2], const Unit& u, int wr, int wc, int fr, int fq) const {
        asm volatile("" : "+v"(fr), "+v"(fq));
        const int which = u.pn < 4 ? 1 : (u.pn < 8 ? 2 : 0), h0 = (u.pn & 3) * 4, pm = u.pm & 127;
        const float sc = (which == 0 ? QSCALE : 1.f) * mul;
        float nmax[2] = {0.f, 0.f};
#pragma unroll
        for (int ai = 0; ai < 2; ++ai)
#pragma unroll
            for (int m = 0; m < 4; ++m) {
                const int tok = pm * BM + ai * HALF + wr * 64 + m * 16 + fr, b = tok >> 12, s = tok & 4095;
#pragma unroll
                for (int bj = 0; bj < 2; ++bj) {
                    const int head = h0 + 2 * bj + (wc >> 1), dcol = (wc & 1) * 32 + 8 * fq;
                    const size_t plane = (size_t)((b * 3 + which) * 16 + head);
                    const f32x4 v0 = acc[ai][bj][m][0] * sc, v1 = acc[ai][bj][m][1] * sc;
                    u32x4 w; w.x = cvt_pk_bf16(v0[0], v0[1]); w.y = cvt_pk_bf16(v0[2], v0[3]); w.z = cvt_pk_bf16(v1[0], v1[1]); w.w = cvt_pk_bf16(v1[2], v1[3]);
                    *(u32x4*)(O + (plane * 4096 + s) * 64 + dcol) = w;
                    if (which != 2) {
                        float ss = 0.f;
#pragma unroll
                        for (int k4 = 0; k4 < 4; ++k4) { const unsigned pw_ = k4 == 0 ? w.x : (k4 == 1 ? w.y : (k4 == 2 ? w.z : w.w)); const float lo_ = __uint_as_float(pw_ << 16), hi_ = __uint_as_float(pw_ & 0xffff0000u); ss += lo_ * lo_ + hi_ * hi_; }
                        ss += __shfl_xor(ss, 16); ss += __shfl_xor(ss, 32);
                        nmax[bj] = fmaxf(nmax[bj], ss);
                    }
                }
            }
        if (which != 2) {
#pragma unroll
            for (int bj = 0; bj < 2; ++bj) { float v = nmax[bj];
                v = fmaxf(v, __shfl_xor(v, 1)); v = fmaxf(v, __shfl_xor(v, 2)); v = fmaxf(v, __shfl_xor(v, 4)); v = fmaxf(v, __shfl_xor(v, 8));
                if (fr == 0 && fq == 0) { const int b0 = (pm * BM) >> 12, head = h0 + 2 * bj + (wc >> 1);
                    atomicMax(nrm + (((b0 * 2 + which) * 16 + head) * 2 + (wc & 1)), __float_as_uint(v)); } }
        }
    }
};
template <bool SRC_BF16> struct EpiResid {
    static constexpr bool PERM = true, AFTER_DRAIN = false; static constexpr int NSTORE = 16;
    const void* src; bf16_t* dst; const float* gate; float mul;
    __device__ __forceinline__ void operator()(const f32x4 (&acc)[2][2][4][2], const Unit& u, int wr, int wc, int fr, int fq) const {
        asm volatile("" : "+v"(fr), "+v"(fq));
#pragma unroll
        for (int ai = 0; ai < 2; ++ai)
#pragma unroll
            for (int m = 0; m < 4; ++m) {
                const int row = u.pm * BM + ai * HALF + wr * 64 + m * 16 + fr, b = row >> 12;
#pragma unroll
                for (int bj = 0; bj < 2; ++bj) {
                    const int col = u.pn * BM + bj * HALF + wc * 32 + 8 * fq;
                    f32x4 x0, x1;
                    if (SRC_BF16) { const u32x4 r = *(const u32x4*)((const bf16_t*)src + (size_t)row * D + col);
                        x0 = (f32x4){__uint_as_float(r.x << 16), __uint_as_float(r.x & 0xffff0000u), __uint_as_float(r.y << 16), __uint_as_float(r.y & 0xffff0000u)};
                        x1 = (f32x4){__uint_as_float(r.z << 16), __uint_as_float(r.z & 0xffff0000u), __uint_as_float(r.w << 16), __uint_as_float(r.w & 0xffff0000u)}; }
                    else if (NT_ROWS) { x0 = __builtin_nontemporal_load((const f32x4*)((const float*)src + (size_t)row * D + col)); x1 = __builtin_nontemporal_load((const f32x4*)((const float*)src + (size_t)row * D + col + 4)); }
                    else { x0 = *(const f32x4*)((const float*)src + (size_t)row * D + col); x1 = *(const f32x4*)((const float*)src + (size_t)row * D + col + 4); }
                    const f32x4 g0 = *(const f32x4*)(gate + b * 6144 + col), g1 = *(const f32x4*)(gate + b * 6144 + col + 4);
                    const f32x4 v0 = x0 + (g0 * mul) * acc[ai][bj][m][0], v1 = x1 + (g1 * mul) * acc[ai][bj][m][1];
                    u32x4 w; w.x = cvt_pk_bf16(v0[0], v0[1]); w.y = cvt_pk_bf16(v0[2], v0[3]); w.z = cvt_pk_bf16(v1[0], v1[1]); w.w = cvt_pk_bf16(v1[2], v1[3]);
                    *(u32x4*)(dst + (size_t)row * D + col) = w;
                }
            }
    }
};
struct EpiSwiGLU {
    static constexpr bool PERM = true, AFTER_DRAIN = false; static constexpr int NSTORE = 0;
    bf16_t* ACT; const float* bgu;
    __device__ __forceinline__ void operator()(const f32x4 (&acc)[2][2][4][2], const Unit& u, int wr, int wc, int fr, int fq) const {
        const int e = u.pn >> 3, pnl = u.pn & 7, j0 = pnl * 128 + wc * 32 + 8 * fq;
        f32x4 bg[2], bu[2];
#pragma unroll
        for (int n = 0; n < 2; ++n) { bg[n] = *(const f32x4*)(bgu + e * 2048 + j0 + 4 * n); bu[n] = *(const f32x4*)(bgu + e * 2048 + 1024 + j0 + 4 * n); }
#pragma unroll
        for (int ai = 0; ai < 2; ++ai)
#pragma unroll
            for (int m = 0; m < 4; ++m) {
                const int row = u.pm * BM + ai * HALF + wr * 64 + m * 16 + fr;
                float a[8];
#pragma unroll
                for (int n = 0; n < 2; ++n) {
                    const f32x4 gv = acc[ai][0][m][n] + bg[n], uv = acc[ai][1][m][n] + bu[n];
#pragma unroll
                    for (int i = 0; i < 4; ++i) {
                        const float gg = fminf(gv[i], 7.f), uu = fminf(fmaxf(uv[i], -7.f), 7.f);
                        const float sg = __builtin_amdgcn_rcpf(1.f + __builtin_amdgcn_exp2f(-1.702f * LOG2E * gg));
                        a[4 * n + i] = (uu + 1.f) * gg * sg;
                    }
                }
                u32x4 w; w.x = cvt_pk_bf16(a[0], a[1]); w.y = cvt_pk_bf16(a[2], a[3]); w.z = cvt_pk_bf16(a[4], a[5]); w.w = cvt_pk_bf16(a[6], a[7]);
                *(u32x4*)(ACT + (size_t)row * D + j0) = w;
            }
    }
};
struct EpiDown {
    static constexpr bool PERM = true, AFTER_DRAIN = false; static constexpr int NSTORE = 0;
    bf16_t* Y; const float* bdn;
    __device__ __forceinline__ void operator()(const f32x4 (&acc)[2][2][4][2], const Unit& u, int wr, int wc, int fr, int fq) const {
        const int e = u.pn >> 2, pnl = u.pn & 3;
#pragma unroll
        for (int ai = 0; ai < 2; ++ai)
#pragma unroll
            for (int m = 0; m < 4; ++m) {
                const int row = u.pm * BM + ai * HALF + wr * 64 + m * 16 + fr;
#pragma unroll
                for (int bj = 0; bj < 2; ++bj) {
                    const int col = pnl * BM + bj * HALF + wc * 32 + 8 * fq;
                    const f32x4 b0 = *(const f32x4*)(bdn + e * 1024 + col), b1 = *(const f32x4*)(bdn + e * 1024 + col + 4);
                    const f32x4 v0 = acc[ai][bj][m][0] + b0, v1 = acc[ai][bj][m][1] + b1;
                    u32x4 w; w.x = cvt_pk_bf16(v0[0], v0[1]); w.y = cvt_pk_bf16(v0[2], v0[3]); w.z = cvt_pk_bf16(v1[0], v1[1]); w.w = cvt_pk_bf16(v1[2], v1[3]);
                    *(u32x4*)(Y + (size_t)row * D + col) = w;
                }
            }
    }
};
__device__ __forceinline__ unsigned pk4_fp8(float a, float b, float c, float d) { int v = __builtin_amdgcn_cvt_pk_fp8_f32(a, b, 0, false); v = __builtin_amdgcn_cvt_pk_fp8_f32(c, d, v, true); return (unsigned)v; }
struct EpiSwiGLU8 {
    static constexpr bool PERM = true, AFTER_DRAIN = false; static constexpr int NSTORE = 8;
    unsigned char* ACT; const float* bgu;
    __device__ __forceinline__ void operator()(const f32x4 (&acc)[2][2][4][2], const Unit& u, int wr, int wc, int fr, int fq) const {
        _Pragma("unroll") for (int rep_e = 0; rep_e < 1 + ((PROBE_EPI >> 1) & 1); ++rep_e) {
        asm volatile("" : "+v"(fr), "+v"(fq));
        const int e = u.pn >> 3, pnl = u.pn & 7, j0 = pnl * 128 + wc * 32 + 8 * fq;
        f32x4 bg[2], bu[2];
#pragma unroll
        for (int n = 0; n < 2; ++n) { bg[n] = *(const f32x4*)(bgu + e * 2048 + j0 + 4 * n) * 64.f; bu[n] = *(const f32x4*)(bgu + e * 2048 + 1024 + j0 + 4 * n) * 64.f + 64.f; }
#pragma unroll
        for (int ai = 0; ai < 2; ++ai)
#pragma unroll
            for (int m = 0; m < 4; ++m) {
                const int row = u.pm * BM + ai * HALF + wr * 64 + m * 16 + fr;
                float a[8];
#pragma unroll
                for (int n = 0; n < 2; ++n) {
                    const f32x4 gv = acc[ai][0][m][n] + bg[n], uv = acc[ai][1][m][n] + bu[n];
#pragma unroll
                    for (int i = 0; i < 4; ++i) {
                        const float gg = fminf(gv[i], 448.f), uu = fminf(fmaxf(uv[i], -384.f), 512.f);
                        const float t = __builtin_amdgcn_exp2f((-1.702f * LOG2E * 0.015625f) * gg);
                        const float sg = __builtin_amdgcn_rcpf(__builtin_fmaf(t, 4096.f, 4096.f));
                        a[4 * n + i] = (uu * gg) * sg;
                    }
                }
                typedef unsigned u32x2e __attribute__((ext_vector_type(2)));
                u32x2e w; w.x = pk4_fp8(a[0], a[1], a[2], a[3]); w.y = pk4_fp8(a[4], a[5], a[6], a[7]);
                *(u32x2e*)(ACT + (size_t)row * D + j0) = w;
            }
        }
    }
};
template <int VAR> struct EpiProbeGU {
    static constexpr bool PERM = true, AFTER_DRAIN = false; static constexpr int NSTORE = 0;
    unsigned char* ACT; const float* bgu;
    __device__ __forceinline__ void operator()(const f32x4 (&acc)[2][2][4][2], const Unit& u, int wr, int wc, int fr, int fq) const {
        if (VAR == 2) { if (acc[0][0][0][0][0] == 12345.678f) ACT[0] = 1; return; }
        asm volatile("" : "+v"(fr), "+v"(fq));
        const int pnl = u.pn & 7, j0 = pnl * 128 + wc * 32 + 8 * fq;
#pragma unroll
        for (int ai = 0; ai < 2; ++ai)
#pragma unroll
            for (int m = 0; m < 4; ++m) {
                const int row = u.pm * BM + ai * HALF + wr * 64 + m * 16 + fr;
                const f32x4 g0 = acc[ai][0][m][0] + acc[ai][1][m][0], g1 = acc[ai][0][m][1] + acc[ai][1][m][1];
                typedef unsigned u32x2e __attribute__((ext_vector_type(2)));
                u32x2e w; w.x = pk4_fp8(g0[0], g0[1], g0[2], g0[3]); w.y = pk4_fp8(g1[0], g1[1], g1[2], g1[3]);
                *(u32x2e*)(ACT + (size_t)row * D + j0) = w;
            }
    }
};
struct EpiNone { static constexpr bool PERM = true, AFTER_DRAIN = false; static constexpr int NSTORE = 0; unsigned char* P;
    __device__ __forceinline__ void operator()(const f32x4 (&acc)[2][2][4][2], const Unit& u, int wr, int wc, int fr, int fq) const { if (acc[0][0][0][0][0] == 12345.678f) P[0] = 1; } };
struct EpiDown8 {
    static constexpr bool PERM = true, AFTER_DRAIN = false; static constexpr int NSTORE = 16;
    bf16_t* Y; const float* bdn;
    __device__ __forceinline__ void operator()(const f32x4 (&acc)[2][2][4][2], const Unit& u, int wr, int wc, int fr, int fq) const {
        _Pragma("unroll") for (int rep_e = 0; rep_e < 1 + ((PROBE_EPI >> 2) & 1); ++rep_e) {
        asm volatile("" : "+v"(fr), "+v"(fq));
        const int e = u.pn >> 2, pnl = u.pn & 3;
#pragma unroll
        for (int ai = 0; ai < 2; ++ai)
#pragma unroll
            for (int m = 0; m < 4; ++m) {
                const int row = u.pm * BM + ai * HALF + wr * 64 + m * 16 + fr;
#pragma unroll
                for (int bj = 0; bj < 2; ++bj) {
                    const int col = pnl * BM + bj * HALF + wc * 32 + 8 * fq;
                    const f32x4 b0 = *(const f32x4*)(bdn + e * 1024 + col), b1 = *(const f32x4*)(bdn + e * 1024 + col + 4);
                    const f32x4 v0 = acc[ai][bj][m][0] * 0.015625f + b0, v1 = acc[ai][bj][m][1] * 0.015625f + b1;
                    if (Y_FP8) { typedef unsigned u32x2e __attribute__((ext_vector_type(2))); u32x2e w8; w8.x = pk4_fp8(v0[0], v0[1], v0[2], v0[3]); w8.y = pk4_fp8(v1[0], v1[1], v1[2], v1[3]);
                        *(u32x2e*)((unsigned char*)Y + (size_t)row * D + col) = w8; }
                    else { u32x4 w; w.x = cvt_pk_bf16(v0[0], v0[1]); w.y = cvt_pk_bf16(v0[2], v0[3]); w.z = cvt_pk_bf16(v1[0], v1[1]); w.w = cvt_pk_bf16(v1[2], v1[3]);
                        *(u32x4*)(Y + (size_t)row * D + col) = w; }
                }
            }
        }
    }
};
struct KVQOrder : StaticOrder {
    __device__ bool next(int i, Unit& u) const { if (!StaticOrder::next(i, u)) return false; if (u.pn >= 8) u.pm += 128; return true; }
};
template <int NN> struct MoeOrder {
    static constexpr int TR = 32 / NN;
    const LAS int* tile_exp; int n_tiles, c, G;
    __device__ __forceinline__ bool next(int i, Unit& u) const {
        int st, j;
        if (G == 256) { st = i * 8 + (c & 7); j = c >> 3; } else { const int L = i * G + c; st = L >> 5; j = L & 31; }
        const int tile = st * TR + (j % TR);
        if (tile >= n_tiles) return false;
        u.pm = tile; u.pn = tile_exp[tile] * NN + j / TR; return true;
    }
    __device__ __forceinline__ void a_ready(const Unit&) const {}
    __device__ __forceinline__ void done(const Unit&) const {}
};
struct MoeOrderProbe { const LAS int* tile_exp; int n_tiles, c, G;
    __device__ __forceinline__ bool next(int i, Unit& u) const { int st, j; if (G == 256) { st = i * 8 + (c & 7); j = c >> 3; } else { const int L = i * G + c; st = L >> 5; j = L & 31; }
        const int tile = st * 4 + (j % 4); if (tile >= n_tiles) return false; u.pm = tile; u.pn = j / 4; return true; }
    __device__ __forceinline__ void a_ready(const Unit&) const {}
    __device__ __forceinline__ void done(const Unit&) const {} };
}

namespace attn_body {
constexpr int KSLOT = 8192;
constexpr int L_K = 0, L_V = 2 * KSLOT, L_WS = 4 * KSLOT, L_OST = L_WS + 8 * 256, L_TAB = L_OST + 8 * 4096, L_ATT_END = L_TAB + 1024;
__device__ __forceinline__ void qkt2(f32x16& p0, f32x16& p1, const char* Kslot, const bf16x8* qr, const f32x16& c0, const f32x16& c1, int r32, int hi) {
  const char* kb = Kslot + hi * 1024 + r32 * 16;
  #pragma unroll
  for (int d0 = 0; d0 < 4; ++d0) {
    const bf16x8 b0 = *reinterpret_cast<const bf16x8*>(kb + d0 * 2048);
    const bf16x8 b1 = *reinterpret_cast<const bf16x8*>(kb + d0 * 2048 + 512);
    if (d0 == 0) { p0 = __builtin_amdgcn_mfma_f32_32x32x16_bf16(b0, qr[0], c0, 0, 0, 0); p1 = __builtin_amdgcn_mfma_f32_32x32x16_bf16(b1, qr[0], c1, 0, 0, 0); }
    else { p0 = __builtin_amdgcn_mfma_f32_32x32x16_bf16(b0, qr[d0], p0, 0, 0, 0); p1 = __builtin_amdgcn_mfma_f32_32x32x16_bf16(b1, qr[d0], p1, 0, 0, 0); } }
}
template <int MODE> __device__ __forceinline__ void attn_unit(const bf16* Qp, const bf16* __restrict__ Kp, const bf16* __restrict__ Vp, int q0, bf16* Ob, long ostride,
                                                               float* lse, long lstride, const float* __restrict__ F2, const float* __restrict__ tabg, char* shm) {
  const int tid = threadIdx.x, lane = tid & 63, r32 = lane & 31, hi = lane >> 5; const int wid = __builtin_amdgcn_readfirstlane(tid >> 6);
  const unsigned lds0 = (unsigned)(uintptr_t)shm;
  float* wsf = (float*)(shm + L_WS) + wid * 64;
  const int tq = q0 >> 6, t_hi = tq + 4;
  const int t_lo = (MODE == 0) ? (tq >= 2 ? tq - 2 : 0) : 0;
  const int w_hi = tq + (wid >> 1);
  const int w_lo = (MODE == 0) ? (w_hi >= 2 ? w_hi - 2 : 0) : 0;
  const bf16* ksrc = Kp + (long)lane * 64 + wid * 8;
  const bf16* vsrc = Vp + (long)(16 * (wid & 3) + (lane >> 2)) * 64 + (wid >> 2) * 32 + (lane & 3) * 8;
  const unsigned kdst = lds0 + L_K + wid * 1024, vdst = lds0 + L_V + wid * 1024;
  #define DMA_KV(t, slot) do { glds16(ksrc + (long)(t) * 4096, (unsigned)__builtin_amdgcn_readfirstlane(kdst + (slot) * KSLOT)); glds16(vsrc + (long)(t) * 4096, (unsigned)__builtin_amdgcn_readfirstlane(vdst + (slot) * KSLOT)); } while (0)
  if (MODE == 0) { float* tab = (float*)(shm + L_TAB); if (tid < 129) tab[tid] = tabg[tid]; }
  const int qi = q0 + wid * 32 + r32;
  f32x4 fk[8];
  #pragma unroll
  for (int g4 = 0; g4 < 8; ++g4) fk[g4] = (f32x4){0.f, 0.f, 0.f, 0.f};
  float Fq = 0.f;
  if (MODE == 1) { Fq = F2[qi];
    #pragma unroll
    for (int g4 = 0; g4 < 4; ++g4) { fk[g4] = *(const f32x4*)(F2 + 64 * t_lo + 4 * hi + 8 * g4); fk[4 + g4] = *(const f32x4*)(F2 + 64 * t_lo + 32 + 4 * hi + 8 * g4); } }
  bf16x8 qr[4];
  { const bf16* Qw = Qp + (long)(q0 + wid * 32) * 64;
    #pragma unroll
    for (int d0 = 0; d0 < 4; ++d0) qr[d0] = *reinterpret_cast<const bf16x8*>(&Qw[(long)r32 * 64 + d0 * 16 + hi * 8]); }
  DMA_KV(t_lo, 0);
  float m_run = -INFINITY, l_run = 0.f; f32x16 o[2]; o[0] = f32x16{}; o[1] = f32x16{};
  const int vb0 = (int)(lds0 + L_V) + ((lane >> 4) & 1) * 32 + (lane & 3) * 8 + (4 * hi + ((lane & 15) >> 2)) * 64;
  for (int t = t_lo; t < t_hi; ++t) {
    const int s = (t - t_lo) & 1;
    asm volatile("s_waitcnt vmcnt(0) lgkmcnt(0)\n\ts_barrier" ::: "memory");
    f32x4 fn[8];
    #pragma unroll
    for (int g4 = 0; g4 < 8; ++g4) fn[g4] = fk[g4];
    if (t + 1 < t_hi) {
      if (MODE == 1) {
        #pragma unroll
        for (int g4 = 0; g4 < 4; ++g4) { fn[g4] = *(const f32x4*)(F2 + 64 * (t + 1) + 4 * hi + 8 * g4); fn[4 + g4] = *(const f32x4*)(F2 + 64 * (t + 1) + 32 + 4 * hi + 8 * g4); } }
      DMA_KV(t + 1, s ^ 1);
    }
    if (t >= w_lo && t <= w_hi) {
      f32x16 c0, c1, p0, p1;
      if (MODE == 1) {
        #pragma unroll
        for (int r = 0; r < 16; ++r) { c0[r] = Fq - fk[r >> 2][r & 3]; c1[r] = Fq - fk[4 + (r >> 2)][r & 3]; }
      } else {
        const float* tab = (const float*)(shm + L_TAB);
        #pragma unroll
        for (int r = 0; r < 16; ++r) { const int d0_ = qi - (64 * t + crow(r, hi)), d1_ = d0_ - 32;
          c0[r] = tab[d0_ < 0 ? 0 : (d0_ > 128 ? 128 : d0_)]; c1[r] = tab[d1_ < 0 ? 0 : (d1_ > 128 ? 128 : d1_)]; }
      }
      qkt2(p0, p1, shm + L_K + s * KSLOT, qr, c0, c1, r32, hi);
      if (MODE == 1) {
        if (t == w_hi) {
          #pragma unroll
          for (int r = 0; r < 16; ++r) { const int kv = 64 * t + crow(r, hi); if (kv > qi) p0[r] = -INFINITY; if (kv + 32 > qi) p1[r] = -INFINITY; } }
      } else {
        #pragma unroll
        for (int r = 0; r < 16; ++r) { const int d0_ = qi - (64 * t + crow(r, hi)), d1_ = d0_ - 32;
          if ((unsigned)d0_ > 128u) p0[r] = -INFINITY; if ((unsigned)d1_ > 128u) p1[r] = -INFINITY; }
      }
      const float rm = rowmax(p0, p1), mnew = fmaxf(m_run, rm), msub = (mnew == -INFINITY) ? 0.f : mnew;
      const float f = __builtin_amdgcn_exp2f(m_run - msub);
      m_run = mnew;
      float sacc = 0.f;
      #pragma unroll
      for (int r = 0; r < 16; ++r) { p0[r] = __builtin_amdgcn_exp2f(p0[r] - msub); p1[r] = __builtin_amdgcn_exp2f(p1[r] - msub); sacc += p0[r] + p1[r]; }
      l_run = l_run * f + sacc;
      if (__any(f != 1.f)) {
        if (hi == 0) wsf[r32] = f;
        asm volatile("s_waitcnt lgkmcnt(0)" ::: "memory");
        #pragma unroll
        for (int r = 0; r < 16; ++r) { const float ff = wsf[crow(r, hi)]; o[0][r] *= ff; o[1][r] *= ff; }
      }
      u32x4 pw0, pw1, pw2, pw3;
      pw0 = (u32x4){cvtpk_s(p0[0], p0[1]), cvtpk_s(p0[2], p0[3]), cvtpk_s(p0[4], p0[5]), cvtpk_s(p0[6], p0[7])};
      pw1 = (u32x4){cvtpk_s(p0[8], p0[9]), cvtpk_s(p0[10], p0[11]), cvtpk_s(p0[12], p0[13]), cvtpk_s(p0[14], p0[15])};
      pw2 = (u32x4){cvtpk_s(p1[0], p1[1]), cvtpk_s(p1[2], p1[3]), cvtpk_s(p1[4], p1[5]), cvtpk_s(p1[6], p1[7])};
      pw3 = (u32x4){cvtpk_s(p1[8], p1[9]), cvtpk_s(p1[10], p1[11]), cvtpk_s(p1[12], p1[13]), cvtpk_s(p1[14], p1[15])};
      SBAR();
      pv(o, vb0 + s * KSLOT, __builtin_bit_cast(bf16x8, pw0), __builtin_bit_cast(bf16x8, pw1), __builtin_bit_cast(bf16x8, pw2), __builtin_bit_cast(bf16x8, pw3));
    }
    #pragma unroll
    for (int g4 = 0; g4 < 8; ++g4) fk[g4] = fn[g4];
  }
  { auto rr = __builtin_amdgcn_permlane32_swap(__float_as_uint(l_run), __float_as_uint(l_run), false, false); l_run = __uint_as_float(rr[0]) + __uint_as_float(rr[1]); }
  if (hi == 0) { wsf[32 + r32] = l_run; if (MODE == 0) lse[(long)qi * lstride] = m_run + __builtin_amdgcn_logf(l_run); }
  asm volatile("s_waitcnt lgkmcnt(0)" ::: "memory");
  float rli[16];
  #pragma unroll
  for (int r = 0; r < 16; ++r) rli[r] = __builtin_amdgcn_rcpf(wsf[32 + crow(r, hi)]);
  { bf16* stg = (bf16*)(shm + L_OST) + wid * 2048;
    #pragma unroll
    for (int r = 0; r < 16; ++r) { const int orow = crow(r, hi);
      #pragma unroll
      for (int d0 = 0; d0 < 2; ++d0) stg[orow * 64 + d0 * 32 + r32] = __float2bfloat16(o[d0][r] * rli[r]); }
    asm volatile("s_waitcnt lgkmcnt(0)" ::: "memory");
    bf16* Ow = Ob + (long)(q0 + wid * 32) * ostride;
    #pragma unroll
    for (int i = 0; i < 4; ++i) { const int row = i * 8 + (lane >> 3), ch = lane & 7; const u32x4 v = *(const u32x4*)(stg + row * 64 + ch * 8); *(u32x4*)(Ow + (long)row * ostride + ch * 8) = v; } }
  asm volatile("s_waitcnt lgkmcnt(0)\n\ts_barrier" ::: "memory");
  #undef DMA_KV
}
#undef SBAR
#undef WAIT_BAR
}

namespace attn_body {
constexpr int NSLOT = 3, SLOTB = 8192;
constexpr int T_K = 0, T_V = NSLOT * SLOTB, T_WS = 2 * NSLOT * SLOTB, T_OST = T_WS + 8 * 256, T_END = T_OST + 8 * 4096;
constexpr int T_F = 90112;
__device__ __forceinline__ void glds16s(unsigned voff,const void*sbase,unsigned lds_dst){unsigned keep;
  asm volatile("s_mov_b32 %0, m0\n\ts_mov_b32 m0, %3\n\ts_nop 0\n\tglobal_load_lds_dwordx4 %1, %2\n\ts_mov_b32 m0, %0":"=&s"(keep):"v"(voff),"s"(sbase),"s"(lds_dst):"memory");}
#define SBAR() __builtin_amdgcn_sched_barrier(0)
#define WAIT_BAR(N) asm volatile("s_waitcnt vmcnt(" #N ") lgkmcnt(0)\n\ts_barrier":::"memory")
template<int MODE, int THRL> __device__ __forceinline__ void attn_unit_t(const bf16* Qw0, const bf16* __restrict__ Kb, const bf16* __restrict__ Vb, const int NT, const int qoff,
                                                                         bf16* Ob, long ostride, float* lse, long lstride, char* shm) {
  const int tid=threadIdx.x,lane=tid&63,r32=lane&31,hi=lane>>5; const int wid=__builtin_amdgcn_readfirstlane(tid>>6);
  const unsigned lds0=(unsigned)(uintptr_t)shm;
  float*wsf=(float*)(shm+T_WS)+wid*64;
  typedef __attribute__((address_space(3))) const float* lds_f;
  const lds_f Fl=(lds_f)(shm+T_F)+((MODE==1)?qoff:0);
  const unsigned koff_=(unsigned)(lane*128+wid*16), voff_=(unsigned)((16*(wid&3)+(lane>>2))*128+(wid>>2)*64+(lane&3)*16);
  #define KOFF() koff_
  #define VOFF() voff_
  const unsigned kdst=lds0+T_K+wid*1024, vdst=lds0+T_V+wid*1024;
  #define DMA_K(t,slot) glds16s(KOFF(),(const char*)Kb+(long)(t)*8192,(unsigned)__builtin_amdgcn_readfirstlane(kdst+(slot)))
  #define DMA_V(t,slot) glds16s(VOFF(),(const char*)Vb+(long)(t)*8192,(unsigned)__builtin_amdgcn_readfirstlane(vdst+(slot)))
  const char*Kbase=shm+T_K; bf16x8 kf[8];
  const lds_cptr shm3=(lds_cptr)shm; const lds_cptr kp0=shm3+T_K+hi*1024+r32*16; const lds_cptr vp0=shm3+T_V+((lane>>4)&1)*32+(lane&3)*8+(4*hi+((lane&15)>>2))*64;
  DMA_K(0,0);DMA_V(0,0);DMA_K(1,SLOTB);
  bf16x8 qr[4];
  { const bf16*Qw=Qw0+(long)(wid*32)*64;
    #pragma unroll
    for(int d0=0;d0<4;++d0)qr[d0]=*reinterpret_cast<const bf16x8*>(&Qw[(long)r32*64+d0*16+hi*8]); }
  float mhat=0.f,l_reg=0.f;f32x16 o[2];o[0]=f32x16{};o[1]=f32x16{};
  const int qrel=wid*32+r32;
  const int qpos=(MODE>=1)?(64*(NT-4)+qrel):(qoff+qrel);
  #define FQ() ((MODE==1)?Fl[64*(NT-4)+wid*32+r32]:0.f)
  const int jb0=384-qpos+4*hi;
  #define CINIT(C0,C1,t,MASKED) do{ \
    if(MODE==2){ _Pragma("unroll") for(int r=0;r<16;++r){ C0[r]=-mhat; C1[r]=-mhat; } \
      if(MASKED){ const int jb_=(t)-(NT-4); if(jb_>=0){ const int kb_=64*jb_+4*hi; \
        _Pragma("unroll") for(int r=0;r<16;++r){ const int kv_=kb_+(r&3)+8*(r>>2); if(kv_>qrel)C0[r]=-INFINITY; if(kv_+32>qrel)C1[r]=-INFINITY; } } } \
    } else if(MODE==1){ const float fqm=FQ()-mhat; const lds_f fp_=Fl+64*(t)+4*hi; \
      _Pragma("unroll") for(int g4=0;g4<4;++g4){ const f32x4 a_=*(const __attribute__((address_space(3))) f32x4*)(fp_+8*g4), b_=*(const __attribute__((address_space(3))) f32x4*)(fp_+32+8*g4); \
        _Pragma("unroll") for(int i_=0;i_<4;++i_){ C0[4*g4+i_]=fqm-a_[i_]; C1[4*g4+i_]=fqm-b_[i_]; } } \
      if(MASKED){ const int jb_=(t)-(NT-4); if(jb_>=0){ const int kb_=64*jb_+4*hi; \
        _Pragma("unroll") for(int r=0;r<16;++r){ const int kv_=kb_+(r&3)+8*(r>>2); if(kv_>qrel)C0[r]=-INFINITY; if(kv_+32>qrel)C1[r]=-INFINITY; } } } \
    } else { const lds_f tp_=Fl+jb0+64*(t); \
      _Pragma("unroll") for(int r=0;r<16;++r){ C0[r]=tp_[(r&3)+8*(r>>2)]-mhat; C1[r]=tp_[32+(r&3)+8*(r>>2)]-mhat; } } \
  }while(0)
  bool resc=false;
  #define START(P0,P1) do{ const float rm=rowmax(P0,P1); resc=false; \
    { const float dl=(rm==-INFINITY)?0.f:rm; mhat=fadd_s(mhat,dl); \
      _Pragma("unroll") for(int r=0;r<16;++r){P0[r]=fsub_s(P0[r],dl);P1[r]=fsub_s(P1[r],dl);} } \
    _Pragma("unroll") for(int r=0;r<16;++r)P0[r]=__builtin_amdgcn_exp2f(P0[r]); }while(0)
  #define RESC() do{ if(resc){ asm volatile("s_waitcnt lgkmcnt(0)":::"memory"); \
      _Pragma("unroll") for(int d_=0;d_<2;++d_) _Pragma("unroll") for(int r=0;r<16;++r)o[d_][r]*=wsf[crow(r,hi)]; } }while(0)
  f32x16 pA0,pA1,pB0,pB1;
  int sl_prev=0,sl_cur=0,sl_next=SLOTB;
  #define ROT() do{sl_prev=sl_cur;sl_cur=sl_next;sl_next=(sl_next==(NSLOT-1)*SLOTB)?0:sl_next+SLOTB;}while(0)
  DMA_K(2,2*SLOTB);
  WAIT_BAR(3);
  CINIT(pA0,pA1,0,true);
  qkt2(pA0,pA1,Kbase,qr,pA0,pA1,r32,hi);asm volatile("s_nop 15\n\ts_nop 7":"+v"(pA0),"+v"(pA1));
  START(pA0,pA1);
  _Pragma("unroll") for(int r=0;r<16;++r)pA1[r]=__builtin_amdgcn_exp2f(pA1[r]);
  WAIT_BAR(0);
  DMA_K(3,0);DMA_V(1,SLOTB);
  ROT();
  kload8(kf,kp0+sl_cur);
  WAIT_BAR(2);
  s16x4 vlo[8],vhi[8]; u32x4 pw0,pw1,pw2,pw3;
  #define PKW(P,B) cvtpk_s(P[B],P[B+1])
  #define PAF(k) __builtin_bit_cast(bf16x8,pw##k)
  #define VFR(i) (bf16x8){vlo[i][0],vlo[i][1],vlo[i][2],vlo[i][3],vhi[i][0],vhi[i][1],vhi[i][2],vhi[i][3]}
  #define PIN(x) asm volatile("":"+v"(x))
  #define MX3(a,b,c) __builtin_fmaxf(__builtin_fmaxf((a),(b)),(c))
  #define GAPA(MF,A0,A1,A2,A3,W0,W1,PW) do{ MF; sacc+=A0; sacc+=A1; sacc+=A2; sacc+=A3; PIN(sacc); W0; W1; PIN(PW); SBAR(); }while(0)
  #define EX(v) __builtin_amdgcn_exp2f(v)
  #define GAPB(MF,X,B) do{ MF; X[B]=EX(X[B]); X[B+1]=EX(X[B+1]); X[B+2]=EX(X[B+2]); X[B+3]=EX(X[B+3]); PIN(X); SBAR(); }while(0)
  #define VRD(i) do{ vlo[i]=vtr(vp_+(((i)>>2)*4096+((i)&3)*1024)); vhi[i]=vtr(vp_+(((i)>>2)*4096+((i)&3)*1024+512)); }while(0)
  #define KRD(G,j) do{ if(G){ kload2(kf,kp0+sl_next,j); SBAR(); } }while(0)
  #define STEP(C0,C1,P0,P1,t,GK,GV,GL,MASKED) do{ SBAR(); \
    CINIT(C0,C1,t,MASKED); \
    const lds_cptr vp_=vp0+sl_prev; \
    VRD(0); SBAR(); float sacc=(P0[0]+P0[1]); \
    GAPA(C0=__builtin_amdgcn_mfma_f32_32x32x16_bf16(kf[0],qr[0],C0,0,0,0), P0[2],P0[3],P0[4],P0[5],     pw0[0]=PKW(P0,0), pw0[1]=PKW(P0,2), pw0); \
    VRD(4); SBAR(); GAPA(C1=__builtin_amdgcn_mfma_f32_32x32x16_bf16(kf[1],qr[0],C1,0,0,0), P0[6],P0[7],P0[8],P0[9],     pw0[2]=PKW(P0,4), pw0[3]=PKW(P0,6), pw0); \
    VRD(1); SBAR(); GAPA(C0=__builtin_amdgcn_mfma_f32_32x32x16_bf16(kf[2],qr[1],C0,0,0,0),   P0[10],P0[11],P0[12],P0[13], pw1[0]=PKW(P0,8), pw1[1]=PKW(P0,10), pw1); \
    VRD(5); SBAR(); GAPA(C1=__builtin_amdgcn_mfma_f32_32x32x16_bf16(kf[3],qr[1],C1,0,0,0),   P0[14],P0[15],P1[0],P1[1],   pw1[2]=PKW(P0,12),pw1[3]=PKW(P0,14), pw1); \
    VRD(2); SBAR(); GAPA(C0=__builtin_amdgcn_mfma_f32_32x32x16_bf16(kf[4],qr[2],C0,0,0,0),   P1[2],P1[3],P1[4],P1[5],     pw2[0]=PKW(P1,0), pw2[1]=PKW(P1,2), pw2); \
    VRD(6); SBAR(); GAPA(C1=__builtin_amdgcn_mfma_f32_32x32x16_bf16(kf[5],qr[2],C1,0,0,0),   P1[6],P1[7],P1[8],P1[9],     pw2[2]=PKW(P1,4), pw2[3]=PKW(P1,6), pw2); \
    VRD(3); SBAR(); GAPA(C0=__builtin_amdgcn_mfma_f32_32x32x16_bf16(kf[6],qr[3],C0,0,0,0),   P1[10],P1[11],P1[12],P1[13], pw3[0]=PKW(P1,8), pw3[1]=PKW(P1,10), pw3); \
    VRD(7); SBAR(); GAPA(C1=__builtin_amdgcn_mfma_f32_32x32x16_bf16(kf[7],qr[3],C1,0,0,0),   P1[14],P1[15],0.f,0.f,       pw3[2]=PKW(P1,12),pw3[3]=PKW(P1,14), pw3); \
    l_reg+=sacc; \
    if(GK){DMA_K((t)+3,sl_cur);} if(GV){DMA_V((t)+1,sl_next);} \
    { float a=MX3(C0[0],C0[1],C1[0]),b=MX3(C0[2],C0[3],C1[1]); a=MX3(a,C1[2],C1[3]); \
      _Pragma("unroll") for(int r=4;r<16;r+=4){a=MX3(a,C0[r],C0[r+1]);b=MX3(b,C0[r+2],C0[r+3]);a=MX3(a,C1[r],C1[r+1]);b=MX3(b,C1[r+2],C1[r+3]);} \
      float rm=__builtin_fmaxf(a,b); { auto rr=__builtin_amdgcn_permlane32_swap(__float_as_uint(rm),__float_as_uint(rm),false,false); rm=__builtin_fmaxf(__uint_as_float(rr[0]),__uint_as_float(rr[1])); } \
      resc=false; \
      if(__builtin_expect(__any(rm>(float)THRL),0)){ const float dl=__builtin_fmaxf(rm,0.f); mhat+=dl; \
        _Pragma("unroll") for(int r=0;r<16;++r){C0[r]-=dl;C1[r]-=dl;} \
        const float f=__builtin_amdgcn_exp2f(-dl); l_reg*=f; if(hi==0)wsf[r32]=f; resc=true; } } \
    SBAR(); \
    GAPB(o[0]=__builtin_amdgcn_mfma_f32_32x32x16_bf16(PAF(0),VFR(0),o[0],0,0,0), C0,0); \
    GAPB(o[1]=__builtin_amdgcn_mfma_f32_32x32x16_bf16(PAF(0),VFR(4),o[1],0,0,0), C0,4); \
    KRD(GL,0); GAPB(o[0]=__builtin_amdgcn_mfma_f32_32x32x16_bf16(PAF(1),VFR(1),o[0],0,0,0), C0,8); \
    KRD(GL,1); GAPB(o[1]=__builtin_amdgcn_mfma_f32_32x32x16_bf16(PAF(1),VFR(5),o[1],0,0,0), C0,12); \
    KRD(GL,2); GAPB(o[0]=__builtin_amdgcn_mfma_f32_32x32x16_bf16(PAF(2),VFR(2),o[0],0,0,0), C1,0); \
    KRD(GL,3); GAPB(o[1]=__builtin_amdgcn_mfma_f32_32x32x16_bf16(PAF(2),VFR(6),o[1],0,0,0), C1,4); \
    GAPB(o[0]=__builtin_amdgcn_mfma_f32_32x32x16_bf16(PAF(3),VFR(3),o[0],0,0,0), C1,8); \
    GAPB(o[1]=__builtin_amdgcn_mfma_f32_32x32x16_bf16(PAF(3),VFR(7),o[1],0,0,0), C1,12); \
    }while(0)
  int t=1;
  for(;t+5<NT;t+=2){
    STEP(pB0,pB1,pA0,pA1,t,true,true,true,false);     WAIT_BAR(2); RESC(); ROT();
    STEP(pA0,pA1,pB0,pB1,t+1,true,true,true,false);   WAIT_BAR(2); RESC(); ROT();
  }
  #define ENDW(tt) do{ if((tt)+3<NT){WAIT_BAR(2);} else if((tt)+2<NT){WAIT_BAR(1);} else {WAIT_BAR(0);} }while(0)
  for(;t+1<NT;t+=2){
    STEP(pB0,pB1,pA0,pA1,t,(t+3<NT),(t+1<NT),(t+1<NT),true);       ENDW(t);   RESC(); ROT();
    STEP(pA0,pA1,pB0,pB1,t+1,(t+4<NT),(t+2<NT),(t+2<NT),true);     ENDW(t+1); RESC(); ROT();
  }
  STEP(pB0,pB1,pA0,pA1,NT-1,false,false,false,true); RESC();
  { float sacc=pB0[0]+pB0[1]; _Pragma("unroll") for(int r=2;r<16;++r)sacc+=pB0[r]; _Pragma("unroll") for(int r=0;r<16;++r)sacc+=pB1[r]; l_reg+=sacc;
    pw0=(u32x4){PKW(pB0,0),PKW(pB0,2),PKW(pB0,4),PKW(pB0,6)};pw1=(u32x4){PKW(pB0,8),PKW(pB0,10),PKW(pB0,12),PKW(pB0,14)};pw2=(u32x4){PKW(pB1,0),PKW(pB1,2),PKW(pB1,4),PKW(pB1,6)};pw3=(u32x4){PKW(pB1,8),PKW(pB1,10),PKW(pB1,12),PKW(pB1,14)};
    int ln_=lane; asm volatile("":"+v"(ln_)); const int hi_=ln_>>5; const int vb0=(int)(lds0+T_V)+((ln_>>4)&1)*32+(ln_&3)*8+(4*hi_+((ln_&15)>>2))*64;
    SBAR(); pv(o,vb0+sl_cur,PAF(0),PAF(1),PAF(2),PAF(3)); }
  #undef PKW
  #undef PAF
  #undef VFR
  #undef PIN
  #undef MX3
  #undef GAPA
  #undef GAPB
  #undef EX
  #undef VRD
  #undef KRD
  #undef STEP
  #undef ENDW
  #undef CINIT
  {auto rr=__builtin_amdgcn_permlane32_swap(__float_as_uint(l_reg),__float_as_uint(l_reg),false,false);l_reg=__uint_as_float(rr[0])+__uint_as_float(rr[1]);}
  int r32e=r32,hie=hi; asm volatile("":"+v"(r32e),"+v"(hie));
  if(hie==0){ wsf[32+r32e]=l_reg; if(MODE==0) lse[(long)(wid*32+r32e)*lstride]=mhat+__builtin_amdgcn_logf(l_reg); }
  asm volatile("s_waitcnt lgkmcnt(0)":::"memory");
  float rli[16];
  #pragma unroll
  for(int r=0;r<16;++r)rli[r]=__builtin_amdgcn_rcpf(wsf[32+crow(r,hie)]);
  { bf16*stg=(bf16*)(shm+T_OST)+wid*2048;
    #pragma unroll
    for(int r=0;r<16;++r){const int orow=crow(r,hie);
      #pragma unroll
      for(int d0=0;d0<2;++d0)stg[orow*64+d0*32+r32e]=__float2bfloat16(o[d0][r]*rli[r]);}
    asm volatile("s_waitcnt lgkmcnt(0)":::"memory");
    bf16*Ow=Ob+(long)(wid*32)*ostride;
    int le_=lane; asm volatile("":"+v"(le_));
    #pragma unroll
    for(int i=0;i<4;++i){const int row=i*8+(le_>>3),ch=le_&7; const u32x4 v=*(const u32x4*)(stg+row*64+ch*8);
      if(WO_FP8&&MODE==1){ typedef unsigned u32x2o __attribute__((ext_vector_type(2))); u32x2o w8;
        w8.x=pg8::pk4_fp8(__uint_as_float(v.x<<16),__uint_as_float(v.x&0xffff0000u),__uint_as_float(v.y<<16),__uint_as_float(v.y&0xffff0000u));
        w8.y=pg8::pk4_fp8(__uint_as_float(v.z<<16),__uint_as_float(v.z&0xffff0000u),__uint_as_float(v.w<<16),__uint_as_float(v.w&0xffff0000u));
        *(u32x2o*)((unsigned char*)Ob+(long)(wid*32+row)*ostride+ch*8)=w8; }
      else *(u32x4*)(Ow+(long)row*ostride+ch*8)=v;} }
  asm volatile("s_waitcnt lgkmcnt(0)\n\ts_barrier":::"memory");
  #undef DMA_K
  #undef DMA_V
  #undef KOFF
  #undef FQ
  #undef VOFF
  #undef START
  #undef RESC
  #undef ROT
}
#undef SBAR
#undef WAIT_BAR
}

namespace attn_body {
constexpr int B_V = 0, B_VBUF = 49152, B_K = B_VBUF, B_WS = 2 * B_VBUF, B_OST = B_WS + 2048, B_TAB = B_OST + 32768, B_END = B_TAB + 2 * 1024;
struct BandUnit { const bf16* Q; const bf16* K; const bf16* V; bf16* O; float* L; const float* tab; int q0; int sh; };
__device__ __forceinline__ void band_decode(int L, BandUnit& u, const bf16* QKV, bf16* OG, float* LSE, const float* BT) {
    const int tri = L >> 4, u16 = L & 15, b = tri / 48, gh = tri % 48, g = gh >> 4, h = gh & 15;
    const int sh = 2 * g, Ls = 4096 >> sh;
    const int r = (g == 0) ? 0 : (g == 1 ? (u16 >> 2) : u16), uq = (g == 0) ? u16 : (g == 1 ? (u16 & 3) : 0);
    const size_t pl = (size_t)((b * 3 + g) * 3) * 16 + h;
    u.Q = QKV + (pl * 4096 + (size_t)r * Ls) * 64; u.K = u.Q + (size_t)16 * 4096 * 64; u.V = u.Q + (size_t)32 * 4096 * 64;
    const size_t tok0 = (size_t)b * 4096 + r;
    u.O = OG + ((size_t)g * 32768 + tok0) * 1024 + h * 64; u.L = LSE + ((size_t)g * 32768 + tok0) * 16 + h;
    u.tab = BT + gh * 132; u.q0 = uq * 256; u.sh = sh;
}
__device__ __forceinline__ void band_issue_v(const BandUnit& u, unsigned lds0, int lane, int wid) {
    const unsigned voff = (unsigned)((16 * (wid & 3) + (lane >> 2)) * 128 + (wid >> 2) * 64 + (lane & 3) * 16);
    const int w0 = u.q0 - 128;
    #pragma unroll
    for (int t = 0; t < 6; ++t) { const int k0 = w0 + 64 * t;
        if (k0 >= 0) glds16s(voff, (const char*)u.V + (long)k0 * 128, (unsigned)__builtin_amdgcn_readfirstlane(lds0 + B_V + t * 8192 + wid * 1024)); }
}
__device__ __forceinline__ void band_issue_k(const BandUnit& u, int tbuf, unsigned lds0, int tid, int lane, int wid) {
    const unsigned koff = (unsigned)(lane * 128 + wid * 16);
    const int w0 = u.q0 - 128;
    #pragma unroll
    for (int t = 0; t < 6; ++t) { const int k0 = w0 + 64 * t;
        if (k0 >= 0) glds16s(koff, (const char*)u.K + (long)k0 * 128, (unsigned)__builtin_amdgcn_readfirstlane(lds0 + B_K + t * 8192 + wid * 1024)); }
    if (tid < 192) { __attribute__((address_space(3))) float* tb = (__attribute__((address_space(3))) float*)(uintptr_t)(lds0 + B_TAB + tbuf * 1024);
        tb[tid] = (tid >= 32 && tid <= 160) ? u.tab[tid - 32] : -INFINITY; }
}
template <int VAR> __device__ __forceinline__ void band_phase(const bf16* QKV, bf16* OG, float* LSE, const float* BT, int first, int step, int NU, char* shm) {
    const int tid = threadIdx.x, lane = tid & 63, r32 = lane & 31, hi = lane >> 5; const int wid = __builtin_amdgcn_readfirstlane(tid >> 6);
    const unsigned lds0 = (unsigned)(uintptr_t)shm;
    float* wsf = (float*)(shm + B_WS) + wid * 64;
    typedef __attribute__((address_space(3))) const float* lds_f;
    BandUnit cur, nxt;
    int L = first, buf = 0;
#define BAND_LOADQ(U) do { const bf16* Qw_ = (U).Q + (long)((U).q0 + 32 * wid) * 64; \
        _Pragma("unroll") for (int d0 = 0; d0 < 4; ++d0) qn[d0] = *reinterpret_cast<const bf16x8*>(&Qw_[(long)r32 * 64 + d0 * 16 + hi * 8]); } while (0)
    bf16x8 qn[4];
    #pragma unroll
    for (int d0 = 0; d0 < 4; ++d0) qn[d0] = (bf16x8){0, 0, 0, 0, 0, 0, 0, 0};
    if (L < NU) { band_decode(L, cur, QKV, OG, LSE, BT); band_issue_k(cur, 0, lds0, tid, lane, wid); BAND_LOADQ(cur); }
    for (; L < NU; L += step, buf ^= 1) {
        const bool has_next = (L + step) < NU;
        if (has_next) band_decode(L + step, nxt, QKV, OG, LSE, BT); else nxt = cur;
        const int qw = cur.q0 + 32 * wid;
        const int jlo = (qw >= 128) ? 0 : ((128 - qw) >> 5);
        if (L == first) asm volatile("s_waitcnt vmcnt(0) lgkmcnt(0)\n\ts_barrier" ::: "memory");
        else asm volatile("s_waitcnt vmcnt(5) lgkmcnt(0)\n\ts_barrier" ::: "memory");
        bf16x8 qr[4];
        #pragma unroll
        for (int d0 = 0; d0 < 4; ++d0) qr[d0] = qn[d0];
        band_issue_v(cur, lds0, lane, wid);
        f32x16 S[5];
        { const lds_f tb = (lds_f)(uintptr_t)(lds0 + B_TAB + buf * 1024) + (5 + r32 - 4 * hi);
          #pragma unroll
          for (int j = 0; j < 5; ++j) {
              #pragma unroll
              for (int r = 0; r < 16; ++r) S[j][r] = (j >= jlo) ? tb[(128 - 32 * j) + 27 - ((r & 3) + 8 * (r >> 2))] : -INFINITY;
              if (j >= jlo) { const int wj = wid + j;
                  const __attribute__((address_space(3))) char* kp = (const __attribute__((address_space(3))) char*)(uintptr_t)(lds0 + B_K + (wj >> 1) * 8192 + hi * 1024 + ((wj & 1) * 32 + r32) * 16);
                  #pragma unroll
                  for (int d0 = 0; d0 < 4; ++d0) { const bf16x8 kf = *(const __attribute__((address_space(3))) bf16x8*)(kp + d0 * 2048);
                      S[j] = __builtin_amdgcn_mfma_f32_32x32x16_bf16(kf, qr[d0], S[j], 0, 0, 0); } } } }
        asm volatile("s_waitcnt vmcnt(0) lgkmcnt(0)\n\ts_barrier" ::: "memory");
        if (has_next) { band_issue_k(nxt, buf ^ 1, lds0, tid, lane, wid); BAND_LOADQ(nxt); }
        float mx = -INFINITY;
        #pragma unroll
        for (int j = 0; j < 5; ++j)
            #pragma unroll
            for (int r = 0; r < 16; ++r) mx = fmaxf(mx, S[j][r]);
        { auto rr = __builtin_amdgcn_permlane32_swap(__float_as_uint(mx), __float_as_uint(mx), false, false); mx = fmaxf(__uint_as_float(rr[0]), __uint_as_float(rr[1])); }
        float lsum = 0.f; u32x4 pw[5][2];
        #pragma unroll
        for (int j = 0; j < 5; ++j) {
            #pragma unroll
            for (int r = 0; r < 16; ++r) { S[j][r] = __builtin_amdgcn_exp2f(S[j][r] - mx); lsum += S[j][r]; }
            pw[j][0] = (u32x4){cvtpk_s(S[j][0], S[j][1]), cvtpk_s(S[j][2], S[j][3]), cvtpk_s(S[j][4], S[j][5]), cvtpk_s(S[j][6], S[j][7])};
            pw[j][1] = (u32x4){cvtpk_s(S[j][8], S[j][9]), cvtpk_s(S[j][10], S[j][11]), cvtpk_s(S[j][12], S[j][13]), cvtpk_s(S[j][14], S[j][15])}; }
        { auto rr = __builtin_amdgcn_permlane32_swap(__float_as_uint(lsum), __float_as_uint(lsum), false, false); lsum = __uint_as_float(rr[0]) + __uint_as_float(rr[1]); }
        f32x16 o[2]; o[0] = f32x16{}; o[1] = f32x16{};
        const int vlane = ((lane >> 4) & 1) * 32 + (lane & 3) * 8 + (4 * hi + ((lane & 15) >> 2)) * 64;
        #pragma unroll
        for (int j = 0; j < 5; ++j) if (j >= jlo) {
            const int wj = wid + j;
            const int vb = (int)(lds0 + B_V) + (wj >> 1) * 8192 + (wj & 1) * 2048 + vlane;
            s16x4 l0[2], h0[2], l1[2], h1[2];
            #pragma unroll
            for (int d0 = 0; d0 < 2; ++d0) {
                asm volatile("ds_read_b64_tr_b16 %0,%1 offset:%c2" : "=&v"(l0[d0]) : "v"(vb), "i"(d0 * 4096) : "memory");
                asm volatile("ds_read_b64_tr_b16 %0,%1 offset:%c2" : "=&v"(h0[d0]) : "v"(vb), "i"(d0 * 4096 + 512) : "memory");
                asm volatile("ds_read_b64_tr_b16 %0,%1 offset:%c2" : "=&v"(l1[d0]) : "v"(vb), "i"(d0 * 4096 + 1024) : "memory");
                asm volatile("ds_read_b64_tr_b16 %0,%1 offset:%c2" : "=&v"(h1[d0]) : "v"(vb), "i"(d0 * 4096 + 1536) : "memory"); }
            asm volatile("s_waitcnt lgkmcnt(0)" : "+v"(l0[0]), "+v"(h0[0]), "+v"(l1[0]), "+v"(h1[0]), "+v"(l0[1]), "+v"(h0[1]), "+v"(l1[1]), "+v"(h1[1]) :: "memory"); __builtin_amdgcn_sched_barrier(0);
            #pragma unroll
            for (int d0 = 0; d0 < 2; ++d0) {
                o[d0] = __builtin_amdgcn_mfma_f32_32x32x16_bf16(__builtin_bit_cast(bf16x8, pw[j][0]), (bf16x8){l0[d0][0], l0[d0][1], l0[d0][2], l0[d0][3], h0[d0][0], h0[d0][1], h0[d0][2], h0[d0][3]}, o[d0], 0, 0, 0);
                o[d0] = __builtin_amdgcn_mfma_f32_32x32x16_bf16(__builtin_bit_cast(bf16x8, pw[j][1]), (bf16x8){l1[d0][0], l1[d0][1], l1[d0][2], l1[d0][3], h1[d0][0], h1[d0][1], h1[d0][2], h1[d0][3]}, o[d0], 0, 0, 0); } }
        const long ostride = 1024L << cur.sh, lstride = 16L << cur.sh;
        if (hi == 0) { wsf[32 + r32] = lsum; cur.L[(long)(qw + r32) * lstride] = mx + __builtin_amdgcn_logf(lsum); }
        asm volatile("s_waitcnt lgkmcnt(0)" ::: "memory");
        float rli[16];
        #pragma unroll
        for (int r = 0; r < 16; ++r) rli[r] = __builtin_amdgcn_rcpf(wsf[32 + crow(r, hi)]);
        { bf16* stg = (bf16*)(shm + B_OST) + wid * 2048;
          #pragma unroll
          for (int r = 0; r < 16; ++r) { const int orow = crow(r, hi);
            #pragma unroll
            for (int d0 = 0; d0 < 2; ++d0) stg[orow * 64 + d0 * 32 + r32] = __float2bfloat16(o[d0][r] * rli[r]); }
          asm volatile("s_waitcnt lgkmcnt(0)" ::: "memory");
          bf16* Ow = cur.O + (long)qw * ostride;
          #pragma unroll
          for (int i = 0; i < 4; ++i) { const int row = i * 8 + (lane >> 3), ch = lane & 7; const u32x4 v = *(const u32x4*)(stg + row * 64 + ch * 8); *(u32x4*)(Ow + (long)row * ostride + ch * 8) = v; } }
        cur = nxt;
    }
    asm volatile("s_waitcnt vmcnt(0) lgkmcnt(0)\n\ts_barrier" ::: "memory");
#undef BAND_LOADQ
}
}
#define XB_TMO      128
#define XB_XCNT(j)  (256  + 64 * (j))
#define XB_XSUB(j)  (1280 + 64 * (j))
#define XB_XGEN(j)  (2304 + 64 * (j))
#define XB_TOP      3328
#define XB_TOPGEN   3392
#define XCD_BAR_WORDS 3456
#define XB_SPIN_CAP (1u << 18)

__device__ __forceinline__ unsigned xb_ld(unsigned* p)              { return __hip_atomic_load(p, __ATOMIC_RELAXED, __HIP_MEMORY_SCOPE_AGENT); }
__device__ __forceinline__ unsigned xb_add(unsigned* p, unsigned v) { return __hip_atomic_fetch_add(p, v, __ATOMIC_RELAXED, __HIP_MEMORY_SCOPE_AGENT); }
__device__ __forceinline__ unsigned xb_xcc_id() { return (unsigned)__builtin_amdgcn_s_getreg((3 << 11) | 20) & 0xFu; }
#define XB_SPIN(cond, bar) do { unsigned _sp = 0; while (cond) { __builtin_amdgcn_s_sleep(1); \
    if ((++_sp & 255u) == 0u) { if (xb_ld(&(bar)[XB_TMO])) break; if (_sp > XB_SPIN_CAP) { atomicAdd(&(bar)[XB_TMO], 1u); break; } } } } while (0)

struct XcdBarrier {
    unsigned* bar; unsigned x;
    volatile LAS unsigned* st;
};

__device__ __forceinline__ XcdBarrier xcd_barrier_post(unsigned* bar, volatile LAS unsigned* st) {
    XcdBarrier b; b.bar = bar; b.x = xb_xcc_id(); b.st = st;
    if (threadIdx.x == 0) (void)xb_add(&bar[XB_XCNT(b.x)], 1u);
    return b;
}
__device__ __forceinline__ void xcd_barrier_complete(unsigned* bar, unsigned x, unsigned& nloc, unsigned& nx) {
    const unsigned G = gridDim.x * gridDim.y * gridDim.z;
    unsigned sum, cnt, mine, sp = 0u;
    for (;;) {
        sum = 0u; cnt = 0u; mine = 0u;
#pragma unroll
        for (unsigned j = 0; j < 16; ++j) { const unsigned c = xb_ld(&bar[XB_XCNT(j)]); sum += c; cnt += (c > 0u) ? 1u : 0u; mine = (j == x) ? c : mine; }
        if (sum == G) break;
        __builtin_amdgcn_s_sleep(1);
        if ((++sp & 255u) == 0u) { if (xb_ld(&bar[XB_TMO])) break; if (sp > XB_SPIN_CAP) { atomicAdd(&bar[XB_TMO], 1u); break; } }
    }
    nloc = mine > 0u ? mine : 1u; nx = cnt > 0u ? cnt : 1u;
}

__device__ __forceinline__ void xcd_barrier(const XcdBarrier& b) {
    asm volatile("s_waitcnt vmcnt(0)" ::: "memory");
    __syncthreads();
    if (threadIdx.x == 0) {
        unsigned* bar = b.bar;
        __builtin_amdgcn_s_waitcnt(0);
        unsigned nloc = b.st[0], nx = b.st[1];
        if (nloc == 0u) { xcd_barrier_complete(bar, b.x, nloc, nx); b.st[0] = nloc; b.st[1] = nx; }
        const unsigned old = xb_add(&bar[XB_XSUB(b.x)], 1u);
        const unsigned gen = old / nloc;
        if (old + 1u == (gen + 1u) * nloc) {
            __builtin_amdgcn_fence(__ATOMIC_RELEASE, "agent");
            asm volatile("s_waitcnt vmcnt(0)" ::: "memory");
            const unsigned og = xb_add(&bar[XB_TOP], 1u);
            const unsigned tg = og / nx;
            if (og + 1u == (tg + 1u) * nx) xb_add(&bar[XB_TOPGEN], 1u);
            else XB_SPIN(xb_ld(&bar[XB_TOPGEN]) == tg, bar);
            __builtin_amdgcn_fence(__ATOMIC_ACQUIRE, "agent");
            xb_add(&bar[XB_XGEN(b.x)], 1u);
            asm volatile("s_waitcnt vmcnt(0)" ::: "memory");
        } else {
            XB_SPIN(xb_ld(&bar[XB_XGEN(b.x)]) == gen, bar);
            __builtin_amdgcn_fence(__ATOMIC_ACQUIRE, "agent");
            asm volatile("s_waitcnt vmcnt(0)" ::: "memory");
        }
    }
    __syncthreads();
}

struct Args { const float* in[21]; float* out; unsigned char* ws; int ph_lo, ph_hi; };
enum { IN_X = 0, IN_C, IN_ADAW, IN_ADAB, IN_NMIX, IN_NFFN, IN_AWQKV, IN_AWO, IN_RELB, IN_KVNG, IN_WKVF, IN_BF, IN_BWQ, IN_BWO, IN_RW, IN_RB, IN_WGU, IN_BGU, IN_WDN, IN_BDN, IN_FNG };

struct Ctx {
    LAS unsigned char* lds; unsigned char* ws; int tid, lane, wave, vcu, G;
};

__device__ __forceinline__ void transpose_item(const float* __restrict__ W, int pitch, int Kd, bf16* WT, int k0, int n0, int row_off, LAS float* scr, int lane) {
#pragma unroll
    for (int i = 0; i < 8; ++i) { const int kk = 8 * i + (lane >> 3), c4 = (lane & 7) * 4;
        const f32x4 v = *(const f32x4*)(W + (size_t)(k0 + kk) * pitch + n0 + c4);
        scr[kk * 33 + c4] = v[0]; scr[kk * 33 + c4 + 1] = v[1]; scr[kk * 33 + c4 + 2] = v[2]; scr[kk * 33 + c4 + 3] = v[3]; }
    LDS_WAIT(); asm volatile("" ::: "memory");
    const int c = lane & 7;
#pragma unroll
    for (int j = 0; j < 4; ++j) { const int n = (lane >> 3) + 8 * j; const LAS float* s = scr + (8 * c) * 33 + n;
        u32x4v o; o.x = pkbf(s[0 * 33], s[1 * 33]); o.y = pkbf(s[2 * 33], s[3 * 33]); o.z = pkbf(s[4 * 33], s[5 * 33]); o.w = pkbf(s[6 * 33], s[7 * 33]);
        *(u32x4v*)(WT + (size_t)(row_off + n0 + n) * Kd + k0 + 8 * c) = o; }
    LDS_WAIT(); asm volatile("" ::: "memory");
}

__device__ __forceinline__ void transpose_item8(const float* __restrict__ W, int pitch, int Kd, unsigned char* WT, int k0, int n0, int row_off, LAS float* scr, int lane) {
#pragma unroll
    for (int i = 0; i < 8; ++i) { const int kk = 8 * i + (lane >> 3), c4 = (lane & 7) * 4;
        const f32x4 v = *(const f32x4*)(W + (size_t)(k0 + kk) * pitch + n0 + c4) * 64.f;
        scr[kk * 33 + c4] = v[0]; scr[kk * 33 + c4 + 1] = v[1]; scr[kk * 33 + c4 + 2] = v[2]; scr[kk * 33 + c4 + 3] = v[3]; }
    LDS_WAIT(); asm volatile("" ::: "memory");
    const int c = lane & 7;
#pragma unroll
    for (int j = 0; j < 4; ++j) { const int n = (lane >> 3) + 8 * j; const LAS float* s = scr + (8 * c) * 33 + n;
        u32x2v o; o.x = pg8::pk4_fp8(s[0 * 33], s[1 * 33], s[2 * 33], s[3 * 33]); o.y = pg8::pk4_fp8(s[4 * 33], s[5 * 33], s[6 * 33], s[7 * 33]);
        *(u32x2v*)(WT + (size_t)(row_off + n0 + n) * Kd + k0 + 8 * c) = o; }
    LDS_WAIT(); asm volatile("" ::: "memory");
}

__device__ __forceinline__ void p0_prologue(const Ctx& C, const Args& a) {
    LAS float* scr = (LAS float*)(C.lds + RING_OFF + C.wave * 8704);
    const int gw = C.vcu * NWAVES + C.wave, NGW = C.G * NWAVES;
    constexpr int I_QKV = 16 * 288, I_SQ = 16 * 32, I_KV = 16 * 64, I_GU1 = 16 * 64, I_DN1 = 16 * 32;
    constexpr int O_WO0 = I_QKV, O_KV = O_WO0 + I_SQ, O_WQ = O_KV + I_KV, O_WO1 = O_WQ + I_SQ, O_GU = O_WO1 + I_SQ, O_DN = O_GU + 64 * I_GU1, NITEMS = O_DN + 64 * I_DN1;
    static_assert(QKV_FP8 && KVQ_FP8 && WO_FP8, "the pipelined prologue converts every weight to fp8");
    struct Item { const float* W; unsigned char* WT; int pitch, k0, n0, row_off; };
    auto decode = [&](int it, Item& I) {
        if (it < O_WO0) { const int r = it, kb = r / 288, nb = r % 288; I = {a.in[IN_AWQKV], (unsigned char*)(C.ws + WS_WQKV), NQKV, 64 * kb, 32 * nb, 0}; }
        else if (it < O_KV) { const int r = it - O_WO0, kb = r / 32, nb = r % 32; I = {a.in[IN_AWO], (unsigned char*)(C.ws + WS_WO0), D, 64 * kb, 32 * nb, 0}; }
        else if (it < O_WQ) { const int r = it - O_KV, kb = r / 64, nb = r % 64; I = {a.in[IN_WKVF], (unsigned char*)(C.ws + WS_WKV), 2064, 64 * kb, 32 * nb, 0}; }
        else if (it < O_WO1) { const int r = it - O_WQ, kb = r / 32, nb = r % 32; I = {a.in[IN_BWQ], (unsigned char*)(C.ws + WS_WKV) + (size_t)2048 * D, D, 64 * kb, 32 * nb, 0}; }
        else if (it < O_GU) { const int r = it - O_WO1, kb = r / 32, nb = r % 32; I = {a.in[IN_BWO], (unsigned char*)(C.ws + WS_WO1), D, 64 * kb, 32 * nb, 0}; }
        else if (it < O_DN) { const int r = it - O_GU, mat = r / I_GU1, q = r % I_GU1, kb = q / 64, nb = q % 64;
            const int n0 = 32 * nb, which = n0 >> 10, j0 = n0 & 1023, drow0 = (j0 >> 7) * 256 + which * 128 + (j0 & 127);
            I = {a.in[IN_WGU] + (size_t)mat * D * 2048, (unsigned char*)(C.ws + WS_WGU) + (size_t)mat * 2048 * D, 2048, 64 * kb, n0, drow0 - n0}; }
        else { const int r = it - O_DN, mat = r / I_DN1, q = r % I_DN1, kb = q / 32, nb = q % 32;
            I = {a.in[IN_WDN] + (size_t)mat * D * D, (unsigned char*)(C.ws + WS_WDN) + (size_t)mat * D * D, D, 64 * kb, 32 * nb, 0}; }
    };
    const int lr = C.lane >> 3, c4 = (C.lane & 7) * 4;
#define P0_LOAD(V, I) do { _Pragma("unroll") for (int i = 0; i < 8; ++i) V[i] = NT_P0 ? __builtin_nontemporal_load((const f32x4*)((I).W + (size_t)((I).k0 + 8 * i + lr) * (I).pitch + (I).n0 + c4)) : *(const f32x4*)((I).W + (size_t)((I).k0 + 8 * i + lr) * (I).pitch + (I).n0 + c4); } while (0)
    f32x4 vc[8], vn[8]; Item Ic, In;
    if (gw < NITEMS) { decode(gw, Ic); P0_LOAD(vc, Ic); }
    for (int it = gw; it < NITEMS; it += NGW) {
        const bool hn = (it + NGW) < NITEMS;
        if (hn) { decode(it + NGW, In); P0_LOAD(vn, In); }
#pragma unroll
        for (int i = 0; i < 8; ++i) { const int kk = 8 * i + lr; const f32x4 v = vc[i] * 64.f;
            scr[kk * 33 + c4] = v[0]; scr[kk * 33 + c4 + 1] = v[1]; scr[kk * 33 + c4 + 2] = v[2]; scr[kk * 33 + c4 + 3] = v[3]; }
        LDS_WAIT(); asm volatile("" ::: "memory");
        { const int cc = C.lane & 7;
#pragma unroll
          for (int j = 0; j < 4; ++j) { const int n = lr + 8 * j; const LAS float* s = scr + (8 * cc) * 33 + n;
              u32x2v o; o.x = pg8::pk4_fp8(s[0 * 33], s[1 * 33], s[2 * 33], s[3 * 33]); o.y = pg8::pk4_fp8(s[4 * 33], s[5 * 33], s[6 * 33], s[7 * 33]);
              *(u32x2v*)(Ic.WT + (size_t)(Ic.row_off + Ic.n0 + n) * D + Ic.k0 + 8 * cc) = o; } }
        LDS_WAIT(); asm volatile("" ::: "memory");
        if (hn) { Ic = In;
#pragma unroll
            for (int i = 0; i < 8; ++i) vc[i] = vn[i]; }
    }
#undef P0_LOAD
    __syncthreads();
    LAS float* cs = (LAS float*)(C.lds + RING_OFF);
    LAS float* red = (LAS float*)(C.lds + RING_OFF + 32768);
    for (int i = C.tid; i < 8192; i += 512) { const float v = a.in[IN_C][i]; cs[i] = v / (1.f + __expf(-v)); }
    __syncthreads();
    float* ADA = (float*)(C.ws + SM_ADA);
    for (int grp = C.vcu; grp < 192; grp += C.G) {
        const int l = grp / 96, col = (grp % 96) * 64 + C.lane;
        const float* w = a.in[IN_ADAW] + (size_t)l * D * 6144 + col;
        float acc[8];
#pragma unroll
        for (int b = 0; b < 8; ++b) acc[b] = 0.f;
        const int kbeg = C.wave * 128;
#pragma unroll 4
        for (int k = kbeg; k < kbeg + 128; k += 4) {
            float wv[4];
#pragma unroll
            for (int j = 0; j < 4; ++j) wv[j] = w[(size_t)(k + j) * 6144];
#pragma unroll
            for (int b = 0; b < 8; ++b) { const f32x4 cv = *(const LAS f32x4*)(cs + b * 1024 + k); acc[b] += cv[0] * wv[0] + cv[1] * wv[1] + cv[2] * wv[2] + cv[3] * wv[3]; }
        }
#pragma unroll
        for (int b = 0; b < 8; ++b) red[(C.wave * 8 + b) * 64 + C.lane] = acc[b];
        __syncthreads();
        { const int b = C.wave; float s = 0.f;
#pragma unroll
          for (int w8 = 0; w8 < 8; ++w8) s += red[(w8 * 8 + b) * 64 + C.lane];
          ADA[(size_t)(l * 8 + b) * 6144 + col] = s + a.in[IN_ADAB][l * 6144 + col]; }
        __syncthreads();
    }
    if (C.vcu == C.G - 1) {
        float* BT = (float*)(C.ws + SM_BIAST);
        for (int i = C.tid; i < 48 * 129; i += 512) { const int gh = i / 129, dl = i % 129, g = gh >> 4, n = dl << (2 * g);
            int bk = n;
            if (n >= 16) { const float nf = (float)n; bk = 16 + (int)(logf(nf / 16.f) / 4.852030263919617f * 16.f); bk = bk > 31 ? 31 : bk; }
            BT[gh * 132 + dl] = a.in[IN_RELB][bk * 48 + gh] * LOG2E; }
    }
}

__device__ __forceinline__ void p1_rows0(const Ctx& C, const Args& a) {
    const float* ADA = (const float*)(C.ws + SM_ADA);
    float* GM = (float*)(C.ws + SM_GM); float* CSH = (float*)(C.ws + SM_CSH);
    const int gt = C.vcu * 512 + C.tid, NGT = C.G * 512;
    for (int i = gt; i < 2 * 2 * 8 * 1024; i += NGT) { const int d = i & 1023, b = (i >> 10) & 7, kind = (i >> 13) & 1, l = i >> 14;
        const float g = kind ? a.in[IN_NFFN][l * D + d] : a.in[IN_NMIX][l * D + d];
        GM[i] = g * (1.f + ADA[(size_t)(l * 8 + b) * 6144 + (kind ? 4 : 1) * 1024 + d]); }
    const int gw = C.vcu * NWAVES + C.wave, NGW = C.G * NWAVES;
    for (int o = gw; o < 512; o += NGW) { const int e = o & 31, b = (o >> 5) & 7, l = o >> 8; float s = 0.f;
        for (int d = C.lane; d < D; d += 64) s += ADA[(size_t)(l * 8 + b) * 6144 + 3 * 1024 + d] * a.in[IN_RW][(size_t)l * D * 32 + d * 32 + e];
        s = wave_sum(s); if (C.lane == 0) CSH[o] = s + a.in[IN_RB][l * 32 + e]; }
    bf16* H = (bf16*)(C.ws + WS_H);
    for (int m = gw; m < T; m += NGW) {
        const int b = m >> 12;
        const f32x4* xr = (const f32x4*)(a.in[IN_X] + (size_t)m * D) + C.lane;
        const f32x4* gr = (const f32x4*)(a.in[IN_NMIX]) + C.lane;
        const f32x4* sc = (const f32x4*)(ADA + (size_t)b * 6144 + 1024) + C.lane;
        const f32x4* sh = (const f32x4*)(ADA + (size_t)b * 6144) + C.lane;
        f32x4 v[4]; float s = 0.f;
#pragma unroll
        for (int j = 0; j < 4; ++j) { v[j] = NT_ROWS ? __builtin_nontemporal_load(xr + 64 * j) : xr[64 * j]; s += (v[j].x * v[j].x + v[j].y * v[j].y) + (v[j].z * v[j].z + v[j].w * v[j].w); }
        const float rstd = 1.f / sqrtf(wave_sum(s) * (1.f / D) + RMS_EPS);
        unsigned long long* o8 = (unsigned long long*)(H + (size_t)m * D) + C.lane; unsigned* o4 = (unsigned*)(C.ws + WS_H8 + (size_t)m * D) + C.lane;
#pragma unroll
        for (int j = 0; j < 4; ++j) { const f32x4 h = v[j] * rstd * gr[64 * j] * (sc[64 * j] + 1.f) + sh[64 * j];
            if (QKV_FP8) o4[64 * j] = pg8::pk4_fp8(h.x, h.y, h.z, h.w);
            else o8[64 * j] = (unsigned long long)pkbf(h.x, h.y) | ((unsigned long long)pkbf(h.z, h.w) << 32); }
    }
}

__device__ __forceinline__ void p3_dilated(const Ctx& C) {
    attn_body::band_phase<0>((const attn_body::bf16*)(C.ws + WS_QKV0), (attn_body::bf16*)(C.ws + WS_OG), (float*)(C.ws + SM_LSE), (const float*)(C.ws + SM_BIAST), C.vcu, C.G, 384 * 16, (char*)C.lds + RING_OFF);
}
template <int MODE> __device__ __forceinline__ void p12_fox(const Ctx& C, size_t o_off) {
    const attn_body::bf16* QKV = (const attn_body::bf16*)(C.ws + WS_QKV1);
    attn_body::bf16* O = (attn_body::bf16*)(C.ws + o_off); const float* FC = (const float*)(C.ws + SM_FCUM);
    LAS float* Fl = (LAS float*)(C.lds + RING_OFF + attn_body::T_F);
    LAS int* qslot = (LAS int*)(C.lds + BLK_OFF);
    unsigned* qhead = (unsigned*)(C.ws + WS_CTL) + CW_QUEUE; const unsigned* NRM = (const unsigned*)(C.ws + WS_CTL) + CW_NRM;
    int cur_bh = -1; float thr = 0.f;
    for (;;) {
        int l_; asm volatile("v_mbcnt_lo_u32_b32 %0, -1, 0\n\tv_mbcnt_hi_u32_b32 %0, -1, %0" : "=v"(l_)); const int t_ = C.wave * 64 + l_;
        __syncthreads();
        if (t_ == 0) qslot[0] = (int)__hip_atomic_fetch_add(qhead, 1u, __ATOMIC_RELAXED, __HIP_MEMORY_SCOPE_AGENT);
        __syncthreads();
        const int idx = qslot[0];
        if (idx >= 2048) break;
        const int qb = 15 - (idx >> 7), bh = idx & 127, b = bh >> 4, h = bh & 15, q0 = qb * 256;
        const attn_body::bf16* Qp = QKV + ((size_t)(b * 3 + 0) * 16 + h) * 4096 * 64;
        const attn_body::bf16* Kp = QKV + ((size_t)(b * 3 + 1) * 16 + h) * 4096 * 64;
        const attn_body::bf16* Vp = QKV + ((size_t)(b * 3 + 2) * 16 + h) * 4096 * 64;
        if (bh != cur_bh) {
            { const f32x4* src = (const f32x4*)(FC + (size_t)bh * 4096); LAS f32x4* dst = (LAS f32x4*)Fl; dst[t_] = src[t_]; dst[512 + t_] = src[512 + t_]; }
            const float gq = __uint_as_float(NRM[((b * 2 + 0) * 16 + h) * 2]) + __uint_as_float(NRM[((b * 2 + 0) * 16 + h) * 2 + 1]);
            const float gk = __uint_as_float(NRM[((b * 2 + 1) * 16 + h) * 2]) + __uint_as_float(NRM[((b * 2 + 1) * 16 + h) * 2 + 1]);
            thr = 2.f * (sqrtf(gq) * sqrtf(gk) * 1.001f + 1e-3f) + 152.f;
            cur_bh = bh;
            __syncthreads();
        }
        int tlo = 0;
        if (MODE == 1) {
            const int NTq = 4 * qb;
            const bool dead = (l_ < NTq) && (Fl[q0] - Fl[64 * l_ + 63] <= -thr);
            tlo = __popcll(__ballot(dead)) & ~1;
        }
        attn_body::attn_unit_t<MODE, 64>(Qp + (size_t)q0 * 64, Kp + (size_t)tlo * 4096, Vp + (size_t)tlo * 4096, 4 * qb + 4 - tlo, 64 * tlo, (WO_FP8 && MODE == 1) ? (attn_body::bf16*)((unsigned char*)O + ((size_t)b * 4096 + q0) * D + h * 64) : O + ((size_t)b * 4096 + q0) * D + h * 64, (long)D, nullptr, 0, (char*)C.lds + RING_OFF);
    }
}
__device__ __forceinline__ void p4_merge(const Ctx& C) {
    const bf16* OG = (const bf16*)(C.ws + WS_OG); const float* LSE = (const float*)(C.ws + SM_LSE); bf16* O = (bf16*)(C.ws + WS_O);
    const int gt = C.vcu * 512 + C.tid, NGT = C.G * 512;
    for (int i = gt; i < T * 128; i += NGT) { const int tok = i >> 7, c8 = i & 127, hd = c8 >> 3;
        const float l0 = LSE[(size_t)tok * 16 + hd], l1 = LSE[((size_t)T + tok) * 16 + hd], l2 = LSE[((size_t)2 * T + tok) * 16 + hd];
        const float mx = fmaxf(l0, fmaxf(l1, l2)); float w0 = __builtin_amdgcn_exp2f(l0 - mx), w1 = __builtin_amdgcn_exp2f(l1 - mx), w2 = __builtin_amdgcn_exp2f(l2 - mx);
        const float inv = 1.f / (w0 + w1 + w2); w0 *= inv; w1 *= inv; w2 *= inv;
        const u32x4v a0 = NT_ROWS ? __builtin_nontemporal_load((const u32x4v*)(OG + (size_t)tok * D + c8 * 8)) : *(const u32x4v*)(OG + (size_t)tok * D + c8 * 8), a1 = NT_ROWS ? __builtin_nontemporal_load((const u32x4v*)(OG + ((size_t)T + tok) * D + c8 * 8)) : *(const u32x4v*)(OG + ((size_t)T + tok) * D + c8 * 8), a2 = NT_ROWS ? __builtin_nontemporal_load((const u32x4v*)(OG + ((size_t)2 * T + tok) * D + c8 * 8)) : *(const u32x4v*)(OG + ((size_t)2 * T + tok) * D + c8 * 8);
        u32x4v o;
#pragma unroll
        for (int k = 0; k < 4; ++k) { const float lo = w0 * bf2f(a0[k] & 0xffffu) + w1 * bf2f(a1[k] & 0xffffu) + w2 * bf2f(a2[k] & 0xffffu);
            float hi = w0 * bf2f(a0[k] >> 16) + w1 * bf2f(a1[k] >> 16) + w2 * bf2f(a2[k] >> 16); float lo2 = lo;
#if PROBE_SANITIZE
            if (!(fabsf(lo2) < 1e30f)) lo2 = 0.f; if (!(fabsf(hi) < 1e30f)) hi = 0.f;
#endif
            o[k] = pkbf(lo2, hi); }
        if (WO_FP8) { u32x2v o8; o8.x = pg8::pk4_fp8(bf2f(o[0] & 0xffffu), bf2f(o[0] >> 16), bf2f(o[1] & 0xffffu), bf2f(o[1] >> 16)); o8.y = pg8::pk4_fp8(bf2f(o[2] & 0xffffu), bf2f(o[2] >> 16), bf2f(o[3] & 0xffffu), bf2f(o[3] >> 16));
            *(u32x2v*)((unsigned char*)O + (size_t)tok * D + c8 * 8) = o8; }
        else *(u32x4v*)(O + (size_t)tok * D + c8 * 8) = o; }
}

__device__ __forceinline__ f32x4 bf4_to_f32(u32x2v v) { return (f32x4){bf2f(v.x & 0xffffu), bf2f(v.x >> 16), bf2f(v.y & 0xffffu), bf2f(v.y >> 16)}; }
typedef u32x2v xs4_t;
__device__ __forceinline__ f32x4 xs4_to_f32(xs4_t v) { return bf4_to_f32(v); }
__device__ __forceinline__ xs4_t f32_to_xs4(f32x4 v) { xs4_t r; r.x = pkbf(v.x, v.y); r.y = pkbf(v.z, v.w); return r; }
#if Y_FP8
typedef unsigned yraw4_t;
__device__ __forceinline__ f32x4 y4_to_f32(yraw4_t v) { const auto lo = __builtin_amdgcn_cvt_pk_f32_fp8((int)v, false), hi = __builtin_amdgcn_cvt_pk_f32_fp8((int)v, true); return (f32x4){lo[0], lo[1], hi[0], hi[1]}; }
#define Y_ROWPTR(Yb, slot) ((const yraw4_t*)((const unsigned char*)(Yb) + (size_t)(slot) * D) + C.lane)
#else
typedef u32x2v yraw4_t;
__device__ __forceinline__ f32x4 y4_to_f32(yraw4_t v) { return bf4_to_f32(v); }
#define Y_ROWPTR(Yb, slot) ((const yraw4_t*)((Yb) + (size_t)(slot) * D) + C.lane)
#endif

__device__ __forceinline__ void r1_router(const Ctx& C, const Args& a, int l) {
    LAS float* scrf = (LAS float*)(C.lds + SCR_OFF + C.wave * 2048);
    LAS int* scri = (LAS int*)scrf;
    LAS int* blk = (LAS int*)(C.lds + BLK_OFF);
    const float* rw = a.in[IN_RW] + (size_t)l * D * 32;
    LAS unsigned short* wh = (LAS unsigned short*)(C.lds + RING_OFF); LAS unsigned short* wlo = (LAS unsigned short*)(C.lds + RING_OFF + 65536);
    int tab_b = -1;
    const bf16* XS = (const bf16*)(C.ws + WS_XS); unsigned char* H8 = (unsigned char*)(C.ws + WS_H8);
    const float* ADA = (const float*)(C.ws + SM_ADA) + (size_t)l * 8 * 6144;
    const float* GM = (const float*)(C.ws + SM_GM) + (size_t)(l * 2 + 1) * 8 * 1024;
    const float* CSH = (const float*)(C.ws + SM_CSH) + l * 256;
    int* TOPI = (int*)(C.ws + SM_TOPI); float* TOPG = (float*)(C.ws + SM_TOPG); int* RANK = (int*)(C.ws + SM_RANK); int* BLKCNT = (int*)(C.ws + SM_BLKCNT);
    const int tk = C.lane & 15, q = C.lane >> 4;
    for (int vb = C.vcu; vb < NVB; vb += C.G) {
        const int tok0 = vb * 128 + C.wave * 16, b = tok0 >> 12, tok = tok0 + tk;
        if (b != tab_b) {
            __syncthreads();
            const float* gmb = GM + b * 1024;
            for (int i = C.tid; i < D * 32; i += 512) { const int dd = i >> 5, e = i & 31; const float w = rw[i] * gmb[dd];
                const unsigned hb = pkbf(w, 0.f) & 0xffffu; const float hf = bf2f(hb); const unsigned lb = pkbf(w - hf, 0.f) & 0xffffu;
                const int pos = ((((dd >> 5) * 4 + ((dd >> 3) & 3)) * 32 + e) << 3) + (dd & 7);
                wh[pos] = (unsigned short)hb; wlo[pos] = (unsigned short)lb; }
            __syncthreads();
            tab_b = b;
        }
        const bf16* xrow = XS + (size_t)tok * D + 8 * q;
        f32x4 acc0 = {0.f, 0.f, 0.f, 0.f}, acc1 = {0.f, 0.f, 0.f, 0.f}; float ssq = 0.f;
        typedef short bf16x8r __attribute__((ext_vector_type(8)));
#pragma unroll 4
        for (int kk = 0; kk < 32; ++kk) {
            const u32x4v xr8 = *(const u32x4v*)(xrow + 32 * kk);
#pragma unroll
            for (int e2 = 0; e2 < 4; ++e2) { const float x0 = bf2f(xr8[e2] & 0xffffu), x1 = bf2f(xr8[e2] >> 16); ssq += x0 * x0 + x1 * x1; }
            const bf16x8r xb = __builtin_bit_cast(bf16x8r, xr8);
            const int fo = ((kk * 4 + q) * 32 + tk) << 3;
            const bf16x8r h0 = *(const LAS bf16x8r*)(wh + fo), h1 = *(const LAS bf16x8r*)(wh + fo + 128), l0 = *(const LAS bf16x8r*)(wlo + fo), l1 = *(const LAS bf16x8r*)(wlo + fo + 128);
            acc0 = __builtin_amdgcn_mfma_f32_16x16x32_bf16(h0, xb, acc0, 0, 0, 0); acc1 = __builtin_amdgcn_mfma_f32_16x16x32_bf16(h1, xb, acc1, 0, 0, 0);
            acc0 = __builtin_amdgcn_mfma_f32_16x16x32_bf16(l0, xb, acc0, 0, 0, 0); acc1 = __builtin_amdgcn_mfma_f32_16x16x32_bf16(l1, xb, acc1, 0, 0, 0);
        }
        ssq += __shfl_xor(ssq, 16); ssq += __shfl_xor(ssq, 32);
        const float rstd = 1.f / sqrtf(ssq * (1.f / D) + RMS_EPS);
        { const f32x4 c0 = *(const f32x4*)(CSH + b * 32 + 4 * q), c1 = *(const f32x4*)(CSH + b * 32 + 16 + 4 * q);
          *(LAS f32x4*)(scrf + tk * 32 + 4 * q) = acc0 * rstd + c0; *(LAS f32x4*)(scrf + tk * 32 + 16 + 4 * q) = acc1 * rstd + c1; }
        LDS_WAIT();
        int myidx[4] = {0, 0, 0, 0};
        if (C.lane < 16) {
            float v[32];
#pragma unroll
            for (int j = 0; j < 8; ++j) { const f32x4 t4 = *(const LAS f32x4*)(scrf + C.lane * 32 + 4 * j); v[4 * j] = t4.x; v[4 * j + 1] = t4.y; v[4 * j + 2] = t4.z; v[4 * j + 3] = t4.w; }
            float val[4];
#pragma unroll
            for (int k = 0; k < 4; ++k) { float best = v[0]; int bi = 0;
#pragma unroll
                for (int e = 1; e < 32; ++e) { if (v[e] > best) { best = v[e]; bi = e; } }
                val[k] = best; myidx[k] = bi;
#pragma unroll
                for (int e = 0; e < 32; ++e) v[e] = (e == bi) ? -INFINITY : v[e]; }
            const float e1 = __expf(val[1] - val[0]), e2 = __expf(val[2] - val[0]), e3 = __expf(val[3] - val[0]), inv = 1.f / (1.f + e1 + e2 + e3);
            *(i32x4v*)(TOPI + (size_t)(tok0 + C.lane) * 4) = (i32x4v){myidx[0], myidx[1], myidx[2], myidx[3]};
            *(f32x4*)(TOPG + (size_t)(tok0 + C.lane) * 4) = (f32x4){inv, e1 * inv, e2 * inv, e3 * inv};
        }
        LDS_WAIT();
        if (C.lane < 16) *(LAS i32x4v*)(scri + C.lane * 4) = (i32x4v){myidx[0], myidx[1], myidx[2], myidx[3]};
        LDS_WAIT();
        const int e = scri[C.lane];
        const unsigned long long lt = (1ull << C.lane) - 1ull;
        int rank = 0, mycnt = 0;
#pragma unroll 4
        for (int j = 0; j < 32; ++j) { const unsigned long long mk = __ballot(e == j); if (e == j) rank = __popcll(mk & lt); if (C.lane == j) mycnt = __popcll(mk); }
        if (C.lane < 32) blk[BL_WCNT + C.wave * 32 + C.lane] = mycnt;
        __syncthreads();
        if (C.lane < 32) { int wb = 0;
            for (int w8 = 0; w8 < C.wave; ++w8) wb += blk[BL_WCNT + w8 * 32 + C.lane];
            blk[BL_WBASE + C.wave * 32 + C.lane] = wb;
            if (C.wave == NWAVES - 1) BLKCNT[vb * 32 + C.lane] = wb + mycnt; }
        LDS_WAIT();
        RANK[(size_t)tok0 * 4 + C.lane] = blk[BL_WBASE + C.wave * 32 + e] + rank;
        const f32x4* shf = (const f32x4*)(ADA + (size_t)b * 6144 + 3 * 1024) + C.lane; const f32x4* gm4 = (const f32x4*)(GM + b * 1024) + C.lane;
#pragma unroll 2
        for (int tt = 0; tt < 16; ++tt) { const float rs = __shfl(rstd, tt); const int tkn = tok0 + tt;
            const xs4_t* xr = (const xs4_t*)(XS + (size_t)tkn * D) + C.lane; unsigned* o4 = (unsigned*)(H8 + (size_t)tkn * D) + C.lane;
#pragma unroll
            for (int j = 0; j < 4; ++j) { const f32x4 h = xs4_to_f32(xr[64 * j]) * rs * gm4[64 * j] + shf[64 * j];
                o4[64 * j] = pg8::pk4_fp8(h.x, h.y, h.z, h.w); } }
        __syncthreads();
    }
}

__device__ __forceinline__ void p7_route(const Ctx& C) {
    LAS int* blk = (LAS int*)(C.lds + BLK_OFF);
    const int* BLKCNT = (const int*)(C.ws + SM_BLKCNT); const int* TOPI = (const int*)(C.ws + SM_TOPI); const int* RANK = (const int*)(C.ws + SM_RANK);
    int* SLOT = (int*)(C.ws + SM_SLOT); int* TILEEXP = (int*)(C.ws + SM_TILEEXP); int* TOKSLOT = (int*)(C.ws + SM_TOKSLOT);
    const unsigned char* H8 = (const unsigned char*)(C.ws + WS_H8); unsigned char* XB = (unsigned char*)(C.ws + WS_XB);
    const int e = C.tid & 31, part = C.tid >> 5;
    { int s = 0; for (int k = 0; k < 16; ++k) s += BLKCNT[(part * 16 + k) * 32 + e]; blk[BL_PARTA + part * 32 + e] = s; }
    __syncthreads();
    if (C.tid < 32) { int tot = 0; for (int p = 0; p < 16; ++p) tot += blk[BL_PARTA + p * 32 + C.tid]; blk[BL_TOT + C.tid] = tot; }
    __syncthreads();
    if (C.tid == 0) { int run = 0; for (int k = 0; k < 32; ++k) { blk[BL_PADS + k] = run; run += (blk[BL_TOT + k] + 255) & ~255; } blk[BL_PADS + 32] = run; }
    __syncthreads();
    if (C.vcu == 0) {
        const int nt = blk[BL_PADS + 32] >> 8;
        if (C.tid == 0) TILEEXP[0] = nt;
        for (int i = C.tid; i < nt; i += 512) { int ex = 0; for (int k = 1; k < 32; ++k) ex += (blk[BL_PADS + k] <= i * 256) ? 1 : 0; TILEEXP[16 + i] = ex; }
        if (C.tid < 33) TILEEXP[640 + C.tid] = blk[BL_PADS + C.tid] >> 8;
    }
    for (int vb = C.vcu; vb < NVB; vb += C.G) {
        __syncthreads();
        { int s = 0; for (int k = 0; k < 16; ++k) { const int bb = part * 16 + k; s += (bb < vb) ? BLKCNT[bb * 32 + e] : 0; } blk[BL_PARTB + part * 32 + e] = s; }
        __syncthreads();
        if (C.tid < 32) { int bs = 0; for (int p = 0; p < 16; ++p) bs += blk[BL_PARTB + p * 32 + C.tid]; blk[BL_BASE + C.tid] = bs + blk[BL_PADS + C.tid]; }
        __syncthreads();
        { const int i = vb * 512 + C.tid; const int ex = TOPI[i]; SLOT[i] = blk[BL_BASE + ex] + RANK[i]; }
        VM_WAIT(); __syncthreads();
#if MOE_GATHER
        { const int i = vb * 512 + C.tid; TOKSLOT[SLOT[i]] = i >> 2; }
#else
        for (int tt = 0; tt < 16; ++tt) { const int tok = vb * 128 + C.wave * 16 + tt;
            const i32x4v sl = *(const i32x4v*)(SLOT + (size_t)tok * 4);
            const u32x4v v0 = *((const u32x4v*)(H8 + (size_t)tok * D) + C.lane);
#pragma unroll
            for (int k = 0; k < 4; ++k) { u32x4v* dst = (u32x4v*)(XB + (size_t)sl[k] * D); dst[C.lane] = v0; } }
#endif
    }
#if MOE_GATHER
    for (int ex = C.vcu; ex < 32; ex += C.G) { const int beg = blk[BL_PADS + ex] + blk[BL_TOT + ex], end = blk[BL_PADS + ex + 1];
        for (int s = beg + C.tid; s < end; s += 512) TOKSLOT[s] = 0; }
#endif
}
__device__ __forceinline__ int load_tile_table(const Ctx& C) {
    LAS int* blk = (LAS int*)(C.lds + BLK_OFF); const int* TILEEXP = (const int*)(C.ws + SM_TILEEXP);
    const int nt = TILEEXP[0];
    __syncthreads();
    for (int i = C.tid; i < MAXTILES; i += 512) blk[BL_TILE + i] = (i < nt) ? TILEEXP[16 + i] : 0;
    __syncthreads();
    return __builtin_amdgcn_readfirstlane(nt);
}


__device__ __forceinline__ void r2_seam(const Ctx& C, const Args& a) {
    LAS float* wl = (LAS float*)(C.lds + RING_OFF);
    { const float* wf = a.in[IN_WKVF]; const float* gkv0 = a.in[IN_KVNG];
      for (int i = C.tid; i < D * 16; i += 512) { const int d = i >> 4, h = i & 15, jj = d >> 8, ln = (d >> 2) & 63, c = d & 3;
          wl[((((jj * 4 + c) * 4 + (h >> 2)) * 64 + ln) << 2) + (h & 3)] = wf[(size_t)d * 2064 + 2048 + h] * gkv0[d]; } }
    __syncthreads();
    bf16* XS = (bf16*)(C.ws + WS_XS); bf16* HKV = (bf16*)(C.ws + WS_HKV); const bf16* Y = (const bf16*)(C.ws + WS_Y);
    const float* ADA0 = (const float*)(C.ws + SM_ADA); const float* ADA1 = ADA0 + (size_t)8 * 6144;
    const float* GM1 = (const float*)(C.ws + SM_GM) + (size_t)(1 * 2 + 0) * 8 * 1024;
    const int* SLOT = (const int*)(C.ws + SM_SLOT); const float* TOPG = (const float*)(C.ws + SM_TOPG); float* LOGF = (float*)(C.ws + SM_LOGF);
    const f32x4* gk4 = (const f32x4*)a.in[IN_KVNG] + C.lane;
    const int gw = C.vcu * NWAVES + C.wave, NGW = C.G * NWAVES;
    const float bfh = a.in[IN_BF][(C.lane >> 2) & 15];
    typedef yraw4_t yraw_t;
#define R2_LOADRAW(XR, Y0, Y1, Y2, Y3, MM, SS) do { const xs4_t* xr_ = (const xs4_t*)(XS + (size_t)(MM) * D) + C.lane; \
        const yraw4_t* z0_ = Y_ROWPTR(Y, (SS)[0]); const yraw4_t* z1_ = Y_ROWPTR(Y, (SS)[1]); \
        const yraw4_t* z2_ = Y_ROWPTR(Y, (SS)[2]); const yraw4_t* z3_ = Y_ROWPTR(Y, (SS)[3]); \
        _Pragma("unroll") for (int j = 0; j < 4; ++j) { if (NT_ROWS) { XR[j] = __builtin_nontemporal_load(xr_ + 64 * j); Y0[j] = __builtin_nontemporal_load(z0_ + 64 * j); Y1[j] = __builtin_nontemporal_load(z1_ + 64 * j); Y2[j] = __builtin_nontemporal_load(z2_ + 64 * j); Y3[j] = __builtin_nontemporal_load(z3_ + 64 * j); } else { XR[j] = xr_[64 * j]; Y0[j] = z0_[64 * j]; Y1[j] = z1_[64 * j]; Y2[j] = z2_[64 * j]; Y3[j] = z3_[64 * j]; } } } while (0)
    xs4_t xc[4], xn[4]; yraw_t y0c[4], y1c[4], y2c[4], y3c[4], y0n[4], y1n[4], y2n[4], y3n[4];
    i32x4v s_cur = *(const i32x4v*)(SLOT + (size_t)gw * 4); f32x4 g_cur = *(const f32x4*)(TOPG + (size_t)gw * 4);
    i32x4v s_nxt = s_cur; f32x4 g_nxt = g_cur;
    if (gw + NGW < T) { s_nxt = *(const i32x4v*)(SLOT + (size_t)(gw + NGW) * 4); g_nxt = *(const f32x4*)(TOPG + (size_t)(gw + NGW) * 4); }
    R2_LOADRAW(xc, y0c, y1c, y2c, y3c, gw, s_cur);
    for (int m = gw; m < T; m += NGW) { const int b = m >> 12;
        const int mn = m + NGW, mnn = m + 2 * NGW;
        i32x4v s_nn = s_nxt; f32x4 g_nn = g_nxt;
        if (mnn < T) { s_nn = *(const i32x4v*)(SLOT + (size_t)mnn * 4); g_nn = *(const f32x4*)(TOPG + (size_t)mnn * 4); }
        if (mn < T) R2_LOADRAW(xn, y0n, y1n, y2n, y3n, mn, s_nxt);
        const f32x4* gf4 = (const f32x4*)(ADA0 + (size_t)b * 6144 + 5 * 1024) + C.lane;
        const f32x4* gm4 = (const f32x4*)(GM1 + b * 1024) + C.lane; const f32x4* shm4 = (const f32x4*)(ADA1 + (size_t)b * 6144) + C.lane;
        xs4_t* xw = (xs4_t*)(XS + (size_t)m * D) + C.lane;
        f32x4 v[4]; float s = 0.f;
#pragma unroll
        for (int j = 0; j < 4; ++j) {
            const f32x4 ys = y4_to_f32(y0c[j]) * g_cur[0] + y4_to_f32(y1c[j]) * g_cur[1] + y4_to_f32(y2c[j]) * g_cur[2] + y4_to_f32(y3c[j]) * g_cur[3];
            v[j] = xs4_to_f32(xc[j]) + gf4[64 * j] * ys; xw[64 * j] = f32_to_xs4(v[j]); v[j] = xs4_to_f32(f32_to_xs4(v[j]));
            s += (v[j].x * v[j].x + v[j].y * v[j].y) + (v[j].z * v[j].z + v[j].w * v[j].w); }
        const float rstd = 1.f / sqrtf(wave_sum(s) * (1.f / D) + RMS_EPS);
        float acc[16];
#pragma unroll
        for (int h = 0; h < 16; ++h) acc[h] = 0.f;
#pragma unroll
        for (int j = 0; j < 4; ++j)
#pragma unroll
            for (int c = 0; c < 4; ++c) { const float xv = v[j][c];
#pragma unroll
                for (int h4 = 0; h4 < 4; ++h4) { const f32x4 w = *(const LAS f32x4*)(wl + ((((j * 4 + c) * 4 + h4) * 64 + C.lane) << 2));
                    acc[4 * h4] += xv * w[0]; acc[4 * h4 + 1] += xv * w[1]; acc[4 * h4 + 2] += xv * w[2]; acc[4 * h4 + 3] += xv * w[3]; }
                if (c == 3) __builtin_amdgcn_sched_barrier(0); }
#pragma unroll
        for (int j = 0; j < 4; ++j) { const f32x4 n = v[j] * rstd, h = n * gm4[64 * j] + shm4[64 * j], hk = n * gk4[64 * j];
            if (KVQ_FP8) { ((unsigned*)(C.ws + WS_HKV + (size_t)T * D + (size_t)m * D) + C.lane)[64 * j] = pg8::pk4_fp8(h.x, h.y, h.z, h.w);
                           ((unsigned*)(C.ws + WS_HKV + (size_t)m * D) + C.lane)[64 * j] = pg8::pk4_fp8(hk.x, hk.y, hk.z, hk.w); }
            else { ((unsigned long long*)(HKV + (size_t)T * D + (size_t)m * D) + C.lane)[64 * j] = (unsigned long long)pkbf(h.x, h.y) | ((unsigned long long)pkbf(h.z, h.w) << 32);
                   ((unsigned long long*)(HKV + (size_t)m * D) + C.lane)[64 * j] = (unsigned long long)pkbf(hk.x, hk.y) | ((unsigned long long)pkbf(hk.z, hk.w) << 32); } }
        __builtin_amdgcn_sched_barrier(0);
        float r8[8], r4[4], r2v[2], r1;
        { const bool up = (C.lane & 32) != 0;
#pragma unroll
          for (int i = 0; i < 8; ++i) { const float snd = up ? acc[i] : acc[i + 8], kp = up ? acc[i + 8] : acc[i]; r8[i] = kp + __shfl_xor(snd, 32); } }
        { const bool up = (C.lane & 16) != 0;
#pragma unroll
          for (int i = 0; i < 4; ++i) { const float snd = up ? r8[i] : r8[i + 4], kp = up ? r8[i + 4] : r8[i]; r4[i] = kp + __shfl_xor(snd, 16); } }
        { const bool up = (C.lane & 8) != 0;
#pragma unroll
          for (int i = 0; i < 2; ++i) { const float snd = up ? r4[i] : r4[i + 2], kp = up ? r4[i + 2] : r4[i]; r2v[i] = kp + __shfl_xor(snd, 8); } }
        { const bool up = (C.lane & 4) != 0; const float snd = up ? r2v[0] : r2v[1], kp = up ? r2v[1] : r2v[0]; r1 = kp + __shfl_xor(snd, 4); }
        r1 += __shfl_xor(r1, 2); r1 += __shfl_xor(r1, 1);
        if ((C.lane & 3) == 0) { const float z = r1 * rstd + bfh; LOGF[(size_t)m * 16 + ((C.lane >> 2) & 15)] = (fminf(z, 0.f) - log1pf(__expf(-fabsf(z)))) * LOG2E; }
#pragma unroll
        for (int j = 0; j < 4; ++j) { xc[j] = xn[j]; y0c[j] = y0n[j]; y1c[j] = y1n[j]; y2c[j] = y2n[j]; y3c[j] = y3n[j]; }
        s_cur = s_nxt; g_cur = g_nxt; s_nxt = s_nn; g_nxt = g_nn;
    }
#undef R2_LOADRAW
}
__device__ __forceinline__ void fcum_scan(const Ctx& C) {
    const float* LOGF = (const float*)(C.ws + SM_LOGF); float* FC = (float*)(C.ws + SM_FCUM);
    LAS float* wtot = (LAS float*)(C.lds + BLK_OFF);
    for (int sq = C.vcu; sq < 128; sq += C.G) { const int b = sq >> 4, h = sq & 15;
        const float* src = LOGF + ((size_t)b * 4096 + C.tid * 8) * 16 + h; float* dst = FC + (size_t)sq * 4096 + C.tid * 8;
        float v[8]; float tot = 0.f;
#pragma unroll
        for (int i = 0; i < 8; ++i) { v[i] = src[i * 16]; }
#pragma unroll
        for (int i = 0; i < 8; ++i) { tot += v[i]; v[i] = tot; }
        float inc = tot;
#pragma unroll
        for (int o = 1; o < 64; o <<= 1) { const float t = __shfl_up(inc, o); if (C.lane >= o) inc += t; }
        __syncthreads();
        if (C.lane == 63) wtot[C.wave] = inc;
        __syncthreads();
        float carry = inc - tot;
        for (int w8 = 0; w8 < C.wave; ++w8) carry += wtot[w8];
#pragma unroll
        for (int i = 0; i < 8; ++i) dst[i] = v[i] + carry;
    }
}
__device__ __forceinline__ void r3_final(const Ctx& C, const Args& a, float* XD) {
    const bf16* XS = (const bf16*)(C.ws + WS_XS); const bf16* Y = (const bf16*)(C.ws + WS_Y);
    const float* ADA1 = (const float*)(C.ws + SM_ADA) + (size_t)8 * 6144;
    const int* SLOT = (const int*)(C.ws + SM_SLOT); const float* TOPG = (const float*)(C.ws + SM_TOPG);
    const f32x4* fg4 = (const f32x4*)a.in[IN_FNG] + C.lane;
    const int gw = C.vcu * NWAVES + C.wave, NGW = C.G * NWAVES;
#define R3_LOADRAW(XR, Y0, Y1, Y2, Y3, MM, SS) do { const xs4_t* xr_ = (const xs4_t*)(XS + (size_t)(MM) * D) + C.lane; \
        const yraw4_t* z0_ = Y_ROWPTR(Y, (SS)[0]); const yraw4_t* z1_ = Y_ROWPTR(Y, (SS)[1]); \
        const yraw4_t* z2_ = Y_ROWPTR(Y, (SS)[2]); const yraw4_t* z3_ = Y_ROWPTR(Y, (SS)[3]); \
        _Pragma("unroll") for (int j = 0; j < 4; ++j) { if (NT_ROWS) { XR[j] = __builtin_nontemporal_load(xr_ + 64 * j); Y0[j] = __builtin_nontemporal_load(z0_ + 64 * j); Y1[j] = __builtin_nontemporal_load(z1_ + 64 * j); Y2[j] = __builtin_nontemporal_load(z2_ + 64 * j); Y3[j] = __builtin_nontemporal_load(z3_ + 64 * j); } else { XR[j] = xr_[64 * j]; Y0[j] = z0_[64 * j]; Y1[j] = z1_[64 * j]; Y2[j] = z2_[64 * j]; Y3[j] = z3_[64 * j]; } } } while (0)
    xs4_t xc[4], xn[4]; yraw4_t y0c[4], y1c[4], y2c[4], y3c[4], y0n[4], y1n[4], y2n[4], y3n[4];
    i32x4v s_cur = *(const i32x4v*)(SLOT + (size_t)gw * 4); f32x4 g_cur = *(const f32x4*)(TOPG + (size_t)gw * 4);
    i32x4v s_nxt = s_cur; f32x4 g_nxt = g_cur;
    if (gw + NGW < T) { s_nxt = *(const i32x4v*)(SLOT + (size_t)(gw + NGW) * 4); g_nxt = *(const f32x4*)(TOPG + (size_t)(gw + NGW) * 4); }
    R3_LOADRAW(xc, y0c, y1c, y2c, y3c, gw, s_cur);
    for (int m = gw; m < T; m += NGW) { const int b = m >> 12;
        const int mn = m + NGW, mnn = m + 2 * NGW;
        i32x4v s_nn = s_nxt; f32x4 g_nn = g_nxt;
        if (mnn < T) { s_nn = *(const i32x4v*)(SLOT + (size_t)mnn * 4); g_nn = *(const f32x4*)(TOPG + (size_t)mnn * 4); }
        if (mn < T) R3_LOADRAW(xn, y0n, y1n, y2n, y3n, mn, s_nxt);
        const f32x4* gf4 = (const f32x4*)(ADA1 + (size_t)b * 6144 + 5 * 1024) + C.lane;
        f32x4* xw = (f32x4*)(XD + (size_t)m * D) + C.lane;
        f32x4 v[4]; float s = 0.f;
#pragma unroll
        for (int j = 0; j < 4; ++j) {
            const f32x4 ys = y4_to_f32(y0c[j]) * g_cur[0] + y4_to_f32(y1c[j]) * g_cur[1] + y4_to_f32(y2c[j]) * g_cur[2] + y4_to_f32(y3c[j]) * g_cur[3];
            v[j] = xs4_to_f32(xc[j]) + gf4[64 * j] * ys; s += (v[j].x * v[j].x + v[j].y * v[j].y) + (v[j].z * v[j].z + v[j].w * v[j].w); }
        const float rstd = 1.f / sqrtf(wave_sum(s) * (1.f / D) + RMS_EPS);
#pragma unroll
        for (int j = 0; j < 4; ++j) xw[64 * j] = v[j] * rstd * fg4[64 * j];
#pragma unroll
        for (int j = 0; j < 4; ++j) { xc[j] = xn[j]; y0c[j] = y0n[j]; y1c[j] = y1n[j]; y2c[j] = y2n[j]; y3c[j] = y3n[j]; }
        s_cur = s_nxt; g_cur = g_nxt; s_nxt = s_nn; g_nxt = g_nn;
    }
#undef R3_LOADRAW
}

constexpr int N_PHASES = 19;
__global__ void __launch_bounds__(NWAVES * 64, 2) yoco_fwd(Args args) {
    extern __shared__ __attribute__((aligned(16))) unsigned char lds[];
    Ctx C;
    C.lds = (LAS unsigned char*)lds; C.ws = args.ws;
    C.tid = threadIdx.x; C.lane = C.tid & 63; C.wave = __builtin_amdgcn_readfirstlane(C.tid >> 6);
    C.G = gridDim.x; { const int bx = blockIdx.x; C.vcu = (C.G % 8 == 0) ? (bx % 8) * (C.G / 8) + bx / 8 : bx; }
    volatile LAS unsigned* MISC = (volatile LAS unsigned*)(C.lds + MISC_OFF);
    if (C.tid < 64) MISC[C.tid] = 0u;
    __syncthreads();
    const int lo = args.ph_lo, hi = args.ph_hi;
    const bool one = (hi - lo) > 1;
    unsigned* ctl = (unsigned*)(args.ws + WS_CTL);
    XcdBarrier bar; bar.bar = ctl + CW_BAR; bar.x = 0; bar.st = nullptr;
    if (one) bar = xcd_barrier_post(ctl + CW_BAR, MISC + 8);
#define IN(k) (lo <= (k) && (k) < hi)
#define SEAM(k) do { if (IN(k) && IN((k) + 1)) xcd_barrier(bar); } while (0)
#define FRESH() do { int l_; asm volatile("v_mbcnt_lo_u32_b32 %0, -1, 0\n\tv_mbcnt_hi_u32_b32 %0, -1, %0" : "=v"(l_)); C.lane = l_; C.tid = C.wave * 64 + l_; } while (0)
#define REP(k) _Pragma("unroll") for (int rep_ = 0; rep_ < 1 + ((PROBE_DUP >> (k)) & 1); ++rep_)
    bf16* const Hb = (bf16*)(C.ws + WS_H);
    if (IN(0)) { FRESH(); REP(0) { p0_prologue(C, args); } SEAM(0); }
    if (IN(1)) { FRESH(); REP(1) { p1_rows0(C, args); } SEAM(1); }
    if (IN(2)) { FRESH();
#if PROBE_QKV
        { pg8::Gemm g{(const pg8::bf16_t*)(C.ws + WS_H8), (const pg8::bf16_t*)(C.ws + WS_WQKV), T, NQKV, D}; pg8::StaticOrder S; S.init(T, NQKV, C.G, (int)blockIdx.x);
#if PROBE_QKV == 1
          pg8::EpiQKV0 E{(pg8::bf16_t*)(C.ws + WS_QKV0), 0.015625f};
          pg8::gemm_phase<pg8::EpiQKV0, pg8::StaticOrder, true, true, 1>(C.lds + RING_OFF, g, S, E);
#elif PROBE_QKV == 2
          pg8::EpiQKV0Probe E{(pg8::bf16_t*)(C.ws + WS_XB), 0.015625f, 4};
          pg8::gemm_phase<pg8::EpiQKV0Probe, pg8::StaticOrder, true, true, 1>(C.lds + RING_OFF, g, S, E);
#else
          pg8::EpiNone E{(unsigned char*)(C.ws + WS_XB)};
          pg8::gemm_phase<pg8::EpiNone, pg8::StaticOrder, true, true, 1>(C.lds + RING_OFF, g, S, E);
#endif
        }
#endif
#if STAGGER_QKV
        { const unsigned long long t0 = __builtin_amdgcn_s_memrealtime(); const unsigned long long dl = (unsigned long long)(C.vcu & 7) * STAGGER_QKV;
          while (__builtin_amdgcn_s_memrealtime() - t0 < dl) __builtin_amdgcn_s_sleep(8); }
#endif
        REP(2) {
        pg8::Gemm g{QKV_FP8 ? (const pg8::bf16_t*)(C.ws + WS_H8) : (const pg8::bf16_t*)Hb, (const pg8::bf16_t*)(C.ws + WS_WQKV), T, NQKV, D}; pg8::StaticOrder S; S.init(T, NQKV, C.G, (int)blockIdx.x);
        pg8::EpiQKV0 E{(pg8::bf16_t*)(C.ws + WS_QKV0), QKV_FP8 ? 0.015625f : 1.f};
        pg8::gemm_phase<pg8::EpiQKV0, pg8::StaticOrder, true, true, QKV_FP8 ? 1 : 2>(C.lds + RING_OFF, g, S, E);
        } SEAM(2);
    }
    if (IN(3)) { FRESH(); REP(3) { p3_dilated(C); } SEAM(3); }
    if (IN(4)) { FRESH(); REP(4) { p4_merge(C); } SEAM(4); }
    if (IN(5)) { FRESH(); REP(5) {
        pg8::Gemm g{(const pg8::bf16_t*)(C.ws + WS_O), (const pg8::bf16_t*)(C.ws + WS_WO0), T, D, D}; pg8::StaticOrder S; S.init(T, D, C.G, (int)blockIdx.x);
        pg8::EpiResid<false> E{args.in[IN_X], (pg8::bf16_t*)(C.ws + WS_XS), (const float*)(C.ws + SM_ADA) + 2 * 1024, WO_FP8 ? 0.015625f : 1.f};
        pg8::gemm_phase<pg8::EpiResid<false>, pg8::StaticOrder, true, true, WO_FP8 ? 1 : 2>(C.lds + RING_OFF, g, S, E);
        } SEAM(5);
    }
    if (IN(6)) { FRESH(); REP(6) { r1_router(C, args, 0); } SEAM(6); }
    if (IN(7)) { FRESH(); REP(7) { p7_route(C); } SEAM(7); }
    if (IN(8)) { FRESH();
#if PROBE_GU
        { const int nt = load_tile_table(C);
          pg8::Gemm g{(const pg8::bf16_t*)(C.ws + WS_H8), (const pg8::bf16_t*)(C.ws + WS_WGU), MAXROWS, 32 * 2048, D, (const int*)(C.ws + SM_TOKSLOT)};
          pg8::MoeOrder<8> S{(const LAS int*)(C.lds + BLK_OFF) + BL_TILE, nt, (int)blockIdx.x, C.G};
#if PROBE_GU == 1
          pg8::EpiSwiGLU8 E{(unsigned char*)(C.ws + WS_XB), args.in[IN_BGU]};
          pg8::gemm_phase<pg8::EpiSwiGLU8, pg8::MoeOrder<8>, true, true, 1, true>(C.lds + RING_OFF, g, S, E);
#elif PROBE_GU == 6
          { pg8::MoeOrderProbe S2{(const LAS int*)(C.lds + BLK_OFF) + BL_TILE, nt, (int)blockIdx.x, C.G};
            pg8::EpiProbeGU<2> E{(unsigned char*)(C.ws + WS_XB), args.in[IN_BGU]};
            pg8::gemm_phase<pg8::EpiProbeGU<2>, pg8::MoeOrderProbe, true, true, 1, true>(C.lds + RING_OFF, g, S2, E); }
#else
          pg8::EpiProbeGU<PROBE_GU - 2> E{(unsigned char*)(C.ws + WS_XB), args.in[IN_BGU]};
          pg8::gemm_phase<pg8::EpiProbeGU<PROBE_GU - 2>, pg8::MoeOrder<8>, true, true, 1, true>(C.lds + RING_OFF, g, S, E);
#endif
        }
#endif
        REP(8) {
        const int nt = load_tile_table(C);
        pg8::Gemm g{(const pg8::bf16_t*)(C.ws + (MOE_GATHER ? WS_H8 : WS_XB)), (const pg8::bf16_t*)(C.ws + WS_WGU), MAXROWS, 32 * 2048, D, (const int*)(C.ws + SM_TOKSLOT)};
        pg8::MoeOrder<8> S{(const LAS int*)(C.lds + BLK_OFF) + BL_TILE, nt, (int)blockIdx.x, C.G};
        pg8::EpiSwiGLU8 E{(unsigned char*)(C.ws + WS_ACT), args.in[IN_BGU]};
        pg8::gemm_phase<pg8::EpiSwiGLU8, pg8::MoeOrder<8>, true, true, 1, MOE_GATHER != 0>(C.lds + RING_OFF, g, S, E);
        } SEAM(8);
    }
    if (IN(9)) { FRESH(); REP(9) {
        const int nt = load_tile_table(C);
        pg8::Gemm g{(const pg8::bf16_t*)(C.ws + WS_ACT), (const pg8::bf16_t*)(C.ws + WS_WDN), MAXROWS, 32 * 1024, D};
        pg8::MoeOrder<4> S{(const LAS int*)(C.lds + BLK_OFF) + BL_TILE, nt, (int)blockIdx.x, C.G};
        pg8::EpiDown8 E{(pg8::bf16_t*)(C.ws + WS_Y), args.in[IN_BDN]};
        pg8::gemm_phase<pg8::EpiDown8, pg8::MoeOrder<4>, true, true, 1>(C.lds + RING_OFF, g, S, E);
        } SEAM(9);
    }
    if (IN(10)) { FRESH(); r2_seam(C, args); SEAM(10); }
    if (IN(11)) { FRESH(); REP(11) {
        fcum_scan(C);
        pg8::Gemm g{(const pg8::bf16_t*)(C.ws + WS_HKV), (const pg8::bf16_t*)(C.ws + WS_WKV), T, 3072, D}; pg8::KVQOrder S; S.init(T, 3072, C.G, (int)blockIdx.x);
        pg8::EpiKVQ E{(pg8::bf16_t*)(C.ws + WS_QKV1), KVQ_FP8 ? 0.015625f : 1.f, (unsigned*)(C.ws + WS_CTL) + CW_NRM};
        pg8::gemm_phase<pg8::EpiKVQ, pg8::KVQOrder, true, true, KVQ_FP8 ? 1 : 2>(C.lds + RING_OFF, g, S, E);
        } SEAM(11);
    }
    if (IN(12)) { FRESH(); if (PROBE_FOX == 2) p12_fox<2>(C, WS_OG); REP(12) { p12_fox<1>(C, WS_O); } SEAM(12); }
    if (IN(13)) { FRESH(); REP(13) {
        pg8::Gemm g{(const pg8::bf16_t*)(C.ws + WS_O), (const pg8::bf16_t*)(C.ws + WS_WO1), T, D, D}; pg8::StaticOrder S; S.init(T, D, C.G, (int)blockIdx.x);
        pg8::EpiResid<true> E{C.ws + WS_XS, (pg8::bf16_t*)(C.ws + WS_XS), (const float*)(C.ws + SM_ADA) + (size_t)8 * 6144 + 2 * 1024, WO_FP8 ? 0.015625f : 1.f};
        pg8::gemm_phase<pg8::EpiResid<true>, pg8::StaticOrder, true, true, WO_FP8 ? 1 : 2>(C.lds + RING_OFF, g, S, E);
        } SEAM(13);
    }
    if (IN(14)) { FRESH(); REP(14) { r1_router(C, args, 1); } SEAM(14); }
    if (IN(15)) { FRESH(); REP(15) { p7_route(C); } SEAM(15); }
    if (IN(16)) { FRESH();
#if PROBE_LATE_QKV
        { pg8::Gemm g{(const pg8::bf16_t*)(C.ws + WS_ACT), (const pg8::bf16_t*)(C.ws + WS_WQKV), T, NQKV, D}; pg8::StaticOrder S; S.init(T, NQKV, C.G, (int)blockIdx.x);
          pg8::EpiNone E{(unsigned char*)(C.ws + WS_XB)};
          pg8::gemm_phase<pg8::EpiNone, pg8::StaticOrder, true, true, 1>(C.lds + RING_OFF, g, S, E); }
#endif
        REP(16) {
        const int nt = load_tile_table(C);
        pg8::Gemm g{(const pg8::bf16_t*)(C.ws + (MOE_GATHER ? WS_H8 : WS_XB)), (const pg8::bf16_t*)(C.ws + WS_WGU + (size_t)32 * 2048 * D), MAXROWS, 32 * 2048, D, (const int*)(C.ws + SM_TOKSLOT)};
        pg8::MoeOrder<8> S{(const LAS int*)(C.lds + BLK_OFF) + BL_TILE, nt, (int)blockIdx.x, C.G};
        pg8::EpiSwiGLU8 E{(unsigned char*)(C.ws + WS_ACT), args.in[IN_BGU] + 32 * 2048};
        pg8::gemm_phase<pg8::EpiSwiGLU8, pg8::MoeOrder<8>, true, true, 1, MOE_GATHER != 0>(C.lds + RING_OFF, g, S, E);
        } SEAM(16);
    }
    if (IN(17)) { FRESH(); REP(17) {
        const int nt = load_tile_table(C);
        pg8::Gemm g{(const pg8::bf16_t*)(C.ws + WS_ACT), (const pg8::bf16_t*)(C.ws + WS_WDN + (size_t)32 * 1024 * D), MAXROWS, 32 * 1024, D};
        pg8::MoeOrder<4> S{(const LAS int*)(C.lds + BLK_OFF) + BL_TILE, nt, (int)blockIdx.x, C.G};
        pg8::EpiDown8 E{(pg8::bf16_t*)(C.ws + WS_Y), args.in[IN_BDN] + 32 * 1024};
        pg8::gemm_phase<pg8::EpiDown8, pg8::MoeOrder<4>, true, true, 1>(C.lds + RING_OFF, g, S, E);
        } SEAM(17);
    }
    if (IN(18)) { FRESH(); r3_final(C, args, args.out); }
#undef IN
#undef SEAM
}

extern "C" void kernel_launch(void* const* d_in, const int* in_sizes, int n_in, void* d_out, int out_size, void* d_ws, size_t ws_size, hipStream_t stream) {
    static int grid = 0;
    if (grid == 0) {
        if (n_in != 21 || in_sizes[0] != T * D || out_size != T * D || ws_size < WS_END) { fprintf(stderr, "kernel_launch: unexpected shapes (n_in %d, in0 %d, out %d, ws %zu)\n", n_in, n_in > 0 ? in_sizes[0] : -1, out_size, ws_size); grid = -1; return; }
        int dev = 0, cus = 0, per_cu = 0;
        if (hipGetDevice(&dev) != hipSuccess || hipDeviceGetAttribute(&cus, hipDeviceAttributeMultiprocessorCount, dev) != hipSuccess) { grid = -1; return; }
        if (hipFuncSetAttribute((const void*)yoco_fwd, hipFuncAttributeMaxDynamicSharedMemorySize, LDS_BYTES) != hipSuccess) { fprintf(stderr, "kernel_launch: hipFuncSetAttribute failed\n"); grid = -1; return; }
        if (hipOccupancyMaxActiveBlocksPerMultiprocessor(&per_cu, (const void*)yoco_fwd, NWAVES * 64, LDS_BYTES) != hipSuccess || per_cu < 1) { fprintf(stderr, "kernel_launch: occupancy query reports %d blocks per CU\n", per_cu); }
        (void)hipGetLastError();
        grid = cus;
    }
    if (grid < 0) return;
    (void)hipMemsetAsync((char*)d_ws + WS_CTL, 0, CTL_ZERO_BYTES, stream);
    Args a{};
    for (int i = 0; i < 21; ++i) a.in[i] = (const float*)d_in[i];
    a.out = (float*)d_out; a.ws = (unsigned char*)d_ws;
#if MK_ONE_LAUNCH
    a.ph_lo = 0; a.ph_hi = N_PHASES;
    hipLaunchKernelGGL(yoco_fwd, dim3(grid), dim3(NWAVES * 64), LDS_BYTES, stream, a);
#else
    for (int p = 0; p < N_PHASES; ++p) { a.ph_lo = p; a.ph_hi = p + 1; hipLaunchKernelGGL(yoco_fwd, dim3(grid), dim3(NWAVES * 64), LDS_BYTES, stream, a); }
#endif
}
```

```cpp
#include <hip/hip_runtime.h>
#include <hip/hip_bf16.h>
#include <cstdio>
#include <cstdint>
#include <cmath>
#ifndef MK_ONE_LAUNCH
#define MK_ONE_LAUNCH 1
#endif
#ifndef PROBE_DUP
#define PROBE_DUP 0
#endif
#ifndef PG8_F8_SCALED
#define PG8_F8_SCALED 0
#endif
#ifndef QKV_FP8
#define QKV_FP8 1
#endif
#ifndef KVQ_FP8
#define KVQ_FP8 1
#endif
#ifndef PROBE_EPI
#define PROBE_EPI 0
#endif
#ifndef PROBE_FOX
#define PROBE_FOX 0
#endif
#ifndef PROBE_SANITIZE
#define PROBE_SANITIZE 0
#endif
#ifndef PROBE_BAND
#define PROBE_BAND 0
#endif
#ifndef Y_FP8
#define Y_FP8 1
#endif
#ifndef WO_FP8
#define WO_FP8 1
#endif
#ifndef MOE_GATHER
#define MOE_GATHER 1
#endif
#ifndef PROBE_QKV
#define PROBE_QKV 0
#endif
#ifndef PROBE_GU
#define PROBE_GU 0
#endif
#ifndef STAGGER_QKV
#define STAGGER_QKV 0
#endif
#ifndef NT_STORE
#define NT_STORE 0
#endif
#ifndef RELAX_STORES
#define RELAX_STORES 0
#endif
#ifndef PROBE_LATE_QKV
#define PROBE_LATE_QKV 0
#endif
#ifndef NT_P0
#define NT_P0 1
#endif
#ifndef NT_ROWS
#define NT_ROWS 1
#endif
#ifndef NT_P0ST
#define NT_P0ST 0
#endif
#ifndef DEFER_L1W
#define DEFER_L1W 0
#endif
#ifndef BAND_FP8
#define BAND_FP8 1
#endif
namespace pg8 {
#define PG8_LAS __attribute__((address_space(3)))
typedef unsigned short bf16_t;
typedef short bf16x8 __attribute__((ext_vector_type(8)));
typedef float f32x4 __attribute__((ext_vector_type(4)));
typedef unsigned u32x4 __attribute__((ext_vector_type(4)));
constexpr int BM = 256, BK = 64, HALF = 128, HTB = HALF * BK * 2  , STAGE_BYTES = 8 * HTB, NXCD = 8, WGM = 8;

__host__ __device__ __forceinline__ int lds_byte(int r, int c) { const int st = (r >> 4) * 2 + (c >> 5), rr = r & 15, cc = c & 31, ob = rr * 64 + cc * 2; return st * 1024 + (ob ^ (((ob >> 9) & 1) << 5)); }
__host__ __device__ __forceinline__ void stage_rc(int b, int& R, int& C) { const int st = b / 1024, sb = b % 1024, swz = sb ^ (((sb >> 9) & 1) << 5); R = (st >> 1) * 16 + swz / 64; C = (st & 1) * 32 + (swz % 64) / 2; }
__host__ __device__ __forceinline__ int perm32(int rho) { const int n = rho >> 4, i = rho & 15; return 8 * (i >> 2) + 4 * n + (i & 3); }

struct Unit { int pm, pn; };
struct Gemm { const bf16_t* A; const bf16_t* Bt; int M, N, K; const int* rows = nullptr; };

struct StaticOrder {
    int nM, nN, nwg, G, c;
    __host__ __device__ void init(int M, int N, int G_, int c_) { nM = M / BM; nN = N / BM; nwg = nM * nN; G = G_; c = c_; }
    __host__ __device__ bool next(int i, Unit& u) const {
        const long L = (long)i * G + c; if (L >= nwg) return false;
        int wgid = (int)L; { const int q = nwg / NXCD, r = nwg % NXCD, xcd = wgid % NXCD, off = wgid / NXCD; wgid = (xcd < r ? xcd * (q + 1) : r * (q + 1) + (xcd - r) * q) + off; }
        const int nig = WGM * nN, gid = wgid / nig, fm = gid * WGM, gsz = (nM - fm) < WGM ? (nM - fm) : WGM;
        u.pm = fm + ((wgid % nig) % gsz); u.pn = (wgid % nig) / gsz; return true;
    }
    __device__ __forceinline__ void a_ready(const Unit&) const {}
    __device__ __forceinline__ void done(const Unit&) const {}
};
__device__ __forceinline__ unsigned cvt_pk_bf16(float lo, float hi) { unsigned r; asm volatile("v_cvt_pk_bf16_f32 %0, %1, %2" : "=v"(r) : "v"(lo), "v"(hi)); return r; }
typedef float f32x2 __attribute__((ext_vector_type(2)));
typedef int i32x8 __attribute__((ext_vector_type(8))); typedef int i32x4p __attribute__((ext_vector_type(4)));
#ifndef PG8_F8_SCALE
#define PG8_F8_SCALE 0x7f7f7f7f
#endif
__device__ __forceinline__ i32x8 pg8_cat(bf16x8 lo, bf16x8 hi) { const i32x4p a = __builtin_bit_cast(i32x4p, lo), b = __builtin_bit_cast(i32x4p, hi); return (i32x8){a.x, a.y, a.z, a.w, b.x, b.y, b.z, b.w}; }
#if PG8_F8_SCALED
__device__ __forceinline__ void pg8_mma8(f32x4& acc, i32x8 b, i32x8 a) { asm volatile("v_mfma_scale_f32_16x16x128_f8f6f4 %0, %1, %2, %0, %3, %3 op_sel_hi:[0,0,0]" : "+v"(acc) : "v"(b), "v"(a), "v"(0x7f7f7f7f)); }
#else
__device__ __forceinline__ void pg8_mma8(f32x4& acc, i32x8 b, i32x8 a) { asm volatile("v_mfma_f32_16x16x128_f8f6f4 %0, %1, %2, %0" : "+v"(acc) : "v"(b), "v"(a)); }
#endif
__device__ __forceinline__ void pg8_mma16(f32x4& acc, bf16x8 b, bf16x8 a) { asm volatile("v_mfma_f32_16x16x32_bf16 %0, %1, %2, %0" : "+v"(acc) : "v"(b), "v"(a)); }
template <class Epi, class Sched, bool ALIGN_EPI = false, bool SP2 = false, int ES = 2  , bool GATHER = false  >
__device__ __forceinline__ void gemm_phase(PG8_LAS unsigned char* lds, const Gemm g, const Sched& S, const Epi& E) {
    const int tid = threadIdx.x, wid = __builtin_amdgcn_readfirstlane(tid >> 6), lane = tid & 63, wr = wid >> 2, wc = wid & 3, fr = lane & 15, fq = lane >> 4;
    const int K = g.K * ES / 2  , nt = K / BK;
    unsigned voffA[2], voffB[2];
#pragma unroll
    for (int i = 0; i < 2; ++i) { int R, C; stage_rc(tid * 16 + i * 8192, R, C); const int Rb = Epi::PERM ? ((R & ~31) + perm32(R & 31)) : R;
        voffA[i] = (unsigned)(R * K + C) * 2u; voffB[i] = (unsigned)(Rb * K + C) * 2u; }
    const size_t kstep = (size_t)(BK * 2);
    const size_t hstep = (size_t)HALF * K * 2;
    const size_t tstep = 2 * hstep;
    const size_t hstepA = GATHER ? 0 : hstep;
    unsigned cG0[2] = {voffA[0], voffA[1]}, cG1[2] = {voffA[0], voffA[1]}, nG0[2] = {voffA[0], voffA[1]}, nG1[2] = {voffA[0], voffA[1]};
#define PG8_GROWS(G0, G1, PM) do { if constexpr (GATHER) { _Pragma("unroll") for (int i_ = 0; i_ < 2; ++i_) { int R_, C_; stage_rc(tid * 16 + i_ * 8192, R_, C_); \
        const int* rp_ = g.rows + (size_t)(PM) * 256 + R_; G0[i_] = (unsigned)rp_[0] * (unsigned)(K * 2) + (unsigned)(C_ * 2); G1[i_] = (unsigned)rp_[128] * (unsigned)(K * 2) + (unsigned)(C_ * 2); } } } while (0)
    const unsigned ldsw = (unsigned)wid * 1024u;
    const int aoff = lds_byte(wr * 64 + fr, fq * 8), boff = lds_byte(wc * 32 + fr, fq * 8);
#define PG8_SA(b, h) (((b) * 2 + (h)) * HTB)
#define PG8_SB(b, h) ((4 + (b) * 2 + (h)) * HTB)
#define PG8_STAGE(bufoff, gbase, voff) do { _Pragma("unroll") for (int _i = 0; _i < 2; ++_i) \
        __builtin_amdgcn_global_load_lds((const unsigned*)((const char*)(gbase) + (voff)[_i]), (PG8_LAS unsigned*)(lds + (bufoff) + ldsw + _i * 8192), 16, 0, 0); } while (0)
#define PG8_LDA(dst, b, h) do { _Pragma("unroll") for (int m = 0; m < 4; ++m) _Pragma("unroll") for (int k = 0; k < 2; ++k) dst[m][k] = *(const PG8_LAS bf16x8*)(lds + PG8_SA(b, h) + aoff + m * 2048 + k * 1024); } while (0)
#define PG8_LDB(dst, b, h) do { _Pragma("unroll") for (int n = 0; n < 2; ++n) _Pragma("unroll") for (int k = 0; k < 2; ++k) dst[n][k] = *(const PG8_LAS bf16x8*)(lds + PG8_SB(b, h) + boff + n * 2048 + k * 1024); } while (0)
#define PG8_MMA(ai, bj, At, Bt) do { __builtin_amdgcn_s_setprio(1); _Pragma("unroll") for (int m = 0; m < 4; ++m) _Pragma("unroll") for (int n = 0; n < 2; ++n) { \
        if constexpr (ES == 2) { _Pragma("unroll") for (int k = 0; k < 2; ++k) acc[ai][bj][m][n] = __builtin_amdgcn_mfma_f32_16x16x32_bf16(Bt[n][k], At[m][k], acc[ai][bj][m][n], 0, 0, 0); } \
        else { pg8_mma8(acc[ai][bj][m][n], pg8_cat(Bt[n][0], Bt[n][1]), pg8_cat(At[m][0], At[m][1])); } } \
        __builtin_amdgcn_s_setprio(0); } while (0)
#define PG8_WAIT_V(n) asm volatile("s_waitcnt vmcnt(" #n ")" ::: "memory")
#define PG8_WAIT_L(n) asm volatile("s_waitcnt lgkmcnt(" #n ")" ::: "memory")
#define PG8_WAIT_V8R do { if (relax_st) { if constexpr (Epi::NSTORE == 16) asm volatile("s_waitcnt vmcnt(24)" ::: "memory"); else if constexpr (Epi::NSTORE == 8) asm volatile("s_waitcnt vmcnt(16)" ::: "memory"); else asm volatile("s_waitcnt vmcnt(8)" ::: "memory"); } \
        else asm volatile("s_waitcnt vmcnt(8)" ::: "memory"); } while (0)
#define PG8_BAR __builtin_amdgcn_s_barrier()
#define PG8_SCHED __builtin_amdgcn_sched_barrier(0)
    Unit cur, nxt; int ui = 0;
    if (!S.next(0, cur)) return;
    f32x4 acc[2][2][4][2];
#pragma unroll
    for (int a = 0; a < 2; ++a)
#pragma unroll
        for (int b = 0; b < 2; ++b)
#pragma unroll
            for (int m = 0; m < 4; ++m)
#pragma unroll
                for (int n = 0; n < 2; ++n) acc[a][b][m][n] = (f32x4){0.f, 0.f, 0.f, 0.f};
    bf16x8 At[4][2], B0[2][2], B1[2][2];
    const char* cA = (const char*)g.A + (GATHER ? (size_t)0 : (size_t)cur.pm * tstep); const char* cB = (const char*)g.Bt + (size_t)cur.pn * tstep;
    PG8_GROWS(cG0, cG1, cur.pm);
    S.a_ready(cur);
    if constexpr (SP2) {
        PG8_STAGE(PG8_SB(0, 0), cB, voffB); PG8_STAGE(PG8_SB(0, 1), cB + hstep, voffB); PG8_STAGE(PG8_SA(0, 0), cA, cG0); PG8_STAGE(PG8_SA(0, 1), cA + hstepA, cG1);
        if (wr == 1) PG8_BAR;
        PG8_WAIT_V(2); PG8_BAR;
        PG8_STAGE(PG8_SB(1, 0), cB + kstep, voffB); PG8_STAGE(PG8_SA(1, 0), cA + kstep, cG0); PG8_STAGE(PG8_SB(1, 1), cB + hstep + kstep, voffB);
        PG8_WAIT_V(6); PG8_BAR;
    } else {
        PG8_STAGE(PG8_SB(0, 0), cB, voffB); PG8_STAGE(PG8_SA(0, 0), cA, cG0); PG8_STAGE(PG8_SB(0, 1), cB + hstep, voffB); PG8_STAGE(PG8_SA(0, 1), cA + hstepA, cG1);
        if (wr == 1) PG8_BAR;
        PG8_WAIT_V(4); PG8_BAR;
        PG8_STAGE(PG8_SB(1, 0), cB + kstep, voffB); PG8_STAGE(PG8_SA(1, 0), cA + kstep, cG0); PG8_STAGE(PG8_SB(1, 1), cB + hstep + kstep, voffB);
        PG8_WAIT_V(6); PG8_BAR;
    }
    for (;;) {
        const bool has_next = S.next(ui + 1, nxt);
        const char* nA = (has_next && !GATHER) ? (const char*)g.A + (size_t)nxt.pm * tstep : cA; const char* nB = has_next ? (const char*)g.Bt + (size_t)nxt.pn * tstep : cB;
        if (has_next) PG8_GROWS(nG0, nG1, nxt.pm); else { nG0[0] = cG0[0]; nG0[1] = cG0[1]; nG1[0] = cG1[0]; nG1[1] = cG1[1]; }
#pragma unroll 1
        for (int t = 0; t < nt; t += 2) {
            const bool last = (t == nt - 2);
            const bool relax_st = RELAX_STORES && (t == 0) && (ui > 0);
            const char* a1 = cA + (size_t)(t + 1) * kstep;
            const char* a2 = last ? nA : cA + (size_t)(t + 2) * kstep; const char* b2 = last ? nB : cB + (size_t)(t + 2) * kstep;
            const char* a3 = a2 + kstep; const char* b3 = b2 + kstep;
            if (last && has_next) S.a_ready(nxt);
            const unsigned s0[2] = {last ? nG0[0] : cG0[0], last ? nG0[1] : cG0[1]}, s1[2] = {last ? nG1[0] : cG1[0], last ? nG1[1] : cG1[1]};
            if constexpr (SP2) {
            PG8_LDB(B0, 0, 0); PG8_LDB(B1, 0, 1); PG8_SCHED; PG8_LDA(At, 0, 0); PG8_STAGE(PG8_SA(1, 1), a1 + hstepA, cG1);
            PG8_WAIT_V8R; PG8_WAIT_L(0); PG8_BAR; PG8_MMA(0, 0, At, B0); PG8_MMA(0, 1, At, B1); PG8_BAR; PG8_SCHED;
            PG8_LDA(At, 0, 1); PG8_STAGE(PG8_SB(0, 0), b2, voffB); PG8_STAGE(PG8_SB(0, 1), b2 + hstep, voffB); PG8_STAGE(PG8_SA(0, 0), a2, s0);
            PG8_WAIT_V8R; PG8_WAIT_L(0); PG8_BAR; PG8_MMA(1, 0, At, B0); PG8_MMA(1, 1, At, B1); PG8_BAR; PG8_SCHED;
            PG8_LDB(B0, 1, 0); PG8_LDB(B1, 1, 1); PG8_SCHED; PG8_LDA(At, 1, 0); PG8_STAGE(PG8_SA(0, 1), a2 + hstepA, s1);
            PG8_WAIT_V(8); PG8_WAIT_L(0); PG8_BAR; PG8_MMA(0, 0, At, B0); PG8_MMA(0, 1, At, B1); PG8_BAR; PG8_SCHED;
            PG8_LDA(At, 1, 1); PG8_STAGE(PG8_SB(1, 0), b3, voffB); PG8_STAGE(PG8_SB(1, 1), b3 + hstep, voffB); PG8_STAGE(PG8_SA(1, 0), a3, s0);
            PG8_WAIT_V(8); PG8_WAIT_L(0); PG8_BAR; PG8_MMA(1, 0, At, B0); PG8_MMA(1, 1, At, B1); PG8_BAR; PG8_SCHED;
            } else {
            PG8_LDB(B0, 0, 0); PG8_SCHED; PG8_LDA(At, 0, 0); PG8_STAGE(PG8_SA(1, 1), a1 + hstepA, cG1);
            PG8_WAIT_L(8); PG8_BAR; PG8_WAIT_L(0); PG8_MMA(0, 0, At, B0); PG8_BAR; PG8_SCHED;
            PG8_LDB(B1, 0, 1); PG8_STAGE(PG8_SB(0, 0), b2, voffB);
            PG8_BAR; PG8_WAIT_L(0); PG8_MMA(0, 1, At, B1); PG8_BAR;
            PG8_LDA(At, 0, 1); PG8_STAGE(PG8_SA(0, 0), a2, s0);
            PG8_BAR; PG8_WAIT_L(0); PG8_MMA(1, 0, At, B0); PG8_BAR; PG8_SCHED;
            PG8_STAGE(PG8_SB(0, 1), b2 + hstep, voffB);
            PG8_WAIT_V(6); PG8_BAR; PG8_MMA(1, 1, At, B1); PG8_BAR;
            PG8_LDB(B0, 1, 0); PG8_SCHED; PG8_LDA(At, 1, 0); PG8_STAGE(PG8_SA(0, 1), a2 + hstepA, s1);
            PG8_WAIT_L(8); PG8_BAR; PG8_WAIT_L(0); PG8_MMA(0, 0, At, B0); PG8_BAR; PG8_SCHED;
            PG8_LDB(B1, 1, 1); PG8_STAGE(PG8_SB(1, 0), b3, voffB);
            PG8_BAR; PG8_WAIT_L(0); PG8_MMA(0, 1, At, B1); PG8_BAR;
            PG8_LDA(At, 1, 1); PG8_STAGE(PG8_SA(1, 0), a3, s0);
            PG8_BAR; PG8_WAIT_L(0); PG8_MMA(1, 0, At, B0); PG8_BAR; PG8_SCHED;
            PG8_STAGE(PG8_SB(1, 1), b3 + hstep, voffB);
            PG8_WAIT_V(6); PG8_BAR; PG8_MMA(1, 1, At, B1); PG8_BAR;
            }
        }
        if constexpr (ES == 1) asm volatile("s_nop 15\n\ts_nop 15" ::: "memory");
        if constexpr (ALIGN_EPI) { if (wr == 0) PG8_BAR; }
        if constexpr (!Epi::AFTER_DRAIN) { E(acc, cur, wr, wc, fr, fq); S.done(cur); }
        if (!has_next) break;
#pragma unroll
        for (int a = 0; a < 2; ++a)
#pragma unroll
            for (int b = 0; b < 2; ++b)
#pragma unroll
                for (int m = 0; m < 4; ++m)
#pragma unroll
                    for (int n = 0; n < 2; ++n) acc[a][b][m][n] = (f32x4){0.f, 0.f, 0.f, 0.f};
        cur = nxt; cA = nA; cB = nB; ++ui; cG0[0] = nG0[0]; cG0[1] = nG0[1]; cG1[0] = nG1[0]; cG1[1] = nG1[1];
        if constexpr (ALIGN_EPI) { if (wr == 1) PG8_BAR; }
    }
    PG8_WAIT_V(0);
    if constexpr (!ALIGN_EPI) { if (wr == 0) PG8_BAR; }
    PG8_BAR;
    if constexpr (Epi::AFTER_DRAIN) { E.fused(acc, cur, wr, wc, fr, fq, lds, wid, lane); S.done(cur); }
#undef PG8_GROWS
#undef PG8_SA
#undef PG8_SB
#undef PG8_STAGE
#undef PG8_LDA
#undef PG8_LDB
#undef PG8_MMA
#undef PG8_WAIT_V
#undef PG8_WAIT_L
#undef PG8_WAIT_V8R
#undef PG8_BAR
#undef PG8_SCHED
}
}
namespace attn_body {
using bf16=__hip_bfloat16;
using bf16x8=__attribute__((ext_vector_type(8)))short;
using s16x4=__attribute__((ext_vector_type(4)))short;
using f32x16=__attribute__((ext_vector_type(16)))float;
using u32x4=__attribute__((ext_vector_type(4)))unsigned;
__device__ __forceinline__ int crow(int r,int hi){return (r&3)+8*(r>>2)+4*hi;}
#define SBAR() __builtin_amdgcn_sched_barrier(0)
__device__ __forceinline__ void glds16(const void*gsrc,unsigned lds_dst){unsigned keep;
  asm volatile("s_mov_b32 %0, m0\n\ts_mov_b32 m0, %2\n\ts_nop 0\n\tglobal_load_lds_dwordx4 %1, off\n\ts_mov_b32 m0, %0":"=&s"(keep):"v"(gsrc),"s"(lds_dst):"memory");}
__device__ __forceinline__ float max3f(float a,float b,float c){float r;asm("v_max3_f32 %0, %1, %2, %3":"=v"(r):"v"(a),"v"(b),"v"(c));return r;}
__device__ __forceinline__ float max2f(float a,float b){float r;asm("v_max_f32_e32 %0, %1, %2":"=v"(r):"v"(a),"v"(b));return r;}
__device__ __forceinline__ float fadd_s(float a,float b){float r;asm("v_add_f32_e32 %0, %1, %2":"=v"(r):"v"(a),"v"(b));return r;}
__device__ __forceinline__ float fsub_s(float a,float b){float r;asm("v_sub_f32_e32 %0, %1, %2":"=v"(r):"v"(a),"v"(b));return r;}
typedef float f32x2_t __attribute__((ext_vector_type(2))); typedef __bf16 bf16x2_t __attribute__((ext_vector_type(2)));
__device__ __forceinline__ unsigned cvtpk_s(float lo,float hi){f32x2_t v={lo,hi};bf16x2_t b=__builtin_convertvector(v,bf16x2_t);return __builtin_bit_cast(unsigned,b);}
#define WAIT_BAR(N) asm volatile("s_waitcnt vmcnt(" #N ") lgkmcnt(0)\n\ts_barrier":::"memory")
typedef __attribute__((address_space(3))) const char* lds_cptr;
typedef short v4i16_t __attribute__((ext_vector_type(4)));
__device__ __forceinline__ void kload8(bf16x8*kf,lds_cptr kp){
  kf[0]=*(const __attribute__((address_space(3))) bf16x8*)(kp);      kf[1]=*(const __attribute__((address_space(3))) bf16x8*)(kp+512);
  kf[2]=*(const __attribute__((address_space(3))) bf16x8*)(kp+2048); kf[3]=*(const __attribute__((address_space(3))) bf16x8*)(kp+2560);
  kf[4]=*(const __attribute__((address_space(3))) bf16x8*)(kp+4096); kf[5]=*(const __attribute__((address_space(3))) bf16x8*)(kp+4608);
  kf[6]=*(const __attribute__((address_space(3))) bf16x8*)(kp+6144); kf[7]=*(const __attribute__((address_space(3))) bf16x8*)(kp+6656);
}
__device__ __forceinline__ void kload2(bf16x8*kf,lds_cptr kp,int j){ kf[2*j]=*(const __attribute__((address_space(3))) bf16x8*)(kp+j*2048); kf[2*j+1]=*(const __attribute__((address_space(3))) bf16x8*)(kp+j*2048+512); }
__device__ __forceinline__ s16x4 vtr(lds_cptr p){ return __builtin_bit_cast(s16x4,__builtin_amdgcn_ds_read_tr16_b64_v4i16((__attribute__((address_space(3))) v4i16_t*)p)); }
__device__ __forceinline__ float rowmax(const f32x16&p0,const f32x16&p1){
  float a=max3f(p0[0],p0[1],p1[0]),b=max3f(p0[2],p0[3],p1[1]);a=max3f(a,p1[2],p1[3]);
  #pragma unroll
  for(int r=4;r<16;r+=4){a=max3f(a,p0[r],p0[r+1]);b=max3f(b,p0[r+2],p0[r+3]);a=max3f(a,p1[r],p1[r+1]);b=max3f(b,p1[r+2],p1[r+3]);}
  const float m=max2f(a,b);
  auto rr=__builtin_amdgcn_permlane32_swap(__float_as_uint(m),__float_as_uint(m),false,false);
  return max2f(__uint_as_float(rr[0]),__uint_as_float(rr[1]));
}
__device__ __forceinline__ void pv(f32x16*o,int vb,bf16x8 pa0,bf16x8 pa1,bf16x8 pa2,bf16x8 pa3){
  #pragma unroll
  for(int d0=0;d0<2;++d0){s16x4 lo[4],hi[4];
    #pragma unroll
    for(int ks=0;ks<4;++ks){
      asm volatile("ds_read_b64_tr_b16 %0,%1 offset:%c2":"=&v"(lo[ks]):"v"(vb),"i"(d0*4096+ks*1024):"memory");
      asm volatile("ds_read_b64_tr_b16 %0,%1 offset:%c2":"=&v"(hi[ks]):"v"(vb),"i"(d0*4096+ks*1024+512):"memory");}
    asm volatile("s_waitcnt lgkmcnt(0)":::"memory");SBAR();
    #define PK(k) (bf16x8){lo[k][0],lo[k][1],lo[k][2],lo[k][3],hi[k][0],hi[k][1],hi[k][2],hi[k][3]}
    o[d0]=__builtin_amdgcn_mfma_f32_32x32x16_bf16(pa0,PK(0),o[d0],0,0,0);
    o[d0]=__builtin_amdgcn_mfma_f32_32x32x16_bf16(pa1,PK(1),o[d0],0,0,0);
    o[d0]=__builtin_amdgcn_mfma_f32_32x32x16_bf16(pa2,PK(2),o[d0],0,0,0);
    o[d0]=__builtin_amdgcn_mfma_f32_32x32x16_bf16(pa3,PK(3),o[d0],0,0,0);
    #undef PK
  }
}
}

constexpr int BATCH = 8, SEQ = 4096, T = BATCH * SEQ, D = 1024, NE = 32, TOPK = 4, NH = 16, HD = 64;
constexpr int NQKV = 9216;
constexpr int MAXROWS = T * TOPK + NE * 256;
constexpr int MAXTILES = MAXROWS / 256;
constexpr int NVB = T / 128;
constexpr float LOG2E = 1.4426950408889634f;
constexpr float QSCALE = 0.125f * LOG2E;
constexpr float RMS_EPS = 1e-6f;
constexpr int NWAVES = 8;

constexpr size_t MiB = 1ull << 20;
constexpr size_t WS_CTL = 0, CTL_ZERO_BYTES = 1 * MiB;
constexpr size_t WS_SM = 1 * MiB;
constexpr size_t SM_ADA = WS_SM;
constexpr size_t SM_GM = WS_SM + 512 * 1024;
constexpr size_t SM_CSH = WS_SM + 640 * 1024;
constexpr size_t SM_BIAST = WS_SM + 644 * 1024;
constexpr size_t SM_BLKCNT = WS_SM + 704 * 1024;
constexpr size_t SM_TILEEXP = WS_SM + 768 * 1024;
constexpr size_t SM_TOPI = WS_SM + 1 * MiB;
constexpr size_t SM_TOPG = SM_TOPI + 512 * 1024;
constexpr size_t SM_RANK = SM_TOPG + 512 * 1024;
constexpr size_t SM_SLOT = SM_RANK + 512 * 1024;
constexpr size_t SM_TOKSLOT = WS_SM + 3 * MiB;
constexpr size_t SM_LOGF = WS_SM + 4 * MiB;
constexpr size_t SM_FCUM = WS_SM + 6 * MiB;
constexpr size_t SM_LSE = WS_SM + 8 * MiB;
constexpr size_t WS_WQKV = 16 * MiB, WS_WO0 = 34 * MiB, WS_WKV = 36 * MiB, WS_WQ = 40 * MiB, WS_WO1 = 42 * MiB, WS_WGU = 44 * MiB, WS_WDN = 300 * MiB;
constexpr size_t WS_HKV = 428 * MiB, WS_H = 492 * MiB, WS_OG = 556 * MiB, WS_O = 748 * MiB;
constexpr size_t WS_QKV0 = 812 * MiB, WS_ACT = 812 * MiB, WS_Y = 1084 * MiB, WS_QKV1 = 1388 * MiB, WS_XB = 1388 * MiB, WS_H8 = 1524 * MiB, WS_END = 1660 * MiB, WS_XS = WS_H;
static_assert(WS_H == WS_HKV + (size_t)T * D * 2, "H must follow HKV (KVQ GEMM addresses both through one A pointer)");
static_assert(WS_WQ == WS_WKV + (size_t)2048 * 1024 * 2, "Wq_t must follow Wkv_t");
static_assert(SM_LSE + (size_t)3 * T * 16 * 4 <= WS_WQKV, "small region");
static_assert(WS_Y + (size_t)MAXROWS * D * 2 <= WS_QKV1 && WS_XB + (size_t)MAXROWS * D * 2 <= WS_END && WS_QKV0 + (size_t)BATCH * 9 * 16 * SEQ * 64 * 2 <= WS_QKV1, "ws map");
constexpr int CW_TMO = 0, CW_BAR = 4096, CW_QUEUE = 65536  , CW_NRM = 131072  ;

constexpr int RING_OFF = 0, RING_BYTES = 131072;
constexpr int SCR_OFF = RING_BYTES, SCR_BYTES = 16384;
constexpr int BLK_OFF = SCR_OFF + SCR_BYTES, BLK_BYTES = 12288;
constexpr int MISC_OFF = BLK_OFF + BLK_BYTES;
constexpr int LDS_BYTES = MISC_OFF + 256;
constexpr int BL_TILE = 0, BL_WCNT = 576, BL_WBASE = 832, BL_PARTA = 1088, BL_PARTB = 1600, BL_TOT = 2112, BL_BASE = 2144, BL_PADS = 2176;

#define LAS __attribute__((address_space(3)))
#define GAS __attribute__((address_space(1)))
typedef unsigned short bf16;
typedef float f32x4 __attribute__((ext_vector_type(4)));
typedef unsigned u32x4v __attribute__((ext_vector_type(4)));
typedef unsigned u32x2v __attribute__((ext_vector_type(2)));
typedef int i32x4v __attribute__((ext_vector_type(4)));
#define LDS_WAIT() asm volatile("s_waitcnt lgkmcnt(0)" ::: "memory")
#define VM_WAIT() asm volatile("s_waitcnt vmcnt(0)" ::: "memory")

__device__ __forceinline__ float bf2f(unsigned v) { return __uint_as_float(v << 16); }
__device__ __forceinline__ unsigned pkbf(float lo, float hi) { return attn_body::cvtpk_s(lo, hi); }
__device__ __forceinline__ float wave_sum(float v) {
#pragma unroll
    for (int o = 1; o < 64; o <<= 1) v += __shfl_xor(v, o);
    return v;
}

namespace pg8 {
struct EpiQKV0 {
    static constexpr bool PERM = true, AFTER_DRAIN = false; static constexpr int NSTORE = 16;
    bf16_t* O; float mul;
    __device__ __forceinline__ void operator()(const f32x4 (&acc)[2][2][4][2], const Unit& u, int wr, int wc, int fr, int fq) const {
        _Pragma("unroll") for (int rep_e = 0; rep_e < 1 + ((PROBE_EPI >> 0) & 1); ++rep_e) {
        asm volatile("" : "+v"(fr), "+v"(fq));
        const int g = u.pn / 12, rem = u.pn - g * 12, which = rem >> 2, h0 = (rem & 3) * 4, sh = 2 * g;
        const float sc = (which == 0 ? QSCALE : 1.f) * mul;
#pragma unroll
        for (int ai = 0; ai < 2; ++ai)
#pragma unroll
            for (int m = 0; m < 4; ++m) {
                const int tok = u.pm * BM + ai * HALF + wr * 64 + m * 16 + fr, b = tok >> 12, s = tok & 4095;
                const int subrow = (s & ((1 << sh) - 1)) * (4096 >> sh) + (s >> sh);
#pragma unroll
                for (int bj = 0; bj < 2; ++bj) {
                    const int head = h0 + 2 * bj + (wc >> 1), dcol = (wc & 1) * 32 + 8 * fq;
                    const size_t plane = (size_t)(((b * 3 + g) * 3 + which) * 16 + head);
                    const f32x4 v0 = acc[ai][bj][m][0] * sc, v1 = acc[ai][bj][m][1] * sc;
                    u32x4 w; w.x = cvt_pk_bf16(v0[0], v0[1]); w.y = cvt_pk_bf16(v0[2], v0[3]); w.z = cvt_pk_bf16(v1[0], v1[1]); w.w = cvt_pk_bf16(v1[2], v1[3]);
#if NT_STORE
                    __builtin_nontemporal_store(w, (u32x4*)(O + (plane * 4096 + subrow) * 64 + dcol));
#else
                    *(u32x4*)(O + (plane * 4096 + subrow) * 64 + dcol) = w;
#endif
                }
            }
        }
    }
};
struct EpiQKV0Probe {
    static constexpr bool PERM = true, AFTER_DRAIN = false; static constexpr int NSTORE = 16;
    bf16_t* O; float mul; int wide;
    __device__ __forceinline__ void operator()(const f32x4 (&acc)[2][2][4][2], const Unit& u, int wr, int wc, int fr, int fq) const {
        asm volatile("" : "+v"(fr), "+v"(fq));
        const int g = u.pn / 12, rem = u.pn - g * 12, which = rem >> 2, h0 = (rem & 3) * 4, sh = 2 * g;
        const float sc = (which == 0 ? QSCALE : 1.f) * mul;
#pragma unroll
        for (int ai = 0; ai < 2; ++ai)
#pragma unroll
            for (int m = 0; m < 4; ++m) {
                const int tok = u.pm * BM + ai * HALF + wr * 64 + m * 16 + fr, b = tok >> 12, s = tok & 4095;
                const int subrow = (s & ((1 << sh) - 1)) * (4096 >> sh) + (s >> sh);
                const int head = h0 + wc, dcol = 16 * fq;
                const size_t plane = (size_t)(((b * 3 + g) * 3 + which) * 16 + head);
#pragma unroll
                for (int bj = 0; bj < 2; ++bj) {
                    const f32x4 v0 = acc[ai][bj][m][0] * sc, v1 = acc[ai][bj][m][1] * sc;
                    u32x4 w; w.x = cvt_pk_bf16(v0[0], v0[1]); w.y = cvt_pk_bf16(v0[2], v0[3]); w.z = cvt_pk_bf16(v1[0], v1[1]); w.w = cvt_pk_bf16(v1[2], v1[3]);
                    if (wide == 4) { const size_t off_ = ((size_t)(u.pm * 36 + u.pn) * 131072 + (size_t)(wr * 4 + wc) * 16384 + (size_t)((ai * 4 + m) * 2 + bj) * 1024 + fr * 64 + fq * 16) & (size_t)0x7fffff;
                        *(u32x4*)((unsigned char*)O + off_) = w; }
                    else if (wide != 3 || m == 0) *(u32x4*)(O + (((plane * 4096 + subrow) * 64 + dcol + 8 * bj) & (size_t)(wide == 2 ? 0x3fffff : 0x7fffffffff)) ) = w; else if (w.x == 0x12345678u) O[0] = 1;
                }
            }
    }
};
struct EpiKVQ {
    static constexpr bool PERM = true, AFTER_DRAIN = false; static constexpr int NSTORE = 16;
    bf16_t* O; float mul; unsigned* nrm;
    __device__ __forceinline__ void operator()(const f32x4 (&acc)[2][2][4][2], const Unit& u, int wr, int wc, int fr, int fq) const {
        asm volatile("" : "+v"(fr), "+v"(fq));
        const int which = u.pn < 4 ? 1 : (u.pn < 8 ? 2 : 0), h0 = (u.pn & 3) * 4, pm = u.pm & 127;
        const float sc = (which == 0 ? QSCALE : 1.f) * mul;
        float nmax[2] = {0.f, 0.f};
#pragma unroll
        for (int ai = 0; ai < 2; ++ai)
#pragma unroll
            for (int m = 0; m < 4; ++m) {
                const int tok = pm * BM + ai * HALF + wr * 64 + m * 16 + fr, b = tok >> 12, s = tok & 4095;
#pragma unroll
                for (int bj = 0; bj < 2; ++bj) {
                    const int head = h0 + 2 * bj + (wc >> 1), dcol = (wc & 1) * 32 + 8 * fq;
                    const size_t plane = (size_t)((b * 3 + which) * 16 + head);
                    const f32x4 v0 = acc[ai][bj][m][0] * sc, v1 = acc[ai][bj][m][1] * sc;
                    u32x4 w; w.x = cvt_pk_bf16(v0[0], v0[1]); w.y = cvt_pk_bf16(v0[2], v0[3]); w.z = cvt_pk_bf16(v1[0], v1[1]); w.w = cvt_pk_bf16(v1[2], v1[3]);
                    *(u32x4*)(O + (plane * 4096 + s) * 64 + dcol) = w;
                    if (which != 2) {
                        float ss = 0.f;
#pragma unroll
                        for (int k4 = 0; k4 < 4; ++k4) { const unsigned pw_ = k4 == 0 ? w.x : (k4 == 1 ? w.y : (k4 == 2 ? w.z : w.w)); const float lo_ = __uint_as_float(pw_ << 16), hi_ = __uint_as_float(pw_ & 0xffff0000u); ss += lo_ * lo_ + hi_ * hi_; }
                        ss += __shfl_xor(ss, 16); ss += __shfl_xor(ss, 32);
                        nmax[bj] = fmaxf(nmax[bj], ss);
                    }
                }
            }
        if (which != 2) {
#pragma unroll
            for (int bj = 0; bj < 2; ++bj) { float v = nmax[bj];
                v = fmaxf(v, __shfl_xor(v, 1)); v = fmaxf(v, __shfl_xor(v, 2)); v = fmaxf(v, __shfl_xor(v, 4)); v = fmaxf(v, __shfl_xor(v, 8));
                if (fr == 0 && fq == 0) { const int b0 = (pm * BM) >> 12, head = h0 + 2 * bj + (wc >> 1);
                    atomicMax(nrm + (((b0 * 2 + which) * 16 + head) * 2 + (wc & 1)), __float_as_uint(v)); } }
        }
    }
};
template <bool SRC_BF16> struct EpiResid {
    static constexpr bool PERM = true, AFTER_DRAIN = false; static constexpr int NSTORE = 16;
    const void* src; bf16_t* dst; const float* gate; float mul;
    __device__ __forceinline__ void operator()(const f32x4 (&acc)[2][2][4][2], const Unit& u, int wr, int wc, int fr, int fq) const {
        asm volatile("" : "+v"(fr), "+v"(fq));
#pragma unroll
        for (int ai = 0; ai < 2; ++ai)
#pragma unroll
            for (int m = 0; m < 4; ++m) {
                const int row = u.pm * BM + ai * HALF + wr * 64 + m * 16 + fr, b = row >> 12;
#pragma unroll
                for (int bj = 0; bj < 2; ++bj) {
                    const int col = u.pn * BM + bj * HALF + wc * 32 + 8 * fq;
                    f32x4 x0, x1;
                    if (SRC_BF16) { const u32x4 r = *(const u32x4*)((const bf16_t*)src + (size_t)row * D + col);
                        x0 = (f32x4){__uint_as_float(r.x << 16), __uint_as_float(r.x & 0xffff0000u), __uint_as_float(r.y << 16), __uint_as_float(r.y & 0xffff0000u)};
                        x1 = (f32x4){__uint_as_float(r.z << 16), __uint_as_float(r.z & 0xffff0000u), __uint_as_float(r.w << 16), __uint_as_float(r.w & 0xffff0000u)}; }
                    else if (NT_ROWS) { x0 = __builtin_nontemporal_load((const f32x4*)((const float*)src + (size_t)row * D + col)); x1 = __builtin_nontemporal_load((const f32x4*)((const float*)src + (size_t)row * D + col + 4)); }
                    else { x0 = *(const f32x4*)((const float*)src + (size_t)row * D + col); x1 = *(const f32x4*)((const float*)src + (size_t)row * D + col + 4); }
                    const f32x4 g0 = *(const f32x4*)(gate + b * 6144 + col), g1 = *(const f32x4*)(gate + b * 6144 + col + 4);
                    const f32x4 v0 = x0 + (g0 * mul) * acc[ai][bj][m][0], v1 = x1 + (g1 * mul) * acc[ai][bj][m][1];
                    u32x4 w; w.x = cvt_pk_bf16(v0[0], v0[1]); w.y = cvt_pk_bf16(v0[2], v0[3]); w.z = cvt_pk_bf16(v1[0], v1[1]); w.w = cvt_pk_bf16(v1[2], v1[3]);
                    *(u32x4*)(dst + (size_t)row * D + col) = w;
                }
            }
    }
};
struct EpiSwiGLU {
    static constexpr bool PERM = true, AFTER_DRAIN = false; static constexpr int NSTORE = 0;
    bf16_t* ACT; const float* bgu;
    __device__ __forceinline__ void operator()(const f32x4 (&acc)[2][2][4][2], const Unit& u, int wr, int wc, int fr, int fq) const {
        const int e = u.pn >> 3, pnl = u.pn & 7, j0 = pnl * 128 + wc * 32 + 8 * fq;
        f32x4 bg[2], bu[2];
#pragma unroll
        for (int n = 0; n < 2; ++n) { bg[n] = *(const f32x4*)(bgu + e * 2048 + j0 + 4 * n); bu[n] = *(const f32x4*)(bgu + e * 2048 + 1024 + j0 + 4 * n); }
#pragma unroll
        for (int ai = 0; ai < 2; ++ai)
#pragma unroll
            for (int m = 0; m < 4; ++m) {
                const int row = u.pm * BM + ai * HALF + wr * 64 + m * 16 + fr;
                float a[8];
#pragma unroll
                for (int n = 0; n < 2; ++n) {
                    const f32x4 gv = acc[ai][0][m][n] + bg[n], uv = acc[ai][1][m][n] + bu[n];
#pragma unroll
                    for (int i = 0; i < 4; ++i) {
                        const float gg = fminf(gv[i], 7.f), uu = fminf(fmaxf(uv[i], -7.f), 7.f);
                        const float sg = __builtin_amdgcn_rcpf(1.f + __builtin_amdgcn_exp2f(-1.702f * LOG2E * gg));
                        a[4 * n + i] = (uu + 1.f) * gg * sg;
                    }
                }
                u32x4 w; w.x = cvt_pk_bf16(a[0], a[1]); w.y = cvt_pk_bf16(a[2], a[3]); w.z = cvt_pk_bf16(a[4], a[5]); w.w = cvt_pk_bf16(a[6], a[7]);
                *(u32x4*)(ACT + (size_t)row * D + j0) = w;
            }
    }
};
struct EpiDown {
    static constexpr bool PERM = true, AFTER_DRAIN = false; static constexpr int NSTORE = 0;
    bf16_t* Y; const float* bdn;
    __device__ __forceinline__ void operator()(const f32x4 (&acc)[2][2][4][2], const Unit& u, int wr, int wc, int fr, int fq) const {
        const int e = u.pn >> 2, pnl = u.pn & 3;
#pragma unroll
        for (int ai = 0; ai < 2; ++ai)
#pragma unroll
            for (int m = 0; m < 4; ++m) {
                const int row = u.pm * BM + ai * HALF + wr * 64 + m * 16 + fr;
#pragma unroll
                for (int bj = 0; bj < 2; ++bj) {
                    const int col = pnl * BM + bj * HALF + wc * 32 + 8 * fq;
                    const f32x4 b0 = *(const f32x4*)(bdn + e * 1024 + col), b1 = *(const f32x4*)(bdn + e * 1024 + col + 4);
                    const f32x4 v0 = acc[ai][bj][m][0] + b0, v1 = acc[ai][bj][m][1] + b1;
                    u32x4 w; w.x = cvt_pk_bf16(v0[0], v0[1]); w.y = cvt_pk_bf16(v0[2], v0[3]); w.z = cvt_pk_bf16(v1[0], v1[1]); w.w = cvt_pk_bf16(v1[2], v1[3]);
                    *(u32x4*)(Y + (size_t)row * D + col) = w;
                }
            }
    }
};
__device__ __forceinline__ unsigned pk4_fp8(float a, float b, float c, float d) { int v = __builtin_amdgcn_cvt_pk_fp8_f32(a, b, 0, false); v = __builtin_amdgcn_cvt_pk_fp8_f32(c, d, v, true); return (unsigned)v; }
struct EpiQKV08 {
    static constexpr bool PERM = true, AFTER_DRAIN = false; static constexpr int NSTORE = 16;
    unsigned char* O; float mul;
    __device__ __forceinline__ void operator()(const f32x4 (&acc)[2][2][4][2], const Unit& u, int wr, int wc, int fr, int fq) const {
        asm volatile("" : "+v"(fr), "+v"(fq));
        const int g = u.pn / 12, rem = u.pn - g * 12, which = rem >> 2, h0 = (rem & 3) * 4, sh = 2 * g;
        const float sc = (which == 0 ? QSCALE : 1.f) * mul;
#pragma unroll
        for (int ai = 0; ai < 2; ++ai)
#pragma unroll
            for (int m = 0; m < 4; ++m) {
                const int tok = u.pm * BM + ai * HALF + wr * 64 + m * 16 + fr, b = tok >> 12, s = tok & 4095;
                const int subrow = (s & ((1 << sh) - 1)) * (4096 >> sh) + (s >> sh);
#pragma unroll
                for (int bj = 0; bj < 2; ++bj) {
                    const int head = h0 + 2 * bj + (wc >> 1), dcol = (wc & 1) * 32 + 8 * fq;
                    const size_t plane = (size_t)(((b * 3 + g) * 3 + which) * 16 + head);
                    const f32x4 v0 = acc[ai][bj][m][0] * sc, v1 = acc[ai][bj][m][1] * sc;
                    typedef unsigned u32x2e __attribute__((ext_vector_type(2)));
                    u32x2e w8; w8.x = pk4_fp8(v0[0], v0[1], v0[2], v0[3]); w8.y = pk4_fp8(v1[0], v1[1], v1[2], v1[3]);
                    *(u32x2e*)(O + (plane * 4096 + subrow) * 64 + dcol) = w8;
                }
            }
    }
};
struct EpiSwiGLU8 {
    static constexpr bool PERM = true, AFTER_DRAIN = false; static constexpr int NSTORE = 8;
    unsigned char* ACT; const float* bgu;
    __device__ __forceinline__ void operator()(const f32x4 (&acc)[2][2][4][2], const Unit& u, int wr, int wc, int fr, int fq) const {
        _Pragma("unroll") for (int rep_e = 0; rep_e < 1 + ((PROBE_EPI >> 1) & 1); ++rep_e) {
        asm volatile("" : "+v"(fr), "+v"(fq));
        const int e = u.pn >> 3, pnl = u.pn & 7, j0 = pnl * 128 + wc * 32 + 8 * fq;
        f32x4 bg[2], bu[2];
#pragma unroll
        for (int n = 0; n < 2; ++n) { bg[n] = *(const f32x4*)(bgu + e * 2048 + j0 + 4 * n) * 64.f; bu[n] = *(const f32x4*)(bgu + e * 2048 + 1024 + j0 + 4 * n) * 64.f + 64.f; }
#pragma unroll
        for (int ai = 0; ai < 2; ++ai)
#pragma unroll
            for (int m = 0; m < 4; ++m) {
                const int row = u.pm * BM + ai * HALF + wr * 64 + m * 16 + fr;
                float a[8];
#pragma unroll
                for (int n = 0; n < 2; ++n) {
                    const f32x4 gv = acc[ai][0][m][n] + bg[n], uv = acc[ai][1][m][n] + bu[n];
#pragma unroll
                    for (int i = 0; i < 4; ++i) {
                        const float gg = fminf(gv[i], 448.f), uu = fminf(fmaxf(uv[i], -384.f), 512.f);
                        const float t = __builtin_amdgcn_exp2f((-1.702f * LOG2E * 0.015625f) * gg);
                        const float sg = __builtin_amdgcn_rcpf(__builtin_fmaf(t, 4096.f, 4096.f));
                        a[4 * n + i] = (uu * gg) * sg;
                    }
                }
                typedef unsigned u32x2e __attribute__((ext_vector_type(2)));
                u32x2e w; w.x = pk4_fp8(a[0], a[1], a[2], a[3]); w.y = pk4_fp8(a[4], a[5], a[6], a[7]);
                *(u32x2e*)(ACT + (size_t)row * D + j0) = w;
            }
        }
    }
};
template <int VAR> struct EpiProbeGU {
    static constexpr bool PERM = true, AFTER_DRAIN = false; static constexpr int NSTORE = 0;
    unsigned char* ACT; const float* bgu;
    __device__ __forceinline__ void operator()(const f32x4 (&acc)[2][2][4][2], const Unit& u, int wr, int wc, int fr, int fq) const {
        if (VAR == 2) { if (acc[0][0][0][0][0] == 12345.678f) ACT[0] = 1; return; }
        asm volatile("" : "+v"(fr), "+v"(fq));
        const int pnl = u.pn & 7, j0 = pnl * 128 + wc * 32 + 8 * fq;
#pragma unroll
        for (int ai = 0; ai < 2; ++ai)
#pragma unroll
            for (int m = 0; m < 4; ++m) {
                const int row = u.pm * BM + ai * HALF + wr * 64 + m * 16 + fr;
                const f32x4 g0 = acc[ai][0][m][0] + acc[ai][1][m][0], g1 = acc[ai][0][m][1] + acc[ai][1][m][1];
                typedef unsigned u32x2e __attribute__((ext_vector_type(2)));
                u32x2e w; w.x = pk4_fp8(g0[0], g0[1], g0[2], g0[3]); w.y = pk4_fp8(g1[0], g1[1], g1[2], g1[3]);
                *(u32x2e*)(ACT + (size_t)row * D + j0) = w;
            }
    }
};
struct EpiNone { static constexpr bool PERM = true, AFTER_DRAIN = false; static constexpr int NSTORE = 0; unsigned char* P;
    __device__ __forceinline__ void operator()(const f32x4 (&acc)[2][2][4][2], const Unit& u, int wr, int wc, int fr, int fq) const { if (acc[0][0][0][0][0] == 12345.678f) P[0] = 1; } };
struct EpiDown8 {
    static constexpr bool PERM = true, AFTER_DRAIN = false; static constexpr int NSTORE = 16;
    bf16_t* Y; const float* bdn;
    __device__ __forceinline__ void operator()(const f32x4 (&acc)[2][2][4][2], const Unit& u, int wr, int wc, int fr, int fq) const {
        _Pragma("unroll") for (int rep_e = 0; rep_e < 1 + ((PROBE_EPI >> 2) & 1); ++rep_e) {
        asm volatile("" : "+v"(fr), "+v"(fq));
        const int e = u.pn >> 2, pnl = u.pn & 3;
#pragma unroll
        for (int ai = 0; ai < 2; ++ai)
#pragma unroll
            for (int m = 0; m < 4; ++m) {
                const int row = u.pm * BM + ai * HALF + wr * 64 + m * 16 + fr;
#pragma unroll
                for (int bj = 0; bj < 2; ++bj) {
                    const int col = pnl * BM + bj * HALF + wc * 32 + 8 * fq;
                    const f32x4 b0 = *(const f32x4*)(bdn + e * 1024 + col), b1 = *(const f32x4*)(bdn + e * 1024 + col + 4);
                    const f32x4 v0 = acc[ai][bj][m][0] * 0.015625f + b0, v1 = acc[ai][bj][m][1] * 0.015625f + b1;
                    if (Y_FP8) { typedef unsigned u32x2e __attribute__((ext_vector_type(2))); u32x2e w8; w8.x = pk4_fp8(v0[0], v0[1], v0[2], v0[3]); w8.y = pk4_fp8(v1[0], v1[1], v1[2], v1[3]);
                        *(u32x2e*)((unsigned char*)Y + (size_t)row * D + col) = w8; }
                    else { u32x4 w; w.x = cvt_pk_bf16(v0[0], v0[1]); w.y = cvt_pk_bf16(v0[2], v0[3]); w.z = cvt_pk_bf16(v1[0], v1[1]); w.w = cvt_pk_bf16(v1[2], v1[3]);
                        *(u32x4*)(Y + (size_t)row * D + col) = w; }
                }
            }
        }
    }
};
struct KVQOrder : StaticOrder {
    __device__ bool next(int i, Unit& u) const { if (!StaticOrder::next(i, u)) return false; if (u.pn >= 8) u.pm += 128; return true; }
};
template <int NN> struct MoeOrder {
    static constexpr int TR = 32 / NN;
    const LAS int* tile_exp; int n_tiles, c, G;
    __device__ __forceinline__ bool next(int i, Unit& u) const {
        int st, j;
        if (G == 256) { st = i * 8 + (c & 7); j = c >> 3; } else { const int L = i * G + c; st = L >> 5; j = L & 31; }
        const int tile = st * TR + (j % TR);
        if (tile >= n_tiles) return false;
        u.pm = tile; u.pn = tile_exp[tile] * NN + j / TR; return true;
    }
    __device__ __forceinline__ void a_ready(const Unit&) const {}
    __device__ __forceinline__ void done(const Unit&) const {}
};
struct MoeOrderProbe { const LAS int* tile_exp; int n_tiles, c, G;
    __device__ __forceinline__ bool next(int i, Unit& u) const { int st, j; if (G == 256) { st = i * 8 + (c & 7); j = c >> 3; } else { const int L = i * G + c; st = L >> 5; j = L & 31; }
        const int tile = st * 4 + (j % 4); if (tile >= n_tiles) return false; u.pm = tile; u.pn = j / 4; return true; }
    __device__ __forceinline__ void a_ready(const Unit&) const {}
    __device__ __forceinline__ void done(const Unit&) const {} };
}

namespace attn_body {
constexpr int KSLOT = 8192;
constexpr int L_K = 0, L_V = 2 * KSLOT, L_WS = 4 * KSLOT, L_OST = L_WS + 8 * 256, L_TAB = L_OST + 8 * 4096, L_ATT_END = L_TAB + 1024;
__device__ __forceinline__ void qkt2(f32x16& p0, f32x16& p1, const char* Kslot, const bf16x8* qr, const f32x16& c0, const f32x16& c1, int r32, int hi) {
  const char* kb = Kslot + hi * 1024 + r32 * 16;
  #pragma unroll
  for (int d0 = 0; d0 < 4; ++d0) {
    const bf16x8 b0 = *reinterpret_cast<const bf16x8*>(kb + d0 * 2048);
    const bf16x8 b1 = *reinterpret_cast<const bf16x8*>(kb + d0 * 2048 + 512);
    if (d0 == 0) { p0 = __builtin_amdgcn_mfma_f32_32x32x16_bf16(b0, qr[0], c0, 0, 0, 0); p1 = __builtin_amdgcn_mfma_f32_32x32x16_bf16(b1, qr[0], c1, 0, 0, 0); }
    else { p0 = __builtin_amdgcn_mfma_f32_32x32x16_bf16(b0, qr[d0], p0, 0, 0, 0); p1 = __builtin_amdgcn_mfma_f32_32x32x16_bf16(b1, qr[d0], p1, 0, 0, 0); } }
}
template <int MODE> __device__ __forceinline__ void attn_unit(const bf16* Qp, const bf16* __restrict__ Kp, const bf16* __restrict__ Vp, int q0, bf16* Ob, long ostride,
                                                               float* lse, long lstride, const float* __restrict__ F2, const float* __restrict__ tabg, char* shm) {
  const int tid = threadIdx.x, lane = tid & 63, r32 = lane & 31, hi = lane >> 5; const int wid = __builtin_amdgcn_readfirstlane(tid >> 6);
  const unsigned lds0 = (unsigned)(uintptr_t)shm;
  float* wsf = (float*)(shm + L_WS) + wid * 64;
  const int tq = q0 >> 6, t_hi = tq + 4;
  const int t_lo = (MODE == 0) ? (tq >= 2 ? tq - 2 : 0) : 0;
  const int w_hi = tq + (wid >> 1);
  const int w_lo = (MODE == 0) ? (w_hi >= 2 ? w_hi - 2 : 0) : 0;
  const bf16* ksrc = Kp + (long)lane * 64 + wid * 8;
  const bf16* vsrc = Vp + (long)(16 * (wid & 3) + (lane >> 2)) * 64 + (wid >> 2) * 32 + (lane & 3) * 8;
  const unsigned kdst = lds0 + L_K + wid * 1024, vdst = lds0 + L_V + wid * 1024;
  #define DMA_KV(t, slot) do { glds16(ksrc + (long)(t) * 4096, (unsigned)__builtin_amdgcn_readfirstlane(kdst + (slot) * KSLOT)); glds16(vsrc + (long)(t) * 4096, (unsigned)__builtin_amdgcn_readfirstlane(vdst + (slot) * KSLOT)); } while (0)
  if (MODE == 0) { float* tab = (float*)(shm + L_TAB); if (tid < 129) tab[tid] = tabg[tid]; }
  const int qi = q0 + wid * 32 + r32;
  f32x4 fk[8];
  #pragma unroll
  for (int g4 = 0; g4 < 8; ++g4) fk[g4] = (f32x4){0.f, 0.f, 0.f, 0.f};
  float Fq = 0.f;
  if (MODE == 1) { Fq = F2[qi];
    #pragma unroll
    for (int g4 = 0; g4 < 4; ++g4) { fk[g4] = *(const f32x4*)(F2 + 64 * t_lo + 4 * hi + 8 * g4); fk[4 + g4] = *(const f32x4*)(F2 + 64 * t_lo + 32 + 4 * hi + 8 * g4); } }
  bf16x8 qr[4];
  { const bf16* Qw = Qp + (long)(q0 + wid * 32) * 64;
    #pragma unroll
    for (int d0 = 0; d0 < 4; ++d0) qr[d0] = *reinterpret_cast<const bf16x8*>(&Qw[(long)r32 * 64 + d0 * 16 + hi * 8]); }
  DMA_KV(t_lo, 0);
  float m_run = -INFINITY, l_run = 0.f; f32x16 o[2]; o[0] = f32x16{}; o[1] = f32x16{};
  const int vb0 = (int)(lds0 + L_V) + ((lane >> 4) & 1) * 32 + (lane & 3) * 8 + (4 * hi + ((lane & 15) >> 2)) * 64;
  for (int t = t_lo; t < t_hi; ++t) {
    const int s = (t - t_lo) & 1;
    asm volatile("s_waitcnt vmcnt(0) lgkmcnt(0)\n\ts_barrier" ::: "memory");
    f32x4 fn[8];
    #pragma unroll
    for (int g4 = 0; g4 < 8; ++g4) fn[g4] = fk[g4];
    if (t + 1 < t_hi) {
      if (MODE == 1) {
        #pragma unroll
        for (int g4 = 0; g4 < 4; ++g4) { fn[g4] = *(const f32x4*)(F2 + 64 * (t + 1) + 4 * hi + 8 * g4); fn[4 + g4] = *(const f32x4*)(F2 + 64 * (t + 1) + 32 + 4 * hi + 8 * g4); } }
      DMA_KV(t + 1, s ^ 1);
    }
    if (t >= w_lo && t <= w_hi) {
      f32x16 c0, c1, p0, p1;
      if (MODE == 1) {
        #pragma unroll
        for (int r = 0; r < 16; ++r) { c0[r] = Fq - fk[r >> 2][r & 3]; c1[r] = Fq - fk[4 + (r >> 2)][r & 3]; }
      } else {
        const float* tab = (const float*)(shm + L_TAB);
        #pragma unroll
        for (int r = 0; r < 16; ++r) { const int d0_ = qi - (64 * t + crow(r, hi)), d1_ = d0_ - 32;
          c0[r] = tab[d0_ < 0 ? 0 : (d0_ > 128 ? 128 : d0_)]; c1[r] = tab[d1_ < 0 ? 0 : (d1_ > 128 ? 128 : d1_)]; }
      }
      qkt2(p0, p1, shm + L_K + s * KSLOT, qr, c0, c1, r32, hi);
      if (MODE == 1) {
        if (t == w_hi) {
          #pragma unroll
          for (int r = 0; r < 16; ++r) { const int kv = 64 * t + crow(r, hi); if (kv > qi) p0[r] = -INFINITY; if (kv + 32 > qi) p1[r] = -INFINITY; } }
      } else {
        #pragma unroll
        for (int r = 0; r < 16; ++r) { const int d0_ = qi - (64 * t + crow(r, hi)), d1_ = d0_ - 32;
          if ((unsigned)d0_ > 128u) p0[r] = -INFINITY; if ((unsigned)d1_ > 128u) p1[r] = -INFINITY; }
      }
      const float rm = rowmax(p0, p1), mnew = fmaxf(m_run, rm), msub = (mnew == -INFINITY) ? 0.f : mnew;
      const float f = __builtin_amdgcn_exp2f(m_run - msub);
      m_run = mnew;
      float sacc = 0.f;
      #pragma unroll
      for (int r = 0; r < 16; ++r) { p0[r] = __builtin_amdgcn_exp2f(p0[r] - msub); p1[r] = __builtin_amdgcn_exp2f(p1[r] - msub); sacc += p0[r] + p1[r]; }
      l_run = l_run * f + sacc;
      if (__any(f != 1.f)) {
        if (hi == 0) wsf[r32] = f;
        asm volatile("s_waitcnt lgkmcnt(0)" ::: "memory");
        #pragma unroll
        for (int r = 0; r < 16; ++r) { const float ff = wsf[crow(r, hi)]; o[0][r] *= ff; o[1][r] *= ff; }
      }
      u32x4 pw0, pw1, pw2, pw3;
      pw0 = (u32x4){cvtpk_s(p0[0], p0[1]), cvtpk_s(p0[2], p0[3]), cvtpk_s(p0[4], p0[5]), cvtpk_s(p0[6], p0[7])};
      pw1 = (u32x4){cvtpk_s(p0[8], p0[9]), cvtpk_s(p0[10], p0[11]), cvtpk_s(p0[12], p0[13]), cvtpk_s(p0[14], p0[15])};
      pw2 = (u32x4){cvtpk_s(p1[0], p1[1]), cvtpk_s(p1[2], p1[3]), cvtpk_s(p1[4], p1[5]), cvtpk_s(p1[6], p1[7])};
      pw3 = (u32x4){cvtpk_s(p1[8], p1[9]), cvtpk_s(p1[10], p1[11]), cvtpk_s(p1[12], p1[13]), cvtpk_s(p1[14], p1[15])};
      SBAR();
      pv(o, vb0 + s * KSLOT, __builtin_bit_cast(bf16x8, pw0), __builtin_bit_cast(bf16x8, pw1), __builtin_bit_cast(bf16x8, pw2), __builtin_bit_cast(bf16x8, pw3));
    }
    #pragma unroll
    for (int g4 = 0; g4 < 8; ++g4) fk[g4] = fn[g4];
  }
  { auto rr = __builtin_amdgcn_permlane32_swap(__float_as_uint(l_run), __float_as_uint(l_run), false, false); l_run = __uint_as_float(rr[0]) + __uint_as_float(rr[1]); }
  if (hi == 0) { wsf[32 + r32] = l_run; if (MODE == 0) lse[(long)qi * lstride] = m_run + __builtin_amdgcn_logf(l_run); }
  asm volatile("s_waitcnt lgkmcnt(0)" ::: "memory");
  float rli[16];
  #pragma unroll
  for (int r = 0; r < 16; ++r) rli[r] = __builtin_amdgcn_rcpf(wsf[32 + crow(r, hi)]);
  { bf16* stg = (bf16*)(shm + L_OST) + wid * 2048;
    #pragma unroll
    for (int r = 0; r < 16; ++r) { const int orow = crow(r, hi);
      #pragma unroll
      for (int d0 = 0; d0 < 2; ++d0) stg[orow * 64 + d0 * 32 + r32] = __float2bfloat16(o[d0][r] * rli[r]); }
    asm volatile("s_waitcnt lgkmcnt(0)" ::: "memory");
    bf16* Ow = Ob + (long)(q0 + wid * 32) * ostride;
    #pragma unroll
    for (int i = 0; i < 4; ++i) { const int row = i * 8 + (lane >> 3), ch = lane & 7; const u32x4 v = *(const u32x4*)(stg + row * 64 + ch * 8); *(u32x4*)(Ow + (long)row * ostride + ch * 8) = v; } }
  asm volatile("s_waitcnt lgkmcnt(0)\n\ts_barrier" ::: "memory");
  #undef DMA_KV
}
#undef SBAR
#undef WAIT_BAR
}

namespace attn_body {
constexpr int NSLOT = 3, SLOTB = 8192;
constexpr int T_K = 0, T_V = NSLOT * SLOTB, T_WS = 2 * NSLOT * SLOTB, T_OST = T_WS + 8 * 256, T_END = T_OST + 8 * 4096;
constexpr int T_F = 90112;
__device__ __forceinline__ void glds16s(unsigned voff,const void*sbase,unsigned lds_dst){unsigned keep;
  asm volatile("s_mov_b32 %0, m0\n\ts_mov_b32 m0, %3\n\ts_nop 0\n\tglobal_load_lds_dwordx4 %1, %2\n\ts_mov_b32 m0, %0":"=&s"(keep):"v"(voff),"s"(sbase),"s"(lds_dst):"memory");}
#define SBAR() __builtin_amdgcn_sched_barrier(0)
#define WAIT_BAR(N) asm volatile("s_waitcnt vmcnt(" #N ") lgkmcnt(0)\n\ts_barrier":::"memory")
template<int MODE, int THRL> __device__ __forceinline__ void attn_unit_t(const bf16* Qw0, const bf16* __restrict__ Kb, const bf16* __restrict__ Vb, const int NT, const int qoff,
                                                                         bf16* Ob, long ostride, float* lse, long lstride, char* shm) {
  const int tid=threadIdx.x,lane=tid&63,r32=lane&31,hi=lane>>5; const int wid=__builtin_amdgcn_readfirstlane(tid>>6);
  const unsigned lds0=(unsigned)(uintptr_t)shm;
  float*wsf=(float*)(shm+T_WS)+wid*64;
  typedef __attribute__((address_space(3))) const float* lds_f;
  const lds_f Fl=(lds_f)(shm+T_F)+((MODE==1)?qoff:0);
  const unsigned koff_=(unsigned)(lane*128+wid*16), voff_=(unsigned)((16*(wid&3)+(lane>>2))*128+(wid>>2)*64+(lane&3)*16);
  #define KOFF() koff_
  #define VOFF() voff_
  const unsigned kdst=lds0+T_K+wid*1024, vdst=lds0+T_V+wid*1024;
  #define DMA_K(t,slot) glds16s(KOFF(),(const char*)Kb+(long)(t)*8192,(unsigned)__builtin_amdgcn_readfirstlane(kdst+(slot)))
  #define DMA_V(t,slot) glds16s(VOFF(),(const char*)Vb+(long)(t)*8192,(unsigned)__builtin_amdgcn_readfirstlane(vdst+(slot)))
  const char*Kbase=shm+T_K; bf16x8 kf[8];
  const lds_cptr shm3=(lds_cptr)shm; const lds_cptr kp0=shm3+T_K+hi*1024+r32*16; const lds_cptr vp0=shm3+T_V+((lane>>4)&1)*32+(lane&3)*8+(4*hi+((lane&15)>>2))*64;
  DMA_K(0,0);DMA_V(0,0);DMA_K(1,SLOTB);
  bf16x8 qr[4];
  { const bf16*Qw=Qw0+(long)(wid*32)*64;
    #pragma unroll
    for(int d0=0;d0<4;++d0)qr[d0]=*reinterpret_cast<const bf16x8*>(&Qw[(long)r32*64+d0*16+hi*8]); }
  float mhat=0.f,l_reg=0.f;f32x16 o[2];o[0]=f32x16{};o[1]=f32x16{};
  const int qrel=wid*32+r32;
  const int qpos=(MODE>=1)?(64*(NT-4)+qrel):(qoff+qrel);
  #define FQ() ((MODE==1)?Fl[64*(NT-4)+wid*32+r32]:0.f)
  const int jb0=384-qpos+4*hi;
  #define CINIT(C0,C1,t,MASKED) do{ \
    if(MODE==2){ _Pragma("unroll") for(int r=0;r<16;++r){ C0[r]=-mhat; C1[r]=-mhat; } \
      if(MASKED){ const int jb_=(t)-(NT-4); if(jb_>=0){ const int kb_=64*jb_+4*hi; \
        _Pragma("unroll") for(int r=0;r<16;++r){ const int kv_=kb_+(r&3)+8*(r>>2); if(kv_>qrel)C0[r]=-INFINITY; if(kv_+32>qrel)C1[r]=-INFINITY; } } } \
    } else if(MODE==1){ const float fqm=FQ()-mhat; const lds_f fp_=Fl+64*(t)+4*hi; \
      _Pragma("unroll") for(int g4=0;g4<4;++g4){ const f32x4 a_=*(const __attribute__((address_space(3))) f32x4*)(fp_+8*g4), b_=*(const __attribute__((address_space(3))) f32x4*)(fp_+32+8*g4); \
        _Pragma("unroll") for(int i_=0;i_<4;++i_){ C0[4*g4+i_]=fqm-a_[i_]; C1[4*g4+i_]=fqm-b_[i_]; } } \
      if(MASKED){ const int jb_=(t)-(NT-4); if(jb_>=0){ const int kb_=64*jb_+4*hi; \
        _Pragma("unroll") for(int r=0;r<16;++r){ const int kv_=kb_+(r&3)+8*(r>>2); if(kv_>qrel)C0[r]=-INFINITY; if(kv_+32>qrel)C1[r]=-INFINITY; } } } \
    } else { const lds_f tp_=Fl+jb0+64*(t); \
      _Pragma("unroll") for(int r=0;r<16;++r){ C0[r]=tp_[(r&3)+8*(r>>2)]-mhat; C1[r]=tp_[32+(r&3)+8*(r>>2)]-mhat; } } \
  }while(0)
  bool resc=false;
  #define START(P0,P1) do{ const float rm=rowmax(P0,P1); resc=false; \
    { const float dl=(rm==-INFINITY)?0.f:rm; mhat=fadd_s(mhat,dl); \
      _Pragma("unroll") for(int r=0;r<16;++r){P0[r]=fsub_s(P0[r],dl);P1[r]=fsub_s(P1[r],dl);} } \
    _Pragma("unroll") for(int r=0;r<16;++r)P0[r]=__builtin_amdgcn_exp2f(P0[r]); }while(0)
  #define RESC() do{ if(resc){ asm volatile("s_waitcnt lgkmcnt(0)":::"memory"); \
      _Pragma("unroll") for(int d_=0;d_<2;++d_) _Pragma("unroll") for(int r=0;r<16;++r)o[d_][r]*=wsf[crow(r,hi)]; } }while(0)
  f32x16 pA0,pA1,pB0,pB1;
  int sl_prev=0,sl_cur=0,sl_next=SLOTB;
  #define ROT() do{sl_prev=sl_cur;sl_cur=sl_next;sl_next=(sl_next==(NSLOT-1)*SLOTB)?0:sl_next+SLOTB;}while(0)
  DMA_K(2,2*SLOTB);
  WAIT_BAR(3);
  CINIT(pA0,pA1,0,true);
  qkt2(pA0,pA1,Kbase,qr,pA0,pA1,r32,hi);asm volatile("s_nop 15\n\ts_nop 7":"+v"(pA0),"+v"(pA1));
  START(pA0,pA1);
  _Pragma("unroll") for(int r=0;r<16;++r)pA1[r]=__builtin_amdgcn_exp2f(pA1[r]);
  WAIT_BAR(0);
  DMA_K(3,0);DMA_V(1,SLOTB);
  ROT();
  kload8(kf,kp0+sl_cur);
  WAIT_BAR(2);
  s16x4 vlo[8],vhi[8]; u32x4 pw0,pw1,pw2,pw3;
  #define PKW(P,B) cvtpk_s(P[B],P[B+1])
  #define PAF(k) __builtin_bit_cast(bf16x8,pw##k)
  #define VFR(i) (bf16x8){vlo[i][0],vlo[i][1],vlo[i][2],vlo[i][3],vhi[i][0],vhi[i][1],vhi[i][2],vhi[i][3]}
  #define PIN(x) asm volatile("":"+v"(x))
  #define MX3(a,b,c) __builtin_fmaxf(__builtin_fmaxf((a),(b)),(c))
  #define GAPA(MF,A0,A1,A2,A3,W0,W1,PW) do{ MF; sacc+=A0; sacc+=A1; sacc+=A2; sacc+=A3; PIN(sacc); W0; W1; PIN(PW); SBAR(); }while(0)
  #define EX(v) __builtin_amdgcn_exp2f(v)
  #define GAPB(MF,X,B) do{ MF; X[B]=EX(X[B]); X[B+1]=EX(X[B+1]); X[B+2]=EX(X[B+2]); X[B+3]=EX(X[B+3]); PIN(X); SBAR(); }while(0)
  #define VRD(i) do{ vlo[i]=vtr(vp_+(((i)>>2)*4096+((i)&3)*1024)); vhi[i]=vtr(vp_+(((i)>>2)*4096+((i)&3)*1024+512)); }while(0)
  #define KRD(G,j) do{ if(G){ kload2(kf,kp0+sl_next,j); SBAR(); } }while(0)
  #define STEP(C0,C1,P0,P1,t,GK,GV,GL,MASKED) do{ SBAR(); \
    CINIT(C0,C1,t,MASKED); \
    const lds_cptr vp_=vp0+sl_prev; \
    VRD(0); SBAR(); float sacc=(P0[0]+P0[1]); \
    GAPA(C0=__builtin_amdgcn_mfma_f32_32x32x16_bf16(kf[0],qr[0],C0,0,0,0), P0[2],P0[3],P0[4],P0[5],     pw0[0]=PKW(P0,0), pw0[1]=PKW(P0,2), pw0); \
    VRD(4); SBAR(); GAPA(C1=__builtin_amdgcn_mfma_f32_32x32x16_bf16(kf[1],qr[0],C1,0,0,0), P0[6],P0[7],P0[8],P0[9],     pw0[2]=PKW(P0,4), pw0[3]=PKW(P0,6), pw0); \
    VRD(1); SBAR(); GAPA(C0=__builtin_amdgcn_mfma_f32_32x32x16_bf16(kf[2],qr[1],C0,0,0,0),   P0[10],P0[11],P0[12],P0[13], pw1[0]=PKW(P0,8), pw1[1]=PKW(P0,10), pw1); \
    VRD(5); SBAR(); GAPA(C1=__builtin_amdgcn_mfma_f32_32x32x16_bf16(kf[3],qr[1],C1,0,0,0),   P0[14],P0[15],P1[0],P1[1],   pw1[2]=PKW(P0,12),pw1[3]=PKW(P0,14), pw1); \
    VRD(2); SBAR(); GAPA(C0=__builtin_amdgcn_mfma_f32_32x32x16_bf16(kf[4],qr[2],C0,0,0,0),   P1[2],P1[3],P1[4],P1[5],     pw2[0]=PKW(P1,0), pw2[1]=PKW(P1,2), pw2); \
    VRD(6); SBAR(); GAPA(C1=__builtin_amdgcn_mfma_f32_32x32x16_bf16(kf[5],qr[2],C1,0,0,0),   P1[6],P1[7],P1[8],P1[9],     pw2[2]=PKW(P1,4), pw2[3]=PKW(P1,6), pw2); \
    VRD(3); SBAR(); GAPA(C0=__builtin_amdgcn_mfma_f32_32x32x16_bf16(kf[6],qr[3],C0,0,0,0),   P1[10],P1[11],P1[12],P1[13], pw3[0]=PKW(P1,8), pw3[1]=PKW(P1,10), pw3); \
    VRD(7); SBAR(); GAPA(C1=__builtin_amdgcn_mfma_f32_32x32x16_bf16(kf[7],qr[3],C1,0,0,0),   P1[14],P1[15],0.f,0.f,       pw3[2]=PKW(P1,12),pw3[3]=PKW(P1,14), pw3); \
    l_reg+=sacc; \
    if(GK){DMA_K((t)+3,sl_cur);} if(GV){DMA_V((t)+1,sl_next);} \
    { float a=MX3(C0[0],C0[1],C1[0]),b=MX3(C0[2],C0[3],C1[1]); a=MX3(a,C1[2],C1[3]); \
      _Pragma("unroll") for(int r=4;r<16;r+=4){a=MX3(a,C0[r],C0[r+1]);b=MX3(b,C0[r+2],C0[r+3]);a=MX3(a,C1[r],C1[r+1]);b=MX3(b,C1[r+2],C1[r+3]);} \
      float rm=__builtin_fmaxf(a,b); { auto rr=__builtin_amdgcn_permlane32_swap(__float_as_uint(rm),__float_as_uint(rm),false,false); rm=__builtin_fmaxf(__uint_as_float(rr[0]),__uint_as_float(rr[1])); } \
      resc=false; \
      if(__builtin_expect(__any(rm>(float)THRL),0)){ const float dl=__builtin_fmaxf(rm,0.f); mhat+=dl; \
        _Pragma("unroll") for(int r=0;r<16;++r){C0[r]-=dl;C1[r]-=dl;} \
        const float f=__builtin_amdgcn_exp2f(-dl); l_reg*=f; if(hi==0)wsf[r32]=f; resc=true; } } \
    SBAR(); \
    GAPB(o[0]=__builtin_amdgcn_mfma_f32_32x32x16_bf16(PAF(0),VFR(0),o[0],0,0,0), C0,0); \
    GAPB(o[1]=__builtin_amdgcn_mfma_f32_32x32x16_bf16(PAF(0),VFR(4),o[1],0,0,0), C0,4); \
    KRD(GL,0); GAPB(o[0]=__builtin_amdgcn_mfma_f32_32x32x16_bf16(PAF(1),VFR(1),o[0],0,0,0), C0,8); \
    KRD(GL,1); GAPB(o[1]=__builtin_amdgcn_mfma_f32_32x32x16_bf16(PAF(1),VFR(5),o[1],0,0,0), C0,12); \
    KRD(GL,2); GAPB(o[0]=__builtin_amdgcn_mfma_f32_32x32x16_bf16(PAF(2),VFR(2),o[0],0,0,0), C1,0); \
    KRD(GL,3); GAPB(o[1]=__builtin_amdgcn_mfma_f32_32x32x16_bf16(PAF(2),VFR(6),o[1],0,0,0), C1,4); \
    GAPB(o[0]=__builtin_amdgcn_mfma_f32_32x32x16_bf16(PAF(3),VFR(3),o[0],0,0,0), C1,8); \
    GAPB(o[1]=__builtin_amdgcn_mfma_f32_32x32x16_bf16(PAF(3),VFR(7),o[1],0,0,0), C1,12); \
    }while(0)
  int t=1;
  for(;t+5<NT;t+=2){
    STEP(pB0,pB1,pA0,pA1,t,true,true,true,false);     WAIT_BAR(2); RESC(); ROT();
    STEP(pA0,pA1,pB0,pB1,t+1,true,true,true,false);   WAIT_BAR(2); RESC(); ROT();
  }
  #define ENDW(tt) do{ if((tt)+3<NT){WAIT_BAR(2);} else if((tt)+2<NT){WAIT_BAR(1);} else {WAIT_BAR(0);} }while(0)
  for(;t+1<NT;t+=2){
    STEP(pB0,pB1,pA0,pA1,t,(t+3<NT),(t+1<NT),(t+1<NT),true);       ENDW(t);   RESC(); ROT();
    STEP(pA0,pA1,pB0,pB1,t+1,(t+4<NT),(t+2<NT),(t+2<NT),true);     ENDW(t+1); RESC(); ROT();
  }
  STEP(pB0,pB1,pA0,pA1,NT-1,false,false,false,true); RESC();
  { float sacc=pB0[0]+pB0[1]; _Pragma("unroll") for(int r=2;r<16;++r)sacc+=pB0[r]; _Pragma("unroll") for(int r=0;r<16;++r)sacc+=pB1[r]; l_reg+=sacc;
    pw0=(u32x4){PKW(pB0,0),PKW(pB0,2),PKW(pB0,4),PKW(pB0,6)};pw1=(u32x4){PKW(pB0,8),PKW(pB0,10),PKW(pB0,12),PKW(pB0,14)};pw2=(u32x4){PKW(pB1,0),PKW(pB1,2),PKW(pB1,4),PKW(pB1,6)};pw3=(u32x4){PKW(pB1,8),PKW(pB1,10),PKW(pB1,12),PKW(pB1,14)};
    int ln_=lane; asm volatile("":"+v"(ln_)); const int hi_=ln_>>5; const int vb0=(int)(lds0+T_V)+((ln_>>4)&1)*32+(ln_&3)*8+(4*hi_+((ln_&15)>>2))*64;
    SBAR(); pv(o,vb0+sl_cur,PAF(0),PAF(1),PAF(2),PAF(3)); }
  #undef PKW
  #undef PAF
  #undef VFR
  #undef PIN
  #undef MX3
  #undef GAPA
  #undef GAPB
  #undef EX
  #undef VRD
  #undef KRD
  #undef STEP
  #undef ENDW
  #undef CINIT
  {auto rr=__builtin_amdgcn_permlane32_swap(__float_as_uint(l_reg),__float_as_uint(l_reg),false,false);l_reg=__uint_as_float(rr[0])+__uint_as_float(rr[1]);}
  int r32e=r32,hie=hi; asm volatile("":"+v"(r32e),"+v"(hie));
  if(hie==0){ wsf[32+r32e]=l_reg; if(MODE==0) lse[(long)(wid*32+r32e)*lstride]=mhat+__builtin_amdgcn_logf(l_reg); }
  asm volatile("s_waitcnt lgkmcnt(0)":::"memory");
  float rli[16];
  #pragma unroll
  for(int r=0;r<16;++r)rli[r]=__builtin_amdgcn_rcpf(wsf[32+crow(r,hie)]);
  { bf16*stg=(bf16*)(shm+T_OST)+wid*2048;
    #pragma unroll
    for(int r=0;r<16;++r){const int orow=crow(r,hie);
      #pragma unroll
      for(int d0=0;d0<2;++d0)stg[orow*64+d0*32+r32e]=__float2bfloat16(o[d0][r]*rli[r]);}
    asm volatile("s_waitcnt lgkmcnt(0)":::"memory");
    bf16*Ow=Ob+(long)(wid*32)*ostride;
    int le_=lane; asm volatile("":"+v"(le_));
    #pragma unroll
    for(int i=0;i<4;++i){const int row=i*8+(le_>>3),ch=le_&7; const u32x4 v=*(const u32x4*)(stg+row*64+ch*8);
      if(WO_FP8&&MODE==1){ typedef unsigned u32x2o __attribute__((ext_vector_type(2))); u32x2o w8;
        w8.x=pg8::pk4_fp8(__uint_as_float(v.x<<16),__uint_as_float(v.x&0xffff0000u),__uint_as_float(v.y<<16),__uint_as_float(v.y&0xffff0000u));
        w8.y=pg8::pk4_fp8(__uint_as_float(v.z<<16),__uint_as_float(v.z&0xffff0000u),__uint_as_float(v.w<<16),__uint_as_float(v.w&0xffff0000u));
        *(u32x2o*)((unsigned char*)Ob+(long)(wid*32+row)*ostride+ch*8)=w8; }
      else *(u32x4*)(Ow+(long)row*ostride+ch*8)=v;} }
  asm volatile("s_waitcnt lgkmcnt(0)\n\ts_barrier":::"memory");
  #undef DMA_K
  #undef DMA_V
  #undef KOFF
  #undef FQ
  #undef VOFF
  #undef START
  #undef RESC
  #undef ROT
}
#undef SBAR
#undef WAIT_BAR
}

namespace attn_body {
constexpr int B_V = 0, B_VBUF = 49152, B_K = B_VBUF, B_WS = 2 * B_VBUF, B_OST = B_WS + 2048, B_TAB = B_OST + 32768, B_END = B_TAB + 2 * 1024;
struct BandUnit { const bf16* Q; const bf16* K; const bf16* V; bf16* O; float* L; const float* tab; int q0; int sh; };
__device__ __forceinline__ void band_decode(int L, BandUnit& u, const bf16* QKV, bf16* OG, float* LSE, const float* BT) {
    const int tri = L >> 4, u16 = L & 15, b = tri / 48, gh = tri % 48, g = gh >> 4, h = gh & 15;
    const int sh = 2 * g, Ls = 4096 >> sh;
    const int r = (g == 0) ? 0 : (g == 1 ? (u16 >> 2) : u16), uq = (g == 0) ? u16 : (g == 1 ? (u16 & 3) : 0);
    const size_t pl = (size_t)((b * 3 + g) * 3) * 16 + h;
    u.Q = QKV + (pl * 4096 + (size_t)r * Ls) * 64; u.K = u.Q + (size_t)16 * 4096 * 64; u.V = u.Q + (size_t)32 * 4096 * 64;
    const size_t tok0 = (size_t)b * 4096 + r;
    u.O = OG + ((size_t)g * 32768 + tok0) * 1024 + h * 64; u.L = LSE + ((size_t)g * 32768 + tok0) * 16 + h;
    u.tab = BT + gh * 132; u.q0 = uq * 256; u.sh = sh;
}
__device__ __forceinline__ void band_issue_v(const BandUnit& u, unsigned lds0, int lane, int wid) {
    const unsigned voff = (unsigned)((16 * (wid & 3) + (lane >> 2)) * 128 + (wid >> 2) * 64 + (lane & 3) * 16);
    const int w0 = u.q0 - 128;
    #pragma unroll
    for (int t = 0; t < 6; ++t) { const int k0 = w0 + 64 * t;
        if (k0 >= 0) glds16s(voff, (const char*)u.V + (long)k0 * 128, (unsigned)__builtin_amdgcn_readfirstlane(lds0 + B_V + t * 8192 + wid * 1024)); }
}
__device__ __forceinline__ void band_issue_k(const BandUnit& u, int tbuf, unsigned lds0, int tid, int lane, int wid) {
    const unsigned koff = (unsigned)(lane * 128 + wid * 16);
    const int w0 = u.q0 - 128;
    #pragma unroll
    for (int t = 0; t < 6; ++t) { const int k0 = w0 + 64 * t;
        if (k0 >= 0) glds16s(koff, (const char*)u.K + (long)k0 * 128, (unsigned)__builtin_amdgcn_readfirstlane(lds0 + B_K + t * 8192 + wid * 1024)); }
    if (tid < 192) { __attribute__((address_space(3))) float* tb = (__attribute__((address_space(3))) float*)(uintptr_t)(lds0 + B_TAB + tbuf * 1024);
        tb[tid] = (tid >= 32 && tid <= 160) ? u.tab[tid - 32] : -INFINITY; }
}
template <int VAR> __device__ __forceinline__ void band_phase(const bf16* QKV, bf16* OG, float* LSE, const float* BT, int first, int step, int NU, char* shm) {
    const int tid = threadIdx.x, lane = tid & 63, r32 = lane & 31, hi = lane >> 5; const int wid = __builtin_amdgcn_readfirstlane(tid >> 6);
    const unsigned lds0 = (unsigned)(uintptr_t)shm;
    float* wsf = (float*)(shm + B_WS) + wid * 64;
    typedef __attribute__((address_space(3))) const float* lds_f;
    BandUnit cur, nxt;
    int L = first, buf = 0;
#define BAND_LOADQ(U) do { const bf16* Qw_ = (U).Q + (long)((U).q0 + 32 * wid) * 64; \
        _Pragma("unroll") for (int d0 = 0; d0 < 4; ++d0) qn[d0] = *reinterpret_cast<const bf16x8*>(&Qw_[(long)r32 * 64 + d0 * 16 + hi * 8]); } while (0)
    bf16x8 qn[4];
    #pragma unroll
    for (int d0 = 0; d0 < 4; ++d0) qn[d0] = (bf16x8){0, 0, 0, 0, 0, 0, 0, 0};
    if (L < NU) { band_decode(L, cur, QKV, OG, LSE, BT); band_issue_k(cur, 0, lds0, tid, lane, wid); BAND_LOADQ(cur); }
    for (; L < NU; L += step, buf ^= 1) {
        const bool has_next = (L + step) < NU;
        if (has_next) band_decode(L + step, nxt, QKV, OG, LSE, BT); else nxt = cur;
        const int qw = cur.q0 + 32 * wid;
        const int jlo = (qw >= 128) ? 0 : ((128 - qw) >> 5);
        if (L == first) asm volatile("s_waitcnt vmcnt(0) lgkmcnt(0)\n\ts_barrier" ::: "memory");
        else asm volatile("s_waitcnt vmcnt(5) lgkmcnt(0)\n\ts_barrier" ::: "memory");
        bf16x8 qr[4];
        #pragma unroll
        for (int d0 = 0; d0 < 4; ++d0) qr[d0] = qn[d0];
        band_issue_v(cur, lds0, lane, wid);
        f32x16 S[5];
        { const lds_f tb = (lds_f)(uintptr_t)(lds0 + B_TAB + buf * 1024) + (5 + r32 - 4 * hi);
          #pragma unroll
          for (int j = 0; j < 5; ++j) {
              #pragma unroll
              for (int r = 0; r < 16; ++r) S[j][r] = (VAR == 2) ? 0.f : ((j >= jlo) ? tb[(128 - 32 * j) + 27 - ((r & 3) + 8 * (r >> 2))] : -INFINITY);
              if (VAR != 2 && j >= jlo) { const int wj = wid + j;
                  const __attribute__((address_space(3))) char* kp = (const __attribute__((address_space(3))) char*)(uintptr_t)(lds0 + B_K + (wj >> 1) * 8192 + hi * 1024 + ((wj & 1) * 32 + r32) * 16);
                  #pragma unroll
                  for (int d0 = 0; d0 < 4; ++d0) { const bf16x8 kf = *(const __attribute__((address_space(3))) bf16x8*)(kp + d0 * 2048);
                      S[j] = __builtin_amdgcn_mfma_f32_32x32x16_bf16(kf, qr[d0], S[j], 0, 0, 0); } } } }
        asm volatile("s_waitcnt vmcnt(0) lgkmcnt(0)\n\ts_barrier" ::: "memory");
        if (has_next) { band_issue_k(nxt, buf ^ 1, lds0, tid, lane, wid); BAND_LOADQ(nxt); }
        float mx = -INFINITY;
        #pragma unroll
        for (int j = 0; j < 5; ++j)
            #pragma unroll
            for (int r = 0; r < 16; ++r) mx = fmaxf(mx, S[j][r]);
        { auto rr = __builtin_amdgcn_permlane32_swap(__float_as_uint(mx), __float_as_uint(mx), false, false); mx = fmaxf(__uint_as_float(rr[0]), __uint_as_float(rr[1])); }
        float lsum = 0.f; u32x4 pw[5][2];
        #pragma unroll
        for (int j = 0; j < 5; ++j) {
            #pragma unroll
            for (int r = 0; r < 16; ++r) { if (VAR != 3) S[j][r] = __builtin_amdgcn_exp2f(S[j][r] - mx); lsum += S[j][r]; }
            pw[j][0] = (u32x4){cvtpk_s(S[j][0], S[j][1]), cvtpk_s(S[j][2], S[j][3]), cvtpk_s(S[j][4], S[j][5]), cvtpk_s(S[j][6], S[j][7])};
            pw[j][1] = (u32x4){cvtpk_s(S[j][8], S[j][9]), cvtpk_s(S[j][10], S[j][11]), cvtpk_s(S[j][12], S[j][13]), cvtpk_s(S[j][14], S[j][15])}; }
        { auto rr = __builtin_amdgcn_permlane32_swap(__float_as_uint(lsum), __float_as_uint(lsum), false, false); lsum = __uint_as_float(rr[0]) + __uint_as_float(rr[1]); }
        f32x16 o[2]; o[0] = f32x16{}; o[1] = f32x16{};
        const int vlane = ((lane >> 4) & 1) * 32 + (lane & 3) * 8 + (4 * hi + ((lane & 15) >> 2)) * 64;
        #pragma unroll
        for (int j = 0; j < 5; ++j) if (VAR != 1 && j >= jlo) {
            const int wj = wid + j;
            const int vb = (int)(lds0 + B_V) + (wj >> 1) * 8192 + (wj & 1) * 2048 + vlane;
            s16x4 l0[2], h0[2], l1[2], h1[2];
            #pragma unroll
            for (int d0 = 0; d0 < 2; ++d0) {
                asm volatile("ds_read_b64_tr_b16 %0,%1 offset:%c2" : "=&v"(l0[d0]) : "v"(vb), "i"(d0 * 4096) : "memory");
                asm volatile("ds_read_b64_tr_b16 %0,%1 offset:%c2" : "=&v"(h0[d0]) : "v"(vb), "i"(d0 * 4096 + 512) : "memory");
                asm volatile("ds_read_b64_tr_b16 %0,%1 offset:%c2" : "=&v"(l1[d0]) : "v"(vb), "i"(d0 * 4096 + 1024) : "memory");
                asm volatile("ds_read_b64_tr_b16 %0,%1 offset:%c2" : "=&v"(h1[d0]) : "v"(vb), "i"(d0 * 4096 + 1536) : "memory"); }
            asm volatile("s_waitcnt lgkmcnt(0)" : "+v"(l0[0]), "+v"(h0[0]), "+v"(l1[0]), "+v"(h1[0]), "+v"(l0[1]), "+v"(h0[1]), "+v"(l1[1]), "+v"(h1[1]) :: "memory"); __builtin_amdgcn_sched_barrier(0);
            #pragma unroll
            for (int d0 = 0; d0 < 2; ++d0) {
                o[d0] = __builtin_amdgcn_mfma_f32_32x32x16_bf16(__builtin_bit_cast(bf16x8, pw[j][0]), (bf16x8){l0[d0][0], l0[d0][1], l0[d0][2], l0[d0][3], h0[d0][0], h0[d0][1], h0[d0][2], h0[d0][3]}, o[d0], 0, 0, 0);
                o[d0] = __builtin_amdgcn_mfma_f32_32x32x16_bf16(__builtin_bit_cast(bf16x8, pw[j][1]), (bf16x8){l1[d0][0], l1[d0][1], l1[d0][2], l1[d0][3], h1[d0][0], h1[d0][1], h1[d0][2], h1[d0][3]}, o[d0], 0, 0, 0); } }
        const long ostride = 1024L << cur.sh, lstride = 16L << cur.sh;
        if (hi == 0) { wsf[32 + r32] = lsum; cur.L[(long)(qw + r32) * lstride] = mx + __builtin_amdgcn_logf(lsum); }
        asm volatile("s_waitcnt lgkmcnt(0)" ::: "memory");
        float rli[16];
        #pragma unroll
        for (int r = 0; r < 16; ++r) rli[r] = __builtin_amdgcn_rcpf(wsf[32 + crow(r, hi)]);
        { bf16* stg = (bf16*)(shm + B_OST) + wid * 2048;
          #pragma unroll
          for (int r = 0; r < 16; ++r) { const int orow = crow(r, hi);
            #pragma unroll
            for (int d0 = 0; d0 < 2; ++d0) stg[orow * 64 + d0 * 32 + r32] = __float2bfloat16(o[d0][r] * rli[r]); }
          asm volatile("s_waitcnt lgkmcnt(0)" ::: "memory");
          bf16* Ow = cur.O + (long)qw * ostride;
          #pragma unroll
          for (int i = 0; i < 4; ++i) { const int row = i * 8 + (lane >> 3), ch = lane & 7; const u32x4 v = *(const u32x4*)(stg + row * 64 + ch * 8); *(u32x4*)(Ow + (long)row * ostride + ch * 8) = v; } }
        cur = nxt;
    }
    asm volatile("s_waitcnt vmcnt(0) lgkmcnt(0)\n\ts_barrier" ::: "memory");
#undef BAND_LOADQ
}
}

namespace attn_body {
typedef int i32x8b __attribute__((ext_vector_type(8)));
typedef int i32x4b __attribute__((ext_vector_type(4)));
typedef int i32x2b __attribute__((ext_vector_type(2)));
constexpr int C_KV = 0, C_KVBUF = 49152  , C_WS = 2 * C_KVBUF, C_OST = C_WS + 2048, C_TAB = C_OST + 32768, C_END = C_TAB + 2 * 1024;
struct Band8Unit { const unsigned char* Q; const unsigned char* K; const unsigned char* V; bf16* O; float* L; const float* tab; int q0; int sh; };
__device__ __forceinline__ void band8_decode(int L, Band8Unit& u, const unsigned char* QKV, bf16* OG, float* LSE, const float* BT) {
    const int tri = L >> 4, u16 = L & 15, b = tri / 48, gh = tri % 48, g = gh >> 4, h = gh & 15;
    const int sh = 2 * g, Ls = 4096 >> sh;
    const int r = (g == 0) ? 0 : (g == 1 ? (u16 >> 2) : u16), uq = (g == 0) ? u16 : (g == 1 ? (u16 & 3) : 0);
    const size_t pl = (size_t)((b * 3 + g) * 3) * 16 + h;
    u.Q = QKV + (pl * 4096 + (size_t)r * Ls) * 64; u.K = u.Q + (size_t)16 * 4096 * 64; u.V = u.Q + (size_t)32 * 4096 * 64;
    const size_t tok0 = (size_t)b * 4096 + r;
    u.O = OG + ((size_t)g * 32768 + tok0) * 1024 + h * 64; u.L = LSE + ((size_t)g * 32768 + tok0) * 16 + h;
    u.tab = BT + gh * 132; u.q0 = uq * 256; u.sh = sh;
}
__device__ __forceinline__ void band8_issue(const Band8Unit& u, int b, unsigned lds0, int tid, int lane, int wid) {
    const unsigned lane64 = (unsigned)lane * 64u;
    const int w0 = u.q0 - 128;
    #pragma unroll
    for (int i = 0; i < 3; ++i) { const int p = wid * 3 + i, k0 = w0 + 64 * (p >> 2);
        if (k0 >= 0) { const long go = (long)k0 * 64 + (p & 3) * 16;
            glds16s(lane64, (const char*)u.K + go, (unsigned)__builtin_amdgcn_readfirstlane(lds0 + C_KV + b * C_KVBUF + p * 1024));
            glds16s(lane64, (const char*)u.V + go, (unsigned)__builtin_amdgcn_readfirstlane(lds0 + C_KV + b * C_KVBUF + 24576 + p * 1024)); } }
    if (tid < 192) { __attribute__((address_space(3))) float* tb = (__attribute__((address_space(3))) float*)(uintptr_t)(lds0 + C_TAB + b * 1024);
        tb[tid] = (tid >= 32 && tid <= 160) ? u.tab[tid - 32] : -INFINITY; }
}
__device__ __forceinline__ unsigned pk4_e4m3(float a, float b, float c, float d) { int v = __builtin_amdgcn_cvt_pk_fp8_f32(a, b, 0, false); v = __builtin_amdgcn_cvt_pk_fp8_f32(c, d, v, true); return (unsigned)v; }
template <int VAR> __device__ __forceinline__ void band8_phase(const unsigned char* QKV, bf16* OG, float* LSE, const float* BT, int first, int step, int NU, char* shm) {
    const int tid = threadIdx.x, lane = tid & 63, r32 = lane & 31, hi = lane >> 5; const int wid = __builtin_amdgcn_readfirstlane(tid >> 6);
    const unsigned lds0 = (unsigned)(uintptr_t)shm;
    float* wsf = (float*)(shm + C_WS) + wid * 64;
    typedef __attribute__((address_space(3))) const float* lds_f;
    typedef __attribute__((address_space(3))) const i32x4b* lds_q;
    Band8Unit cur, nxt;
    int L = first, buf = 0;
#define BAND8_LOADQ(U) do { const unsigned char* Qw_ = (U).Q + (long)((U).q0 + 32 * wid + r32) * 64 + hi * 32; \
        qn[0] = *reinterpret_cast<const i32x4b*>(Qw_); qn[1] = *reinterpret_cast<const i32x4b*>(Qw_ + 16); } while (0)
    i32x4b qn[2]; qn[0] = (i32x4b){0, 0, 0, 0}; qn[1] = qn[0];
    if (L < NU) { band8_decode(L, cur, QKV, OG, LSE, BT); band8_issue(cur, 0, lds0, tid, lane, wid); BAND8_LOADQ(cur); }
    const int vlane8 = ((lane >> 4) & 1) * 1024 + ((((lane & 15) >> 3) & 1) * 8 + (((lane & 15) >> 1) & 3) + 4 * hi) * 16 + (lane & 1) * 8;
    for (; L < NU; L += step, buf ^= 1) {
        const bool has_next = (L + step) < NU;
        if (has_next) band8_decode(L + step, nxt, QKV, OG, LSE, BT); else nxt = cur;
        const int qw = cur.q0 + 32 * wid;
        const int jlo = (qw >= 128) ? 0 : ((128 - qw) >> 5);
        if (L == first) asm volatile("s_waitcnt vmcnt(0) lgkmcnt(0)\n\ts_barrier" ::: "memory");
        else asm volatile("s_waitcnt vmcnt(5) lgkmcnt(0)\n\ts_barrier" ::: "memory");
        const i32x8b qf = (i32x8b){qn[0][0], qn[0][1], qn[0][2], qn[0][3], qn[1][0], qn[1][1], qn[1][2], qn[1][3]};
        if (has_next) { band8_issue(nxt, buf ^ 1, lds0, tid, lane, wid); BAND8_LOADQ(nxt); }
        const unsigned kvb = lds0 + C_KV + buf * C_KVBUF;
        f32x16 S[5];
        { const lds_f tb = (lds_f)(uintptr_t)(lds0 + C_TAB + buf * 1024) + (5 + r32 - 4 * hi);
          #pragma unroll
          for (int j = 0; j < 5; ++j) {
              #pragma unroll
              for (int r = 0; r < 16; ++r) S[j][r] = (j >= jlo) ? tb[(128 - 32 * j) + 27 - ((r & 3) + 8 * (r >> 2))] : -INFINITY;
              if (j >= jlo) { const int wj = wid + j;
                  const lds_q kp = (lds_q)(uintptr_t)(kvb + (wj >> 1) * 4096 + hi * 2048 + ((wj & 1) * 32 + r32) * 16);
                  const i32x4b k0 = kp[0], k1 = kp[64];
                  S[j] = __builtin_amdgcn_mfma_scale_f32_32x32x64_f8f6f4((i32x8b){k0[0], k0[1], k0[2], k0[3], k1[0], k1[1], k1[2], k1[3]}, qf, S[j], 0, 0, 0, 0, 0, 0); } } }
        float mx = -INFINITY;
        #pragma unroll
        for (int j = 0; j < 5; ++j)
            #pragma unroll
            for (int r = 0; r < 16; ++r) mx = fmaxf(mx, S[j][r]);
        { auto rr = __builtin_amdgcn_permlane32_swap(__float_as_uint(mx), __float_as_uint(mx), false, false); mx = fmaxf(__uint_as_float(rr[0]), __uint_as_float(rr[1])); }
        const float mxs = mx - 7.f;
        float lsum = 0.f; unsigned pw[5][4];
        #pragma unroll
        for (int j = 0; j < 5; ++j) {
            #pragma unroll
            for (int r = 0; r < 16; ++r) { S[j][r] = __builtin_amdgcn_exp2f(S[j][r] - mxs); lsum += S[j][r]; }
            #pragma unroll
            for (int q4 = 0; q4 < 4; ++q4) pw[j][q4] = pk4_e4m3(S[j][4 * q4], S[j][4 * q4 + 1], S[j][4 * q4 + 2], S[j][4 * q4 + 3]); }
        { auto rr = __builtin_amdgcn_permlane32_swap(__float_as_uint(lsum), __float_as_uint(lsum), false, false); lsum = __uint_as_float(rr[0]) + __uint_as_float(rr[1]); }
        f32x16 o[2]; o[0] = f32x16{}; o[1] = f32x16{};
        i32x2b vf[3][2][4];
        #pragma unroll
        for (int pr = 0; pr < 3; ++pr)
            #pragma unroll
            for (int c = 0; c < (pr == 2 ? 2 : 4); ++c) {
                const int j = 2 * pr + (c >> 1), je = j > jlo ? j : jlo, wj = wid + je;
                const int vb = (int)(kvb + 24576) + (wj >> 1) * 4096 + (wj & 1) * 512 + vlane8;
                asm volatile("ds_read_b64_tr_b8 %0,%1 offset:%c2" : "=&v"(vf[pr][0][c]) : "v"(vb), "i"((c & 1) * 256) : "memory");
                asm volatile("ds_read_b64_tr_b8 %0,%1 offset:%c2" : "=&v"(vf[pr][1][c]) : "v"(vb), "i"(2048 + (c & 1) * 256) : "memory"); }
        asm volatile("s_waitcnt lgkmcnt(0)" : "+v"(vf[0][0][0]), "+v"(vf[0][0][1]), "+v"(vf[0][0][2]), "+v"(vf[0][0][3]), "+v"(vf[0][1][0]), "+v"(vf[0][1][1]), "+v"(vf[0][1][2]), "+v"(vf[0][1][3]),
                     "+v"(vf[1][0][0]), "+v"(vf[1][0][1]), "+v"(vf[1][0][2]), "+v"(vf[1][0][3]), "+v"(vf[1][1][0]), "+v"(vf[1][1][1]), "+v"(vf[1][1][2]), "+v"(vf[1][1][3]),
                     "+v"(vf[2][0][0]), "+v"(vf[2][0][1]), "+v"(vf[2][1][0]), "+v"(vf[2][1][1]) :: "memory"); __builtin_amdgcn_sched_barrier(0);
        #pragma unroll
        for (int pr = 0; pr < 3; ++pr) {
            const i32x8b pa = (pr == 2) ? (i32x8b){(int)pw[4][0], (int)pw[4][1], (int)pw[4][2], (int)pw[4][3], 0, 0, 0, 0}
                                        : (i32x8b){(int)pw[2 * pr][0], (int)pw[2 * pr][1], (int)pw[2 * pr][2], (int)pw[2 * pr][3], (int)pw[2 * pr + 1][0], (int)pw[2 * pr + 1][1], (int)pw[2 * pr + 1][2], (int)pw[2 * pr + 1][3]};
            #pragma unroll
            for (int d0 = 0; d0 < 2; ++d0) {
                const i32x2b v2 = (pr == 2) ? vf[2][d0][0] : vf[pr][d0][2], v3 = (pr == 2) ? vf[2][d0][1] : vf[pr][d0][3];
                o[d0] = __builtin_amdgcn_mfma_scale_f32_32x32x64_f8f6f4(pa, (i32x8b){vf[pr][d0][0][0], vf[pr][d0][0][1], vf[pr][d0][1][0], vf[pr][d0][1][1], v2[0], v2[1], v3[0], v3[1]}, o[d0], 0, 0, 0, 0, 0, 0); } }
        const long ostride = 1024L << cur.sh, lstride = 16L << cur.sh;
        if (hi == 0) { wsf[32 + r32] = lsum; cur.L[(long)(qw + r32) * lstride] = mxs + __builtin_amdgcn_logf(lsum); }
        asm volatile("s_waitcnt lgkmcnt(0)" ::: "memory");
        float rli[16];
        #pragma unroll
        for (int r = 0; r < 16; ++r) rli[r] = __builtin_amdgcn_rcpf(wsf[32 + crow(r, hi)]);
        { bf16* stg = (bf16*)(shm + C_OST) + wid * 2048;
          #pragma unroll
          for (int r = 0; r < 16; ++r) { const int orow = crow(r, hi);
            #pragma unroll
            for (int d0 = 0; d0 < 2; ++d0) stg[orow * 64 + d0 * 32 + r32] = __float2bfloat16(o[d0][r] * rli[r]); }
          asm volatile("s_waitcnt lgkmcnt(0)" ::: "memory");
          bf16* Ow = cur.O + (long)qw * ostride;
          #pragma unroll
          for (int i = 0; i < 4; ++i) { const int row = i * 8 + (lane >> 3), ch = lane & 7; const u32x4 v = *(const u32x4*)(stg + row * 64 + ch * 8); *(u32x4*)(Ow + (long)row * ostride + ch * 8) = v; } }
        cur = nxt;
    }
    asm volatile("s_waitcnt vmcnt(0) lgkmcnt(0)\n\ts_barrier" ::: "memory");
#undef BAND8_LOADQ
}
}
#define XB_TMO      128
#define XB_XCNT(j)  (256  + 64 * (j))
#define XB_XSUB(j)  (1280 + 64 * (j))
#define XB_XGEN(j)  (2304 + 64 * (j))
#define XB_TOP      3328
#define XB_TOPGEN   3392
#define XCD_BAR_WORDS 3456
#define XB_SPIN_CAP (1u << 18)

__device__ __forceinline__ unsigned xb_ld(unsigned* p)              { return __hip_atomic_load(p, __ATOMIC_RELAXED, __HIP_MEMORY_SCOPE_AGENT); }
__device__ __forceinline__ unsigned xb_add(unsigned* p, unsigned v) { return __hip_atomic_fetch_add(p, v, __ATOMIC_RELAXED, __HIP_MEMORY_SCOPE_AGENT); }
__device__ __forceinline__ unsigned xb_xcc_id() { return (unsigned)__builtin_amdgcn_s_getreg((3 << 11) | 20) & 0xFu; }
#define XB_SPIN(cond, bar) do { unsigned _sp = 0; while (cond) { __builtin_amdgcn_s_sleep(1); \
    if ((++_sp & 255u) == 0u) { if (xb_ld(&(bar)[XB_TMO])) break; if (_sp > XB_SPIN_CAP) { atomicAdd(&(bar)[XB_TMO], 1u); break; } } } } while (0)

struct XcdBarrier {
    unsigned* bar; unsigned x;
    volatile LAS unsigned* st;
};

__device__ __forceinline__ XcdBarrier xcd_barrier_post(unsigned* bar, volatile LAS unsigned* st) {
    XcdBarrier b; b.bar = bar; b.x = xb_xcc_id(); b.st = st;
    if (threadIdx.x == 0) (void)xb_add(&bar[XB_XCNT(b.x)], 1u);
    return b;
}
__device__ __forceinline__ void xcd_barrier_complete(unsigned* bar, unsigned x, unsigned& nloc, unsigned& nx) {
    const unsigned G = gridDim.x * gridDim.y * gridDim.z;
    unsigned sum, cnt, mine, sp = 0u;
    for (;;) {
        sum = 0u; cnt = 0u; mine = 0u;
#pragma unroll
        for (unsigned j = 0; j < 16; ++j) { const unsigned c = xb_ld(&bar[XB_XCNT(j)]); sum += c; cnt += (c > 0u) ? 1u : 0u; mine = (j == x) ? c : mine; }
        if (sum == G) break;
        __builtin_amdgcn_s_sleep(1);
        if ((++sp & 255u) == 0u) { if (xb_ld(&bar[XB_TMO])) break; if (sp > XB_SPIN_CAP) { atomicAdd(&bar[XB_TMO], 1u); break; } }
    }
    nloc = mine > 0u ? mine : 1u; nx = cnt > 0u ? cnt : 1u;
}

__device__ __forceinline__ void xcd_barrier(const XcdBarrier& b) {
    asm volatile("s_waitcnt vmcnt(0)" ::: "memory");
    __syncthreads();
    if (threadIdx.x == 0) {
        unsigned* bar = b.bar;
        __builtin_amdgcn_s_waitcnt(0);
        unsigned nloc = b.st[0], nx = b.st[1];
        if (nloc == 0u) { xcd_barrier_complete(bar, b.x, nloc, nx); b.st[0] = nloc; b.st[1] = nx; }
        const unsigned old = xb_add(&bar[XB_XSUB(b.x)], 1u);
        const unsigned gen = old / nloc;
        if (old + 1u == (gen + 1u) * nloc) {
            __builtin_amdgcn_fence(__ATOMIC_RELEASE, "agent");
            asm volatile("s_waitcnt vmcnt(0)" ::: "memory");
            const unsigned og = xb_add(&bar[XB_TOP], 1u);
            const unsigned tg = og / nx;
            if (og + 1u == (tg + 1u) * nx) xb_add(&bar[XB_TOPGEN], 1u);
            else XB_SPIN(xb_ld(&bar[XB_TOPGEN]) == tg, bar);
            __builtin_amdgcn_fence(__ATOMIC_ACQUIRE, "agent");
            xb_add(&bar[XB_XGEN(b.x)], 1u);
            asm volatile("s_waitcnt vmcnt(0)" ::: "memory");
        } else {
            XB_SPIN(xb_ld(&bar[XB_XGEN(b.x)]) == gen, bar);
            __builtin_amdgcn_fence(__ATOMIC_ACQUIRE, "agent");
            asm volatile("s_waitcnt vmcnt(0)" ::: "memory");
        }
    }
    __syncthreads();
}

struct Args { const float* in[21]; float* out; unsigned char* ws; int ph_lo, ph_hi; };
enum { IN_X = 0, IN_C, IN_ADAW, IN_ADAB, IN_NMIX, IN_NFFN, IN_AWQKV, IN_AWO, IN_RELB, IN_KVNG, IN_WKVF, IN_BF, IN_BWQ, IN_BWO, IN_RW, IN_RB, IN_WGU, IN_BGU, IN_WDN, IN_BDN, IN_FNG };

struct Ctx {
    LAS unsigned char* lds; unsigned char* ws; int tid, lane, wave, vcu, G;
};

__device__ __forceinline__ void transpose_item(const float* __restrict__ W, int pitch, int Kd, bf16* WT, int k0, int n0, int row_off, LAS float* scr, int lane) {
#pragma unroll
    for (int i = 0; i < 8; ++i) { const int kk = 8 * i + (lane >> 3), c4 = (lane & 7) * 4;
        const f32x4 v = *(const f32x4*)(W + (size_t)(k0 + kk) * pitch + n0 + c4);
        scr[kk * 33 + c4] = v[0]; scr[kk * 33 + c4 + 1] = v[1]; scr[kk * 33 + c4 + 2] = v[2]; scr[kk * 33 + c4 + 3] = v[3]; }
    LDS_WAIT(); asm volatile("" ::: "memory");
    const int c = lane & 7;
#pragma unroll
    for (int j = 0; j < 4; ++j) { const int n = (lane >> 3) + 8 * j; const LAS float* s = scr + (8 * c) * 33 + n;
        u32x4v o; o.x = pkbf(s[0 * 33], s[1 * 33]); o.y = pkbf(s[2 * 33], s[3 * 33]); o.z = pkbf(s[4 * 33], s[5 * 33]); o.w = pkbf(s[6 * 33], s[7 * 33]);
        *(u32x4v*)(WT + (size_t)(row_off + n0 + n) * Kd + k0 + 8 * c) = o; }
    LDS_WAIT(); asm volatile("" ::: "memory");
}

__device__ __forceinline__ void transpose_item8(const float* __restrict__ W, int pitch, int Kd, unsigned char* WT, int k0, int n0, int row_off, LAS float* scr, int lane) {
#pragma unroll
    for (int i = 0; i < 8; ++i) { const int kk = 8 * i + (lane >> 3), c4 = (lane & 7) * 4;
        const f32x4 v = *(const f32x4*)(W + (size_t)(k0 + kk) * pitch + n0 + c4) * 64.f;
        scr[kk * 33 + c4] = v[0]; scr[kk * 33 + c4 + 1] = v[1]; scr[kk * 33 + c4 + 2] = v[2]; scr[kk * 33 + c4 + 3] = v[3]; }
    LDS_WAIT(); asm volatile("" ::: "memory");
    const int c = lane & 7;
#pragma unroll
    for (int j = 0; j < 4; ++j) { const int n = (lane >> 3) + 8 * j; const LAS float* s = scr + (8 * c) * 33 + n;
        u32x2v o; o.x = pg8::pk4_fp8(s[0 * 33], s[1 * 33], s[2 * 33], s[3 * 33]); o.y = pg8::pk4_fp8(s[4 * 33], s[5 * 33], s[6 * 33], s[7 * 33]);
        *(u32x2v*)(WT + (size_t)(row_off + n0 + n) * Kd + k0 + 8 * c) = o; }
    LDS_WAIT(); asm volatile("" ::: "memory");
}

__device__ __forceinline__ void convert_weights(const Ctx& C, const Args& a, const int part) {
    LAS float* scr = (LAS float*)(C.lds + RING_OFF + C.wave * 8704);
    const int gw = C.vcu * NWAVES + C.wave, NGW = C.G * NWAVES;
    constexpr int I_QKV = 16 * 288, I_SQ = 16 * 32, I_KV = 16 * 64, I_GU1 = 16 * 64, I_DN1 = 16 * 32;
    constexpr int O_WO0 = I_QKV, O_KV = O_WO0 + I_SQ, O_WQ = O_KV + I_KV, O_WO1 = O_WQ + I_SQ, O_GU = O_WO1 + I_SQ, O_DN = O_GU + 64 * I_GU1, NITEMS = O_DN + 64 * I_DN1;
    static_assert(QKV_FP8 && KVQ_FP8 && WO_FP8, "the pipelined prologue converts every weight to fp8");
    struct Item { const float* W; unsigned char* WT; int pitch, k0, n0, row_off; };
    auto decode = [&](int it, Item& I) {
        if (it < O_WO0) { const int r = it, kb = r / 288, nb = r % 288; I = {a.in[IN_AWQKV], (unsigned char*)(C.ws + WS_WQKV), NQKV, 64 * kb, 32 * nb, 0}; }
        else if (it < O_KV) { const int r = it - O_WO0, kb = r / 32, nb = r % 32; I = {a.in[IN_AWO], (unsigned char*)(C.ws + WS_WO0), D, 64 * kb, 32 * nb, 0}; }
        else if (it < O_WQ) { const int r = it - O_KV, kb = r / 64, nb = r % 64; I = {a.in[IN_WKVF], (unsigned char*)(C.ws + WS_WKV), 2064, 64 * kb, 32 * nb, 0}; }
        else if (it < O_WO1) { const int r = it - O_WQ, kb = r / 32, nb = r % 32; I = {a.in[IN_BWQ], (unsigned char*)(C.ws + WS_WKV) + (size_t)2048 * D, D, 64 * kb, 32 * nb, 0}; }
        else if (it < O_GU) { const int r = it - O_WO1, kb = r / 32, nb = r % 32; I = {a.in[IN_BWO], (unsigned char*)(C.ws + WS_WO1), D, 64 * kb, 32 * nb, 0}; }
        else if (it < O_DN) { const int r = it - O_GU, mat = r / I_GU1, q = r % I_GU1, kb = q / 64, nb = q % 64;
            const int n0 = 32 * nb, which = n0 >> 10, j0 = n0 & 1023, drow0 = (j0 >> 7) * 256 + which * 128 + (j0 & 127);
            I = {a.in[IN_WGU] + (size_t)mat * D * 2048, (unsigned char*)(C.ws + WS_WGU) + (size_t)mat * 2048 * D, 2048, 64 * kb, n0, drow0 - n0}; }
        else { const int r = it - O_DN, mat = r / I_DN1, q = r % I_DN1, kb = q / 32, nb = q % 32;
            I = {a.in[IN_WDN] + (size_t)mat * D * D, (unsigned char*)(C.ws + WS_WDN) + (size_t)mat * D * D, D, 64 * kb, 32 * nb, 0}; }
    };
    const int lr = C.lane >> 3, c4 = (C.lane & 7) * 4;
#define P0_LOAD(V, I) do { _Pragma("unroll") for (int i = 0; i < 8; ++i) V[i] = NT_P0 ? __builtin_nontemporal_load((const f32x4*)((I).W + (size_t)((I).k0 + 8 * i + lr) * (I).pitch + (I).n0 + c4)) : *(const f32x4*)((I).W + (size_t)((I).k0 + 8 * i + lr) * (I).pitch + (I).n0 + c4); } while (0)
    f32x4 vc[8], vn[8]; Item Ic, In;
    constexpr int L1GU = 32 * I_GU1, L1DN = 32 * I_DN1;
    const int NV = DEFER_L1W ? (part == 0 ? (O_GU + L1GU) + L1DN : L1GU + L1DN) : (part == 0 ? NITEMS : 0);
    auto vmap = [&](int v) -> int { if (!DEFER_L1W) return v; if (part == 0) return v < O_GU + L1GU ? v : O_DN + (v - (O_GU + L1GU)); return v < L1GU ? O_GU + L1GU + v : O_DN + L1DN + (v - L1GU); };
    if (gw < NV) { decode(vmap(gw), Ic); P0_LOAD(vc, Ic); }
    for (int vv = gw; vv < NV; vv += NGW) {
        const int it = vmap(vv);
        const bool hn = (vv + NGW) < NV;
        if (hn) { decode(vmap(vv + NGW), In); P0_LOAD(vn, In); }
#pragma unroll
        for (int i = 0; i < 8; ++i) { const int kk = 8 * i + lr; const f32x4 v = vc[i] * 64.f;
            scr[kk * 33 + c4] = v[0]; scr[kk * 33 + c4 + 1] = v[1]; scr[kk * 33 + c4 + 2] = v[2]; scr[kk * 33 + c4 + 3] = v[3]; }
        LDS_WAIT(); asm volatile("" ::: "memory");
        { const int cc = C.lane & 7;
#pragma unroll
          for (int j = 0; j < 4; ++j) { const int n = lr + 8 * j; const LAS float* s = scr + (8 * cc) * 33 + n;
              u32x2v o; o.x = pg8::pk4_fp8(s[0 * 33], s[1 * 33], s[2 * 33], s[3 * 33]); o.y = pg8::pk4_fp8(s[4 * 33], s[5 * 33], s[6 * 33], s[7 * 33]);
              if (NT_P0ST && it >= O_GU) __builtin_nontemporal_store(o, (u32x2v*)(Ic.WT + (size_t)(Ic.row_off + Ic.n0 + n) * D + Ic.k0 + 8 * cc));
              else *(u32x2v*)(Ic.WT + (size_t)(Ic.row_off + Ic.n0 + n) * D + Ic.k0 + 8 * cc) = o; } }
        LDS_WAIT(); asm volatile("" ::: "memory");
        if (hn) { Ic = In;
#pragma unroll
            for (int i = 0; i < 8; ++i) vc[i] = vn[i]; }
    }
#undef P0_LOAD
    __syncthreads();
}
__device__ __forceinline__ void p0_prologue(const Ctx& C, const Args& a) {
    convert_weights(C, a, 0);
    LAS float* cs = (LAS float*)(C.lds + RING_OFF);
    LAS float* red = (LAS float*)(C.lds + RING_OFF + 32768);
    for (int i = C.tid; i < 8192; i += 512) { const float v = a.in[IN_C][i]; cs[i] = v / (1.f + __expf(-v)); }
    __syncthreads();
    float* ADA = (float*)(C.ws + SM_ADA);
    for (int grp = C.vcu; grp < 192; grp += C.G) {
        const int l = grp / 96, col = (grp % 96) * 64 + C.lane;
        const float* w = a.in[IN_ADAW] + (size_t)l * D * 6144 + col;
        float acc[8];
#pragma unroll
        for (int b = 0; b < 8; ++b) acc[b] = 0.f;
        const int kbeg = C.wave * 128;
#pragma unroll 4
        for (int k = kbeg; k < kbeg + 128; k += 4) {
            float wv[4];
#pragma unroll
            for (int j = 0; j < 4; ++j) wv[j] = w[(size_t)(k + j) * 6144];
#pragma unroll
            for (int b = 0; b < 8; ++b) { const f32x4 cv = *(const LAS f32x4*)(cs + b * 1024 + k); acc[b] += cv[0] * wv[0] + cv[1] * wv[1] + cv[2] * wv[2] + cv[3] * wv[3]; }
        }
#pragma unroll
        for (int b = 0; b < 8; ++b) red[(C.wave * 8 + b) * 64 + C.lane] = acc[b];
        __syncthreads();
        { const int b = C.wave; float s = 0.f;
#pragma unroll
          for (int w8 = 0; w8 < 8; ++w8) s += red[(w8 * 8 + b) * 64 + C.lane];
          ADA[(size_t)(l * 8 + b) * 6144 + col] = s + a.in[IN_ADAB][l * 6144 + col]; }
        __syncthreads();
    }
    if (C.vcu == C.G - 1) {
        float* BT = (float*)(C.ws + SM_BIAST);
        for (int i = C.tid; i < 48 * 129; i += 512) { const int gh = i / 129, dl = i % 129, g = gh >> 4, n = dl << (2 * g);
            int bk = n;
            if (n >= 16) { const float nf = (float)n; bk = 16 + (int)(logf(nf / 16.f) / 4.852030263919617f * 16.f); bk = bk > 31 ? 31 : bk; }
            BT[gh * 132 + dl] = a.in[IN_RELB][bk * 48 + gh] * LOG2E; }
    }
}

__device__ __forceinline__ void p1_rows0(const Ctx& C, const Args& a) {
    const float* ADA = (const float*)(C.ws + SM_ADA);
    float* GM = (float*)(C.ws + SM_GM); float* CSH = (float*)(C.ws + SM_CSH);
    const int gt = C.vcu * 512 + C.tid, NGT = C.G * 512;
    for (int i = gt; i < 2 * 2 * 8 * 1024; i += NGT) { const int d = i & 1023, b = (i >> 10) & 7, kind = (i >> 13) & 1, l = i >> 14;
        const float g = kind ? a.in[IN_NFFN][l * D + d] : a.in[IN_NMIX][l * D + d];
        GM[i] = g * (1.f + ADA[(size_t)(l * 8 + b) * 6144 + (kind ? 4 : 1) * 1024 + d]); }
    const int gw = C.vcu * NWAVES + C.wave, NGW = C.G * NWAVES;
    for (int o = gw; o < 512; o += NGW) { const int e = o & 31, b = (o >> 5) & 7, l = o >> 8; float s = 0.f;
        for (int d = C.lane; d < D; d += 64) s += ADA[(size_t)(l * 8 + b) * 6144 + 3 * 1024 + d] * a.in[IN_RW][(size_t)l * D * 32 + d * 32 + e];
        s = wave_sum(s); if (C.lane == 0) CSH[o] = s + a.in[IN_RB][l * 32 + e]; }
    bf16* H = (bf16*)(C.ws + WS_H);
    for (int m = gw; m < T; m += NGW) {
        const int b = m >> 12;
        const f32x4* xr = (const f32x4*)(a.in[IN_X] + (size_t)m * D) + C.lane;
        const f32x4* gr = (const f32x4*)(a.in[IN_NMIX]) + C.lane;
        const f32x4* sc = (const f32x4*)(ADA + (size_t)b * 6144 + 1024) + C.lane;
        const f32x4* sh = (const f32x4*)(ADA + (size_t)b * 6144) + C.lane;
        f32x4 v[4]; float s = 0.f;
#pragma unroll
        for (int j = 0; j < 4; ++j) { v[j] = NT_ROWS ? __builtin_nontemporal_load(xr + 64 * j) : xr[64 * j]; s += (v[j].x * v[j].x + v[j].y * v[j].y) + (v[j].z * v[j].z + v[j].w * v[j].w); }
        const float rstd = 1.f / sqrtf(wave_sum(s) * (1.f / D) + RMS_EPS);
        unsigned long long* o8 = (unsigned long long*)(H + (size_t)m * D) + C.lane; unsigned* o4 = (unsigned*)(C.ws + WS_H8 + (size_t)m * D) + C.lane;
#pragma unroll
        for (int j = 0; j < 4; ++j) { const f32x4 h = v[j] * rstd * gr[64 * j] * (sc[64 * j] + 1.f) + sh[64 * j];
            if (QKV_FP8) o4[64 * j] = pg8::pk4_fp8(h.x, h.y, h.z, h.w);
            else o8[64 * j] = (unsigned long long)pkbf(h.x, h.y) | ((unsigned long long)pkbf(h.z, h.w) << 32); }
    }
}

__device__ __forceinline__ void p3_dilated(const Ctx& C) {
#if BAND_FP8
    attn_body::band8_phase<0>((const unsigned char*)(C.ws + WS_QKV0), (attn_body::bf16*)(C.ws + WS_OG), (float*)(C.ws + SM_LSE), (const float*)(C.ws + SM_BIAST), C.vcu, C.G, 384 * 16, (char*)C.lds + RING_OFF);
    return;
#endif
#if PROBE_BAND
    attn_body::band_phase<PROBE_BAND - 1>((const attn_body::bf16*)(C.ws + WS_QKV0), (attn_body::bf16*)(C.ws + WS_XB), (float*)(C.ws + WS_XB + 200 * MiB), (const float*)(C.ws + SM_BIAST), C.vcu, C.G, 384 * 16, (char*)C.lds + RING_OFF);
#endif
    attn_body::band_phase<0>((const attn_body::bf16*)(C.ws + WS_QKV0), (attn_body::bf16*)(C.ws + WS_OG), (float*)(C.ws + SM_LSE), (const float*)(C.ws + SM_BIAST), C.vcu, C.G, 384 * 16, (char*)C.lds + RING_OFF);
}
template <int MODE> __device__ __forceinline__ void p12_fox(const Ctx& C, size_t o_off) {
    const attn_body::bf16* QKV = (const attn_body::bf16*)(C.ws + WS_QKV1);
    attn_body::bf16* O = (attn_body::bf16*)(C.ws + o_off); const float* FC = (const float*)(C.ws + SM_FCUM);
    LAS float* Fl = (LAS float*)(C.lds + RING_OFF + attn_body::T_F);
    LAS int* qslot = (LAS int*)(C.lds + BLK_OFF);
    unsigned* qhead = (unsigned*)(C.ws + WS_CTL) + CW_QUEUE; const unsigned* NRM = (const unsigned*)(C.ws + WS_CTL) + CW_NRM;
    int cur_bh = -1; float thr = 0.f;
    for (;;) {
        int l_; asm volatile("v_mbcnt_lo_u32_b32 %0, -1, 0\n\tv_mbcnt_hi_u32_b32 %0, -1, %0" : "=v"(l_)); const int t_ = C.wave * 64 + l_;
        __syncthreads();
        if (t_ == 0) qslot[0] = (int)__hip_atomic_fetch_add(qhead, 1u, __ATOMIC_RELAXED, __HIP_MEMORY_SCOPE_AGENT);
        __syncthreads();
        const int idx = qslot[0];
        if (idx >= 2048) break;
        const int qb = 15 - (idx >> 7), bh = idx & 127, b = bh >> 4, h = bh & 15, q0 = qb * 256;
        const attn_body::bf16* Qp = QKV + ((size_t)(b * 3 + 0) * 16 + h) * 4096 * 64;
        const attn_body::bf16* Kp = QKV + ((size_t)(b * 3 + 1) * 16 + h) * 4096 * 64;
        const attn_body::bf16* Vp = QKV + ((size_t)(b * 3 + 2) * 16 + h) * 4096 * 64;
        if (bh != cur_bh) {
            { const f32x4* src = (const f32x4*)(FC + (size_t)bh * 4096); LAS f32x4* dst = (LAS f32x4*)Fl; dst[t_] = src[t_]; dst[512 + t_] = src[512 + t_]; }
            const float gq = __uint_as_float(NRM[((b * 2 + 0) * 16 + h) * 2]) + __uint_as_float(NRM[((b * 2 + 0) * 16 + h) * 2 + 1]);
            const float gk = __uint_as_float(NRM[((b * 2 + 1) * 16 + h) * 2]) + __uint_as_float(NRM[((b * 2 + 1) * 16 + h) * 2 + 1]);
            thr = 2.f * (sqrtf(gq) * sqrtf(gk) * 1.001f + 1e-3f) + 152.f;
            cur_bh = bh;
            __syncthreads();
        }
        int tlo = 0;
        if (MODE == 1) {
            const int NTq = 4 * qb;
            const bool dead = (l_ < NTq) && (Fl[q0] - Fl[64 * l_ + 63] <= -thr);
            tlo = __popcll(__ballot(dead)) & ~1;
        }
        attn_body::attn_unit_t<MODE, 64>(Qp + (size_t)q0 * 64, Kp + (size_t)tlo * 4096, Vp + (size_t)tlo * 4096, 4 * qb + 4 - tlo, 64 * tlo, (WO_FP8 && MODE == 1) ? (attn_body::bf16*)((unsigned char*)O + ((size_t)b * 4096 + q0) * D + h * 64) : O + ((size_t)b * 4096 + q0) * D + h * 64, (long)D, nullptr, 0, (char*)C.lds + RING_OFF);
    }
}
__device__ __forceinline__ void p4_merge(const Ctx& C) {
    const bf16* OG = (const bf16*)(C.ws + WS_OG); const float* LSE = (const float*)(C.ws + SM_LSE); bf16* O = (bf16*)(C.ws + WS_O);
    const int gt = C.vcu * 512 + C.tid, NGT = C.G * 512;
    for (int i = gt; i < T * 128; i += NGT) { const int tok = i >> 7, c8 = i & 127, hd = c8 >> 3;
        const float l0 = LSE[(size_t)tok * 16 + hd], l1 = LSE[((size_t)T + tok) * 16 + hd], l2 = LSE[((size_t)2 * T + tok) * 16 + hd];
        const float mx = fmaxf(l0, fmaxf(l1, l2)); float w0 = __builtin_amdgcn_exp2f(l0 - mx), w1 = __builtin_amdgcn_exp2f(l1 - mx), w2 = __builtin_amdgcn_exp2f(l2 - mx);
        const float inv = 1.f / (w0 + w1 + w2); w0 *= inv; w1 *= inv; w2 *= inv;
        const u32x4v a0 = NT_ROWS ? __builtin_nontemporal_load((const u32x4v*)(OG + (size_t)tok * D + c8 * 8)) : *(const u32x4v*)(OG + (size_t)tok * D + c8 * 8), a1 = NT_ROWS ? __builtin_nontemporal_load((const u32x4v*)(OG + ((size_t)T + tok) * D + c8 * 8)) : *(const u32x4v*)(OG + ((size_t)T + tok) * D + c8 * 8), a2 = NT_ROWS ? __builtin_nontemporal_load((const u32x4v*)(OG + ((size_t)2 * T + tok) * D + c8 * 8)) : *(const u32x4v*)(OG + ((size_t)2 * T + tok) * D + c8 * 8);
        u32x4v o;
#pragma unroll
        for (int k = 0; k < 4; ++k) { const float lo = w0 * bf2f(a0[k] & 0xffffu) + w1 * bf2f(a1[k] & 0xffffu) + w2 * bf2f(a2[k] & 0xffffu);
            float hi = w0 * bf2f(a0[k] >> 16) + w1 * bf2f(a1[k] >> 16) + w2 * bf2f(a2[k] >> 16); float lo2 = lo;
#if PROBE_SANITIZE
            if (!(fabsf(lo2) < 1e30f)) lo2 = 0.f; if (!(fabsf(hi) < 1e30f)) hi = 0.f;
#endif
            o[k] = pkbf(lo2, hi); }
        if (WO_FP8) { u32x2v o8; o8.x = pg8::pk4_fp8(bf2f(o[0] & 0xffffu), bf2f(o[0] >> 16), bf2f(o[1] & 0xffffu), bf2f(o[1] >> 16)); o8.y = pg8::pk4_fp8(bf2f(o[2] & 0xffffu), bf2f(o[2] >> 16), bf2f(o[3] & 0xffffu), bf2f(o[3] >> 16));
            *(u32x2v*)((unsigned char*)O + (size_t)tok * D + c8 * 8) = o8; }
        else *(u32x4v*)(O + (size_t)tok * D + c8 * 8) = o; }
}

__device__ __forceinline__ f32x4 bf4_to_f32(u32x2v v) { return (f32x4){bf2f(v.x & 0xffffu), bf2f(v.x >> 16), bf2f(v.y & 0xffffu), bf2f(v.y >> 16)}; }
typedef u32x2v xs4_t;
__device__ __forceinline__ f32x4 xs4_to_f32(xs4_t v) { return bf4_to_f32(v); }
__device__ __forceinline__ xs4_t f32_to_xs4(f32x4 v) { xs4_t r; r.x = pkbf(v.x, v.y); r.y = pkbf(v.z, v.w); return r; }
#if Y_FP8
typedef unsigned yraw4_t;
__device__ __forceinline__ f32x4 y4_to_f32(yraw4_t v) { const auto lo = __builtin_amdgcn_cvt_pk_f32_fp8((int)v, false), hi = __builtin_amdgcn_cvt_pk_f32_fp8((int)v, true); return (f32x4){lo[0], lo[1], hi[0], hi[1]}; }
#define Y_ROWPTR(Yb, slot) ((const yraw4_t*)((const unsigned char*)(Yb) + (size_t)(slot) * D) + C.lane)
#else
typedef u32x2v yraw4_t;
__device__ __forceinline__ f32x4 y4_to_f32(yraw4_t v) { return bf4_to_f32(v); }
#define Y_ROWPTR(Yb, slot) ((const yraw4_t*)((Yb) + (size_t)(slot) * D) + C.lane)
#endif

__device__ __forceinline__ void r1_router(const Ctx& C, const Args& a, int l) {
    LAS float* scrf = (LAS float*)(C.lds + SCR_OFF + C.wave * 2048);
    LAS int* scri = (LAS int*)scrf;
    LAS int* blk = (LAS int*)(C.lds + BLK_OFF);
    const float* rw = a.in[IN_RW] + (size_t)l * D * 32;
    LAS unsigned short* wh = (LAS unsigned short*)(C.lds + RING_OFF); LAS unsigned short* wlo = (LAS unsigned short*)(C.lds + RING_OFF + 65536);
    int tab_b = -1;
    const bf16* XS = (const bf16*)(C.ws + WS_XS); unsigned char* H8 = (unsigned char*)(C.ws + WS_H8);
    const float* ADA = (const float*)(C.ws + SM_ADA) + (size_t)l * 8 * 6144;
    const float* GM = (const float*)(C.ws + SM_GM) + (size_t)(l * 2 + 1) * 8 * 1024;
    const float* CSH = (const float*)(C.ws + SM_CSH) + l * 256;
    int* TOPI = (int*)(C.ws + SM_TOPI); float* TOPG = (float*)(C.ws + SM_TOPG); int* RANK = (int*)(C.ws + SM_RANK); int* BLKCNT = (int*)(C.ws + SM_BLKCNT);
    const int tk = C.lane & 15, q = C.lane >> 4;
    for (int vb = C.vcu; vb < NVB; vb += C.G) {
        const int tok0 = vb * 128 + C.wave * 16, b = tok0 >> 12, tok = tok0 + tk;
        if (b != tab_b) {
            __syncthreads();
            const float* gmb = GM + b * 1024;
            for (int i = C.tid; i < D * 32; i += 512) { const int dd = i >> 5, e = i & 31; const float w = rw[i] * gmb[dd];
                const unsigned hb = pkbf(w, 0.f) & 0xffffu; const float hf = bf2f(hb); const unsigned lb = pkbf(w - hf, 0.f) & 0xffffu;
                const int pos = ((((dd >> 5) * 4 + ((dd >> 3) & 3)) * 32 + e) << 3) + (dd & 7);
                wh[pos] = (unsigned short)hb; wlo[pos] = (unsigned short)lb; }
            __syncthreads();
            tab_b = b;
        }
        const bf16* xrow = XS + (size_t)tok * D + 8 * q;
        f32x4 acc0 = {0.f, 0.f, 0.f, 0.f}, acc1 = {0.f, 0.f, 0.f, 0.f}; float ssq = 0.f;
        typedef short bf16x8r __attribute__((ext_vector_type(8)));
#pragma unroll 4
        for (int kk = 0; kk < 32; ++kk) {
            const u32x4v xr8 = *(const u32x4v*)(xrow + 32 * kk);
#pragma unroll
            for (int e2 = 0; e2 < 4; ++e2) { const float x0 = bf2f(xr8[e2] & 0xffffu), x1 = bf2f(xr8[e2] >> 16); ssq += x0 * x0 + x1 * x1; }
            const bf16x8r xb = __builtin_bit_cast(bf16x8r, xr8);
            const int fo = ((kk * 4 + q) * 32 + tk) << 3;
            const bf16x8r h0 = *(const LAS bf16x8r*)(wh + fo), h1 = *(const LAS bf16x8r*)(wh + fo + 128), l0 = *(const LAS bf16x8r*)(wlo + fo), l1 = *(const LAS bf16x8r*)(wlo + fo + 128);
            acc0 = __builtin_amdgcn_mfma_f32_16x16x32_bf16(h0, xb, acc0, 0, 0, 0); acc1 = __builtin_amdgcn_mfma_f32_16x16x32_bf16(h1, xb, acc1, 0, 0, 0);
            acc0 = __builtin_amdgcn_mfma_f32_16x16x32_bf16(l0, xb, acc0, 0, 0, 0); acc1 = __builtin_amdgcn_mfma_f32_16x16x32_bf16(l1, xb, acc1, 0, 0, 0);
        }
        ssq += __shfl_xor(ssq, 16); ssq += __shfl_xor(ssq, 32);
        const float rstd = 1.f / sqrtf(ssq * (1.f / D) + RMS_EPS);
        { const f32x4 c0 = *(const f32x4*)(CSH + b * 32 + 4 * q), c1 = *(const f32x4*)(CSH + b * 32 + 16 + 4 * q);
          *(LAS f32x4*)(scrf + tk * 32 + 4 * q) = acc0 * rstd + c0; *(LAS f32x4*)(scrf + tk * 32 + 16 + 4 * q) = acc1 * rstd + c1; }
        LDS_WAIT();
        int myidx[4] = {0, 0, 0, 0};
        if (C.lane < 16) {
            float v[32];
#pragma unroll
            for (int j = 0; j < 8; ++j) { const f32x4 t4 = *(const LAS f32x4*)(scrf + C.lane * 32 + 4 * j); v[4 * j] = t4.x; v[4 * j + 1] = t4.y; v[4 * j + 2] = t4.z; v[4 * j + 3] = t4.w; }
            float val[4];
#pragma unroll
            for (int k = 0; k < 4; ++k) { float best = v[0]; int bi = 0;
#pragma unroll
                for (int e = 1; e < 32; ++e) { if (v[e] > best) { best = v[e]; bi = e; } }
                val[k] = best; myidx[k] = bi;
#pragma unroll
                for (int e = 0; e < 32; ++e) v[e] = (e == bi) ? -INFINITY : v[e]; }
            const float e1 = __expf(val[1] - val[0]), e2 = __expf(val[2] - val[0]), e3 = __expf(val[3] - val[0]), inv = 1.f / (1.f + e1 + e2 + e3);
            *(i32x4v*)(TOPI + (size_t)(tok0 + C.lane) * 4) = (i32x4v){myidx[0], myidx[1], myidx[2], myidx[3]};
            *(f32x4*)(TOPG + (size_t)(tok0 + C.lane) * 4) = (f32x4){inv, e1 * inv, e2 * inv, e3 * inv};
        }
        LDS_WAIT();
        if (C.lane < 16) *(LAS i32x4v*)(scri + C.lane * 4) = (i32x4v){myidx[0], myidx[1], myidx[2], myidx[3]};
        LDS_WAIT();
        const int e = scri[C.lane];
        const unsigned long long lt = (1ull << C.lane) - 1ull;
        int rank = 0, mycnt = 0;
#pragma unroll 4
        for (int j = 0; j < 32; ++j) { const unsigned long long mk = __ballot(e == j); if (e == j) rank = __popcll(mk & lt); if (C.lane == j) mycnt = __popcll(mk); }
        if (C.lane < 32) blk[BL_WCNT + C.wave * 32 + C.lane] = mycnt;
        __syncthreads();
        if (C.lane < 32) { int wb = 0;
            for (int w8 = 0; w8 < C.wave; ++w8) wb += blk[BL_WCNT + w8 * 32 + C.lane];
            blk[BL_WBASE + C.wave * 32 + C.lane] = wb;
            if (C.wave == NWAVES - 1) BLKCNT[vb * 32 + C.lane] = wb + mycnt; }
        LDS_WAIT();
        RANK[(size_t)tok0 * 4 + C.lane] = blk[BL_WBASE + C.wave * 32 + e] + rank;
        const f32x4* shf = (const f32x4*)(ADA + (size_t)b * 6144 + 3 * 1024) + C.lane; const f32x4* gm4 = (const f32x4*)(GM + b * 1024) + C.lane;
#pragma unroll 2
        for (int tt = 0; tt < 16; ++tt) { const float rs = __shfl(rstd, tt); const int tkn = tok0 + tt;
            const xs4_t* xr = (const xs4_t*)(XS + (size_t)tkn * D) + C.lane; unsigned* o4 = (unsigned*)(H8 + (size_t)tkn * D) + C.lane;
#pragma unroll
            for (int j = 0; j < 4; ++j) { const f32x4 h = xs4_to_f32(xr[64 * j]) * rs * gm4[64 * j] + shf[64 * j];
                o4[64 * j] = pg8::pk4_fp8(h.x, h.y, h.z, h.w); } }
        __syncthreads();
    }
}

__device__ __forceinline__ void p7_route(const Ctx& C) {
    LAS int* blk = (LAS int*)(C.lds + BLK_OFF);
    const int* BLKCNT = (const int*)(C.ws + SM_BLKCNT); const int* TOPI = (const int*)(C.ws + SM_TOPI); const int* RANK = (const int*)(C.ws + SM_RANK);
    int* SLOT = (int*)(C.ws + SM_SLOT); int* TILEEXP = (int*)(C.ws + SM_TILEEXP); int* TOKSLOT = (int*)(C.ws + SM_TOKSLOT);
    const unsigned char* H8 = (const unsigned char*)(C.ws + WS_H8); unsigned char* XB = (unsigned char*)(C.ws + WS_XB);
    const int e = C.tid & 31, part = C.tid >> 5;
    { int s = 0; for (int k = 0; k < 16; ++k) s += BLKCNT[(part * 16 + k) * 32 + e]; blk[BL_PARTA + part * 32 + e] = s; }
    __syncthreads();
    if (C.tid < 32) { int tot = 0; for (int p = 0; p < 16; ++p) tot += blk[BL_PARTA + p * 32 + C.tid]; blk[BL_TOT + C.tid] = tot; }
    __syncthreads();
    if (C.tid == 0) { int run = 0; for (int k = 0; k < 32; ++k) { blk[BL_PADS + k] = run; run += (blk[BL_TOT + k] + 255) & ~255; } blk[BL_PADS + 32] = run; }
    __syncthreads();
    if (C.vcu == 0) {
        const int nt = blk[BL_PADS + 32] >> 8;
        if (C.tid == 0) TILEEXP[0] = nt;
        for (int i = C.tid; i < nt; i += 512) { int ex = 0; for (int k = 1; k < 32; ++k) ex += (blk[BL_PADS + k] <= i * 256) ? 1 : 0; TILEEXP[16 + i] = ex; }
        if (C.tid < 33) TILEEXP[640 + C.tid] = blk[BL_PADS + C.tid] >> 8;
    }
    for (int vb = C.vcu; vb < NVB; vb += C.G) {
        __syncthreads();
        { int s = 0; for (int k = 0; k < 16; ++k) { const int bb = part * 16 + k; s += (bb < vb) ? BLKCNT[bb * 32 + e] : 0; } blk[BL_PARTB + part * 32 + e] = s; }
        __syncthreads();
        if (C.tid < 32) { int bs = 0; for (int p = 0; p < 16; ++p) bs += blk[BL_PARTB + p * 32 + C.tid]; blk[BL_BASE + C.tid] = bs + blk[BL_PADS + C.tid]; }
        __syncthreads();
        { const int i = vb * 512 + C.tid; const int ex = TOPI[i]; SLOT[i] = blk[BL_BASE + ex] + RANK[i]; }
        VM_WAIT(); __syncthreads();
#if MOE_GATHER
        { const int i = vb * 512 + C.tid; TOKSLOT[SLOT[i]] = i >> 2; }
#else
        for (int tt = 0; tt < 16; ++tt) { const int tok = vb * 128 + C.wave * 16 + tt;
            const i32x4v sl = *(const i32x4v*)(SLOT + (size_t)tok * 4);
            const u32x4v v0 = *((const u32x4v*)(H8 + (size_t)tok * D) + C.lane);
#pragma unroll
            for (int k = 0; k < 4; ++k) { u32x4v* dst = (u32x4v*)(XB + (size_t)sl[k] * D); dst[C.lane] = v0; } }
#endif
    }
#if MOE_GATHER
    for (int ex = C.vcu; ex < 32; ex += C.G) { const int beg = blk[BL_PADS + ex] + blk[BL_TOT + ex], end = blk[BL_PADS + ex + 1];
        for (int s = beg + C.tid; s < end; s += 512) TOKSLOT[s] = 0; }
#endif
}
__device__ __forceinline__ int load_tile_table(const Ctx& C) {
    LAS int* blk = (LAS int*)(C.lds + BLK_OFF); const int* TILEEXP = (const int*)(C.ws + SM_TILEEXP);
    const int nt = TILEEXP[0];
    __syncthreads();
    for (int i = C.tid; i < MAXTILES; i += 512) blk[BL_TILE + i] = (i < nt) ? TILEEXP[16 + i] : 0;
    __syncthreads();
    return __builtin_amdgcn_readfirstlane(nt);
}


__device__ __forceinline__ void r2_seam(const Ctx& C, const Args& a) {
    LAS float* wl = (LAS float*)(C.lds + RING_OFF);
    { const float* wf = a.in[IN_WKVF]; const float* gkv0 = a.in[IN_KVNG];
      for (int i = C.tid; i < D * 16; i += 512) { const int d = i >> 4, h = i & 15, jj = d >> 8, ln = (d >> 2) & 63, c = d & 3;
          wl[((((jj * 4 + c) * 4 + (h >> 2)) * 64 + ln) << 2) + (h & 3)] = wf[(size_t)d * 2064 + 2048 + h] * gkv0[d]; } }
    __syncthreads();
    bf16* XS = (bf16*)(C.ws + WS_XS); bf16* HKV = (bf16*)(C.ws + WS_HKV); const bf16* Y = (const bf16*)(C.ws + WS_Y);
    const float* ADA0 = (const float*)(C.ws + SM_ADA); const float* ADA1 = ADA0 + (size_t)8 * 6144;
    const float* GM1 = (const float*)(C.ws + SM_GM) + (size_t)(1 * 2 + 0) * 8 * 1024;
    const int* SLOT = (const int*)(C.ws + SM_SLOT); const float* TOPG = (const float*)(C.ws + SM_TOPG); float* LOGF = (float*)(C.ws + SM_LOGF);
    const f32x4* gk4 = (const f32x4*)a.in[IN_KVNG] + C.lane;
    const int gw = C.vcu * NWAVES + C.wave, NGW = C.G * NWAVES;
    const float bfh = a.in[IN_BF][(C.lane >> 2) & 15];
    typedef yraw4_t yraw_t;
#define R2_LOADRAW(XR, Y0, Y1, Y2, Y3, MM, SS) do { const xs4_t* xr_ = (const xs4_t*)(XS + (size_t)(MM) * D) + C.lane; \
        const yraw4_t* z0_ = Y_ROWPTR(Y, (SS)[0]); const yraw4_t* z1_ = Y_ROWPTR(Y, (SS)[1]); \
        const yraw4_t* z2_ = Y_ROWPTR(Y, (SS)[2]); const yraw4_t* z3_ = Y_ROWPTR(Y, (SS)[3]); \
        _Pragma("unroll") for (int j = 0; j < 4; ++j) { if (NT_ROWS) { XR[j] = __builtin_nontemporal_load(xr_ + 64 * j); Y0[j] = __builtin_nontemporal_load(z0_ + 64 * j); Y1[j] = __builtin_nontemporal_load(z1_ + 64 * j); Y2[j] = __builtin_nontemporal_load(z2_ + 64 * j); Y3[j] = __builtin_nontemporal_load(z3_ + 64 * j); } else { XR[j] = xr_[64 * j]; Y0[j] = z0_[64 * j]; Y1[j] = z1_[64 * j]; Y2[j] = z2_[64 * j]; Y3[j] = z3_[64 * j]; } } } while (0)
    xs4_t xc[4], xn[4]; yraw_t y0c[4], y1c[4], y2c[4], y3c[4], y0n[4], y1n[4], y2n[4], y3n[4];
    i32x4v s_cur = *(const i32x4v*)(SLOT + (size_t)gw * 4); f32x4 g_cur = *(const f32x4*)(TOPG + (size_t)gw * 4);
    i32x4v s_nxt = s_cur; f32x4 g_nxt = g_cur;
    if (gw + NGW < T) { s_nxt = *(const i32x4v*)(SLOT + (size_t)(gw + NGW) * 4); g_nxt = *(const f32x4*)(TOPG + (size_t)(gw + NGW) * 4); }
    R2_LOADRAW(xc, y0c, y1c, y2c, y3c, gw, s_cur);
    for (int m = gw; m < T; m += NGW) { const int b = m >> 12;
        const int mn = m + NGW, mnn = m + 2 * NGW;
        i32x4v s_nn = s_nxt; f32x4 g_nn = g_nxt;
        if (mnn < T) { s_nn = *(const i32x4v*)(SLOT + (size_t)mnn * 4); g_nn = *(const f32x4*)(TOPG + (size_t)mnn * 4); }
        if (mn < T) R2_LOADRAW(xn, y0n, y1n, y2n, y3n, mn, s_nxt);
        const f32x4* gf4 = (const f32x4*)(ADA0 + (size_t)b * 6144 + 5 * 1024) + C.lane;
        const f32x4* gm4 = (const f32x4*)(GM1 + b * 1024) + C.lane; const f32x4* shm4 = (const f32x4*)(ADA1 + (size_t)b * 6144) + C.lane;
        xs4_t* xw = (xs4_t*)(XS + (size_t)m * D) + C.lane;
        f32x4 v[4]; float s = 0.f;
#pragma unroll
        for (int j = 0; j < 4; ++j) {
            const f32x4 ys = y4_to_f32(y0c[j]) * g_cur[0] + y4_to_f32(y1c[j]) * g_cur[1] + y4_to_f32(y2c[j]) * g_cur[2] + y4_to_f32(y3c[j]) * g_cur[3];
            v[j] = xs4_to_f32(xc[j]) + gf4[64 * j] * ys; xw[64 * j] = f32_to_xs4(v[j]); v[j] = xs4_to_f32(f32_to_xs4(v[j]));
            s += (v[j].x * v[j].x + v[j].y * v[j].y) + (v[j].z * v[j].z + v[j].w * v[j].w); }
        const float rstd = 1.f / sqrtf(wave_sum(s) * (1.f / D) + RMS_EPS);
        float acc[16];
#pragma unroll
        for (int h = 0; h < 16; ++h) acc[h] = 0.f;
#pragma unroll
        for (int j = 0; j < 4; ++j)
#pragma unroll
            for (int c = 0; c < 4; ++c) { const float xv = v[j][c];
#pragma unroll
                for (int h4 = 0; h4 < 4; ++h4) { const f32x4 w = *(const LAS f32x4*)(wl + ((((j * 4 + c) * 4 + h4) * 64 + C.lane) << 2));
                    acc[4 * h4] += xv * w[0]; acc[4 * h4 + 1] += xv * w[1]; acc[4 * h4 + 2] += xv * w[2]; acc[4 * h4 + 3] += xv * w[3]; }
                if (c == 3) __builtin_amdgcn_sched_barrier(0); }
#pragma unroll
        for (int j = 0; j < 4; ++j) { const f32x4 n = v[j] * rstd, h = n * gm4[64 * j] + shm4[64 * j], hk = n * gk4[64 * j];
            if (KVQ_FP8) { ((unsigned*)(C.ws + WS_HKV + (size_t)T * D + (size_t)m * D) + C.lane)[64 * j] = pg8::pk4_fp8(h.x, h.y, h.z, h.w);
                           ((unsigned*)(C.ws + WS_HKV + (size_t)m * D) + C.lane)[64 * j] = pg8::pk4_fp8(hk.x, hk.y, hk.z, hk.w); }
            else { ((unsigned long long*)(HKV + (size_t)T * D + (size_t)m * D) + C.lane)[64 * j] = (unsigned long long)pkbf(h.x, h.y) | ((unsigned long long)pkbf(h.z, h.w) << 32);
                   ((unsigned long long*)(HKV + (size_t)m * D) + C.lane)[64 * j] = (unsigned long long)pkbf(hk.x, hk.y) | ((unsigned long long)pkbf(hk.z, hk.w) << 32); } }
        __builtin_amdgcn_sched_barrier(0);
        float r8[8], r4[4], r2v[2], r1;
        { const bool up = (C.lane & 32) != 0;
#pragma unroll
          for (int i = 0; i < 8; ++i) { const float snd = up ? acc[i] : acc[i + 8], kp = up ? acc[i + 8] : acc[i]; r8[i] = kp + __shfl_xor(snd, 32); } }
        { const bool up = (C.lane & 16) != 0;
#pragma unroll
          for (int i = 0; i < 4; ++i) { const float snd = up ? r8[i] : r8[i + 4], kp = up ? r8[i + 4] : r8[i]; r4[i] = kp + __shfl_xor(snd, 16); } }
        { const bool up = (C.lane & 8) != 0;
#pragma unroll
          for (int i = 0; i < 2; ++i) { const float snd = up ? r4[i] : r4[i + 2], kp = up ? r4[i + 2] : r4[i]; r2v[i] = kp + __shfl_xor(snd, 8); } }
        { const bool up = (C.lane & 4) != 0; const float snd = up ? r2v[0] : r2v[1], kp = up ? r2v[1] : r2v[0]; r1 = kp + __shfl_xor(snd, 4); }
        r1 += __shfl_xor(r1, 2); r1 += __shfl_xor(r1, 1);
        if ((C.lane & 3) == 0) { const float z = r1 * rstd + bfh; LOGF[(size_t)m * 16 + ((C.lane >> 2) & 15)] = (fminf(z, 0.f) - log1pf(__expf(-fabsf(z)))) * LOG2E; }
#pragma unroll
        for (int j = 0; j < 4; ++j) { xc[j] = xn[j]; y0c[j] = y0n[j]; y1c[j] = y1n[j]; y2c[j] = y2n[j]; y3c[j] = y3n[j]; }
        s_cur = s_nxt; g_cur = g_nxt; s_nxt = s_nn; g_nxt = g_nn;
    }
#undef R2_LOADRAW
}
__device__ __forceinline__ void fcum_scan(const Ctx& C) {
    const float* LOGF = (const float*)(C.ws + SM_LOGF); float* FC = (float*)(C.ws + SM_FCUM);
    LAS float* wtot = (LAS float*)(C.lds + BLK_OFF);
    for (int sq = C.vcu; sq < 128; sq += C.G) { const int b = sq >> 4, h = sq & 15;
        const float* src = LOGF + ((size_t)b * 4096 + C.tid * 8) * 16 + h; float* dst = FC + (size_t)sq * 4096 + C.tid * 8;
        float v[8]; float tot = 0.f;
#pragma unroll
        for (int i = 0; i < 8; ++i) { v[i] = src[i * 16]; }
#pragma unroll
        for (int i = 0; i < 8; ++i) { tot += v[i]; v[i] = tot; }
        float inc = tot;
#pragma unroll
        for (int o = 1; o < 64; o <<= 1) { const float t = __shfl_up(inc, o); if (C.lane >= o) inc += t; }
        __syncthreads();
        if (C.lane == 63) wtot[C.wave] = inc;
        __syncthreads();
        float carry = inc - tot;
        for (int w8 = 0; w8 < C.wave; ++w8) carry += wtot[w8];
#pragma unroll
        for (int i = 0; i < 8; ++i) dst[i] = v[i] + carry;
    }
}
__device__ __forceinline__ void r3_final(const Ctx& C, const Args& a, float* XD) {
    const bf16* XS = (const bf16*)(C.ws + WS_XS); const bf16* Y = (const bf16*)(C.ws + WS_Y);
    const float* ADA1 = (const float*)(C.ws + SM_ADA) + (size_t)8 * 6144;
    const int* SLOT = (const int*)(C.ws + SM_SLOT); const float* TOPG = (const float*)(C.ws + SM_TOPG);
    const f32x4* fg4 = (const f32x4*)a.in[IN_FNG] + C.lane;
    const int gw = C.vcu * NWAVES + C.wave, NGW = C.G * NWAVES;
#define R3_LOADRAW(XR, Y0, Y1, Y2, Y3, MM, SS) do { const xs4_t* xr_ = (const xs4_t*)(XS + (size_t)(MM) * D) + C.lane; \
        const yraw4_t* z0_ = Y_ROWPTR(Y, (SS)[0]); const yraw4_t* z1_ = Y_ROWPTR(Y, (SS)[1]); \
        const yraw4_t* z2_ = Y_ROWPTR(Y, (SS)[2]); const yraw4_t* z3_ = Y_ROWPTR(Y, (SS)[3]); \
        _Pragma("unroll") for (int j = 0; j < 4; ++j) { if (NT_ROWS) { XR[j] = __builtin_nontemporal_load(xr_ + 64 * j); Y0[j] = __builtin_nontemporal_load(z0_ + 64 * j); Y1[j] = __builtin_nontemporal_load(z1_ + 64 * j); Y2[j] = __builtin_nontemporal_load(z2_ + 64 * j); Y3[j] = __builtin_nontemporal_load(z3_ + 64 * j); } else { XR[j] = xr_[64 * j]; Y0[j] = z0_[64 * j]; Y1[j] = z1_[64 * j]; Y2[j] = z2_[64 * j]; Y3[j] = z3_[64 * j]; } } } while (0)
    xs4_t xc[4], xn[4]; yraw4_t y0c[4], y1c[4], y2c[4], y3c[4], y0n[4], y1n[4], y2n[4], y3n[4];
    i32x4v s_cur = *(const i32x4v*)(SLOT + (size_t)gw * 4); f32x4 g_cur = *(const f32x4*)(TOPG + (size_t)gw * 4);
    i32x4v s_nxt = s_cur; f32x4 g_nxt = g_cur;
    if (gw + NGW < T) { s_nxt = *(const i32x4v*)(SLOT + (size_t)(gw + NGW) * 4); g_nxt = *(const f32x4*)(TOPG + (size_t)(gw + NGW) * 4); }
    R3_LOADRAW(xc, y0c, y1c, y2c, y3c, gw, s_cur);
    for (int m = gw; m < T; m += NGW) { const int b = m >> 12;
        const int mn = m + NGW, mnn = m + 2 * NGW;
        i32x4v s_nn = s_nxt; f32x4 g_nn = g_nxt;
        if (mnn < T) { s_nn = *(const i32x4v*)(SLOT + (size_t)mnn * 4); g_nn = *(const f32x4*)(TOPG + (size_t)mnn * 4); }
        if (mn < T) R3_LOADRAW(xn, y0n, y1n, y2n, y3n, mn, s_nxt);
        const f32x4* gf4 = (const f32x4*)(ADA1 + (size_t)b * 6144 + 5 * 1024) + C.lane;
        f32x4* xw = (f32x4*)(XD + (size_t)m * D) + C.lane;
        f32x4 v[4]; float s = 0.f;
#pragma unroll
        for (int j = 0; j < 4; ++j) {
            const f32x4 ys = y4_to_f32(y0c[j]) * g_cur[0] + y4_to_f32(y1c[j]) * g_cur[1] + y4_to_f32(y2c[j]) * g_cur[2] + y4_to_f32(y3c[j]) * g_cur[3];
            v[j] = xs4_to_f32(xc[j]) + gf4[64 * j] * ys; s += (v[j].x * v[j].x + v[j].y * v[j].y) + (v[j].z * v[j].z + v[j].w * v[j].w); }
        const float rstd = 1.f / sqrtf(wave_sum(s) * (1.f / D) + RMS_EPS);
#pragma unroll
        for (int j = 0; j < 4; ++j) xw[64 * j] = v[j] * rstd * fg4[64 * j];
#pragma unroll
        for (int j = 0; j < 4; ++j) { xc[j] = xn[j]; y0c[j] = y0n[j]; y1c[j] = y1n[j]; y2c[j] = y2n[j]; y3c[j] = y3n[j]; }
        s_cur = s_nxt; g_cur = g_nxt; s_nxt = s_nn; g_nxt = g_nn;
    }
#undef R3_LOADRAW
}

constexpr int N_PHASES = 19;
__global__ void __launch_bounds__(NWAVES * 64, 2) yoco_fwd(Args args) {
    extern __shared__ __attribute__((aligned(16))) unsigned char lds[];
    Ctx C;
    C.lds = (LAS unsigned char*)lds; C.ws = args.ws;
    C.tid = threadIdx.x; C.lane = C.tid & 63; C.wave = __builtin_amdgcn_readfirstlane(C.tid >> 6);
    C.G = gridDim.x; { const int bx = blockIdx.x; C.vcu = (C.G % 8 == 0) ? (bx % 8) * (C.G / 8) + bx / 8 : bx; }
    volatile LAS unsigned* MISC = (volatile LAS unsigned*)(C.lds + MISC_OFF);
    if (C.tid < 64) MISC[C.tid] = 0u;
    __syncthreads();
    const int lo = args.ph_lo, hi = args.ph_hi;
    const bool one = (hi - lo) > 1;
    unsigned* ctl = (unsigned*)(args.ws + WS_CTL);
    XcdBarrier bar; bar.bar = ctl + CW_BAR; bar.x = 0; bar.st = nullptr;
    if (one) bar = xcd_barrier_post(ctl + CW_BAR, MISC + 8);
#define IN(k) (lo <= (k) && (k) < hi)
#define SEAM(k) do { if (IN(k) && IN((k) + 1)) xcd_barrier(bar); } while (0)
#define FRESH() do { int l_; asm volatile("v_mbcnt_lo_u32_b32 %0, -1, 0\n\tv_mbcnt_hi_u32_b32 %0, -1, %0" : "=v"(l_)); C.lane = l_; C.tid = C.wave * 64 + l_; } while (0)
#define REP(k) _Pragma("unroll") for (int rep_ = 0; rep_ < 1 + ((PROBE_DUP >> (k)) & 1); ++rep_)
    bf16* const Hb = (bf16*)(C.ws + WS_H);
    if (IN(0)) { FRESH(); REP(0) { p0_prologue(C, args); } SEAM(0); }
    if (IN(1)) { FRESH(); REP(1) { p1_rows0(C, args); } SEAM(1); }
    if (IN(2)) { FRESH();
#if PROBE_QKV
        { pg8::Gemm g{(const pg8::bf16_t*)(C.ws + WS_H8), (const pg8::bf16_t*)(C.ws + WS_WQKV), T, NQKV, D}; pg8::StaticOrder S; S.init(T, NQKV, C.G, (int)blockIdx.x);
#if PROBE_QKV == 1
          pg8::EpiQKV0 E{(pg8::bf16_t*)(C.ws + WS_QKV0), 0.015625f};
          pg8::gemm_phase<pg8::EpiQKV0, pg8::StaticOrder, true, true, 1>(C.lds + RING_OFF, g, S, E);
#elif PROBE_QKV == 2
          pg8::EpiQKV0Probe E{(pg8::bf16_t*)(C.ws + WS_XB), 0.015625f, 4};
          pg8::gemm_phase<pg8::EpiQKV0Probe, pg8::StaticOrder, true, true, 1>(C.lds + RING_OFF, g, S, E);
#else
          pg8::EpiNone E{(unsigned char*)(C.ws + WS_XB)};
          pg8::gemm_phase<pg8::EpiNone, pg8::StaticOrder, true, true, 1>(C.lds + RING_OFF, g, S, E);
#endif
        }
#endif
#if STAGGER_QKV
        { const unsigned long long t0 = __builtin_amdgcn_s_memrealtime(); const unsigned long long dl = (unsigned long long)(C.vcu & 7) * STAGGER_QKV;
          while (__builtin_amdgcn_s_memrealtime() - t0 < dl) __builtin_amdgcn_s_sleep(8); }
#endif
        REP(2) {
        pg8::Gemm g{QKV_FP8 ? (const pg8::bf16_t*)(C.ws + WS_H8) : (const pg8::bf16_t*)Hb, (const pg8::bf16_t*)(C.ws + WS_WQKV), T, NQKV, D}; pg8::StaticOrder S; S.init(T, NQKV, C.G, (int)blockIdx.x);
#if BAND_FP8
        pg8::EpiQKV08 E{(unsigned char*)(C.ws + WS_QKV0), QKV_FP8 ? 0.015625f : 1.f};
        pg8::gemm_phase<pg8::EpiQKV08, pg8::StaticOrder, true, true, QKV_FP8 ? 1 : 2>(C.lds + RING_OFF, g, S, E);
#else
        pg8::EpiQKV0 E{(pg8::bf16_t*)(C.ws + WS_QKV0), QKV_FP8 ? 0.015625f : 1.f};
        pg8::gemm_phase<pg8::EpiQKV0, pg8::StaticOrder, true, true, QKV_FP8 ? 1 : 2>(C.lds + RING_OFF, g, S, E);
#endif
        } SEAM(2);
    }
    if (IN(3)) { FRESH(); REP(3) { p3_dilated(C); } SEAM(3); }
    if (IN(4)) { FRESH(); REP(4) { p4_merge(C); } SEAM(4); }
    if (IN(5)) { FRESH(); REP(5) {
        pg8::Gemm g{(const pg8::bf16_t*)(C.ws + WS_O), (const pg8::bf16_t*)(C.ws + WS_WO0), T, D, D}; pg8::StaticOrder S; S.init(T, D, C.G, (int)blockIdx.x);
        pg8::EpiResid<false> E{args.in[IN_X], (pg8::bf16_t*)(C.ws + WS_XS), (const float*)(C.ws + SM_ADA) + 2 * 1024, WO_FP8 ? 0.015625f : 1.f};
        pg8::gemm_phase<pg8::EpiResid<false>, pg8::StaticOrder, true, true, WO_FP8 ? 1 : 2>(C.lds + RING_OFF, g, S, E);
        } SEAM(5);
    }
    if (IN(6)) { FRESH(); REP(6) { r1_router(C, args, 0); } SEAM(6); }
    if (IN(7)) { FRESH(); REP(7) { p7_route(C); } SEAM(7); }
    if (IN(8)) { FRESH();
#if PROBE_GU
        { const int nt = load_tile_table(C);
          pg8::Gemm g{(const pg8::bf16_t*)(C.ws + WS_H8), (const pg8::bf16_t*)(C.ws + WS_WGU), MAXROWS, 32 * 2048, D, (const int*)(C.ws + SM_TOKSLOT)};
          pg8::MoeOrder<8> S{(const LAS int*)(C.lds + BLK_OFF) + BL_TILE, nt, (int)blockIdx.x, C.G};
#if PROBE_GU == 1
          pg8::EpiSwiGLU8 E{(unsigned char*)(C.ws + WS_XB), args.in[IN_BGU]};
          pg8::gemm_phase<pg8::EpiSwiGLU8, pg8::MoeOrder<8>, true, true, 1, true>(C.lds + RING_OFF, g, S, E);
#elif PROBE_GU == 6
          { pg8::MoeOrderProbe S2{(const LAS int*)(C.lds + BLK_OFF) + BL_TILE, nt, (int)blockIdx.x, C.G};
            pg8::EpiProbeGU<2> E{(unsigned char*)(C.ws + WS_XB), args.in[IN_BGU]};
            pg8::gemm_phase<pg8::EpiProbeGU<2>, pg8::MoeOrderProbe, true, true, 1, true>(C.lds + RING_OFF, g, S2, E); }
#else
          pg8::EpiProbeGU<PROBE_GU - 2> E{(unsigned char*)(C.ws + WS_XB), args.in[IN_BGU]};
          pg8::gemm_phase<pg8::EpiProbeGU<PROBE_GU - 2>, pg8::MoeOrder<8>, true, true, 1, true>(C.lds + RING_OFF, g, S, E);
#endif
        }
#endif
        REP(8) {
        const int nt = load_tile_table(C);
        pg8::Gemm g{(const pg8::bf16_t*)(C.ws + (MOE_GATHER ? WS_H8 : WS_XB)), (const pg8::bf16_t*)(C.ws + WS_WGU), MAXROWS, 32 * 2048, D, (const int*)(C.ws + SM_TOKSLOT)};
        pg8::MoeOrder<8> S{(const LAS int*)(C.lds + BLK_OFF) + BL_TILE, nt, (int)blockIdx.x, C.G};
        pg8::EpiSwiGLU8 E{(unsigned char*)(C.ws + WS_ACT), args.in[IN_BGU]};
        pg8::gemm_phase<pg8::EpiSwiGLU8, pg8::MoeOrder<8>, true, true, 1, MOE_GATHER != 0>(C.lds + RING_OFF, g, S, E);
        } SEAM(8);
    }
    if (IN(9)) { FRESH(); REP(9) {
        const int nt = load_tile_table(C);
        pg8::Gemm g{(const pg8::bf16_t*)(C.ws + WS_ACT), (const pg8::bf16_t*)(C.ws + WS_WDN), MAXROWS, 32 * 1024, D};
        pg8::MoeOrder<4> S{(const LAS int*)(C.lds + BLK_OFF) + BL_TILE, nt, (int)blockIdx.x, C.G};
        pg8::EpiDown8 E{(pg8::bf16_t*)(C.ws + WS_Y), args.in[IN_BDN]};
        pg8::gemm_phase<pg8::EpiDown8, pg8::MoeOrder<4>, true, true, 1>(C.lds + RING_OFF, g, S, E);
        } SEAM(9);
    }
    if (IN(10)) { FRESH(); r2_seam(C, args); SEAM(10); }
    if (IN(11)) { FRESH(); REP(11) {
        fcum_scan(C);
        pg8::Gemm g{(const pg8::bf16_t*)(C.ws + WS_HKV), (const pg8::bf16_t*)(C.ws + WS_WKV), T, 3072, D}; pg8::KVQOrder S; S.init(T, 3072, C.G, (int)blockIdx.x);
        pg8::EpiKVQ E{(pg8::bf16_t*)(C.ws + WS_QKV1), KVQ_FP8 ? 0.015625f : 1.f, (unsigned*)(C.ws + WS_CTL) + CW_NRM};
        pg8::gemm_phase<pg8::EpiKVQ, pg8::KVQOrder, true, true, KVQ_FP8 ? 1 : 2>(C.lds + RING_OFF, g, S, E);
        } SEAM(11);
    }
    if (IN(12)) { FRESH(); if (PROBE_FOX == 2) p12_fox<2>(C, WS_OG); REP(12) { p12_fox<1>(C, WS_O); } SEAM(12); }
    if (IN(13)) { FRESH(); REP(13) {
        pg8::Gemm g{(const pg8::bf16_t*)(C.ws + WS_O), (const pg8::bf16_t*)(C.ws + WS_WO1), T, D, D}; pg8::StaticOrder S; S.init(T, D, C.G, (int)blockIdx.x);
        pg8::EpiResid<true> E{C.ws + WS_XS, (pg8::bf16_t*)(C.ws + WS_XS), (const float*)(C.ws + SM_ADA) + (size_t)8 * 6144 + 2 * 1024, WO_FP8 ? 0.015625f : 1.f};
        pg8::gemm_phase<pg8::EpiResid<true>, pg8::StaticOrder, true, true, WO_FP8 ? 1 : 2>(C.lds + RING_OFF, g, S, E);
        } SEAM(13);
    }
    if (IN(14)) { FRESH(); REP(14) { r1_router(C, args, 1); } SEAM(14); }
    if (IN(15)) { FRESH(); REP(15) { p7_route(C); } if (DEFER_L1W) { __syncthreads(); convert_weights(C, args, 1); } SEAM(15); }
    if (IN(16)) { FRESH();
#if PROBE_LATE_QKV
        { pg8::Gemm g{(const pg8::bf16_t*)(C.ws + WS_ACT), (const pg8::bf16_t*)(C.ws + WS_WQKV), T, NQKV, D}; pg8::StaticOrder S; S.init(T, NQKV, C.G, (int)blockIdx.x);
          pg8::EpiNone E{(unsigned char*)(C.ws + WS_XB)};
          pg8::gemm_phase<pg8::EpiNone, pg8::StaticOrder, true, true, 1>(C.lds + RING_OFF, g, S, E); }
#endif
        REP(16) {
        const int nt = load_tile_table(C);
        pg8::Gemm g{(const pg8::bf16_t*)(C.ws + (MOE_GATHER ? WS_H8 : WS_XB)), (const pg8::bf16_t*)(C.ws + WS_WGU + (size_t)32 * 2048 * D), MAXROWS, 32 * 2048, D, (const int*)(C.ws + SM_TOKSLOT)};
        pg8::MoeOrder<8> S{(const LAS int*)(C.lds + BLK_OFF) + BL_TILE, nt, (int)blockIdx.x, C.G};
        pg8::EpiSwiGLU8 E{(unsigned char*)(C.ws + WS_ACT), args.in[IN_BGU] + 32 * 2048};
        pg8::gemm_phase<pg8::EpiSwiGLU8, pg8::MoeOrder<8>, true, true, 1, MOE_GATHER != 0>(C.lds + RING_OFF, g, S, E);
        } SEAM(16);
    }
    if (IN(17)) { FRESH(); REP(17) {
        const int nt = load_tile_table(C);
        pg8::Gemm g{(const pg8::bf16_t*)(C.ws + WS_ACT), (const pg8::bf16_t*)(C.ws + WS_WDN + (size_t)32 * 1024 * D), MAXROWS, 32 * 1024, D};
        pg8::MoeOrder<4> S{(const LAS int*)(C.lds + BLK_OFF) + BL_TILE, nt, (int)blockIdx.x, C.G};
        pg8::EpiDown8 E{(pg8::bf16_t*)(C.ws + WS_Y), args.in[IN_BDN] + 32 * 1024};
        pg8::gemm_phase<pg8::EpiDown8, pg8::MoeOrder<4>, true, true, 1>(C.lds + RING_OFF, g, S, E);
        } SEAM(17);
    }
    if (IN(18)) { FRESH(); r3_final(C, args, args.out); }
#undef IN
#undef SEAM
}

extern "C" void kernel_launch(void* const* d_in, const int* in_sizes, int n_in, void* d_out, int out_size, void* d_ws, size_t ws_size, hipStream_t stream) {
    static int grid = 0;
    if (grid == 0) {
        if (n_in != 21 || in_sizes[0] != T * D || out_size != T * D || ws_size < WS_END) { fprintf(stderr, "kernel_launch: unexpected shapes (n_in %d, in0 %d, out %d, ws %zu)\n", n_in, n_in > 0 ? in_sizes[0] : -1, out_size, ws_size); grid = -1; return; }
        int dev = 0, cus = 0, per_cu = 0;
        if (hipGetDevice(&dev) != hipSuccess || hipDeviceGetAttribute(&cus, hipDeviceAttributeMultiprocessorCount, dev) != hipSuccess) { grid = -1; return; }
        if (hipFuncSetAttribute((const void*)yoco_fwd, hipFuncAttributeMaxDynamicSharedMemorySize, LDS_BYTES) != hipSuccess) { fprintf(stderr, "kernel_launch: hipFuncSetAttribute failed\n"); grid = -1; return; }
        if (hipOccupancyMaxActiveBlocksPerMultiprocessor(&per_cu, (const void*)yoco_fwd, NWAVES * 64, LDS_BYTES) != hipSuccess || per_cu < 1) { fprintf(stderr, "kernel_launch: occupancy query reports %d blocks per CU\n", per_cu); }
        (void)hipGetLastError();
        grid = cus;
    }
    if (grid < 0) return;
    (void)hipMemsetAsync((char*)d_ws + WS_CTL, 0, CTL_ZERO_BYTES, stream);
    Args a{};
    for (int i = 0; i < 21; ++i) a.in[i] = (const float*)d_in[i];
    a.out = (float*)d_out; a.ws = (unsigned char*)d_ws;
#if MK_ONE_LAUNCH
    a.ph_lo = 0; a.ph_hi = N_PHASES;
    hipLaunchKernelGGL(yoco_fwd, dim3(grid), dim3(NWAVES * 64), LDS_BYTES, stream, a);
#else
    for (int p = 0; p < N_PHASES; ++p) { a.ph_lo = p; a.ph_hi = p + 1; hipLaunchKernelGGL(yoco_fwd, dim3(grid), dim3(NWAVES * 64), LDS_BYTES, stream, a); }
#endif
}
```

```cpp
#include <hip/hip_runtime.h>
#include <hip/hip_bf16.h>
#include <cstdio>
#include <cstdint>
#include <cmath>
#ifndef MK_ONE_LAUNCH
#define MK_ONE_LAUNCH 1
#endif
#ifndef PROBE_DUP
#define PROBE_DUP 0
#endif
#ifndef PG8_F8_SCALED
#define PG8_F8_SCALED 0
#endif
#ifndef QKV_FP8
#define QKV_FP8 1
#endif
#ifndef KVQ_FP8
#define KVQ_FP8 1
#endif
#ifndef PROBE_EPI
#define PROBE_EPI 0
#endif
#ifndef PROBE_FOX
#define PROBE_FOX 0
#endif
#ifndef PROBE_SANITIZE
#define PROBE_SANITIZE 0
#endif
#ifndef PROBE_BAND
#define PROBE_BAND 0
#endif
#ifndef Y_FP8
#define Y_FP8 1
#endif
#ifndef WO_FP8
#define WO_FP8 1
#endif
#ifndef MOE_GATHER
#define MOE_GATHER 1
#endif
#ifndef PROBE_QKV
#define PROBE_QKV 0
#endif
#ifndef PROBE_GU
#define PROBE_GU 0
#endif
#ifndef STAGGER_QKV
#define STAGGER_QKV 0
#endif
#ifndef NT_STORE
#define NT_STORE 0
#endif
#ifndef RELAX_STORES
#define RELAX_STORES 0
#endif
#ifndef PROBE_LATE_QKV
#define PROBE_LATE_QKV 0
#endif
#ifndef NT_P0
#define NT_P0 1
#endif
#ifndef NT_ROWS
#define NT_ROWS 1
#endif
#ifndef NT_P0ST
#define NT_P0ST 0
#endif
#ifndef DEFER_L1W
#define DEFER_L1W 0
#endif
#ifndef BAND_FP8
#define BAND_FP8 1
#endif
#ifndef QKV_WIDE
#define QKV_WIDE 1
#endif
namespace pg8 {
#define PG8_LAS __attribute__((address_space(3)))
typedef unsigned short bf16_t;
typedef short bf16x8 __attribute__((ext_vector_type(8)));
typedef float f32x4 __attribute__((ext_vector_type(4)));
typedef unsigned u32x4 __attribute__((ext_vector_type(4)));
constexpr int BM = 256, BK = 64, HALF = 128, HTB = HALF * BK * 2  , STAGE_BYTES = 8 * HTB, NXCD = 8, WGM = 8;

__host__ __device__ __forceinline__ int lds_byte(int r, int c) { const int st = (r >> 4) * 2 + (c >> 5), rr = r & 15, cc = c & 31, ob = rr * 64 + cc * 2; return st * 1024 + (ob ^ (((ob >> 9) & 1) << 5)); }
__host__ __device__ __forceinline__ void stage_rc(int b, int& R, int& C) { const int st = b / 1024, sb = b % 1024, swz = sb ^ (((sb >> 9) & 1) << 5); R = (st >> 1) * 16 + swz / 64; C = (st & 1) * 32 + (swz % 64) / 2; }
__host__ __device__ __forceinline__ int perm32(int rho) { const int n = rho >> 4, i = rho & 15; return 8 * (i >> 2) + 4 * n + (i & 3); }

struct Unit { int pm, pn; };
struct Gemm { const bf16_t* A; const bf16_t* Bt; int M, N, K; const int* rows = nullptr; };

struct StaticOrder {
    int nM, nN, nwg, G, c;
    __host__ __device__ void init(int M, int N, int G_, int c_) { nM = M / BM; nN = N / BM; nwg = nM * nN; G = G_; c = c_; }
    __host__ __device__ bool next(int i, Unit& u) const {
        const long L = (long)i * G + c; if (L >= nwg) return false;
        int wgid = (int)L; { const int q = nwg / NXCD, r = nwg % NXCD, xcd = wgid % NXCD, off = wgid / NXCD; wgid = (xcd < r ? xcd * (q + 1) : r * (q + 1) + (xcd - r) * q) + off; }
        const int nig = WGM * nN, gid = wgid / nig, fm = gid * WGM, gsz = (nM - fm) < WGM ? (nM - fm) : WGM;
        u.pm = fm + ((wgid % nig) % gsz); u.pn = (wgid % nig) / gsz; return true;
    }
    __device__ __forceinline__ void a_ready(const Unit&) const {}
    __device__ __forceinline__ void done(const Unit&) const {}
};
__device__ __forceinline__ unsigned cvt_pk_bf16(float lo, float hi) { unsigned r; asm volatile("v_cvt_pk_bf16_f32 %0, %1, %2" : "=v"(r) : "v"(lo), "v"(hi)); return r; }
typedef float f32x2 __attribute__((ext_vector_type(2)));
typedef int i32x8 __attribute__((ext_vector_type(8))); typedef int i32x4p __attribute__((ext_vector_type(4)));
#ifndef PG8_F8_SCALE
#define PG8_F8_SCALE 0x7f7f7f7f
#endif
__device__ __forceinline__ i32x8 pg8_cat(bf16x8 lo, bf16x8 hi) { const i32x4p a = __builtin_bit_cast(i32x4p, lo), b = __builtin_bit_cast(i32x4p, hi); return (i32x8){a.x, a.y, a.z, a.w, b.x, b.y, b.z, b.w}; }
#if PG8_F8_SCALED
__device__ __forceinline__ void pg8_mma8(f32x4& acc, i32x8 b, i32x8 a) { asm volatile("v_mfma_scale_f32_16x16x128_f8f6f4 %0, %1, %2, %0, %3, %3 op_sel_hi:[0,0,0]" : "+v"(acc) : "v"(b), "v"(a), "v"(0x7f7f7f7f)); }
#else
__device__ __forceinline__ void pg8_mma8(f32x4& acc, i32x8 b, i32x8 a) { asm volatile("v_mfma_f32_16x16x128_f8f6f4 %0, %1, %2, %0" : "+v"(acc) : "v"(b), "v"(a)); }
#endif
__device__ __forceinline__ void pg8_mma16(f32x4& acc, bf16x8 b, bf16x8 a) { asm volatile("v_mfma_f32_16x16x32_bf16 %0, %1, %2, %0" : "+v"(acc) : "v"(b), "v"(a)); }
template <class Epi, class Sched, bool ALIGN_EPI = false, bool SP2 = false, int ES = 2  , bool GATHER = false  , int BMAP = 0  >
__device__ __forceinline__ void gemm_phase(PG8_LAS unsigned char* lds, const Gemm g, const Sched& S, const Epi& E) {
    const int tid = threadIdx.x, wid = __builtin_amdgcn_readfirstlane(tid >> 6), lane = tid & 63, wr = wid >> 2, wc = wid & 3, fr = lane & 15, fq = lane >> 4;
    const int K = g.K * ES / 2  , nt = K / BK;
    unsigned voffA[2], voffB[2];
#pragma unroll
    for (int i = 0; i < 2; ++i) { int R, C; stage_rc(tid * 16 + i * 8192, R, C); const int Rb = BMAP == 1 ? ((R >> 5) * 64 + 16 * ((R & 15) >> 2) + 4 * ((R >> 4) & 1) + (R & 3)) : (Epi::PERM ? ((R & ~31) + perm32(R & 31)) : R);
        voffA[i] = (unsigned)(R * K + C) * 2u; voffB[i] = (unsigned)(Rb * K + C) * 2u; }
    const size_t kstep = (size_t)(BK * 2);
    const size_t hstep = (size_t)HALF * K * 2;
    const size_t tstep = 2 * hstep;
    const size_t hstepB = BMAP == 1 ? (size_t)8 * K * 2 : hstep;
    const size_t hstepA = GATHER ? 0 : hstep;
    unsigned cG0[2] = {voffA[0], voffA[1]}, cG1[2] = {voffA[0], voffA[1]}, nG0[2] = {voffA[0], voffA[1]}, nG1[2] = {voffA[0], voffA[1]};
#define PG8_GROWS(G0, G1, PM) do { if constexpr (GATHER) { _Pragma("unroll") for (int i_ = 0; i_ < 2; ++i_) { int R_, C_; stage_rc(tid * 16 + i_ * 8192, R_, C_); \
        const int* rp_ = g.rows + (size_t)(PM) * 256 + R_; G0[i_] = (unsigned)rp_[0] * (unsigned)(K * 2) + (unsigned)(C_ * 2); G1[i_] = (unsigned)rp_[128] * (unsigned)(K * 2) + (unsigned)(C_ * 2); } } } while (0)
    const unsigned ldsw = (unsigned)wid * 1024u;
    const int aoff = lds_byte(wr * 64 + fr, fq * 8), boff = lds_byte(wc * 32 + fr, fq * 8);
#define PG8_SA(b, h) (((b) * 2 + (h)) * HTB)
#define PG8_SB(b, h) ((4 + (b) * 2 + (h)) * HTB)
#define PG8_STAGE(bufoff, gbase, voff) do { _Pragma("unroll") for (int _i = 0; _i < 2; ++_i) \
        __builtin_amdgcn_global_load_lds((const unsigned*)((const char*)(gbase) + (voff)[_i]), (PG8_LAS unsigned*)(lds + (bufoff) + ldsw + _i * 8192), 16, 0, 0); } while (0)
#define PG8_LDA(dst, b, h) do { _Pragma("unroll") for (int m = 0; m < 4; ++m) _Pragma("unroll") for (int k = 0; k < 2; ++k) dst[m][k] = *(const PG8_LAS bf16x8*)(lds + PG8_SA(b, h) + aoff + m * 2048 + k * 1024); } while (0)
#define PG8_LDB(dst, b, h) do { _Pragma("unroll") for (int n = 0; n < 2; ++n) _Pragma("unroll") for (int k = 0; k < 2; ++k) dst[n][k] = *(const PG8_LAS bf16x8*)(lds + PG8_SB(b, h) + boff + n * 2048 + k * 1024); } while (0)
#define PG8_MMA(ai, bj, At, Bt) do { __builtin_amdgcn_s_setprio(1); _Pragma("unroll") for (int m = 0; m < 4; ++m) _Pragma("unroll") for (int n = 0; n < 2; ++n) { \
        if constexpr (ES == 2) { _Pragma("unroll") for (int k = 0; k < 2; ++k) acc[ai][bj][m][n] = __builtin_amdgcn_mfma_f32_16x16x32_bf16(Bt[n][k], At[m][k], acc[ai][bj][m][n], 0, 0, 0); } \
        else { pg8_mma8(acc[ai][bj][m][n], pg8_cat(Bt[n][0], Bt[n][1]), pg8_cat(At[m][0], At[m][1])); } } \
        __builtin_amdgcn_s_setprio(0); } while (0)
#define PG8_WAIT_V(n) asm volatile("s_waitcnt vmcnt(" #n ")" ::: "memory")
#define PG8_WAIT_L(n) asm volatile("s_waitcnt lgkmcnt(" #n ")" ::: "memory")
#define PG8_WAIT_V8R do { if (relax_st) { if constexpr (Epi::NSTORE == 16) asm volatile("s_waitcnt vmcnt(24)" ::: "memory"); else if constexpr (Epi::NSTORE == 8) asm volatile("s_waitcnt vmcnt(16)" ::: "memory"); else asm volatile("s_waitcnt vmcnt(8)" ::: "memory"); } \
        else asm volatile("s_waitcnt vmcnt(8)" ::: "memory"); } while (0)
#define PG8_BAR __builtin_amdgcn_s_barrier()
#define PG8_SCHED __builtin_amdgcn_sched_barrier(0)
    Unit cur, nxt; int ui = 0;
    if (!S.next(0, cur)) return;
    f32x4 acc[2][2][4][2];
#pragma unroll
    for (int a = 0; a < 2; ++a)
#pragma unroll
        for (int b = 0; b < 2; ++b)
#pragma unroll
            for (int m = 0; m < 4; ++m)
#pragma unroll
                for (int n = 0; n < 2; ++n) acc[a][b][m][n] = (f32x4){0.f, 0.f, 0.f, 0.f};
    bf16x8 At[4][2], B0[2][2], B1[2][2];
    const char* cA = (const char*)g.A + (GATHER ? (size_t)0 : (size_t)cur.pm * tstep); const char* cB = (const char*)g.Bt + (size_t)cur.pn * tstep;
    PG8_GROWS(cG0, cG1, cur.pm);
    S.a_ready(cur);
    if constexpr (SP2) {
        PG8_STAGE(PG8_SB(0, 0), cB, voffB); PG8_STAGE(PG8_SB(0, 1), cB + hstepB, voffB); PG8_STAGE(PG8_SA(0, 0), cA, cG0); PG8_STAGE(PG8_SA(0, 1), cA + hstepA, cG1);
        if (wr == 1) PG8_BAR;
        PG8_WAIT_V(2); PG8_BAR;
        PG8_STAGE(PG8_SB(1, 0), cB + kstep, voffB); PG8_STAGE(PG8_SA(1, 0), cA + kstep, cG0); PG8_STAGE(PG8_SB(1, 1), cB + hstepB + kstep, voffB);
        PG8_WAIT_V(6); PG8_BAR;
    } else {
        PG8_STAGE(PG8_SB(0, 0), cB, voffB); PG8_STAGE(PG8_SA(0, 0), cA, cG0); PG8_STAGE(PG8_SB(0, 1), cB + hstepB, voffB); PG8_STAGE(PG8_SA(0, 1), cA + hstepA, cG1);
        if (wr == 1) PG8_BAR;
        PG8_WAIT_V(4); PG8_BAR;
        PG8_STAGE(PG8_SB(1, 0), cB + kstep, voffB); PG8_STAGE(PG8_SA(1, 0), cA + kstep, cG0); PG8_STAGE(PG8_SB(1, 1), cB + hstepB + kstep, voffB);
        PG8_WAIT_V(6); PG8_BAR;
    }
    for (;;) {
        const bool has_next = S.next(ui + 1, nxt);
        const char* nA = (has_next && !GATHER) ? (const char*)g.A + (size_t)nxt.pm * tstep : cA; const char* nB = has_next ? (const char*)g.Bt + (size_t)nxt.pn * tstep : cB;
        if (has_next) PG8_GROWS(nG0, nG1, nxt.pm); else { nG0[0] = cG0[0]; nG0[1] = cG0[1]; nG1[0] = cG1[0]; nG1[1] = cG1[1]; }
#pragma unroll 1
        for (int t = 0; t < nt; t += 2) {
            const bool last = (t == nt - 2);
            const bool relax_st = RELAX_STORES && (t == 0) && (ui > 0);
            const char* a1 = cA + (size_t)(t + 1) * kstep;
            const char* a2 = last ? nA : cA + (size_t)(t + 2) * kstep; const char* b2 = last ? nB : cB + (size_t)(t + 2) * kstep;
            const char* a3 = a2 + kstep; const char* b3 = b2 + kstep;
            if (last && has_next) S.a_ready(nxt);
            const unsigned s0[2] = {last ? nG0[0] : cG0[0], last ? nG0[1] : cG0[1]}, s1[2] = {last ? nG1[0] : cG1[0], last ? nG1[1] : cG1[1]};
            if constexpr (SP2) {
            PG8_LDB(B0, 0, 0); PG8_LDB(B1, 0, 1); PG8_SCHED; PG8_LDA(At, 0, 0); PG8_STAGE(PG8_SA(1, 1), a1 + hstepA, cG1);
            PG8_WAIT_V8R; PG8_WAIT_L(0); PG8_BAR; PG8_MMA(0, 0, At, B0); PG8_MMA(0, 1, At, B1); PG8_BAR; PG8_SCHED;
            PG8_LDA(At, 0, 1); PG8_STAGE(PG8_SB(0, 0), b2, voffB); PG8_STAGE(PG8_SB(0, 1), b2 + hstepB, voffB); PG8_STAGE(PG8_SA(0, 0), a2, s0);
            PG8_WAIT_V8R; PG8_WAIT_L(0); PG8_BAR; PG8_MMA(1, 0, At, B0); PG8_MMA(1, 1, At, B1); PG8_BAR; PG8_SCHED;
            PG8_LDB(B0, 1, 0); PG8_LDB(B1, 1, 1); PG8_SCHED; PG8_LDA(At, 1, 0); PG8_STAGE(PG8_SA(0, 1), a2 + hstepA, s1);
            PG8_WAIT_V(8); PG8_WAIT_L(0); PG8_BAR; PG8_MMA(0, 0, At, B0); PG8_MMA(0, 1, At, B1); PG8_BAR; PG8_SCHED;
            PG8_LDA(At, 1, 1); PG8_STAGE(PG8_SB(1, 0), b3, voffB); PG8_STAGE(PG8_SB(1, 1), b3 + hstepB, voffB); PG8_STAGE(PG8_SA(1, 0), a3, s0);
            PG8_WAIT_V(8); PG8_WAIT_L(0); PG8_BAR; PG8_MMA(1, 0, At, B0); PG8_MMA(1, 1, At, B1); PG8_BAR; PG8_SCHED;
            } else {
            PG8_LDB(B0, 0, 0); PG8_SCHED; PG8_LDA(At, 0, 0); PG8_STAGE(PG8_SA(1, 1), a1 + hstepA, cG1);
            PG8_WAIT_L(8); PG8_BAR; PG8_WAIT_L(0); PG8_MMA(0, 0, At, B0); PG8_BAR; PG8_SCHED;
            PG8_LDB(B1, 0, 1); PG8_STAGE(PG8_SB(0, 0), b2, voffB);
            PG8_BAR; PG8_WAIT_L(0); PG8_MMA(0, 1, At, B1); PG8_BAR;
            PG8_LDA(At, 0, 1); PG8_STAGE(PG8_SA(0, 0), a2, s0);
            PG8_BAR; PG8_WAIT_L(0); PG8_MMA(1, 0, At, B0); PG8_BAR; PG8_SCHED;
            PG8_STAGE(PG8_SB(0, 1), b2 + hstepB, voffB);
            PG8_WAIT_V(6); PG8_BAR; PG8_MMA(1, 1, At, B1); PG8_BAR;
            PG8_LDB(B0, 1, 0); PG8_SCHED; PG8_LDA(At, 1, 0); PG8_STAGE(PG8_SA(0, 1), a2 + hstepA, s1);
            PG8_WAIT_L(8); PG8_BAR; PG8_WAIT_L(0); PG8_MMA(0, 0, At, B0); PG8_BAR; PG8_SCHED;
            PG8_LDB(B1, 1, 1); PG8_STAGE(PG8_SB(1, 0), b3, voffB);
            PG8_BAR; PG8_WAIT_L(0); PG8_MMA(0, 1, At, B1); PG8_BAR;
            PG8_LDA(At, 1, 1); PG8_STAGE(PG8_SA(1, 0), a3, s0);
            PG8_BAR; PG8_WAIT_L(0); PG8_MMA(1, 0, At, B0); PG8_BAR; PG8_SCHED;
            PG8_STAGE(PG8_SB(1, 1), b3 + hstepB, voffB);
            PG8_WAIT_V(6); PG8_BAR; PG8_MMA(1, 1, At, B1); PG8_BAR;
            }
        }
        if constexpr (ES == 1) asm volatile("s_nop 15\n\ts_nop 15" ::: "memory");
        if constexpr (ALIGN_EPI) { if (wr == 0) PG8_BAR; }
        if constexpr (!Epi::AFTER_DRAIN) { E(acc, cur, wr, wc, fr, fq); S.done(cur); }
        if (!has_next) break;
#pragma unroll
        for (int a = 0; a < 2; ++a)
#pragma unroll
            for (int b = 0; b < 2; ++b)
#pragma unroll
                for (int m = 0; m < 4; ++m)
#pragma unroll
                    for (int n = 0; n < 2; ++n) acc[a][b][m][n] = (f32x4){0.f, 0.f, 0.f, 0.f};
        cur = nxt; cA = nA; cB = nB; ++ui; cG0[0] = nG0[0]; cG0[1] = nG0[1]; cG1[0] = nG1[0]; cG1[1] = nG1[1];
        if constexpr (ALIGN_EPI) { if (wr == 1) PG8_BAR; }
    }
    PG8_WAIT_V(0);
    if constexpr (!ALIGN_EPI) { if (wr == 0) PG8_BAR; }
    PG8_BAR;
    if constexpr (Epi::AFTER_DRAIN) { E.fused(acc, cur, wr, wc, fr, fq, lds, wid, lane); S.done(cur); }
#undef PG8_GROWS
#undef PG8_SA
#undef PG8_SB
#undef PG8_STAGE
#undef PG8_LDA
#undef PG8_LDB
#undef PG8_MMA
#undef PG8_WAIT_V
#undef PG8_WAIT_L
#undef PG8_WAIT_V8R
#undef PG8_BAR
#undef PG8_SCHED
}
}
namespace attn_body {
using bf16=__hip_bfloat16;
using bf16x8=__attribute__((ext_vector_type(8)))short;
using s16x4=__attribute__((ext_vector_type(4)))short;
using f32x16=__attribute__((ext_vector_type(16)))float;
using u32x4=__attribute__((ext_vector_type(4)))unsigned;
__device__ __forceinline__ int crow(int r,int hi){return (r&3)+8*(r>>2)+4*hi;}
#define SBAR() __builtin_amdgcn_sched_barrier(0)
__device__ __forceinline__ void glds16(const void*gsrc,unsigned lds_dst){unsigned keep;
  asm volatile("s_mov_b32 %0, m0\n\ts_mov_b32 m0, %2\n\ts_nop 0\n\tglobal_load_lds_dwordx4 %1, off\n\ts_mov_b32 m0, %0":"=&s"(keep):"v"(gsrc),"s"(lds_dst):"memory");}
__device__ __forceinline__ float max3f(float a,float b,float c){float r;asm("v_max3_f32 %0, %1, %2, %3":"=v"(r):"v"(a),"v"(b),"v"(c));return r;}
__device__ __forceinline__ float max2f(float a,float b){float r;asm("v_max_f32_e32 %0, %1, %2":"=v"(r):"v"(a),"v"(b));return r;}
__device__ __forceinline__ float fadd_s(float a,float b){float r;asm("v_add_f32_e32 %0, %1, %2":"=v"(r):"v"(a),"v"(b));return r;}
__device__ __forceinline__ float fsub_s(float a,float b){float r;asm("v_sub_f32_e32 %0, %1, %2":"=v"(r):"v"(a),"v"(b));return r;}
typedef float f32x2_t __attribute__((ext_vector_type(2))); typedef __bf16 bf16x2_t __attribute__((ext_vector_type(2)));
__device__ __forceinline__ unsigned cvtpk_s(float lo,float hi){f32x2_t v={lo,hi};bf16x2_t b=__builtin_convertvector(v,bf16x2_t);return __builtin_bit_cast(unsigned,b);}
#define WAIT_BAR(N) asm volatile("s_waitcnt vmcnt(" #N ") lgkmcnt(0)\n\ts_barrier":::"memory")
typedef __attribute__((address_space(3))) const char* lds_cptr;
typedef short v4i16_t __attribute__((ext_vector_type(4)));
__device__ __forceinline__ void kload8(bf16x8*kf,lds_cptr kp){
  kf[0]=*(const __attribute__((address_space(3))) bf16x8*)(kp);      kf[1]=*(const __attribute__((address_space(3))) bf16x8*)(kp+512);
  kf[2]=*(const __attribute__((address_space(3))) bf16x8*)(kp+2048); kf[3]=*(const __attribute__((address_space(3))) bf16x8*)(kp+2560);
  kf[4]=*(const __attribute__((address_space(3))) bf16x8*)(kp+4096); kf[5]=*(const __attribute__((address_space(3))) bf16x8*)(kp+4608);
  kf[6]=*(const __attribute__((address_space(3))) bf16x8*)(kp+6144); kf[7]=*(const __attribute__((address_space(3))) bf16x8*)(kp+6656);
}
__device__ __forceinline__ void kload2(bf16x8*kf,lds_cptr kp,int j){ kf[2*j]=*(const __attribute__((address_space(3))) bf16x8*)(kp+j*2048); kf[2*j+1]=*(const __attribute__((address_space(3))) bf16x8*)(kp+j*2048+512); }
__device__ __forceinline__ s16x4 vtr(lds_cptr p){ return __builtin_bit_cast(s16x4,__builtin_amdgcn_ds_read_tr16_b64_v4i16((__attribute__((address_space(3))) v4i16_t*)p)); }
__device__ __forceinline__ float rowmax(const f32x16&p0,const f32x16&p1){
  float a=max3f(p0[0],p0[1],p1[0]),b=max3f(p0[2],p0[3],p1[1]);a=max3f(a,p1[2],p1[3]);
  #pragma unroll
  for(int r=4;r<16;r+=4){a=max3f(a,p0[r],p0[r+1]);b=max3f(b,p0[r+2],p0[r+3]);a=max3f(a,p1[r],p1[r+1]);b=max3f(b,p1[r+2],p1[r+3]);}
  const float m=max2f(a,b);
  auto rr=__builtin_amdgcn_permlane32_swap(__float_as_uint(m),__float_as_uint(m),false,false);
  return max2f(__uint_as_float(rr[0]),__uint_as_float(rr[1]));
}
__device__ __forceinline__ void pv(f32x16*o,int vb,bf16x8 pa0,bf16x8 pa1,bf16x8 pa2,bf16x8 pa3){
  #pragma unroll
  for(int d0=0;d0<2;++d0){s16x4 lo[4],hi[4];
    #pragma unroll
    for(int ks=0;ks<4;++ks){
      asm volatile("ds_read_b64_tr_b16 %0,%1 offset:%c2":"=&v"(lo[ks]):"v"(vb),"i"(d0*4096+ks*1024):"memory");
      asm volatile("ds_read_b64_tr_b16 %0,%1 offset:%c2":"=&v"(hi[ks]):"v"(vb),"i"(d0*4096+ks*1024+512):"memory");}
    asm volatile("s_waitcnt lgkmcnt(0)":::"memory");SBAR();
    #define PK(k) (bf16x8){lo[k][0],lo[k][1],lo[k][2],lo[k][3],hi[k][0],hi[k][1],hi[k][2],hi[k][3]}
    o[d0]=__builtin_amdgcn_mfma_f32_32x32x16_bf16(pa0,PK(0),o[d0],0,0,0);
    o[d0]=__builtin_amdgcn_mfma_f32_32x32x16_bf16(pa1,PK(1),o[d0],0,0,0);
    o[d0]=__builtin_amdgcn_mfma_f32_32x32x16_bf16(pa2,PK(2),o[d0],0,0,0);
    o[d0]=__builtin_amdgcn_mfma_f32_32x32x16_bf16(pa3,PK(3),o[d0],0,0,0);
    #undef PK
  }
}
}

constexpr int BATCH = 8, SEQ = 4096, T = BATCH * SEQ, D = 1024, NE = 32, TOPK = 4, NH = 16, HD = 64;
constexpr int NQKV = 9216;
constexpr int MAXROWS = T * TOPK + NE * 256;
constexpr int MAXTILES = MAXROWS / 256;
constexpr int NVB = T / 128;
constexpr float LOG2E = 1.4426950408889634f;
constexpr float QSCALE = 0.125f * LOG2E;
constexpr float RMS_EPS = 1e-6f;
constexpr int NWAVES = 8;

constexpr size_t MiB = 1ull << 20;
constexpr size_t WS_CTL = 0, CTL_ZERO_BYTES = 1 * MiB;
constexpr size_t WS_SM = 1 * MiB;
constexpr size_t SM_ADA = WS_SM;
constexpr size_t SM_GM = WS_SM + 512 * 1024;
constexpr size_t SM_CSH = WS_SM + 640 * 1024;
constexpr size_t SM_BIAST = WS_SM + 644 * 1024;
constexpr size_t SM_BLKCNT = WS_SM + 704 * 1024;
constexpr size_t SM_TILEEXP = WS_SM + 768 * 1024;
constexpr size_t SM_TOPI = WS_SM + 1 * MiB;
constexpr size_t SM_TOPG = SM_TOPI + 512 * 1024;
constexpr size_t SM_RANK = SM_TOPG + 512 * 1024;
constexpr size_t SM_SLOT = SM_RANK + 512 * 1024;
constexpr size_t SM_TOKSLOT = WS_SM + 3 * MiB;
constexpr size_t SM_LOGF = WS_SM + 4 * MiB;
constexpr size_t SM_FCUM = WS_SM + 6 * MiB;
constexpr size_t SM_LSE = WS_SM + 8 * MiB;
constexpr size_t WS_WQKV = 16 * MiB, WS_WO0 = 34 * MiB, WS_WKV = 36 * MiB, WS_WQ = 40 * MiB, WS_WO1 = 42 * MiB, WS_WGU = 44 * MiB, WS_WDN = 300 * MiB;
constexpr size_t WS_HKV = 428 * MiB, WS_H = 492 * MiB, WS_OG = 556 * MiB, WS_O = 748 * MiB;
constexpr size_t WS_QKV0 = 812 * MiB, WS_ACT = 812 * MiB, WS_Y = 1084 * MiB, WS_QKV1 = 1388 * MiB, WS_XB = 1388 * MiB, WS_H8 = 1524 * MiB, WS_END = 1660 * MiB, WS_XS = WS_H;
static_assert(WS_H == WS_HKV + (size_t)T * D * 2, "H must follow HKV (KVQ GEMM addresses both through one A pointer)");
static_assert(WS_WQ == WS_WKV + (size_t)2048 * 1024 * 2, "Wq_t must follow Wkv_t");
static_assert(SM_LSE + (size_t)3 * T * 16 * 4 <= WS_WQKV, "small region");
static_assert(WS_Y + (size_t)MAXROWS * D * 2 <= WS_QKV1 && WS_XB + (size_t)MAXROWS * D * 2 <= WS_END && WS_QKV0 + (size_t)BATCH * 9 * 16 * SEQ * 64 * 2 <= WS_QKV1, "ws map");
constexpr int CW_TMO = 0, CW_BAR = 4096, CW_QUEUE = 65536  , CW_NRM = 131072  ;

constexpr int RING_OFF = 0, RING_BYTES = 131072;
constexpr int SCR_OFF = RING_BYTES, SCR_BYTES = 16384;
constexpr int BLK_OFF = SCR_OFF + SCR_BYTES, BLK_BYTES = 12288;
constexpr int MISC_OFF = BLK_OFF + BLK_BYTES;
constexpr int LDS_BYTES = MISC_OFF + 256;
constexpr int BL_TILE = 0, BL_WCNT = 576, BL_WBASE = 832, BL_PARTA = 1088, BL_PARTB = 1600, BL_TOT = 2112, BL_BASE = 2144, BL_PADS = 2176;

#define LAS __attribute__((address_space(3)))
#define GAS __attribute__((address_space(1)))
typedef unsigned short bf16;
typedef float f32x4 __attribute__((ext_vector_type(4)));
typedef unsigned u32x4v __attribute__((ext_vector_type(4)));
typedef unsigned u32x2v __attribute__((ext_vector_type(2)));
typedef int i32x4v __attribute__((ext_vector_type(4)));
#define LDS_WAIT() asm volatile("s_waitcnt lgkmcnt(0)" ::: "memory")
#define VM_WAIT() asm volatile("s_waitcnt vmcnt(0)" ::: "memory")

__device__ __forceinline__ float bf2f(unsigned v) { return __uint_as_float(v << 16); }
__device__ __forceinline__ unsigned pkbf(float lo, float hi) { return attn_body::cvtpk_s(lo, hi); }
__device__ __forceinline__ float wave_sum(float v) {
#pragma unroll
    for (int o = 1; o < 64; o <<= 1) v += __shfl_xor(v, o);
    return v;
}

namespace pg8 {
struct EpiQKV0 {
    static constexpr bool PERM = true, AFTER_DRAIN = false; static constexpr int NSTORE = 16;
    bf16_t* O; float mul;
    __device__ __forceinline__ void operator()(const f32x4 (&acc)[2][2][4][2], const Unit& u, int wr, int wc, int fr, int fq) const {
        _Pragma("unroll") for (int rep_e = 0; rep_e < 1 + ((PROBE_EPI >> 0) & 1); ++rep_e) {
        asm volatile("" : "+v"(fr), "+v"(fq));
        const int g = u.pn / 12, rem = u.pn - g * 12, which = rem >> 2, h0 = (rem & 3) * 4, sh = 2 * g;
        const float sc = (which == 0 ? QSCALE : 1.f) * mul;
#pragma unroll
        for (int ai = 0; ai < 2; ++ai)
#pragma unroll
            for (int m = 0; m < 4; ++m) {
                const int tok = u.pm * BM + ai * HALF + wr * 64 + m * 16 + fr, b = tok >> 12, s = tok & 4095;
                const int subrow = (s & ((1 << sh) - 1)) * (4096 >> sh) + (s >> sh);
#pragma unroll
                for (int bj = 0; bj < 2; ++bj) {
                    const int head = h0 + 2 * bj + (wc >> 1), dcol = (wc & 1) * 32 + 8 * fq;
                    const size_t plane = (size_t)(((b * 3 + g) * 3 + which) * 16 + head);
                    const f32x4 v0 = acc[ai][bj][m][0] * sc, v1 = acc[ai][bj][m][1] * sc;
                    u32x4 w; w.x = cvt_pk_bf16(v0[0], v0[1]); w.y = cvt_pk_bf16(v0[2], v0[3]); w.z = cvt_pk_bf16(v1[0], v1[1]); w.w = cvt_pk_bf16(v1[2], v1[3]);
#if NT_STORE
                    __builtin_nontemporal_store(w, (u32x4*)(O + (plane * 4096 + subrow) * 64 + dcol));
#else
                    *(u32x4*)(O + (plane * 4096 + subrow) * 64 + dcol) = w;
#endif
                }
            }
        }
    }
};
struct EpiQKV0Probe {
    static constexpr bool PERM = true, AFTER_DRAIN = false; static constexpr int NSTORE = 16;
    bf16_t* O; float mul; int wide;
    __device__ __forceinline__ void operator()(const f32x4 (&acc)[2][2][4][2], const Unit& u, int wr, int wc, int fr, int fq) const {
        asm volatile("" : "+v"(fr), "+v"(fq));
        const int g = u.pn / 12, rem = u.pn - g * 12, which = rem >> 2, h0 = (rem & 3) * 4, sh = 2 * g;
        const float sc = (which == 0 ? QSCALE : 1.f) * mul;
#pragma unroll
        for (int ai = 0; ai < 2; ++ai)
#pragma unroll
            for (int m = 0; m < 4; ++m) {
                const int tok = u.pm * BM + ai * HALF + wr * 64 + m * 16 + fr, b = tok >> 12, s = tok & 4095;
                const int subrow = (s & ((1 << sh) - 1)) * (4096 >> sh) + (s >> sh);
                const int head = h0 + wc, dcol = 16 * fq;
                const size_t plane = (size_t)(((b * 3 + g) * 3 + which) * 16 + head);
#pragma unroll
                for (int bj = 0; bj < 2; ++bj) {
                    const f32x4 v0 = acc[ai][bj][m][0] * sc, v1 = acc[ai][bj][m][1] * sc;
                    u32x4 w; w.x = cvt_pk_bf16(v0[0], v0[1]); w.y = cvt_pk_bf16(v0[2], v0[3]); w.z = cvt_pk_bf16(v1[0], v1[1]); w.w = cvt_pk_bf16(v1[2], v1[3]);
                    if (wide == 4) { const size_t off_ = ((size_t)(u.pm * 36 + u.pn) * 131072 + (size_t)(wr * 4 + wc) * 16384 + (size_t)((ai * 4 + m) * 2 + bj) * 1024 + fr * 64 + fq * 16) & (size_t)0x7fffff;
                        *(u32x4*)((unsigned char*)O + off_) = w; }
                    else if (wide != 3 || m == 0) *(u32x4*)(O + (((plane * 4096 + subrow) * 64 + dcol + 8 * bj) & (size_t)(wide == 2 ? 0x3fffff : 0x7fffffffff)) ) = w; else if (w.x == 0x12345678u) O[0] = 1;
                }
            }
    }
};
struct EpiKVQ {
    static constexpr bool PERM = true, AFTER_DRAIN = false; static constexpr int NSTORE = 16;
    bf16_t* O; float mul; unsigned* nrm;
    __device__ __forceinline__ void operator()(const f32x4 (&acc)[2][2][4][2], const Unit& u, int wr, int wc, int fr, int fq) const {
        asm volatile("" : "+v"(fr), "+v"(fq));
        const int which = u.pn < 4 ? 1 : (u.pn < 8 ? 2 : 0), h0 = (u.pn & 3) * 4, pm = u.pm & 127;
        const float sc = (which == 0 ? QSCALE : 1.f) * mul;
        float nmax[2] = {0.f, 0.f};
#pragma unroll
        for (int ai = 0; ai < 2; ++ai)
#pragma unroll
            for (int m = 0; m < 4; ++m) {
                const int tok = pm * BM + ai * HALF + wr * 64 + m * 16 + fr, b = tok >> 12, s = tok & 4095;
#pragma unroll
                for (int bj = 0; bj < 2; ++bj) {
                    const int head = h0 + 2 * bj + (wc >> 1), dcol = (wc & 1) * 32 + 8 * fq;
                    const size_t plane = (size_t)((b * 3 + which) * 16 + head);
                    const f32x4 v0 = acc[ai][bj][m][0] * sc, v1 = acc[ai][bj][m][1] * sc;
                    u32x4 w; w.x = cvt_pk_bf16(v0[0], v0[1]); w.y = cvt_pk_bf16(v0[2], v0[3]); w.z = cvt_pk_bf16(v1[0], v1[1]); w.w = cvt_pk_bf16(v1[2], v1[3]);
                    *(u32x4*)(O + (plane * 4096 + s) * 64 + dcol) = w;
                    if (which != 2) {
                        float ss = 0.f;
#pragma unroll
                        for (int k4 = 0; k4 < 4; ++k4) { const unsigned pw_ = k4 == 0 ? w.x : (k4 == 1 ? w.y : (k4 == 2 ? w.z : w.w)); const float lo_ = __uint_as_float(pw_ << 16), hi_ = __uint_as_float(pw_ & 0xffff0000u); ss += lo_ * lo_ + hi_ * hi_; }
                        ss += __shfl_xor(ss, 16); ss += __shfl_xor(ss, 32);
                        nmax[bj] = fmaxf(nmax[bj], ss);
                    }
                }
            }
        if (which != 2) {
#pragma unroll
            for (int bj = 0; bj < 2; ++bj) { float v = nmax[bj];
                v = fmaxf(v, __shfl_xor(v, 1)); v = fmaxf(v, __shfl_xor(v, 2)); v = fmaxf(v, __shfl_xor(v, 4)); v = fmaxf(v, __shfl_xor(v, 8));
                if (fr == 0 && fq == 0) { const int b0 = (pm * BM) >> 12, head = h0 + 2 * bj + (wc >> 1);
                    atomicMax(nrm + (((b0 * 2 + which) * 16 + head) * 2 + (wc & 1)), __float_as_uint(v)); } }
        }
    }
};
template <bool SRC_BF16> struct EpiResid {
    static constexpr bool PERM = true, AFTER_DRAIN = false; static constexpr int NSTORE = 16;
    const void* src; bf16_t* dst; const float* gate; float mul;
    __device__ __forceinline__ void operator()(const f32x4 (&acc)[2][2][4][2], const Unit& u, int wr, int wc, int fr, int fq) const {
        asm volatile("" : "+v"(fr), "+v"(fq));
#pragma unroll
        for (int ai = 0; ai < 2; ++ai)
#pragma unroll
            for (int m = 0; m < 4; ++m) {
                const int row = u.pm * BM + ai * HALF + wr * 64 + m * 16 + fr, b = row >> 12;
#pragma unroll
                for (int bj = 0; bj < 2; ++bj) {
                    const int col = u.pn * BM + bj * HALF + wc * 32 + 8 * fq;
                    f32x4 x0, x1;
                    if (SRC_BF16) { const u32x4 r = *(const u32x4*)((const bf16_t*)src + (size_t)row * D + col);
                        x0 = (f32x4){__uint_as_float(r.x << 16), __uint_as_float(r.x & 0xffff0000u), __uint_as_float(r.y << 16), __uint_as_float(r.y & 0xffff0000u)};
                        x1 = (f32x4){__uint_as_float(r.z << 16), __uint_as_float(r.z & 0xffff0000u), __uint_as_float(r.w << 16), __uint_as_float(r.w & 0xffff0000u)}; }
                    else if (NT_ROWS) { x0 = __builtin_nontemporal_load((const f32x4*)((const float*)src + (size_t)row * D + col)); x1 = __builtin_nontemporal_load((const f32x4*)((const float*)src + (size_t)row * D + col + 4)); }
                    else { x0 = *(const f32x4*)((const float*)src + (size_t)row * D + col); x1 = *(const f32x4*)((const float*)src + (size_t)row * D + col + 4); }
                    const f32x4 g0 = *(const f32x4*)(gate + b * 6144 + col), g1 = *(const f32x4*)(gate + b * 6144 + col + 4);
                    const f32x4 v0 = x0 + (g0 * mul) * acc[ai][bj][m][0], v1 = x1 + (g1 * mul) * acc[ai][bj][m][1];
                    u32x4 w; w.x = cvt_pk_bf16(v0[0], v0[1]); w.y = cvt_pk_bf16(v0[2], v0[3]); w.z = cvt_pk_bf16(v1[0], v1[1]); w.w = cvt_pk_bf16(v1[2], v1[3]);
                    *(u32x4*)(dst + (size_t)row * D + col) = w;
                }
            }
    }
};
struct EpiSwiGLU {
    static constexpr bool PERM = true, AFTER_DRAIN = false; static constexpr int NSTORE = 0;
    bf16_t* ACT; const float* bgu;
    __device__ __forceinline__ void operator()(const f32x4 (&acc)[2][2][4][2], const Unit& u, int wr, int wc, int fr, int fq) const {
        const int e = u.pn >> 3, pnl = u.pn & 7, j0 = pnl * 128 + wc * 32 + 8 * fq;
        f32x4 bg[2], bu[2];
#pragma unroll
        for (int n = 0; n < 2; ++n) { bg[n] = *(const f32x4*)(bgu + e * 2048 + j0 + 4 * n); bu[n] = *(const f32x4*)(bgu + e * 2048 + 1024 + j0 + 4 * n); }
#pragma unroll
        for (int ai = 0; ai < 2; ++ai)
#pragma unroll
            for (int m = 0; m < 4; ++m) {
                const int row = u.pm * BM + ai * HALF + wr * 64 + m * 16 + fr;
                float a[8];
#pragma unroll
                for (int n = 0; n < 2; ++n) {
                    const f32x4 gv = acc[ai][0][m][n] + bg[n], uv = acc[ai][1][m][n] + bu[n];
#pragma unroll
                    for (int i = 0; i < 4; ++i) {
                        const float gg = fminf(gv[i], 7.f), uu = fminf(fmaxf(uv[i], -7.f), 7.f);
                        const float sg = __builtin_amdgcn_rcpf(1.f + __builtin_amdgcn_exp2f(-1.702f * LOG2E * gg));
                        a[4 * n + i] = (uu + 1.f) * gg * sg;
                    }
                }
                u32x4 w; w.x = cvt_pk_bf16(a[0], a[1]); w.y = cvt_pk_bf16(a[2], a[3]); w.z = cvt_pk_bf16(a[4], a[5]); w.w = cvt_pk_bf16(a[6], a[7]);
                *(u32x4*)(ACT + (size_t)row * D + j0) = w;
            }
    }
};
struct EpiDown {
    static constexpr bool PERM = true, AFTER_DRAIN = false; static constexpr int NSTORE = 0;
    bf16_t* Y; const float* bdn;
    __device__ __forceinline__ void operator()(const f32x4 (&acc)[2][2][4][2], const Unit& u, int wr, int wc, int fr, int fq) const {
        const int e = u.pn >> 2, pnl = u.pn & 3;
#pragma unroll
        for (int ai = 0; ai < 2; ++ai)
#pragma unroll
            for (int m = 0; m < 4; ++m) {
                const int row = u.pm * BM + ai * HALF + wr * 64 + m * 16 + fr;
#pragma unroll
                for (int bj = 0; bj < 2; ++bj) {
                    const int col = pnl * BM + bj * HALF + wc * 32 + 8 * fq;
                    const f32x4 b0 = *(const f32x4*)(bdn + e * 1024 + col), b1 = *(const f32x4*)(bdn + e * 1024 + col + 4);
                    const f32x4 v0 = acc[ai][bj][m][0] + b0, v1 = acc[ai][bj][m][1] + b1;
                    u32x4 w; w.x = cvt_pk_bf16(v0[0], v0[1]); w.y = cvt_pk_bf16(v0[2], v0[3]); w.z = cvt_pk_bf16(v1[0], v1[1]); w.w = cvt_pk_bf16(v1[2], v1[3]);
                    *(u32x4*)(Y + (size_t)row * D + col) = w;
                }
            }
    }
};
__device__ __forceinline__ unsigned pk4_fp8(float a, float b, float c, float d) { int v = __builtin_amdgcn_cvt_pk_fp8_f32(a, b, 0, false); v = __builtin_amdgcn_cvt_pk_fp8_f32(c, d, v, true); return (unsigned)v; }
struct EpiQKV08 {
    static constexpr bool PERM = true, AFTER_DRAIN = false; static constexpr int NSTORE = 16;
    unsigned char* O; float mul;
    __device__ __forceinline__ void operator()(const f32x4 (&acc)[2][2][4][2], const Unit& u, int wr, int wc, int fr, int fq) const {
        asm volatile("" : "+v"(fr), "+v"(fq));
        const int g = u.pn / 12, rem = u.pn - g * 12, which = rem >> 2, h0 = (rem & 3) * 4, sh = 2 * g;
        const float sc = (which == 0 ? QSCALE : 1.f) * mul;
#pragma unroll
        for (int ai = 0; ai < 2; ++ai)
#pragma unroll
            for (int m = 0; m < 4; ++m) {
                const int tok = u.pm * BM + ai * HALF + wr * 64 + m * 16 + fr, b = tok >> 12, s = tok & 4095;
                const int subrow = (s & ((1 << sh) - 1)) * (4096 >> sh) + (s >> sh);
#pragma unroll
                for (int bj = 0; bj < 2; ++bj) {
                    const int head = h0 + 2 * bj + (wc >> 1), dcol = (wc & 1) * 32 + 8 * fq;
                    const size_t plane = (size_t)(((b * 3 + g) * 3 + which) * 16 + head);
                    const f32x4 v0 = acc[ai][bj][m][0] * sc, v1 = acc[ai][bj][m][1] * sc;
                    typedef unsigned u32x2e __attribute__((ext_vector_type(2)));
                    u32x2e w8; w8.x = pk4_fp8(v0[0], v0[1], v0[2], v0[3]); w8.y = pk4_fp8(v1[0], v1[1], v1[2], v1[3]);
                    *(u32x2e*)(O + (plane * 4096 + subrow) * 64 + dcol) = w8;
                }
            }
    }
};
struct EpiQKV08W {
    static constexpr bool PERM = true, AFTER_DRAIN = false; static constexpr int NSTORE = 8;
    unsigned char* O; float mul;
    __device__ __forceinline__ void operator()(const f32x4 (&acc)[2][2][4][2], const Unit& u, int wr, int wc, int fr, int fq) const {
        asm volatile("" : "+v"(fr), "+v"(fq));
        const int g = u.pn / 12, rem = u.pn - g * 12, which = rem >> 2, head = (rem & 3) * 4 + wc, sh = 2 * g;
        const float sc = (which == 0 ? QSCALE : 1.f) * mul;
#pragma unroll
        for (int ai = 0; ai < 2; ++ai)
#pragma unroll
            for (int m = 0; m < 4; ++m) {
                const int tok = u.pm * BM + ai * HALF + wr * 64 + m * 16 + fr, b = tok >> 12, s = tok & 4095;
                const int subrow = (s & ((1 << sh) - 1)) * (4096 >> sh) + (s >> sh);
                const size_t plane = (size_t)(((b * 3 + g) * 3 + which) * 16 + head);
                u32x4 w;
                { const f32x4 v0 = acc[ai][0][m][0] * sc, v1 = acc[ai][0][m][1] * sc; w.x = pk4_fp8(v0[0], v0[1], v0[2], v0[3]); w.y = pk4_fp8(v1[0], v1[1], v1[2], v1[3]); }
                { const f32x4 v0 = acc[ai][1][m][0] * sc, v1 = acc[ai][1][m][1] * sc; w.z = pk4_fp8(v0[0], v0[1], v0[2], v0[3]); w.w = pk4_fp8(v1[0], v1[1], v1[2], v1[3]); }
                *(u32x4*)(O + (plane * 4096 + subrow) * 64 + 16 * fq) = w;
            }
    }
};
struct EpiSwiGLU8 {
    static constexpr bool PERM = true, AFTER_DRAIN = false; static constexpr int NSTORE = 8;
    unsigned char* ACT; const float* bgu;
    __device__ __forceinline__ void operator()(const f32x4 (&acc)[2][2][4][2], const Unit& u, int wr, int wc, int fr, int fq) const {
        _Pragma("unroll") for (int rep_e = 0; rep_e < 1 + ((PROBE_EPI >> 1) & 1); ++rep_e) {
        asm volatile("" : "+v"(fr), "+v"(fq));
        const int e = u.pn >> 3, pnl = u.pn & 7, j0 = pnl * 128 + wc * 32 + 8 * fq;
        f32x4 bg[2], bu[2];
#pragma unroll
        for (int n = 0; n < 2; ++n) { bg[n] = *(const f32x4*)(bgu + e * 2048 + j0 + 4 * n) * 64.f; bu[n] = *(const f32x4*)(bgu + e * 2048 + 1024 + j0 + 4 * n) * 64.f + 64.f; }
#pragma unroll
        for (int ai = 0; ai < 2; ++ai)
#pragma unroll
            for (int m = 0; m < 4; ++m) {
                const int row = u.pm * BM + ai * HALF + wr * 64 + m * 16 + fr;
                float a[8];
#pragma unroll
                for (int n = 0; n < 2; ++n) {
                    const f32x4 gv = acc[ai][0][m][n] + bg[n], uv = acc[ai][1][m][n] + bu[n];
#pragma unroll
                    for (int i = 0; i < 4; ++i) {
                        const float gg = fminf(gv[i], 448.f), uu = fminf(fmaxf(uv[i], -384.f), 512.f);
                        const float t = __builtin_amdgcn_exp2f((-1.702f * LOG2E * 0.015625f) * gg);
                        const float sg = __builtin_amdgcn_rcpf(__builtin_fmaf(t, 4096.f, 4096.f));
                        a[4 * n + i] = (uu * gg) * sg;
                    }
                }
                typedef unsigned u32x2e __attribute__((ext_vector_type(2)));
                u32x2e w; w.x = pk4_fp8(a[0], a[1], a[2], a[3]); w.y = pk4_fp8(a[4], a[5], a[6], a[7]);
                *(u32x2e*)(ACT + (size_t)row * D + j0) = w;
            }
        }
    }
};
template <int VAR> struct EpiProbeGU {
    static constexpr bool PERM = true, AFTER_DRAIN = false; static constexpr int NSTORE = 0;
    unsigned char* ACT; const float* bgu;
    __device__ __forceinline__ void operator()(const f32x4 (&acc)[2][2][4][2], const Unit& u, int wr, int wc, int fr, int fq) const {
        if (VAR == 2) { if (acc[0][0][0][0][0] == 12345.678f) ACT[0] = 1; return; }
        asm volatile("" : "+v"(fr), "+v"(fq));
        const int pnl = u.pn & 7, j0 = pnl * 128 + wc * 32 + 8 * fq;
#pragma unroll
        for (int ai = 0; ai < 2; ++ai)
#pragma unroll
            for (int m = 0; m < 4; ++m) {
                const int row = u.pm * BM + ai * HALF + wr * 64 + m * 16 + fr;
                const f32x4 g0 = acc[ai][0][m][0] + acc[ai][1][m][0], g1 = acc[ai][0][m][1] + acc[ai][1][m][1];
                typedef unsigned u32x2e __attribute__((ext_vector_type(2)));
                u32x2e w; w.x = pk4_fp8(g0[0], g0[1], g0[2], g0[3]); w.y = pk4_fp8(g1[0], g1[1], g1[2], g1[3]);
                *(u32x2e*)(ACT + (size_t)row * D + j0) = w;
            }
    }
};
struct EpiNone { static constexpr bool PERM = true, AFTER_DRAIN = false; static constexpr int NSTORE = 0; unsigned char* P;
    __device__ __forceinline__ void operator()(const f32x4 (&acc)[2][2][4][2], const Unit& u, int wr, int wc, int fr, int fq) const { if (acc[0][0][0][0][0] == 12345.678f) P[0] = 1; } };
struct EpiDown8 {
    static constexpr bool PERM = true, AFTER_DRAIN = false; static constexpr int NSTORE = 16;
    bf16_t* Y; const float* bdn;
    __device__ __forceinline__ void operator()(const f32x4 (&acc)[2][2][4][2], const Unit& u, int wr, int wc, int fr, int fq) const {
        _Pragma("unroll") for (int rep_e = 0; rep_e < 1 + ((PROBE_EPI >> 2) & 1); ++rep_e) {
        asm volatile("" : "+v"(fr), "+v"(fq));
        const int e = u.pn >> 2, pnl = u.pn & 3;
#pragma unroll
        for (int ai = 0; ai < 2; ++ai)
#pragma unroll
            for (int m = 0; m < 4; ++m) {
                const int row = u.pm * BM + ai * HALF + wr * 64 + m * 16 + fr;
#pragma unroll
                for (int bj = 0; bj < 2; ++bj) {
                    const int col = pnl * BM + bj * HALF + wc * 32 + 8 * fq;
                    const f32x4 b0 = *(const f32x4*)(bdn + e * 1024 + col), b1 = *(const f32x4*)(bdn + e * 1024 + col + 4);
                    const f32x4 v0 = acc[ai][bj][m][0] * 0.015625f + b0, v1 = acc[ai][bj][m][1] * 0.015625f + b1;
                    if (Y_FP8) { typedef unsigned u32x2e __attribute__((ext_vector_type(2))); u32x2e w8; w8.x = pk4_fp8(v0[0], v0[1], v0[2], v0[3]); w8.y = pk4_fp8(v1[0], v1[1], v1[2], v1[3]);
                        *(u32x2e*)((unsigned char*)Y + (size_t)row * D + col) = w8; }
                    else { u32x4 w; w.x = cvt_pk_bf16(v0[0], v0[1]); w.y = cvt_pk_bf16(v0[2], v0[3]); w.z = cvt_pk_bf16(v1[0], v1[1]); w.w = cvt_pk_bf16(v1[2], v1[3]);
                        *(u32x4*)(Y + (size_t)row * D + col) = w; }
                }
            }
        }
    }
};
struct KVQOrder : StaticOrder {
    __device__ bool next(int i, Unit& u) const { if (!StaticOrder::next(i, u)) return false; if (u.pn >= 8) u.pm += 128; return true; }
};
template <int NN> struct MoeOrder {
    static constexpr int TR = 32 / NN;
    const LAS int* tile_exp; int n_tiles, c, G;
    __device__ __forceinline__ bool next(int i, Unit& u) const {
        int st, j;
        if (G == 256) { st = i * 8 + (c & 7); j = c >> 3; } else { const int L = i * G + c; st = L >> 5; j = L & 31; }
        const int tile = st * TR + (j % TR);
        if (tile >= n_tiles) return false;
        u.pm = tile; u.pn = tile_exp[tile] * NN + j / TR; return true;
    }
    __device__ __forceinline__ void a_ready(const Unit&) const {}
    __device__ __forceinline__ void done(const Unit&) const {}
};
struct MoeOrderProbe { const LAS int* tile_exp; int n_tiles, c, G;
    __device__ __forceinline__ bool next(int i, Unit& u) const { int st, j; if (G == 256) { st = i * 8 + (c & 7); j = c >> 3; } else { const int L = i * G + c; st = L >> 5; j = L & 31; }
        const int tile = st * 4 + (j % 4); if (tile >= n_tiles) return false; u.pm = tile; u.pn = j / 4; return true; }
    __device__ __forceinline__ void a_ready(const Unit&) const {}
    __device__ __forceinline__ void done(const Unit&) const {} };
}

namespace attn_body {
constexpr int KSLOT = 8192;
constexpr int L_K = 0, L_V = 2 * KSLOT, L_WS = 4 * KSLOT, L_OST = L_WS + 8 * 256, L_TAB = L_OST + 8 * 4096, L_ATT_END = L_TAB + 1024;
__device__ __forceinline__ void qkt2(f32x16& p0, f32x16& p1, const char* Kslot, const bf16x8* qr, const f32x16& c0, const f32x16& c1, int r32, int hi) {
  const char* kb = Kslot + hi * 1024 + r32 * 16;
  #pragma unroll
  for (int d0 = 0; d0 < 4; ++d0) {
    const bf16x8 b0 = *reinterpret_cast<const bf16x8*>(kb + d0 * 2048);
    const bf16x8 b1 = *reinterpret_cast<const bf16x8*>(kb + d0 * 2048 + 512);
    if (d0 == 0) { p0 = __builtin_amdgcn_mfma_f32_32x32x16_bf16(b0, qr[0], c0, 0, 0, 0); p1 = __builtin_amdgcn_mfma_f32_32x32x16_bf16(b1, qr[0], c1, 0, 0, 0); }
    else { p0 = __builtin_amdgcn_mfma_f32_32x32x16_bf16(b0, qr[d0], p0, 0, 0, 0); p1 = __builtin_amdgcn_mfma_f32_32x32x16_bf16(b1, qr[d0], p1, 0, 0, 0); } }
}
template <int MODE> __device__ __forceinline__ void attn_unit(const bf16* Qp, const bf16* __restrict__ Kp, const bf16* __restrict__ Vp, int q0, bf16* Ob, long ostride,
                                                               float* lse, long lstride, const float* __restrict__ F2, const float* __restrict__ tabg, char* shm) {
  const int tid = threadIdx.x, lane = tid & 63, r32 = lane & 31, hi = lane >> 5; const int wid = __builtin_amdgcn_readfirstlane(tid >> 6);
  const unsigned lds0 = (unsigned)(uintptr_t)shm;
  float* wsf = (float*)(shm + L_WS) + wid * 64;
  const int tq = q0 >> 6, t_hi = tq + 4;
  const int t_lo = (MODE == 0) ? (tq >= 2 ? tq - 2 : 0) : 0;
  const int w_hi = tq + (wid >> 1);
  const int w_lo = (MODE == 0) ? (w_hi >= 2 ? w_hi - 2 : 0) : 0;
  const bf16* ksrc = Kp + (long)lane * 64 + wid * 8;
  const bf16* vsrc = Vp + (long)(16 * (wid & 3) + (lane >> 2)) * 64 + (wid >> 2) * 32 + (lane & 3) * 8;
  const unsigned kdst = lds0 + L_K + wid * 1024, vdst = lds0 + L_V + wid * 1024;
  #define DMA_KV(t, slot) do { glds16(ksrc + (long)(t) * 4096, (unsigned)__builtin_amdgcn_readfirstlane(kdst + (slot) * KSLOT)); glds16(vsrc + (long)(t) * 4096, (unsigned)__builtin_amdgcn_readfirstlane(vdst + (slot) * KSLOT)); } while (0)
  if (MODE == 0) { float* tab = (float*)(shm + L_TAB); if (tid < 129) tab[tid] = tabg[tid]; }
  const int qi = q0 + wid * 32 + r32;
  f32x4 fk[8];
  #pragma unroll
  for (int g4 = 0; g4 < 8; ++g4) fk[g4] = (f32x4){0.f, 0.f, 0.f, 0.f};
  float Fq = 0.f;
  if (MODE == 1) { Fq = F2[qi];
    #pragma unroll
    for (int g4 = 0; g4 < 4; ++g4) { fk[g4] = *(const f32x4*)(F2 + 64 * t_lo + 4 * hi + 8 * g4); fk[4 + g4] = *(const f32x4*)(F2 + 64 * t_lo + 32 + 4 * hi + 8 * g4); } }
  bf16x8 qr[4];
  { const bf16* Qw = Qp + (long)(q0 + wid * 32) * 64;
    #pragma unroll
    for (int d0 = 0; d0 < 4; ++d0) qr[d0] = *reinterpret_cast<const bf16x8*>(&Qw[(long)r32 * 64 + d0 * 16 + hi * 8]); }
  DMA_KV(t_lo, 0);
  float m_run = -INFINITY, l_run = 0.f; f32x16 o[2]; o[0] = f32x16{}; o[1] = f32x16{};
  const int vb0 = (int)(lds0 + L_V) + ((lane >> 4) & 1) * 32 + (lane & 3) * 8 + (4 * hi + ((lane & 15) >> 2)) * 64;
  for (int t = t_lo; t < t_hi; ++t) {
    const int s = (t - t_lo) & 1;
    asm volatile("s_waitcnt vmcnt(0) lgkmcnt(0)\n\ts_barrier" ::: "memory");
    f32x4 fn[8];
    #pragma unroll
    for (int g4 = 0; g4 < 8; ++g4) fn[g4] = fk[g4];
    if (t + 1 < t_hi) {
      if (MODE == 1) {
        #pragma unroll
        for (int g4 = 0; g4 < 4; ++g4) { fn[g4] = *(const f32x4*)(F2 + 64 * (t + 1) + 4 * hi + 8 * g4); fn[4 + g4] = *(const f32x4*)(F2 + 64 * (t + 1) + 32 + 4 * hi + 8 * g4); } }
      DMA_KV(t + 1, s ^ 1);
    }
    if (t >= w_lo && t <= w_hi) {
      f32x16 c0, c1, p0, p1;
      if (MODE == 1) {
        #pragma unroll
        for (int r = 0; r < 16; ++r) { c0[r] = Fq - fk[r >> 2][r & 3]; c1[r] = Fq - fk[4 + (r >> 2)][r & 3]; }
      } else {
        const float* tab = (const float*)(shm + L_TAB);
        #pragma unroll
        for (int r = 0; r < 16; ++r) { const int d0_ = qi - (64 * t + crow(r, hi)), d1_ = d0_ - 32;
          c0[r] = tab[d0_ < 0 ? 0 : (d0_ > 128 ? 128 : d0_)]; c1[r] = tab[d1_ < 0 ? 0 : (d1_ > 128 ? 128 : d1_)]; }
      }
      qkt2(p0, p1, shm + L_K + s * KSLOT, qr, c0, c1, r32, hi);
      if (MODE == 1) {
        if (t == w_hi) {
          #pragma unroll
          for (int r = 0; r < 16; ++r) { const int kv = 64 * t + crow(r, hi); if (kv > qi) p0[r] = -INFINITY; if (kv + 32 > qi) p1[r] = -INFINITY; } }
      } else {
        #pragma unroll
        for (int r = 0; r < 16; ++r) { const int d0_ = qi - (64 * t + crow(r, hi)), d1_ = d0_ - 32;
          if ((unsigned)d0_ > 128u) p0[r] = -INFINITY; if ((unsigned)d1_ > 128u) p1[r] = -INFINITY; }
      }
      const float rm = rowmax(p0, p1), mnew = fmaxf(m_run, rm), msub = (mnew == -INFINITY) ? 0.f : mnew;
      const float f = __builtin_amdgcn_exp2f(m_run - msub);
      m_run = mnew;
      float sacc = 0.f;
      #pragma unroll
      for (int r = 0; r < 16; ++r) { p0[r] = __builtin_amdgcn_exp2f(p0[r] - msub); p1[r] = __builtin_amdgcn_exp2f(p1[r] - msub); sacc += p0[r] + p1[r]; }
      l_run = l_run * f + sacc;
      if (__any(f != 1.f)) {
        if (hi == 0) wsf[r32] = f;
        asm volatile("s_waitcnt lgkmcnt(0)" ::: "memory");
        #pragma unroll
        for (int r = 0; r < 16; ++r) { const float ff = wsf[crow(r, hi)]; o[0][r] *= ff; o[1][r] *= ff; }
      }
      u32x4 pw0, pw1, pw2, pw3;
      pw0 = (u32x4){cvtpk_s(p0[0], p0[1]), cvtpk_s(p0[2], p0[3]), cvtpk_s(p0[4], p0[5]), cvtpk_s(p0[6], p0[7])};
      pw1 = (u32x4){cvtpk_s(p0[8], p0[9]), cvtpk_s(p0[10], p0[11]), cvtpk_s(p0[12], p0[13]), cvtpk_s(p0[14], p0[15])};
      pw2 = (u32x4){cvtpk_s(p1[0], p1[1]), cvtpk_s(p1[2], p1[3]), cvtpk_s(p1[4], p1[5]), cvtpk_s(p1[6], p1[7])};
      pw3 = (u32x4){cvtpk_s(p1[8], p1[9]), cvtpk_s(p1[10], p1[11]), cvtpk_s(p1[12], p1[13]), cvtpk_s(p1[14], p1[15])};
      SBAR();
      pv(o, vb0 + s * KSLOT, __builtin_bit_cast(bf16x8, pw0), __builtin_bit_cast(bf16x8, pw1), __builtin_bit_cast(bf16x8, pw2), __builtin_bit_cast(bf16x8, pw3));
    }
    #pragma unroll
    for (int g4 = 0; g4 < 8; ++g4) fk[g4] = fn[g4];
  }
  { auto rr = __builtin_amdgcn_permlane32_swap(__float_as_uint(l_run), __float_as_uint(l_run), false, false); l_run = __uint_as_float(rr[0]) + __uint_as_float(rr[1]); }
  if (hi == 0) { wsf[32 + r32] = l_run; if (MODE == 0) lse[(long)qi * lstride] = m_run + __builtin_amdgcn_logf(l_run); }
  asm volatile("s_waitcnt lgkmcnt(0)" ::: "memory");
  float rli[16];
  #pragma unroll
  for (int r = 0; r < 16; ++r) rli[r] = __builtin_amdgcn_rcpf(wsf[32 + crow(r, hi)]);
  { bf16* stg = (bf16*)(shm + L_OST) + wid * 2048;
    #pragma unroll
    for (int r = 0; r < 16; ++r) { const int orow = crow(r, hi);
      #pragma unroll
      for (int d0 = 0; d0 < 2; ++d0) stg[orow * 64 + d0 * 32 + r32] = __float2bfloat16(o[d0][r] * rli[r]); }
    asm volatile("s_waitcnt lgkmcnt(0)" ::: "memory");
    bf16* Ow = Ob + (long)(q0 + wid * 32) * ostride;
    #pragma unroll
    for (int i = 0; i < 4; ++i) { const int row = i * 8 + (lane >> 3), ch = lane & 7; const u32x4 v = *(const u32x4*)(stg + row * 64 + ch * 8); *(u32x4*)(Ow + (long)row * ostride + ch * 8) = v; } }
  asm volatile("s_waitcnt lgkmcnt(0)\n\ts_barrier" ::: "memory");
  #undef DMA_KV
}
#undef SBAR
#undef WAIT_BAR
}

namespace attn_body {
constexpr int NSLOT = 3, SLOTB = 8192;
constexpr int T_K = 0, T_V = NSLOT * SLOTB, T_WS = 2 * NSLOT * SLOTB, T_OST = T_WS + 8 * 256, T_END = T_OST + 8 * 4096;
constexpr int T_F = 90112;
__device__ __forceinline__ void glds16s(unsigned voff,const void*sbase,unsigned lds_dst){unsigned keep;
  asm volatile("s_mov_b32 %0, m0\n\ts_mov_b32 m0, %3\n\ts_nop 0\n\tglobal_load_lds_dwordx4 %1, %2\n\ts_mov_b32 m0, %0":"=&s"(keep):"v"(voff),"s"(sbase),"s"(lds_dst):"memory");}
#define SBAR() __builtin_amdgcn_sched_barrier(0)
#define WAIT_BAR(N) asm volatile("s_waitcnt vmcnt(" #N ") lgkmcnt(0)\n\ts_barrier":::"memory")
template<int MODE, int THRL> __device__ __forceinline__ void attn_unit_t(const bf16* Qw0, const bf16* __restrict__ Kb, const bf16* __restrict__ Vb, const int NT, const int qoff,
                                                                         bf16* Ob, long ostride, float* lse, long lstride, char* shm) {
  const int tid=threadIdx.x,lane=tid&63,r32=lane&31,hi=lane>>5; const int wid=__builtin_amdgcn_readfirstlane(tid>>6);
  const unsigned lds0=(unsigned)(uintptr_t)shm;
  float*wsf=(float*)(shm+T_WS)+wid*64;
  typedef __attribute__((address_space(3))) const float* lds_f;
  const lds_f Fl=(lds_f)(shm+T_F)+((MODE==1)?qoff:0);
  const unsigned koff_=(unsigned)(lane*128+wid*16), voff_=(unsigned)((16*(wid&3)+(lane>>2))*128+(wid>>2)*64+(lane&3)*16);
  #define KOFF() koff_
  #define VOFF() voff_
  const unsigned kdst=lds0+T_K+wid*1024, vdst=lds0+T_V+wid*1024;
  #define DMA_K(t,slot) glds16s(KOFF(),(const char*)Kb+(long)(t)*8192,(unsigned)__builtin_amdgcn_readfirstlane(kdst+(slot)))
  #define DMA_V(t,slot) glds16s(VOFF(),(const char*)Vb+(long)(t)*8192,(unsigned)__builtin_amdgcn_readfirstlane(vdst+(slot)))
  const char*Kbase=shm+T_K; bf16x8 kf[8];
  const lds_cptr shm3=(lds_cptr)shm; const lds_cptr kp0=shm3+T_K+hi*1024+r32*16; const lds_cptr vp0=shm3+T_V+((lane>>4)&1)*32+(lane&3)*8+(4*hi+((lane&15)>>2))*64;
  DMA_K(0,0);DMA_V(0,0);DMA_K(1,SLOTB);
  bf16x8 qr[4];
  { const bf16*Qw=Qw0+(long)(wid*32)*64;
    #pragma unroll
    for(int d0=0;d0<4;++d0)qr[d0]=*reinterpret_cast<const bf16x8*>(&Qw[(long)r32*64+d0*16+hi*8]); }
  float mhat=0.f,l_reg=0.f;f32x16 o[2];o[0]=f32x16{};o[1]=f32x16{};
  const int qrel=wid*32+r32;
  const int qpos=(MODE>=1)?(64*(NT-4)+qrel):(qoff+qrel);
  #define FQ() ((MODE==1)?Fl[64*(NT-4)+wid*32+r32]:0.f)
  const int jb0=384-qpos+4*hi;
  #define CINIT(C0,C1,t,MASKED) do{ \
    if(MODE==2){ _Pragma("unroll") for(int r=0;r<16;++r){ C0[r]=-mhat; C1[r]=-mhat; } \
      if(MASKED){ const int jb_=(t)-(NT-4); if(jb_>=0){ const int kb_=64*jb_+4*hi; \
        _Pragma("unroll") for(int r=0;r<16;++r){ const int kv_=kb_+(r&3)+8*(r>>2); if(kv_>qrel)C0[r]=-INFINITY; if(kv_+32>qrel)C1[r]=-INFINITY; } } } \
    } else if(MODE==1){ const float fqm=FQ()-mhat; const lds_f fp_=Fl+64*(t)+4*hi; \
      _Pragma("unroll") for(int g4=0;g4<4;++g4){ const f32x4 a_=*(const __attribute__((address_space(3))) f32x4*)(fp_+8*g4), b_=*(const __attribute__((address_space(3))) f32x4*)(fp_+32+8*g4); \
        _Pragma("unroll") for(int i_=0;i_<4;++i_){ C0[4*g4+i_]=fqm-a_[i_]; C1[4*g4+i_]=fqm-b_[i_]; } } \
      if(MASKED){ const int jb_=(t)-(NT-4); if(jb_>=0){ const int kb_=64*jb_+4*hi; \
        _Pragma("unroll") for(int r=0;r<16;++r){ const int kv_=kb_+(r&3)+8*(r>>2); if(kv_>qrel)C0[r]=-INFINITY; if(kv_+32>qrel)C1[r]=-INFINITY; } } } \
    } else { const lds_f tp_=Fl+jb0+64*(t); \
      _Pragma("unroll") for(int r=0;r<16;++r){ C0[r]=tp_[(r&3)+8*(r>>2)]-mhat; C1[r]=tp_[32+(r&3)+8*(r>>2)]-mhat; } } \
  }while(0)
  bool resc=false;
  #define START(P0,P1) do{ const float rm=rowmax(P0,P1); resc=false; \
    { const float dl=(rm==-INFINITY)?0.f:rm; mhat=fadd_s(mhat,dl); \
      _Pragma("unroll") for(int r=0;r<16;++r){P0[r]=fsub_s(P0[r],dl);P1[r]=fsub_s(P1[r],dl);} } \
    _Pragma("unroll") for(int r=0;r<16;++r)P0[r]=__builtin_amdgcn_exp2f(P0[r]); }while(0)
  #define RESC() do{ if(resc){ asm volatile("s_waitcnt lgkmcnt(0)":::"memory"); \
      _Pragma("unroll") for(int d_=0;d_<2;++d_) _Pragma("unroll") for(int r=0;r<16;++r)o[d_][r]*=wsf[crow(r,hi)]; } }while(0)
  f32x16 pA0,pA1,pB0,pB1;
  int sl_prev=0,sl_cur=0,sl_next=SLOTB;
  #define ROT() do{sl_prev=sl_cur;sl_cur=sl_next;sl_next=(sl_next==(NSLOT-1)*SLOTB)?0:sl_next+SLOTB;}while(0)
  DMA_K(2,2*SLOTB);
  WAIT_BAR(3);
  CINIT(pA0,pA1,0,true);
  qkt2(pA0,pA1,Kbase,qr,pA0,pA1,r32,hi);asm volatile("s_nop 15\n\ts_nop 7":"+v"(pA0),"+v"(pA1));
  START(pA0,pA1);
  _Pragma("unroll") for(int r=0;r<16;++r)pA1[r]=__builtin_amdgcn_exp2f(pA1[r]);
  WAIT_BAR(0);
  DMA_K(3,0);DMA_V(1,SLOTB);
  ROT();
  kload8(kf,kp0+sl_cur);
  WAIT_BAR(2);
  s16x4 vlo[8],vhi[8]; u32x4 pw0,pw1,pw2,pw3;
  #define PKW(P,B) cvtpk_s(P[B],P[B+1])
  #define PAF(k) __builtin_bit_cast(bf16x8,pw##k)
  #define VFR(i) (bf16x8){vlo[i][0],vlo[i][1],vlo[i][2],vlo[i][3],vhi[i][0],vhi[i][1],vhi[i][2],vhi[i][3]}
  #define PIN(x) asm volatile("":"+v"(x))
  #define MX3(a,b,c) __builtin_fmaxf(__builtin_fmaxf((a),(b)),(c))
  #define GAPA(MF,A0,A1,A2,A3,W0,W1,PW) do{ MF; sacc+=A0; sacc+=A1; sacc+=A2; sacc+=A3; PIN(sacc); W0; W1; PIN(PW); SBAR(); }while(0)
  #define EX(v) __builtin_amdgcn_exp2f(v)
  #define GAPB(MF,X,B) do{ MF; X[B]=EX(X[B]); X[B+1]=EX(X[B+1]); X[B+2]=EX(X[B+2]); X[B+3]=EX(X[B+3]); PIN(X); SBAR(); }while(0)
  #define VRD(i) do{ vlo[i]=vtr(vp_+(((i)>>2)*4096+((i)&3)*1024)); vhi[i]=vtr(vp_+(((i)>>2)*4096+((i)&3)*1024+512)); }while(0)
  #define KRD(G,j) do{ if(G){ kload2(kf,kp0+sl_next,j); SBAR(); } }while(0)
  #define STEP(C0,C1,P0,P1,t,GK,GV,GL,MASKED) do{ SBAR(); \
    CINIT(C0,C1,t,MASKED); \
    const lds_cptr vp_=vp0+sl_prev; \
    VRD(0); SBAR(); float sacc=(P0[0]+P0[1]); \
    GAPA(C0=__builtin_amdgcn_mfma_f32_32x32x16_bf16(kf[0],qr[0],C0,0,0,0), P0[2],P0[3],P0[4],P0[5],     pw0[0]=PKW(P0,0), pw0[1]=PKW(P0,2), pw0); \
    VRD(4); SBAR(); GAPA(C1=__builtin_amdgcn_mfma_f32_32x32x16_bf16(kf[1],qr[0],C1,0,0,0), P0[6],P0[7],P0[8],P0[9],     pw0[2]=PKW(P0,4), pw0[3]=PKW(P0,6), pw0); \
    VRD(1); SBAR(); GAPA(C0=__builtin_amdgcn_mfma_f32_32x32x16_bf16(kf[2],qr[1],C0,0,0,0),   P0[10],P0[11],P0[12],P0[13], pw1[0]=PKW(P0,8), pw1[1]=PKW(P0,10), pw1); \
    VRD(5); SBAR(); GAPA(C1=__builtin_amdgcn_mfma_f32_32x32x16_bf16(kf[3],qr[1],C1,0,0,0),   P0[14],P0[15],P1[0],P1[1],   pw1[2]=PKW(P0,12),pw1[3]=PKW(P0,14), pw1); \
    VRD(2); SBAR(); GAPA(C0=__builtin_amdgcn_mfma_f32_32x32x16_bf16(kf[4],qr[2],C0,0,0,0),   P1[2],P1[3],P1[4],P1[5],     pw2[0]=PKW(P1,0), pw2[1]=PKW(P1,2), pw2); \
    VRD(6); SBAR(); GAPA(C1=__builtin_amdgcn_mfma_f32_32x32x16_bf16(kf[5],qr[2],C1,0,0,0),   P1[6],P1[7],P1[8],P1[9],     pw2[2]=PKW(P1,4), pw2[3]=PKW(P1,6), pw2); \
    VRD(3); SBAR(); GAPA(C0=__builtin_amdgcn_mfma_f32_32x32x16_bf16(kf[6],qr[3],C0,0,0,0),   P1[10],P1[11],P1[12],P1[13], pw3[0]=PKW(P1,8), pw3[1]=PKW(P1,10), pw3); \
    VRD(7); SBAR(); GAPA(C1=__builtin_amdgcn_mfma_f32_32x32x16_bf16(kf[7],qr[3],C1,0,0,0),   P1[14],P1[15],0.f,0.f,       pw3[2]=PKW(P1,12),pw3[3]=PKW(P1,14), pw3); \
    l_reg+=sacc; \
    if(GK){DMA_K((t)+3,sl_cur);} if(GV){DMA_V((t)+1,sl_next);} \
    { float a=MX3(C0[0],C0[1],C1[0]),b=MX3(C0[2],C0[3],C1[1]); a=MX3(a,C1[2],C1[3]); \
      _Pragma("unroll") for(int r=4;r<16;r+=4){a=MX3(a,C0[r],C0[r+1]);b=MX3(b,C0[r+2],C0[r+3]);a=MX3(a,C1[r],C1[r+1]);b=MX3(b,C1[r+2],C1[r+3]);} \
      float rm=__builtin_fmaxf(a,b); { auto rr=__builtin_amdgcn_permlane32_swap(__float_as_uint(rm),__float_as_uint(rm),false,false); rm=__builtin_fmaxf(__uint_as_float(rr[0]),__uint_as_float(rr[1])); } \
      resc=false; \
      if(__builtin_expect(__any(rm>(float)THRL),0)){ const float dl=__builtin_fmaxf(rm,0.f); mhat+=dl; \
        _Pragma("unroll") for(int r=0;r<16;++r){C0[r]-=dl;C1[r]-=dl;} \
        const float f=__builtin_amdgcn_exp2f(-dl); l_reg*=f; if(hi==0)wsf[r32]=f; resc=true; } } \
    SBAR(); \
    GAPB(o[0]=__builtin_amdgcn_mfma_f32_32x32x16_bf16(PAF(0),VFR(0),o[0],0,0,0), C0,0); \
    GAPB(o[1]=__builtin_amdgcn_mfma_f32_32x32x16_bf16(PAF(0),VFR(4),o[1],0,0,0), C0,4); \
    KRD(GL,0); GAPB(o[0]=__builtin_amdgcn_mfma_f32_32x32x16_bf16(PAF(1),VFR(1),o[0],0,0,0), C0,8); \
    KRD(GL,1); GAPB(o[1]=__builtin_amdgcn_mfma_f32_32x32x16_bf16(PAF(1),VFR(5),o[1],0,0,0), C0,12); \
    KRD(GL,2); GAPB(o[0]=__builtin_amdgcn_mfma_f32_32x32x16_bf16(PAF(2),VFR(2),o[0],0,0,0), C1,0); \
    KRD(GL,3); GAPB(o[1]=__builtin_amdgcn_mfma_f32_32x32x16_bf16(PAF(2),VFR(6),o[1],0,0,0), C1,4); \
    GAPB(o[0]=__builtin_amdgcn_mfma_f32_32x32x16_bf16(PAF(3),VFR(3),o[0],0,0,0), C1,8); \
    GAPB(o[1]=__builtin_amdgcn_mfma_f32_32x32x16_bf16(PAF(3),VFR(7),o[1],0,0,0), C1,12); \
    }while(0)
  int t=1;
  for(;t+5<NT;t+=2){
    STEP(pB0,pB1,pA0,pA1,t,true,true,true,false);     WAIT_BAR(2); RESC(); ROT();
    STEP(pA0,pA1,pB0,pB1,t+1,true,true,true,false);   WAIT_BAR(2); RESC(); ROT();
  }
  #define ENDW(tt) do{ if((tt)+3<NT){WAIT_BAR(2);} else if((tt)+2<NT){WAIT_BAR(1);} else {WAIT_BAR(0);} }while(0)
  for(;t+1<NT;t+=2){
    STEP(pB0,pB1,pA0,pA1,t,(t+3<NT),(t+1<NT),(t+1<NT),true);       ENDW(t);   RESC(); ROT();
    STEP(pA0,pA1,pB0,pB1,t+1,(t+4<NT),(t+2<NT),(t+2<NT),true);     ENDW(t+1); RESC(); ROT();
  }
  STEP(pB0,pB1,pA0,pA1,NT-1,false,false,false,true); RESC();
  { float sacc=pB0[0]+pB0[1]; _Pragma("unroll") for(int r=2;r<16;++r)sacc+=pB0[r]; _Pragma("unroll") for(int r=0;r<16;++r)sacc+=pB1[r]; l_reg+=sacc;
    pw0=(u32x4){PKW(pB0,0),PKW(pB0,2),PKW(pB0,4),PKW(pB0,6)};pw1=(u32x4){PKW(pB0,8),PKW(pB0,10),PKW(pB0,12),PKW(pB0,14)};pw2=(u32x4){PKW(pB1,0),PKW(pB1,2),PKW(pB1,4),PKW(pB1,6)};pw3=(u32x4){PKW(pB1,8),PKW(pB1,10),PKW(pB1,12),PKW(pB1,14)};
    int ln_=lane; asm volatile("":"+v"(ln_)); const int hi_=ln_>>5; const int vb0=(int)(lds0+T_V)+((ln_>>4)&1)*32+(ln_&3)*8+(4*hi_+((ln_&15)>>2))*64;
    SBAR(); pv(o,vb0+sl_cur,PAF(0),PAF(1),PAF(2),PAF(3)); }
  #undef PKW
  #undef PAF
  #undef VFR
  #undef PIN
  #undef MX3
  #undef GAPA
  #undef GAPB
  #undef EX
  #undef VRD
  #undef KRD
  #undef STEP
  #undef ENDW
  #undef CINIT
  {auto rr=__builtin_amdgcn_permlane32_swap(__float_as_uint(l_reg),__float_as_uint(l_reg),false,false);l_reg=__uint_as_float(rr[0])+__uint_as_float(rr[1]);}
  int r32e=r32,hie=hi; asm volatile("":"+v"(r32e),"+v"(hie));
  if(hie==0){ wsf[32+r32e]=l_reg; if(MODE==0) lse[(long)(wid*32+r32e)*lstride]=mhat+__builtin_amdgcn_logf(l_reg); }
  asm volatile("s_waitcnt lgkmcnt(0)":::"memory");
  float rli[16];
  #pragma unroll
  for(int r=0;r<16;++r)rli[r]=__builtin_amdgcn_rcpf(wsf[32+crow(r,hie)]);
  { bf16*stg=(bf16*)(shm+T_OST)+wid*2048;
    #pragma unroll
    for(int r=0;r<16;++r){const int orow=crow(r,hie);
      #pragma unroll
      for(int d0=0;d0<2;++d0)stg[orow*64+d0*32+r32e]=__float2bfloat16(o[d0][r]*rli[r]);}
    asm volatile("s_waitcnt lgkmcnt(0)":::"memory");
    bf16*Ow=Ob+(long)(wid*32)*ostride;
    int le_=lane; asm volatile("":"+v"(le_));
    #pragma unroll
    for(int i=0;i<4;++i){const int row=i*8+(le_>>3),ch=le_&7; const u32x4 v=*(const u32x4*)(stg+row*64+ch*8);
      if(WO_FP8&&MODE==1){ typedef unsigned u32x2o __attribute__((ext_vector_type(2))); u32x2o w8;
        w8.x=pg8::pk4_fp8(__uint_as_float(v.x<<16),__uint_as_float(v.x&0xffff0000u),__uint_as_float(v.y<<16),__uint_as_float(v.y&0xffff0000u));
        w8.y=pg8::pk4_fp8(__uint_as_float(v.z<<16),__uint_as_float(v.z&0xffff0000u),__uint_as_float(v.w<<16),__uint_as_float(v.w&0xffff0000u));
        *(u32x2o*)((unsigned char*)Ob+(long)(wid*32+row)*ostride+ch*8)=w8; }
      else *(u32x4*)(Ow+(long)row*ostride+ch*8)=v;} }
  asm volatile("s_waitcnt lgkmcnt(0)\n\ts_barrier":::"memory");
  #undef DMA_K
  #undef DMA_V
  #undef KOFF
  #undef FQ
  #undef VOFF
  #undef START
  #undef RESC
  #undef ROT
}
#undef SBAR
#undef WAIT_BAR
}

namespace attn_body {
constexpr int B_V = 0, B_VBUF = 49152, B_K = B_VBUF, B_WS = 2 * B_VBUF, B_OST = B_WS + 2048, B_TAB = B_OST + 32768, B_END = B_TAB + 2 * 1024;
struct BandUnit { const bf16* Q; const bf16* K; const bf16* V; bf16* O; float* L; const float* tab; int q0; int sh; };
__device__ __forceinline__ void band_decode(int L, BandUnit& u, const bf16* QKV, bf16* OG, float* LSE, const float* BT) {
    const int tri = L >> 4, u16 = L & 15, b = tri / 48, gh = tri % 48, g = gh >> 4, h = gh & 15;
    const int sh = 2 * g, Ls = 4096 >> sh;
    const int r = (g == 0) ? 0 : (g == 1 ? (u16 >> 2) : u16), uq = (g == 0) ? u16 : (g == 1 ? (u16 & 3) : 0);
    const size_t pl = (size_t)((b * 3 + g) * 3) * 16 + h;
    u.Q = QKV + (pl * 4096 + (size_t)r * Ls) * 64; u.K = u.Q + (size_t)16 * 4096 * 64; u.V = u.Q + (size_t)32 * 4096 * 64;
    const size_t tok0 = (size_t)b * 4096 + r;
    u.O = OG + ((size_t)g * 32768 + tok0) * 1024 + h * 64; u.L = LSE + ((size_t)g * 32768 + tok0) * 16 + h;
    u.tab = BT + gh * 132; u.q0 = uq * 256; u.sh = sh;
}
__device__ __forceinline__ void band_issue_v(const BandUnit& u, unsigned lds0, int lane, int wid) {
    const unsigned voff = (unsigned)((16 * (wid & 3) + (lane >> 2)) * 128 + (wid >> 2) * 64 + (lane & 3) * 16);
    const int w0 = u.q0 - 128;
    #pragma unroll
    for (int t = 0; t < 6; ++t) { const int k0 = w0 + 64 * t;
        if (k0 >= 0) glds16s(voff, (const char*)u.V + (long)k0 * 128, (unsigned)__builtin_amdgcn_readfirstlane(lds0 + B_V + t * 8192 + wid * 1024)); }
}
__device__ __forceinline__ void band_issue_k(const BandUnit& u, int tbuf, unsigned lds0, int tid, int lane, int wid) {
    const unsigned koff = (unsigned)(lane * 128 + wid * 16);
    const int w0 = u.q0 - 128;
    #pragma unroll
    for (int t = 0; t < 6; ++t) { const int k0 = w0 + 64 * t;
        if (k0 >= 0) glds16s(koff, (const char*)u.K + (long)k0 * 128, (unsigned)__builtin_amdgcn_readfirstlane(lds0 + B_K + t * 8192 + wid * 1024)); }
    if (tid < 192) { __attribute__((address_space(3))) float* tb = (__attribute__((address_space(3))) float*)(uintptr_t)(lds0 + B_TAB + tbuf * 1024);
        tb[tid] = (tid >= 32 && tid <= 160) ? u.tab[tid - 32] : -INFINITY; }
}
template <int VAR> __device__ __forceinline__ void band_phase(const bf16* QKV, bf16* OG, float* LSE, const float* BT, int first, int step, int NU, char* shm) {
    const int tid = threadIdx.x, lane = tid & 63, r32 = lane & 31, hi = lane >> 5; const int wid = __builtin_amdgcn_readfirstlane(tid >> 6);
    const unsigned lds0 = (unsigned)(uintptr_t)shm;
    float* wsf = (float*)(shm + B_WS) + wid * 64;
    typedef __attribute__((address_space(3))) const float* lds_f;
    BandUnit cur, nxt;
    int L = first, buf = 0;
#define BAND_LOADQ(U) do { const bf16* Qw_ = (U).Q + (long)((U).q0 + 32 * wid) * 64; \
        _Pragma("unroll") for (int d0 = 0; d0 < 4; ++d0) qn[d0] = *reinterpret_cast<const bf16x8*>(&Qw_[(long)r32 * 64 + d0 * 16 + hi * 8]); } while (0)
    bf16x8 qn[4];
    #pragma unroll
    for (int d0 = 0; d0 < 4; ++d0) qn[d0] = (bf16x8){0, 0, 0, 0, 0, 0, 0, 0};
    if (L < NU) { band_decode(L, cur, QKV, OG, LSE, BT); band_issue_k(cur, 0, lds0, tid, lane, wid); BAND_LOADQ(cur); }
    for (; L < NU; L += step, buf ^= 1) {
        const bool has_next = (L + step) < NU;
        if (has_next) band_decode(L + step, nxt, QKV, OG, LSE, BT); else nxt = cur;
        const int qw = cur.q0 + 32 * wid;
        const int jlo = (qw >= 128) ? 0 : ((128 - qw) >> 5);
        if (L == first) asm volatile("s_waitcnt vmcnt(0) lgkmcnt(0)\n\ts_barrier" ::: "memory");
        else asm volatile("s_waitcnt vmcnt(5) lgkmcnt(0)\n\ts_barrier" ::: "memory");
        bf16x8 qr[4];
        #pragma unroll
        for (int d0 = 0; d0 < 4; ++d0) qr[d0] = qn[d0];
        band_issue_v(cur, lds0, lane, wid);
        f32x16 S[5];
        { const lds_f tb = (lds_f)(uintptr_t)(lds0 + B_TAB + buf * 1024) + (5 + r32 - 4 * hi);
          #pragma unroll
          for (int j = 0; j < 5; ++j) {
              #pragma unroll
              for (int r = 0; r < 16; ++r) S[j][r] = (VAR == 2) ? 0.f : ((j >= jlo) ? tb[(128 - 32 * j) + 27 - ((r & 3) + 8 * (r >> 2))] : -INFINITY);
              if (VAR != 2 && j >= jlo) { const int wj = wid + j;
                  const __attribute__((address_space(3))) char* kp = (const __attribute__((address_space(3))) char*)(uintptr_t)(lds0 + B_K + (wj >> 1) * 8192 + hi * 1024 + ((wj & 1) * 32 + r32) * 16);
                  #pragma unroll
                  for (int d0 = 0; d0 < 4; ++d0) { const bf16x8 kf = *(const __attribute__((address_space(3))) bf16x8*)(kp + d0 * 2048);
                      S[j] = __builtin_amdgcn_mfma_f32_32x32x16_bf16(kf, qr[d0], S[j], 0, 0, 0); } } } }
        asm volatile("s_waitcnt vmcnt(0) lgkmcnt(0)\n\ts_barrier" ::: "memory");
        if (has_next) { band_issue_k(nxt, buf ^ 1, lds0, tid, lane, wid); BAND_LOADQ(nxt); }
        float mx = -INFINITY;
        #pragma unroll
        for (int j = 0; j < 5; ++j)
            #pragma unroll
            for (int r = 0; r < 16; ++r) mx = fmaxf(mx, S[j][r]);
        { auto rr = __builtin_amdgcn_permlane32_swap(__float_as_uint(mx), __float_as_uint(mx), false, false); mx = fmaxf(__uint_as_float(rr[0]), __uint_as_float(rr[1])); }
        float lsum = 0.f; u32x4 pw[5][2];
        #pragma unroll
        for (int j = 0; j < 5; ++j) {
            #pragma unroll
            for (int r = 0; r < 16; ++r) { if (VAR != 3) S[j][r] = __builtin_amdgcn_exp2f(S[j][r] - mx); lsum += S[j][r]; }
            pw[j][0] = (u32x4){cvtpk_s(S[j][0], S[j][1]), cvtpk_s(S[j][2], S[j][3]), cvtpk_s(S[j][4], S[j][5]), cvtpk_s(S[j][6], S[j][7])};
            pw[j][1] = (u32x4){cvtpk_s(S[j][8], S[j][9]), cvtpk_s(S[j][10], S[j][11]), cvtpk_s(S[j][12], S[j][13]), cvtpk_s(S[j][14], S[j][15])}; }
        { auto rr = __builtin_amdgcn_permlane32_swap(__float_as_uint(lsum), __float_as_uint(lsum), false, false); lsum = __uint_as_float(rr[0]) + __uint_as_float(rr[1]); }
        f32x16 o[2]; o[0] = f32x16{}; o[1] = f32x16{};
        const int vlane = ((lane >> 4) & 1) * 32 + (lane & 3) * 8 + (4 * hi + ((lane & 15) >> 2)) * 64;
        #pragma unroll
        for (int j = 0; j < 5; ++j) if (VAR != 1 && j >= jlo) {
            const int wj = wid + j;
            const int vb = (int)(lds0 + B_V) + (wj >> 1) * 8192 + (wj & 1) * 2048 + vlane;
            s16x4 l0[2], h0[2], l1[2], h1[2];
            #pragma unroll
            for (int d0 = 0; d0 < 2; ++d0) {
                asm volatile("ds_read_b64_tr_b16 %0,%1 offset:%c2" : "=&v"(l0[d0]) : "v"(vb), "i"(d0 * 4096) : "memory");
                asm volatile("ds_read_b64_tr_b16 %0,%1 offset:%c2" : "=&v"(h0[d0]) : "v"(vb), "i"(d0 * 4096 + 512) : "memory");
                asm volatile("ds_read_b64_tr_b16 %0,%1 offset:%c2" : "=&v"(l1[d0]) : "v"(vb), "i"(d0 * 4096 + 1024) : "memory");
                asm volatile("ds_read_b64_tr_b16 %0,%1 offset:%c2" : "=&v"(h1[d0]) : "v"(vb), "i"(d0 * 4096 + 1536) : "memory"); }
            asm volatile("s_waitcnt lgkmcnt(0)" : "+v"(l0[0]), "+v"(h0[0]), "+v"(l1[0]), "+v"(h1[0]), "+v"(l0[1]), "+v"(h0[1]), "+v"(l1[1]), "+v"(h1[1]) :: "memory"); __builtin_amdgcn_sched_barrier(0);
            #pragma unroll
            for (int d0 = 0; d0 < 2; ++d0) {
                o[d0] = __builtin_amdgcn_mfma_f32_32x32x16_bf16(__builtin_bit_cast(bf16x8, pw[j][0]), (bf16x8){l0[d0][0], l0[d0][1], l0[d0][2], l0[d0][3], h0[d0][0], h0[d0][1], h0[d0][2], h0[d0][3]}, o[d0], 0, 0, 0);
                o[d0] = __builtin_amdgcn_mfma_f32_32x32x16_bf16(__builtin_bit_cast(bf16x8, pw[j][1]), (bf16x8){l1[d0][0], l1[d0][1], l1[d0][2], l1[d0][3], h1[d0][0], h1[d0][1], h1[d0][2], h1[d0][3]}, o[d0], 0, 0, 0); } }
        const long ostride = 1024L << cur.sh, lstride = 16L << cur.sh;
        if (hi == 0) { wsf[32 + r32] = lsum; cur.L[(long)(qw + r32) * lstride] = mx + __builtin_amdgcn_logf(lsum); }
        asm volatile("s_waitcnt lgkmcnt(0)" ::: "memory");
        float rli[16];
        #pragma unroll
        for (int r = 0; r < 16; ++r) rli[r] = __builtin_amdgcn_rcpf(wsf[32 + crow(r, hi)]);
        { bf16* stg = (bf16*)(shm + B_OST) + wid * 2048;
          #pragma unroll
          for (int r = 0; r < 16; ++r) { const int orow = crow(r, hi);
            #pragma unroll
            for (int d0 = 0; d0 < 2; ++d0) stg[orow * 64 + d0 * 32 + r32] = __float2bfloat16(o[d0][r] * rli[r]); }
          asm volatile("s_waitcnt lgkmcnt(0)" ::: "memory");
          bf16* Ow = cur.O + (long)qw * ostride;
          #pragma unroll
          for (int i = 0; i < 4; ++i) { const int row = i * 8 + (lane >> 3), ch = lane & 7; const u32x4 v = *(const u32x4*)(stg + row * 64 + ch * 8); *(u32x4*)(Ow + (long)row * ostride + ch * 8) = v; } }
        cur = nxt;
    }
    asm volatile("s_waitcnt vmcnt(0) lgkmcnt(0)\n\ts_barrier" ::: "memory");
#undef BAND_LOADQ
}
}

namespace attn_body {
typedef int i32x8b __attribute__((ext_vector_type(8)));
typedef int i32x4b __attribute__((ext_vector_type(4)));
typedef int i32x2b __attribute__((ext_vector_type(2)));
constexpr int C_KV = 0, C_KVBUF = 49152  , C_WS = 2 * C_KVBUF, C_OST = C_WS + 2048, C_TAB = C_OST + 32768, C_END = C_TAB + 2 * 1024;
struct Band8Unit { const unsigned char* Q; const unsigned char* K; const unsigned char* V; bf16* O; float* L; const float* tab; int q0; int sh; };
__device__ __forceinline__ void band8_decode(int L, Band8Unit& u, const unsigned char* QKV, bf16* OG, float* LSE, const float* BT) {
    const int tri = L >> 4, u16 = L & 15, b = tri / 48, gh = tri % 48, g = gh >> 4, h = gh & 15;
    const int sh = 2 * g, Ls = 4096 >> sh;
    const int r = (g == 0) ? 0 : (g == 1 ? (u16 >> 2) : u16), uq = (g == 0) ? u16 : (g == 1 ? (u16 & 3) : 0);
    const size_t pl = (size_t)((b * 3 + g) * 3) * 16 + h;
    u.Q = QKV + (pl * 4096 + (size_t)r * Ls) * 64; u.K = u.Q + (size_t)16 * 4096 * 64; u.V = u.Q + (size_t)32 * 4096 * 64;
    const size_t tok0 = (size_t)b * 4096 + r;
    u.O = OG + ((size_t)g * 32768 + tok0) * 1024 + h * 64; u.L = LSE + ((size_t)g * 32768 + tok0) * 16 + h;
    u.tab = BT + gh * 132; u.q0 = uq * 256; u.sh = sh;
}
__device__ __forceinline__ void band8_issue(const Band8Unit& u, int b, unsigned lds0, int tid, int lane, int wid) {
    const unsigned lane64 = (unsigned)lane * 64u;
    const int w0 = u.q0 - 128;
    #pragma unroll
    for (int i = 0; i < 3; ++i) { const int p = wid * 3 + i, k0 = w0 + 64 * (p >> 2);
        if (k0 >= 0) { const long go = (long)k0 * 64 + (p & 3) * 16;
            glds16s(lane64, (const char*)u.K + go, (unsigned)__builtin_amdgcn_readfirstlane(lds0 + C_KV + b * C_KVBUF + p * 1024));
            glds16s(lane64, (const char*)u.V + go, (unsigned)__builtin_amdgcn_readfirstlane(lds0 + C_KV + b * C_KVBUF + 24576 + p * 1024)); } }
    if (tid < 192) { __attribute__((address_space(3))) float* tb = (__attribute__((address_space(3))) float*)(uintptr_t)(lds0 + C_TAB + b * 1024);
        tb[tid] = (tid >= 32 && tid <= 160) ? u.tab[tid - 32] : -INFINITY; }
}
__device__ __forceinline__ unsigned pk4_e4m3(float a, float b, float c, float d) { int v = __builtin_amdgcn_cvt_pk_fp8_f32(a, b, 0, false); v = __builtin_amdgcn_cvt_pk_fp8_f32(c, d, v, true); return (unsigned)v; }
template <int VAR> __device__ __forceinline__ void band8_phase(const unsigned char* QKV, bf16* OG, float* LSE, const float* BT, int first, int step, int NU, char* shm) {
    const int tid = threadIdx.x, lane = tid & 63, r32 = lane & 31, hi = lane >> 5; const int wid = __builtin_amdgcn_readfirstlane(tid >> 6);
    const unsigned lds0 = (unsigned)(uintptr_t)shm;
    float* wsf = (float*)(shm + C_WS) + wid * 64;
    typedef __attribute__((address_space(3))) const float* lds_f;
    typedef __attribute__((address_space(3))) const i32x4b* lds_q;
    Band8Unit cur, nxt;
    int L = first, buf = 0;
#define BAND8_LOADQ(U) do { const unsigned char* Qw_ = (U).Q + (long)((U).q0 + 32 * wid + r32) * 64 + hi * 32; \
        qn[0] = *reinterpret_cast<const i32x4b*>(Qw_); qn[1] = *reinterpret_cast<const i32x4b*>(Qw_ + 16); } while (0)
    i32x4b qn[2]; qn[0] = (i32x4b){0, 0, 0, 0}; qn[1] = qn[0];
    if (L < NU) { band8_decode(L, cur, QKV, OG, LSE, BT); band8_issue(cur, 0, lds0, tid, lane, wid); BAND8_LOADQ(cur); }
    const int vlane8 = ((lane >> 4) & 1) * 1024 + ((((lane & 15) >> 3) & 1) * 8 + (((lane & 15) >> 1) & 3) + 4 * hi) * 16 + (lane & 1) * 8;
    for (; L < NU; L += step, buf ^= 1) {
        const bool has_next = (L + step) < NU;
        if (has_next) band8_decode(L + step, nxt, QKV, OG, LSE, BT); else nxt = cur;
        const int qw = cur.q0 + 32 * wid;
        const int jlo = (qw >= 128) ? 0 : ((128 - qw) >> 5);
        if (L == first) asm volatile("s_waitcnt vmcnt(0) lgkmcnt(0)\n\ts_barrier" ::: "memory");
        else asm volatile("s_waitcnt vmcnt(5) lgkmcnt(0)\n\ts_barrier" ::: "memory");
        const i32x8b qf = (i32x8b){qn[0][0], qn[0][1], qn[0][2], qn[0][3], qn[1][0], qn[1][1], qn[1][2], qn[1][3]};
        if (has_next) { band8_issue(nxt, buf ^ 1, lds0, tid, lane, wid); BAND8_LOADQ(nxt); }
        const unsigned kvb = lds0 + C_KV + buf * C_KVBUF;
        f32x16 S[5];
        { const lds_f tb = (lds_f)(uintptr_t)(lds0 + C_TAB + buf * 1024) + (5 + r32 - 4 * hi);
          #pragma unroll
          for (int j = 0; j < 5; ++j) {
              #pragma unroll
              for (int r = 0; r < 16; ++r) S[j][r] = (j >= jlo) ? tb[(128 - 32 * j) + 27 - ((r & 3) + 8 * (r >> 2))] : -INFINITY;
              if (j >= jlo) { const int wj = wid + j;
                  const lds_q kp = (lds_q)(uintptr_t)(kvb + (wj >> 1) * 4096 + hi * 2048 + ((wj & 1) * 32 + r32) * 16);
                  const i32x4b k0 = kp[0], k1 = kp[64];
                  S[j] = __builtin_amdgcn_mfma_scale_f32_32x32x64_f8f6f4((i32x8b){k0[0], k0[1], k0[2], k0[3], k1[0], k1[1], k1[2], k1[3]}, qf, S[j], 0, 0, 0, 0, 0, 0); } } }
        float mx = -INFINITY;
        #pragma unroll
        for (int j = 0; j < 5; ++j)
            #pragma unroll
            for (int r = 0; r < 16; ++r) mx = fmaxf(mx, S[j][r]);
        { auto rr = __builtin_amdgcn_permlane32_swap(__float_as_uint(mx), __float_as_uint(mx), false, false); mx = fmaxf(__uint_as_float(rr[0]), __uint_as_float(rr[1])); }
        const float mxs = mx - 7.f;
        float lsum = 0.f; unsigned pw[5][4];
        #pragma unroll
        for (int j = 0; j < 5; ++j) {
            #pragma unroll
            for (int r = 0; r < 16; ++r) { S[j][r] = __builtin_amdgcn_exp2f(S[j][r] - mxs); lsum += S[j][r]; }
            #pragma unroll
            for (int q4 = 0; q4 < 4; ++q4) pw[j][q4] = pk4_e4m3(S[j][4 * q4], S[j][4 * q4 + 1], S[j][4 * q4 + 2], S[j][4 * q4 + 3]); }
        { auto rr = __builtin_amdgcn_permlane32_swap(__float_as_uint(lsum), __float_as_uint(lsum), false, false); lsum = __uint_as_float(rr[0]) + __uint_as_float(rr[1]); }
        f32x16 o[2]; o[0] = f32x16{}; o[1] = f32x16{};
        i32x2b vf[3][2][4];
        #pragma unroll
        for (int pr = 0; pr < 3; ++pr)
            #pragma unroll
            for (int c = 0; c < (pr == 2 ? 2 : 4); ++c) {
                const int j = 2 * pr + (c >> 1), je = j > jlo ? j : jlo, wj = wid + je;
                const int vb = (int)(kvb + 24576) + (wj >> 1) * 4096 + (wj & 1) * 512 + vlane8;
                asm volatile("ds_read_b64_tr_b8 %0,%1 offset:%c2" : "=&v"(vf[pr][0][c]) : "v"(vb), "i"((c & 1) * 256) : "memory");
                asm volatile("ds_read_b64_tr_b8 %0,%1 offset:%c2" : "=&v"(vf[pr][1][c]) : "v"(vb), "i"(2048 + (c & 1) * 256) : "memory"); }
        asm volatile("s_waitcnt lgkmcnt(0)" : "+v"(vf[0][0][0]), "+v"(vf[0][0][1]), "+v"(vf[0][0][2]), "+v"(vf[0][0][3]), "+v"(vf[0][1][0]), "+v"(vf[0][1][1]), "+v"(vf[0][1][2]), "+v"(vf[0][1][3]),
                     "+v"(vf[1][0][0]), "+v"(vf[1][0][1]), "+v"(vf[1][0][2]), "+v"(vf[1][0][3]), "+v"(vf[1][1][0]), "+v"(vf[1][1][1]), "+v"(vf[1][1][2]), "+v"(vf[1][1][3]),
                     "+v"(vf[2][0][0]), "+v"(vf[2][0][1]), "+v"(vf[2][1][0]), "+v"(vf[2][1][1]) :: "memory"); __builtin_amdgcn_sched_barrier(0);
        #pragma unroll
        for (int pr = 0; pr < 3; ++pr) {
            const i32x8b pa = (pr == 2) ? (i32x8b){(int)pw[4][0], (int)pw[4][1], (int)pw[4][2], (int)pw[4][3], 0, 0, 0, 0}
                                        : (i32x8b){(int)pw[2 * pr][0], (int)pw[2 * pr][1], (int)pw[2 * pr][2], (int)pw[2 * pr][3], (int)pw[2 * pr + 1][0], (int)pw[2 * pr + 1][1], (int)pw[2 * pr + 1][2], (int)pw[2 * pr + 1][3]};
            #pragma unroll
            for (int d0 = 0; d0 < 2; ++d0) {
                const i32x2b v2 = (pr == 2) ? vf[2][d0][0] : vf[pr][d0][2], v3 = (pr == 2) ? vf[2][d0][1] : vf[pr][d0][3];
                o[d0] = __builtin_amdgcn_mfma_scale_f32_32x32x64_f8f6f4(pa, (i32x8b){vf[pr][d0][0][0], vf[pr][d0][0][1], vf[pr][d0][1][0], vf[pr][d0][1][1], v2[0], v2[1], v3[0], v3[1]}, o[d0], 0, 0, 0, 0, 0, 0); } }
        const long ostride = 1024L << cur.sh, lstride = 16L << cur.sh;
        if (hi == 0) { wsf[32 + r32] = lsum; cur.L[(long)(qw + r32) * lstride] = mxs + __builtin_amdgcn_logf(lsum); }
        asm volatile("s_waitcnt lgkmcnt(0)" ::: "memory");
        float rli[16];
        #pragma unroll
        for (int r = 0; r < 16; ++r) rli[r] = __builtin_amdgcn_rcpf(wsf[32 + crow(r, hi)]);
        { bf16* stg = (bf16*)(shm + C_OST) + wid * 2048;
          #pragma unroll
          for (int r = 0; r < 16; ++r) { const int orow = crow(r, hi);
            #pragma unroll
            for (int d0 = 0; d0 < 2; ++d0) stg[orow * 64 + d0 * 32 + r32] = __float2bfloat16(o[d0][r] * rli[r]); }
          asm volatile("s_waitcnt lgkmcnt(0)" ::: "memory");
          bf16* Ow = cur.O + (long)qw * ostride;
          #pragma unroll
          for (int i = 0; i < 4; ++i) { const int row = i * 8 + (lane >> 3), ch = lane & 7; const u32x4 v = *(const u32x4*)(stg + row * 64 + ch * 8); *(u32x4*)(Ow + (long)row * ostride + ch * 8) = v; } }
        cur = nxt;
    }
    asm volatile("s_waitcnt vmcnt(0) lgkmcnt(0)\n\ts_barrier" ::: "memory");
#undef BAND8_LOADQ
}
}
#define XB_TMO      128
#define XB_XCNT(j)  (256  + 64 * (j))
#define XB_XSUB(j)  (1280 + 64 * (j))
#define XB_XGEN(j)  (2304 + 64 * (j))
#define XB_TOP      3328
#define XB_TOPGEN   3392
#define XCD_BAR_WORDS 3456
#define XB_SPIN_CAP (1u << 18)

__device__ __forceinline__ unsigned xb_ld(unsigned* p)              { return __hip_atomic_load(p, __ATOMIC_RELAXED, __HIP_MEMORY_SCOPE_AGENT); }
__device__ __forceinline__ unsigned xb_add(unsigned* p, unsigned v) { return __hip_atomic_fetch_add(p, v, __ATOMIC_RELAXED, __HIP_MEMORY_SCOPE_AGENT); }
__device__ __forceinline__ unsigned xb_xcc_id() { return (unsigned)__builtin_amdgcn_s_getreg((3 << 11) | 20) & 0xFu; }
#define XB_SPIN(cond, bar) do { unsigned _sp = 0; while (cond) { __builtin_amdgcn_s_sleep(1); \
    if ((++_sp & 255u) == 0u) { if (xb_ld(&(bar)[XB_TMO])) break; if (_sp > XB_SPIN_CAP) { atomicAdd(&(bar)[XB_TMO], 1u); break; } } } } while (0)

struct XcdBarrier {
    unsigned* bar; unsigned x;
    volatile LAS unsigned* st;
};

__device__ __forceinline__ XcdBarrier xcd_barrier_post(unsigned* bar, volatile LAS unsigned* st) {
    XcdBarrier b; b.bar = bar; b.x = xb_xcc_id(); b.st = st;
    if (threadIdx.x == 0) (void)xb_add(&bar[XB_XCNT(b.x)], 1u);
    return b;
}
__device__ __forceinline__ void xcd_barrier_complete(unsigned* bar, unsigned x, unsigned& nloc, unsigned& nx) {
    const unsigned G = gridDim.x * gridDim.y * gridDim.z;
    unsigned sum, cnt, mine, sp = 0u;
    for (;;) {
        sum = 0u; cnt = 0u; mine = 0u;
#pragma unroll
        for (unsigned j = 0; j < 16; ++j) { const unsigned c = xb_ld(&bar[XB_XCNT(j)]); sum += c; cnt += (c > 0u) ? 1u : 0u; mine = (j == x) ? c : mine; }
        if (sum == G) break;
        __builtin_amdgcn_s_sleep(1);
        if ((++sp & 255u) == 0u) { if (xb_ld(&bar[XB_TMO])) break; if (sp > XB_SPIN_CAP) { atomicAdd(&bar[XB_TMO], 1u); break; } }
    }
    nloc = mine > 0u ? mine : 1u; nx = cnt > 0u ? cnt : 1u;
}

__device__ __forceinline__ void xcd_barrier(const XcdBarrier& b) {
    asm volatile("s_waitcnt vmcnt(0)" ::: "memory");
    __syncthreads();
    if (threadIdx.x == 0) {
        unsigned* bar = b.bar;
        __builtin_amdgcn_s_waitcnt(0);
        unsigned nloc = b.st[0], nx = b.st[1];
        if (nloc == 0u) { xcd_barrier_complete(bar, b.x, nloc, nx); b.st[0] = nloc; b.st[1] = nx; }
        const unsigned old = xb_add(&bar[XB_XSUB(b.x)], 1u);
        const unsigned gen = old / nloc;
        if (old + 1u == (gen + 1u) * nloc) {
            __builtin_amdgcn_fence(__ATOMIC_RELEASE, "agent");
            asm volatile("s_waitcnt vmcnt(0)" ::: "memory");
            const unsigned og = xb_add(&bar[XB_TOP], 1u);
            const unsigned tg = og / nx;
            if (og + 1u == (tg + 1u) * nx) xb_add(&bar[XB_TOPGEN], 1u);
            else XB_SPIN(xb_ld(&bar[XB_TOPGEN]) == tg, bar);
            __builtin_amdgcn_fence(__ATOMIC_ACQUIRE, "agent");
            xb_add(&bar[XB_XGEN(b.x)], 1u);
            asm volatile("s_waitcnt vmcnt(0)" ::: "memory");
        } else {
            XB_SPIN(xb_ld(&bar[XB_XGEN(b.x)]) == gen, bar);
            __builtin_amdgcn_fence(__ATOMIC_ACQUIRE, "agent");
            asm volatile("s_waitcnt vmcnt(0)" ::: "memory");
        }
    }
    __syncthreads();
}

struct Args { const float* in[21]; float* out; unsigned char* ws; int ph_lo, ph_hi; };
enum { IN_X = 0, IN_C, IN_ADAW, IN_ADAB, IN_NMIX, IN_NFFN, IN_AWQKV, IN_AWO, IN_RELB, IN_KVNG, IN_WKVF, IN_BF, IN_BWQ, IN_BWO, IN_RW, IN_RB, IN_WGU, IN_BGU, IN_WDN, IN_BDN, IN_FNG };

struct Ctx {
    LAS unsigned char* lds; unsigned char* ws; int tid, lane, wave, vcu, G;
};

__device__ __forceinline__ void transpose_item(const float* __restrict__ W, int pitch, int Kd, bf16* WT, int k0, int n0, int row_off, LAS float* scr, int lane) {
#pragma unroll
    for (int i = 0; i < 8; ++i) { const int kk = 8 * i + (lane >> 3), c4 = (lane & 7) * 4;
        const f32x4 v = *(const f32x4*)(W + (size_t)(k0 + kk) * pitch + n0 + c4);
        scr[kk * 33 + c4] = v[0]; scr[kk * 33 + c4 + 1] = v[1]; scr[kk * 33 + c4 + 2] = v[2]; scr[kk * 33 + c4 + 3] = v[3]; }
    LDS_WAIT(); asm volatile("" ::: "memory");
    const int c = lane & 7;
#pragma unroll
    for (int j = 0; j < 4; ++j) { const int n = (lane >> 3) + 8 * j; const LAS float* s = scr + (8 * c) * 33 + n;
        u32x4v o; o.x = pkbf(s[0 * 33], s[1 * 33]); o.y = pkbf(s[2 * 33], s[3 * 33]); o.z = pkbf(s[4 * 33], s[5 * 33]); o.w = pkbf(s[6 * 33], s[7 * 33]);
        *(u32x4v*)(WT + (size_t)(row_off + n0 + n) * Kd + k0 + 8 * c) = o; }
    LDS_WAIT(); asm volatile("" ::: "memory");
}

__device__ __forceinline__ void transpose_item8(const float* __restrict__ W, int pitch, int Kd, unsigned char* WT, int k0, int n0, int row_off, LAS float* scr, int lane) {
#pragma unroll
    for (int i = 0; i < 8; ++i) { const int kk = 8 * i + (lane >> 3), c4 = (lane & 7) * 4;
        const f32x4 v = *(const f32x4*)(W + (size_t)(k0 + kk) * pitch + n0 + c4) * 64.f;
        scr[kk * 33 + c4] = v[0]; scr[kk * 33 + c4 + 1] = v[1]; scr[kk * 33 + c4 + 2] = v[2]; scr[kk * 33 + c4 + 3] = v[3]; }
    LDS_WAIT(); asm volatile("" ::: "memory");
    const int c = lane & 7;
#pragma unroll
    for (int j = 0; j < 4; ++j) { const int n = (lane >> 3) + 8 * j; const LAS float* s = scr + (8 * c) * 33 + n;
        u32x2v o; o.x = pg8::pk4_fp8(s[0 * 33], s[1 * 33], s[2 * 33], s[3 * 33]); o.y = pg8::pk4_fp8(s[4 * 33], s[5 * 33], s[6 * 33], s[7 * 33]);
        *(u32x2v*)(WT + (size_t)(row_off + n0 + n) * Kd + k0 + 8 * c) = o; }
    LDS_WAIT(); asm volatile("" ::: "memory");
}

__device__ __forceinline__ void convert_weights(const Ctx& C, const Args& a, const int part) {
    LAS float* scr = (LAS float*)(C.lds + RING_OFF + C.wave * 8704);
    const int gw = C.vcu * NWAVES + C.wave, NGW = C.G * NWAVES;
    constexpr int I_QKV = 16 * 288, I_SQ = 16 * 32, I_KV = 16 * 64, I_GU1 = 16 * 64, I_DN1 = 16 * 32;
    constexpr int O_WO0 = I_QKV, O_KV = O_WO0 + I_SQ, O_WQ = O_KV + I_KV, O_WO1 = O_WQ + I_SQ, O_GU = O_WO1 + I_SQ, O_DN = O_GU + 64 * I_GU1, NITEMS = O_DN + 64 * I_DN1;
    static_assert(QKV_FP8 && KVQ_FP8 && WO_FP8, "the pipelined prologue converts every weight to fp8");
    struct Item { const float* W; unsigned char* WT; int pitch, k0, n0, row_off; };
    auto decode = [&](int it, Item& I) {
        if (it < O_WO0) { const int r = it, kb = r / 288, nb = r % 288; I = {a.in[IN_AWQKV], (unsigned char*)(C.ws + WS_WQKV), NQKV, 64 * kb, 32 * nb, 0}; }
        else if (it < O_KV) { const int r = it - O_WO0, kb = r / 32, nb = r % 32; I = {a.in[IN_AWO], (unsigned char*)(C.ws + WS_WO0), D, 64 * kb, 32 * nb, 0}; }
        else if (it < O_WQ) { const int r = it - O_KV, kb = r / 64, nb = r % 64; I = {a.in[IN_WKVF], (unsigned char*)(C.ws + WS_WKV), 2064, 64 * kb, 32 * nb, 0}; }
        else if (it < O_WO1) { const int r = it - O_WQ, kb = r / 32, nb = r % 32; I = {a.in[IN_BWQ], (unsigned char*)(C.ws + WS_WKV) + (size_t)2048 * D, D, 64 * kb, 32 * nb, 0}; }
        else if (it < O_GU) { const int r = it - O_WO1, kb = r / 32, nb = r % 32; I = {a.in[IN_BWO], (unsigned char*)(C.ws + WS_WO1), D, 64 * kb, 32 * nb, 0}; }
        else if (it < O_DN) { const int r = it - O_GU, mat = r / I_GU1, q = r % I_GU1, kb = q / 64, nb = q % 64;
            const int n0 = 32 * nb, which = n0 >> 10, j0 = n0 & 1023, drow0 = (j0 >> 7) * 256 + which * 128 + (j0 & 127);
            I = {a.in[IN_WGU] + (size_t)mat * D * 2048, (unsigned char*)(C.ws + WS_WGU) + (size_t)mat * 2048 * D, 2048, 64 * kb, n0, drow0 - n0}; }
        else { const int r = it - O_DN, mat = r / I_DN1, q = r % I_DN1, kb = q / 32, nb = q % 32;
            I = {a.in[IN_WDN] + (size_t)mat * D * D, (unsigned char*)(C.ws + WS_WDN) + (size_t)mat * D * D, D, 64 * kb, 32 * nb, 0}; }
    };
    const int lr = C.lane >> 3, c4 = (C.lane & 7) * 4;
#define P0_LOAD(V, I) do { _Pragma("unroll") for (int i = 0; i < 8; ++i) V[i] = NT_P0 ? __builtin_nontemporal_load((const f32x4*)((I).W + (size_t)((I).k0 + 8 * i + lr) * (I).pitch + (I).n0 + c4)) : *(const f32x4*)((I).W + (size_t)((I).k0 + 8 * i + lr) * (I).pitch + (I).n0 + c4); } while (0)
    f32x4 vc[8], vn[8]; Item Ic, In;
    constexpr int L1GU = 32 * I_GU1, L1DN = 32 * I_DN1;
    const int NV = DEFER_L1W ? (part == 0 ? (O_GU + L1GU) + L1DN : L1GU + L1DN) : (part == 0 ? NITEMS : 0);
    auto vmap = [&](int v) -> int { if (!DEFER_L1W) return v; if (part == 0) return v < O_GU + L1GU ? v : O_DN + (v - (O_GU + L1GU)); return v < L1GU ? O_GU + L1GU + v : O_DN + L1DN + (v - L1GU); };
    if (gw < NV) { decode(vmap(gw), Ic); P0_LOAD(vc, Ic); }
    for (int vv = gw; vv < NV; vv += NGW) {
        const int it = vmap(vv);
        const bool hn = (vv + NGW) < NV;
        if (hn) { decode(vmap(vv + NGW), In); P0_LOAD(vn, In); }
#pragma unroll
        for (int i = 0; i < 8; ++i) { const int kk = 8 * i + lr; const f32x4 v = vc[i] * 64.f;
            scr[kk * 33 + c4] = v[0]; scr[kk * 33 + c4 + 1] = v[1]; scr[kk * 33 + c4 + 2] = v[2]; scr[kk * 33 + c4 + 3] = v[3]; }
        LDS_WAIT(); asm volatile("" ::: "memory");
        { const int cc = C.lane & 7;
#pragma unroll
          for (int j = 0; j < 4; ++j) { const int n = lr + 8 * j; const LAS float* s = scr + (8 * cc) * 33 + n;
              u32x2v o; o.x = pg8::pk4_fp8(s[0 * 33], s[1 * 33], s[2 * 33], s[3 * 33]); o.y = pg8::pk4_fp8(s[4 * 33], s[5 * 33], s[6 * 33], s[7 * 33]);
              if (NT_P0ST && it >= O_GU) __builtin_nontemporal_store(o, (u32x2v*)(Ic.WT + (size_t)(Ic.row_off + Ic.n0 + n) * D + Ic.k0 + 8 * cc));
              else *(u32x2v*)(Ic.WT + (size_t)(Ic.row_off + Ic.n0 + n) * D + Ic.k0 + 8 * cc) = o; } }
        LDS_WAIT(); asm volatile("" ::: "memory");
        if (hn) { Ic = In;
#pragma unroll
            for (int i = 0; i < 8; ++i) vc[i] = vn[i]; }
    }
#undef P0_LOAD
    __syncthreads();
}
__device__ __forceinline__ void p0_prologue(const Ctx& C, const Args& a) {
    convert_weights(C, a, 0);
    LAS float* cs = (LAS float*)(C.lds + RING_OFF);
    LAS float* red = (LAS float*)(C.lds + RING_OFF + 32768);
    for (int i = C.tid; i < 8192; i += 512) { const float v = a.in[IN_C][i]; cs[i] = v / (1.f + __expf(-v)); }
    __syncthreads();
    float* ADA = (float*)(C.ws + SM_ADA);
    for (int grp = C.vcu; grp < 192; grp += C.G) {
        const int l = grp / 96, col = (grp % 96) * 64 + C.lane;
        const float* w = a.in[IN_ADAW] + (size_t)l * D * 6144 + col;
        float acc[8];
#pragma unroll
        for (int b = 0; b < 8; ++b) acc[b] = 0.f;
        const int kbeg = C.wave * 128;
#pragma unroll 4
        for (int k = kbeg; k < kbeg + 128; k += 4) {
            float wv[4];
#pragma unroll
            for (int j = 0; j < 4; ++j) wv[j] = w[(size_t)(k + j) * 6144];
#pragma unroll
            for (int b = 0; b < 8; ++b) { const f32x4 cv = *(const LAS f32x4*)(cs + b * 1024 + k); acc[b] += cv[0] * wv[0] + cv[1] * wv[1] + cv[2] * wv[2] + cv[3] * wv[3]; }
        }
#pragma unroll
        for (int b = 0; b < 8; ++b) red[(C.wave * 8 + b) * 64 + C.lane] = acc[b];
        __syncthreads();
        { const int b = C.wave; float s = 0.f;
#pragma unroll
          for (int w8 = 0; w8 < 8; ++w8) s += red[(w8 * 8 + b) * 64 + C.lane];
          ADA[(size_t)(l * 8 + b) * 6144 + col] = s + a.in[IN_ADAB][l * 6144 + col]; }
        __syncthreads();
    }
    if (C.vcu == C.G - 1) {
        float* BT = (float*)(C.ws + SM_BIAST);
        for (int i = C.tid; i < 48 * 129; i += 512) { const int gh = i / 129, dl = i % 129, g = gh >> 4, n = dl << (2 * g);
            int bk = n;
            if (n >= 16) { const float nf = (float)n; bk = 16 + (int)(logf(nf / 16.f) / 4.852030263919617f * 16.f); bk = bk > 31 ? 31 : bk; }
            BT[gh * 132 + dl] = a.in[IN_RELB][bk * 48 + gh] * LOG2E; }
    }
}

__device__ __forceinline__ void p1_rows0(const Ctx& C, const Args& a) {
    const float* ADA = (const float*)(C.ws + SM_ADA);
    float* GM = (float*)(C.ws + SM_GM); float* CSH = (float*)(C.ws + SM_CSH);
    const int gt = C.vcu * 512 + C.tid, NGT = C.G * 512;
    for (int i = gt; i < 2 * 2 * 8 * 1024; i += NGT) { const int d = i & 1023, b = (i >> 10) & 7, kind = (i >> 13) & 1, l = i >> 14;
        const float g = kind ? a.in[IN_NFFN][l * D + d] : a.in[IN_NMIX][l * D + d];
        GM[i] = g * (1.f + ADA[(size_t)(l * 8 + b) * 6144 + (kind ? 4 : 1) * 1024 + d]); }
    const int gw = C.vcu * NWAVES + C.wave, NGW = C.G * NWAVES;
    for (int o = gw; o < 512; o += NGW) { const int e = o & 31, b = (o >> 5) & 7, l = o >> 8; float s = 0.f;
        for (int d = C.lane; d < D; d += 64) s += ADA[(size_t)(l * 8 + b) * 6144 + 3 * 1024 + d] * a.in[IN_RW][(size_t)l * D * 32 + d * 32 + e];
        s = wave_sum(s); if (C.lane == 0) CSH[o] = s + a.in[IN_RB][l * 32 + e]; }
    bf16* H = (bf16*)(C.ws + WS_H);
    for (int m = gw; m < T; m += NGW) {
        const int b = m >> 12;
        const f32x4* xr = (const f32x4*)(a.in[IN_X] + (size_t)m * D) + C.lane;
        const f32x4* gr = (const f32x4*)(a.in[IN_NMIX]) + C.lane;
        const f32x4* sc = (const f32x4*)(ADA + (size_t)b * 6144 + 1024) + C.lane;
        const f32x4* sh = (const f32x4*)(ADA + (size_t)b * 6144) + C.lane;
        f32x4 v[4]; float s = 0.f;
#pragma unroll
        for (int j = 0; j < 4; ++j) { v[j] = NT_ROWS ? __builtin_nontemporal_load(xr + 64 * j) : xr[64 * j]; s += (v[j].x * v[j].x + v[j].y * v[j].y) + (v[j].z * v[j].z + v[j].w * v[j].w); }
        const float rstd = 1.f / sqrtf(wave_sum(s) * (1.f / D) + RMS_EPS);
        unsigned long long* o8 = (unsigned long long*)(H + (size_t)m * D) + C.lane; unsigned* o4 = (unsigned*)(C.ws + WS_H8 + (size_t)m * D) + C.lane;
#pragma unroll
        for (int j = 0; j < 4; ++j) { const f32x4 h = v[j] * rstd * gr[64 * j] * (sc[64 * j] + 1.f) + sh[64 * j];
            if (QKV_FP8) o4[64 * j] = pg8::pk4_fp8(h.x, h.y, h.z, h.w);
            else o8[64 * j] = (unsigned long long)pkbf(h.x, h.y) | ((unsigned long long)pkbf(h.z, h.w) << 32); }
    }
}

__device__ __forceinline__ void p3_dilated(const Ctx& C) {
#if BAND_FP8
    attn_body::band8_phase<0>((const unsigned char*)(C.ws + WS_QKV0), (attn_body::bf16*)(C.ws + WS_OG), (float*)(C.ws + SM_LSE), (const float*)(C.ws + SM_BIAST), C.vcu, C.G, 384 * 16, (char*)C.lds + RING_OFF);
    return;
#endif
#if PROBE_BAND
    attn_body::band_phase<PROBE_BAND - 1>((const attn_body::bf16*)(C.ws + WS_QKV0), (attn_body::bf16*)(C.ws + WS_XB), (float*)(C.ws + WS_XB + 200 * MiB), (const float*)(C.ws + SM_BIAST), C.vcu, C.G, 384 * 16, (char*)C.lds + RING_OFF);
#endif
    attn_body::band_phase<0>((const attn_body::bf16*)(C.ws + WS_QKV0), (attn_body::bf16*)(C.ws + WS_OG), (float*)(C.ws + SM_LSE), (const float*)(C.ws + SM_BIAST), C.vcu, C.G, 384 * 16, (char*)C.lds + RING_OFF);
}
template <int MODE> __device__ __forceinline__ void p12_fox(const Ctx& C, size_t o_off) {
    const attn_body::bf16* QKV = (const attn_body::bf16*)(C.ws + WS_QKV1);
    attn_body::bf16* O = (attn_body::bf16*)(C.ws + o_off); const float* FC = (const float*)(C.ws + SM_FCUM);
    LAS float* Fl = (LAS float*)(C.lds + RING_OFF + attn_body::T_F);
    LAS int* qslot = (LAS int*)(C.lds + BLK_OFF);
    unsigned* qhead = (unsigned*)(C.ws + WS_CTL) + CW_QUEUE; const unsigned* NRM = (const unsigned*)(C.ws + WS_CTL) + CW_NRM;
    int cur_bh = -1; float thr = 0.f;
    for (;;) {
        int l_; asm volatile("v_mbcnt_lo_u32_b32 %0, -1, 0\n\tv_mbcnt_hi_u32_b32 %0, -1, %0" : "=v"(l_)); const int t_ = C.wave * 64 + l_;
        __syncthreads();
        if (t_ == 0) qslot[0] = (int)__hip_atomic_fetch_add(qhead, 1u, __ATOMIC_RELAXED, __HIP_MEMORY_SCOPE_AGENT);
        __syncthreads();
        const int idx = qslot[0];
        if (idx >= 2048) break;
        const int qb = 15 - (idx >> 7), bh = idx & 127, b = bh >> 4, h = bh & 15, q0 = qb * 256;
        const attn_body::bf16* Qp = QKV + ((size_t)(b * 3 + 0) * 16 + h) * 4096 * 64;
        const attn_body::bf16* Kp = QKV + ((size_t)(b * 3 + 1) * 16 + h) * 4096 * 64;
        const attn_body::bf16* Vp = QKV + ((size_t)(b * 3 + 2) * 16 + h) * 4096 * 64;
        if (bh != cur_bh) {
            { const f32x4* src = (const f32x4*)(FC + (size_t)bh * 4096); LAS f32x4* dst = (LAS f32x4*)Fl; dst[t_] = src[t_]; dst[512 + t_] = src[512 + t_]; }
            const float gq = __uint_as_float(NRM[((b * 2 + 0) * 16 + h) * 2]) + __uint_as_float(NRM[((b * 2 + 0) * 16 + h) * 2 + 1]);
            const float gk = __uint_as_float(NRM[((b * 2 + 1) * 16 + h) * 2]) + __uint_as_float(NRM[((b * 2 + 1) * 16 + h) * 2 + 1]);
            thr = 2.f * (sqrtf(gq) * sqrtf(gk) * 1.001f + 1e-3f) + 152.f;
            cur_bh = bh;
            __syncthreads();
        }
        int tlo = 0;
        if (MODE == 1) {
            const int NTq = 4 * qb;
            const bool dead = (l_ < NTq) && (Fl[q0] - Fl[64 * l_ + 63] <= -thr);
            tlo = __popcll(__ballot(dead)) & ~1;
        }
        attn_body::attn_unit_t<MODE, 64>(Qp + (size_t)q0 * 64, Kp + (size_t)tlo * 4096, Vp + (size_t)tlo * 4096, 4 * qb + 4 - tlo, 64 * tlo, (WO_FP8 && MODE == 1) ? (attn_body::bf16*)((unsigned char*)O + ((size_t)b * 4096 + q0) * D + h * 64) : O + ((size_t)b * 4096 + q0) * D + h * 64, (long)D, nullptr, 0, (char*)C.lds + RING_OFF);
    }
}
__device__ __forceinline__ void p4_merge(const Ctx& C) {
    const bf16* OG = (const bf16*)(C.ws + WS_OG); const float* LSE = (const float*)(C.ws + SM_LSE); bf16* O = (bf16*)(C.ws + WS_O);
    const int gt = C.vcu * 512 + C.tid, NGT = C.G * 512;
    for (int i = gt; i < T * 128; i += NGT) { const int tok = i >> 7, c8 = i & 127, hd = c8 >> 3;
        const float l0 = LSE[(size_t)tok * 16 + hd], l1 = LSE[((size_t)T + tok) * 16 + hd], l2 = LSE[((size_t)2 * T + tok) * 16 + hd];
        const float mx = fmaxf(l0, fmaxf(l1, l2)); float w0 = __builtin_amdgcn_exp2f(l0 - mx), w1 = __builtin_amdgcn_exp2f(l1 - mx), w2 = __builtin_amdgcn_exp2f(l2 - mx);
        const float inv = 1.f / (w0 + w1 + w2); w0 *= inv; w1 *= inv; w2 *= inv;
        const u32x4v a0 = NT_ROWS ? __builtin_nontemporal_load((const u32x4v*)(OG + (size_t)tok * D + c8 * 8)) : *(const u32x4v*)(OG + (size_t)tok * D + c8 * 8), a1 = NT_ROWS ? __builtin_nontemporal_load((const u32x4v*)(OG + ((size_t)T + tok) * D + c8 * 8)) : *(const u32x4v*)(OG + ((size_t)T + tok) * D + c8 * 8), a2 = NT_ROWS ? __builtin_nontemporal_load((const u32x4v*)(OG + ((size_t)2 * T + tok) * D + c8 * 8)) : *(const u32x4v*)(OG + ((size_t)2 * T + tok) * D + c8 * 8);
        u32x4v o;
#pragma unroll
        for (int k = 0; k < 4; ++k) { const float lo = w0 * bf2f(a0[k] & 0xffffu) + w1 * bf2f(a1[k] & 0xffffu) + w2 * bf2f(a2[k] & 0xffffu);
            float hi = w0 * bf2f(a0[k] >> 16) + w1 * bf2f(a1[k] >> 16) + w2 * bf2f(a2[k] >> 16); float lo2 = lo;
#if PROBE_SANITIZE
            if (!(fabsf(lo2) < 1e30f)) lo2 = 0.f; if (!(fabsf(hi) < 1e30f)) hi = 0.f;
#endif
            o[k] = pkbf(lo2, hi); }
        if (WO_FP8) { u32x2v o8; o8.x = pg8::pk4_fp8(bf2f(o[0] & 0xffffu), bf2f(o[0] >> 16), bf2f(o[1] & 0xffffu), bf2f(o[1] >> 16)); o8.y = pg8::pk4_fp8(bf2f(o[2] & 0xffffu), bf2f(o[2] >> 16), bf2f(o[3] & 0xffffu), bf2f(o[3] >> 16));
            *(u32x2v*)((unsigned char*)O + (size_t)tok * D + c8 * 8) = o8; }
        else *(u32x4v*)(O + (size_t)tok * D + c8 * 8) = o; }
}

__device__ __forceinline__ f32x4 bf4_to_f32(u32x2v v) { return (f32x4){bf2f(v.x & 0xffffu), bf2f(v.x >> 16), bf2f(v.y & 0xffffu), bf2f(v.y >> 16)}; }
typedef u32x2v xs4_t;
__device__ __forceinline__ f32x4 xs4_to_f32(xs4_t v) { return bf4_to_f32(v); }
__device__ __forceinline__ xs4_t f32_to_xs4(f32x4 v) { xs4_t r; r.x = pkbf(v.x, v.y); r.y = pkbf(v.z, v.w); return r; }
#if Y_FP8
typedef unsigned yraw4_t;
__device__ __forceinline__ f32x4 y4_to_f32(yraw4_t v) { const auto lo = __builtin_amdgcn_cvt_pk_f32_fp8((int)v, false), hi = __builtin_amdgcn_cvt_pk_f32_fp8((int)v, true); return (f32x4){lo[0], lo[1], hi[0], hi[1]}; }
#define Y_ROWPTR(Yb, slot) ((const yraw4_t*)((const unsigned char*)(Yb) + (size_t)(slot) * D) + C.lane)
#else
typedef u32x2v yraw4_t;
__device__ __forceinline__ f32x4 y4_to_f32(yraw4_t v) { return bf4_to_f32(v); }
#define Y_ROWPTR(Yb, slot) ((const yraw4_t*)((Yb) + (size_t)(slot) * D) + C.lane)
#endif

__device__ __forceinline__ void r1_router(const Ctx& C, const Args& a, int l) {
    LAS float* scrf = (LAS float*)(C.lds + SCR_OFF + C.wave * 2048);
    LAS int* scri = (LAS int*)scrf;
    LAS int* blk = (LAS int*)(C.lds + BLK_OFF);
    const float* rw = a.in[IN_RW] + (size_t)l * D * 32;
    LAS unsigned short* wh = (LAS unsigned short*)(C.lds + RING_OFF); LAS unsigned short* wlo = (LAS unsigned short*)(C.lds + RING_OFF + 65536);
    int tab_b = -1;
    const bf16* XS = (const bf16*)(C.ws + WS_XS); unsigned char* H8 = (unsigned char*)(C.ws + WS_H8);
    const float* ADA = (const float*)(C.ws + SM_ADA) + (size_t)l * 8 * 6144;
    const float* GM = (const float*)(C.ws + SM_GM) + (size_t)(l * 2 + 1) * 8 * 1024;
    const float* CSH = (const float*)(C.ws + SM_CSH) + l * 256;
    int* TOPI = (int*)(C.ws + SM_TOPI); float* TOPG = (float*)(C.ws + SM_TOPG); int* RANK = (int*)(C.ws + SM_RANK); int* BLKCNT = (int*)(C.ws + SM_BLKCNT);
    const int tk = C.lane & 15, q = C.lane >> 4;
    for (int vb = C.vcu; vb < NVB; vb += C.G) {
        const int tok0 = vb * 128 + C.wave * 16, b = tok0 >> 12, tok = tok0 + tk;
        if (b != tab_b) {
            __syncthreads();
            const float* gmb = GM + b * 1024;
            for (int i = C.tid; i < D * 32; i += 512) { const int dd = i >> 5, e = i & 31; const float w = rw[i] * gmb[dd];
                const unsigned hb = pkbf(w, 0.f) & 0xffffu; const float hf = bf2f(hb); const unsigned lb = pkbf(w - hf, 0.f) & 0xffffu;
                const int pos = ((((dd >> 5) * 4 + ((dd >> 3) & 3)) * 32 + e) << 3) + (dd & 7);
                wh[pos] = (unsigned short)hb; wlo[pos] = (unsigned short)lb; }
            __syncthreads();
            tab_b = b;
        }
        const bf16* xrow = XS + (size_t)tok * D + 8 * q;
        f32x4 acc0 = {0.f, 0.f, 0.f, 0.f}, acc1 = {0.f, 0.f, 0.f, 0.f}; float ssq = 0.f;
        typedef short bf16x8r __attribute__((ext_vector_type(8)));
#pragma unroll 4
        for (int kk = 0; kk < 32; ++kk) {
            const u32x4v xr8 = *(const u32x4v*)(xrow + 32 * kk);
#pragma unroll
            for (int e2 = 0; e2 < 4; ++e2) { const float x0 = bf2f(xr8[e2] & 0xffffu), x1 = bf2f(xr8[e2] >> 16); ssq += x0 * x0 + x1 * x1; }
            const bf16x8r xb = __builtin_bit_cast(bf16x8r, xr8);
            const int fo = ((kk * 4 + q) * 32 + tk) << 3;
            const bf16x8r h0 = *(const LAS bf16x8r*)(wh + fo), h1 = *(const LAS bf16x8r*)(wh + fo + 128), l0 = *(const LAS bf16x8r*)(wlo + fo), l1 = *(const LAS bf16x8r*)(wlo + fo + 128);
            acc0 = __builtin_amdgcn_mfma_f32_16x16x32_bf16(h0, xb, acc0, 0, 0, 0); acc1 = __builtin_amdgcn_mfma_f32_16x16x32_bf16(h1, xb, acc1, 0, 0, 0);
            acc0 = __builtin_amdgcn_mfma_f32_16x16x32_bf16(l0, xb, acc0, 0, 0, 0); acc1 = __builtin_amdgcn_mfma_f32_16x16x32_bf16(l1, xb, acc1, 0, 0, 0);
        }
        ssq += __shfl_xor(ssq, 16); ssq += __shfl_xor(ssq, 32);
        const float rstd = 1.f / sqrtf(ssq * (1.f / D) + RMS_EPS);
        { const f32x4 c0 = *(const f32x4*)(CSH + b * 32 + 4 * q), c1 = *(const f32x4*)(CSH + b * 32 + 16 + 4 * q);
          *(LAS f32x4*)(scrf + tk * 32 + 4 * q) = acc0 * rstd + c0; *(LAS f32x4*)(scrf + tk * 32 + 16 + 4 * q) = acc1 * rstd + c1; }
        LDS_WAIT();
        int myidx[4] = {0, 0, 0, 0};
        if (C.lane < 16) {
            float v[32];
#pragma unroll
            for (int j = 0; j < 8; ++j) { const f32x4 t4 = *(const LAS f32x4*)(scrf + C.lane * 32 + 4 * j); v[4 * j] = t4.x; v[4 * j + 1] = t4.y; v[4 * j + 2] = t4.z; v[4 * j + 3] = t4.w; }
            float val[4];
#pragma unroll
            for (int k = 0; k < 4; ++k) { float best = v[0]; int bi = 0;
#pragma unroll
                for (int e = 1; e < 32; ++e) { if (v[e] > best) { best = v[e]; bi = e; } }
                val[k] = best; myidx[k] = bi;
#pragma unroll
                for (int e = 0; e < 32; ++e) v[e] = (e == bi) ? -INFINITY : v[e]; }
            const float e1 = __expf(val[1] - val[0]), e2 = __expf(val[2] - val[0]), e3 = __expf(val[3] - val[0]), inv = 1.f / (1.f + e1 + e2 + e3);
            *(i32x4v*)(TOPI + (size_t)(tok0 + C.lane) * 4) = (i32x4v){myidx[0], myidx[1], myidx[2], myidx[3]};
            *(f32x4*)(TOPG + (size_t)(tok0 + C.lane) * 4) = (f32x4){inv, e1 * inv, e2 * inv, e3 * inv};
        }
        LDS_WAIT();
        if (C.lane < 16) *(LAS i32x4v*)(scri + C.lane * 4) = (i32x4v){myidx[0], myidx[1], myidx[2], myidx[3]};
        LDS_WAIT();
        const int e = scri[C.lane];
        const unsigned long long lt = (1ull << C.lane) - 1ull;
        int rank = 0, mycnt = 0;
#pragma unroll 4
        for (int j = 0; j < 32; ++j) { const unsigned long long mk = __ballot(e == j); if (e == j) rank = __popcll(mk & lt); if (C.lane == j) mycnt = __popcll(mk); }
        if (C.lane < 32) blk[BL_WCNT + C.wave * 32 + C.lane] = mycnt;
        __syncthreads();
        if (C.lane < 32) { int wb = 0;
            for (int w8 = 0; w8 < C.wave; ++w8) wb += blk[BL_WCNT + w8 * 32 + C.lane];
            blk[BL_WBASE + C.wave * 32 + C.lane] = wb;
            if (C.wave == NWAVES - 1) BLKCNT[vb * 32 + C.lane] = wb + mycnt; }
        LDS_WAIT();
        RANK[(size_t)tok0 * 4 + C.lane] = blk[BL_WBASE + C.wave * 32 + e] + rank;
        const f32x4* shf = (const f32x4*)(ADA + (size_t)b * 6144 + 3 * 1024) + C.lane; const f32x4* gm4 = (const f32x4*)(GM + b * 1024) + C.lane;
#pragma unroll 2
        for (int tt = 0; tt < 16; ++tt) { const float rs = __shfl(rstd, tt); const int tkn = tok0 + tt;
            const xs4_t* xr = (const xs4_t*)(XS + (size_t)tkn * D) + C.lane; unsigned* o4 = (unsigned*)(H8 + (size_t)tkn * D) + C.lane;
#pragma unroll
            for (int j = 0; j < 4; ++j) { const f32x4 h = xs4_to_f32(xr[64 * j]) * rs * gm4[64 * j] + shf[64 * j];
                o4[64 * j] = pg8::pk4_fp8(h.x, h.y, h.z, h.w); } }
        __syncthreads();
    }
}

__device__ __forceinline__ void p7_route(const Ctx& C) {
    LAS int* blk = (LAS int*)(C.lds + BLK_OFF);
    const int* BLKCNT = (const int*)(C.ws + SM_BLKCNT); const int* TOPI = (const int*)(C.ws + SM_TOPI); const int* RANK = (const int*)(C.ws + SM_RANK);
    int* SLOT = (int*)(C.ws + SM_SLOT); int* TILEEXP = (int*)(C.ws + SM_TILEEXP); int* TOKSLOT = (int*)(C.ws + SM_TOKSLOT);
    const unsigned char* H8 = (const unsigned char*)(C.ws + WS_H8); unsigned char* XB = (unsigned char*)(C.ws + WS_XB);
    const int e = C.tid & 31, part = C.tid >> 5;
    { int s = 0; for (int k = 0; k < 16; ++k) s += BLKCNT[(part * 16 + k) * 32 + e]; blk[BL_PARTA + part * 32 + e] = s; }
    __syncthreads();
    if (C.tid < 32) { int tot = 0; for (int p = 0; p < 16; ++p) tot += blk[BL_PARTA + p * 32 + C.tid]; blk[BL_TOT + C.tid] = tot; }
    __syncthreads();
    if (C.tid == 0) { int run = 0; for (int k = 0; k < 32; ++k) { blk[BL_PADS + k] = run; run += (blk[BL_TOT + k] + 255) & ~255; } blk[BL_PADS + 32] = run; }
    __syncthreads();
    if (C.vcu == 0) {
        const int nt = blk[BL_PADS + 32] >> 8;
        if (C.tid == 0) TILEEXP[0] = nt;
        for (int i = C.tid; i < nt; i += 512) { int ex = 0; for (int k = 1; k < 32; ++k) ex += (blk[BL_PADS + k] <= i * 256) ? 1 : 0; TILEEXP[16 + i] = ex; }
        if (C.tid < 33) TILEEXP[640 + C.tid] = blk[BL_PADS + C.tid] >> 8;
    }
    for (int vb = C.vcu; vb < NVB; vb += C.G) {
        __syncthreads();
        { int s = 0; for (int k = 0; k < 16; ++k) { const int bb = part * 16 + k; s += (bb < vb) ? BLKCNT[bb * 32 + e] : 0; } blk[BL_PARTB + part * 32 + e] = s; }
        __syncthreads();
        if (C.tid < 32) { int bs = 0; for (int p = 0; p < 16; ++p) bs += blk[BL_PARTB + p * 32 + C.tid]; blk[BL_BASE + C.tid] = bs + blk[BL_PADS + C.tid]; }
        __syncthreads();
        { const int i = vb * 512 + C.tid; const int ex = TOPI[i]; SLOT[i] = blk[BL_BASE + ex] + RANK[i]; }
        VM_WAIT(); __syncthreads();
#if MOE_GATHER
        { const int i = vb * 512 + C.tid; TOKSLOT[SLOT[i]] = i >> 2; }
#else
        for (int tt = 0; tt < 16; ++tt) { const int tok = vb * 128 + C.wave * 16 + tt;
            const i32x4v sl = *(const i32x4v*)(SLOT + (size_t)tok * 4);
            const u32x4v v0 = *((const u32x4v*)(H8 + (size_t)tok * D) + C.lane);
#pragma unroll
            for (int k = 0; k < 4; ++k) { u32x4v* dst = (u32x4v*)(XB + (size_t)sl[k] * D); dst[C.lane] = v0; } }
#endif
    }
#if MOE_GATHER
    for (int ex = C.vcu; ex < 32; ex += C.G) { const int beg = blk[BL_PADS + ex] + blk[BL_TOT + ex], end = blk[BL_PADS + ex + 1];
        for (int s = beg + C.tid; s < end; s += 512) TOKSLOT[s] = 0; }
#endif
}
__device__ __forceinline__ int load_tile_table(const Ctx& C) {
    LAS int* blk = (LAS int*)(C.lds + BLK_OFF); const int* TILEEXP = (const int*)(C.ws + SM_TILEEXP);
    const int nt = TILEEXP[0];
    __syncthreads();
    for (int i = C.tid; i < MAXTILES; i += 512) blk[BL_TILE + i] = (i < nt) ? TILEEXP[16 + i] : 0;
    __syncthreads();
    return __builtin_amdgcn_readfirstlane(nt);
}


__device__ __forceinline__ void r2_seam(const Ctx& C, const Args& a) {
    LAS float* wl = (LAS float*)(C.lds + RING_OFF);
    { const float* wf = a.in[IN_WKVF]; const float* gkv0 = a.in[IN_KVNG];
      for (int i = C.tid; i < D * 16; i += 512) { const int d = i >> 4, h = i & 15, jj = d >> 8, ln = (d >> 2) & 63, c = d & 3;
          wl[((((jj * 4 + c) * 4 + (h >> 2)) * 64 + ln) << 2) + (h & 3)] = wf[(size_t)d * 2064 + 2048 + h] * gkv0[d]; } }
    __syncthreads();
    bf16* XS = (bf16*)(C.ws + WS_XS); bf16* HKV = (bf16*)(C.ws + WS_HKV); const bf16* Y = (const bf16*)(C.ws + WS_Y);
    const float* ADA0 = (const float*)(C.ws + SM_ADA); const float* ADA1 = ADA0 + (size_t)8 * 6144;
    const float* GM1 = (const float*)(C.ws + SM_GM) + (size_t)(1 * 2 + 0) * 8 * 1024;
    const int* SLOT = (const int*)(C.ws + SM_SLOT); const float* TOPG = (const float*)(C.ws + SM_TOPG); float* LOGF = (float*)(C.ws + SM_LOGF);
    const f32x4* gk4 = (const f32x4*)a.in[IN_KVNG] + C.lane;
    const int gw = C.vcu * NWAVES + C.wave, NGW = C.G * NWAVES;
    const float bfh = a.in[IN_BF][(C.lane >> 2) & 15];
    typedef yraw4_t yraw_t;
#define R2_LOADRAW(XR, Y0, Y1, Y2, Y3, MM, SS) do { const xs4_t* xr_ = (const xs4_t*)(XS + (size_t)(MM) * D) + C.lane; \
        const yraw4_t* z0_ = Y_ROWPTR(Y, (SS)[0]); const yraw4_t* z1_ = Y_ROWPTR(Y, (SS)[1]); \
        const yraw4_t* z2_ = Y_ROWPTR(Y, (SS)[2]); const yraw4_t* z3_ = Y_ROWPTR(Y, (SS)[3]); \
        _Pragma("unroll") for (int j = 0; j < 4; ++j) { if (NT_ROWS) { XR[j] = __builtin_nontemporal_load(xr_ + 64 * j); Y0[j] = __builtin_nontemporal_load(z0_ + 64 * j); Y1[j] = __builtin_nontemporal_load(z1_ + 64 * j); Y2[j] = __builtin_nontemporal_load(z2_ + 64 * j); Y3[j] = __builtin_nontemporal_load(z3_ + 64 * j); } else { XR[j] = xr_[64 * j]; Y0[j] = z0_[64 * j]; Y1[j] = z1_[64 * j]; Y2[j] = z2_[64 * j]; Y3[j] = z3_[64 * j]; } } } while (0)
    xs4_t xc[4], xn[4]; yraw_t y0c[4], y1c[4], y2c[4], y3c[4], y0n[4], y1n[4], y2n[4], y3n[4];
    i32x4v s_cur = *(const i32x4v*)(SLOT + (size_t)gw * 4); f32x4 g_cur = *(const f32x4*)(TOPG + (size_t)gw * 4);
    i32x4v s_nxt = s_cur; f32x4 g_nxt = g_cur;
    if (gw + NGW < T) { s_nxt = *(const i32x4v*)(SLOT + (size_t)(gw + NGW) * 4); g_nxt = *(const f32x4*)(TOPG + (size_t)(gw + NGW) * 4); }
    R2_LOADRAW(xc, y0c, y1c, y2c, y3c, gw, s_cur);
    for (int m = gw; m < T; m += NGW) { const int b = m >> 12;
        const int mn = m + NGW, mnn = m + 2 * NGW;
        i32x4v s_nn = s_nxt; f32x4 g_nn = g_nxt;
        if (mnn < T) { s_nn = *(const i32x4v*)(SLOT + (size_t)mnn * 4); g_nn = *(const f32x4*)(TOPG + (size_t)mnn * 4); }
        if (mn < T) R2_LOADRAW(xn, y0n, y1n, y2n, y3n, mn, s_nxt);
        const f32x4* gf4 = (const f32x4*)(ADA0 + (size_t)b * 6144 + 5 * 1024) + C.lane;
        const f32x4* gm4 = (const f32x4*)(GM1 + b * 1024) + C.lane; const f32x4* shm4 = (const f32x4*)(ADA1 + (size_t)b * 6144) + C.lane;
        xs4_t* xw = (xs4_t*)(XS + (size_t)m * D) + C.lane;
        f32x4 v[4]; float s = 0.f;
#pragma unroll
        for (int j = 0; j < 4; ++j) {
            const f32x4 ys = y4_to_f32(y0c[j]) * g_cur[0] + y4_to_f32(y1c[j]) * g_cur[1] + y4_to_f32(y2c[j]) * g_cur[2] + y4_to_f32(y3c[j]) * g_cur[3];
            v[j] = xs4_to_f32(xc[j]) + gf4[64 * j] * ys; xw[64 * j] = f32_to_xs4(v[j]); v[j] = xs4_to_f32(f32_to_xs4(v[j]));
            s += (v[j].x * v[j].x + v[j].y * v[j].y) + (v[j].z * v[j].z + v[j].w * v[j].w); }
        const float rstd = 1.f / sqrtf(wave_sum(s) * (1.f / D) + RMS_EPS);
        float acc[16];
#pragma unroll
        for (int h = 0; h < 16; ++h) acc[h] = 0.f;
#pragma unroll
        for (int j = 0; j < 4; ++j)
#pragma unroll
            for (int c = 0; c < 4; ++c) { const float xv = v[j][c];
#pragma unroll
                for (int h4 = 0; h4 < 4; ++h4) { const f32x4 w = *(const LAS f32x4*)(wl + ((((j * 4 + c) * 4 + h4) * 64 + C.lane) << 2));
                    acc[4 * h4] += xv * w[0]; acc[4 * h4 + 1] += xv * w[1]; acc[4 * h4 + 2] += xv * w[2]; acc[4 * h4 + 3] += xv * w[3]; }
                if (c == 3) __builtin_amdgcn_sched_barrier(0); }
#pragma unroll
        for (int j = 0; j < 4; ++j) { const f32x4 n = v[j] * rstd, h = n * gm4[64 * j] + shm4[64 * j], hk = n * gk4[64 * j];
            if (KVQ_FP8) { ((unsigned*)(C.ws + WS_HKV + (size_t)T * D + (size_t)m * D) + C.lane)[64 * j] = pg8::pk4_fp8(h.x, h.y, h.z, h.w);
                           ((unsigned*)(C.ws + WS_HKV + (size_t)m * D) + C.lane)[64 * j] = pg8::pk4_fp8(hk.x, hk.y, hk.z, hk.w); }
            else { ((unsigned long long*)(HKV + (size_t)T * D + (size_t)m * D) + C.lane)[64 * j] = (unsigned long long)pkbf(h.x, h.y) | ((unsigned long long)pkbf(h.z, h.w) << 32);
                   ((unsigned long long*)(HKV + (size_t)m * D) + C.lane)[64 * j] = (unsigned long long)pkbf(hk.x, hk.y) | ((unsigned long long)pkbf(hk.z, hk.w) << 32); } }
        __builtin_amdgcn_sched_barrier(0);
        float r8[8], r4[4], r2v[2], r1;
        { const bool up = (C.lane & 32) != 0;
#pragma unroll
          for (int i = 0; i < 8; ++i) { const float snd = up ? acc[i] : acc[i + 8], kp = up ? acc[i + 8] : acc[i]; r8[i] = kp + __shfl_xor(snd, 32); } }
        { const bool up = (C.lane & 16) != 0;
#pragma unroll
          for (int i = 0; i < 4; ++i) { const float snd = up ? r8[i] : r8[i + 4], kp = up ? r8[i + 4] : r8[i]; r4[i] = kp + __shfl_xor(snd, 16); } }
        { const bool up = (C.lane & 8) != 0;
#pragma unroll
          for (int i = 0; i < 2; ++i) { const float snd = up ? r4[i] : r4[i + 2], kp = up ? r4[i + 2] : r4[i]; r2v[i] = kp + __shfl_xor(snd, 8); } }
        { const bool up = (C.lane & 4) != 0; const float snd = up ? r2v[0] : r2v[1], kp = up ? r2v[1] : r2v[0]; r1 = kp + __shfl_xor(snd, 4); }
        r1 += __shfl_xor(r1, 2); r1 += __shfl_xor(r1, 1);
        if ((C.lane & 3) == 0) { const float z = r1 * rstd + bfh; LOGF[(size_t)m * 16 + ((C.lane >> 2) & 15)] = (fminf(z, 0.f) - log1pf(__expf(-fabsf(z)))) * LOG2E; }
#pragma unroll
        for (int j = 0; j < 4; ++j) { xc[j] = xn[j]; y0c[j] = y0n[j]; y1c[j] = y1n[j]; y2c[j] = y2n[j]; y3c[j] = y3n[j]; }
        s_cur = s_nxt; g_cur = g_nxt; s_nxt = s_nn; g_nxt = g_nn;
    }
#undef R2_LOADRAW
}
__device__ __forceinline__ void fcum_scan(const Ctx& C) {
    const float* LOGF = (const float*)(C.ws + SM_LOGF); float* FC = (float*)(C.ws + SM_FCUM);
    LAS float* wtot = (LAS float*)(C.lds + BLK_OFF);
    for (int sq = C.vcu; sq < 128; sq += C.G) { const int b = sq >> 4, h = sq & 15;
        const float* src = LOGF + ((size_t)b * 4096 + C.tid * 8) * 16 + h; float* dst = FC + (size_t)sq * 4096 + C.tid * 8;
        float v[8]; float tot = 0.f;
#pragma unroll
        for (int i = 0; i < 8; ++i) { v[i] = src[i * 16]; }
#pragma unroll
        for (int i = 0; i < 8; ++i) { tot += v[i]; v[i] = tot; }
        float inc = tot;
#pragma unroll
        for (int o = 1; o < 64; o <<= 1) { const float t = __shfl_up(inc, o); if (C.lane >= o) inc += t; }
        __syncthreads();
        if (C.lane == 63) wtot[C.wave] = inc;
        __syncthreads();
        float carry = inc - tot;
        for (int w8 = 0; w8 < C.wave; ++w8) carry += wtot[w8];
#pragma unroll
        for (int i = 0; i < 8; ++i) dst[i] = v[i] + carry;
    }
}
__device__ __forceinline__ void r3_final(const Ctx& C, const Args& a, float* XD) {
    const bf16* XS = (const bf16*)(C.ws + WS_XS); const bf16* Y = (const bf16*)(C.ws + WS_Y);
    const float* ADA1 = (const float*)(C.ws + SM_ADA) + (size_t)8 * 6144;
    const int* SLOT = (const int*)(C.ws + SM_SLOT); const float* TOPG = (const float*)(C.ws + SM_TOPG);
    const f32x4* fg4 = (const f32x4*)a.in[IN_FNG] + C.lane;
    const int gw = C.vcu * NWAVES + C.wave, NGW = C.G * NWAVES;
#define R3_LOADRAW(XR, Y0, Y1, Y2, Y3, MM, SS) do { const xs4_t* xr_ = (const xs4_t*)(XS + (size_t)(MM) * D) + C.lane; \
        const yraw4_t* z0_ = Y_ROWPTR(Y, (SS)[0]); const yraw4_t* z1_ = Y_ROWPTR(Y, (SS)[1]); \
        const yraw4_t* z2_ = Y_ROWPTR(Y, (SS)[2]); const yraw4_t* z3_ = Y_ROWPTR(Y, (SS)[3]); \
        _Pragma("unroll") for (int j = 0; j < 4; ++j) { if (NT_ROWS) { XR[j] = __builtin_nontemporal_load(xr_ + 64 * j); Y0[j] = __builtin_nontemporal_load(z0_ + 64 * j); Y1[j] = __builtin_nontemporal_load(z1_ + 64 * j); Y2[j] = __builtin_nontemporal_load(z2_ + 64 * j); Y3[j] = __builtin_nontemporal_load(z3_ + 64 * j); } else { XR[j] = xr_[64 * j]; Y0[j] = z0_[64 * j]; Y1[j] = z1_[64 * j]; Y2[j] = z2_[64 * j]; Y3[j] = z3_[64 * j]; } } } while (0)
    xs4_t xc[4], xn[4]; yraw4_t y0c[4], y1c[4], y2c[4], y3c[4], y0n[4], y1n[4], y2n[4], y3n[4];
    i32x4v s_cur = *(const i32x4v*)(SLOT + (size_t)gw * 4); f32x4 g_cur = *(const f32x4*)(TOPG + (size_t)gw * 4);
    i32x4v s_nxt = s_cur; f32x4 g_nxt = g_cur;
    if (gw + NGW < T) { s_nxt = *(const i32x4v*)(SLOT + (size_t)(gw + NGW) * 4); g_nxt = *(const f32x4*)(TOPG + (size_t)(gw + NGW) * 4); }
    R3_LOADRAW(xc, y0c, y1c, y2c, y3c, gw, s_cur);
    for (int m = gw; m < T; m += NGW) { const int b = m >> 12;
        const int mn = m + NGW, mnn = m + 2 * NGW;
        i32x4v s_nn = s_nxt; f32x4 g_nn = g_nxt;
        if (mnn < T) { s_nn = *(const i32x4v*)(SLOT + (size_t)mnn * 4); g_nn = *(const f32x4*)(TOPG + (size_t)mnn * 4); }
        if (mn < T) R3_LOADRAW(xn, y0n, y1n, y2n, y3n, mn, s_nxt);
        const f32x4* gf4 = (const f32x4*)(ADA1 + (size_t)b * 6144 + 5 * 1024) + C.lane;
        f32x4* xw = (f32x4*)(XD + (size_t)m * D) + C.lane;
        f32x4 v[4]; float s = 0.f;
#pragma unroll
        for (int j = 0; j < 4; ++j) {
            const f32x4 ys = y4_to_f32(y0c[j]) * g_cur[0] + y4_to_f32(y1c[j]) * g_cur[1] + y4_to_f32(y2c[j]) * g_cur[2] + y4_to_f32(y3c[j]) * g_cur[3];
            v[j] = xs4_to_f32(xc[j]) + gf4[64 * j] * ys; s += (v[j].x * v[j].x + v[j].y * v[j].y) + (v[j].z * v[j].z + v[j].w * v[j].w); }
        const float rstd = 1.f / sqrtf(wave_sum(s) * (1.f / D) + RMS_EPS);
#pragma unroll
        for (int j = 0; j < 4; ++j) xw[64 * j] = v[j] * rstd * fg4[64 * j];
#pragma unroll
        for (int j = 0; j < 4; ++j) { xc[j] = xn[j]; y0c[j] = y0n[j]; y1c[j] = y1n[j]; y2c[j] = y2n[j]; y3c[j] = y3n[j]; }
        s_cur = s_nxt; g_cur = g_nxt; s_nxt = s_nn; g_nxt = g_nn;
    }
#undef R3_LOADRAW
}

constexpr int N_PHASES = 19;
__global__ void __launch_bounds__(NWAVES * 64, 2) yoco_fwd(Args args) {
    extern __shared__ __attribute__((aligned(16))) unsigned char lds[];
    Ctx C;
    C.lds = (LAS unsigned char*)lds; C.ws = args.ws;
    C.tid = threadIdx.x; C.lane = C.tid & 63; C.wave = __builtin_amdgcn_readfirstlane(C.tid >> 6);
    C.G = gridDim.x; { const int bx = blockIdx.x; C.vcu = (C.G % 8 == 0) ? (bx % 8) * (C.G / 8) + bx / 8 : bx; }
    volatile LAS unsigned* MISC = (volatile LAS unsigned*)(C.lds + MISC_OFF);
    if (C.tid < 64) MISC[C.tid] = 0u;
    __syncthreads();
    const int lo = args.ph_lo, hi = args.ph_hi;
    const bool one = (hi - lo) > 1;
    unsigned* ctl = (unsigned*)(args.ws + WS_CTL);
    XcdBarrier bar; bar.bar = ctl + CW_BAR; bar.x = 0; bar.st = nullptr;
    if (one) bar = xcd_barrier_post(ctl + CW_BAR, MISC + 8);
#define IN(k) (lo <= (k) && (k) < hi)
#define SEAM(k) do { if (IN(k) && IN((k) + 1)) xcd_barrier(bar); } while (0)
#define FRESH() do { int l_; asm volatile("v_mbcnt_lo_u32_b32 %0, -1, 0\n\tv_mbcnt_hi_u32_b32 %0, -1, %0" : "=v"(l_)); C.lane = l_; C.tid = C.wave * 64 + l_; } while (0)
#define REP(k) _Pragma("unroll") for (int rep_ = 0; rep_ < 1 + ((PROBE_DUP >> (k)) & 1); ++rep_)
    bf16* const Hb = (bf16*)(C.ws + WS_H);
    if (IN(0)) { FRESH(); REP(0) { p0_prologue(C, args); } SEAM(0); }
    if (IN(1)) { FRESH(); REP(1) { p1_rows0(C, args); } SEAM(1); }
    if (IN(2)) { FRESH();
#if PROBE_QKV
        { pg8::Gemm g{(const pg8::bf16_t*)(C.ws + WS_H8), (const pg8::bf16_t*)(C.ws + WS_WQKV), T, NQKV, D}; pg8::StaticOrder S; S.init(T, NQKV, C.G, (int)blockIdx.x);
#if PROBE_QKV == 1
          pg8::EpiQKV0 E{(pg8::bf16_t*)(C.ws + WS_QKV0), 0.015625f};
          pg8::gemm_phase<pg8::EpiQKV0, pg8::StaticOrder, true, true, 1>(C.lds + RING_OFF, g, S, E);
#elif PROBE_QKV == 2
          pg8::EpiQKV0Probe E{(pg8::bf16_t*)(C.ws + WS_XB), 0.015625f, 4};
          pg8::gemm_phase<pg8::EpiQKV0Probe, pg8::StaticOrder, true, true, 1>(C.lds + RING_OFF, g, S, E);
#else
          pg8::EpiNone E{(unsigned char*)(C.ws + WS_XB)};
          pg8::gemm_phase<pg8::EpiNone, pg8::StaticOrder, true, true, 1>(C.lds + RING_OFF, g, S, E);
#endif
        }
#endif
#if STAGGER_QKV
        { const unsigned long long t0 = __builtin_amdgcn_s_memrealtime(); const unsigned long long dl = (unsigned long long)(C.vcu & 7) * STAGGER_QKV;
          while (__builtin_amdgcn_s_memrealtime() - t0 < dl) __builtin_amdgcn_s_sleep(8); }
#endif
        REP(2) {
        pg8::Gemm g{QKV_FP8 ? (const pg8::bf16_t*)(C.ws + WS_H8) : (const pg8::bf16_t*)Hb, (const pg8::bf16_t*)(C.ws + WS_WQKV), T, NQKV, D}; pg8::StaticOrder S; S.init(T, NQKV, C.G, (int)blockIdx.x);
#if BAND_FP8
#if QKV_WIDE
        pg8::EpiQKV08W E{(unsigned char*)(C.ws + WS_QKV0), QKV_FP8 ? 0.015625f : 1.f};
        pg8::gemm_phase<pg8::EpiQKV08W, pg8::StaticOrder, true, true, QKV_FP8 ? 1 : 2, false, 1>(C.lds + RING_OFF, g, S, E);
#else
        pg8::EpiQKV08 E{(unsigned char*)(C.ws + WS_QKV0), QKV_FP8 ? 0.015625f : 1.f};
        pg8::gemm_phase<pg8::EpiQKV08, pg8::StaticOrder, true, true, QKV_FP8 ? 1 : 2>(C.lds + RING_OFF, g, S, E);
#endif
#else
        pg8::EpiQKV0 E{(pg8::bf16_t*)(C.ws + WS_QKV0), QKV_FP8 ? 0.015625f : 1.f};
        pg8::gemm_phase<pg8::EpiQKV0, pg8::StaticOrder, true, true, QKV_FP8 ? 1 : 2>(C.lds + RING_OFF, g, S, E);
#endif
        } SEAM(2);
    }
    if (IN(3)) { FRESH(); REP(3) { p3_dilated(C); } SEAM(3); }
    if (IN(4)) { FRESH(); REP(4) { p4_merge(C); } SEAM(4); }
    if (IN(5)) { FRESH(); REP(5) {
        pg8::Gemm g{(const pg8::bf16_t*)(C.ws + WS_O), (const pg8::bf16_t*)(C.ws + WS_WO0), T, D, D}; pg8::StaticOrder S; S.init(T, D, C.G, (int)blockIdx.x);
        pg8::EpiResid<false> E{args.in[IN_X], (pg8::bf16_t*)(C.ws + WS_XS), (const float*)(C.ws + SM_ADA) + 2 * 1024, WO_FP8 ? 0.015625f : 1.f};
        pg8::gemm_phase<pg8::EpiResid<false>, pg8::StaticOrder, true, true, WO_FP8 ? 1 : 2>(C.lds + RING_OFF, g, S, E);
        } SEAM(5);
    }
    if (IN(6)) { FRESH(); REP(6) { r1_router(C, args, 0); } SEAM(6); }
    if (IN(7)) { FRESH(); REP(7) { p7_route(C); } SEAM(7); }
    if (IN(8)) { FRESH();
#if PROBE_GU
        { const int nt = load_tile_table(C);
          pg8::Gemm g{(const pg8::bf16_t*)(C.ws + WS_H8), (const pg8::bf16_t*)(C.ws + WS_WGU), MAXROWS, 32 * 2048, D, (const int*)(C.ws + SM_TOKSLOT)};
          pg8::MoeOrder<8> S{(const LAS int*)(C.lds + BLK_OFF) + BL_TILE, nt, (int)blockIdx.x, C.G};
#if PROBE_GU == 1
          pg8::EpiSwiGLU8 E{(unsigned char*)(C.ws + WS_XB), args.in[IN_BGU]};
          pg8::gemm_phase<pg8::EpiSwiGLU8, pg8::MoeOrder<8>, true, true, 1, true>(C.lds + RING_OFF, g, S, E);
#elif PROBE_GU == 6
          { pg8::MoeOrderProbe S2{(const LAS int*)(C.lds + BLK_OFF) + BL_TILE, nt, (int)blockIdx.x, C.G};
            pg8::EpiProbeGU<2> E{(unsigned char*)(C.ws + WS_XB), args.in[IN_BGU]};
            pg8::gemm_phase<pg8::EpiProbeGU<2>, pg8::MoeOrderProbe, true, true, 1, true>(C.lds + RING_OFF, g, S2, E); }
#else
          pg8::EpiProbeGU<PROBE_GU - 2> E{(unsigned char*)(C.ws + WS_XB), args.in[IN_BGU]};
          pg8::gemm_phase<pg8::EpiProbeGU<PROBE_GU - 2>, pg8::MoeOrder<8>, true, true, 1, true>(C.lds + RING_OFF, g, S, E);
#endif
        }
#endif
        REP(8) {
        const int nt = load_tile_table(C);
        pg8::Gemm g{(const pg8::bf16_t*)(C.ws + (MOE_GATHER ? WS_H8 : WS_XB)), (const pg8::bf16_t*)(C.ws + WS_WGU), MAXROWS, 32 * 2048, D, (const int*)(C.ws + SM_TOKSLOT)};
        pg8::MoeOrder<8> S{(const LAS int*)(C.lds + BLK_OFF) + BL_TILE, nt, (int)blockIdx.x, C.G};
        pg8::EpiSwiGLU8 E{(unsigned char*)(C.ws + WS_ACT), args.in[IN_BGU]};
        pg8::gemm_phase<pg8::EpiSwiGLU8, pg8::MoeOrder<8>, true, true, 1, MOE_GATHER != 0>(C.lds + RING_OFF, g, S, E);
        } SEAM(8);
    }
    if (IN(9)) { FRESH(); REP(9) {
        const int nt = load_tile_table(C);
        pg8::Gemm g{(const pg8::bf16_t*)(C.ws + WS_ACT), (const pg8::bf16_t*)(C.ws + WS_WDN), MAXROWS, 32 * 1024, D};
        pg8::MoeOrder<4> S{(const LAS int*)(C.lds + BLK_OFF) + BL_TILE, nt, (int)blockIdx.x, C.G};
        pg8::EpiDown8 E{(pg8::bf16_t*)(C.ws + WS_Y), args.in[IN_BDN]};
        pg8::gemm_phase<pg8::EpiDown8, pg8::MoeOrder<4>, true, true, 1>(C.lds + RING_OFF, g, S, E);
        } SEAM(9);
    }
    if (IN(10)) { FRESH(); r2_seam(C, args); SEAM(10); }
    if (IN(11)) { FRESH(); REP(11) {
        fcum_scan(C);
        pg8::Gemm g{(const pg8::bf16_t*)(C.ws + WS_HKV), (const pg8::bf16_t*)(C.ws + WS_WKV), T, 3072, D}; pg8::KVQOrder S; S.init(T, 3072, C.G, (int)blockIdx.x);
        pg8::EpiKVQ E{(pg8::bf16_t*)(C.ws + WS_QKV1), KVQ_FP8 ? 0.015625f : 1.f, (unsigned*)(C.ws + WS_CTL) + CW_NRM};
        pg8::gemm_phase<pg8::EpiKVQ, pg8::KVQOrder, true, true, KVQ_FP8 ? 1 : 2>(C.lds + RING_OFF, g, S, E);
        } SEAM(11);
    }
    if (IN(12)) { FRESH(); if (PROBE_FOX == 2) p12_fox<2>(C, WS_OG); REP(12) { p12_fox<1>(C, WS_O); } SEAM(12); }
    if (IN(13)) { FRESH(); REP(13) {
        pg8::Gemm g{(const pg8::bf16_t*)(C.ws + WS_O), (const pg8::bf16_t*)(C.ws + WS_WO1), T, D, D}; pg8::StaticOrder S; S.init(T, D, C.G, (int)blockIdx.x);
        pg8::EpiResid<true> E{C.ws + WS_XS, (pg8::bf16_t*)(C.ws + WS_XS), (const float*)(C.ws + SM_ADA) + (size_t)8 * 6144 + 2 * 1024, WO_FP8 ? 0.015625f : 1.f};
        pg8::gemm_phase<pg8::EpiResid<true>, pg8::StaticOrder, true, true, WO_FP8 ? 1 : 2>(C.lds + RING_OFF, g, S, E);
        } SEAM(13);
    }
    if (IN(14)) { FRESH(); REP(14) { r1_router(C, args, 1); } SEAM(14); }
    if (IN(15)) { FRESH(); REP(15) { p7_route(C); } if (DEFER_L1W) { __syncthreads(); convert_weights(C, args, 1); } SEAM(15); }
    if (IN(16)) { FRESH();
#if PROBE_LATE_QKV
        { pg8::Gemm g{(const pg8::bf16_t*)(C.ws + WS_ACT), (const pg8::bf16_t*)(C.ws + WS_WQKV), T, NQKV, D}; pg8::StaticOrder S; S.init(T, NQKV, C.G, (int)blockIdx.x);
          pg8::EpiNone E{(unsigned char*)(C.ws + WS_XB)};
          pg8::gemm_phase<pg8::EpiNone, pg8::StaticOrder, true, true, 1>(C.lds + RING_OFF, g, S, E); }
#endif
        REP(16) {
        const int nt = load_tile_table(C);
        pg8::Gemm g{(const pg8::bf16_t*)(C.ws + (MOE_GATHER ? WS_H8 : WS_XB)), (const pg8::bf16_t*)(C.ws + WS_WGU + (size_t)32 * 2048 * D), MAXROWS, 32 * 2048, D, (const int*)(C.ws + SM_TOKSLOT)};
        pg8::MoeOrder<8> S{(const LAS int*)(C.lds + BLK_OFF) + BL_TILE, nt, (int)blockIdx.x, C.G};
        pg8::EpiSwiGLU8 E{(unsigned char*)(C.ws + WS_ACT), args.in[IN_BGU] + 32 * 2048};
        pg8::gemm_phase<pg8::EpiSwiGLU8, pg8::MoeOrder<8>, true, true, 1, MOE_GATHER != 0>(C.lds + RING_OFF, g, S, E);
        } SEAM(16);
    }
    if (IN(17)) { FRESH(); REP(17) {
        const int nt = load_tile_table(C);
        pg8::Gemm g{(const pg8::bf16_t*)(C.ws + WS_ACT), (const pg8::bf16_t*)(C.ws + WS_WDN + (size_t)32 * 1024 * D), MAXROWS, 32 * 1024, D};
        pg8::MoeOrder<4> S{(const LAS int*)(C.lds + BLK_OFF) + BL_TILE, nt, (int)blockIdx.x, C.G};
        pg8::EpiDown8 E{(pg8::bf16_t*)(C.ws + WS_Y), args.in[IN_BDN] + 32 * 1024};
        pg8::gemm_phase<pg8::EpiDown8, pg8::MoeOrder<4>, true, true, 1>(C.lds + RING_OFF, g, S, E);
        } SEAM(17);
    }
    if (IN(18)) { FRESH(); r3_final(C, args, args.out); }
#undef IN
#undef SEAM
}

extern "C" void kernel_launch(void* const* d_in, const int* in_sizes, int n_in, void* d_out, int out_size, void* d_ws, size_t ws_size, hipStream_t stream) {
    static int grid = 0;
    if (grid == 0) {
        if (n_in != 21 || in_sizes[0] != T * D || out_size != T * D || ws_size < WS_END) { fprintf(stderr, "kernel_launch: unexpected shapes (n_in %d, in0 %d, out %d, ws %zu)\n", n_in, n_in > 0 ? in_sizes[0] : -1, out_size, ws_size); grid = -1; return; }
        int dev = 0, cus = 0, per_cu = 0;
        if (hipGetDevice(&dev) != hipSuccess || hipDeviceGetAttribute(&cus, hipDeviceAttributeMultiprocessorCount, dev) != hipSuccess) { grid = -1; return; }
        if (hipFuncSetAttribute((const void*)yoco_fwd, hipFuncAttributeMaxDynamicSharedMemorySize, LDS_BYTES) != hipSuccess) { fprintf(stderr, "kernel_launch: hipFuncSetAttribute failed\n"); grid = -1; return; }
        if (hipOccupancyMaxActiveBlocksPerMultiprocessor(&per_cu, (const void*)yoco_fwd, NWAVES * 64, LDS_BYTES) != hipSuccess || per_cu < 1) { fprintf(stderr, "kernel_launch: occupancy query reports %d blocks per CU\n", per_cu); }
        (void)hipGetLastError();
        grid = cus;
    }
    if (grid < 0) return;
    (void)hipMemsetAsync((char*)d_ws + WS_CTL, 0, CTL_ZERO_BYTES, stream);
    Args a{};
    for (int i = 0; i < 21; ++i) a.in[i] = (const float*)d_in[i];
    a.out = (float*)d_out; a.ws = (unsigned char*)d_ws;
#if MK_ONE_LAUNCH
    a.ph_lo = 0; a.ph_hi = N_PHASES;
    hipLaunchKernelGGL(yoco_fwd, dim3(grid), dim3(NWAVES * 64), LDS_BYTES, stream, a);
#else
    for (int p = 0; p < N_PHASES; ++p) { a.ph_lo = p; a.ph_hi = p + 1; hipLaunchKernelGGL(yoco_fwd, dim3(grid), dim3(NWAVES * 64), LDS_BYTES, stream, a); }
#endif
}
```

```cpp
#include <hip/hip_runtime.h>
#include <hip/hip_bf16.h>
#include <cstdio>
#include <cstdint>
#include <cmath>
#ifndef MK_ONE_LAUNCH
#define MK_ONE_LAUNCH 1
#endif
#ifndef PROBE_DUP
#define PROBE_DUP 0
#endif
#ifndef PG8_F8_SCALED
#define PG8_F8_SCALED 0
#endif
#ifndef QKV_FP8
#define QKV_FP8 1
#endif
#ifndef KVQ_FP8
#define KVQ_FP8 1
#endif
#ifndef PROBE_EPI
#define PROBE_EPI 0
#endif
#ifndef PROBE_FOX
#define PROBE_FOX 0
#endif
#ifndef PROBE_SANITIZE
#define PROBE_SANITIZE 0
#endif
#ifndef PROBE_BAND
#define PROBE_BAND 0
#endif
#ifndef Y_FP8
#define Y_FP8 1
#endif
#ifndef WO_FP8
#define WO_FP8 1
#endif
#ifndef MOE_GATHER
#define MOE_GATHER 1
#endif
#ifndef PROBE_QKV
#define PROBE_QKV 0
#endif
#ifndef PROBE_GU
#define PROBE_GU 0
#endif
#ifndef STAGGER_QKV
#define STAGGER_QKV 0
#endif
#ifndef NT_STORE
#define NT_STORE 0
#endif
#ifndef RELAX_STORES
#define RELAX_STORES 0
#endif
#ifndef PROBE_LATE_QKV
#define PROBE_LATE_QKV 0
#endif
#ifndef NT_P0
#define NT_P0 1
#endif
#ifndef NT_ROWS
#define NT_ROWS 1
#endif
#ifndef NT_P0ST
#define NT_P0ST 0
#endif
#ifndef DEFER_L1W
#define DEFER_L1W 0
#endif
#ifndef BAND_FP8
#define BAND_FP8 1
#endif
#ifndef QKV_WIDE
#define QKV_WIDE 1
#endif
#ifndef CONV_X0
#define CONV_X0 0
#endif
#ifndef CONV_X1
#define CONV_X1 40
#endif
#ifndef CONV_DEPTH
#define CONV_DEPTH 5
#endif
namespace pg8 {
#define PG8_LAS __attribute__((address_space(3)))
typedef unsigned short bf16_t;
typedef short bf16x8 __attribute__((ext_vector_type(8)));
typedef float f32x4 __attribute__((ext_vector_type(4)));
typedef unsigned u32x4 __attribute__((ext_vector_type(4)));
constexpr int BM = 256, BK = 64, HALF = 128, HTB = HALF * BK * 2  , STAGE_BYTES = 8 * HTB, NXCD = 8, WGM = 8;

__host__ __device__ __forceinline__ int lds_byte(int r, int c) { const int st = (r >> 4) * 2 + (c >> 5), rr = r & 15, cc = c & 31, ob = rr * 64 + cc * 2; return st * 1024 + (ob ^ (((ob >> 9) & 1) << 5)); }
__host__ __device__ __forceinline__ void stage_rc(int b, int& R, int& C) { const int st = b / 1024, sb = b % 1024, swz = sb ^ (((sb >> 9) & 1) << 5); R = (st >> 1) * 16 + swz / 64; C = (st & 1) * 32 + (swz % 64) / 2; }
__host__ __device__ __forceinline__ int perm32(int rho) { const int n = rho >> 4, i = rho & 15; return 8 * (i >> 2) + 4 * n + (i & 3); }

struct Unit { int pm, pn; };
struct Gemm { const bf16_t* A; const bf16_t* Bt; int M, N, K; const int* rows = nullptr; };

struct StaticOrder {
    int nM, nN, nwg, G, c;
    __host__ __device__ void init(int M, int N, int G_, int c_) { nM = M / BM; nN = N / BM; nwg = nM * nN; G = G_; c = c_; }
    __host__ __device__ bool next(int i, Unit& u) const {
        const long L = (long)i * G + c; if (L >= nwg) return false;
        int wgid = (int)L; { const int q = nwg / NXCD, r = nwg % NXCD, xcd = wgid % NXCD, off = wgid / NXCD; wgid = (xcd < r ? xcd * (q + 1) : r * (q + 1) + (xcd - r) * q) + off; }
        const int nig = WGM * nN, gid = wgid / nig, fm = gid * WGM, gsz = (nM - fm) < WGM ? (nM - fm) : WGM;
        u.pm = fm + ((wgid % nig) % gsz); u.pn = (wgid % nig) / gsz; return true;
    }
    __device__ __forceinline__ void a_ready(const Unit&) const {}
    __device__ __forceinline__ void done(const Unit&) const {}
};
__device__ __forceinline__ unsigned cvt_pk_bf16(float lo, float hi) { unsigned r; asm volatile("v_cvt_pk_bf16_f32 %0, %1, %2" : "=v"(r) : "v"(lo), "v"(hi)); return r; }
typedef float f32x2 __attribute__((ext_vector_type(2)));
typedef int i32x8 __attribute__((ext_vector_type(8))); typedef int i32x4p __attribute__((ext_vector_type(4)));
#ifndef PG8_F8_SCALE
#define PG8_F8_SCALE 0x7f7f7f7f
#endif
__device__ __forceinline__ i32x8 pg8_cat(bf16x8 lo, bf16x8 hi) { const i32x4p a = __builtin_bit_cast(i32x4p, lo), b = __builtin_bit_cast(i32x4p, hi); return (i32x8){a.x, a.y, a.z, a.w, b.x, b.y, b.z, b.w}; }
#if PG8_F8_SCALED
__device__ __forceinline__ void pg8_mma8(f32x4& acc, i32x8 b, i32x8 a) { asm volatile("v_mfma_scale_f32_16x16x128_f8f6f4 %0, %1, %2, %0, %3, %3 op_sel_hi:[0,0,0]" : "+v"(acc) : "v"(b), "v"(a), "v"(0x7f7f7f7f)); }
#else
__device__ __forceinline__ void pg8_mma8(f32x4& acc, i32x8 b, i32x8 a) { asm volatile("v_mfma_f32_16x16x128_f8f6f4 %0, %1, %2, %0" : "+v"(acc) : "v"(b), "v"(a)); }
#endif
__device__ __forceinline__ void pg8_mma16(f32x4& acc, bf16x8 b, bf16x8 a) { asm volatile("v_mfma_f32_16x16x32_bf16 %0, %1, %2, %0" : "+v"(acc) : "v"(b), "v"(a)); }
template <class Epi, class Sched, bool ALIGN_EPI = false, bool SP2 = false, int ES = 2  , bool GATHER = false  , int BMAP = 0  >
__device__ __forceinline__ void gemm_phase(PG8_LAS unsigned char* lds, const Gemm g, const Sched& S, const Epi& E) {
    const int tid = threadIdx.x, wid = __builtin_amdgcn_readfirstlane(tid >> 6), lane = tid & 63, wr = wid >> 2, wc = wid & 3, fr = lane & 15, fq = lane >> 4;
    const int K = g.K * ES / 2  , nt = K / BK;
    unsigned voffA[2], voffB[2];
#pragma unroll
    for (int i = 0; i < 2; ++i) { int R, C; stage_rc(tid * 16 + i * 8192, R, C); const int Rb = BMAP == 1 ? ((R >> 5) * 64 + 16 * ((R & 15) >> 2) + 4 * ((R >> 4) & 1) + (R & 3)) : (Epi::PERM ? ((R & ~31) + perm32(R & 31)) : R);
        voffA[i] = (unsigned)(R * K + C) * 2u; voffB[i] = (unsigned)(Rb * K + C) * 2u; }
    const size_t kstep = (size_t)(BK * 2);
    const size_t hstep = (size_t)HALF * K * 2;
    const size_t tstep = 2 * hstep;
    const size_t hstepB = BMAP == 1 ? (size_t)8 * K * 2 : hstep;
    const size_t hstepA = GATHER ? 0 : hstep;
    unsigned cG0[2] = {voffA[0], voffA[1]}, cG1[2] = {voffA[0], voffA[1]}, nG0[2] = {voffA[0], voffA[1]}, nG1[2] = {voffA[0], voffA[1]};
#define PG8_GROWS(G0, G1, PM) do { if constexpr (GATHER) { _Pragma("unroll") for (int i_ = 0; i_ < 2; ++i_) { int R_, C_; stage_rc(tid * 16 + i_ * 8192, R_, C_); \
        const int* rp_ = g.rows + (size_t)(PM) * 256 + R_; G0[i_] = (unsigned)rp_[0] * (unsigned)(K * 2) + (unsigned)(C_ * 2); G1[i_] = (unsigned)rp_[128] * (unsigned)(K * 2) + (unsigned)(C_ * 2); } } } while (0)
    const unsigned ldsw = (unsigned)wid * 1024u;
    const int aoff = lds_byte(wr * 64 + fr, fq * 8), boff = lds_byte(wc * 32 + fr, fq * 8);
#define PG8_SA(b, h) (((b) * 2 + (h)) * HTB)
#define PG8_SB(b, h) ((4 + (b) * 2 + (h)) * HTB)
#define PG8_STAGE(bufoff, gbase, voff) do { _Pragma("unroll") for (int _i = 0; _i < 2; ++_i) \
        __builtin_amdgcn_global_load_lds((const unsigned*)((const char*)(gbase) + (voff)[_i]), (PG8_LAS unsigned*)(lds + (bufoff) + ldsw + _i * 8192), 16, 0, 0); } while (0)
#define PG8_LDA(dst, b, h) do { _Pragma("unroll") for (int m = 0; m < 4; ++m) _Pragma("unroll") for (int k = 0; k < 2; ++k) dst[m][k] = *(const PG8_LAS bf16x8*)(lds + PG8_SA(b, h) + aoff + m * 2048 + k * 1024); } while (0)
#define PG8_LDB(dst, b, h) do { _Pragma("unroll") for (int n = 0; n < 2; ++n) _Pragma("unroll") for (int k = 0; k < 2; ++k) dst[n][k] = *(const PG8_LAS bf16x8*)(lds + PG8_SB(b, h) + boff + n * 2048 + k * 1024); } while (0)
#define PG8_MMA(ai, bj, At, Bt) do { __builtin_amdgcn_s_setprio(1); _Pragma("unroll") for (int m = 0; m < 4; ++m) _Pragma("unroll") for (int n = 0; n < 2; ++n) { \
        if constexpr (ES == 2) { _Pragma("unroll") for (int k = 0; k < 2; ++k) acc[ai][bj][m][n] = __builtin_amdgcn_mfma_f32_16x16x32_bf16(Bt[n][k], At[m][k], acc[ai][bj][m][n], 0, 0, 0); } \
        else { pg8_mma8(acc[ai][bj][m][n], pg8_cat(Bt[n][0], Bt[n][1]), pg8_cat(At[m][0], At[m][1])); } } \
        __builtin_amdgcn_s_setprio(0); } while (0)
#define PG8_WAIT_V(n) asm volatile("s_waitcnt vmcnt(" #n ")" ::: "memory")
#define PG8_WAIT_L(n) asm volatile("s_waitcnt lgkmcnt(" #n ")" ::: "memory")
#define PG8_WAIT_V8R do { if (relax_st) { if constexpr (Epi::NSTORE == 16) asm volatile("s_waitcnt vmcnt(24)" ::: "memory"); else if constexpr (Epi::NSTORE == 8) asm volatile("s_waitcnt vmcnt(16)" ::: "memory"); else asm volatile("s_waitcnt vmcnt(8)" ::: "memory"); } \
        else asm volatile("s_waitcnt vmcnt(8)" ::: "memory"); } while (0)
#define PG8_BAR __builtin_amdgcn_s_barrier()
#define PG8_SCHED __builtin_amdgcn_sched_barrier(0)
    Unit cur, nxt; int ui = 0;
    if (!S.next(0, cur)) return;
    f32x4 acc[2][2][4][2];
#pragma unroll
    for (int a = 0; a < 2; ++a)
#pragma unroll
        for (int b = 0; b < 2; ++b)
#pragma unroll
            for (int m = 0; m < 4; ++m)
#pragma unroll
                for (int n = 0; n < 2; ++n) acc[a][b][m][n] = (f32x4){0.f, 0.f, 0.f, 0.f};
    bf16x8 At[4][2], B0[2][2], B1[2][2];
    const char* cA = (const char*)g.A + (GATHER ? (size_t)0 : (size_t)cur.pm * tstep); const char* cB = (const char*)g.Bt + (size_t)cur.pn * tstep;
    PG8_GROWS(cG0, cG1, cur.pm);
    S.a_ready(cur);
    if constexpr (SP2) {
        PG8_STAGE(PG8_SB(0, 0), cB, voffB); PG8_STAGE(PG8_SB(0, 1), cB + hstepB, voffB); PG8_STAGE(PG8_SA(0, 0), cA, cG0); PG8_STAGE(PG8_SA(0, 1), cA + hstepA, cG1);
        if (wr == 1) PG8_BAR;
        PG8_WAIT_V(2); PG8_BAR;
        PG8_STAGE(PG8_SB(1, 0), cB + kstep, voffB); PG8_STAGE(PG8_SA(1, 0), cA + kstep, cG0); PG8_STAGE(PG8_SB(1, 1), cB + hstepB + kstep, voffB);
        PG8_WAIT_V(6); PG8_BAR;
    } else {
        PG8_STAGE(PG8_SB(0, 0), cB, voffB); PG8_STAGE(PG8_SA(0, 0), cA, cG0); PG8_STAGE(PG8_SB(0, 1), cB + hstepB, voffB); PG8_STAGE(PG8_SA(0, 1), cA + hstepA, cG1);
        if (wr == 1) PG8_BAR;
        PG8_WAIT_V(4); PG8_BAR;
        PG8_STAGE(PG8_SB(1, 0), cB + kstep, voffB); PG8_STAGE(PG8_SA(1, 0), cA + kstep, cG0); PG8_STAGE(PG8_SB(1, 1), cB + hstepB + kstep, voffB);
        PG8_WAIT_V(6); PG8_BAR;
    }
    for (;;) {
        const bool has_next = S.next(ui + 1, nxt);
        const char* nA = (has_next && !GATHER) ? (const char*)g.A + (size_t)nxt.pm * tstep : cA; const char* nB = has_next ? (const char*)g.Bt + (size_t)nxt.pn * tstep : cB;
        if (has_next) PG8_GROWS(nG0, nG1, nxt.pm); else { nG0[0] = cG0[0]; nG0[1] = cG0[1]; nG1[0] = cG1[0]; nG1[1] = cG1[1]; }
#pragma unroll 1
        for (int t = 0; t < nt; t += 2) {
            const bool last = (t == nt - 2);
            const bool relax_st = RELAX_STORES && (t == 0) && (ui > 0);
            const char* a1 = cA + (size_t)(t + 1) * kstep;
            const char* a2 = last ? nA : cA + (size_t)(t + 2) * kstep; const char* b2 = last ? nB : cB + (size_t)(t + 2) * kstep;
            const char* a3 = a2 + kstep; const char* b3 = b2 + kstep;
            if (last && has_next) S.a_ready(nxt);
            const unsigned s0[2] = {last ? nG0[0] : cG0[0], last ? nG0[1] : cG0[1]}, s1[2] = {last ? nG1[0] : cG1[0], last ? nG1[1] : cG1[1]};
            if constexpr (SP2) {
            PG8_LDB(B0, 0, 0); PG8_LDB(B1, 0, 1); PG8_SCHED; PG8_LDA(At, 0, 0); PG8_STAGE(PG8_SA(1, 1), a1 + hstepA, cG1);
            PG8_WAIT_V8R; PG8_WAIT_L(0); PG8_BAR; PG8_MMA(0, 0, At, B0); PG8_MMA(0, 1, At, B1); PG8_BAR; PG8_SCHED;
            PG8_LDA(At, 0, 1); PG8_STAGE(PG8_SB(0, 0), b2, voffB); PG8_STAGE(PG8_SB(0, 1), b2 + hstepB, voffB); PG8_STAGE(PG8_SA(0, 0), a2, s0);
            PG8_WAIT_V8R; PG8_WAIT_L(0); PG8_BAR; PG8_MMA(1, 0, At, B0); PG8_MMA(1, 1, At, B1); PG8_BAR; PG8_SCHED;
            PG8_LDB(B0, 1, 0); PG8_LDB(B1, 1, 1); PG8_SCHED; PG8_LDA(At, 1, 0); PG8_STAGE(PG8_SA(0, 1), a2 + hstepA, s1);
            PG8_WAIT_V(8); PG8_WAIT_L(0); PG8_BAR; PG8_MMA(0, 0, At, B0); PG8_MMA(0, 1, At, B1); PG8_BAR; PG8_SCHED;
            PG8_LDA(At, 1, 1); PG8_STAGE(PG8_SB(1, 0), b3, voffB); PG8_STAGE(PG8_SB(1, 1), b3 + hstepB, voffB); PG8_STAGE(PG8_SA(1, 0), a3, s0);
            PG8_WAIT_V(8); PG8_WAIT_L(0); PG8_BAR; PG8_MMA(1, 0, At, B0); PG8_MMA(1, 1, At, B1); PG8_BAR; PG8_SCHED;
            } else {
            PG8_LDB(B0, 0, 0); PG8_SCHED; PG8_LDA(At, 0, 0); PG8_STAGE(PG8_SA(1, 1), a1 + hstepA, cG1);
            PG8_WAIT_L(8); PG8_BAR; PG8_WAIT_L(0); PG8_MMA(0, 0, At, B0); PG8_BAR; PG8_SCHED;
            PG8_LDB(B1, 0, 1); PG8_STAGE(PG8_SB(0, 0), b2, voffB);
            PG8_BAR; PG8_WAIT_L(0); PG8_MMA(0, 1, At, B1); PG8_BAR;
            PG8_LDA(At, 0, 1); PG8_STAGE(PG8_SA(0, 0), a2, s0);
            PG8_BAR; PG8_WAIT_L(0); PG8_MMA(1, 0, At, B0); PG8_BAR; PG8_SCHED;
            PG8_STAGE(PG8_SB(0, 1), b2 + hstepB, voffB);
            PG8_WAIT_V(6); PG8_BAR; PG8_MMA(1, 1, At, B1); PG8_BAR;
            PG8_LDB(B0, 1, 0); PG8_SCHED; PG8_LDA(At, 1, 0); PG8_STAGE(PG8_SA(0, 1), a2 + hstepA, s1);
            PG8_WAIT_L(8); PG8_BAR; PG8_WAIT_L(0); PG8_MMA(0, 0, At, B0); PG8_BAR; PG8_SCHED;
            PG8_LDB(B1, 1, 1); PG8_STAGE(PG8_SB(1, 0), b3, voffB);
            PG8_BAR; PG8_WAIT_L(0); PG8_MMA(0, 1, At, B1); PG8_BAR;
            PG8_LDA(At, 1, 1); PG8_STAGE(PG8_SA(1, 0), a3, s0);
            PG8_BAR; PG8_WAIT_L(0); PG8_MMA(1, 0, At, B0); PG8_BAR; PG8_SCHED;
            PG8_STAGE(PG8_SB(1, 1), b3 + hstepB, voffB);
            PG8_WAIT_V(6); PG8_BAR; PG8_MMA(1, 1, At, B1); PG8_BAR;
            }
        }
        if constexpr (ES == 1) asm volatile("s_nop 15\n\ts_nop 15" ::: "memory");
        if constexpr (ALIGN_EPI) { if (wr == 0) PG8_BAR; }
        if constexpr (!Epi::AFTER_DRAIN) { E(acc, cur, wr, wc, fr, fq); S.done(cur); }
        if (!has_next) break;
#pragma unroll
        for (int a = 0; a < 2; ++a)
#pragma unroll
            for (int b = 0; b < 2; ++b)
#pragma unroll
                for (int m = 0; m < 4; ++m)
#pragma unroll
                    for (int n = 0; n < 2; ++n) acc[a][b][m][n] = (f32x4){0.f, 0.f, 0.f, 0.f};
        cur = nxt; cA = nA; cB = nB; ++ui; cG0[0] = nG0[0]; cG0[1] = nG0[1]; cG1[0] = nG1[0]; cG1[1] = nG1[1];
        if constexpr (ALIGN_EPI) { if (wr == 1) PG8_BAR; }
    }
    PG8_WAIT_V(0);
    if constexpr (!ALIGN_EPI) { if (wr == 0) PG8_BAR; }
    PG8_BAR;
    if constexpr (Epi::AFTER_DRAIN) { E.fused(acc, cur, wr, wc, fr, fq, lds, wid, lane); S.done(cur); }
#undef PG8_GROWS
#undef PG8_SA
#undef PG8_SB
#undef PG8_STAGE
#undef PG8_LDA
#undef PG8_LDB
#undef PG8_MMA
#undef PG8_WAIT_V
#undef PG8_WAIT_L
#undef PG8_WAIT_V8R
#undef PG8_BAR
#undef PG8_SCHED
}
}
namespace attn_body {
using bf16=__hip_bfloat16;
using bf16x8=__attribute__((ext_vector_type(8)))short;
using s16x4=__attribute__((ext_vector_type(4)))short;
using f32x16=__attribute__((ext_vector_type(16)))float;
using u32x4=__attribute__((ext_vector_type(4)))unsigned;
__device__ __forceinline__ int crow(int r,int hi){return (r&3)+8*(r>>2)+4*hi;}
#define SBAR() __builtin_amdgcn_sched_barrier(0)
__device__ __forceinline__ void glds16(const void*gsrc,unsigned lds_dst){unsigned keep;
  asm volatile("s_mov_b32 %0, m0\n\ts_mov_b32 m0, %2\n\ts_nop 0\n\tglobal_load_lds_dwordx4 %1, off\n\ts_mov_b32 m0, %0":"=&s"(keep):"v"(gsrc),"s"(lds_dst):"memory");}
__device__ __forceinline__ float max3f(float a,float b,float c){float r;asm("v_max3_f32 %0, %1, %2, %3":"=v"(r):"v"(a),"v"(b),"v"(c));return r;}
__device__ __forceinline__ float max2f(float a,float b){float r;asm("v_max_f32_e32 %0, %1, %2":"=v"(r):"v"(a),"v"(b));return r;}
__device__ __forceinline__ float fadd_s(float a,float b){float r;asm("v_add_f32_e32 %0, %1, %2":"=v"(r):"v"(a),"v"(b));return r;}
__device__ __forceinline__ float fsub_s(float a,float b){float r;asm("v_sub_f32_e32 %0, %1, %2":"=v"(r):"v"(a),"v"(b));return r;}
typedef float f32x2_t __attribute__((ext_vector_type(2))); typedef __bf16 bf16x2_t __attribute__((ext_vector_type(2)));
__device__ __forceinline__ unsigned cvtpk_s(float lo,float hi){f32x2_t v={lo,hi};bf16x2_t b=__builtin_convertvector(v,bf16x2_t);return __builtin_bit_cast(unsigned,b);}
#define WAIT_BAR(N) asm volatile("s_waitcnt vmcnt(" #N ") lgkmcnt(0)\n\ts_barrier":::"memory")
typedef __attribute__((address_space(3))) const char* lds_cptr;
typedef short v4i16_t __attribute__((ext_vector_type(4)));
__device__ __forceinline__ void kload8(bf16x8*kf,lds_cptr kp){
  kf[0]=*(const __attribute__((address_space(3))) bf16x8*)(kp);      kf[1]=*(const __attribute__((address_space(3))) bf16x8*)(kp+512);
  kf[2]=*(const __attribute__((address_space(3))) bf16x8*)(kp+2048); kf[3]=*(const __attribute__((address_space(3))) bf16x8*)(kp+2560);
  kf[4]=*(const __attribute__((address_space(3))) bf16x8*)(kp+4096); kf[5]=*(const __attribute__((address_space(3))) bf16x8*)(kp+4608);
  kf[6]=*(const __attribute__((address_space(3))) bf16x8*)(kp+6144); kf[7]=*(const __attribute__((address_space(3))) bf16x8*)(kp+6656);
}
__device__ __forceinline__ void kload2(bf16x8*kf,lds_cptr kp,int j){ kf[2*j]=*(const __attribute__((address_space(3))) bf16x8*)(kp+j*2048); kf[2*j+1]=*(const __attribute__((address_space(3))) bf16x8*)(kp+j*2048+512); }
__device__ __forceinline__ s16x4 vtr(lds_cptr p){ return __builtin_bit_cast(s16x4,__builtin_amdgcn_ds_read_tr16_b64_v4i16((__attribute__((address_space(3))) v4i16_t*)p)); }
__device__ __forceinline__ float rowmax(const f32x16&p0,const f32x16&p1){
  float a=max3f(p0[0],p0[1],p1[0]),b=max3f(p0[2],p0[3],p1[1]);a=max3f(a,p1[2],p1[3]);
  #pragma unroll
  for(int r=4;r<16;r+=4){a=max3f(a,p0[r],p0[r+1]);b=max3f(b,p0[r+2],p0[r+3]);a=max3f(a,p1[r],p1[r+1]);b=max3f(b,p1[r+2],p1[r+3]);}
  const float m=max2f(a,b);
  auto rr=__builtin_amdgcn_permlane32_swap(__float_as_uint(m),__float_as_uint(m),false,false);
  return max2f(__uint_as_float(rr[0]),__uint_as_float(rr[1]));
}
__device__ __forceinline__ void pv(f32x16*o,int vb,bf16x8 pa0,bf16x8 pa1,bf16x8 pa2,bf16x8 pa3){
  #pragma unroll
  for(int d0=0;d0<2;++d0){s16x4 lo[4],hi[4];
    #pragma unroll
    for(int ks=0;ks<4;++ks){
      asm volatile("ds_read_b64_tr_b16 %0,%1 offset:%c2":"=&v"(lo[ks]):"v"(vb),"i"(d0*4096+ks*1024):"memory");
      asm volatile("ds_read_b64_tr_b16 %0,%1 offset:%c2":"=&v"(hi[ks]):"v"(vb),"i"(d0*4096+ks*1024+512):"memory");}
    asm volatile("s_waitcnt lgkmcnt(0)":::"memory");SBAR();
    #define PK(k) (bf16x8){lo[k][0],lo[k][1],lo[k][2],lo[k][3],hi[k][0],hi[k][1],hi[k][2],hi[k][3]}
    o[d0]=__builtin_amdgcn_mfma_f32_32x32x16_bf16(pa0,PK(0),o[d0],0,0,0);
    o[d0]=__builtin_amdgcn_mfma_f32_32x32x16_bf16(pa1,PK(1),o[d0],0,0,0);
    o[d0]=__builtin_amdgcn_mfma_f32_32x32x16_bf16(pa2,PK(2),o[d0],0,0,0);
    o[d0]=__builtin_amdgcn_mfma_f32_32x32x16_bf16(pa3,PK(3),o[d0],0,0,0);
    #undef PK
  }
}
}

constexpr int BATCH = 8, SEQ = 4096, T = BATCH * SEQ, D = 1024, NE = 32, TOPK = 4, NH = 16, HD = 64;
constexpr int NQKV = 9216;
constexpr int MAXROWS = T * TOPK + NE * 256;
constexpr int MAXTILES = MAXROWS / 256;
constexpr int NVB = T / 128;
constexpr float LOG2E = 1.4426950408889634f;
constexpr float QSCALE = 0.125f * LOG2E;
constexpr float RMS_EPS = 1e-6f;
constexpr int NWAVES = 8;

constexpr size_t MiB = 1ull << 20;
constexpr size_t WS_CTL = 0, CTL_ZERO_BYTES = 1 * MiB;
constexpr size_t WS_SM = 1 * MiB;
constexpr size_t SM_ADA = WS_SM;
constexpr size_t SM_GM = WS_SM + 512 * 1024;
constexpr size_t SM_CSH = WS_SM + 640 * 1024;
constexpr size_t SM_BIAST = WS_SM + 644 * 1024;
constexpr size_t SM_BLKCNT = WS_SM + 704 * 1024;
constexpr size_t SM_TILEEXP = WS_SM + 768 * 1024;
constexpr size_t SM_TOPI = WS_SM + 1 * MiB;
constexpr size_t SM_TOPG = SM_TOPI + 512 * 1024;
constexpr size_t SM_RANK = SM_TOPG + 512 * 1024;
constexpr size_t SM_SLOT = SM_RANK + 512 * 1024;
constexpr size_t SM_TOKSLOT = WS_SM + 3 * MiB;
constexpr size_t SM_LOGF = WS_SM + 4 * MiB;
constexpr size_t SM_FCUM = WS_SM + 6 * MiB;
constexpr size_t SM_LSE = WS_SM + 8 * MiB;
constexpr size_t WS_WQKV = 16 * MiB, WS_WO0 = 34 * MiB, WS_WKV = 36 * MiB, WS_WQ = 40 * MiB, WS_WO1 = 42 * MiB, WS_WGU = 44 * MiB, WS_WDN = 300 * MiB;
constexpr size_t WS_HKV = 428 * MiB, WS_H = 492 * MiB, WS_OG = 556 * MiB, WS_O = 748 * MiB;
constexpr size_t WS_QKV0 = 812 * MiB, WS_ACT = 812 * MiB, WS_Y = 1084 * MiB, WS_QKV1 = 1388 * MiB, WS_XB = 1388 * MiB, WS_H8 = 1524 * MiB, WS_END = 1660 * MiB, WS_XS = WS_H;
static_assert(WS_H == WS_HKV + (size_t)T * D * 2, "H must follow HKV (KVQ GEMM addresses both through one A pointer)");
static_assert(WS_WQ == WS_WKV + (size_t)2048 * 1024 * 2, "Wq_t must follow Wkv_t");
static_assert(SM_LSE + (size_t)3 * T * 16 * 4 <= WS_WQKV, "small region");
static_assert(WS_Y + (size_t)MAXROWS * D * 2 <= WS_QKV1 && WS_XB + (size_t)MAXROWS * D * 2 <= WS_END && WS_QKV0 + (size_t)BATCH * 9 * 16 * SEQ * 64 * 2 <= WS_QKV1, "ws map");
constexpr int CW_TMO = 0, CW_BAR = 4096, CW_QUEUE = 65536  , CW_NRM = 131072  ;

constexpr int RING_OFF = 0, RING_BYTES = 131072;
constexpr int SCR_OFF = RING_BYTES, SCR_BYTES = 16384;
constexpr int BLK_OFF = SCR_OFF + SCR_BYTES, BLK_BYTES = 12288;
constexpr int MISC_OFF = BLK_OFF + BLK_BYTES;
constexpr int LDS_BYTES = MISC_OFF + 256;
constexpr int BL_TILE = 0, BL_WCNT = 576, BL_WBASE = 832, BL_PARTA = 1088, BL_PARTB = 1600, BL_TOT = 2112, BL_BASE = 2144, BL_PADS = 2176;

#define LAS __attribute__((address_space(3)))
#define GAS __attribute__((address_space(1)))
typedef unsigned short bf16;
typedef float f32x4 __attribute__((ext_vector_type(4)));
typedef unsigned u32x4v __attribute__((ext_vector_type(4)));
typedef unsigned u32x2v __attribute__((ext_vector_type(2)));
typedef int i32x4v __attribute__((ext_vector_type(4)));
#define LDS_WAIT() asm volatile("s_waitcnt lgkmcnt(0)" ::: "memory")
#define VM_WAIT() asm volatile("s_waitcnt vmcnt(0)" ::: "memory")

__device__ __forceinline__ float bf2f(unsigned v) { return __uint_as_float(v << 16); }
__device__ __forceinline__ unsigned pkbf(float lo, float hi) { return attn_body::cvtpk_s(lo, hi); }
__device__ __forceinline__ float wave_sum(float v) {
#pragma unroll
    for (int o = 1; o < 64; o <<= 1) v += __shfl_xor(v, o);
    return v;
}

namespace pg8 {
struct EpiQKV0 {
    static constexpr bool PERM = true, AFTER_DRAIN = false; static constexpr int NSTORE = 16;
    bf16_t* O; float mul;
    __device__ __forceinline__ void operator()(const f32x4 (&acc)[2][2][4][2], const Unit& u, int wr, int wc, int fr, int fq) const {
        _Pragma("unroll") for (int rep_e = 0; rep_e < 1 + ((PROBE_EPI >> 0) & 1); ++rep_e) {
        asm volatile("" : "+v"(fr), "+v"(fq));
        const int g = u.pn / 12, rem = u.pn - g * 12, which = rem >> 2, h0 = (rem & 3) * 4, sh = 2 * g;
        const float sc = (which == 0 ? QSCALE : 1.f) * mul;
#pragma unroll
        for (int ai = 0; ai < 2; ++ai)
#pragma unroll
            for (int m = 0; m < 4; ++m) {
                const int tok = u.pm * BM + ai * HALF + wr * 64 + m * 16 + fr, b = tok >> 12, s = tok & 4095;
                const int subrow = (s & ((1 << sh) - 1)) * (4096 >> sh) + (s >> sh);
#pragma unroll
                for (int bj = 0; bj < 2; ++bj) {
                    const int head = h0 + 2 * bj + (wc >> 1), dcol = (wc & 1) * 32 + 8 * fq;
                    const size_t plane = (size_t)(((b * 3 + g) * 3 + which) * 16 + head);
                    const f32x4 v0 = acc[ai][bj][m][0] * sc, v1 = acc[ai][bj][m][1] * sc;
                    u32x4 w; w.x = cvt_pk_bf16(v0[0], v0[1]); w.y = cvt_pk_bf16(v0[2], v0[3]); w.z = cvt_pk_bf16(v1[0], v1[1]); w.w = cvt_pk_bf16(v1[2], v1[3]);
#if NT_STORE
                    __builtin_nontemporal_store(w, (u32x4*)(O + (plane * 4096 + subrow) * 64 + dcol));
#else
                    *(u32x4*)(O + (plane * 4096 + subrow) * 64 + dcol) = w;
#endif
                }
            }
        }
    }
};
struct EpiQKV0Probe {
    static constexpr bool PERM = true, AFTER_DRAIN = false; static constexpr int NSTORE = 16;
    bf16_t* O; float mul; int wide;
    __device__ __forceinline__ void operator()(const f32x4 (&acc)[2][2][4][2], const Unit& u, int wr, int wc, int fr, int fq) const {
        asm volatile("" : "+v"(fr), "+v"(fq));
        const int g = u.pn / 12, rem = u.pn - g * 12, which = rem >> 2, h0 = (rem & 3) * 4, sh = 2 * g;
        const float sc = (which == 0 ? QSCALE : 1.f) * mul;
#pragma unroll
        for (int ai = 0; ai < 2; ++ai)
#pragma unroll
            for (int m = 0; m < 4; ++m) {
                const int tok = u.pm * BM + ai * HALF + wr * 64 + m * 16 + fr, b = tok >> 12, s = tok & 4095;
                const int subrow = (s & ((1 << sh) - 1)) * (4096 >> sh) + (s >> sh);
                const int head = h0 + wc, dcol = 16 * fq;
                const size_t plane = (size_t)(((b * 3 + g) * 3 + which) * 16 + head);
#pragma unroll
                for (int bj = 0; bj < 2; ++bj) {
                    const f32x4 v0 = acc[ai][bj][m][0] * sc, v1 = acc[ai][bj][m][1] * sc;
                    u32x4 w; w.x = cvt_pk_bf16(v0[0], v0[1]); w.y = cvt_pk_bf16(v0[2], v0[3]); w.z = cvt_pk_bf16(v1[0], v1[1]); w.w = cvt_pk_bf16(v1[2], v1[3]);
                    if (wide == 4) { const size_t off_ = ((size_t)(u.pm * 36 + u.pn) * 131072 + (size_t)(wr * 4 + wc) * 16384 + (size_t)((ai * 4 + m) * 2 + bj) * 1024 + fr * 64 + fq * 16) & (size_t)0x7fffff;
                        *(u32x4*)((unsigned char*)O + off_) = w; }
                    else if (wide != 3 || m == 0) *(u32x4*)(O + (((plane * 4096 + subrow) * 64 + dcol + 8 * bj) & (size_t)(wide == 2 ? 0x3fffff : 0x7fffffffff)) ) = w; else if (w.x == 0x12345678u) O[0] = 1;
                }
            }
    }
};
struct EpiKVQ {
    static constexpr bool PERM = true, AFTER_DRAIN = false; static constexpr int NSTORE = 16;
    bf16_t* O; float mul; unsigned* nrm;
    __device__ __forceinline__ void operator()(const f32x4 (&acc)[2][2][4][2], const Unit& u, int wr, int wc, int fr, int fq) const {
        asm volatile("" : "+v"(fr), "+v"(fq));
        const int which = u.pn < 4 ? 1 : (u.pn < 8 ? 2 : 0), h0 = (u.pn & 3) * 4, pm = u.pm & 127;
        const float sc = (which == 0 ? QSCALE : 1.f) * mul;
        float nmax[2] = {0.f, 0.f};
#pragma unroll
        for (int ai = 0; ai < 2; ++ai)
#pragma unroll
            for (int m = 0; m < 4; ++m) {
                const int tok = pm * BM + ai * HALF + wr * 64 + m * 16 + fr, b = tok >> 12, s = tok & 4095;
#pragma unroll
                for (int bj = 0; bj < 2; ++bj) {
                    const int head = h0 + 2 * bj + (wc >> 1), dcol = (wc & 1) * 32 + 8 * fq;
                    const size_t plane = (size_t)((b * 3 + which) * 16 + head);
                    const f32x4 v0 = acc[ai][bj][m][0] * sc, v1 = acc[ai][bj][m][1] * sc;
                    u32x4 w; w.x = cvt_pk_bf16(v0[0], v0[1]); w.y = cvt_pk_bf16(v0[2], v0[3]); w.z = cvt_pk_bf16(v1[0], v1[1]); w.w = cvt_pk_bf16(v1[2], v1[3]);
                    *(u32x4*)(O + (plane * 4096 + s) * 64 + dcol) = w;
                    if (which != 2) {
                        float ss = 0.f;
#pragma unroll
                        for (int k4 = 0; k4 < 4; ++k4) { const unsigned pw_ = k4 == 0 ? w.x : (k4 == 1 ? w.y : (k4 == 2 ? w.z : w.w)); const float lo_ = __uint_as_float(pw_ << 16), hi_ = __uint_as_float(pw_ & 0xffff0000u); ss += lo_ * lo_ + hi_ * hi_; }
                        ss += __shfl_xor(ss, 16); ss += __shfl_xor(ss, 32);
                        nmax[bj] = fmaxf(nmax[bj], ss);
                    }
                }
            }
        if (which != 2) {
#pragma unroll
            for (int bj = 0; bj < 2; ++bj) { float v = nmax[bj];
                v = fmaxf(v, __shfl_xor(v, 1)); v = fmaxf(v, __shfl_xor(v, 2)); v = fmaxf(v, __shfl_xor(v, 4)); v = fmaxf(v, __shfl_xor(v, 8));
                if (fr == 0 && fq == 0) { const int b0 = (pm * BM) >> 12, head = h0 + 2 * bj + (wc >> 1);
                    atomicMax(nrm + (((b0 * 2 + which) * 16 + head) * 2 + (wc & 1)), __float_as_uint(v)); } }
        }
    }
};
template <bool SRC_BF16> struct EpiResid {
    static constexpr bool PERM = true, AFTER_DRAIN = false; static constexpr int NSTORE = 16;
    const void* src; bf16_t* dst; const float* gate; float mul;
    __device__ __forceinline__ void operator()(const f32x4 (&acc)[2][2][4][2], const Unit& u, int wr, int wc, int fr, int fq) const {
        asm volatile("" : "+v"(fr), "+v"(fq));
#pragma unroll
        for (int ai = 0; ai < 2; ++ai)
#pragma unroll
            for (int m = 0; m < 4; ++m) {
                const int row = u.pm * BM + ai * HALF + wr * 64 + m * 16 + fr, b = row >> 12;
#pragma unroll
                for (int bj = 0; bj < 2; ++bj) {
                    const int col = u.pn * BM + bj * HALF + wc * 32 + 8 * fq;
                    f32x4 x0, x1;
                    if (SRC_BF16) { const u32x4 r = *(const u32x4*)((const bf16_t*)src + (size_t)row * D + col);
                        x0 = (f32x4){__uint_as_float(r.x << 16), __uint_as_float(r.x & 0xffff0000u), __uint_as_float(r.y << 16), __uint_as_float(r.y & 0xffff0000u)};
                        x1 = (f32x4){__uint_as_float(r.z << 16), __uint_as_float(r.z & 0xffff0000u), __uint_as_float(r.w << 16), __uint_as_float(r.w & 0xffff0000u)}; }
                    else if (NT_ROWS) { x0 = __builtin_nontemporal_load((const f32x4*)((const float*)src + (size_t)row * D + col)); x1 = __builtin_nontemporal_load((const f32x4*)((const float*)src + (size_t)row * D + col + 4)); }
                    else { x0 = *(const f32x4*)((const float*)src + (size_t)row * D + col); x1 = *(const f32x4*)((const float*)src + (size_t)row * D + col + 4); }
                    const f32x4 g0 = *(const f32x4*)(gate + b * 6144 + col), g1 = *(const f32x4*)(gate + b * 6144 + col + 4);
                    const f32x4 v0 = x0 + (g0 * mul) * acc[ai][bj][m][0], v1 = x1 + (g1 * mul) * acc[ai][bj][m][1];
                    u32x4 w; w.x = cvt_pk_bf16(v0[0], v0[1]); w.y = cvt_pk_bf16(v0[2], v0[3]); w.z = cvt_pk_bf16(v1[0], v1[1]); w.w = cvt_pk_bf16(v1[2], v1[3]);
                    *(u32x4*)(dst + (size_t)row * D + col) = w;
                }
            }
    }
};
struct EpiSwiGLU {
    static constexpr bool PERM = true, AFTER_DRAIN = false; static constexpr int NSTORE = 0;
    bf16_t* ACT; const float* bgu;
    __device__ __forceinline__ void operator()(const f32x4 (&acc)[2][2][4][2], const Unit& u, int wr, int wc, int fr, int fq) const {
        const int e = u.pn >> 3, pnl = u.pn & 7, j0 = pnl * 128 + wc * 32 + 8 * fq;
        f32x4 bg[2], bu[2];
#pragma unroll
        for (int n = 0; n < 2; ++n) { bg[n] = *(const f32x4*)(bgu + e * 2048 + j0 + 4 * n); bu[n] = *(const f32x4*)(bgu + e * 2048 + 1024 + j0 + 4 * n); }
#pragma unroll
        for (int ai = 0; ai < 2; ++ai)
#pragma unroll
            for (int m = 0; m < 4; ++m) {
                const int row = u.pm * BM + ai * HALF + wr * 64 + m * 16 + fr;
                float a[8];
#pragma unroll
                for (int n = 0; n < 2; ++n) {
                    const f32x4 gv = acc[ai][0][m][n] + bg[n], uv = acc[ai][1][m][n] + bu[n];
#pragma unroll
                    for (int i = 0; i < 4; ++i) {
                        const float gg = fminf(gv[i], 7.f), uu = fminf(fmaxf(uv[i], -7.f), 7.f);
                        const float sg = __builtin_amdgcn_rcpf(1.f + __builtin_amdgcn_exp2f(-1.702f * LOG2E * gg));
                        a[4 * n + i] = (uu + 1.f) * gg * sg;
                    }
                }
                u32x4 w; w.x = cvt_pk_bf16(a[0], a[1]); w.y = cvt_pk_bf16(a[2], a[3]); w.z = cvt_pk_bf16(a[4], a[5]); w.w = cvt_pk_bf16(a[6], a[7]);
                *(u32x4*)(ACT + (size_t)row * D + j0) = w;
            }
    }
};
struct EpiDown {
    static constexpr bool PERM = true, AFTER_DRAIN = false; static constexpr int NSTORE = 0;
    bf16_t* Y; const float* bdn;
    __device__ __forceinline__ void operator()(const f32x4 (&acc)[2][2][4][2], const Unit& u, int wr, int wc, int fr, int fq) const {
        const int e = u.pn >> 2, pnl = u.pn & 3;
#pragma unroll
        for (int ai = 0; ai < 2; ++ai)
#pragma unroll
            for (int m = 0; m < 4; ++m) {
                const int row = u.pm * BM + ai * HALF + wr * 64 + m * 16 + fr;
#pragma unroll
                for (int bj = 0; bj < 2; ++bj) {
                    const int col = pnl * BM + bj * HALF + wc * 32 + 8 * fq;
                    const f32x4 b0 = *(const f32x4*)(bdn + e * 1024 + col), b1 = *(const f32x4*)(bdn + e * 1024 + col + 4);
                    const f32x4 v0 = acc[ai][bj][m][0] + b0, v1 = acc[ai][bj][m][1] + b1;
                    u32x4 w; w.x = cvt_pk_bf16(v0[0], v0[1]); w.y = cvt_pk_bf16(v0[2], v0[3]); w.z = cvt_pk_bf16(v1[0], v1[1]); w.w = cvt_pk_bf16(v1[2], v1[3]);
                    *(u32x4*)(Y + (size_t)row * D + col) = w;
                }
            }
    }
};
__device__ __forceinline__ unsigned pk4_fp8(float a, float b, float c, float d) { int v = __builtin_amdgcn_cvt_pk_fp8_f32(a, b, 0, false); v = __builtin_amdgcn_cvt_pk_fp8_f32(c, d, v, true); return (unsigned)v; }
struct EpiQKV08 {
    static constexpr bool PERM = true, AFTER_DRAIN = false; static constexpr int NSTORE = 16;
    unsigned char* O; float mul;
    __device__ __forceinline__ void operator()(const f32x4 (&acc)[2][2][4][2], const Unit& u, int wr, int wc, int fr, int fq) const {
        asm volatile("" : "+v"(fr), "+v"(fq));
        const int g = u.pn / 12, rem = u.pn - g * 12, which = rem >> 2, h0 = (rem & 3) * 4, sh = 2 * g;
        const float sc = (which == 0 ? QSCALE : 1.f) * mul;
#pragma unroll
        for (int ai = 0; ai < 2; ++ai)
#pragma unroll
            for (int m = 0; m < 4; ++m) {
                const int tok = u.pm * BM + ai * HALF + wr * 64 + m * 16 + fr, b = tok >> 12, s = tok & 4095;
                const int subrow = (s & ((1 << sh) - 1)) * (4096 >> sh) + (s >> sh);
#pragma unroll
                for (int bj = 0; bj < 2; ++bj) {
                    const int head = h0 + 2 * bj + (wc >> 1), dcol = (wc & 1) * 32 + 8 * fq;
                    const size_t plane = (size_t)(((b * 3 + g) * 3 + which) * 16 + head);
                    const f32x4 v0 = acc[ai][bj][m][0] * sc, v1 = acc[ai][bj][m][1] * sc;
                    typedef unsigned u32x2e __attribute__((ext_vector_type(2)));
                    u32x2e w8; w8.x = pk4_fp8(v0[0], v0[1], v0[2], v0[3]); w8.y = pk4_fp8(v1[0], v1[1], v1[2], v1[3]);
                    *(u32x2e*)(O + (plane * 4096 + subrow) * 64 + dcol) = w8;
                }
            }
    }
};
struct EpiQKV08W {
    static constexpr bool PERM = true, AFTER_DRAIN = false; static constexpr int NSTORE = 8;
    unsigned char* O; float mul;
    __device__ __forceinline__ void operator()(const f32x4 (&acc)[2][2][4][2], const Unit& u, int wr, int wc, int fr, int fq) const {
        asm volatile("" : "+v"(fr), "+v"(fq));
        const int g = u.pn / 12, rem = u.pn - g * 12, which = rem >> 2, head = (rem & 3) * 4 + wc, sh = 2 * g;
        const float sc = (which == 0 ? QSCALE : 1.f) * mul;
#pragma unroll
        for (int ai = 0; ai < 2; ++ai)
#pragma unroll
            for (int m = 0; m < 4; ++m) {
                const int tok = u.pm * BM + ai * HALF + wr * 64 + m * 16 + fr, b = tok >> 12, s = tok & 4095;
                const int subrow = (s & ((1 << sh) - 1)) * (4096 >> sh) + (s >> sh);
                const size_t plane = (size_t)(((b * 3 + g) * 3 + which) * 16 + head);
                u32x4 w;
                { const f32x4 v0 = acc[ai][0][m][0] * sc, v1 = acc[ai][0][m][1] * sc; w.x = pk4_fp8(v0[0], v0[1], v0[2], v0[3]); w.y = pk4_fp8(v1[0], v1[1], v1[2], v1[3]); }
                { const f32x4 v0 = acc[ai][1][m][0] * sc, v1 = acc[ai][1][m][1] * sc; w.z = pk4_fp8(v0[0], v0[1], v0[2], v0[3]); w.w = pk4_fp8(v1[0], v1[1], v1[2], v1[3]); }
                *(u32x4*)(O + (plane * 4096 + subrow) * 64 + 16 * fq) = w;
            }
    }
};
struct EpiSwiGLU8 {
    static constexpr bool PERM = true, AFTER_DRAIN = false; static constexpr int NSTORE = 8;
    unsigned char* ACT; const float* bgu;
    __device__ __forceinline__ void operator()(const f32x4 (&acc)[2][2][4][2], const Unit& u, int wr, int wc, int fr, int fq) const {
        _Pragma("unroll") for (int rep_e = 0; rep_e < 1 + ((PROBE_EPI >> 1) & 1); ++rep_e) {
        asm volatile("" : "+v"(fr), "+v"(fq));
        const int e = u.pn >> 3, pnl = u.pn & 7, j0 = pnl * 128 + wc * 32 + 8 * fq;
        f32x4 bg[2], bu[2];
#pragma unroll
        for (int n = 0; n < 2; ++n) { bg[n] = *(const f32x4*)(bgu + e * 2048 + j0 + 4 * n) * 64.f; bu[n] = *(const f32x4*)(bgu + e * 2048 + 1024 + j0 + 4 * n) * 64.f + 64.f; }
#pragma unroll
        for (int ai = 0; ai < 2; ++ai)
#pragma unroll
            for (int m = 0; m < 4; ++m) {
                const int row = u.pm * BM + ai * HALF + wr * 64 + m * 16 + fr;
                float a[8];
#pragma unroll
                for (int n = 0; n < 2; ++n) {
                    const f32x4 gv = acc[ai][0][m][n] + bg[n], uv = acc[ai][1][m][n] + bu[n];
#pragma unroll
                    for (int i = 0; i < 4; ++i) {
                        const float gg = fminf(gv[i], 448.f), uu = fminf(fmaxf(uv[i], -384.f), 512.f);
                        const float t = __builtin_amdgcn_exp2f((-1.702f * LOG2E * 0.015625f) * gg);
                        const float sg = __builtin_amdgcn_rcpf(__builtin_fmaf(t, 4096.f, 4096.f));
                        a[4 * n + i] = (uu * gg) * sg;
                    }
                }
                typedef unsigned u32x2e __attribute__((ext_vector_type(2)));
                u32x2e w; w.x = pk4_fp8(a[0], a[1], a[2], a[3]); w.y = pk4_fp8(a[4], a[5], a[6], a[7]);
                *(u32x2e*)(ACT + (size_t)row * D + j0) = w;
            }
        }
    }
};
template <int VAR> struct EpiProbeGU {
    static constexpr bool PERM = true, AFTER_DRAIN = false; static constexpr int NSTORE = 0;
    unsigned char* ACT; const float* bgu;
    __device__ __forceinline__ void operator()(const f32x4 (&acc)[2][2][4][2], const Unit& u, int wr, int wc, int fr, int fq) const {
        if (VAR == 2) { if (acc[0][0][0][0][0] == 12345.678f) ACT[0] = 1; return; }
        asm volatile("" : "+v"(fr), "+v"(fq));
        const int pnl = u.pn & 7, j0 = pnl * 128 + wc * 32 + 8 * fq;
#pragma unroll
        for (int ai = 0; ai < 2; ++ai)
#pragma unroll
            for (int m = 0; m < 4; ++m) {
                const int row = u.pm * BM + ai * HALF + wr * 64 + m * 16 + fr;
                const f32x4 g0 = acc[ai][0][m][0] + acc[ai][1][m][0], g1 = acc[ai][0][m][1] + acc[ai][1][m][1];
                typedef unsigned u32x2e __attribute__((ext_vector_type(2)));
                u32x2e w; w.x = pk4_fp8(g0[0], g0[1], g0[2], g0[3]); w.y = pk4_fp8(g1[0], g1[1], g1[2], g1[3]);
                *(u32x2e*)(ACT + (size_t)row * D + j0) = w;
            }
    }
};
struct EpiNone { static constexpr bool PERM = true, AFTER_DRAIN = false; static constexpr int NSTORE = 0; unsigned char* P;
    __device__ __forceinline__ void operator()(const f32x4 (&acc)[2][2][4][2], const Unit& u, int wr, int wc, int fr, int fq) const { if (acc[0][0][0][0][0] == 12345.678f) P[0] = 1; } };
struct EpiDown8 {
    static constexpr bool PERM = true, AFTER_DRAIN = false; static constexpr int NSTORE = 16;
    bf16_t* Y; const float* bdn;
    __device__ __forceinline__ void operator()(const f32x4 (&acc)[2][2][4][2], const Unit& u, int wr, int wc, int fr, int fq) const {
        _Pragma("unroll") for (int rep_e = 0; rep_e < 1 + ((PROBE_EPI >> 2) & 1); ++rep_e) {
        asm volatile("" : "+v"(fr), "+v"(fq));
        const int e = u.pn >> 2, pnl = u.pn & 3;
#pragma unroll
        for (int ai = 0; ai < 2; ++ai)
#pragma unroll
            for (int m = 0; m < 4; ++m) {
                const int row = u.pm * BM + ai * HALF + wr * 64 + m * 16 + fr;
#pragma unroll
                for (int bj = 0; bj < 2; ++bj) {
                    const int col = pnl * BM + bj * HALF + wc * 32 + 8 * fq;
                    const f32x4 b0 = *(const f32x4*)(bdn + e * 1024 + col), b1 = *(const f32x4*)(bdn + e * 1024 + col + 4);
                    const f32x4 v0 = acc[ai][bj][m][0] * 0.015625f + b0, v1 = acc[ai][bj][m][1] * 0.015625f + b1;
                    if (Y_FP8) { typedef unsigned u32x2e __attribute__((ext_vector_type(2))); u32x2e w8; w8.x = pk4_fp8(v0[0], v0[1], v0[2], v0[3]); w8.y = pk4_fp8(v1[0], v1[1], v1[2], v1[3]);
                        *(u32x2e*)((unsigned char*)Y + (size_t)row * D + col) = w8; }
                    else { u32x4 w; w.x = cvt_pk_bf16(v0[0], v0[1]); w.y = cvt_pk_bf16(v0[2], v0[3]); w.z = cvt_pk_bf16(v1[0], v1[1]); w.w = cvt_pk_bf16(v1[2], v1[3]);
                        *(u32x4*)(Y + (size_t)row * D + col) = w; }
                }
            }
        }
    }
};
struct KVQOrder : StaticOrder {
    __device__ bool next(int i, Unit& u) const { if (!StaticOrder::next(i, u)) return false; if (u.pn >= 8) u.pm += 128; return true; }
};
template <int NN> struct MoeOrder {
    static constexpr int TR = 32 / NN;
    const LAS int* tile_exp; int n_tiles, c, G;
    __device__ __forceinline__ bool next(int i, Unit& u) const {
        int st, j;
        if (G == 256) { st = i * 8 + (c & 7); j = c >> 3; } else { const int L = i * G + c; st = L >> 5; j = L & 31; }
        const int tile = st * TR + (j % TR);
        if (tile >= n_tiles) return false;
        u.pm = tile; u.pn = tile_exp[tile] * NN + j / TR; return true;
    }
    __device__ __forceinline__ void a_ready(const Unit&) const {}
    __device__ __forceinline__ void done(const Unit&) const {}
};
struct MoeOrderProbe { const LAS int* tile_exp; int n_tiles, c, G;
    __device__ __forceinline__ bool next(int i, Unit& u) const { int st, j; if (G == 256) { st = i * 8 + (c & 7); j = c >> 3; } else { const int L = i * G + c; st = L >> 5; j = L & 31; }
        const int tile = st * 4 + (j % 4); if (tile >= n_tiles) return false; u.pm = tile; u.pn = j / 4; return true; }
    __device__ __forceinline__ void a_ready(const Unit&) const {}
    __device__ __forceinline__ void done(const Unit&) const {} };
}

namespace attn_body {
constexpr int KSLOT = 8192;
constexpr int L_K = 0, L_V = 2 * KSLOT, L_WS = 4 * KSLOT, L_OST = L_WS + 8 * 256, L_TAB = L_OST + 8 * 4096, L_ATT_END = L_TAB + 1024;
__device__ __forceinline__ void qkt2(f32x16& p0, f32x16& p1, const char* Kslot, const bf16x8* qr, const f32x16& c0, const f32x16& c1, int r32, int hi) {
  const char* kb = Kslot + hi * 1024 + r32 * 16;
  #pragma unroll
  for (int d0 = 0; d0 < 4; ++d0) {
    const bf16x8 b0 = *reinterpret_cast<const bf16x8*>(kb + d0 * 2048);
    const bf16x8 b1 = *reinterpret_cast<const bf16x8*>(kb + d0 * 2048 + 512);
    if (d0 == 0) { p0 = __builtin_amdgcn_mfma_f32_32x32x16_bf16(b0, qr[0], c0, 0, 0, 0); p1 = __builtin_amdgcn_mfma_f32_32x32x16_bf16(b1, qr[0], c1, 0, 0, 0); }
    else { p0 = __builtin_amdgcn_mfma_f32_32x32x16_bf16(b0, qr[d0], p0, 0, 0, 0); p1 = __builtin_amdgcn_mfma_f32_32x32x16_bf16(b1, qr[d0], p1, 0, 0, 0); } }
}
template <int MODE> __device__ __forceinline__ void attn_unit(const bf16* Qp, const bf16* __restrict__ Kp, const bf16* __restrict__ Vp, int q0, bf16* Ob, long ostride,
                                                               float* lse, long lstride, const float* __restrict__ F2, const float* __restrict__ tabg, char* shm) {
  const int tid = threadIdx.x, lane = tid & 63, r32 = lane & 31, hi = lane >> 5; const int wid = __builtin_amdgcn_readfirstlane(tid >> 6);
  const unsigned lds0 = (unsigned)(uintptr_t)shm;
  float* wsf = (float*)(shm + L_WS) + wid * 64;
  const int tq = q0 >> 6, t_hi = tq + 4;
  const int t_lo = (MODE == 0) ? (tq >= 2 ? tq - 2 : 0) : 0;
  const int w_hi = tq + (wid >> 1);
  const int w_lo = (MODE == 0) ? (w_hi >= 2 ? w_hi - 2 : 0) : 0;
  const bf16* ksrc = Kp + (long)lane * 64 + wid * 8;
  const bf16* vsrc = Vp + (long)(16 * (wid & 3) + (lane >> 2)) * 64 + (wid >> 2) * 32 + (lane & 3) * 8;
  const unsigned kdst = lds0 + L_K + wid * 1024, vdst = lds0 + L_V + wid * 1024;
  #define DMA_KV(t, slot) do { glds16(ksrc + (long)(t) * 4096, (unsigned)__builtin_amdgcn_readfirstlane(kdst + (slot) * KSLOT)); glds16(vsrc + (long)(t) * 4096, (unsigned)__builtin_amdgcn_readfirstlane(vdst + (slot) * KSLOT)); } while (0)
  if (MODE == 0) { float* tab = (float*)(shm + L_TAB); if (tid < 129) tab[tid] = tabg[tid]; }
  const int qi = q0 + wid * 32 + r32;
  f32x4 fk[8];
  #pragma unroll
  for (int g4 = 0; g4 < 8; ++g4) fk[g4] = (f32x4){0.f, 0.f, 0.f, 0.f};
  float Fq = 0.f;
  if (MODE == 1) { Fq = F2[qi];
    #pragma unroll
    for (int g4 = 0; g4 < 4; ++g4) { fk[g4] = *(const f32x4*)(F2 + 64 * t_lo + 4 * hi + 8 * g4); fk[4 + g4] = *(const f32x4*)(F2 + 64 * t_lo + 32 + 4 * hi + 8 * g4); } }
  bf16x8 qr[4];
  { const bf16* Qw = Qp + (long)(q0 + wid * 32) * 64;
    #pragma unroll
    for (int d0 = 0; d0 < 4; ++d0) qr[d0] = *reinterpret_cast<const bf16x8*>(&Qw[(long)r32 * 64 + d0 * 16 + hi * 8]); }
  DMA_KV(t_lo, 0);
  float m_run = -INFINITY, l_run = 0.f; f32x16 o[2]; o[0] = f32x16{}; o[1] = f32x16{};
  const int vb0 = (int)(lds0 + L_V) + ((lane >> 4) & 1) * 32 + (lane & 3) * 8 + (4 * hi + ((lane & 15) >> 2)) * 64;
  for (int t = t_lo; t < t_hi; ++t) {
    const int s = (t - t_lo) & 1;
    asm volatile("s_waitcnt vmcnt(0) lgkmcnt(0)\n\ts_barrier" ::: "memory");
    f32x4 fn[8];
    #pragma unroll
    for (int g4 = 0; g4 < 8; ++g4) fn[g4] = fk[g4];
    if (t + 1 < t_hi) {
      if (MODE == 1) {
        #pragma unroll
        for (int g4 = 0; g4 < 4; ++g4) { fn[g4] = *(const f32x4*)(F2 + 64 * (t + 1) + 4 * hi + 8 * g4); fn[4 + g4] = *(const f32x4*)(F2 + 64 * (t + 1) + 32 + 4 * hi + 8 * g4); } }
      DMA_KV(t + 1, s ^ 1);
    }
    if (t >= w_lo && t <= w_hi) {
      f32x16 c0, c1, p0, p1;
      if (MODE == 1) {
        #pragma unroll
        for (int r = 0; r < 16; ++r) { c0[r] = Fq - fk[r >> 2][r & 3]; c1[r] = Fq - fk[4 + (r >> 2)][r & 3]; }
      } else {
        const float* tab = (const float*)(shm + L_TAB);
        #pragma unroll
        for (int r = 0; r < 16; ++r) { const int d0_ = qi - (64 * t + crow(r, hi)), d1_ = d0_ - 32;
          c0[r] = tab[d0_ < 0 ? 0 : (d0_ > 128 ? 128 : d0_)]; c1[r] = tab[d1_ < 0 ? 0 : (d1_ > 128 ? 128 : d1_)]; }
      }
      qkt2(p0, p1, shm + L_K + s * KSLOT, qr, c0, c1, r32, hi);
      if (MODE == 1) {
        if (t == w_hi) {
          #pragma unroll
          for (int r = 0; r < 16; ++r) { const int kv = 64 * t + crow(r, hi); if (kv > qi) p0[r] = -INFINITY; if (kv + 32 > qi) p1[r] = -INFINITY; } }
      } else {
        #pragma unroll
        for (int r = 0; r < 16; ++r) { const int d0_ = qi - (64 * t + crow(r, hi)), d1_ = d0_ - 32;
          if ((unsigned)d0_ > 128u) p0[r] = -INFINITY; if ((unsigned)d1_ > 128u) p1[r] = -INFINITY; }
      }
      const float rm = rowmax(p0, p1), mnew = fmaxf(m_run, rm), msub = (mnew == -INFINITY) ? 0.f : mnew;
      const float f = __builtin_amdgcn_exp2f(m_run - msub);
      m_run = mnew;
      float sacc = 0.f;
      #pragma unroll
      for (int r = 0; r < 16; ++r) { p0[r] = __builtin_amdgcn_exp2f(p0[r] - msub); p1[r] = __builtin_amdgcn_exp2f(p1[r] - msub); sacc += p0[r] + p1[r]; }
      l_run = l_run * f + sacc;
      if (__any(f != 1.f)) {
        if (hi == 0) wsf[r32] = f;
        asm volatile("s_waitcnt lgkmcnt(0)" ::: "memory");
        #pragma unroll
        for (int r = 0; r < 16; ++r) { const float ff = wsf[crow(r, hi)]; o[0][r] *= ff; o[1][r] *= ff; }
      }
      u32x4 pw0, pw1, pw2, pw3;
      pw0 = (u32x4){cvtpk_s(p0[0], p0[1]), cvtpk_s(p0[2], p0[3]), cvtpk_s(p0[4], p0[5]), cvtpk_s(p0[6], p0[7])};
      pw1 = (u32x4){cvtpk_s(p0[8], p0[9]), cvtpk_s(p0[10], p0[11]), cvtpk_s(p0[12], p0[13]), cvtpk_s(p0[14], p0[15])};
      pw2 = (u32x4){cvtpk_s(p1[0], p1[1]), cvtpk_s(p1[2], p1[3]), cvtpk_s(p1[4], p1[5]), cvtpk_s(p1[6], p1[7])};
      pw3 = (u32x4){cvtpk_s(p1[8], p1[9]), cvtpk_s(p1[10], p1[11]), cvtpk_s(p1[12], p1[13]), cvtpk_s(p1[14], p1[15])};
      SBAR();
      pv(o, vb0 + s * KSLOT, __builtin_bit_cast(bf16x8, pw0), __builtin_bit_cast(bf16x8, pw1), __builtin_bit_cast(bf16x8, pw2), __builtin_bit_cast(bf16x8, pw3));
    }
    #pragma unroll
    for (int g4 = 0; g4 < 8; ++g4) fk[g4] = fn[g4];
  }
  { auto rr = __builtin_amdgcn_permlane32_swap(__float_as_uint(l_run), __float_as_uint(l_run), false, false); l_run = __uint_as_float(rr[0]) + __uint_as_float(rr[1]); }
  if (hi == 0) { wsf[32 + r32] = l_run; if (MODE == 0) lse[(long)qi * lstride] = m_run + __builtin_amdgcn_logf(l_run); }
  asm volatile("s_waitcnt lgkmcnt(0)" ::: "memory");
  float rli[16];
  #pragma unroll
  for (int r = 0; r < 16; ++r) rli[r] = __builtin_amdgcn_rcpf(wsf[32 + crow(r, hi)]);
  { bf16* stg = (bf16*)(shm + L_OST) + wid * 2048;
    #pragma unroll
    for (int r = 0; r < 16; ++r) { const int orow = crow(r, hi);
      #pragma unroll
      for (int d0 = 0; d0 < 2; ++d0) stg[orow * 64 + d0 * 32 + r32] = __float2bfloat16(o[d0][r] * rli[r]); }
    asm volatile("s_waitcnt lgkmcnt(0)" ::: "memory");
    bf16* Ow = Ob + (long)(q0 + wid * 32) * ostride;
    #pragma unroll
    for (int i = 0; i < 4; ++i) { const int row = i * 8 + (lane >> 3), ch = lane & 7; const u32x4 v = *(const u32x4*)(stg + row * 64 + ch * 8); *(u32x4*)(Ow + (long)row * ostride + ch * 8) = v; } }
  asm volatile("s_waitcnt lgkmcnt(0)\n\ts_barrier" ::: "memory");
  #undef DMA_KV
}
#undef SBAR
#undef WAIT_BAR
}

namespace attn_body {
constexpr int NSLOT = 3, SLOTB = 8192;
constexpr int T_K = 0, T_V = NSLOT * SLOTB, T_WS = 2 * NSLOT * SLOTB, T_OST = T_WS + 8 * 256, T_END = T_OST + 8 * 4096;
constexpr int T_F = 90112;
__device__ __forceinline__ void glds16s(unsigned voff,const void*sbase,unsigned lds_dst){unsigned keep;
  asm volatile("s_mov_b32 %0, m0\n\ts_mov_b32 m0, %3\n\ts_nop 0\n\tglobal_load_lds_dwordx4 %1, %2\n\ts_mov_b32 m0, %0":"=&s"(keep):"v"(voff),"s"(sbase),"s"(lds_dst):"memory");}
#define SBAR() __builtin_amdgcn_sched_barrier(0)
#define WAIT_BAR(N) asm volatile("s_waitcnt vmcnt(" #N ") lgkmcnt(0)\n\ts_barrier":::"memory")
template<int MODE, int THRL> __device__ __forceinline__ void attn_unit_t(const bf16* Qw0, const bf16* __restrict__ Kb, const bf16* __restrict__ Vb, const int NT, const int qoff,
                                                                         bf16* Ob, long ostride, float* lse, long lstride, char* shm) {
  const int tid=threadIdx.x,lane=tid&63,r32=lane&31,hi=lane>>5; const int wid=__builtin_amdgcn_readfirstlane(tid>>6);
  const unsigned lds0=(unsigned)(uintptr_t)shm;
  float*wsf=(float*)(shm+T_WS)+wid*64;
  typedef __attribute__((address_space(3))) const float* lds_f;
  const lds_f Fl=(lds_f)(shm+T_F)+((MODE==1)?qoff:0);
  const unsigned koff_=(unsigned)(lane*128+wid*16), voff_=(unsigned)((16*(wid&3)+(lane>>2))*128+(wid>>2)*64+(lane&3)*16);
  #define KOFF() koff_
  #define VOFF() voff_
  const unsigned kdst=lds0+T_K+wid*1024, vdst=lds0+T_V+wid*1024;
  #define DMA_K(t,slot) glds16s(KOFF(),(const char*)Kb+(long)(t)*8192,(unsigned)__builtin_amdgcn_readfirstlane(kdst+(slot)))
  #define DMA_V(t,slot) glds16s(VOFF(),(const char*)Vb+(long)(t)*8192,(unsigned)__builtin_amdgcn_readfirstlane(vdst+(slot)))
  const char*Kbase=shm+T_K; bf16x8 kf[8];
  const lds_cptr shm3=(lds_cptr)shm; const lds_cptr kp0=shm3+T_K+hi*1024+r32*16; const lds_cptr vp0=shm3+T_V+((lane>>4)&1)*32+(lane&3)*8+(4*hi+((lane&15)>>2))*64;
  DMA_K(0,0);DMA_V(0,0);DMA_K(1,SLOTB);
  bf16x8 qr[4];
  { const bf16*Qw=Qw0+(long)(wid*32)*64;
    #pragma unroll
    for(int d0=0;d0<4;++d0)qr[d0]=*reinterpret_cast<const bf16x8*>(&Qw[(long)r32*64+d0*16+hi*8]); }
  float mhat=0.f,l_reg=0.f;f32x16 o[2];o[0]=f32x16{};o[1]=f32x16{};
  const int qrel=wid*32+r32;
  const int qpos=(MODE>=1)?(64*(NT-4)+qrel):(qoff+qrel);
  #define FQ() ((MODE==1)?Fl[64*(NT-4)+wid*32+r32]:0.f)
  const int jb0=384-qpos+4*hi;
  #define CINIT(C0,C1,t,MASKED) do{ \
    if(MODE==2){ _Pragma("unroll") for(int r=0;r<16;++r){ C0[r]=-mhat; C1[r]=-mhat; } \
      if(MASKED){ const int jb_=(t)-(NT-4); if(jb_>=0){ const int kb_=64*jb_+4*hi; \
        _Pragma("unroll") for(int r=0;r<16;++r){ const int kv_=kb_+(r&3)+8*(r>>2); if(kv_>qrel)C0[r]=-INFINITY; if(kv_+32>qrel)C1[r]=-INFINITY; } } } \
    } else if(MODE==1){ const float fqm=FQ()-mhat; const lds_f fp_=Fl+64*(t)+4*hi; \
      _Pragma("unroll") for(int g4=0;g4<4;++g4){ const f32x4 a_=*(const __attribute__((address_space(3))) f32x4*)(fp_+8*g4), b_=*(const __attribute__((address_space(3))) f32x4*)(fp_+32+8*g4); \
        _Pragma("unroll") for(int i_=0;i_<4;++i_){ C0[4*g4+i_]=fqm-a_[i_]; C1[4*g4+i_]=fqm-b_[i_]; } } \
      if(MASKED){ const int jb_=(t)-(NT-4); if(jb_>=0){ const int kb_=64*jb_+4*hi; \
        _Pragma("unroll") for(int r=0;r<16;++r){ const int kv_=kb_+(r&3)+8*(r>>2); if(kv_>qrel)C0[r]=-INFINITY; if(kv_+32>qrel)C1[r]=-INFINITY; } } } \
    } else { const lds_f tp_=Fl+jb0+64*(t); \
      _Pragma("unroll") for(int r=0;r<16;++r){ C0[r]=tp_[(r&3)+8*(r>>2)]-mhat; C1[r]=tp_[32+(r&3)+8*(r>>2)]-mhat; } } \
  }while(0)
  bool resc=false;
  #define START(P0,P1) do{ const float rm=rowmax(P0,P1); resc=false; \
    { const float dl=(rm==-INFINITY)?0.f:rm; mhat=fadd_s(mhat,dl); \
      _Pragma("unroll") for(int r=0;r<16;++r){P0[r]=fsub_s(P0[r],dl);P1[r]=fsub_s(P1[r],dl);} } \
    _Pragma("unroll") for(int r=0;r<16;++r)P0[r]=__builtin_amdgcn_exp2f(P0[r]); }while(0)
  #define RESC() do{ if(resc){ asm volatile("s_waitcnt lgkmcnt(0)":::"memory"); \
      _Pragma("unroll") for(int d_=0;d_<2;++d_) _Pragma("unroll") for(int r=0;r<16;++r)o[d_][r]*=wsf[crow(r,hi)]; } }while(0)
  f32x16 pA0,pA1,pB0,pB1;
  int sl_prev=0,sl_cur=0,sl_next=SLOTB;
  #define ROT() do{sl_prev=sl_cur;sl_cur=sl_next;sl_next=(sl_next==(NSLOT-1)*SLOTB)?0:sl_next+SLOTB;}while(0)
  DMA_K(2,2*SLOTB);
  WAIT_BAR(3);
  CINIT(pA0,pA1,0,true);
  qkt2(pA0,pA1,Kbase,qr,pA0,pA1,r32,hi);asm volatile("s_nop 15\n\ts_nop 7":"+v"(pA0),"+v"(pA1));
  START(pA0,pA1);
  _Pragma("unroll") for(int r=0;r<16;++r)pA1[r]=__builtin_amdgcn_exp2f(pA1[r]);
  WAIT_BAR(0);
  DMA_K(3,0);DMA_V(1,SLOTB);
  ROT();
  kload8(kf,kp0+sl_cur);
  WAIT_BAR(2);
  s16x4 vlo[8],vhi[8]; u32x4 pw0,pw1,pw2,pw3;
  #define PKW(P,B) cvtpk_s(P[B],P[B+1])
  #define PAF(k) __builtin_bit_cast(bf16x8,pw##k)
  #define VFR(i) (bf16x8){vlo[i][0],vlo[i][1],vlo[i][2],vlo[i][3],vhi[i][0],vhi[i][1],vhi[i][2],vhi[i][3]}
  #define PIN(x) asm volatile("":"+v"(x))
  #define MX3(a,b,c) __builtin_fmaxf(__builtin_fmaxf((a),(b)),(c))
  #define GAPA(MF,A0,A1,A2,A3,W0,W1,PW) do{ MF; sacc+=A0; sacc+=A1; sacc+=A2; sacc+=A3; PIN(sacc); W0; W1; PIN(PW); SBAR(); }while(0)
  #define EX(v) __builtin_amdgcn_exp2f(v)
  #define GAPB(MF,X,B) do{ MF; X[B]=EX(X[B]); X[B+1]=EX(X[B+1]); X[B+2]=EX(X[B+2]); X[B+3]=EX(X[B+3]); PIN(X); SBAR(); }while(0)
  #define VRD(i) do{ vlo[i]=vtr(vp_+(((i)>>2)*4096+((i)&3)*1024)); vhi[i]=vtr(vp_+(((i)>>2)*4096+((i)&3)*1024+512)); }while(0)
  #define KRD(G,j) do{ if(G){ kload2(kf,kp0+sl_next,j); SBAR(); } }while(0)
  #define STEP(C0,C1,P0,P1,t,GK,GV,GL,MASKED) do{ SBAR(); \
    CINIT(C0,C1,t,MASKED); \
    const lds_cptr vp_=vp0+sl_prev; \
    VRD(0); SBAR(); float sacc=(P0[0]+P0[1]); \
    GAPA(C0=__builtin_amdgcn_mfma_f32_32x32x16_bf16(kf[0],qr[0],C0,0,0,0), P0[2],P0[3],P0[4],P0[5],     pw0[0]=PKW(P0,0), pw0[1]=PKW(P0,2), pw0); \
    VRD(4); SBAR(); GAPA(C1=__builtin_amdgcn_mfma_f32_32x32x16_bf16(kf[1],qr[0],C1,0,0,0), P0[6],P0[7],P0[8],P0[9],     pw0[2]=PKW(P0,4), pw0[3]=PKW(P0,6), pw0); \
    VRD(1); SBAR(); GAPA(C0=__builtin_amdgcn_mfma_f32_32x32x16_bf16(kf[2],qr[1],C0,0,0,0),   P0[10],P0[11],P0[12],P0[13], pw1[0]=PKW(P0,8), pw1[1]=PKW(P0,10), pw1); \
    VRD(5); SBAR(); GAPA(C1=__builtin_amdgcn_mfma_f32_32x32x16_bf16(kf[3],qr[1],C1,0,0,0),   P0[14],P0[15],P1[0],P1[1],   pw1[2]=PKW(P0,12),pw1[3]=PKW(P0,14), pw1); \
    VRD(2); SBAR(); GAPA(C0=__builtin_amdgcn_mfma_f32_32x32x16_bf16(kf[4],qr[2],C0,0,0,0),   P1[2],P1[3],P1[4],P1[5],     pw2[0]=PKW(P1,0), pw2[1]=PKW(P1,2), pw2); \
    VRD(6); SBAR(); GAPA(C1=__builtin_amdgcn_mfma_f32_32x32x16_bf16(kf[5],qr[2],C1,0,0,0),   P1[6],P1[7],P1[8],P1[9],     pw2[2]=PKW(P1,4), pw2[3]=PKW(P1,6), pw2); \
    VRD(3); SBAR(); GAPA(C0=__builtin_amdgcn_mfma_f32_32x32x16_bf16(kf[6],qr[3],C0,0,0,0),   P1[10],P1[11],P1[12],P1[13], pw3[0]=PKW(P1,8), pw3[1]=PKW(P1,10), pw3); \
    VRD(7); SBAR(); GAPA(C1=__builtin_amdgcn_mfma_f32_32x32x16_bf16(kf[7],qr[3],C1,0,0,0),   P1[14],P1[15],0.f,0.f,       pw3[2]=PKW(P1,12),pw3[3]=PKW(P1,14), pw3); \
    l_reg+=sacc; \
    if(GK){DMA_K((t)+3,sl_cur);} if(GV){DMA_V((t)+1,sl_next);} \
    { float a=MX3(C0[0],C0[1],C1[0]),b=MX3(C0[2],C0[3],C1[1]); a=MX3(a,C1[2],C1[3]); \
      _Pragma("unroll") for(int r=4;r<16;r+=4){a=MX3(a,C0[r],C0[r+1]);b=MX3(b,C0[r+2],C0[r+3]);a=MX3(a,C1[r],C1[r+1]);b=MX3(b,C1[r+2],C1[r+3]);} \
      float rm=__builtin_fmaxf(a,b); { auto rr=__builtin_amdgcn_permlane32_swap(__float_as_uint(rm),__float_as_uint(rm),false,false); rm=__builtin_fmaxf(__uint_as_float(rr[0]),__uint_as_float(rr[1])); } \
      resc=false; \
      if(__builtin_expect(__any(rm>(float)THRL),0)){ const float dl=__builtin_fmaxf(rm,0.f); mhat+=dl; \
        _Pragma("unroll") for(int r=0;r<16;++r){C0[r]-=dl;C1[r]-=dl;} \
        const float f=__builtin_amdgcn_exp2f(-dl); l_reg*=f; if(hi==0)wsf[r32]=f; resc=true; } } \
    SBAR(); \
    GAPB(o[0]=__builtin_amdgcn_mfma_f32_32x32x16_bf16(PAF(0),VFR(0),o[0],0,0,0), C0,0); \
    GAPB(o[1]=__builtin_amdgcn_mfma_f32_32x32x16_bf16(PAF(0),VFR(4),o[1],0,0,0), C0,4); \
    KRD(GL,0); GAPB(o[0]=__builtin_amdgcn_mfma_f32_32x32x16_bf16(PAF(1),VFR(1),o[0],0,0,0), C0,8); \
    KRD(GL,1); GAPB(o[1]=__builtin_amdgcn_mfma_f32_32x32x16_bf16(PAF(1),VFR(5),o[1],0,0,0), C0,12); \
    KRD(GL,2); GAPB(o[0]=__builtin_amdgcn_mfma_f32_32x32x16_bf16(PAF(2),VFR(2),o[0],0,0,0), C1,0); \
    KRD(GL,3); GAPB(o[1]=__builtin_amdgcn_mfma_f32_32x32x16_bf16(PAF(2),VFR(6),o[1],0,0,0), C1,4); \
    GAPB(o[0]=__builtin_amdgcn_mfma_f32_32x32x16_bf16(PAF(3),VFR(3),o[0],0,0,0), C1,8); \
    GAPB(o[1]=__builtin_amdgcn_mfma_f32_32x32x16_bf16(PAF(3),VFR(7),o[1],0,0,0), C1,12); \
    }while(0)
  int t=1;
  for(;t+5<NT;t+=2){
    STEP(pB0,pB1,pA0,pA1,t,true,true,true,false);     WAIT_BAR(2); RESC(); ROT();
    STEP(pA0,pA1,pB0,pB1,t+1,true,true,true,false);   WAIT_BAR(2); RESC(); ROT();
  }
  #define ENDW(tt) do{ if((tt)+3<NT){WAIT_BAR(2);} else if((tt)+2<NT){WAIT_BAR(1);} else {WAIT_BAR(0);} }while(0)
  for(;t+1<NT;t+=2){
    STEP(pB0,pB1,pA0,pA1,t,(t+3<NT),(t+1<NT),(t+1<NT),true);       ENDW(t);   RESC(); ROT();
    STEP(pA0,pA1,pB0,pB1,t+1,(t+4<NT),(t+2<NT),(t+2<NT),true);     ENDW(t+1); RESC(); ROT();
  }
  STEP(pB0,pB1,pA0,pA1,NT-1,false,false,false,true); RESC();
  { float sacc=pB0[0]+pB0[1]; _Pragma("unroll") for(int r=2;r<16;++r)sacc+=pB0[r]; _Pragma("unroll") for(int r=0;r<16;++r)sacc+=pB1[r]; l_reg+=sacc;
    pw0=(u32x4){PKW(pB0,0),PKW(pB0,2),PKW(pB0,4),PKW(pB0,6)};pw1=(u32x4){PKW(pB0,8),PKW(pB0,10),PKW(pB0,12),PKW(pB0,14)};pw2=(u32x4){PKW(pB1,0),PKW(pB1,2),PKW(pB1,4),PKW(pB1,6)};pw3=(u32x4){PKW(pB1,8),PKW(pB1,10),PKW(pB1,12),PKW(pB1,14)};
    int ln_=lane; asm volatile("":"+v"(ln_)); const int hi_=ln_>>5; const int vb0=(int)(lds0+T_V)+((ln_>>4)&1)*32+(ln_&3)*8+(4*hi_+((ln_&15)>>2))*64;
    SBAR(); pv(o,vb0+sl_cur,PAF(0),PAF(1),PAF(2),PAF(3)); }
  #undef PKW
  #undef PAF
  #undef VFR
  #undef PIN
  #undef MX3
  #undef GAPA
  #undef GAPB
  #undef EX
  #undef VRD
  #undef KRD
  #undef STEP
  #undef ENDW
  #undef CINIT
  {auto rr=__builtin_amdgcn_permlane32_swap(__float_as_uint(l_reg),__float_as_uint(l_reg),false,false);l_reg=__uint_as_float(rr[0])+__uint_as_float(rr[1]);}
  int r32e=r32,hie=hi; asm volatile("":"+v"(r32e),"+v"(hie));
  if(hie==0){ wsf[32+r32e]=l_reg; if(MODE==0) lse[(long)(wid*32+r32e)*lstride]=mhat+__builtin_amdgcn_logf(l_reg); }
  asm volatile("s_waitcnt lgkmcnt(0)":::"memory");
  float rli[16];
  #pragma unroll
  for(int r=0;r<16;++r)rli[r]=__builtin_amdgcn_rcpf(wsf[32+crow(r,hie)]);
  { bf16*stg=(bf16*)(shm+T_OST)+wid*2048;
    #pragma unroll
    for(int r=0;r<16;++r){const int orow=crow(r,hie);
      #pragma unroll
      for(int d0=0;d0<2;++d0)stg[orow*64+d0*32+r32e]=__float2bfloat16(o[d0][r]*rli[r]);}
    asm volatile("s_waitcnt lgkmcnt(0)":::"memory");
    bf16*Ow=Ob+(long)(wid*32)*ostride;
    int le_=lane; asm volatile("":"+v"(le_));
    #pragma unroll
    for(int i=0;i<4;++i){const int row=i*8+(le_>>3),ch=le_&7; const u32x4 v=*(const u32x4*)(stg+row*64+ch*8);
      if(WO_FP8&&MODE==1){ typedef unsigned u32x2o __attribute__((ext_vector_type(2))); u32x2o w8;
        w8.x=pg8::pk4_fp8(__uint_as_float(v.x<<16),__uint_as_float(v.x&0xffff0000u),__uint_as_float(v.y<<16),__uint_as_float(v.y&0xffff0000u));
        w8.y=pg8::pk4_fp8(__uint_as_float(v.z<<16),__uint_as_float(v.z&0xffff0000u),__uint_as_float(v.w<<16),__uint_as_float(v.w&0xffff0000u));
        *(u32x2o*)((unsigned char*)Ob+(long)(wid*32+row)*ostride+ch*8)=w8; }
      else *(u32x4*)(Ow+(long)row*ostride+ch*8)=v;} }
  asm volatile("s_waitcnt lgkmcnt(0)\n\ts_barrier":::"memory");
  #undef DMA_K
  #undef DMA_V
  #undef KOFF
  #undef FQ
  #undef VOFF
  #undef START
  #undef RESC
  #undef ROT
}
#undef SBAR
#undef WAIT_BAR
}

namespace attn_body {
constexpr int B_V = 0, B_VBUF = 49152, B_K = B_VBUF, B_WS = 2 * B_VBUF, B_OST = B_WS + 2048, B_TAB = B_OST + 32768, B_END = B_TAB + 2 * 1024;
struct BandUnit { const bf16* Q; const bf16* K; const bf16* V; bf16* O; float* L; const float* tab; int q0; int sh; };
__device__ __forceinline__ void band_decode(int L, BandUnit& u, const bf16* QKV, bf16* OG, float* LSE, const float* BT) {
    const int tri = L >> 4, u16 = L & 15, b = tri / 48, gh = tri % 48, g = gh >> 4, h = gh & 15;
    const int sh = 2 * g, Ls = 4096 >> sh;
    const int r = (g == 0) ? 0 : (g == 1 ? (u16 >> 2) : u16), uq = (g == 0) ? u16 : (g == 1 ? (u16 & 3) : 0);
    const size_t pl = (size_t)((b * 3 + g) * 3) * 16 + h;
    u.Q = QKV + (pl * 4096 + (size_t)r * Ls) * 64; u.K = u.Q + (size_t)16 * 4096 * 64; u.V = u.Q + (size_t)32 * 4096 * 64;
    const size_t tok0 = (size_t)b * 4096 + r;
    u.O = OG + ((size_t)g * 32768 + tok0) * 1024 + h * 64; u.L = LSE + ((size_t)g * 32768 + tok0) * 16 + h;
    u.tab = BT + gh * 132; u.q0 = uq * 256; u.sh = sh;
}
__device__ __forceinline__ void band_issue_v(const BandUnit& u, unsigned lds0, int lane, int wid) {
    const unsigned voff = (unsigned)((16 * (wid & 3) + (lane >> 2)) * 128 + (wid >> 2) * 64 + (lane & 3) * 16);
    const int w0 = u.q0 - 128;
    #pragma unroll
    for (int t = 0; t < 6; ++t) { const int k0 = w0 + 64 * t;
        if (k0 >= 0) glds16s(voff, (const char*)u.V + (long)k0 * 128, (unsigned)__builtin_amdgcn_readfirstlane(lds0 + B_V + t * 8192 + wid * 1024)); }
}
__device__ __forceinline__ void band_issue_k(const BandUnit& u, int tbuf, unsigned lds0, int tid, int lane, int wid) {
    const unsigned koff = (unsigned)(lane * 128 + wid * 16);
    const int w0 = u.q0 - 128;
    #pragma unroll
    for (int t = 0; t < 6; ++t) { const int k0 = w0 + 64 * t;
        if (k0 >= 0) glds16s(koff, (const char*)u.K + (long)k0 * 128, (unsigned)__builtin_amdgcn_readfirstlane(lds0 + B_K + t * 8192 + wid * 1024)); }
    if (tid < 192) { __attribute__((address_space(3))) float* tb = (__attribute__((address_space(3))) float*)(uintptr_t)(lds0 + B_TAB + tbuf * 1024);
        tb[tid] = (tid >= 32 && tid <= 160) ? u.tab[tid - 32] : -INFINITY; }
}
template <int VAR> __device__ __forceinline__ void band_phase(const bf16* QKV, bf16* OG, float* LSE, const float* BT, int first, int step, int NU, char* shm) {
    const int tid = threadIdx.x, lane = tid & 63, r32 = lane & 31, hi = lane >> 5; const int wid = __builtin_amdgcn_readfirstlane(tid >> 6);
    const unsigned lds0 = (unsigned)(uintptr_t)shm;
    float* wsf = (float*)(shm + B_WS) + wid * 64;
    typedef __attribute__((address_space(3))) const float* lds_f;
    BandUnit cur, nxt;
    int L = first, buf = 0;
#define BAND_LOADQ(U) do { const bf16* Qw_ = (U).Q + (long)((U).q0 + 32 * wid) * 64; \
        _Pragma("unroll") for (int d0 = 0; d0 < 4; ++d0) qn[d0] = *reinterpret_cast<const bf16x8*>(&Qw_[(long)r32 * 64 + d0 * 16 + hi * 8]); } while (0)
    bf16x8 qn[4];
    #pragma unroll
    for (int d0 = 0; d0 < 4; ++d0) qn[d0] = (bf16x8){0, 0, 0, 0, 0, 0, 0, 0};
    if (L < NU) { band_decode(L, cur, QKV, OG, LSE, BT); band_issue_k(cur, 0, lds0, tid, lane, wid); BAND_LOADQ(cur); }
    for (; L < NU; L += step, buf ^= 1) {
        const bool has_next = (L + step) < NU;
        if (has_next) band_decode(L + step, nxt, QKV, OG, LSE, BT); else nxt = cur;
        const int qw = cur.q0 + 32 * wid;
        const int jlo = (qw >= 128) ? 0 : ((128 - qw) >> 5);
        if (L == first) asm volatile("s_waitcnt vmcnt(0) lgkmcnt(0)\n\ts_barrier" ::: "memory");
        else asm volatile("s_waitcnt vmcnt(5) lgkmcnt(0)\n\ts_barrier" ::: "memory");
        bf16x8 qr[4];
        #pragma unroll
        for (int d0 = 0; d0 < 4; ++d0) qr[d0] = qn[d0];
        band_issue_v(cur, lds0, lane, wid);
        f32x16 S[5];
        { const lds_f tb = (lds_f)(uintptr_t)(lds0 + B_TAB + buf * 1024) + (5 + r32 - 4 * hi);
          #pragma unroll
          for (int j = 0; j < 5; ++j) {
              #pragma unroll
              for (int r = 0; r < 16; ++r) S[j][r] = (VAR == 2) ? 0.f : ((j >= jlo) ? tb[(128 - 32 * j) + 27 - ((r & 3) + 8 * (r >> 2))] : -INFINITY);
              if (VAR != 2 && j >= jlo) { const int wj = wid + j;
                  const __attribute__((address_space(3))) char* kp = (const __attribute__((address_space(3))) char*)(uintptr_t)(lds0 + B_K + (wj >> 1) * 8192 + hi * 1024 + ((wj & 1) * 32 + r32) * 16);
                  #pragma unroll
                  for (int d0 = 0; d0 < 4; ++d0) { const bf16x8 kf = *(const __attribute__((address_space(3))) bf16x8*)(kp + d0 * 2048);
                      S[j] = __builtin_amdgcn_mfma_f32_32x32x16_bf16(kf, qr[d0], S[j], 0, 0, 0); } } } }
        asm volatile("s_waitcnt vmcnt(0) lgkmcnt(0)\n\ts_barrier" ::: "memory");
        if (has_next) { band_issue_k(nxt, buf ^ 1, lds0, tid, lane, wid); BAND_LOADQ(nxt); }
        float mx = -INFINITY;
        #pragma unroll
        for (int j = 0; j < 5; ++j)
            #pragma unroll
            for (int r = 0; r < 16; ++r) mx = fmaxf(mx, S[j][r]);
        { auto rr = __builtin_amdgcn_permlane32_swap(__float_as_uint(mx), __float_as_uint(mx), false, false); mx = fmaxf(__uint_as_float(rr[0]), __uint_as_float(rr[1])); }
        float lsum = 0.f; u32x4 pw[5][2];
        #pragma unroll
        for (int j = 0; j < 5; ++j) {
            #pragma unroll
            for (int r = 0; r < 16; ++r) { if (VAR != 3) S[j][r] = __builtin_amdgcn_exp2f(S[j][r] - mx); lsum += S[j][r]; }
            pw[j][0] = (u32x4){cvtpk_s(S[j][0], S[j][1]), cvtpk_s(S[j][2], S[j][3]), cvtpk_s(S[j][4], S[j][5]), cvtpk_s(S[j][6], S[j][7])};
            pw[j][1] = (u32x4){cvtpk_s(S[j][8], S[j][9]), cvtpk_s(S[j][10], S[j][11]), cvtpk_s(S[j][12], S[j][13]), cvtpk_s(S[j][14], S[j][15])}; }
        { auto rr = __builtin_amdgcn_permlane32_swap(__float_as_uint(lsum), __float_as_uint(lsum), false, false); lsum = __uint_as_float(rr[0]) + __uint_as_float(rr[1]); }
        f32x16 o[2]; o[0] = f32x16{}; o[1] = f32x16{};
        const int vlane = ((lane >> 4) & 1) * 32 + (lane & 3) * 8 + (4 * hi + ((lane & 15) >> 2)) * 64;
        #pragma unroll
        for (int j = 0; j < 5; ++j) if (VAR != 1 && j >= jlo) {
            const int wj = wid + j;
            const int vb = (int)(lds0 + B_V) + (wj >> 1) * 8192 + (wj & 1) * 2048 + vlane;
            s16x4 l0[2], h0[2], l1[2], h1[2];
            #pragma unroll
            for (int d0 = 0; d0 < 2; ++d0) {
                asm volatile("ds_read_b64_tr_b16 %0,%1 offset:%c2" : "=&v"(l0[d0]) : "v"(vb), "i"(d0 * 4096) : "memory");
                asm volatile("ds_read_b64_tr_b16 %0,%1 offset:%c2" : "=&v"(h0[d0]) : "v"(vb), "i"(d0 * 4096 + 512) : "memory");
                asm volatile("ds_read_b64_tr_b16 %0,%1 offset:%c2" : "=&v"(l1[d0]) : "v"(vb), "i"(d0 * 4096 + 1024) : "memory");
                asm volatile("ds_read_b64_tr_b16 %0,%1 offset:%c2" : "=&v"(h1[d0]) : "v"(vb), "i"(d0 * 4096 + 1536) : "memory"); }
            asm volatile("s_waitcnt lgkmcnt(0)" : "+v"(l0[0]), "+v"(h0[0]), "+v"(l1[0]), "+v"(h1[0]), "+v"(l0[1]), "+v"(h0[1]), "+v"(l1[1]), "+v"(h1[1]) :: "memory"); __builtin_amdgcn_sched_barrier(0);
            #pragma unroll
            for (int d0 = 0; d0 < 2; ++d0) {
                o[d0] = __builtin_amdgcn_mfma_f32_32x32x16_bf16(__builtin_bit_cast(bf16x8, pw[j][0]), (bf16x8){l0[d0][0], l0[d0][1], l0[d0][2], l0[d0][3], h0[d0][0], h0[d0][1], h0[d0][2], h0[d0][3]}, o[d0], 0, 0, 0);
                o[d0] = __builtin_amdgcn_mfma_f32_32x32x16_bf16(__builtin_bit_cast(bf16x8, pw[j][1]), (bf16x8){l1[d0][0], l1[d0][1], l1[d0][2], l1[d0][3], h1[d0][0], h1[d0][1], h1[d0][2], h1[d0][3]}, o[d0], 0, 0, 0); } }
        const long ostride = 1024L << cur.sh, lstride = 16L << cur.sh;
        if (hi == 0) { wsf[32 + r32] = lsum; cur.L[(long)(qw + r32) * lstride] = mx + __builtin_amdgcn_logf(lsum); }
        asm volatile("s_waitcnt lgkmcnt(0)" ::: "memory");
        float rli[16];
        #pragma unroll
        for (int r = 0; r < 16; ++r) rli[r] = __builtin_amdgcn_rcpf(wsf[32 + crow(r, hi)]);
        { bf16* stg = (bf16*)(shm + B_OST) + wid * 2048;
          #pragma unroll
          for (int r = 0; r < 16; ++r) { const int orow = crow(r, hi);
            #pragma unroll
            for (int d0 = 0; d0 < 2; ++d0) stg[orow * 64 + d0 * 32 + r32] = __float2bfloat16(o[d0][r] * rli[r]); }
          asm volatile("s_waitcnt lgkmcnt(0)" ::: "memory");
          bf16* Ow = cur.O + (long)qw * ostride;
          #pragma unroll
          for (int i = 0; i < 4; ++i) { const int row = i * 8 + (lane >> 3), ch = lane & 7; const u32x4 v = *(const u32x4*)(stg + row * 64 + ch * 8); *(u32x4*)(Ow + (long)row * ostride + ch * 8) = v; } }
        cur = nxt;
    }
    asm volatile("s_waitcnt vmcnt(0) lgkmcnt(0)\n\ts_barrier" ::: "memory");
#undef BAND_LOADQ
}
}

namespace attn_body {
typedef int i32x8b __attribute__((ext_vector_type(8)));
typedef int i32x4b __attribute__((ext_vector_type(4)));
typedef int i32x2b __attribute__((ext_vector_type(2)));
constexpr int C_KV = 0, C_KVBUF = 49152  , C_WS = 2 * C_KVBUF, C_OST = C_WS + 2048, C_TAB = C_OST + 32768, C_END = C_TAB + 2 * 1024;
struct Band8Unit { const unsigned char* Q; const unsigned char* K; const unsigned char* V; bf16* O; float* L; const float* tab; int q0; int sh; };
__device__ __forceinline__ void band8_decode(int L, Band8Unit& u, const unsigned char* QKV, bf16* OG, float* LSE, const float* BT) {
    const int tri = L >> 4, u16 = L & 15, b = tri / 48, gh = tri % 48, g = gh >> 4, h = gh & 15;
    const int sh = 2 * g, Ls = 4096 >> sh;
    const int r = (g == 0) ? 0 : (g == 1 ? (u16 >> 2) : u16), uq = (g == 0) ? u16 : (g == 1 ? (u16 & 3) : 0);
    const size_t pl = (size_t)((b * 3 + g) * 3) * 16 + h;
    u.Q = QKV + (pl * 4096 + (size_t)r * Ls) * 64; u.K = u.Q + (size_t)16 * 4096 * 64; u.V = u.Q + (size_t)32 * 4096 * 64;
    const size_t tok0 = (size_t)b * 4096 + r;
    u.O = OG + ((size_t)g * 32768 + tok0) * 1024 + h * 64; u.L = LSE + ((size_t)g * 32768 + tok0) * 16 + h;
    u.tab = BT + gh * 132; u.q0 = uq * 256; u.sh = sh;
}
__device__ __forceinline__ void band8_issue(const Band8Unit& u, int b, unsigned lds0, int tid, int lane, int wid) {
    const unsigned lane64 = (unsigned)lane * 64u;
    const int w0 = u.q0 - 128;
    #pragma unroll
    for (int i = 0; i < 3; ++i) { const int p = wid * 3 + i, k0 = w0 + 64 * (p >> 2);
        if (k0 >= 0) { const long go = (long)k0 * 64 + (p & 3) * 16;
            glds16s(lane64, (const char*)u.K + go, (unsigned)__builtin_amdgcn_readfirstlane(lds0 + C_KV + b * C_KVBUF + p * 1024));
            glds16s(lane64, (const char*)u.V + go, (unsigned)__builtin_amdgcn_readfirstlane(lds0 + C_KV + b * C_KVBUF + 24576 + p * 1024)); } }
    if (tid < 192) { __attribute__((address_space(3))) float* tb = (__attribute__((address_space(3))) float*)(uintptr_t)(lds0 + C_TAB + b * 1024);
        tb[tid] = (tid >= 32 && tid <= 160) ? u.tab[tid - 32] : -INFINITY; }
}
__device__ __forceinline__ unsigned pk4_e4m3(float a, float b, float c, float d) { int v = __builtin_amdgcn_cvt_pk_fp8_f32(a, b, 0, false); v = __builtin_amdgcn_cvt_pk_fp8_f32(c, d, v, true); return (unsigned)v; }
template <int VAR> __device__ __forceinline__ void band8_phase(const unsigned char* QKV, bf16* OG, float* LSE, const float* BT, int first, int step, int NU, char* shm) {
    const int tid = threadIdx.x, lane = tid & 63, r32 = lane & 31, hi = lane >> 5; const int wid = __builtin_amdgcn_readfirstlane(tid >> 6);
    const unsigned lds0 = (unsigned)(uintptr_t)shm;
    float* wsf = (float*)(shm + C_WS) + wid * 64;
    typedef __attribute__((address_space(3))) const float* lds_f;
    typedef __attribute__((address_space(3))) const i32x4b* lds_q;
    Band8Unit cur, nxt;
    int L = first, buf = 0;
#define BAND8_LOADQ(U) do { const unsigned char* Qw_ = (U).Q + (long)((U).q0 + 32 * wid + r32) * 64 + hi * 32; \
        qn[0] = *reinterpret_cast<const i32x4b*>(Qw_); qn[1] = *reinterpret_cast<const i32x4b*>(Qw_ + 16); } while (0)
    i32x4b qn[2]; qn[0] = (i32x4b){0, 0, 0, 0}; qn[1] = qn[0];
    if (L < NU) { band8_decode(L, cur, QKV, OG, LSE, BT); band8_issue(cur, 0, lds0, tid, lane, wid); BAND8_LOADQ(cur); }
    const int vlane8 = ((lane >> 4) & 1) * 1024 + ((((lane & 15) >> 3) & 1) * 8 + (((lane & 15) >> 1) & 3) + 4 * hi) * 16 + (lane & 1) * 8;
    for (; L < NU; L += step, buf ^= 1) {
        const bool has_next = (L + step) < NU;
        if (has_next) band8_decode(L + step, nxt, QKV, OG, LSE, BT); else nxt = cur;
        const int qw = cur.q0 + 32 * wid;
        const int jlo = (qw >= 128) ? 0 : ((128 - qw) >> 5);
        if (L == first) asm volatile("s_waitcnt vmcnt(0) lgkmcnt(0)\n\ts_barrier" ::: "memory");
        else asm volatile("s_waitcnt vmcnt(5) lgkmcnt(0)\n\ts_barrier" ::: "memory");
        const i32x8b qf = (i32x8b){qn[0][0], qn[0][1], qn[0][2], qn[0][3], qn[1][0], qn[1][1], qn[1][2], qn[1][3]};
        if (has_next) { band8_issue(nxt, buf ^ 1, lds0, tid, lane, wid); BAND8_LOADQ(nxt); }
        const unsigned kvb = lds0 + C_KV + buf * C_KVBUF;
        f32x16 S[5];
        { const lds_f tb = (lds_f)(uintptr_t)(lds0 + C_TAB + buf * 1024) + (5 + r32 - 4 * hi);
          #pragma unroll
          for (int j = 0; j < 5; ++j) {
              #pragma unroll
              for (int r = 0; r < 16; ++r) S[j][r] = (j >= jlo) ? tb[(128 - 32 * j) + 27 - ((r & 3) + 8 * (r >> 2))] : -INFINITY;
              if (j >= jlo) { const int wj = wid + j;
                  const lds_q kp = (lds_q)(uintptr_t)(kvb + (wj >> 1) * 4096 + hi * 2048 + ((wj & 1) * 32 + r32) * 16);
                  const i32x4b k0 = kp[0], k1 = kp[64];
                  S[j] = __builtin_amdgcn_mfma_scale_f32_32x32x64_f8f6f4((i32x8b){k0[0], k0[1], k0[2], k0[3], k1[0], k1[1], k1[2], k1[3]}, qf, S[j], 0, 0, 0, 0, 0, 0); } } }
        float mx = -INFINITY;
        #pragma unroll
        for (int j = 0; j < 5; ++j)
            #pragma unroll
            for (int r = 0; r < 16; ++r) mx = fmaxf(mx, S[j][r]);
        { auto rr = __builtin_amdgcn_permlane32_swap(__float_as_uint(mx), __float_as_uint(mx), false, false); mx = fmaxf(__uint_as_float(rr[0]), __uint_as_float(rr[1])); }
        const float mxs = mx - 7.f;
        float lsum = 0.f; unsigned pw[5][4];
        #pragma unroll
        for (int j = 0; j < 5; ++j) {
            #pragma unroll
            for (int r = 0; r < 16; ++r) { S[j][r] = __builtin_amdgcn_exp2f(S[j][r] - mxs); lsum += S[j][r]; }
            #pragma unroll
            for (int q4 = 0; q4 < 4; ++q4) pw[j][q4] = pk4_e4m3(S[j][4 * q4], S[j][4 * q4 + 1], S[j][4 * q4 + 2], S[j][4 * q4 + 3]); }
        { auto rr = __builtin_amdgcn_permlane32_swap(__float_as_uint(lsum), __float_as_uint(lsum), false, false); lsum = __uint_as_float(rr[0]) + __uint_as_float(rr[1]); }
        f32x16 o[2]; o[0] = f32x16{}; o[1] = f32x16{};
        i32x2b vf[3][2][4];
        #pragma unroll
        for (int pr = 0; pr < 3; ++pr)
            #pragma unroll
            for (int c = 0; c < (pr == 2 ? 2 : 4); ++c) {
                const int j = 2 * pr + (c >> 1), je = j > jlo ? j : jlo, wj = wid + je;
                const int vb = (int)(kvb + 24576) + (wj >> 1) * 4096 + (wj & 1) * 512 + vlane8;
                asm volatile("ds_read_b64_tr_b8 %0,%1 offset:%c2" : "=&v"(vf[pr][0][c]) : "v"(vb), "i"((c & 1) * 256) : "memory");
                asm volatile("ds_read_b64_tr_b8 %0,%1 offset:%c2" : "=&v"(vf[pr][1][c]) : "v"(vb), "i"(2048 + (c & 1) * 256) : "memory"); }
        asm volatile("s_waitcnt lgkmcnt(0)" : "+v"(vf[0][0][0]), "+v"(vf[0][0][1]), "+v"(vf[0][0][2]), "+v"(vf[0][0][3]), "+v"(vf[0][1][0]), "+v"(vf[0][1][1]), "+v"(vf[0][1][2]), "+v"(vf[0][1][3]),
                     "+v"(vf[1][0][0]), "+v"(vf[1][0][1]), "+v"(vf[1][0][2]), "+v"(vf[1][0][3]), "+v"(vf[1][1][0]), "+v"(vf[1][1][1]), "+v"(vf[1][1][2]), "+v"(vf[1][1][3]),
                     "+v"(vf[2][0][0]), "+v"(vf[2][0][1]), "+v"(vf[2][1][0]), "+v"(vf[2][1][1]) :: "memory"); __builtin_amdgcn_sched_barrier(0);
        #pragma unroll
        for (int pr = 0; pr < 3; ++pr) {
            const i32x8b pa = (pr == 2) ? (i32x8b){(int)pw[4][0], (int)pw[4][1], (int)pw[4][2], (int)pw[4][3], 0, 0, 0, 0}
                                        : (i32x8b){(int)pw[2 * pr][0], (int)pw[2 * pr][1], (int)pw[2 * pr][2], (int)pw[2 * pr][3], (int)pw[2 * pr + 1][0], (int)pw[2 * pr + 1][1], (int)pw[2 * pr + 1][2], (int)pw[2 * pr + 1][3]};
            #pragma unroll
            for (int d0 = 0; d0 < 2; ++d0) {
                const i32x2b v2 = (pr == 2) ? vf[2][d0][0] : vf[pr][d0][2], v3 = (pr == 2) ? vf[2][d0][1] : vf[pr][d0][3];
                o[d0] = __builtin_amdgcn_mfma_scale_f32_32x32x64_f8f6f4(pa, (i32x8b){vf[pr][d0][0][0], vf[pr][d0][0][1], vf[pr][d0][1][0], vf[pr][d0][1][1], v2[0], v2[1], v3[0], v3[1]}, o[d0], 0, 0, 0, 0, 0, 0); } }
        const long ostride = 1024L << cur.sh, lstride = 16L << cur.sh;
        if (hi == 0) { wsf[32 + r32] = lsum; cur.L[(long)(qw + r32) * lstride] = mxs + __builtin_amdgcn_logf(lsum); }
        asm volatile("s_waitcnt lgkmcnt(0)" ::: "memory");
        float rli[16];
        #pragma unroll
        for (int r = 0; r < 16; ++r) rli[r] = __builtin_amdgcn_rcpf(wsf[32 + crow(r, hi)]);
        { bf16* stg = (bf16*)(shm + C_OST) + wid * 2048;
          #pragma unroll
          for (int r = 0; r < 16; ++r) { const int orow = crow(r, hi);
            #pragma unroll
            for (int d0 = 0; d0 < 2; ++d0) stg[orow * 64 + d0 * 32 + r32] = __float2bfloat16(o[d0][r] * rli[r]); }
          asm volatile("s_waitcnt lgkmcnt(0)" ::: "memory");
          bf16* Ow = cur.O + (long)qw * ostride;
          #pragma unroll
          for (int i = 0; i < 4; ++i) { const int row = i * 8 + (lane >> 3), ch = lane & 7; const u32x4 v = *(const u32x4*)(stg + row * 64 + ch * 8); *(u32x4*)(Ow + (long)row * ostride + ch * 8) = v; } }
        cur = nxt;
    }
    asm volatile("s_waitcnt vmcnt(0) lgkmcnt(0)\n\ts_barrier" ::: "memory");
#undef BAND8_LOADQ
}
}
#define XB_TMO      128
#define XB_XCNT(j)  (256  + 64 * (j))
#define XB_XSUB(j)  (1280 + 64 * (j))
#define XB_XGEN(j)  (2304 + 64 * (j))
#define XB_TOP      3328
#define XB_TOPGEN   3392
#define XCD_BAR_WORDS 3456
#define XB_SPIN_CAP (1u << 18)

__device__ __forceinline__ unsigned xb_ld(unsigned* p)              { return __hip_atomic_load(p, __ATOMIC_RELAXED, __HIP_MEMORY_SCOPE_AGENT); }
__device__ __forceinline__ unsigned xb_add(unsigned* p, unsigned v) { return __hip_atomic_fetch_add(p, v, __ATOMIC_RELAXED, __HIP_MEMORY_SCOPE_AGENT); }
__device__ __forceinline__ unsigned xb_xcc_id() { return (unsigned)__builtin_amdgcn_s_getreg((3 << 11) | 20) & 0xFu; }
#define XB_SPIN(cond, bar) do { unsigned _sp = 0; while (cond) { __builtin_amdgcn_s_sleep(1); \
    if ((++_sp & 255u) == 0u) { if (xb_ld(&(bar)[XB_TMO])) break; if (_sp > XB_SPIN_CAP) { atomicAdd(&(bar)[XB_TMO], 1u); break; } } } } while (0)

struct XcdBarrier {
    unsigned* bar; unsigned x;
    volatile LAS unsigned* st;
};

__device__ __forceinline__ XcdBarrier xcd_barrier_post(unsigned* bar, volatile LAS unsigned* st) {
    XcdBarrier b; b.bar = bar; b.x = xb_xcc_id(); b.st = st;
    if (threadIdx.x == 0) (void)xb_add(&bar[XB_XCNT(b.x)], 1u);
    return b;
}
__device__ __forceinline__ void xcd_barrier_complete(unsigned* bar, unsigned x, unsigned& nloc, unsigned& nx) {
    const unsigned G = gridDim.x * gridDim.y * gridDim.z;
    unsigned sum, cnt, mine, sp = 0u;
    for (;;) {
        sum = 0u; cnt = 0u; mine = 0u;
#pragma unroll
        for (unsigned j = 0; j < 16; ++j) { const unsigned c = xb_ld(&bar[XB_XCNT(j)]); sum += c; cnt += (c > 0u) ? 1u : 0u; mine = (j == x) ? c : mine; }
        if (sum == G) break;
        __builtin_amdgcn_s_sleep(1);
        if ((++sp & 255u) == 0u) { if (xb_ld(&bar[XB_TMO])) break; if (sp > XB_SPIN_CAP) { atomicAdd(&bar[XB_TMO], 1u); break; } }
    }
    nloc = mine > 0u ? mine : 1u; nx = cnt > 0u ? cnt : 1u;
}

__device__ __forceinline__ void xcd_barrier(const XcdBarrier& b) {
    asm volatile("s_waitcnt vmcnt(0)" ::: "memory");
    __syncthreads();
    if (threadIdx.x == 0) {
        unsigned* bar = b.bar;
        __builtin_amdgcn_s_waitcnt(0);
        unsigned nloc = b.st[0], nx = b.st[1];
        if (nloc == 0u) { xcd_barrier_complete(bar, b.x, nloc, nx); b.st[0] = nloc; b.st[1] = nx; }
        const unsigned old = xb_add(&bar[XB_XSUB(b.x)], 1u);
        const unsigned gen = old / nloc;
        if (old + 1u == (gen + 1u) * nloc) {
            __builtin_amdgcn_fence(__ATOMIC_RELEASE, "agent");
            asm volatile("s_waitcnt vmcnt(0)" ::: "memory");
            const unsigned og = xb_add(&bar[XB_TOP], 1u);
            const unsigned tg = og / nx;
            if (og + 1u == (tg + 1u) * nx) xb_add(&bar[XB_TOPGEN], 1u);
            else XB_SPIN(xb_ld(&bar[XB_TOPGEN]) == tg, bar);
            __builtin_amdgcn_fence(__ATOMIC_ACQUIRE, "agent");
            xb_add(&bar[XB_XGEN(b.x)], 1u);
            asm volatile("s_waitcnt vmcnt(0)" ::: "memory");
        } else {
            XB_SPIN(xb_ld(&bar[XB_XGEN(b.x)]) == gen, bar);
            __builtin_amdgcn_fence(__ATOMIC_ACQUIRE, "agent");
            asm volatile("s_waitcnt vmcnt(0)" ::: "memory");
        }
    }
    __syncthreads();
}

struct Args { const float* in[21]; float* out; unsigned char* ws; int ph_lo, ph_hi; };
enum { IN_X = 0, IN_C, IN_ADAW, IN_ADAB, IN_NMIX, IN_NFFN, IN_AWQKV, IN_AWO, IN_RELB, IN_KVNG, IN_WKVF, IN_BF, IN_BWQ, IN_BWO, IN_RW, IN_RB, IN_WGU, IN_BGU, IN_WDN, IN_BDN, IN_FNG };

struct Ctx {
    LAS unsigned char* lds; unsigned char* ws; int tid, lane, wave, vcu, G;
};

__device__ __forceinline__ void transpose_item(const float* __restrict__ W, int pitch, int Kd, bf16* WT, int k0, int n0, int row_off, LAS float* scr, int lane) {
#pragma unroll
    for (int i = 0; i < 8; ++i) { const int kk = 8 * i + (lane >> 3), c4 = (lane & 7) * 4;
        const f32x4 v = *(const f32x4*)(W + (size_t)(k0 + kk) * pitch + n0 + c4);
        scr[kk * 33 + c4] = v[0]; scr[kk * 33 + c4 + 1] = v[1]; scr[kk * 33 + c4 + 2] = v[2]; scr[kk * 33 + c4 + 3] = v[3]; }
    LDS_WAIT(); asm volatile("" ::: "memory");
    const int c = lane & 7;
#pragma unroll
    for (int j = 0; j < 4; ++j) { const int n = (lane >> 3) + 8 * j; const LAS float* s = scr + (8 * c) * 33 + n;
        u32x4v o; o.x = pkbf(s[0 * 33], s[1 * 33]); o.y = pkbf(s[2 * 33], s[3 * 33]); o.z = pkbf(s[4 * 33], s[5 * 33]); o.w = pkbf(s[6 * 33], s[7 * 33]);
        *(u32x4v*)(WT + (size_t)(row_off + n0 + n) * Kd + k0 + 8 * c) = o; }
    LDS_WAIT(); asm volatile("" ::: "memory");
}

__device__ __forceinline__ void transpose_item8(const float* __restrict__ W, int pitch, int Kd, unsigned char* WT, int k0, int n0, int row_off, LAS float* scr, int lane) {
#pragma unroll
    for (int i = 0; i < 8; ++i) { const int kk = 8 * i + (lane >> 3), c4 = (lane & 7) * 4;
        const f32x4 v = *(const f32x4*)(W + (size_t)(k0 + kk) * pitch + n0 + c4) * 64.f;
        scr[kk * 33 + c4] = v[0]; scr[kk * 33 + c4 + 1] = v[1]; scr[kk * 33 + c4 + 2] = v[2]; scr[kk * 33 + c4 + 3] = v[3]; }
    LDS_WAIT(); asm volatile("" ::: "memory");
    const int c = lane & 7;
#pragma unroll
    for (int j = 0; j < 4; ++j) { const int n = (lane >> 3) + 8 * j; const LAS float* s = scr + (8 * c) * 33 + n;
        u32x2v o; o.x = pg8::pk4_fp8(s[0 * 33], s[1 * 33], s[2 * 33], s[3 * 33]); o.y = pg8::pk4_fp8(s[4 * 33], s[5 * 33], s[6 * 33], s[7 * 33]);
        *(u32x2v*)(WT + (size_t)(row_off + n0 + n) * Kd + k0 + 8 * c) = o; }
    LDS_WAIT(); asm volatile("" ::: "memory");
}

template <int DEPTH> __device__ __forceinline__ void convert_weights(const Ctx& C, const Args& a, const int part, const int idx, const int cnt) {
    LAS float* scr = (LAS float*)(C.lds + RING_OFF + C.wave * 8704);
    const int gw = idx * NWAVES + C.wave, NGW = cnt * NWAVES;
    constexpr int I_QKV = 16 * 288, I_SQ = 16 * 32, I_KV = 16 * 64, I_GU1 = 16 * 64, I_DN1 = 16 * 32;
    constexpr int O_WO0 = I_QKV, O_KV = O_WO0 + I_SQ, O_WQ = O_KV + I_KV, O_WO1 = O_WQ + I_SQ, O_GU = O_WO1 + I_SQ, O_DN = O_GU + 64 * I_GU1, NITEMS = O_DN + 64 * I_DN1;
    static_assert(QKV_FP8 && KVQ_FP8 && WO_FP8, "the pipelined prologue converts every weight to fp8");
    struct Item { const float* W; unsigned char* WT; int pitch, k0, n0, row_off; };
    auto decode = [&](int it, Item& I) {
        if (it < O_WO0) { const int r = it, kb = r / 288, nb = r % 288; I = {a.in[IN_AWQKV], (unsigned char*)(C.ws + WS_WQKV), NQKV, 64 * kb, 32 * nb, 0}; }
        else if (it < O_KV) { const int r = it - O_WO0, kb = r / 32, nb = r % 32; I = {a.in[IN_AWO], (unsigned char*)(C.ws + WS_WO0), D, 64 * kb, 32 * nb, 0}; }
        else if (it < O_WQ) { const int r = it - O_KV, kb = r / 64, nb = r % 64; I = {a.in[IN_WKVF], (unsigned char*)(C.ws + WS_WKV), 2064, 64 * kb, 32 * nb, 0}; }
        else if (it < O_WO1) { const int r = it - O_WQ, kb = r / 32, nb = r % 32; I = {a.in[IN_BWQ], (unsigned char*)(C.ws + WS_WKV) + (size_t)2048 * D, D, 64 * kb, 32 * nb, 0}; }
        else if (it < O_GU) { const int r = it - O_WO1, kb = r / 32, nb = r % 32; I = {a.in[IN_BWO], (unsigned char*)(C.ws + WS_WO1), D, 64 * kb, 32 * nb, 0}; }
        else if (it < O_DN) { const int r = it - O_GU, mat = r / I_GU1, q = r % I_GU1, kb = q / 64, nb = q % 64;
            const int n0 = 32 * nb, which = n0 >> 10, j0 = n0 & 1023, drow0 = (j0 >> 7) * 256 + which * 128 + (j0 & 127);
            I = {a.in[IN_WGU] + (size_t)mat * D * 2048, (unsigned char*)(C.ws + WS_WGU) + (size_t)mat * 2048 * D, 2048, 64 * kb, n0, drow0 - n0}; }
        else { const int r = it - O_DN, mat = r / I_DN1, q = r % I_DN1, kb = q / 32, nb = q % 32;
            I = {a.in[IN_WDN] + (size_t)mat * D * D, (unsigned char*)(C.ws + WS_WDN) + (size_t)mat * D * D, D, 64 * kb, 32 * nb, 0}; }
    };
    const int lr = C.lane >> 3, c4 = (C.lane & 7) * 4;
#define P0_LOAD(V, I) do { _Pragma("unroll") for (int i = 0; i < 8; ++i) V[i] = NT_P0 ? __builtin_nontemporal_load((const f32x4*)((I).W + (size_t)((I).k0 + 8 * i + lr) * (I).pitch + (I).n0 + c4)) : *(const f32x4*)((I).W + (size_t)((I).k0 + 8 * i + lr) * (I).pitch + (I).n0 + c4); } while (0)
    constexpr int L1GU = 32 * I_GU1, L1DN = 32 * I_DN1;
    const int base = part == 0 ? 0 : (part == 1 ? O_GU : (part == 2 ? O_DN : (part == 3 ? O_GU + L1GU : O_DN + L1DN)));
    const int NV = part == 0 ? O_GU : ((part & 1) ? L1GU : L1DN);
    constexpr int NS = DEPTH + 1;
    f32x4 v[NS][8]; Item I[NS];
#pragma unroll
    for (int s = 0; s < DEPTH; ++s) { const int vp = gw + s * NGW; if (vp < NV) { decode(base + vp, I[s]); P0_LOAD(v[s], I[s]); } }
    for (int vv0 = gw; vv0 < NV; vv0 += NS * NGW) {
#pragma unroll
        for (int s = 0; s < NS; ++s) { const int vv = vv0 + s * NGW;
            if (vv < NV) {
                { const int vp = vv + DEPTH * NGW; constexpr int dummy = 0; (void)dummy; if (vp < NV) { decode(base + vp, I[(s + DEPTH) % NS]); P0_LOAD(v[(s + DEPTH) % NS], I[(s + DEPTH) % NS]); } }
#pragma unroll
                for (int i = 0; i < 8; ++i) { const int kk = 8 * i + lr; const f32x4 x = v[s][i] * 64.f;
                    scr[kk * 33 + c4] = x[0]; scr[kk * 33 + c4 + 1] = x[1]; scr[kk * 33 + c4 + 2] = x[2]; scr[kk * 33 + c4 + 3] = x[3]; }
                LDS_WAIT(); asm volatile("" ::: "memory");
                { const int cc = C.lane & 7;
#pragma unroll
                  for (int j = 0; j < 4; ++j) { const int n = lr + 8 * j; const LAS float* sp = scr + (8 * cc) * 33 + n;
                      u32x2v o; o.x = pg8::pk4_fp8(sp[0 * 33], sp[1 * 33], sp[2 * 33], sp[3 * 33]); o.y = pg8::pk4_fp8(sp[4 * 33], sp[5 * 33], sp[6 * 33], sp[7 * 33]);
                      *(u32x2v*)(I[s].WT + (size_t)(I[s].row_off + I[s].n0 + n) * D + I[s].k0 + 8 * cc) = o; } }
                LDS_WAIT(); asm volatile("" ::: "memory");
            } }
    }
#undef P0_LOAD
    __syncthreads();
}
__device__ __forceinline__ void p0_prologue(const Ctx& C, const Args& a) {
    convert_weights<1>(C, a, 0, C.vcu, C.G);
#if !CONV_X0
    convert_weights<1>(C, a, 1, C.vcu, C.G); convert_weights<1>(C, a, 2, C.vcu, C.G);
#endif
#if !CONV_X1
    convert_weights<1>(C, a, 3, C.vcu, C.G); convert_weights<1>(C, a, 4, C.vcu, C.G);
#endif
    LAS float* cs = (LAS float*)(C.lds + RING_OFF);
    LAS float* red = (LAS float*)(C.lds + RING_OFF + 32768);
    for (int i = C.tid; i < 8192; i += 512) { const float v = a.in[IN_C][i]; cs[i] = v / (1.f + __expf(-v)); }
    __syncthreads();
    float* ADA = (float*)(C.ws + SM_ADA);
    for (int grp = C.vcu; grp < 192; grp += C.G) {
        const int l = grp / 96, col = (grp % 96) * 64 + C.lane;
        const float* w = a.in[IN_ADAW] + (size_t)l * D * 6144 + col;
        float acc[8];
#pragma unroll
        for (int b = 0; b < 8; ++b) acc[b] = 0.f;
        const int kbeg = C.wave * 128;
#pragma unroll 4
        for (int k = kbeg; k < kbeg + 128; k += 4) {
            float wv[4];
#pragma unroll
            for (int j = 0; j < 4; ++j) wv[j] = w[(size_t)(k + j) * 6144];
#pragma unroll
            for (int b = 0; b < 8; ++b) { const f32x4 cv = *(const LAS f32x4*)(cs + b * 1024 + k); acc[b] += cv[0] * wv[0] + cv[1] * wv[1] + cv[2] * wv[2] + cv[3] * wv[3]; }
        }
#pragma unroll
        for (int b = 0; b < 8; ++b) red[(C.wave * 8 + b) * 64 + C.lane] = acc[b];
        __syncthreads();
        { const int b = C.wave; float s = 0.f;
#pragma unroll
          for (int w8 = 0; w8 < 8; ++w8) s += red[(w8 * 8 + b) * 64 + C.lane];
          ADA[(size_t)(l * 8 + b) * 6144 + col] = s + a.in[IN_ADAB][l * 6144 + col]; }
        __syncthreads();
    }
    if (C.vcu == C.G - 1) {
        float* BT = (float*)(C.ws + SM_BIAST);
        for (int i = C.tid; i < 48 * 129; i += 512) { const int gh = i / 129, dl = i % 129, g = gh >> 4, n = dl << (2 * g);
            int bk = n;
            if (n >= 16) { const float nf = (float)n; bk = 16 + (int)(logf(nf / 16.f) / 4.852030263919617f * 16.f); bk = bk > 31 ? 31 : bk; }
            BT[gh * 132 + dl] = a.in[IN_RELB][bk * 48 + gh] * LOG2E; }
    }
}

__device__ __forceinline__ void p1_rows0(const Ctx& C, const Args& a) {
    const float* ADA = (const float*)(C.ws + SM_ADA);
    float* GM = (float*)(C.ws + SM_GM); float* CSH = (float*)(C.ws + SM_CSH);
    const int gt = C.vcu * 512 + C.tid, NGT = C.G * 512;
    for (int i = gt; i < 2 * 2 * 8 * 1024; i += NGT) { const int d = i & 1023, b = (i >> 10) & 7, kind = (i >> 13) & 1, l = i >> 14;
        const float g = kind ? a.in[IN_NFFN][l * D + d] : a.in[IN_NMIX][l * D + d];
        GM[i] = g * (1.f + ADA[(size_t)(l * 8 + b) * 6144 + (kind ? 4 : 1) * 1024 + d]); }
    const int gw = C.vcu * NWAVES + C.wave, NGW = C.G * NWAVES;
    for (int o = gw; o < 512; o += NGW) { const int e = o & 31, b = (o >> 5) & 7, l = o >> 8; float s = 0.f;
        for (int d = C.lane; d < D; d += 64) s += ADA[(size_t)(l * 8 + b) * 6144 + 3 * 1024 + d] * a.in[IN_RW][(size_t)l * D * 32 + d * 32 + e];
        s = wave_sum(s); if (C.lane == 0) CSH[o] = s + a.in[IN_RB][l * 32 + e]; }
    bf16* H = (bf16*)(C.ws + WS_H);
    for (int m = gw; m < T; m += NGW) {
        const int b = m >> 12;
        const f32x4* xr = (const f32x4*)(a.in[IN_X] + (size_t)m * D) + C.lane;
        const f32x4* gr = (const f32x4*)(a.in[IN_NMIX]) + C.lane;
        const f32x4* sc = (const f32x4*)(ADA + (size_t)b * 6144 + 1024) + C.lane;
        const f32x4* sh = (const f32x4*)(ADA + (size_t)b * 6144) + C.lane;
        f32x4 v[4]; float s = 0.f;
#pragma unroll
        for (int j = 0; j < 4; ++j) { v[j] = NT_ROWS ? __builtin_nontemporal_load(xr + 64 * j) : xr[64 * j]; s += (v[j].x * v[j].x + v[j].y * v[j].y) + (v[j].z * v[j].z + v[j].w * v[j].w); }
        const float rstd = 1.f / sqrtf(wave_sum(s) * (1.f / D) + RMS_EPS);
        unsigned long long* o8 = (unsigned long long*)(H + (size_t)m * D) + C.lane; unsigned* o4 = (unsigned*)(C.ws + WS_H8 + (size_t)m * D) + C.lane;
#pragma unroll
        for (int j = 0; j < 4; ++j) { const f32x4 h = v[j] * rstd * gr[64 * j] * (sc[64 * j] + 1.f) + sh[64 * j];
            if (QKV_FP8) o4[64 * j] = pg8::pk4_fp8(h.x, h.y, h.z, h.w);
            else o8[64 * j] = (unsigned long long)pkbf(h.x, h.y) | ((unsigned long long)pkbf(h.z, h.w) << 32); }
    }
}

__device__ __forceinline__ void p3_dilated(const Ctx& C) {
#if BAND_FP8
    attn_body::band8_phase<0>((const unsigned char*)(C.ws + WS_QKV0), (attn_body::bf16*)(C.ws + WS_OG), (float*)(C.ws + SM_LSE), (const float*)(C.ws + SM_BIAST), C.vcu, C.G, 384 * 16, (char*)C.lds + RING_OFF);
    return;
#endif
#if PROBE_BAND
    attn_body::band_phase<PROBE_BAND - 1>((const attn_body::bf16*)(C.ws + WS_QKV0), (attn_body::bf16*)(C.ws + WS_XB), (float*)(C.ws + WS_XB + 200 * MiB), (const float*)(C.ws + SM_BIAST), C.vcu, C.G, 384 * 16, (char*)C.lds + RING_OFF);
#endif
    attn_body::band_phase<0>((const attn_body::bf16*)(C.ws + WS_QKV0), (attn_body::bf16*)(C.ws + WS_OG), (float*)(C.ws + SM_LSE), (const float*)(C.ws + SM_BIAST), C.vcu, C.G, 384 * 16, (char*)C.lds + RING_OFF);
}
template <int MODE> __device__ __forceinline__ void p12_fox(const Ctx& C, size_t o_off, const Args& a) {
#if CONV_X1
    if ((int)blockIdx.x >= C.G - CONV_X1) { const int ci = (int)blockIdx.x - (C.G - CONV_X1);
        convert_weights<CONV_DEPTH>(C, a, 3, ci, CONV_X1); convert_weights<CONV_DEPTH>(C, a, 4, ci, CONV_X1); }
#endif
    const attn_body::bf16* QKV = (const attn_body::bf16*)(C.ws + WS_QKV1);
    attn_body::bf16* O = (attn_body::bf16*)(C.ws + o_off); const float* FC = (const float*)(C.ws + SM_FCUM);
    LAS float* Fl = (LAS float*)(C.lds + RING_OFF + attn_body::T_F);
    LAS int* qslot = (LAS int*)(C.lds + BLK_OFF);
    unsigned* qhead = (unsigned*)(C.ws + WS_CTL) + CW_QUEUE; const unsigned* NRM = (const unsigned*)(C.ws + WS_CTL) + CW_NRM;
    int cur_bh = -1; float thr = 0.f;
    for (;;) {
        int l_; asm volatile("v_mbcnt_lo_u32_b32 %0, -1, 0\n\tv_mbcnt_hi_u32_b32 %0, -1, %0" : "=v"(l_)); const int t_ = C.wave * 64 + l_;
        __syncthreads();
        if (t_ == 0) qslot[0] = (int)__hip_atomic_fetch_add(qhead, 1u, __ATOMIC_RELAXED, __HIP_MEMORY_SCOPE_AGENT);
        __syncthreads();
        const int idx = qslot[0];
        if (idx >= 2048) break;
        const int qb = 15 - (idx >> 7), bh = idx & 127, b = bh >> 4, h = bh & 15, q0 = qb * 256;
        const attn_body::bf16* Qp = QKV + ((size_t)(b * 3 + 0) * 16 + h) * 4096 * 64;
        const attn_body::bf16* Kp = QKV + ((size_t)(b * 3 + 1) * 16 + h) * 4096 * 64;
        const attn_body::bf16* Vp = QKV + ((size_t)(b * 3 + 2) * 16 + h) * 4096 * 64;
        if (bh != cur_bh) {
            { const f32x4* src = (const f32x4*)(FC + (size_t)bh * 4096); LAS f32x4* dst = (LAS f32x4*)Fl; dst[t_] = src[t_]; dst[512 + t_] = src[512 + t_]; }
            const float gq = __uint_as_float(NRM[((b * 2 + 0) * 16 + h) * 2]) + __uint_as_float(NRM[((b * 2 + 0) * 16 + h) * 2 + 1]);
            const float gk = __uint_as_float(NRM[((b * 2 + 1) * 16 + h) * 2]) + __uint_as_float(NRM[((b * 2 + 1) * 16 + h) * 2 + 1]);
            thr = 2.f * (sqrtf(gq) * sqrtf(gk) * 1.001f + 1e-3f) + 152.f;
            cur_bh = bh;
            __syncthreads();
        }
        int tlo = 0;
        if (MODE == 1) {
            const int NTq = 4 * qb;
            const bool dead = (l_ < NTq) && (Fl[q0] - Fl[64 * l_ + 63] <= -thr);
            tlo = __popcll(__ballot(dead)) & ~1;
        }
        attn_body::attn_unit_t<MODE, 64>(Qp + (size_t)q0 * 64, Kp + (size_t)tlo * 4096, Vp + (size_t)tlo * 4096, 4 * qb + 4 - tlo, 64 * tlo, (WO_FP8 && MODE == 1) ? (attn_body::bf16*)((unsigned char*)O + ((size_t)b * 4096 + q0) * D + h * 64) : O + ((size_t)b * 4096 + q0) * D + h * 64, (long)D, nullptr, 0, (char*)C.lds + RING_OFF);
    }
}
__device__ __forceinline__ void p4_merge(const Ctx& C) {
    const bf16* OG = (const bf16*)(C.ws + WS_OG); const float* LSE = (const float*)(C.ws + SM_LSE); bf16* O = (bf16*)(C.ws + WS_O);
    const int gt = C.vcu * 512 + C.tid, NGT = C.G * 512;
    for (int i = gt; i < T * 128; i += NGT) { const int tok = i >> 7, c8 = i & 127, hd = c8 >> 3;
        const float l0 = LSE[(size_t)tok * 16 + hd], l1 = LSE[((size_t)T + tok) * 16 + hd], l2 = LSE[((size_t)2 * T + tok) * 16 + hd];
        const float mx = fmaxf(l0, fmaxf(l1, l2)); float w0 = __builtin_amdgcn_exp2f(l0 - mx), w1 = __builtin_amdgcn_exp2f(l1 - mx), w2 = __builtin_amdgcn_exp2f(l2 - mx);
        const float inv = 1.f / (w0 + w1 + w2); w0 *= inv; w1 *= inv; w2 *= inv;
        const u32x4v a0 = NT_ROWS ? __builtin_nontemporal_load((const u32x4v*)(OG + (size_t)tok * D + c8 * 8)) : *(const u32x4v*)(OG + (size_t)tok * D + c8 * 8), a1 = NT_ROWS ? __builtin_nontemporal_load((const u32x4v*)(OG + ((size_t)T + tok) * D + c8 * 8)) : *(const u32x4v*)(OG + ((size_t)T + tok) * D + c8 * 8), a2 = NT_ROWS ? __builtin_nontemporal_load((const u32x4v*)(OG + ((size_t)2 * T + tok) * D + c8 * 8)) : *(const u32x4v*)(OG + ((size_t)2 * T + tok) * D + c8 * 8);
        u32x4v o;
#pragma unroll
        for (int k = 0; k < 4; ++k) { const float lo = w0 * bf2f(a0[k] & 0xffffu) + w1 * bf2f(a1[k] & 0xffffu) + w2 * bf2f(a2[k] & 0xffffu);
            float hi = w0 * bf2f(a0[k] >> 16) + w1 * bf2f(a1[k] >> 16) + w2 * bf2f(a2[k] >> 16); float lo2 = lo;
#if PROBE_SANITIZE
            if (!(fabsf(lo2) < 1e30f)) lo2 = 0.f; if (!(fabsf(hi) < 1e30f)) hi = 0.f;
#endif
            o[k] = pkbf(lo2, hi); }
        if (WO_FP8) { u32x2v o8; o8.x = pg8::pk4_fp8(bf2f(o[0] & 0xffffu), bf2f(o[0] >> 16), bf2f(o[1] & 0xffffu), bf2f(o[1] >> 16)); o8.y = pg8::pk4_fp8(bf2f(o[2] & 0xffffu), bf2f(o[2] >> 16), bf2f(o[3] & 0xffffu), bf2f(o[3] >> 16));
            *(u32x2v*)((unsigned char*)O + (size_t)tok * D + c8 * 8) = o8; }
        else *(u32x4v*)(O + (size_t)tok * D + c8 * 8) = o; }
}

__device__ __forceinline__ f32x4 bf4_to_f32(u32x2v v) { return (f32x4){bf2f(v.x & 0xffffu), bf2f(v.x >> 16), bf2f(v.y & 0xffffu), bf2f(v.y >> 16)}; }
typedef u32x2v xs4_t;
__device__ __forceinline__ f32x4 xs4_to_f32(xs4_t v) { return bf4_to_f32(v); }
__device__ __forceinline__ xs4_t f32_to_xs4(f32x4 v) { xs4_t r; r.x = pkbf(v.x, v.y); r.y = pkbf(v.z, v.w); return r; }
#if Y_FP8
typedef unsigned yraw4_t;
__device__ __forceinline__ f32x4 y4_to_f32(yraw4_t v) { const auto lo = __builtin_amdgcn_cvt_pk_f32_fp8((int)v, false), hi = __builtin_amdgcn_cvt_pk_f32_fp8((int)v, true); return (f32x4){lo[0], lo[1], hi[0], hi[1]}; }
#define Y_ROWPTR(Yb, slot) ((const yraw4_t*)((const unsigned char*)(Yb) + (size_t)(slot) * D) + C.lane)
#else
typedef u32x2v yraw4_t;
__device__ __forceinline__ f32x4 y4_to_f32(yraw4_t v) { return bf4_to_f32(v); }
#define Y_ROWPTR(Yb, slot) ((const yraw4_t*)((Yb) + (size_t)(slot) * D) + C.lane)
#endif

__device__ __forceinline__ void r1_router(const Ctx& C, const Args& a, int l) {
    LAS float* scrf = (LAS float*)(C.lds + SCR_OFF + C.wave * 2048);
    LAS int* scri = (LAS int*)scrf;
    LAS int* blk = (LAS int*)(C.lds + BLK_OFF);
    const float* rw = a.in[IN_RW] + (size_t)l * D * 32;
    LAS unsigned short* wh = (LAS unsigned short*)(C.lds + RING_OFF); LAS unsigned short* wlo = (LAS unsigned short*)(C.lds + RING_OFF + 65536);
    int tab_b = -1;
    const bf16* XS = (const bf16*)(C.ws + WS_XS); unsigned char* H8 = (unsigned char*)(C.ws + WS_H8);
    const float* ADA = (const float*)(C.ws + SM_ADA) + (size_t)l * 8 * 6144;
    const float* GM = (const float*)(C.ws + SM_GM) + (size_t)(l * 2 + 1) * 8 * 1024;
    const float* CSH = (const float*)(C.ws + SM_CSH) + l * 256;
    int* TOPI = (int*)(C.ws + SM_TOPI); float* TOPG = (float*)(C.ws + SM_TOPG); int* RANK = (int*)(C.ws + SM_RANK); int* BLKCNT = (int*)(C.ws + SM_BLKCNT);
    const int tk = C.lane & 15, q = C.lane >> 4;
    for (int vb = C.vcu; vb < NVB; vb += C.G) {
        const int tok0 = vb * 128 + C.wave * 16, b = tok0 >> 12, tok = tok0 + tk;
        if (b != tab_b) {
            __syncthreads();
            const float* gmb = GM + b * 1024;
            for (int i = C.tid; i < D * 32; i += 512) { const int dd = i >> 5, e = i & 31; const float w = rw[i] * gmb[dd];
                const unsigned hb = pkbf(w, 0.f) & 0xffffu; const float hf = bf2f(hb); const unsigned lb = pkbf(w - hf, 0.f) & 0xffffu;
                const int pos = ((((dd >> 5) * 4 + ((dd >> 3) & 3)) * 32 + e) << 3) + (dd & 7);
                wh[pos] = (unsigned short)hb; wlo[pos] = (unsigned short)lb; }
            __syncthreads();
            tab_b = b;
        }
        const bf16* xrow = XS + (size_t)tok * D + 8 * q;
        f32x4 acc0 = {0.f, 0.f, 0.f, 0.f}, acc1 = {0.f, 0.f, 0.f, 0.f}; float ssq = 0.f;
        typedef short bf16x8r __attribute__((ext_vector_type(8)));
#pragma unroll 4
        for (int kk = 0; kk < 32; ++kk) {
            const u32x4v xr8 = *(const u32x4v*)(xrow + 32 * kk);
#pragma unroll
            for (int e2 = 0; e2 < 4; ++e2) { const float x0 = bf2f(xr8[e2] & 0xffffu), x1 = bf2f(xr8[e2] >> 16); ssq += x0 * x0 + x1 * x1; }
            const bf16x8r xb = __builtin_bit_cast(bf16x8r, xr8);
            const int fo = ((kk * 4 + q) * 32 + tk) << 3;
            const bf16x8r h0 = *(const LAS bf16x8r*)(wh + fo), h1 = *(const LAS bf16x8r*)(wh + fo + 128), l0 = *(const LAS bf16x8r*)(wlo + fo), l1 = *(const LAS bf16x8r*)(wlo + fo + 128);
            acc0 = __builtin_amdgcn_mfma_f32_16x16x32_bf16(h0, xb, acc0, 0, 0, 0); acc1 = __builtin_amdgcn_mfma_f32_16x16x32_bf16(h1, xb, acc1, 0, 0, 0);
            acc0 = __builtin_amdgcn_mfma_f32_16x16x32_bf16(l0, xb, acc0, 0, 0, 0); acc1 = __builtin_amdgcn_mfma_f32_16x16x32_bf16(l1, xb, acc1, 0, 0, 0);
        }
        ssq += __shfl_xor(ssq, 16); ssq += __shfl_xor(ssq, 32);
        const float rstd = 1.f / sqrtf(ssq * (1.f / D) + RMS_EPS);
        { const f32x4 c0 = *(const f32x4*)(CSH + b * 32 + 4 * q), c1 = *(const f32x4*)(CSH + b * 32 + 16 + 4 * q);
          *(LAS f32x4*)(scrf + tk * 32 + 4 * q) = acc0 * rstd + c0; *(LAS f32x4*)(scrf + tk * 32 + 16 + 4 * q) = acc1 * rstd + c1; }
        LDS_WAIT();
        int myidx[4] = {0, 0, 0, 0};
        if (C.lane < 16) {
            float v[32];
#pragma unroll
            for (int j = 0; j < 8; ++j) { const f32x4 t4 = *(const LAS f32x4*)(scrf + C.lane * 32 + 4 * j); v[4 * j] = t4.x; v[4 * j + 1] = t4.y; v[4 * j + 2] = t4.z; v[4 * j + 3] = t4.w; }
            float val[4];
#pragma unroll
            for (int k = 0; k < 4; ++k) { float best = v[0]; int bi = 0;
#pragma unroll
                for (int e = 1; e < 32; ++e) { if (v[e] > best) { best = v[e]; bi = e; } }
                val[k] = best; myidx[k] = bi;
#pragma unroll
                for (int e = 0; e < 32; ++e) v[e] = (e == bi) ? -INFINITY : v[e]; }
            const float e1 = __expf(val[1] - val[0]), e2 = __expf(val[2] - val[0]), e3 = __expf(val[3] - val[0]), inv = 1.f / (1.f + e1 + e2 + e3);
            *(i32x4v*)(TOPI + (size_t)(tok0 + C.lane) * 4) = (i32x4v){myidx[0], myidx[1], myidx[2], myidx[3]};
            *(f32x4*)(TOPG + (size_t)(tok0 + C.lane) * 4) = (f32x4){inv, e1 * inv, e2 * inv, e3 * inv};
        }
        LDS_WAIT();
        if (C.lane < 16) *(LAS i32x4v*)(scri + C.lane * 4) = (i32x4v){myidx[0], myidx[1], myidx[2], myidx[3]};
        LDS_WAIT();
        const int e = scri[C.lane];
        const unsigned long long lt = (1ull << C.lane) - 1ull;
        int rank = 0, mycnt = 0;
#pragma unroll 4
        for (int j = 0; j < 32; ++j) { const unsigned long long mk = __ballot(e == j); if (e == j) rank = __popcll(mk & lt); if (C.lane == j) mycnt = __popcll(mk); }
        if (C.lane < 32) blk[BL_WCNT + C.wave * 32 + C.lane] = mycnt;
        __syncthreads();
        if (C.lane < 32) { int wb = 0;
            for (int w8 = 0; w8 < C.wave; ++w8) wb += blk[BL_WCNT + w8 * 32 + C.lane];
            blk[BL_WBASE + C.wave * 32 + C.lane] = wb;
            if (C.wave == NWAVES - 1) BLKCNT[vb * 32 + C.lane] = wb + mycnt; }
        LDS_WAIT();
        RANK[(size_t)tok0 * 4 + C.lane] = blk[BL_WBASE + C.wave * 32 + e] + rank;
        const f32x4* shf = (const f32x4*)(ADA + (size_t)b * 6144 + 3 * 1024) + C.lane; const f32x4* gm4 = (const f32x4*)(GM + b * 1024) + C.lane;
#pragma unroll 2
        for (int tt = 0; tt < 16; ++tt) { const float rs = __shfl(rstd, tt); const int tkn = tok0 + tt;
            const xs4_t* xr = (const xs4_t*)(XS + (size_t)tkn * D) + C.lane; unsigned* o4 = (unsigned*)(H8 + (size_t)tkn * D) + C.lane;
#pragma unroll
            for (int j = 0; j < 4; ++j) { const f32x4 h = xs4_to_f32(xr[64 * j]) * rs * gm4[64 * j] + shf[64 * j];
                o4[64 * j] = pg8::pk4_fp8(h.x, h.y, h.z, h.w); } }
        __syncthreads();
    }
}

__device__ __forceinline__ void p7_route(const Ctx& C) {
    LAS int* blk = (LAS int*)(C.lds + BLK_OFF);
    const int* BLKCNT = (const int*)(C.ws + SM_BLKCNT); const int* TOPI = (const int*)(C.ws + SM_TOPI); const int* RANK = (const int*)(C.ws + SM_RANK);
    int* SLOT = (int*)(C.ws + SM_SLOT); int* TILEEXP = (int*)(C.ws + SM_TILEEXP); int* TOKSLOT = (int*)(C.ws + SM_TOKSLOT);
    const unsigned char* H8 = (const unsigned char*)(C.ws + WS_H8); unsigned char* XB = (unsigned char*)(C.ws + WS_XB);
    const int e = C.tid & 31, part = C.tid >> 5;
    { int s = 0; for (int k = 0; k < 16; ++k) s += BLKCNT[(part * 16 + k) * 32 + e]; blk[BL_PARTA + part * 32 + e] = s; }
    __syncthreads();
    if (C.tid < 32) { int tot = 0; for (int p = 0; p < 16; ++p) tot += blk[BL_PARTA + p * 32 + C.tid]; blk[BL_TOT + C.tid] = tot; }
    __syncthreads();
    if (C.tid == 0) { int run = 0; for (int k = 0; k < 32; ++k) { blk[BL_PADS + k] = run; run += (blk[BL_TOT + k] + 255) & ~255; } blk[BL_PADS + 32] = run; }
    __syncthreads();
    if (C.vcu == 0) {
        const int nt = blk[BL_PADS + 32] >> 8;
        if (C.tid == 0) TILEEXP[0] = nt;
        for (int i = C.tid; i < nt; i += 512) { int ex = 0; for (int k = 1; k < 32; ++k) ex += (blk[BL_PADS + k] <= i * 256) ? 1 : 0; TILEEXP[16 + i] = ex; }
        if (C.tid < 33) TILEEXP[640 + C.tid] = blk[BL_PADS + C.tid] >> 8;
    }
    for (int vb = C.vcu; vb < NVB; vb += C.G) {
        __syncthreads();
        { int s = 0; for (int k = 0; k < 16; ++k) { const int bb = part * 16 + k; s += (bb < vb) ? BLKCNT[bb * 32 + e] : 0; } blk[BL_PARTB + part * 32 + e] = s; }
        __syncthreads();
        if (C.tid < 32) { int bs = 0; for (int p = 0; p < 16; ++p) bs += blk[BL_PARTB + p * 32 + C.tid]; blk[BL_BASE + C.tid] = bs + blk[BL_PADS + C.tid]; }
        __syncthreads();
        { const int i = vb * 512 + C.tid; const int ex = TOPI[i]; SLOT[i] = blk[BL_BASE + ex] + RANK[i]; }
        VM_WAIT(); __syncthreads();
#if MOE_GATHER
        { const int i = vb * 512 + C.tid; TOKSLOT[SLOT[i]] = i >> 2; }
#else
        for (int tt = 0; tt < 16; ++tt) { const int tok = vb * 128 + C.wave * 16 + tt;
            const i32x4v sl = *(const i32x4v*)(SLOT + (size_t)tok * 4);
            const u32x4v v0 = *((const u32x4v*)(H8 + (size_t)tok * D) + C.lane);
#pragma unroll
            for (int k = 0; k < 4; ++k) { u32x4v* dst = (u32x4v*)(XB + (size_t)sl[k] * D); dst[C.lane] = v0; } }
#endif
    }
#if MOE_GATHER
    for (int ex = C.vcu; ex < 32; ex += C.G) { const int beg = blk[BL_PADS + ex] + blk[BL_TOT + ex], end = blk[BL_PADS + ex + 1];
        for (int s = beg + C.tid; s < end; s += 512) TOKSLOT[s] = 0; }
#endif
}
__device__ __forceinline__ int load_tile_table(const Ctx& C) {
    LAS int* blk = (LAS int*)(C.lds + BLK_OFF); const int* TILEEXP = (const int*)(C.ws + SM_TILEEXP);
    const int nt = TILEEXP[0];
    __syncthreads();
    for (int i = C.tid; i < MAXTILES; i += 512) blk[BL_TILE + i] = (i < nt) ? TILEEXP[16 + i] : 0;
    __syncthreads();
    return __builtin_amdgcn_readfirstlane(nt);
}


__device__ __forceinline__ void r2_seam(const Ctx& C, const Args& a) {
    LAS float* wl = (LAS float*)(C.lds + RING_OFF);
    { const float* wf = a.in[IN_WKVF]; const float* gkv0 = a.in[IN_KVNG];
      for (int i = C.tid; i < D * 16; i += 512) { const int d = i >> 4, h = i & 15, jj = d >> 8, ln = (d >> 2) & 63, c = d & 3;
          wl[((((jj * 4 + c) * 4 + (h >> 2)) * 64 + ln) << 2) + (h & 3)] = wf[(size_t)d * 2064 + 2048 + h] * gkv0[d]; } }
    __syncthreads();
    bf16* XS = (bf16*)(C.ws + WS_XS); bf16* HKV = (bf16*)(C.ws + WS_HKV); const bf16* Y = (const bf16*)(C.ws + WS_Y);
    const float* ADA0 = (const float*)(C.ws + SM_ADA); const float* ADA1 = ADA0 + (size_t)8 * 6144;
    const float* GM1 = (const float*)(C.ws + SM_GM) + (size_t)(1 * 2 + 0) * 8 * 1024;
    const int* SLOT = (const int*)(C.ws + SM_SLOT); const float* TOPG = (const float*)(C.ws + SM_TOPG); float* LOGF = (float*)(C.ws + SM_LOGF);
    const f32x4* gk4 = (const f32x4*)a.in[IN_KVNG] + C.lane;
    const int gw = C.vcu * NWAVES + C.wave, NGW = C.G * NWAVES;
    const float bfh = a.in[IN_BF][(C.lane >> 2) & 15];
    typedef yraw4_t yraw_t;
#define R2_LOADRAW(XR, Y0, Y1, Y2, Y3, MM, SS) do { const xs4_t* xr_ = (const xs4_t*)(XS + (size_t)(MM) * D) + C.lane; \
        const yraw4_t* z0_ = Y_ROWPTR(Y, (SS)[0]); const yraw4_t* z1_ = Y_ROWPTR(Y, (SS)[1]); \
        const yraw4_t* z2_ = Y_ROWPTR(Y, (SS)[2]); const yraw4_t* z3_ = Y_ROWPTR(Y, (SS)[3]); \
        _Pragma("unroll") for (int j = 0; j < 4; ++j) { if (NT_ROWS) { XR[j] = __builtin_nontemporal_load(xr_ + 64 * j); Y0[j] = __builtin_nontemporal_load(z0_ + 64 * j); Y1[j] = __builtin_nontemporal_load(z1_ + 64 * j); Y2[j] = __builtin_nontemporal_load(z2_ + 64 * j); Y3[j] = __builtin_nontemporal_load(z3_ + 64 * j); } else { XR[j] = xr_[64 * j]; Y0[j] = z0_[64 * j]; Y1[j] = z1_[64 * j]; Y2[j] = z2_[64 * j]; Y3[j] = z3_[64 * j]; } } } while (0)
    xs4_t xc[4], xn[4]; yraw_t y0c[4], y1c[4], y2c[4], y3c[4], y0n[4], y1n[4], y2n[4], y3n[4];
    i32x4v s_cur = *(const i32x4v*)(SLOT + (size_t)gw * 4); f32x4 g_cur = *(const f32x4*)(TOPG + (size_t)gw * 4);
    i32x4v s_nxt = s_cur; f32x4 g_nxt = g_cur;
    if (gw + NGW < T) { s_nxt = *(const i32x4v*)(SLOT + (size_t)(gw + NGW) * 4); g_nxt = *(const f32x4*)(TOPG + (size_t)(gw + NGW) * 4); }
    R2_LOADRAW(xc, y0c, y1c, y2c, y3c, gw, s_cur);
    for (int m = gw; m < T; m += NGW) { const int b = m >> 12;
        const int mn = m + NGW, mnn = m + 2 * NGW;
        i32x4v s_nn = s_nxt; f32x4 g_nn = g_nxt;
        if (mnn < T) { s_nn = *(const i32x4v*)(SLOT + (size_t)mnn * 4); g_nn = *(const f32x4*)(TOPG + (size_t)mnn * 4); }
        if (mn < T) R2_LOADRAW(xn, y0n, y1n, y2n, y3n, mn, s_nxt);
        const f32x4* gf4 = (const f32x4*)(ADA0 + (size_t)b * 6144 + 5 * 1024) + C.lane;
        const f32x4* gm4 = (const f32x4*)(GM1 + b * 1024) + C.lane; const f32x4* shm4 = (const f32x4*)(ADA1 + (size_t)b * 6144) + C.lane;
        xs4_t* xw = (xs4_t*)(XS + (size_t)m * D) + C.lane;
        f32x4 v[4]; float s = 0.f;
#pragma unroll
        for (int j = 0; j < 4; ++j) {
            const f32x4 ys = y4_to_f32(y0c[j]) * g_cur[0] + y4_to_f32(y1c[j]) * g_cur[1] + y4_to_f32(y2c[j]) * g_cur[2] + y4_to_f32(y3c[j]) * g_cur[3];
            v[j] = xs4_to_f32(xc[j]) + gf4[64 * j] * ys; xw[64 * j] = f32_to_xs4(v[j]); v[j] = xs4_to_f32(f32_to_xs4(v[j]));
            s += (v[j].x * v[j].x + v[j].y * v[j].y) + (v[j].z * v[j].z + v[j].w * v[j].w); }
        const float rstd = 1.f / sqrtf(wave_sum(s) * (1.f / D) + RMS_EPS);
        float acc[16];
#pragma unroll
        for (int h = 0; h < 16; ++h) acc[h] = 0.f;
#pragma unroll
        for (int j = 0; j < 4; ++j)
#pragma unroll
            for (int c = 0; c < 4; ++c) { const float xv = v[j][c];
#pragma unroll
                for (int h4 = 0; h4 < 4; ++h4) { const f32x4 w = *(const LAS f32x4*)(wl + ((((j * 4 + c) * 4 + h4) * 64 + C.lane) << 2));
                    acc[4 * h4] += xv * w[0]; acc[4 * h4 + 1] += xv * w[1]; acc[4 * h4 + 2] += xv * w[2]; acc[4 * h4 + 3] += xv * w[3]; }
                if (c == 3) __builtin_amdgcn_sched_barrier(0); }
#pragma unroll
        for (int j = 0; j < 4; ++j) { const f32x4 n = v[j] * rstd, h = n * gm4[64 * j] + shm4[64 * j], hk = n * gk4[64 * j];
            if (KVQ_FP8) { ((unsigned*)(C.ws + WS_HKV + (size_t)T * D + (size_t)m * D) + C.lane)[64 * j] = pg8::pk4_fp8(h.x, h.y, h.z, h.w);
                           ((unsigned*)(C.ws + WS_HKV + (size_t)m * D) + C.lane)[64 * j] = pg8::pk4_fp8(hk.x, hk.y, hk.z, hk.w); }
            else { ((unsigned long long*)(HKV + (size_t)T * D + (size_t)m * D) + C.lane)[64 * j] = (unsigned long long)pkbf(h.x, h.y) | ((unsigned long long)pkbf(h.z, h.w) << 32);
                   ((unsigned long long*)(HKV + (size_t)m * D) + C.lane)[64 * j] = (unsigned long long)pkbf(hk.x, hk.y) | ((unsigned long long)pkbf(hk.z, hk.w) << 32); } }
        __builtin_amdgcn_sched_barrier(0);
        float r8[8], r4[4], r2v[2], r1;
        { const bool up = (C.lane & 32) != 0;
#pragma unroll
          for (int i = 0; i < 8; ++i) { const float snd = up ? acc[i] : acc[i + 8], kp = up ? acc[i + 8] : acc[i]; r8[i] = kp + __shfl_xor(snd, 32); } }
        { const bool up = (C.lane & 16) != 0;
#pragma unroll
          for (int i = 0; i < 4; ++i) { const float snd = up ? r8[i] : r8[i + 4], kp = up ? r8[i + 4] : r8[i]; r4[i] = kp + __shfl_xor(snd, 16); } }
        { const bool up = (C.lane & 8) != 0;
#pragma unroll
          for (int i = 0; i < 2; ++i) { const float snd = up ? r4[i] : r4[i + 2], kp = up ? r4[i + 2] : r4[i]; r2v[i] = kp + __shfl_xor(snd, 8); } }
        { const bool up = (C.lane & 4) != 0; const float snd = up ? r2v[0] : r2v[1], kp = up ? r2v[1] : r2v[0]; r1 = kp + __shfl_xor(snd, 4); }
        r1 += __shfl_xor(r1, 2); r1 += __shfl_xor(r1, 1);
        if ((C.lane & 3) == 0) { const float z = r1 * rstd + bfh; LOGF[(size_t)m * 16 + ((C.lane >> 2) & 15)] = (fminf(z, 0.f) - log1pf(__expf(-fabsf(z)))) * LOG2E; }
#pragma unroll
        for (int j = 0; j < 4; ++j) { xc[j] = xn[j]; y0c[j] = y0n[j]; y1c[j] = y1n[j]; y2c[j] = y2n[j]; y3c[j] = y3n[j]; }
        s_cur = s_nxt; g_cur = g_nxt; s_nxt = s_nn; g_nxt = g_nn;
    }
#undef R2_LOADRAW
}
__device__ __forceinline__ void fcum_scan(const Ctx& C) {
    const float* LOGF = (const float*)(C.ws + SM_LOGF); float* FC = (float*)(C.ws + SM_FCUM);
    LAS float* wtot = (LAS float*)(C.lds + BLK_OFF);
    for (int sq = C.vcu; sq < 128; sq += C.G) { const int b = sq >> 4, h = sq & 15;
        const float* src = LOGF + ((size_t)b * 4096 + C.tid * 8) * 16 + h; float* dst = FC + (size_t)sq * 4096 + C.tid * 8;
        float v[8]; float tot = 0.f;
#pragma unroll
        for (int i = 0; i < 8; ++i) { v[i] = src[i * 16]; }
#pragma unroll
        for (int i = 0; i < 8; ++i) { tot += v[i]; v[i] = tot; }
        float inc = tot;
#pragma unroll
        for (int o = 1; o < 64; o <<= 1) { const float t = __shfl_up(inc, o); if (C.lane >= o) inc += t; }
        __syncthreads();
        if (C.lane == 63) wtot[C.wave] = inc;
        __syncthreads();
        float carry = inc - tot;
        for (int w8 = 0; w8 < C.wave; ++w8) carry += wtot[w8];
#pragma unroll
        for (int i = 0; i < 8; ++i) dst[i] = v[i] + carry;
    }
}
__device__ __forceinline__ void r3_final(const Ctx& C, const Args& a, float* XD) {
    const bf16* XS = (const bf16*)(C.ws + WS_XS); const bf16* Y = (const bf16*)(C.ws + WS_Y);
    const float* ADA1 = (const float*)(C.ws + SM_ADA) + (size_t)8 * 6144;
    const int* SLOT = (const int*)(C.ws + SM_SLOT); const float* TOPG = (const float*)(C.ws + SM_TOPG);
    const f32x4* fg4 = (const f32x4*)a.in[IN_FNG] + C.lane;
    const int gw = C.vcu * NWAVES + C.wave, NGW = C.G * NWAVES;
#define R3_LOADRAW(XR, Y0, Y1, Y2, Y3, MM, SS) do { const xs4_t* xr_ = (const xs4_t*)(XS + (size_t)(MM) * D) + C.lane; \
        const yraw4_t* z0_ = Y_ROWPTR(Y, (SS)[0]); const yraw4_t* z1_ = Y_ROWPTR(Y, (SS)[1]); \
        const yraw4_t* z2_ = Y_ROWPTR(Y, (SS)[2]); const yraw4_t* z3_ = Y_ROWPTR(Y, (SS)[3]); \
        _Pragma("unroll") for (int j = 0; j < 4; ++j) { if (NT_ROWS) { XR[j] = __builtin_nontemporal_load(xr_ + 64 * j); Y0[j] = __builtin_nontemporal_load(z0_ + 64 * j); Y1[j] = __builtin_nontemporal_load(z1_ + 64 * j); Y2[j] = __builtin_nontemporal_load(z2_ + 64 * j); Y3[j] = __builtin_nontemporal_load(z3_ + 64 * j); } else { XR[j] = xr_[64 * j]; Y0[j] = z0_[64 * j]; Y1[j] = z1_[64 * j]; Y2[j] = z2_[64 * j]; Y3[j] = z3_[64 * j]; } } } while (0)
    xs4_t xc[4], xn[4]; yraw4_t y0c[4], y1c[4], y2c[4], y3c[4], y0n[4], y1n[4], y2n[4], y3n[4];
    i32x4v s_cur = *(const i32x4v*)(SLOT + (size_t)gw * 4); f32x4 g_cur = *(const f32x4*)(TOPG + (size_t)gw * 4);
    i32x4v s_nxt = s_cur; f32x4 g_nxt = g_cur;
    if (gw + NGW < T) { s_nxt = *(const i32x4v*)(SLOT + (size_t)(gw + NGW) * 4); g_nxt = *(const f32x4*)(TOPG + (size_t)(gw + NGW) * 4); }
    R3_LOADRAW(xc, y0c, y1c, y2c, y3c, gw, s_cur);
    for (int m = gw; m < T; m += NGW) { const int b = m >> 12;
        const int mn = m + NGW, mnn = m + 2 * NGW;
        i32x4v s_nn = s_nxt; f32x4 g_nn = g_nxt;
        if (mnn < T) { s_nn = *(const i32x4v*)(SLOT + (size_t)mnn * 4); g_nn = *(const f32x4*)(TOPG + (size_t)mnn * 4); }
        if (mn < T) R3_LOADRAW(xn, y0n, y1n, y2n, y3n, mn, s_nxt);
        const f32x4* gf4 = (const f32x4*)(ADA1 + (size_t)b * 6144 + 5 * 1024) + C.lane;
        f32x4* xw = (f32x4*)(XD + (size_t)m * D) + C.lane;
        f32x4 v[4]; float s = 0.f;
#pragma unroll
        for (int j = 0; j < 4; ++j) {
            const f32x4 ys = y4_to_f32(y0c[j]) * g_cur[0] + y4_to_f32(y1c[j]) * g_cur[1] + y4_to_f32(y2c[j]) * g_cur[2] + y4_to_f32(y3c[j]) * g_cur[3];
            v[j] = xs4_to_f32(xc[j]) + gf4[64 * j] * ys; s += (v[j].x * v[j].x + v[j].y * v[j].y) + (v[j].z * v[j].z + v[j].w * v[j].w); }
        const float rstd = 1.f / sqrtf(wave_sum(s) * (1.f / D) + RMS_EPS);
#pragma unroll
        for (int j = 0; j < 4; ++j) xw[64 * j] = v[j] * rstd * fg4[64 * j];
#pragma unroll
        for (int j = 0; j < 4; ++j) { xc[j] = xn[j]; y0c[j] = y0n[j]; y1c[j] = y1n[j]; y2c[j] = y2n[j]; y3c[j] = y3n[j]; }
        s_cur = s_nxt; g_cur = g_nxt; s_nxt = s_nn; g_nxt = g_nn;
    }
#undef R3_LOADRAW
}

constexpr int N_PHASES = 19;
__global__ void __launch_bounds__(NWAVES * 64, 2) yoco_fwd(Args args) {
    extern __shared__ __attribute__((aligned(16))) unsigned char lds[];
    Ctx C;
    C.lds = (LAS unsigned char*)lds; C.ws = args.ws;
    C.tid = threadIdx.x; C.lane = C.tid & 63; C.wave = __builtin_amdgcn_readfirstlane(C.tid >> 6);
    C.G = gridDim.x; { const int bx = blockIdx.x; C.vcu = (C.G % 8 == 0) ? (bx % 8) * (C.G / 8) + bx / 8 : bx; }
    volatile LAS unsigned* MISC = (volatile LAS unsigned*)(C.lds + MISC_OFF);
    if (C.tid < 64) MISC[C.tid] = 0u;
    __syncthreads();
    const int lo = args.ph_lo, hi = args.ph_hi;
    const bool one = (hi - lo) > 1;
    unsigned* ctl = (unsigned*)(args.ws + WS_CTL);
    XcdBarrier bar; bar.bar = ctl + CW_BAR; bar.x = 0; bar.st = nullptr;
    if (one) bar = xcd_barrier_post(ctl + CW_BAR, MISC + 8);
#define IN(k) (lo <= (k) && (k) < hi)
#define SEAM(k) do { if (IN(k) && IN((k) + 1)) xcd_barrier(bar); } while (0)
#define FRESH() do { int l_; asm volatile("v_mbcnt_lo_u32_b32 %0, -1, 0\n\tv_mbcnt_hi_u32_b32 %0, -1, %0" : "=v"(l_)); C.lane = l_; C.tid = C.wave * 64 + l_; } while (0)
#define REP(k) _Pragma("unroll") for (int rep_ = 0; rep_ < 1 + ((PROBE_DUP >> (k)) & 1); ++rep_)
    bf16* const Hb = (bf16*)(C.ws + WS_H);
    if (IN(0)) { FRESH(); REP(0) { p0_prologue(C, args); } SEAM(0); }
    if (IN(1)) { FRESH(); REP(1) { p1_rows0(C, args); } SEAM(1); }
    if (IN(2)) { FRESH();
#if PROBE_QKV
        { pg8::Gemm g{(const pg8::bf16_t*)(C.ws + WS_H8), (const pg8::bf16_t*)(C.ws + WS_WQKV), T, NQKV, D}; pg8::StaticOrder S; S.init(T, NQKV, C.G, (int)blockIdx.x);
#if PROBE_QKV == 1
          pg8::EpiQKV0 E{(pg8::bf16_t*)(C.ws + WS_QKV0), 0.015625f};
          pg8::gemm_phase<pg8::EpiQKV0, pg8::StaticOrder, true, true, 1>(C.lds + RING_OFF, g, S, E);
#elif PROBE_QKV == 2
          pg8::EpiQKV0Probe E{(pg8::bf16_t*)(C.ws + WS_XB), 0.015625f, 4};
          pg8::gemm_phase<pg8::EpiQKV0Probe, pg8::StaticOrder, true, true, 1>(C.lds + RING_OFF, g, S, E);
#else
          pg8::EpiNone E{(unsigned char*)(C.ws + WS_XB)};
          pg8::gemm_phase<pg8::EpiNone, pg8::StaticOrder, true, true, 1>(C.lds + RING_OFF, g, S, E);
#endif
        }
#endif
#if STAGGER_QKV
        { const unsigned long long t0 = __builtin_amdgcn_s_memrealtime(); const unsigned long long dl = (unsigned long long)(C.vcu & 7) * STAGGER_QKV;
          while (__builtin_amdgcn_s_memrealtime() - t0 < dl) __builtin_amdgcn_s_sleep(8); }
#endif
        REP(2) {
#if CONV_X0
        if ((int)blockIdx.x >= C.G - CONV_X0) { const int ci = (int)blockIdx.x - (C.G - CONV_X0);
            convert_weights<CONV_DEPTH>(C, args, 1, ci, CONV_X0); convert_weights<CONV_DEPTH>(C, args, 2, ci, CONV_X0); } else
#endif
        {
        pg8::Gemm g{QKV_FP8 ? (const pg8::bf16_t*)(C.ws + WS_H8) : (const pg8::bf16_t*)Hb, (const pg8::bf16_t*)(C.ws + WS_WQKV), T, NQKV, D}; pg8::StaticOrder S; S.init(T, NQKV, C.G - CONV_X0, (int)blockIdx.x);
#if BAND_FP8
#if QKV_WIDE
        pg8::EpiQKV08W E{(unsigned char*)(C.ws + WS_QKV0), QKV_FP8 ? 0.015625f : 1.f};
        pg8::gemm_phase<pg8::EpiQKV08W, pg8::StaticOrder, true, true, QKV_FP8 ? 1 : 2, false, 1>(C.lds + RING_OFF, g, S, E);
#else
        pg8::EpiQKV08 E{(unsigned char*)(C.ws + WS_QKV0), QKV_FP8 ? 0.015625f : 1.f};
        pg8::gemm_phase<pg8::EpiQKV08, pg8::StaticOrder, true, true, QKV_FP8 ? 1 : 2>(C.lds + RING_OFF, g, S, E);
#endif
#else
        pg8::EpiQKV0 E{(pg8::bf16_t*)(C.ws + WS_QKV0), QKV_FP8 ? 0.015625f : 1.f};
        pg8::gemm_phase<pg8::EpiQKV0, pg8::StaticOrder, true, true, QKV_FP8 ? 1 : 2>(C.lds + RING_OFF, g, S, E);
#endif
        } } SEAM(2);
    }
    if (IN(3)) { FRESH(); REP(3) { p3_dilated(C); } SEAM(3); }
    if (IN(4)) { FRESH(); REP(4) { p4_merge(C); } SEAM(4); }
    if (IN(5)) { FRESH(); REP(5) {
        pg8::Gemm g{(const pg8::bf16_t*)(C.ws + WS_O), (const pg8::bf16_t*)(C.ws + WS_WO0), T, D, D}; pg8::StaticOrder S; S.init(T, D, C.G, (int)blockIdx.x);
        pg8::EpiResid<false> E{args.in[IN_X], (pg8::bf16_t*)(C.ws + WS_XS), (const float*)(C.ws + SM_ADA) + 2 * 1024, WO_FP8 ? 0.015625f : 1.f};
        pg8::gemm_phase<pg8::EpiResid<false>, pg8::StaticOrder, true, true, WO_FP8 ? 1 : 2>(C.lds + RING_OFF, g, S, E);
        } SEAM(5);
    }
    if (IN(6)) { FRESH(); REP(6) { r1_router(C, args, 0); } SEAM(6); }
    if (IN(7)) { FRESH(); REP(7) { p7_route(C); } SEAM(7); }
    if (IN(8)) { FRESH();
#if PROBE_GU
        { const int nt = load_tile_table(C);
          pg8::Gemm g{(const pg8::bf16_t*)(C.ws + WS_H8), (const pg8::bf16_t*)(C.ws + WS_WGU), MAXROWS, 32 * 2048, D, (const int*)(C.ws + SM_TOKSLOT)};
          pg8::MoeOrder<8> S{(const LAS int*)(C.lds + BLK_OFF) + BL_TILE, nt, (int)blockIdx.x, C.G};
#if PROBE_GU == 1
          pg8::EpiSwiGLU8 E{(unsigned char*)(C.ws + WS_XB), args.in[IN_BGU]};
          pg8::gemm_phase<pg8::EpiSwiGLU8, pg8::MoeOrder<8>, true, true, 1, true>(C.lds + RING_OFF, g, S, E);
#elif PROBE_GU == 6
          { pg8::MoeOrderProbe S2{(const LAS int*)(C.lds + BLK_OFF) + BL_TILE, nt, (int)blockIdx.x, C.G};
            pg8::EpiProbeGU<2> E{(unsigned char*)(C.ws + WS_XB), args.in[IN_BGU]};
            pg8::gemm_phase<pg8::EpiProbeGU<2>, pg8::MoeOrderProbe, true, true, 1, true>(C.lds + RING_OFF, g, S2, E); }
#else
          pg8::EpiProbeGU<PROBE_GU - 2> E{(unsigned char*)(C.ws + WS_XB), args.in[IN_BGU]};
          pg8::gemm_phase<pg8::EpiProbeGU<PROBE_GU - 2>, pg8::MoeOrder<8>, true, true, 1, true>(C.lds + RING_OFF, g, S, E);
#endif
        }
#endif
        REP(8) {
        const int nt = load_tile_table(C);
        pg8::Gemm g{(const pg8::bf16_t*)(C.ws + (MOE_GATHER ? WS_H8 : WS_XB)), (const pg8::bf16_t*)(C.ws + WS_WGU), MAXROWS, 32 * 2048, D, (const int*)(C.ws + SM_TOKSLOT)};
        pg8::MoeOrder<8> S{(const LAS int*)(C.lds + BLK_OFF) + BL_TILE, nt, (int)blockIdx.x, C.G};
        pg8::EpiSwiGLU8 E{(unsigned char*)(C.ws + WS_ACT), args.in[IN_BGU]};
        pg8::gemm_phase<pg8::EpiSwiGLU8, pg8::MoeOrder<8>, true, true, 1, MOE_GATHER != 0>(C.lds + RING_OFF, g, S, E);
        } SEAM(8);
    }
    if (IN(9)) { FRESH(); REP(9) {
        const int nt = load_tile_table(C);
        pg8::Gemm g{(const pg8::bf16_t*)(C.ws + WS_ACT), (const pg8::bf16_t*)(C.ws + WS_WDN), MAXROWS, 32 * 1024, D};
        pg8::MoeOrder<4> S{(const LAS int*)(C.lds + BLK_OFF) + BL_TILE, nt, (int)blockIdx.x, C.G};
        pg8::EpiDown8 E{(pg8::bf16_t*)(C.ws + WS_Y), args.in[IN_BDN]};
        pg8::gemm_phase<pg8::EpiDown8, pg8::MoeOrder<4>, true, true, 1>(C.lds + RING_OFF, g, S, E);
        } SEAM(9);
    }
    if (IN(10)) { FRESH(); r2_seam(C, args); SEAM(10); }
    if (IN(11)) { FRESH(); REP(11) {
        fcum_scan(C);
        pg8::Gemm g{(const pg8::bf16_t*)(C.ws + WS_HKV), (const pg8::bf16_t*)(C.ws + WS_WKV), T, 3072, D}; pg8::KVQOrder S; S.init(T, 3072, C.G, (int)blockIdx.x);
        pg8::EpiKVQ E{(pg8::bf16_t*)(C.ws + WS_QKV1), KVQ_FP8 ? 0.015625f : 1.f, (unsigned*)(C.ws + WS_CTL) + CW_NRM};
        pg8::gemm_phase<pg8::EpiKVQ, pg8::KVQOrder, true, true, KVQ_FP8 ? 1 : 2>(C.lds + RING_OFF, g, S, E);
        } SEAM(11);
    }
    if (IN(12)) { FRESH(); if (PROBE_FOX == 2) p12_fox<2>(C, WS_OG, args); REP(12) { p12_fox<1>(C, WS_O, args); } SEAM(12); }
    if (IN(13)) { FRESH(); REP(13) {
        pg8::Gemm g{(const pg8::bf16_t*)(C.ws + WS_O), (const pg8::bf16_t*)(C.ws + WS_WO1), T, D, D}; pg8::StaticOrder S; S.init(T, D, C.G, (int)blockIdx.x);
        pg8::EpiResid<true> E{C.ws + WS_XS, (pg8::bf16_t*)(C.ws + WS_XS), (const float*)(C.ws + SM_ADA) + (size_t)8 * 6144 + 2 * 1024, WO_FP8 ? 0.015625f : 1.f};
        pg8::gemm_phase<pg8::EpiResid<true>, pg8::StaticOrder, true, true, WO_FP8 ? 1 : 2>(C.lds + RING_OFF, g, S, E);
        } SEAM(13);
    }
    if (IN(14)) { FRESH(); REP(14) { r1_router(C, args, 1); } SEAM(14); }
    if (IN(15)) { FRESH(); REP(15) { p7_route(C); } SEAM(15); }
    if (IN(16)) { FRESH();
#if PROBE_LATE_QKV
        { pg8::Gemm g{(const pg8::bf16_t*)(C.ws + WS_ACT), (const pg8::bf16_t*)(C.ws + WS_WQKV), T, NQKV, D}; pg8::StaticOrder S; S.init(T, NQKV, C.G, (int)blockIdx.x);
          pg8::EpiNone E{(unsigned char*)(C.ws + WS_XB)};
          pg8::gemm_phase<pg8::EpiNone, pg8::StaticOrder, true, true, 1>(C.lds + RING_OFF, g, S, E); }
#endif
        REP(16) {
        const int nt = load_tile_table(C);
        pg8::Gemm g{(const pg8::bf16_t*)(C.ws + (MOE_GATHER ? WS_H8 : WS_XB)), (const pg8::bf16_t*)(C.ws + WS_WGU + (size_t)32 * 2048 * D), MAXROWS, 32 * 2048, D, (const int*)(C.ws + SM_TOKSLOT)};
        pg8::MoeOrder<8> S{(const LAS int*)(C.lds + BLK_OFF) + BL_TILE, nt, (int)blockIdx.x, C.G};
        pg8::EpiSwiGLU8 E{(unsigned char*)(C.ws + WS_ACT), args.in[IN_BGU] + 32 * 2048};
        pg8::gemm_phase<pg8::EpiSwiGLU8, pg8::MoeOrder<8>, true, true, 1, MOE_GATHER != 0>(C.lds + RING_OFF, g, S, E);
        } SEAM(16);
    }
    if (IN(17)) { FRESH(); REP(17) {
        const int nt = load_tile_table(C);
        pg8::Gemm g{(const pg8::bf16_t*)(C.ws + WS_ACT), (const pg8::bf16_t*)(C.ws + WS_WDN + (size_t)32 * 1024 * D), MAXROWS, 32 * 1024, D};
        pg8::MoeOrder<4> S{(const LAS int*)(C.lds + BLK_OFF) + BL_TILE, nt, (int)blockIdx.x, C.G};
        pg8::EpiDown8 E{(pg8::bf16_t*)(C.ws + WS_Y), args.in[IN_BDN] + 32 * 1024};
        pg8::gemm_phase<pg8::EpiDown8, pg8::MoeOrder<4>, true, true, 1>(C.lds + RING_OFF, g, S, E);
        } SEAM(17);
    }
    if (IN(18)) { FRESH(); r3_final(C, args, args.out); }
#undef IN
#undef SEAM
}

extern "C" void kernel_launch(void* const* d_in, const int* in_sizes, int n_in, void* d_out, int out_size, void* d_ws, size_t ws_size, hipStream_t stream) {
    static int grid = 0;
    if (grid == 0) {
        if (n_in != 21 || in_sizes[0] != T * D || out_size != T * D || ws_size < WS_END) { fprintf(stderr, "kernel_launch: unexpected shapes (n_in %d, in0 %d, out %d, ws %zu)\n", n_in, n_in > 0 ? in_sizes[0] : -1, out_size, ws_size); grid = -1; return; }
        int dev = 0, cus = 0, per_cu = 0;
        if (hipGetDevice(&dev) != hipSuccess || hipDeviceGetAttribute(&cus, hipDeviceAttributeMultiprocessorCount, dev) != hipSuccess) { grid = -1; return; }
        if (hipFuncSetAttribute((const void*)yoco_fwd, hipFuncAttributeMaxDynamicSharedMemorySize, LDS_BYTES) != hipSuccess) { fprintf(stderr, "kernel_launch: hipFuncSetAttribute failed\n"); grid = -1; return; }
        if (hipOccupancyMaxActiveBlocksPerMultiprocessor(&per_cu, (const void*)yoco_fwd, NWAVES * 64, LDS_BYTES) != hipSuccess || per_cu < 1) { fprintf(stderr, "kernel_launch: occupancy query reports %d blocks per CU\n", per_cu); }
        (void)hipGetLastError();
        grid = cus;
    }
    if (grid < 0) return;
    (void)hipMemsetAsync((char*)d_ws + WS_CTL, 0, CTL_ZERO_BYTES, stream);
    Args a{};
    for (int i = 0; i < 21; ++i) a.in[i] = (const float*)d_in[i];
    a.out = (float*)d_out; a.ws = (unsigned char*)d_ws;
#if MK_ONE_LAUNCH
    a.ph_lo = 0; a.ph_hi = N_PHASES;
    hipLaunchKernelGGL(yoco_fwd, dim3(grid), dim3(NWAVES * 64), LDS_BYTES, stream, a);
#else
    for (int p = 0; p < N_PHASES; ++p) { a.ph_lo = p; a.ph_hi = p + 1; hipLaunchKernelGGL(yoco_fwd, dim3(grid), dim3(NWAVES * 64), LDS_BYTES, stream, a); }
#endif
}
```

```cpp
#include <hip/hip_runtime.h>
#include <hip/hip_bf16.h>
#include <cstdio>
#include <cstdint>
#include <cmath>
#ifndef MK_ONE_LAUNCH
#define MK_ONE_LAUNCH 1
#endif
#ifndef PROBE_DUP
#define PROBE_DUP 0
#endif
#ifndef PG8_F8_SCALED
#define PG8_F8_SCALED 0
#endif
#ifndef QKV_FP8
#define QKV_FP8 1
#endif
#ifndef KVQ_FP8
#define KVQ_FP8 1
#endif
#ifndef PROBE_EPI
#define PROBE_EPI 0
#endif
#ifndef PROBE_FOX
#define PROBE_FOX 0
#endif
#ifndef PROBE_SANITIZE
#define PROBE_SANITIZE 0
#endif
#ifndef PROBE_BAND
#define PROBE_BAND 0
#endif
#ifndef Y_FP8
#define Y_FP8 1
#endif
#ifndef WO_FP8
#define WO_FP8 1
#endif
#ifndef MOE_GATHER
#define MOE_GATHER 1
#endif
#ifndef PROBE_QKV
#define PROBE_QKV 0
#endif
#ifndef PROBE_GU
#define PROBE_GU 0
#endif
#ifndef STAGGER_QKV
#define STAGGER_QKV 0
#endif
#ifndef NT_STORE
#define NT_STORE 0
#endif
#ifndef RELAX_STORES
#define RELAX_STORES 0
#endif
#ifndef PROBE_LATE_QKV
#define PROBE_LATE_QKV 0
#endif
#ifndef NT_P0
#define NT_P0 1
#endif
#ifndef NT_ROWS
#define NT_ROWS 1
#endif
#ifndef NT_P0ST
#define NT_P0ST 0
#endif
#ifndef DEFER_L1W
#define DEFER_L1W 0
#endif
#ifndef BAND_FP8
#define BAND_FP8 1
#endif
#ifndef QKV_WIDE
#define QKV_WIDE 1
#endif
#ifndef CONV_X0
#define CONV_X0 0
#endif
#ifndef CONV_X1
#define CONV_X1 40
#endif
#ifndef CONV_DEPTH
#define CONV_DEPTH 5
#endif
#ifndef OG_FP8
#define OG_FP8 1
#endif
namespace pg8 {
#define PG8_LAS __attribute__((address_space(3)))
typedef unsigned short bf16_t;
typedef short bf16x8 __attribute__((ext_vector_type(8)));
typedef float f32x4 __attribute__((ext_vector_type(4)));
typedef unsigned u32x4 __attribute__((ext_vector_type(4)));
constexpr int BM = 256, BK = 64, HALF = 128, HTB = HALF * BK * 2  , STAGE_BYTES = 8 * HTB, NXCD = 8, WGM = 8;

__host__ __device__ __forceinline__ int lds_byte(int r, int c) { const int st = (r >> 4) * 2 + (c >> 5), rr = r & 15, cc = c & 31, ob = rr * 64 + cc * 2; return st * 1024 + (ob ^ (((ob >> 9) & 1) << 5)); }
__host__ __device__ __forceinline__ void stage_rc(int b, int& R, int& C) { const int st = b / 1024, sb = b % 1024, swz = sb ^ (((sb >> 9) & 1) << 5); R = (st >> 1) * 16 + swz / 64; C = (st & 1) * 32 + (swz % 64) / 2; }
__host__ __device__ __forceinline__ int perm32(int rho) { const int n = rho >> 4, i = rho & 15; return 8 * (i >> 2) + 4 * n + (i & 3); }

struct Unit { int pm, pn; };
struct Gemm { const bf16_t* A; const bf16_t* Bt; int M, N, K; const int* rows = nullptr; };

struct StaticOrder {
    int nM, nN, nwg, G, c;
    __host__ __device__ void init(int M, int N, int G_, int c_) { nM = M / BM; nN = N / BM; nwg = nM * nN; G = G_; c = c_; }
    __host__ __device__ bool next(int i, Unit& u) const {
        const long L = (long)i * G + c; if (L >= nwg) return false;
        int wgid = (int)L; { const int q = nwg / NXCD, r = nwg % NXCD, xcd = wgid % NXCD, off = wgid / NXCD; wgid = (xcd < r ? xcd * (q + 1) : r * (q + 1) + (xcd - r) * q) + off; }
        const int nig = WGM * nN, gid = wgid / nig, fm = gid * WGM, gsz = (nM - fm) < WGM ? (nM - fm) : WGM;
        u.pm = fm + ((wgid % nig) % gsz); u.pn = (wgid % nig) / gsz; return true;
    }
    __device__ __forceinline__ void a_ready(const Unit&) const {}
    __device__ __forceinline__ void done(const Unit&) const {}
};
__device__ __forceinline__ unsigned cvt_pk_bf16(float lo, float hi) { unsigned r; asm volatile("v_cvt_pk_bf16_f32 %0, %1, %2" : "=v"(r) : "v"(lo), "v"(hi)); return r; }
typedef float f32x2 __attribute__((ext_vector_type(2)));
typedef int i32x8 __attribute__((ext_vector_type(8))); typedef int i32x4p __attribute__((ext_vector_type(4)));
#ifndef PG8_F8_SCALE
#define PG8_F8_SCALE 0x7f7f7f7f
#endif
__device__ __forceinline__ i32x8 pg8_cat(bf16x8 lo, bf16x8 hi) { const i32x4p a = __builtin_bit_cast(i32x4p, lo), b = __builtin_bit_cast(i32x4p, hi); return (i32x8){a.x, a.y, a.z, a.w, b.x, b.y, b.z, b.w}; }
#if PG8_F8_SCALED
__device__ __forceinline__ void pg8_mma8(f32x4& acc, i32x8 b, i32x8 a) { asm volatile("v_mfma_scale_f32_16x16x128_f8f6f4 %0, %1, %2, %0, %3, %3 op_sel_hi:[0,0,0]" : "+v"(acc) : "v"(b), "v"(a), "v"(0x7f7f7f7f)); }
#else
__device__ __forceinline__ void pg8_mma8(f32x4& acc, i32x8 b, i32x8 a) { asm volatile("v_mfma_f32_16x16x128_f8f6f4 %0, %1, %2, %0" : "+v"(acc) : "v"(b), "v"(a)); }
#endif
__device__ __forceinline__ void pg8_mma16(f32x4& acc, bf16x8 b, bf16x8 a) { asm volatile("v_mfma_f32_16x16x32_bf16 %0, %1, %2, %0" : "+v"(acc) : "v"(b), "v"(a)); }
template <class Epi, class Sched, bool ALIGN_EPI = false, bool SP2 = false, int ES = 2  , bool GATHER = false  , int BMAP = 0  >
__device__ __forceinline__ void gemm_phase(PG8_LAS unsigned char* lds, const Gemm g, const Sched& S, const Epi& E) {
    const int tid = threadIdx.x, wid = __builtin_amdgcn_readfirstlane(tid >> 6), lane = tid & 63, wr = wid >> 2, wc = wid & 3, fr = lane & 15, fq = lane >> 4;
    const int K = g.K * ES / 2  , nt = K / BK;
    unsigned voffA[2], voffB[2];
#pragma unroll
    for (int i = 0; i < 2; ++i) { int R, C; stage_rc(tid * 16 + i * 8192, R, C); const int Rb = BMAP == 1 ? ((R >> 5) * 64 + 16 * ((R & 15) >> 2) + 4 * ((R >> 4) & 1) + (R & 3)) : (Epi::PERM ? ((R & ~31) + perm32(R & 31)) : R);
        voffA[i] = (unsigned)(R * K + C) * 2u; voffB[i] = (unsigned)(Rb * K + C) * 2u; }
    const size_t kstep = (size_t)(BK * 2);
    const size_t hstep = (size_t)HALF * K * 2;
    const size_t tstep = 2 * hstep;
    const size_t hstepB = BMAP == 1 ? (size_t)8 * K * 2 : hstep;
    const size_t hstepA = GATHER ? 0 : hstep;
    unsigned cG0[2] = {voffA[0], voffA[1]}, cG1[2] = {voffA[0], voffA[1]}, nG0[2] = {voffA[0], voffA[1]}, nG1[2] = {voffA[0], voffA[1]};
#define PG8_GROWS(G0, G1, PM) do { if constexpr (GATHER) { _Pragma("unroll") for (int i_ = 0; i_ < 2; ++i_) { int R_, C_; stage_rc(tid * 16 + i_ * 8192, R_, C_); \
        const int* rp_ = g.rows + (size_t)(PM) * 256 + R_; G0[i_] = (unsigned)rp_[0] * (unsigned)(K * 2) + (unsigned)(C_ * 2); G1[i_] = (unsigned)rp_[128] * (unsigned)(K * 2) + (unsigned)(C_ * 2); } } } while (0)
    const unsigned ldsw = (unsigned)wid * 1024u;
    const int aoff = lds_byte(wr * 64 + fr, fq * 8), boff = lds_byte(wc * 32 + fr, fq * 8);
#define PG8_SA(b, h) (((b) * 2 + (h)) * HTB)
#define PG8_SB(b, h) ((4 + (b) * 2 + (h)) * HTB)
#define PG8_STAGE(bufoff, gbase, voff) do { _Pragma("unroll") for (int _i = 0; _i < 2; ++_i) \
        __builtin_amdgcn_global_load_lds((const unsigned*)((const char*)(gbase) + (voff)[_i]), (PG8_LAS unsigned*)(lds + (bufoff) + ldsw + _i * 8192), 16, 0, 0); } while (0)
#define PG8_LDA(dst, b, h) do { _Pragma("unroll") for (int m = 0; m < 4; ++m) _Pragma("unroll") for (int k = 0; k < 2; ++k) dst[m][k] = *(const PG8_LAS bf16x8*)(lds + PG8_SA(b, h) + aoff + m * 2048 + k * 1024); } while (0)
#define PG8_LDB(dst, b, h) do { _Pragma("unroll") for (int n = 0; n < 2; ++n) _Pragma("unroll") for (int k = 0; k < 2; ++k) dst[n][k] = *(const PG8_LAS bf16x8*)(lds + PG8_SB(b, h) + boff + n * 2048 + k * 1024); } while (0)
#define PG8_MMA(ai, bj, At, Bt) do { __builtin_amdgcn_s_setprio(1); _Pragma("unroll") for (int m = 0; m < 4; ++m) _Pragma("unroll") for (int n = 0; n < 2; ++n) { \
        if constexpr (ES == 2) { _Pragma("unroll") for (int k = 0; k < 2; ++k) acc[ai][bj][m][n] = __builtin_amdgcn_mfma_f32_16x16x32_bf16(Bt[n][k], At[m][k], acc[ai][bj][m][n], 0, 0, 0); } \
        else { pg8_mma8(acc[ai][bj][m][n], pg8_cat(Bt[n][0], Bt[n][1]), pg8_cat(At[m][0], At[m][1])); } } \
        __builtin_amdgcn_s_setprio(0); } while (0)
#define PG8_WAIT_V(n) asm volatile("s_waitcnt vmcnt(" #n ")" ::: "memory")
#define PG8_WAIT_L(n) asm volatile("s_waitcnt lgkmcnt(" #n ")" ::: "memory")
#define PG8_WAIT_V8R do { if (relax_st) { if constexpr (Epi::NSTORE == 16) asm volatile("s_waitcnt vmcnt(24)" ::: "memory"); else if constexpr (Epi::NSTORE == 8) asm volatile("s_waitcnt vmcnt(16)" ::: "memory"); else asm volatile("s_waitcnt vmcnt(8)" ::: "memory"); } \
        else asm volatile("s_waitcnt vmcnt(8)" ::: "memory"); } while (0)
#define PG8_BAR __builtin_amdgcn_s_barrier()
#define PG8_SCHED __builtin_amdgcn_sched_barrier(0)
    Unit cur, nxt; int ui = 0;
    if (!S.next(0, cur)) return;
    f32x4 acc[2][2][4][2];
#pragma unroll
    for (int a = 0; a < 2; ++a)
#pragma unroll
        for (int b = 0; b < 2; ++b)
#pragma unroll
            for (int m = 0; m < 4; ++m)
#pragma unroll
                for (int n = 0; n < 2; ++n) acc[a][b][m][n] = (f32x4){0.f, 0.f, 0.f, 0.f};
    bf16x8 At[4][2], B0[2][2], B1[2][2];
    const char* cA = (const char*)g.A + (GATHER ? (size_t)0 : (size_t)cur.pm * tstep); const char* cB = (const char*)g.Bt + (size_t)cur.pn * tstep;
    PG8_GROWS(cG0, cG1, cur.pm);
    S.a_ready(cur);
    if constexpr (SP2) {
        PG8_STAGE(PG8_SB(0, 0), cB, voffB); PG8_STAGE(PG8_SB(0, 1), cB + hstepB, voffB); PG8_STAGE(PG8_SA(0, 0), cA, cG0); PG8_STAGE(PG8_SA(0, 1), cA + hstepA, cG1);
        if (wr == 1) PG8_BAR;
        PG8_WAIT_V(2); PG8_BAR;
        PG8_STAGE(PG8_SB(1, 0), cB + kstep, voffB); PG8_STAGE(PG8_SA(1, 0), cA + kstep, cG0); PG8_STAGE(PG8_SB(1, 1), cB + hstepB + kstep, voffB);
        PG8_WAIT_V(6); PG8_BAR;
    } else {
        PG8_STAGE(PG8_SB(0, 0), cB, voffB); PG8_STAGE(PG8_SA(0, 0), cA, cG0); PG8_STAGE(PG8_SB(0, 1), cB + hstepB, voffB); PG8_STAGE(PG8_SA(0, 1), cA + hstepA, cG1);
        if (wr == 1) PG8_BAR;
        PG8_WAIT_V(4); PG8_BAR;
        PG8_STAGE(PG8_SB(1, 0), cB + kstep, voffB); PG8_STAGE(PG8_SA(1, 0), cA + kstep, cG0); PG8_STAGE(PG8_SB(1, 1), cB + hstepB + kstep, voffB);
        PG8_WAIT_V(6); PG8_BAR;
    }
    for (;;) {
        const bool has_next = S.next(ui + 1, nxt);
        const char* nA = (has_next && !GATHER) ? (const char*)g.A + (size_t)nxt.pm * tstep : cA; const char* nB = has_next ? (const char*)g.Bt + (size_t)nxt.pn * tstep : cB;
        if (has_next) PG8_GROWS(nG0, nG1, nxt.pm); else { nG0[0] = cG0[0]; nG0[1] = cG0[1]; nG1[0] = cG1[0]; nG1[1] = cG1[1]; }
#pragma unroll 1
        for (int t = 0; t < nt; t += 2) {
            const bool last = (t == nt - 2);
            const bool relax_st = RELAX_STORES && (t == 0) && (ui > 0);
            const char* a1 = cA + (size_t)(t + 1) * kstep;
            const char* a2 = last ? nA : cA + (size_t)(t + 2) * kstep; const char* b2 = last ? nB : cB + (size_t)(t + 2) * kstep;
            const char* a3 = a2 + kstep; const char* b3 = b2 + kstep;
            if (last && has_next) S.a_ready(nxt);
            const unsigned s0[2] = {last ? nG0[0] : cG0[0], last ? nG0[1] : cG0[1]}, s1[2] = {last ? nG1[0] : cG1[0], last ? nG1[1] : cG1[1]};
            if constexpr (SP2) {
            PG8_LDB(B0, 0, 0); PG8_LDB(B1, 0, 1); PG8_SCHED; PG8_LDA(At, 0, 0); PG8_STAGE(PG8_SA(1, 1), a1 + hstepA, cG1);
            PG8_WAIT_V8R; PG8_WAIT_L(0); PG8_BAR; PG8_MMA(0, 0, At, B0); PG8_MMA(0, 1, At, B1); PG8_BAR; PG8_SCHED;
            PG8_LDA(At, 0, 1); PG8_STAGE(PG8_SB(0, 0), b2, voffB); PG8_STAGE(PG8_SB(0, 1), b2 + hstepB, voffB); PG8_STAGE(PG8_SA(0, 0), a2, s0);
            PG8_WAIT_V8R; PG8_WAIT_L(0); PG8_BAR; PG8_MMA(1, 0, At, B0); PG8_MMA(1, 1, At, B1); PG8_BAR; PG8_SCHED;
            PG8_LDB(B0, 1, 0); PG8_LDB(B1, 1, 1); PG8_SCHED; PG8_LDA(At, 1, 0); PG8_STAGE(PG8_SA(0, 1), a2 + hstepA, s1);
            PG8_WAIT_V(8); PG8_WAIT_L(0); PG8_BAR; PG8_MMA(0, 0, At, B0); PG8_MMA(0, 1, At, B1); PG8_BAR; PG8_SCHED;
            PG8_LDA(At, 1, 1); PG8_STAGE(PG8_SB(1, 0), b3, voffB); PG8_STAGE(PG8_SB(1, 1), b3 + hstepB, voffB); PG8_STAGE(PG8_SA(1, 0), a3, s0);
            PG8_WAIT_V(8); PG8_WAIT_L(0); PG8_BAR; PG8_MMA(1, 0, At, B0); PG8_MMA(1, 1, At, B1); PG8_BAR; PG8_SCHED;
            } else {
            PG8_LDB(B0, 0, 0); PG8_SCHED; PG8_LDA(At, 0, 0); PG8_STAGE(PG8_SA(1, 1), a1 + hstepA, cG1);
            PG8_WAIT_L(8); PG8_BAR; PG8_WAIT_L(0); PG8_MMA(0, 0, At, B0); PG8_BAR; PG8_SCHED;
            PG8_LDB(B1, 0, 1); PG8_STAGE(PG8_SB(0, 0), b2, voffB);
            PG8_BAR; PG8_WAIT_L(0); PG8_MMA(0, 1, At, B1); PG8_BAR;
            PG8_LDA(At, 0, 1); PG8_STAGE(PG8_SA(0, 0), a2, s0);
            PG8_BAR; PG8_WAIT_L(0); PG8_MMA(1, 0, At, B0); PG8_BAR; PG8_SCHED;
            PG8_STAGE(PG8_SB(0, 1), b2 + hstepB, voffB);
            PG8_WAIT_V(6); PG8_BAR; PG8_MMA(1, 1, At, B1); PG8_BAR;
            PG8_LDB(B0, 1, 0); PG8_SCHED; PG8_LDA(At, 1, 0); PG8_STAGE(PG8_SA(0, 1), a2 + hstepA, s1);
            PG8_WAIT_L(8); PG8_BAR; PG8_WAIT_L(0); PG8_MMA(0, 0, At, B0); PG8_BAR; PG8_SCHED;
            PG8_LDB(B1, 1, 1); PG8_STAGE(PG8_SB(1, 0), b3, voffB);
            PG8_BAR; PG8_WAIT_L(0); PG8_MMA(0, 1, At, B1); PG8_BAR;
            PG8_LDA(At, 1, 1); PG8_STAGE(PG8_SA(1, 0), a3, s0);
            PG8_BAR; PG8_WAIT_L(0); PG8_MMA(1, 0, At, B0); PG8_BAR; PG8_SCHED;
            PG8_STAGE(PG8_SB(1, 1), b3 + hstepB, voffB);
            PG8_WAIT_V(6); PG8_BAR; PG8_MMA(1, 1, At, B1); PG8_BAR;
            }
        }
        if constexpr (ES == 1) asm volatile("s_nop 15\n\ts_nop 15" ::: "memory");
        if constexpr (ALIGN_EPI) { if (wr == 0) PG8_BAR; }
        if constexpr (!Epi::AFTER_DRAIN) { E(acc, cur, wr, wc, fr, fq); S.done(cur); }
        if (!has_next) break;
#pragma unroll
        for (int a = 0; a < 2; ++a)
#pragma unroll
            for (int b = 0; b < 2; ++b)
#pragma unroll
                for (int m = 0; m < 4; ++m)
#pragma unroll
                    for (int n = 0; n < 2; ++n) acc[a][b][m][n] = (f32x4){0.f, 0.f, 0.f, 0.f};
        cur = nxt; cA = nA; cB = nB; ++ui; cG0[0] = nG0[0]; cG0[1] = nG0[1]; cG1[0] = nG1[0]; cG1[1] = nG1[1];
        if constexpr (ALIGN_EPI) { if (wr == 1) PG8_BAR; }
    }
    PG8_WAIT_V(0);
    if constexpr (!ALIGN_EPI) { if (wr == 0) PG8_BAR; }
    PG8_BAR;
    if constexpr (Epi::AFTER_DRAIN) { E.fused(acc, cur, wr, wc, fr, fq, lds, wid, lane); S.done(cur); }
#undef PG8_GROWS
#undef PG8_SA
#undef PG8_SB
#undef PG8_STAGE
#undef PG8_LDA
#undef PG8_LDB
#undef PG8_MMA
#undef PG8_WAIT_V
#undef PG8_WAIT_L
#undef PG8_WAIT_V8R
#undef PG8_BAR
#undef PG8_SCHED
}
}
namespace attn_body {
using bf16=__hip_bfloat16;
using bf16x8=__attribute__((ext_vector_type(8)))short;
using s16x4=__attribute__((ext_vector_type(4)))short;
using f32x16=__attribute__((ext_vector_type(16)))float;
using u32x4=__attribute__((ext_vector_type(4)))unsigned;
__device__ __forceinline__ int crow(int r,int hi){return (r&3)+8*(r>>2)+4*hi;}
#define SBAR() __builtin_amdgcn_sched_barrier(0)
__device__ __forceinline__ void glds16(const void*gsrc,unsigned lds_dst){unsigned keep;
  asm volatile("s_mov_b32 %0, m0\n\ts_mov_b32 m0, %2\n\ts_nop 0\n\tglobal_load_lds_dwordx4 %1, off\n\ts_mov_b32 m0, %0":"=&s"(keep):"v"(gsrc),"s"(lds_dst):"memory");}
__device__ __forceinline__ float max3f(float a,float b,float c){float r;asm("v_max3_f32 %0, %1, %2, %3":"=v"(r):"v"(a),"v"(b),"v"(c));return r;}
__device__ __forceinline__ float max2f(float a,float b){float r;asm("v_max_f32_e32 %0, %1, %2":"=v"(r):"v"(a),"v"(b));return r;}
__device__ __forceinline__ float fadd_s(float a,float b){float r;asm("v_add_f32_e32 %0, %1, %2":"=v"(r):"v"(a),"v"(b));return r;}
__device__ __forceinline__ float fsub_s(float a,float b){float r;asm("v_sub_f32_e32 %0, %1, %2":"=v"(r):"v"(a),"v"(b));return r;}
typedef float f32x2_t __attribute__((ext_vector_type(2))); typedef __bf16 bf16x2_t __attribute__((ext_vector_type(2)));
__device__ __forceinline__ unsigned cvtpk_s(float lo,float hi){f32x2_t v={lo,hi};bf16x2_t b=__builtin_convertvector(v,bf16x2_t);return __builtin_bit_cast(unsigned,b);}
#define WAIT_BAR(N) asm volatile("s_waitcnt vmcnt(" #N ") lgkmcnt(0)\n\ts_barrier":::"memory")
typedef __attribute__((address_space(3))) const char* lds_cptr;
typedef short v4i16_t __attribute__((ext_vector_type(4)));
__device__ __forceinline__ void kload8(bf16x8*kf,lds_cptr kp){
  kf[0]=*(const __attribute__((address_space(3))) bf16x8*)(kp);      kf[1]=*(const __attribute__((address_space(3))) bf16x8*)(kp+512);
  kf[2]=*(const __attribute__((address_space(3))) bf16x8*)(kp+2048); kf[3]=*(const __attribute__((address_space(3))) bf16x8*)(kp+2560);
  kf[4]=*(const __attribute__((address_space(3))) bf16x8*)(kp+4096); kf[5]=*(const __attribute__((address_space(3))) bf16x8*)(kp+4608);
  kf[6]=*(const __attribute__((address_space(3))) bf16x8*)(kp+6144); kf[7]=*(const __attribute__((address_space(3))) bf16x8*)(kp+6656);
}
__device__ __forceinline__ void kload2(bf16x8*kf,lds_cptr kp,int j){ kf[2*j]=*(const __attribute__((address_space(3))) bf16x8*)(kp+j*2048); kf[2*j+1]=*(const __attribute__((address_space(3))) bf16x8*)(kp+j*2048+512); }
__device__ __forceinline__ s16x4 vtr(lds_cptr p){ return __builtin_bit_cast(s16x4,__builtin_amdgcn_ds_read_tr16_b64_v4i16((__attribute__((address_space(3))) v4i16_t*)p)); }
__device__ __forceinline__ float rowmax(const f32x16&p0,const f32x16&p1){
  float a=max3f(p0[0],p0[1],p1[0]),b=max3f(p0[2],p0[3],p1[1]);a=max3f(a,p1[2],p1[3]);
  #pragma unroll
  for(int r=4;r<16;r+=4){a=max3f(a,p0[r],p0[r+1]);b=max3f(b,p0[r+2],p0[r+3]);a=max3f(a,p1[r],p1[r+1]);b=max3f(b,p1[r+2],p1[r+3]);}
  const float m=max2f(a,b);
  auto rr=__builtin_amdgcn_permlane32_swap(__float_as_uint(m),__float_as_uint(m),false,false);
  return max2f(__uint_as_float(rr[0]),__uint_as_float(rr[1]));
}
__device__ __forceinline__ void pv(f32x16*o,int vb,bf16x8 pa0,bf16x8 pa1,bf16x8 pa2,bf16x8 pa3){
  #pragma unroll
  for(int d0=0;d0<2;++d0){s16x4 lo[4],hi[4];
    #pragma unroll
    for(int ks=0;ks<4;++ks){
      asm volatile("ds_read_b64_tr_b16 %0,%1 offset:%c2":"=&v"(lo[ks]):"v"(vb),"i"(d0*4096+ks*1024):"memory");
      asm volatile("ds_read_b64_tr_b16 %0,%1 offset:%c2":"=&v"(hi[ks]):"v"(vb),"i"(d0*4096+ks*1024+512):"memory");}
    asm volatile("s_waitcnt lgkmcnt(0)":::"memory");SBAR();
    #define PK(k) (bf16x8){lo[k][0],lo[k][1],lo[k][2],lo[k][3],hi[k][0],hi[k][1],hi[k][2],hi[k][3]}
    o[d0]=__builtin_amdgcn_mfma_f32_32x32x16_bf16(pa0,PK(0),o[d0],0,0,0);
    o[d0]=__builtin_amdgcn_mfma_f32_32x32x16_bf16(pa1,PK(1),o[d0],0,0,0);
    o[d0]=__builtin_amdgcn_mfma_f32_32x32x16_bf16(pa2,PK(2),o[d0],0,0,0);
    o[d0]=__builtin_amdgcn_mfma_f32_32x32x16_bf16(pa3,PK(3),o[d0],0,0,0);
    #undef PK
  }
}
}

constexpr int BATCH = 8, SEQ = 4096, T = BATCH * SEQ, D = 1024, NE = 32, TOPK = 4, NH = 16, HD = 64;
constexpr int NQKV = 9216;
constexpr int MAXROWS = T * TOPK + NE * 256;
constexpr int MAXTILES = MAXROWS / 256;
constexpr int NVB = T / 128;
constexpr float LOG2E = 1.4426950408889634f;
constexpr float QSCALE = 0.125f * LOG2E;
constexpr float RMS_EPS = 1e-6f;
constexpr int NWAVES = 8;

constexpr size_t MiB = 1ull << 20;
constexpr size_t WS_CTL = 0, CTL_ZERO_BYTES = 1 * MiB;
constexpr size_t WS_SM = 1 * MiB;
constexpr size_t SM_ADA = WS_SM;
constexpr size_t SM_GM = WS_SM + 512 * 1024;
constexpr size_t SM_CSH = WS_SM + 640 * 1024;
constexpr size_t SM_BIAST = WS_SM + 644 * 1024;
constexpr size_t SM_BLKCNT = WS_SM + 704 * 1024;
constexpr size_t SM_TILEEXP = WS_SM + 768 * 1024;
constexpr size_t SM_TOPI = WS_SM + 1 * MiB;
constexpr size_t SM_TOPG = SM_TOPI + 512 * 1024;
constexpr size_t SM_RANK = SM_TOPG + 512 * 1024;
constexpr size_t SM_SLOT = SM_RANK + 512 * 1024;
constexpr size_t SM_TOKSLOT = WS_SM + 3 * MiB;
constexpr size_t SM_LOGF = WS_SM + 4 * MiB;
constexpr size_t SM_FCUM = WS_SM + 6 * MiB;
constexpr size_t SM_LSE = WS_SM + 8 * MiB;
constexpr size_t WS_WQKV = 16 * MiB, WS_WO0 = 34 * MiB, WS_WKV = 36 * MiB, WS_WQ = 40 * MiB, WS_WO1 = 42 * MiB, WS_WGU = 44 * MiB, WS_WDN = 300 * MiB;
constexpr size_t WS_HKV = 428 * MiB, WS_H = 492 * MiB, WS_OG = 556 * MiB, WS_O = 748 * MiB;
constexpr size_t WS_QKV0 = 812 * MiB, WS_ACT = 812 * MiB, WS_Y = 1084 * MiB, WS_QKV1 = 1388 * MiB, WS_XB = 1388 * MiB, WS_H8 = 1524 * MiB, WS_END = 1660 * MiB, WS_XS = WS_H;
static_assert(WS_H == WS_HKV + (size_t)T * D * 2, "H must follow HKV (KVQ GEMM addresses both through one A pointer)");
static_assert(WS_WQ == WS_WKV + (size_t)2048 * 1024 * 2, "Wq_t must follow Wkv_t");
static_assert(SM_LSE + (size_t)3 * T * 16 * 4 <= WS_WQKV, "small region");
static_assert(WS_Y + (size_t)MAXROWS * D * 2 <= WS_QKV1 && WS_XB + (size_t)MAXROWS * D * 2 <= WS_END && WS_QKV0 + (size_t)BATCH * 9 * 16 * SEQ * 64 * 2 <= WS_QKV1, "ws map");
constexpr int CW_TMO = 0, CW_BAR = 4096, CW_QUEUE = 65536  , CW_NRM = 131072  ;

constexpr int RING_OFF = 0, RING_BYTES = 131072;
constexpr int SCR_OFF = RING_BYTES, SCR_BYTES = 16384;
constexpr int BLK_OFF = SCR_OFF + SCR_BYTES, BLK_BYTES = 12288;
constexpr int MISC_OFF = BLK_OFF + BLK_BYTES;
constexpr int LDS_BYTES = MISC_OFF + 256;
constexpr int BL_TILE = 0, BL_WCNT = 576, BL_WBASE = 832, BL_PARTA = 1088, BL_PARTB = 1600, BL_TOT = 2112, BL_BASE = 2144, BL_PADS = 2176;

#define LAS __attribute__((address_space(3)))
#define GAS __attribute__((address_space(1)))
typedef unsigned short bf16;
typedef float f32x4 __attribute__((ext_vector_type(4)));
typedef unsigned u32x4v __attribute__((ext_vector_type(4)));
typedef unsigned u32x2v __attribute__((ext_vector_type(2)));
typedef int i32x4v __attribute__((ext_vector_type(4)));
#define LDS_WAIT() asm volatile("s_waitcnt lgkmcnt(0)" ::: "memory")
#define VM_WAIT() asm volatile("s_waitcnt vmcnt(0)" ::: "memory")

__device__ __forceinline__ float bf2f(unsigned v) { return __uint_as_float(v << 16); }
__device__ __forceinline__ unsigned pkbf(float lo, float hi) { return attn_body::cvtpk_s(lo, hi); }
__device__ __forceinline__ float wave_sum(float v) {
#pragma unroll
    for (int o = 1; o < 64; o <<= 1) v += __shfl_xor(v, o);
    return v;
}

namespace pg8 {
struct EpiQKV0 {
    static constexpr bool PERM = true, AFTER_DRAIN = false; static constexpr int NSTORE = 16;
    bf16_t* O; float mul;
    __device__ __forceinline__ void operator()(const f32x4 (&acc)[2][2][4][2], const Unit& u, int wr, int wc, int fr, int fq) const {
        _Pragma("unroll") for (int rep_e = 0; rep_e < 1 + ((PROBE_EPI >> 0) & 1); ++rep_e) {
        asm volatile("" : "+v"(fr), "+v"(fq));
        const int g = u.pn / 12, rem = u.pn - g * 12, which = rem >> 2, h0 = (rem & 3) * 4, sh = 2 * g;
        const float sc = (which == 0 ? QSCALE : 1.f) * mul;
#pragma unroll
        for (int ai = 0; ai < 2; ++ai)
#pragma unroll
            for (int m = 0; m < 4; ++m) {
                const int tok = u.pm * BM + ai * HALF + wr * 64 + m * 16 + fr, b = tok >> 12, s = tok & 4095;
                const int subrow = (s & ((1 << sh) - 1)) * (4096 >> sh) + (s >> sh);
#pragma unroll
                for (int bj = 0; bj < 2; ++bj) {
                    const int head = h0 + 2 * bj + (wc >> 1), dcol = (wc & 1) * 32 + 8 * fq;
                    const size_t plane = (size_t)(((b * 3 + g) * 3 + which) * 16 + head);
                    const f32x4 v0 = acc[ai][bj][m][0] * sc, v1 = acc[ai][bj][m][1] * sc;
                    u32x4 w; w.x = cvt_pk_bf16(v0[0], v0[1]); w.y = cvt_pk_bf16(v0[2], v0[3]); w.z = cvt_pk_bf16(v1[0], v1[1]); w.w = cvt_pk_bf16(v1[2], v1[3]);
#if NT_STORE
                    __builtin_nontemporal_store(w, (u32x4*)(O + (plane * 4096 + subrow) * 64 + dcol));
#else
                    *(u32x4*)(O + (plane * 4096 + subrow) * 64 + dcol) = w;
#endif
                }
            }
        }
    }
};
struct EpiQKV0Probe {
    static constexpr bool PERM = true, AFTER_DRAIN = false; static constexpr int NSTORE = 16;
    bf16_t* O; float mul; int wide;
    __device__ __forceinline__ void operator()(const f32x4 (&acc)[2][2][4][2], const Unit& u, int wr, int wc, int fr, int fq) const {
        asm volatile("" : "+v"(fr), "+v"(fq));
        const int g = u.pn / 12, rem = u.pn - g * 12, which = rem >> 2, h0 = (rem & 3) * 4, sh = 2 * g;
        const float sc = (which == 0 ? QSCALE : 1.f) * mul;
#pragma unroll
        for (int ai = 0; ai < 2; ++ai)
#pragma unroll
            for (int m = 0; m < 4; ++m) {
                const int tok = u.pm * BM + ai * HALF + wr * 64 + m * 16 + fr, b = tok >> 12, s = tok & 4095;
                const int subrow = (s & ((1 << sh) - 1)) * (4096 >> sh) + (s >> sh);
                const int head = h0 + wc, dcol = 16 * fq;
                const size_t plane = (size_t)(((b * 3 + g) * 3 + which) * 16 + head);
#pragma unroll
                for (int bj = 0; bj < 2; ++bj) {
                    const f32x4 v0 = acc[ai][bj][m][0] * sc, v1 = acc[ai][bj][m][1] * sc;
                    u32x4 w; w.x = cvt_pk_bf16(v0[0], v0[1]); w.y = cvt_pk_bf16(v0[2], v0[3]); w.z = cvt_pk_bf16(v1[0], v1[1]); w.w = cvt_pk_bf16(v1[2], v1[3]);
                    if (wide == 4) { const size_t off_ = ((size_t)(u.pm * 36 + u.pn) * 131072 + (size_t)(wr * 4 + wc) * 16384 + (size_t)((ai * 4 + m) * 2 + bj) * 1024 + fr * 64 + fq * 16) & (size_t)0x7fffff;
                        *(u32x4*)((unsigned char*)O + off_) = w; }
                    else if (wide != 3 || m == 0) *(u32x4*)(O + (((plane * 4096 + subrow) * 64 + dcol + 8 * bj) & (size_t)(wide == 2 ? 0x3fffff : 0x7fffffffff)) ) = w; else if (w.x == 0x12345678u) O[0] = 1;
                }
            }
    }
};
struct EpiKVQ {
    static constexpr bool PERM = true, AFTER_DRAIN = false; static constexpr int NSTORE = 16;
    bf16_t* O; float mul; unsigned* nrm;
    __device__ __forceinline__ void operator()(const f32x4 (&acc)[2][2][4][2], const Unit& u, int wr, int wc, int fr, int fq) const {
        asm volatile("" : "+v"(fr), "+v"(fq));
        const int which = u.pn < 4 ? 1 : (u.pn < 8 ? 2 : 0), h0 = (u.pn & 3) * 4, pm = u.pm & 127;
        const float sc = (which == 0 ? QSCALE : 1.f) * mul;
        float nmax[2] = {0.f, 0.f};
#pragma unroll
        for (int ai = 0; ai < 2; ++ai)
#pragma unroll
            for (int m = 0; m < 4; ++m) {
                const int tok = pm * BM + ai * HALF + wr * 64 + m * 16 + fr, b = tok >> 12, s = tok & 4095;
#pragma unroll
                for (int bj = 0; bj < 2; ++bj) {
                    const int head = h0 + 2 * bj + (wc >> 1), dcol = (wc & 1) * 32 + 8 * fq;
                    const size_t plane = (size_t)((b * 3 + which) * 16 + head);
                    const f32x4 v0 = acc[ai][bj][m][0] * sc, v1 = acc[ai][bj][m][1] * sc;
                    u32x4 w; w.x = cvt_pk_bf16(v0[0], v0[1]); w.y = cvt_pk_bf16(v0[2], v0[3]); w.z = cvt_pk_bf16(v1[0], v1[1]); w.w = cvt_pk_bf16(v1[2], v1[3]);
                    *(u32x4*)(O + (plane * 4096 + s) * 64 + dcol) = w;
                    if (which != 2) {
                        float ss = 0.f;
#pragma unroll
                        for (int k4 = 0; k4 < 4; ++k4) { const unsigned pw_ = k4 == 0 ? w.x : (k4 == 1 ? w.y : (k4 == 2 ? w.z : w.w)); const float lo_ = __uint_as_float(pw_ << 16), hi_ = __uint_as_float(pw_ & 0xffff0000u); ss += lo_ * lo_ + hi_ * hi_; }
                        ss += __shfl_xor(ss, 16); ss += __shfl_xor(ss, 32);
                        nmax[bj] = fmaxf(nmax[bj], ss);
                    }
                }
            }
        if (which != 2) {
#pragma unroll
            for (int bj = 0; bj < 2; ++bj) { float v = nmax[bj];
                v = fmaxf(v, __shfl_xor(v, 1)); v = fmaxf(v, __shfl_xor(v, 2)); v = fmaxf(v, __shfl_xor(v, 4)); v = fmaxf(v, __shfl_xor(v, 8));
                if (fr == 0 && fq == 0) { const int b0 = (pm * BM) >> 12, head = h0 + 2 * bj + (wc >> 1);
                    atomicMax(nrm + (((b0 * 2 + which) * 16 + head) * 2 + (wc & 1)), __float_as_uint(v)); } }
        }
    }
};
template <bool SRC_BF16> struct EpiResid {
    static constexpr bool PERM = true, AFTER_DRAIN = false; static constexpr int NSTORE = 16;
    const void* src; bf16_t* dst; const float* gate; float mul;
    __device__ __forceinline__ void operator()(const f32x4 (&acc)[2][2][4][2], const Unit& u, int wr, int wc, int fr, int fq) const {
        asm volatile("" : "+v"(fr), "+v"(fq));
#pragma unroll
        for (int ai = 0; ai < 2; ++ai)
#pragma unroll
            for (int m = 0; m < 4; ++m) {
                const int row = u.pm * BM + ai * HALF + wr * 64 + m * 16 + fr, b = row >> 12;
#pragma unroll
                for (int bj = 0; bj < 2; ++bj) {
                    const int col = u.pn * BM + bj * HALF + wc * 32 + 8 * fq;
                    f32x4 x0, x1;
                    if (SRC_BF16) { const u32x4 r = *(const u32x4*)((const bf16_t*)src + (size_t)row * D + col);
                        x0 = (f32x4){__uint_as_float(r.x << 16), __uint_as_float(r.x & 0xffff0000u), __uint_as_float(r.y << 16), __uint_as_float(r.y & 0xffff0000u)};
                        x1 = (f32x4){__uint_as_float(r.z << 16), __uint_as_float(r.z & 0xffff0000u), __uint_as_float(r.w << 16), __uint_as_float(r.w & 0xffff0000u)}; }
                    else if (NT_ROWS) { x0 = __builtin_nontemporal_load((const f32x4*)((const float*)src + (size_t)row * D + col)); x1 = __builtin_nontemporal_load((const f32x4*)((const float*)src + (size_t)row * D + col + 4)); }
                    else { x0 = *(const f32x4*)((const float*)src + (size_t)row * D + col); x1 = *(const f32x4*)((const float*)src + (size_t)row * D + col + 4); }
                    const f32x4 g0 = *(const f32x4*)(gate + b * 6144 + col), g1 = *(const f32x4*)(gate + b * 6144 + col + 4);
                    const f32x4 v0 = x0 + (g0 * mul) * acc[ai][bj][m][0], v1 = x1 + (g1 * mul) * acc[ai][bj][m][1];
                    u32x4 w; w.x = cvt_pk_bf16(v0[0], v0[1]); w.y = cvt_pk_bf16(v0[2], v0[3]); w.z = cvt_pk_bf16(v1[0], v1[1]); w.w = cvt_pk_bf16(v1[2], v1[3]);
                    *(u32x4*)(dst + (size_t)row * D + col) = w;
                }
            }
    }
};
struct EpiSwiGLU {
    static constexpr bool PERM = true, AFTER_DRAIN = false; static constexpr int NSTORE = 0;
    bf16_t* ACT; const float* bgu;
    __device__ __forceinline__ void operator()(const f32x4 (&acc)[2][2][4][2], const Unit& u, int wr, int wc, int fr, int fq) const {
        const int e = u.pn >> 3, pnl = u.pn & 7, j0 = pnl * 128 + wc * 32 + 8 * fq;
        f32x4 bg[2], bu[2];
#pragma unroll
        for (int n = 0; n < 2; ++n) { bg[n] = *(const f32x4*)(bgu + e * 2048 + j0 + 4 * n); bu[n] = *(const f32x4*)(bgu + e * 2048 + 1024 + j0 + 4 * n); }
#pragma unroll
        for (int ai = 0; ai < 2; ++ai)
#pragma unroll
            for (int m = 0; m < 4; ++m) {
                const int row = u.pm * BM + ai * HALF + wr * 64 + m * 16 + fr;
                float a[8];
#pragma unroll
                for (int n = 0; n < 2; ++n) {
                    const f32x4 gv = acc[ai][0][m][n] + bg[n], uv = acc[ai][1][m][n] + bu[n];
#pragma unroll
                    for (int i = 0; i < 4; ++i) {
                        const float gg = fminf(gv[i], 7.f), uu = fminf(fmaxf(uv[i], -7.f), 7.f);
                        const float sg = __builtin_amdgcn_rcpf(1.f + __builtin_amdgcn_exp2f(-1.702f * LOG2E * gg));
                        a[4 * n + i] = (uu + 1.f) * gg * sg;
                    }
                }
                u32x4 w; w.x = cvt_pk_bf16(a[0], a[1]); w.y = cvt_pk_bf16(a[2], a[3]); w.z = cvt_pk_bf16(a[4], a[5]); w.w = cvt_pk_bf16(a[6], a[7]);
                *(u32x4*)(ACT + (size_t)row * D + j0) = w;
            }
    }
};
struct EpiDown {
    static constexpr bool PERM = true, AFTER_DRAIN = false; static constexpr int NSTORE = 0;
    bf16_t* Y; const float* bdn;
    __device__ __forceinline__ void operator()(const f32x4 (&acc)[2][2][4][2], const Unit& u, int wr, int wc, int fr, int fq) const {
        const int e = u.pn >> 2, pnl = u.pn & 3;
#pragma unroll
        for (int ai = 0; ai < 2; ++ai)
#pragma unroll
            for (int m = 0; m < 4; ++m) {
                const int row = u.pm * BM + ai * HALF + wr * 64 + m * 16 + fr;
#pragma unroll
                for (int bj = 0; bj < 2; ++bj) {
                    const int col = pnl * BM + bj * HALF + wc * 32 + 8 * fq;
                    const f32x4 b0 = *(const f32x4*)(bdn + e * 1024 + col), b1 = *(const f32x4*)(bdn + e * 1024 + col + 4);
                    const f32x4 v0 = acc[ai][bj][m][0] + b0, v1 = acc[ai][bj][m][1] + b1;
                    u32x4 w; w.x = cvt_pk_bf16(v0[0], v0[1]); w.y = cvt_pk_bf16(v0[2], v0[3]); w.z = cvt_pk_bf16(v1[0], v1[1]); w.w = cvt_pk_bf16(v1[2], v1[3]);
                    *(u32x4*)(Y + (size_t)row * D + col) = w;
                }
            }
    }
};
__device__ __forceinline__ unsigned pk4_fp8(float a, float b, float c, float d) { int v = __builtin_amdgcn_cvt_pk_fp8_f32(a, b, 0, false); v = __builtin_amdgcn_cvt_pk_fp8_f32(c, d, v, true); return (unsigned)v; }
struct EpiQKV08 {
    static constexpr bool PERM = true, AFTER_DRAIN = false; static constexpr int NSTORE = 16;
    unsigned char* O; float mul;
    __device__ __forceinline__ void operator()(const f32x4 (&acc)[2][2][4][2], const Unit& u, int wr, int wc, int fr, int fq) const {
        asm volatile("" : "+v"(fr), "+v"(fq));
        const int g = u.pn / 12, rem = u.pn - g * 12, which = rem >> 2, h0 = (rem & 3) * 4, sh = 2 * g;
        const float sc = (which == 0 ? QSCALE : 1.f) * mul;
#pragma unroll
        for (int ai = 0; ai < 2; ++ai)
#pragma unroll
            for (int m = 0; m < 4; ++m) {
                const int tok = u.pm * BM + ai * HALF + wr * 64 + m * 16 + fr, b = tok >> 12, s = tok & 4095;
                const int subrow = (s & ((1 << sh) - 1)) * (4096 >> sh) + (s >> sh);
#pragma unroll
                for (int bj = 0; bj < 2; ++bj) {
                    const int head = h0 + 2 * bj + (wc >> 1), dcol = (wc & 1) * 32 + 8 * fq;
                    const size_t plane = (size_t)(((b * 3 + g) * 3 + which) * 16 + head);
                    const f32x4 v0 = acc[ai][bj][m][0] * sc, v1 = acc[ai][bj][m][1] * sc;
                    typedef unsigned u32x2e __attribute__((ext_vector_type(2)));
                    u32x2e w8; w8.x = pk4_fp8(v0[0], v0[1], v0[2], v0[3]); w8.y = pk4_fp8(v1[0], v1[1], v1[2], v1[3]);
                    *(u32x2e*)(O + (plane * 4096 + subrow) * 64 + dcol) = w8;
                }
            }
    }
};
struct EpiQKV08W {
    static constexpr bool PERM = true, AFTER_DRAIN = false; static constexpr int NSTORE = 8;
    unsigned char* O; float mul;
    __device__ __forceinline__ void operator()(const f32x4 (&acc)[2][2][4][2], const Unit& u, int wr, int wc, int fr, int fq) const {
        asm volatile("" : "+v"(fr), "+v"(fq));
        const int g = u.pn / 12, rem = u.pn - g * 12, which = rem >> 2, head = (rem & 3) * 4 + wc, sh = 2 * g;
        const float sc = (which == 0 ? QSCALE : 1.f) * mul;
#pragma unroll
        for (int ai = 0; ai < 2; ++ai)
#pragma unroll
            for (int m = 0; m < 4; ++m) {
                const int tok = u.pm * BM + ai * HALF + wr * 64 + m * 16 + fr, b = tok >> 12, s = tok & 4095;
                const int subrow = (s & ((1 << sh) - 1)) * (4096 >> sh) + (s >> sh);
                const size_t plane = (size_t)(((b * 3 + g) * 3 + which) * 16 + head);
                u32x4 w;
                { const f32x4 v0 = acc[ai][0][m][0] * sc, v1 = acc[ai][0][m][1] * sc; w.x = pk4_fp8(v0[0], v0[1], v0[2], v0[3]); w.y = pk4_fp8(v1[0], v1[1], v1[2], v1[3]); }
                { const f32x4 v0 = acc[ai][1][m][0] * sc, v1 = acc[ai][1][m][1] * sc; w.z = pk4_fp8(v0[0], v0[1], v0[2], v0[3]); w.w = pk4_fp8(v1[0], v1[1], v1[2], v1[3]); }
                *(u32x4*)(O + (plane * 4096 + subrow) * 64 + 16 * fq) = w;
            }
    }
};
struct EpiSwiGLU8 {
    static constexpr bool PERM = true, AFTER_DRAIN = false; static constexpr int NSTORE = 8;
    unsigned char* ACT; const float* bgu;
    __device__ __forceinline__ void operator()(const f32x4 (&acc)[2][2][4][2], const Unit& u, int wr, int wc, int fr, int fq) const {
        _Pragma("unroll") for (int rep_e = 0; rep_e < 1 + ((PROBE_EPI >> 1) & 1); ++rep_e) {
        asm volatile("" : "+v"(fr), "+v"(fq));
        const int e = u.pn >> 3, pnl = u.pn & 7, j0 = pnl * 128 + wc * 32 + 8 * fq;
        f32x4 bg[2], bu[2];
#pragma unroll
        for (int n = 0; n < 2; ++n) { bg[n] = *(const f32x4*)(bgu + e * 2048 + j0 + 4 * n) * 64.f; bu[n] = *(const f32x4*)(bgu + e * 2048 + 1024 + j0 + 4 * n) * 64.f + 64.f; }
#pragma unroll
        for (int ai = 0; ai < 2; ++ai)
#pragma unroll
            for (int m = 0; m < 4; ++m) {
                const int row = u.pm * BM + ai * HALF + wr * 64 + m * 16 + fr;
                float a[8];
#pragma unroll
                for (int n = 0; n < 2; ++n) {
                    const f32x4 gv = acc[ai][0][m][n] + bg[n], uv = acc[ai][1][m][n] + bu[n];
#pragma unroll
                    for (int i = 0; i < 4; ++i) {
                        const float gg = fminf(gv[i], 448.f), uu = fminf(fmaxf(uv[i], -384.f), 512.f);
                        const float t = __builtin_amdgcn_exp2f((-1.702f * LOG2E * 0.015625f) * gg);
                        const float sg = __builtin_amdgcn_rcpf(__builtin_fmaf(t, 4096.f, 4096.f));
                        a[4 * n + i] = (uu * gg) * sg;
                    }
                }
                typedef unsigned u32x2e __attribute__((ext_vector_type(2)));
                u32x2e w; w.x = pk4_fp8(a[0], a[1], a[2], a[3]); w.y = pk4_fp8(a[4], a[5], a[6], a[7]);
                *(u32x2e*)(ACT + (size_t)row * D + j0) = w;
            }
        }
    }
};
template <int VAR> struct EpiProbeGU {
    static constexpr bool PERM = true, AFTER_DRAIN = false; static constexpr int NSTORE = 0;
    unsigned char* ACT; const float* bgu;
    __device__ __forceinline__ void operator()(const f32x4 (&acc)[2][2][4][2], const Unit& u, int wr, int wc, int fr, int fq) const {
        if (VAR == 2) { if (acc[0][0][0][0][0] == 12345.678f) ACT[0] = 1; return; }
        asm volatile("" : "+v"(fr), "+v"(fq));
        const int pnl = u.pn & 7, j0 = pnl * 128 + wc * 32 + 8 * fq;
#pragma unroll
        for (int ai = 0; ai < 2; ++ai)
#pragma unroll
            for (int m = 0; m < 4; ++m) {
                const int row = u.pm * BM + ai * HALF + wr * 64 + m * 16 + fr;
                const f32x4 g0 = acc[ai][0][m][0] + acc[ai][1][m][0], g1 = acc[ai][0][m][1] + acc[ai][1][m][1];
                typedef unsigned u32x2e __attribute__((ext_vector_type(2)));
                u32x2e w; w.x = pk4_fp8(g0[0], g0[1], g0[2], g0[3]); w.y = pk4_fp8(g1[0], g1[1], g1[2], g1[3]);
                *(u32x2e*)(ACT + (size_t)row * D + j0) = w;
            }
    }
};
struct EpiNone { static constexpr bool PERM = true, AFTER_DRAIN = false; static constexpr int NSTORE = 0; unsigned char* P;
    __device__ __forceinline__ void operator()(const f32x4 (&acc)[2][2][4][2], const Unit& u, int wr, int wc, int fr, int fq) const { if (acc[0][0][0][0][0] == 12345.678f) P[0] = 1; } };
struct EpiDown8 {
    static constexpr bool PERM = true, AFTER_DRAIN = false; static constexpr int NSTORE = 16;
    bf16_t* Y; const float* bdn;
    __device__ __forceinline__ void operator()(const f32x4 (&acc)[2][2][4][2], const Unit& u, int wr, int wc, int fr, int fq) const {
        _Pragma("unroll") for (int rep_e = 0; rep_e < 1 + ((PROBE_EPI >> 2) & 1); ++rep_e) {
        asm volatile("" : "+v"(fr), "+v"(fq));
        const int e = u.pn >> 2, pnl = u.pn & 3;
#pragma unroll
        for (int ai = 0; ai < 2; ++ai)
#pragma unroll
            for (int m = 0; m < 4; ++m) {
                const int row = u.pm * BM + ai * HALF + wr * 64 + m * 16 + fr;
#pragma unroll
                for (int bj = 0; bj < 2; ++bj) {
                    const int col = pnl * BM + bj * HALF + wc * 32 + 8 * fq;
                    const f32x4 b0 = *(const f32x4*)(bdn + e * 1024 + col), b1 = *(const f32x4*)(bdn + e * 1024 + col + 4);
                    const f32x4 v0 = acc[ai][bj][m][0] * 0.015625f + b0, v1 = acc[ai][bj][m][1] * 0.015625f + b1;
                    if (Y_FP8) { typedef unsigned u32x2e __attribute__((ext_vector_type(2))); u32x2e w8; w8.x = pk4_fp8(v0[0], v0[1], v0[2], v0[3]); w8.y = pk4_fp8(v1[0], v1[1], v1[2], v1[3]);
                        *(u32x2e*)((unsigned char*)Y + (size_t)row * D + col) = w8; }
                    else { u32x4 w; w.x = cvt_pk_bf16(v0[0], v0[1]); w.y = cvt_pk_bf16(v0[2], v0[3]); w.z = cvt_pk_bf16(v1[0], v1[1]); w.w = cvt_pk_bf16(v1[2], v1[3]);
                        *(u32x4*)(Y + (size_t)row * D + col) = w; }
                }
            }
        }
    }
};
struct KVQOrder : StaticOrder {
    __device__ bool next(int i, Unit& u) const { if (!StaticOrder::next(i, u)) return false; if (u.pn >= 8) u.pm += 128; return true; }
};
template <int NN> struct MoeOrder {
    static constexpr int TR = 32 / NN;
    const LAS int* tile_exp; int n_tiles, c, G;
    __device__ __forceinline__ bool next(int i, Unit& u) const {
        int st, j;
        if (G == 256) { st = i * 8 + (c & 7); j = c >> 3; } else { const int L = i * G + c; st = L >> 5; j = L & 31; }
        const int tile = st * TR + (j % TR);
        if (tile >= n_tiles) return false;
        u.pm = tile; u.pn = tile_exp[tile] * NN + j / TR; return true;
    }
    __device__ __forceinline__ void a_ready(const Unit&) const {}
    __device__ __forceinline__ void done(const Unit&) const {}
};
struct MoeOrderProbe { const LAS int* tile_exp; int n_tiles, c, G;
    __device__ __forceinline__ bool next(int i, Unit& u) const { int st, j; if (G == 256) { st = i * 8 + (c & 7); j = c >> 3; } else { const int L = i * G + c; st = L >> 5; j = L & 31; }
        const int tile = st * 4 + (j % 4); if (tile >= n_tiles) return false; u.pm = tile; u.pn = j / 4; return true; }
    __device__ __forceinline__ void a_ready(const Unit&) const {}
    __device__ __forceinline__ void done(const Unit&) const {} };
}

namespace attn_body {
constexpr int KSLOT = 8192;
constexpr int L_K = 0, L_V = 2 * KSLOT, L_WS = 4 * KSLOT, L_OST = L_WS + 8 * 256, L_TAB = L_OST + 8 * 4096, L_ATT_END = L_TAB + 1024;
__device__ __forceinline__ void qkt2(f32x16& p0, f32x16& p1, const char* Kslot, const bf16x8* qr, const f32x16& c0, const f32x16& c1, int r32, int hi) {
  const char* kb = Kslot + hi * 1024 + r32 * 16;
  #pragma unroll
  for (int d0 = 0; d0 < 4; ++d0) {
    const bf16x8 b0 = *reinterpret_cast<const bf16x8*>(kb + d0 * 2048);
    const bf16x8 b1 = *reinterpret_cast<const bf16x8*>(kb + d0 * 2048 + 512);
    if (d0 == 0) { p0 = __builtin_amdgcn_mfma_f32_32x32x16_bf16(b0, qr[0], c0, 0, 0, 0); p1 = __builtin_amdgcn_mfma_f32_32x32x16_bf16(b1, qr[0], c1, 0, 0, 0); }
    else { p0 = __builtin_amdgcn_mfma_f32_32x32x16_bf16(b0, qr[d0], p0, 0, 0, 0); p1 = __builtin_amdgcn_mfma_f32_32x32x16_bf16(b1, qr[d0], p1, 0, 0, 0); } }
}
template <int MODE> __device__ __forceinline__ void attn_unit(const bf16* Qp, const bf16* __restrict__ Kp, const bf16* __restrict__ Vp, int q0, bf16* Ob, long ostride,
                                                               float* lse, long lstride, const float* __restrict__ F2, const float* __restrict__ tabg, char* shm) {
  const int tid = threadIdx.x, lane = tid & 63, r32 = lane & 31, hi = lane >> 5; const int wid = __builtin_amdgcn_readfirstlane(tid >> 6);
  const unsigned lds0 = (unsigned)(uintptr_t)shm;
  float* wsf = (float*)(shm + L_WS) + wid * 64;
  const int tq = q0 >> 6, t_hi = tq + 4;
  const int t_lo = (MODE == 0) ? (tq >= 2 ? tq - 2 : 0) : 0;
  const int w_hi = tq + (wid >> 1);
  const int w_lo = (MODE == 0) ? (w_hi >= 2 ? w_hi - 2 : 0) : 0;
  const bf16* ksrc = Kp + (long)lane * 64 + wid * 8;
  const bf16* vsrc = Vp + (long)(16 * (wid & 3) + (lane >> 2)) * 64 + (wid >> 2) * 32 + (lane & 3) * 8;
  const unsigned kdst = lds0 + L_K + wid * 1024, vdst = lds0 + L_V + wid * 1024;
  #define DMA_KV(t, slot) do { glds16(ksrc + (long)(t) * 4096, (unsigned)__builtin_amdgcn_readfirstlane(kdst + (slot) * KSLOT)); glds16(vsrc + (long)(t) * 4096, (unsigned)__builtin_amdgcn_readfirstlane(vdst + (slot) * KSLOT)); } while (0)
  if (MODE == 0) { float* tab = (float*)(shm + L_TAB); if (tid < 129) tab[tid] = tabg[tid]; }
  const int qi = q0 + wid * 32 + r32;
  f32x4 fk[8];
  #pragma unroll
  for (int g4 = 0; g4 < 8; ++g4) fk[g4] = (f32x4){0.f, 0.f, 0.f, 0.f};
  float Fq = 0.f;
  if (MODE == 1) { Fq = F2[qi];
    #pragma unroll
    for (int g4 = 0; g4 < 4; ++g4) { fk[g4] = *(const f32x4*)(F2 + 64 * t_lo + 4 * hi + 8 * g4); fk[4 + g4] = *(const f32x4*)(F2 + 64 * t_lo + 32 + 4 * hi + 8 * g4); } }
  bf16x8 qr[4];
  { const bf16* Qw = Qp + (long)(q0 + wid * 32) * 64;
    #pragma unroll
    for (int d0 = 0; d0 < 4; ++d0) qr[d0] = *reinterpret_cast<const bf16x8*>(&Qw[(long)r32 * 64 + d0 * 16 + hi * 8]); }
  DMA_KV(t_lo, 0);
  float m_run = -INFINITY, l_run = 0.f; f32x16 o[2]; o[0] = f32x16{}; o[1] = f32x16{};
  const int vb0 = (int)(lds0 + L_V) + ((lane >> 4) & 1) * 32 + (lane & 3) * 8 + (4 * hi + ((lane & 15) >> 2)) * 64;
  for (int t = t_lo; t < t_hi; ++t) {
    const int s = (t - t_lo) & 1;
    asm volatile("s_waitcnt vmcnt(0) lgkmcnt(0)\n\ts_barrier" ::: "memory");
    f32x4 fn[8];
    #pragma unroll
    for (int g4 = 0; g4 < 8; ++g4) fn[g4] = fk[g4];
    if (t + 1 < t_hi) {
      if (MODE == 1) {
        #pragma unroll
        for (int g4 = 0; g4 < 4; ++g4) { fn[g4] = *(const f32x4*)(F2 + 64 * (t + 1) + 4 * hi + 8 * g4); fn[4 + g4] = *(const f32x4*)(F2 + 64 * (t + 1) + 32 + 4 * hi + 8 * g4); } }
      DMA_KV(t + 1, s ^ 1);
    }
    if (t >= w_lo && t <= w_hi) {
      f32x16 c0, c1, p0, p1;
      if (MODE == 1) {
        #pragma unroll
        for (int r = 0; r < 16; ++r) { c0[r] = Fq - fk[r >> 2][r & 3]; c1[r] = Fq - fk[4 + (r >> 2)][r & 3]; }
      } else {
        const float* tab = (const float*)(shm + L_TAB);
        #pragma unroll
        for (int r = 0; r < 16; ++r) { const int d0_ = qi - (64 * t + crow(r, hi)), d1_ = d0_ - 32;
          c0[r] = tab[d0_ < 0 ? 0 : (d0_ > 128 ? 128 : d0_)]; c1[r] = tab[d1_ < 0 ? 0 : (d1_ > 128 ? 128 : d1_)]; }
      }
      qkt2(p0, p1, shm + L_K + s * KSLOT, qr, c0, c1, r32, hi);
      if (MODE == 1) {
        if (t == w_hi) {
          #pragma unroll
          for (int r = 0; r < 16; ++r) { const int kv = 64 * t + crow(r, hi); if (kv > qi) p0[r] = -INFINITY; if (kv + 32 > qi) p1[r] = -INFINITY; } }
      } else {
        #pragma unroll
        for (int r = 0; r < 16; ++r) { const int d0_ = qi - (64 * t + crow(r, hi)), d1_ = d0_ - 32;
          if ((unsigned)d0_ > 128u) p0[r] = -INFINITY; if ((unsigned)d1_ > 128u) p1[r] = -INFINITY; }
      }
      const float rm = rowmax(p0, p1), mnew = fmaxf(m_run, rm), msub = (mnew == -INFINITY) ? 0.f : mnew;
      const float f = __builtin_amdgcn_exp2f(m_run - msub);
      m_run = mnew;
      float sacc = 0.f;
      #pragma unroll
      for (int r = 0; r < 16; ++r) { p0[r] = __builtin_amdgcn_exp2f(p0[r] - msub); p1[r] = __builtin_amdgcn_exp2f(p1[r] - msub); sacc += p0[r] + p1[r]; }
      l_run = l_run * f + sacc;
      if (__any(f != 1.f)) {
        if (hi == 0) wsf[r32] = f;
        asm volatile("s_waitcnt lgkmcnt(0)" ::: "memory");
        #pragma unroll
        for (int r = 0; r < 16; ++r) { const float ff = wsf[crow(r, hi)]; o[0][r] *= ff; o[1][r] *= ff; }
      }
      u32x4 pw0, pw1, pw2, pw3;
      pw0 = (u32x4){cvtpk_s(p0[0], p0[1]), cvtpk_s(p0[2], p0[3]), cvtpk_s(p0[4], p0[5]), cvtpk_s(p0[6], p0[7])};
      pw1 = (u32x4){cvtpk_s(p0[8], p0[9]), cvtpk_s(p0[10], p0[11]), cvtpk_s(p0[12], p0[13]), cvtpk_s(p0[14], p0[15])};
      pw2 = (u32x4){cvtpk_s(p1[0], p1[1]), cvtpk_s(p1[2], p1[3]), cvtpk_s(p1[4], p1[5]), cvtpk_s(p1[6], p1[7])};
      pw3 = (u32x4){cvtpk_s(p1[8], p1[9]), cvtpk_s(p1[10], p1[11]), cvtpk_s(p1[12], p1[13]), cvtpk_s(p1[14], p1[15])};
      SBAR();
      pv(o, vb0 + s * KSLOT, __builtin_bit_cast(bf16x8, pw0), __builtin_bit_cast(bf16x8, pw1), __builtin_bit_cast(bf16x8, pw2), __builtin_bit_cast(bf16x8, pw3));
    }
    #pragma unroll
    for (int g4 = 0; g4 < 8; ++g4) fk[g4] = fn[g4];
  }
  { auto rr = __builtin_amdgcn_permlane32_swap(__float_as_uint(l_run), __float_as_uint(l_run), false, false); l_run = __uint_as_float(rr[0]) + __uint_as_float(rr[1]); }
  if (hi == 0) { wsf[32 + r32] = l_run; if (MODE == 0) lse[(long)qi * lstride] = m_run + __builtin_amdgcn_logf(l_run); }
  asm volatile("s_waitcnt lgkmcnt(0)" ::: "memory");
  float rli[16];
  #pragma unroll
  for (int r = 0; r < 16; ++r) rli[r] = __builtin_amdgcn_rcpf(wsf[32 + crow(r, hi)]);
  { bf16* stg = (bf16*)(shm + L_OST) + wid * 2048;
    #pragma unroll
    for (int r = 0; r < 16; ++r) { const int orow = crow(r, hi);
      #pragma unroll
      for (int d0 = 0; d0 < 2; ++d0) stg[orow * 64 + d0 * 32 + r32] = __float2bfloat16(o[d0][r] * rli[r]); }
    asm volatile("s_waitcnt lgkmcnt(0)" ::: "memory");
    bf16* Ow = Ob + (long)(q0 + wid * 32) * ostride;
    #pragma unroll
    for (int i = 0; i < 4; ++i) { const int row = i * 8 + (lane >> 3), ch = lane & 7; const u32x4 v = *(const u32x4*)(stg + row * 64 + ch * 8); *(u32x4*)(Ow + (long)row * ostride + ch * 8) = v; } }
  asm volatile("s_waitcnt lgkmcnt(0)\n\ts_barrier" ::: "memory");
  #undef DMA_KV
}
#undef SBAR
#undef WAIT_BAR
}

namespace attn_body {
constexpr int NSLOT = 3, SLOTB = 8192;
constexpr int T_K = 0, T_V = NSLOT * SLOTB, T_WS = 2 * NSLOT * SLOTB, T_OST = T_WS + 8 * 256, T_END = T_OST + 8 * 4096;
constexpr int T_F = 90112;
__device__ __forceinline__ void glds16s(unsigned voff,const void*sbase,unsigned lds_dst){unsigned keep;
  asm volatile("s_mov_b32 %0, m0\n\ts_mov_b32 m0, %3\n\ts_nop 0\n\tglobal_load_lds_dwordx4 %1, %2\n\ts_mov_b32 m0, %0":"=&s"(keep):"v"(voff),"s"(sbase),"s"(lds_dst):"memory");}
#define SBAR() __builtin_amdgcn_sched_barrier(0)
#define WAIT_BAR(N) asm volatile("s_waitcnt vmcnt(" #N ") lgkmcnt(0)\n\ts_barrier":::"memory")
template<int MODE, int THRL> __device__ __forceinline__ void attn_unit_t(const bf16* Qw0, const bf16* __restrict__ Kb, const bf16* __restrict__ Vb, const int NT, const int qoff,
                                                                         bf16* Ob, long ostride, float* lse, long lstride, char* shm) {
  const int tid=threadIdx.x,lane=tid&63,r32=lane&31,hi=lane>>5; const int wid=__builtin_amdgcn_readfirstlane(tid>>6);
  const unsigned lds0=(unsigned)(uintptr_t)shm;
  float*wsf=(float*)(shm+T_WS)+wid*64;
  typedef __attribute__((address_space(3))) const float* lds_f;
  const lds_f Fl=(lds_f)(shm+T_F)+((MODE==1)?qoff:0);
  const unsigned koff_=(unsigned)(lane*128+wid*16), voff_=(unsigned)((16*(wid&3)+(lane>>2))*128+(wid>>2)*64+(lane&3)*16);
  #define KOFF() koff_
  #define VOFF() voff_
  const unsigned kdst=lds0+T_K+wid*1024, vdst=lds0+T_V+wid*1024;
  #define DMA_K(t,slot) glds16s(KOFF(),(const char*)Kb+(long)(t)*8192,(unsigned)__builtin_amdgcn_readfirstlane(kdst+(slot)))
  #define DMA_V(t,slot) glds16s(VOFF(),(const char*)Vb+(long)(t)*8192,(unsigned)__builtin_amdgcn_readfirstlane(vdst+(slot)))
  const char*Kbase=shm+T_K; bf16x8 kf[8];
  const lds_cptr shm3=(lds_cptr)shm; const lds_cptr kp0=shm3+T_K+hi*1024+r32*16; const lds_cptr vp0=shm3+T_V+((lane>>4)&1)*32+(lane&3)*8+(4*hi+((lane&15)>>2))*64;
  DMA_K(0,0);DMA_V(0,0);DMA_K(1,SLOTB);
  bf16x8 qr[4];
  { const bf16*Qw=Qw0+(long)(wid*32)*64;
    #pragma unroll
    for(int d0=0;d0<4;++d0)qr[d0]=*reinterpret_cast<const bf16x8*>(&Qw[(long)r32*64+d0*16+hi*8]); }
  float mhat=0.f,l_reg=0.f;f32x16 o[2];o[0]=f32x16{};o[1]=f32x16{};
  const int qrel=wid*32+r32;
  const int qpos=(MODE>=1)?(64*(NT-4)+qrel):(qoff+qrel);
  #define FQ() ((MODE==1)?Fl[64*(NT-4)+wid*32+r32]:0.f)
  const int jb0=384-qpos+4*hi;
  #define CINIT(C0,C1,t,MASKED) do{ \
    if(MODE==2){ _Pragma("unroll") for(int r=0;r<16;++r){ C0[r]=-mhat; C1[r]=-mhat; } \
      if(MASKED){ const int jb_=(t)-(NT-4); if(jb_>=0){ const int kb_=64*jb_+4*hi; \
        _Pragma("unroll") for(int r=0;r<16;++r){ const int kv_=kb_+(r&3)+8*(r>>2); if(kv_>qrel)C0[r]=-INFINITY; if(kv_+32>qrel)C1[r]=-INFINITY; } } } \
    } else if(MODE==1){ const float fqm=FQ()-mhat; const lds_f fp_=Fl+64*(t)+4*hi; \
      _Pragma("unroll") for(int g4=0;g4<4;++g4){ const f32x4 a_=*(const __attribute__((address_space(3))) f32x4*)(fp_+8*g4), b_=*(const __attribute__((address_space(3))) f32x4*)(fp_+32+8*g4); \
        _Pragma("unroll") for(int i_=0;i_<4;++i_){ C0[4*g4+i_]=fqm-a_[i_]; C1[4*g4+i_]=fqm-b_[i_]; } } \
      if(MASKED){ const int jb_=(t)-(NT-4); if(jb_>=0){ const int kb_=64*jb_+4*hi; \
        _Pragma("unroll") for(int r=0;r<16;++r){ const int kv_=kb_+(r&3)+8*(r>>2); if(kv_>qrel)C0[r]=-INFINITY; if(kv_+32>qrel)C1[r]=-INFINITY; } } } \
    } else { const lds_f tp_=Fl+jb0+64*(t); \
      _Pragma("unroll") for(int r=0;r<16;++r){ C0[r]=tp_[(r&3)+8*(r>>2)]-mhat; C1[r]=tp_[32+(r&3)+8*(r>>2)]-mhat; } } \
  }while(0)
  bool resc=false;
  #define START(P0,P1) do{ const float rm=rowmax(P0,P1); resc=false; \
    { const float dl=(rm==-INFINITY)?0.f:rm; mhat=fadd_s(mhat,dl); \
      _Pragma("unroll") for(int r=0;r<16;++r){P0[r]=fsub_s(P0[r],dl);P1[r]=fsub_s(P1[r],dl);} } \
    _Pragma("unroll") for(int r=0;r<16;++r)P0[r]=__builtin_amdgcn_exp2f(P0[r]); }while(0)
  #define RESC() do{ if(resc){ asm volatile("s_waitcnt lgkmcnt(0)":::"memory"); \
      _Pragma("unroll") for(int d_=0;d_<2;++d_) _Pragma("unroll") for(int r=0;r<16;++r)o[d_][r]*=wsf[crow(r,hi)]; } }while(0)
  f32x16 pA0,pA1,pB0,pB1;
  int sl_prev=0,sl_cur=0,sl_next=SLOTB;
  #define ROT() do{sl_prev=sl_cur;sl_cur=sl_next;sl_next=(sl_next==(NSLOT-1)*SLOTB)?0:sl_next+SLOTB;}while(0)
  DMA_K(2,2*SLOTB);
  WAIT_BAR(3);
  CINIT(pA0,pA1,0,true);
  qkt2(pA0,pA1,Kbase,qr,pA0,pA1,r32,hi);asm volatile("s_nop 15\n\ts_nop 7":"+v"(pA0),"+v"(pA1));
  START(pA0,pA1);
  _Pragma("unroll") for(int r=0;r<16;++r)pA1[r]=__builtin_amdgcn_exp2f(pA1[r]);
  WAIT_BAR(0);
  DMA_K(3,0);DMA_V(1,SLOTB);
  ROT();
  kload8(kf,kp0+sl_cur);
  WAIT_BAR(2);
  s16x4 vlo[8],vhi[8]; u32x4 pw0,pw1,pw2,pw3;
  #define PKW(P,B) cvtpk_s(P[B],P[B+1])
  #define PAF(k) __builtin_bit_cast(bf16x8,pw##k)
  #define VFR(i) (bf16x8){vlo[i][0],vlo[i][1],vlo[i][2],vlo[i][3],vhi[i][0],vhi[i][1],vhi[i][2],vhi[i][3]}
  #define PIN(x) asm volatile("":"+v"(x))
  #define MX3(a,b,c) __builtin_fmaxf(__builtin_fmaxf((a),(b)),(c))
  #define GAPA(MF,A0,A1,A2,A3,W0,W1,PW) do{ MF; sacc+=A0; sacc+=A1; sacc+=A2; sacc+=A3; PIN(sacc); W0; W1; PIN(PW); SBAR(); }while(0)
  #define EX(v) __builtin_amdgcn_exp2f(v)
  #define GAPB(MF,X,B) do{ MF; X[B]=EX(X[B]); X[B+1]=EX(X[B+1]); X[B+2]=EX(X[B+2]); X[B+3]=EX(X[B+3]); PIN(X); SBAR(); }while(0)
  #define VRD(i) do{ vlo[i]=vtr(vp_+(((i)>>2)*4096+((i)&3)*1024)); vhi[i]=vtr(vp_+(((i)>>2)*4096+((i)&3)*1024+512)); }while(0)
  #define KRD(G,j) do{ if(G){ kload2(kf,kp0+sl_next,j); SBAR(); } }while(0)
  #define STEP(C0,C1,P0,P1,t,GK,GV,GL,MASKED) do{ SBAR(); \
    CINIT(C0,C1,t,MASKED); \
    const lds_cptr vp_=vp0+sl_prev; \
    VRD(0); SBAR(); float sacc=(P0[0]+P0[1]); \
    GAPA(C0=__builtin_amdgcn_mfma_f32_32x32x16_bf16(kf[0],qr[0],C0,0,0,0), P0[2],P0[3],P0[4],P0[5],     pw0[0]=PKW(P0,0), pw0[1]=PKW(P0,2), pw0); \
    VRD(4); SBAR(); GAPA(C1=__builtin_amdgcn_mfma_f32_32x32x16_bf16(kf[1],qr[0],C1,0,0,0), P0[6],P0[7],P0[8],P0[9],     pw0[2]=PKW(P0,4), pw0[3]=PKW(P0,6), pw0); \
    VRD(1); SBAR(); GAPA(C0=__builtin_amdgcn_mfma_f32_32x32x16_bf16(kf[2],qr[1],C0,0,0,0),   P0[10],P0[11],P0[12],P0[13], pw1[0]=PKW(P0,8), pw1[1]=PKW(P0,10), pw1); \
    VRD(5); SBAR(); GAPA(C1=__builtin_amdgcn_mfma_f32_32x32x16_bf16(kf[3],qr[1],C1,0,0,0),   P0[14],P0[15],P1[0],P1[1],   pw1[2]=PKW(P0,12),pw1[3]=PKW(P0,14), pw1); \
    VRD(2); SBAR(); GAPA(C0=__builtin_amdgcn_mfma_f32_32x32x16_bf16(kf[4],qr[2],C0,0,0,0),   P1[2],P1[3],P1[4],P1[5],     pw2[0]=PKW(P1,0), pw2[1]=PKW(P1,2), pw2); \
    VRD(6); SBAR(); GAPA(C1=__builtin_amdgcn_mfma_f32_32x32x16_bf16(kf[5],qr[2],C1,0,0,0),   P1[6],P1[7],P1[8],P1[9],     pw2[2]=PKW(P1,4), pw2[3]=PKW(P1,6), pw2); \
    VRD(3); SBAR(); GAPA(C0=__builtin_amdgcn_mfma_f32_32x32x16_bf16(kf[6],qr[3],C0,0,0,0),   P1[10],P1[11],P1[12],P1[13], pw3[0]=PKW(P1,8), pw3[1]=PKW(P1,10), pw3); \
    VRD(7); SBAR(); GAPA(C1=__builtin_amdgcn_mfma_f32_32x32x16_bf16(kf[7],qr[3],C1,0,0,0),   P1[14],P1[15],0.f,0.f,       pw3[2]=PKW(P1,12),pw3[3]=PKW(P1,14), pw3); \
    l_reg+=sacc; \
    if(GK){DMA_K((t)+3,sl_cur);} if(GV){DMA_V((t)+1,sl_next);} \
    { float a=MX3(C0[0],C0[1],C1[0]),b=MX3(C0[2],C0[3],C1[1]); a=MX3(a,C1[2],C1[3]); \
      _Pragma("unroll") for(int r=4;r<16;r+=4){a=MX3(a,C0[r],C0[r+1]);b=MX3(b,C0[r+2],C0[r+3]);a=MX3(a,C1[r],C1[r+1]);b=MX3(b,C1[r+2],C1[r+3]);} \
      float rm=__builtin_fmaxf(a,b); { auto rr=__builtin_amdgcn_permlane32_swap(__float_as_uint(rm),__float_as_uint(rm),false,false); rm=__builtin_fmaxf(__uint_as_float(rr[0]),__uint_as_float(rr[1])); } \
      resc=false; \
      if(__builtin_expect(__any(rm>(float)THRL),0)){ const float dl=__builtin_fmaxf(rm,0.f); mhat+=dl; \
        _Pragma("unroll") for(int r=0;r<16;++r){C0[r]-=dl;C1[r]-=dl;} \
        const float f=__builtin_amdgcn_exp2f(-dl); l_reg*=f; if(hi==0)wsf[r32]=f; resc=true; } } \
    SBAR(); \
    GAPB(o[0]=__builtin_amdgcn_mfma_f32_32x32x16_bf16(PAF(0),VFR(0),o[0],0,0,0), C0,0); \
    GAPB(o[1]=__builtin_amdgcn_mfma_f32_32x32x16_bf16(PAF(0),VFR(4),o[1],0,0,0), C0,4); \
    KRD(GL,0); GAPB(o[0]=__builtin_amdgcn_mfma_f32_32x32x16_bf16(PAF(1),VFR(1),o[0],0,0,0), C0,8); \
    KRD(GL,1); GAPB(o[1]=__builtin_amdgcn_mfma_f32_32x32x16_bf16(PAF(1),VFR(5),o[1],0,0,0), C0,12); \
    KRD(GL,2); GAPB(o[0]=__builtin_amdgcn_mfma_f32_32x32x16_bf16(PAF(2),VFR(2),o[0],0,0,0), C1,0); \
    KRD(GL,3); GAPB(o[1]=__builtin_amdgcn_mfma_f32_32x32x16_bf16(PAF(2),VFR(6),o[1],0,0,0), C1,4); \
    GAPB(o[0]=__builtin_amdgcn_mfma_f32_32x32x16_bf16(PAF(3),VFR(3),o[0],0,0,0), C1,8); \
    GAPB(o[1]=__builtin_amdgcn_mfma_f32_32x32x16_bf16(PAF(3),VFR(7),o[1],0,0,0), C1,12); \
    }while(0)
  int t=1;
  for(;t+5<NT;t+=2){
    STEP(pB0,pB1,pA0,pA1,t,true,true,true,false);     WAIT_BAR(2); RESC(); ROT();
    STEP(pA0,pA1,pB0,pB1,t+1,true,true,true,false);   WAIT_BAR(2); RESC(); ROT();
  }
  #define ENDW(tt) do{ if((tt)+3<NT){WAIT_BAR(2);} else if((tt)+2<NT){WAIT_BAR(1);} else {WAIT_BAR(0);} }while(0)
  for(;t+1<NT;t+=2){
    STEP(pB0,pB1,pA0,pA1,t,(t+3<NT),(t+1<NT),(t+1<NT),true);       ENDW(t);   RESC(); ROT();
    STEP(pA0,pA1,pB0,pB1,t+1,(t+4<NT),(t+2<NT),(t+2<NT),true);     ENDW(t+1); RESC(); ROT();
  }
  STEP(pB0,pB1,pA0,pA1,NT-1,false,false,false,true); RESC();
  { float sacc=pB0[0]+pB0[1]; _Pragma("unroll") for(int r=2;r<16;++r)sacc+=pB0[r]; _Pragma("unroll") for(int r=0;r<16;++r)sacc+=pB1[r]; l_reg+=sacc;
    pw0=(u32x4){PKW(pB0,0),PKW(pB0,2),PKW(pB0,4),PKW(pB0,6)};pw1=(u32x4){PKW(pB0,8),PKW(pB0,10),PKW(pB0,12),PKW(pB0,14)};pw2=(u32x4){PKW(pB1,0),PKW(pB1,2),PKW(pB1,4),PKW(pB1,6)};pw3=(u32x4){PKW(pB1,8),PKW(pB1,10),PKW(pB1,12),PKW(pB1,14)};
    int ln_=lane; asm volatile("":"+v"(ln_)); const int hi_=ln_>>5; const int vb0=(int)(lds0+T_V)+((ln_>>4)&1)*32+(ln_&3)*8+(4*hi_+((ln_&15)>>2))*64;
    SBAR(); pv(o,vb0+sl_cur,PAF(0),PAF(1),PAF(2),PAF(3)); }
  #undef PKW
  #undef PAF
  #undef VFR
  #undef PIN
  #undef MX3
  #undef GAPA
  #undef GAPB
  #undef EX
  #undef VRD
  #undef KRD
  #undef STEP
  #undef ENDW
  #undef CINIT
  {auto rr=__builtin_amdgcn_permlane32_swap(__float_as_uint(l_reg),__float_as_uint(l_reg),false,false);l_reg=__uint_as_float(rr[0])+__uint_as_float(rr[1]);}
  int r32e=r32,hie=hi; asm volatile("":"+v"(r32e),"+v"(hie));
  if(hie==0){ wsf[32+r32e]=l_reg; if(MODE==0) lse[(long)(wid*32+r32e)*lstride]=mhat+__builtin_amdgcn_logf(l_reg); }
  asm volatile("s_waitcnt lgkmcnt(0)":::"memory");
  float rli[16];
  #pragma unroll
  for(int r=0;r<16;++r)rli[r]=__builtin_amdgcn_rcpf(wsf[32+crow(r,hie)]);
  { bf16*stg=(bf16*)(shm+T_OST)+wid*2048;
    #pragma unroll
    for(int r=0;r<16;++r){const int orow=crow(r,hie);
      #pragma unroll
      for(int d0=0;d0<2;++d0)stg[orow*64+d0*32+r32e]=__float2bfloat16(o[d0][r]*rli[r]);}
    asm volatile("s_waitcnt lgkmcnt(0)":::"memory");
    bf16*Ow=Ob+(long)(wid*32)*ostride;
    int le_=lane; asm volatile("":"+v"(le_));
    #pragma unroll
    for(int i=0;i<4;++i){const int row=i*8+(le_>>3),ch=le_&7; const u32x4 v=*(const u32x4*)(stg+row*64+ch*8);
      if(WO_FP8&&MODE==1){ typedef unsigned u32x2o __attribute__((ext_vector_type(2))); u32x2o w8;
        w8.x=pg8::pk4_fp8(__uint_as_float(v.x<<16),__uint_as_float(v.x&0xffff0000u),__uint_as_float(v.y<<16),__uint_as_float(v.y&0xffff0000u));
        w8.y=pg8::pk4_fp8(__uint_as_float(v.z<<16),__uint_as_float(v.z&0xffff0000u),__uint_as_float(v.w<<16),__uint_as_float(v.w&0xffff0000u));
        *(u32x2o*)((unsigned char*)Ob+(long)(wid*32+row)*ostride+ch*8)=w8; }
      else *(u32x4*)(Ow+(long)row*ostride+ch*8)=v;} }
  asm volatile("s_waitcnt lgkmcnt(0)\n\ts_barrier":::"memory");
  #undef DMA_K
  #undef DMA_V
  #undef KOFF
  #undef FQ
  #undef VOFF
  #undef START
  #undef RESC
  #undef ROT
}
#undef SBAR
#undef WAIT_BAR
}

namespace attn_body {
constexpr int B_V = 0, B_VBUF = 49152, B_K = B_VBUF, B_WS = 2 * B_VBUF, B_OST = B_WS + 2048, B_TAB = B_OST + 32768, B_END = B_TAB + 2 * 1024;
struct BandUnit { const bf16* Q; const bf16* K; const bf16* V; bf16* O; float* L; const float* tab; int q0; int sh; };
__device__ __forceinline__ void band_decode(int L, BandUnit& u, const bf16* QKV, bf16* OG, float* LSE, const float* BT) {
    const int tri = L >> 4, u16 = L & 15, b = tri / 48, gh = tri % 48, g = gh >> 4, h = gh & 15;
    const int sh = 2 * g, Ls = 4096 >> sh;
    const int r = (g == 0) ? 0 : (g == 1 ? (u16 >> 2) : u16), uq = (g == 0) ? u16 : (g == 1 ? (u16 & 3) : 0);
    const size_t pl = (size_t)((b * 3 + g) * 3) * 16 + h;
    u.Q = QKV + (pl * 4096 + (size_t)r * Ls) * 64; u.K = u.Q + (size_t)16 * 4096 * 64; u.V = u.Q + (size_t)32 * 4096 * 64;
    const size_t tok0 = (size_t)b * 4096 + r;
    u.O = OG + ((size_t)g * 32768 + tok0) * 1024 + h * 64; u.L = LSE + ((size_t)g * 32768 + tok0) * 16 + h;
    u.tab = BT + gh * 132; u.q0 = uq * 256; u.sh = sh;
}
__device__ __forceinline__ void band_issue_v(const BandUnit& u, unsigned lds0, int lane, int wid) {
    const unsigned voff = (unsigned)((16 * (wid & 3) + (lane >> 2)) * 128 + (wid >> 2) * 64 + (lane & 3) * 16);
    const int w0 = u.q0 - 128;
    #pragma unroll
    for (int t = 0; t < 6; ++t) { const int k0 = w0 + 64 * t;
        if (k0 >= 0) glds16s(voff, (const char*)u.V + (long)k0 * 128, (unsigned)__builtin_amdgcn_readfirstlane(lds0 + B_V + t * 8192 + wid * 1024)); }
}
__device__ __forceinline__ void band_issue_k(const BandUnit& u, int tbuf, unsigned lds0, int tid, int lane, int wid) {
    const unsigned koff = (unsigned)(lane * 128 + wid * 16);
    const int w0 = u.q0 - 128;
    #pragma unroll
    for (int t = 0; t < 6; ++t) { const int k0 = w0 + 64 * t;
        if (k0 >= 0) glds16s(koff, (const char*)u.K + (long)k0 * 128, (unsigned)__builtin_amdgcn_readfirstlane(lds0 + B_K + t * 8192 + wid * 1024)); }
    if (tid < 192) { __attribute__((address_space(3))) float* tb = (__attribute__((address_space(3))) float*)(uintptr_t)(lds0 + B_TAB + tbuf * 1024);
        tb[tid] = (tid >= 32 && tid <= 160) ? u.tab[tid - 32] : -INFINITY; }
}
template <int VAR> __device__ __forceinline__ void band_phase(const bf16* QKV, bf16* OG, float* LSE, const float* BT, int first, int step, int NU, char* shm) {
    const int tid = threadIdx.x, lane = tid & 63, r32 = lane & 31, hi = lane >> 5; const int wid = __builtin_amdgcn_readfirstlane(tid >> 6);
    const unsigned lds0 = (unsigned)(uintptr_t)shm;
    float* wsf = (float*)(shm + B_WS) + wid * 64;
    typedef __attribute__((address_space(3))) const float* lds_f;
    BandUnit cur, nxt;
    int L = first, buf = 0;
#define BAND_LOADQ(U) do { const bf16* Qw_ = (U).Q + (long)((U).q0 + 32 * wid) * 64; \
        _Pragma("unroll") for (int d0 = 0; d0 < 4; ++d0) qn[d0] = *reinterpret_cast<const bf16x8*>(&Qw_[(long)r32 * 64 + d0 * 16 + hi * 8]); } while (0)
    bf16x8 qn[4];
    #pragma unroll
    for (int d0 = 0; d0 < 4; ++d0) qn[d0] = (bf16x8){0, 0, 0, 0, 0, 0, 0, 0};
    if (L < NU) { band_decode(L, cur, QKV, OG, LSE, BT); band_issue_k(cur, 0, lds0, tid, lane, wid); BAND_LOADQ(cur); }
    for (; L < NU; L += step, buf ^= 1) {
        const bool has_next = (L + step) < NU;
        if (has_next) band_decode(L + step, nxt, QKV, OG, LSE, BT); else nxt = cur;
        const int qw = cur.q0 + 32 * wid;
        const int jlo = (qw >= 128) ? 0 : ((128 - qw) >> 5);
        if (L == first) asm volatile("s_waitcnt vmcnt(0) lgkmcnt(0)\n\ts_barrier" ::: "memory");
        else asm volatile("s_waitcnt vmcnt(5) lgkmcnt(0)\n\ts_barrier" ::: "memory");
        bf16x8 qr[4];
        #pragma unroll
        for (int d0 = 0; d0 < 4; ++d0) qr[d0] = qn[d0];
        band_issue_v(cur, lds0, lane, wid);
        f32x16 S[5];
        { const lds_f tb = (lds_f)(uintptr_t)(lds0 + B_TAB + buf * 1024) + (5 + r32 - 4 * hi);
          #pragma unroll
          for (int j = 0; j < 5; ++j) {
              #pragma unroll
              for (int r = 0; r < 16; ++r) S[j][r] = (VAR == 2) ? 0.f : ((j >= jlo) ? tb[(128 - 32 * j) + 27 - ((r & 3) + 8 * (r >> 2))] : -INFINITY);
              if (VAR != 2 && j >= jlo) { const int wj = wid + j;
                  const __attribute__((address_space(3))) char* kp = (const __attribute__((address_space(3))) char*)(uintptr_t)(lds0 + B_K + (wj >> 1) * 8192 + hi * 1024 + ((wj & 1) * 32 + r32) * 16);
                  #pragma unroll
                  for (int d0 = 0; d0 < 4; ++d0) { const bf16x8 kf = *(const __attribute__((address_space(3))) bf16x8*)(kp + d0 * 2048);
                      S[j] = __builtin_amdgcn_mfma_f32_32x32x16_bf16(kf, qr[d0], S[j], 0, 0, 0); } } } }
        asm volatile("s_waitcnt vmcnt(0) lgkmcnt(0)\n\ts_barrier" ::: "memory");
        if (has_next) { band_issue_k(nxt, buf ^ 1, lds0, tid, lane, wid); BAND_LOADQ(nxt); }
        float mx = -INFINITY;
        #pragma unroll
        for (int j = 0; j < 5; ++j)
            #pragma unroll
            for (int r = 0; r < 16; ++r) mx = fmaxf(mx, S[j][r]);
        { auto rr = __builtin_amdgcn_permlane32_swap(__float_as_uint(mx), __float_as_uint(mx), false, false); mx = fmaxf(__uint_as_float(rr[0]), __uint_as_float(rr[1])); }
        float lsum = 0.f; u32x4 pw[5][2];
        #pragma unroll
        for (int j = 0; j < 5; ++j) {
            #pragma unroll
            for (int r = 0; r < 16; ++r) { if (VAR != 3) S[j][r] = __builtin_amdgcn_exp2f(S[j][r] - mx); lsum += S[j][r]; }
            pw[j][0] = (u32x4){cvtpk_s(S[j][0], S[j][1]), cvtpk_s(S[j][2], S[j][3]), cvtpk_s(S[j][4], S[j][5]), cvtpk_s(S[j][6], S[j][7])};
            pw[j][1] = (u32x4){cvtpk_s(S[j][8], S[j][9]), cvtpk_s(S[j][10], S[j][11]), cvtpk_s(S[j][12], S[j][13]), cvtpk_s(S[j][14], S[j][15])}; }
        { auto rr = __builtin_amdgcn_permlane32_swap(__float_as_uint(lsum), __float_as_uint(lsum), false, false); lsum = __uint_as_float(rr[0]) + __uint_as_float(rr[1]); }
        f32x16 o[2]; o[0] = f32x16{}; o[1] = f32x16{};
        const int vlane = ((lane >> 4) & 1) * 32 + (lane & 3) * 8 + (4 * hi + ((lane & 15) >> 2)) * 64;
        #pragma unroll
        for (int j = 0; j < 5; ++j) if (VAR != 1 && j >= jlo) {
            const int wj = wid + j;
            const int vb = (int)(lds0 + B_V) + (wj >> 1) * 8192 + (wj & 1) * 2048 + vlane;
            s16x4 l0[2], h0[2], l1[2], h1[2];
            #pragma unroll
            for (int d0 = 0; d0 < 2; ++d0) {
                asm volatile("ds_read_b64_tr_b16 %0,%1 offset:%c2" : "=&v"(l0[d0]) : "v"(vb), "i"(d0 * 4096) : "memory");
                asm volatile("ds_read_b64_tr_b16 %0,%1 offset:%c2" : "=&v"(h0[d0]) : "v"(vb), "i"(d0 * 4096 + 512) : "memory");
                asm volatile("ds_read_b64_tr_b16 %0,%1 offset:%c2" : "=&v"(l1[d0]) : "v"(vb), "i"(d0 * 4096 + 1024) : "memory");
                asm volatile("ds_read_b64_tr_b16 %0,%1 offset:%c2" : "=&v"(h1[d0]) : "v"(vb), "i"(d0 * 4096 + 1536) : "memory"); }
            asm volatile("s_waitcnt lgkmcnt(0)" : "+v"(l0[0]), "+v"(h0[0]), "+v"(l1[0]), "+v"(h1[0]), "+v"(l0[1]), "+v"(h0[1]), "+v"(l1[1]), "+v"(h1[1]) :: "memory"); __builtin_amdgcn_sched_barrier(0);
            #pragma unroll
            for (int d0 = 0; d0 < 2; ++d0) {
                o[d0] = __builtin_amdgcn_mfma_f32_32x32x16_bf16(__builtin_bit_cast(bf16x8, pw[j][0]), (bf16x8){l0[d0][0], l0[d0][1], l0[d0][2], l0[d0][3], h0[d0][0], h0[d0][1], h0[d0][2], h0[d0][3]}, o[d0], 0, 0, 0);
                o[d0] = __builtin_amdgcn_mfma_f32_32x32x16_bf16(__builtin_bit_cast(bf16x8, pw[j][1]), (bf16x8){l1[d0][0], l1[d0][1], l1[d0][2], l1[d0][3], h1[d0][0], h1[d0][1], h1[d0][2], h1[d0][3]}, o[d0], 0, 0, 0); } }
        const long ostride = 1024L << cur.sh, lstride = 16L << cur.sh;
        if (hi == 0) { wsf[32 + r32] = lsum; cur.L[(long)(qw + r32) * lstride] = mx + __builtin_amdgcn_logf(lsum); }
        asm volatile("s_waitcnt lgkmcnt(0)" ::: "memory");
        float rli[16];
        #pragma unroll
        for (int r = 0; r < 16; ++r) rli[r] = __builtin_amdgcn_rcpf(wsf[32 + crow(r, hi)]);
        { bf16* stg = (bf16*)(shm + B_OST) + wid * 2048;
          #pragma unroll
          for (int r = 0; r < 16; ++r) { const int orow = crow(r, hi);
            #pragma unroll
            for (int d0 = 0; d0 < 2; ++d0) stg[orow * 64 + d0 * 32 + r32] = __float2bfloat16(o[d0][r] * rli[r]); }
          asm volatile("s_waitcnt lgkmcnt(0)" ::: "memory");
          bf16* Ow = cur.O + (long)qw * ostride;
          #pragma unroll
          for (int i = 0; i < 4; ++i) { const int row = i * 8 + (lane >> 3), ch = lane & 7; const u32x4 v = *(const u32x4*)(stg + row * 64 + ch * 8); *(u32x4*)(Ow + (long)row * ostride + ch * 8) = v; } }
        cur = nxt;
    }
    asm volatile("s_waitcnt vmcnt(0) lgkmcnt(0)\n\ts_barrier" ::: "memory");
#undef BAND_LOADQ
}
}

namespace attn_body {
typedef int i32x8b __attribute__((ext_vector_type(8)));
typedef int i32x4b __attribute__((ext_vector_type(4)));
typedef int i32x2b __attribute__((ext_vector_type(2)));
constexpr int C_KV = 0, C_KVBUF = 49152  , C_WS = 2 * C_KVBUF, C_OST = C_WS + 2048, C_TAB = C_OST + 32768, C_END = C_TAB + 2 * 1024;
struct Band8Unit { const unsigned char* Q; const unsigned char* K; const unsigned char* V; bf16* O; float* L; const float* tab; int q0; int sh; };
__device__ __forceinline__ void band8_decode(int L, Band8Unit& u, const unsigned char* QKV, bf16* OG, float* LSE, const float* BT) {
    const int tri = L >> 4, u16 = L & 15, b = tri / 48, gh = tri % 48, g = gh >> 4, h = gh & 15;
    const int sh = 2 * g, Ls = 4096 >> sh;
    const int r = (g == 0) ? 0 : (g == 1 ? (u16 >> 2) : u16), uq = (g == 0) ? u16 : (g == 1 ? (u16 & 3) : 0);
    const size_t pl = (size_t)((b * 3 + g) * 3) * 16 + h;
    u.Q = QKV + (pl * 4096 + (size_t)r * Ls) * 64; u.K = u.Q + (size_t)16 * 4096 * 64; u.V = u.Q + (size_t)32 * 4096 * 64;
    const size_t tok0 = (size_t)b * 4096 + r;
    u.O = OG_FP8 ? (bf16*)((unsigned char*)OG + ((size_t)g * 32768 + tok0) * 1024 + h * 64) : OG + ((size_t)g * 32768 + tok0) * 1024 + h * 64; u.L = LSE + ((size_t)g * 32768 + tok0) * 16 + h;
    u.tab = BT + gh * 132; u.q0 = uq * 256; u.sh = sh;
}
__device__ __forceinline__ void band8_issue(const Band8Unit& u, int b, unsigned lds0, int tid, int lane, int wid) {
    const unsigned lane64 = (unsigned)lane * 64u;
    const int w0 = u.q0 - 128;
    #pragma unroll
    for (int i = 0; i < 3; ++i) { const int p = wid * 3 + i, k0 = w0 + 64 * (p >> 2);
        if (k0 >= 0) { const long go = (long)k0 * 64 + (p & 3) * 16;
            glds16s(lane64, (const char*)u.K + go, (unsigned)__builtin_amdgcn_readfirstlane(lds0 + C_KV + b * C_KVBUF + p * 1024));
            glds16s(lane64, (const char*)u.V + go, (unsigned)__builtin_amdgcn_readfirstlane(lds0 + C_KV + b * C_KVBUF + 24576 + p * 1024)); } }
    if (tid < 192) { __attribute__((address_space(3))) float* tb = (__attribute__((address_space(3))) float*)(uintptr_t)(lds0 + C_TAB + b * 1024);
        tb[tid] = (tid >= 32 && tid <= 160) ? u.tab[tid - 32] : -INFINITY; }
}
__device__ __forceinline__ unsigned pk4_e4m3(float a, float b, float c, float d) { int v = __builtin_amdgcn_cvt_pk_fp8_f32(a, b, 0, false); v = __builtin_amdgcn_cvt_pk_fp8_f32(c, d, v, true); return (unsigned)v; }
template <int VAR> __device__ __forceinline__ void band8_phase(const unsigned char* QKV, bf16* OG, float* LSE, const float* BT, int first, int step, int NU, char* shm) {
    const int tid = threadIdx.x, lane = tid & 63, r32 = lane & 31, hi = lane >> 5; const int wid = __builtin_amdgcn_readfirstlane(tid >> 6);
    const unsigned lds0 = (unsigned)(uintptr_t)shm;
    float* wsf = (float*)(shm + C_WS) + wid * 64;
    typedef __attribute__((address_space(3))) const float* lds_f;
    typedef __attribute__((address_space(3))) const i32x4b* lds_q;
    Band8Unit cur, nxt;
    int L = first, buf = 0;
#define BAND8_LOADQ(U) do { const unsigned char* Qw_ = (U).Q + (long)((U).q0 + 32 * wid + r32) * 64 + hi * 32; \
        qn[0] = *reinterpret_cast<const i32x4b*>(Qw_); qn[1] = *reinterpret_cast<const i32x4b*>(Qw_ + 16); } while (0)
    i32x4b qn[2]; qn[0] = (i32x4b){0, 0, 0, 0}; qn[1] = qn[0];
    if (L < NU) { band8_decode(L, cur, QKV, OG, LSE, BT); band8_issue(cur, 0, lds0, tid, lane, wid); BAND8_LOADQ(cur); }
    const int vlane8 = ((lane >> 4) & 1) * 1024 + ((((lane & 15) >> 3) & 1) * 8 + (((lane & 15) >> 1) & 3) + 4 * hi) * 16 + (lane & 1) * 8;
    for (; L < NU; L += step, buf ^= 1) {
        const bool has_next = (L + step) < NU;
        if (has_next) band8_decode(L + step, nxt, QKV, OG, LSE, BT); else nxt = cur;
        const int qw = cur.q0 + 32 * wid;
        const int jlo = (qw >= 128) ? 0 : ((128 - qw) >> 5);
        if (L == first) asm volatile("s_waitcnt vmcnt(0) lgkmcnt(0)\n\ts_barrier" ::: "memory");
        else if (OG_FP8) asm volatile("s_waitcnt vmcnt(3) lgkmcnt(0)\n\ts_barrier" ::: "memory");
        else asm volatile("s_waitcnt vmcnt(5) lgkmcnt(0)\n\ts_barrier" ::: "memory");
        const i32x8b qf = (i32x8b){qn[0][0], qn[0][1], qn[0][2], qn[0][3], qn[1][0], qn[1][1], qn[1][2], qn[1][3]};
        if (has_next) { band8_issue(nxt, buf ^ 1, lds0, tid, lane, wid); BAND8_LOADQ(nxt); }
        const unsigned kvb = lds0 + C_KV + buf * C_KVBUF;
        f32x16 S[5];
        { const lds_f tb = (lds_f)(uintptr_t)(lds0 + C_TAB + buf * 1024) + (5 + r32 - 4 * hi);
          #pragma unroll
          for (int j = 0; j < 5; ++j) {
              #pragma unroll
              for (int r = 0; r < 16; ++r) S[j][r] = (j >= jlo) ? tb[(128 - 32 * j) + 27 - ((r & 3) + 8 * (r >> 2))] : -INFINITY;
              if (j >= jlo) { const int wj = wid + j;
                  const lds_q kp = (lds_q)(uintptr_t)(kvb + (wj >> 1) * 4096 + hi * 2048 + ((wj & 1) * 32 + r32) * 16);
                  const i32x4b k0 = kp[0], k1 = kp[64];
                  S[j] = __builtin_amdgcn_mfma_scale_f32_32x32x64_f8f6f4((i32x8b){k0[0], k0[1], k0[2], k0[3], k1[0], k1[1], k1[2], k1[3]}, qf, S[j], 0, 0, 0, 0, 0, 0); } } }
        float mx = -INFINITY;
        #pragma unroll
        for (int j = 0; j < 5; ++j)
            #pragma unroll
            for (int r = 0; r < 16; ++r) mx = fmaxf(mx, S[j][r]);
        { auto rr = __builtin_amdgcn_permlane32_swap(__float_as_uint(mx), __float_as_uint(mx), false, false); mx = fmaxf(__uint_as_float(rr[0]), __uint_as_float(rr[1])); }
        const float mxs = mx - 7.f;
        float lsum = 0.f; unsigned pw[5][4];
        #pragma unroll
        for (int j = 0; j < 5; ++j) {
            #pragma unroll
            for (int r = 0; r < 16; ++r) { S[j][r] = __builtin_amdgcn_exp2f(S[j][r] - mxs); lsum += S[j][r]; }
            #pragma unroll
            for (int q4 = 0; q4 < 4; ++q4) pw[j][q4] = pk4_e4m3(S[j][4 * q4], S[j][4 * q4 + 1], S[j][4 * q4 + 2], S[j][4 * q4 + 3]); }
        { auto rr = __builtin_amdgcn_permlane32_swap(__float_as_uint(lsum), __float_as_uint(lsum), false, false); lsum = __uint_as_float(rr[0]) + __uint_as_float(rr[1]); }
        f32x16 o[2]; o[0] = f32x16{}; o[1] = f32x16{};
        i32x2b vf[3][2][4];
        #pragma unroll
        for (int pr = 0; pr < 3; ++pr)
            #pragma unroll
            for (int c = 0; c < (pr == 2 ? 2 : 4); ++c) {
                const int j = 2 * pr + (c >> 1), je = j > jlo ? j : jlo, wj = wid + je;
                const int vb = (int)(kvb + 24576) + (wj >> 1) * 4096 + (wj & 1) * 512 + vlane8;
                asm volatile("ds_read_b64_tr_b8 %0,%1 offset:%c2" : "=&v"(vf[pr][0][c]) : "v"(vb), "i"((c & 1) * 256) : "memory");
                asm volatile("ds_read_b64_tr_b8 %0,%1 offset:%c2" : "=&v"(vf[pr][1][c]) : "v"(vb), "i"(2048 + (c & 1) * 256) : "memory"); }
        asm volatile("s_waitcnt lgkmcnt(0)" : "+v"(vf[0][0][0]), "+v"(vf[0][0][1]), "+v"(vf[0][0][2]), "+v"(vf[0][0][3]), "+v"(vf[0][1][0]), "+v"(vf[0][1][1]), "+v"(vf[0][1][2]), "+v"(vf[0][1][3]),
                     "+v"(vf[1][0][0]), "+v"(vf[1][0][1]), "+v"(vf[1][0][2]), "+v"(vf[1][0][3]), "+v"(vf[1][1][0]), "+v"(vf[1][1][1]), "+v"(vf[1][1][2]), "+v"(vf[1][1][3]),
                     "+v"(vf[2][0][0]), "+v"(vf[2][0][1]), "+v"(vf[2][1][0]), "+v"(vf[2][1][1]) :: "memory"); __builtin_amdgcn_sched_barrier(0);
        #pragma unroll
        for (int pr = 0; pr < 3; ++pr) {
            const i32x8b pa = (pr == 2) ? (i32x8b){(int)pw[4][0], (int)pw[4][1], (int)pw[4][2], (int)pw[4][3], 0, 0, 0, 0}
                                        : (i32x8b){(int)pw[2 * pr][0], (int)pw[2 * pr][1], (int)pw[2 * pr][2], (int)pw[2 * pr][3], (int)pw[2 * pr + 1][0], (int)pw[2 * pr + 1][1], (int)pw[2 * pr + 1][2], (int)pw[2 * pr + 1][3]};
            #pragma unroll
            for (int d0 = 0; d0 < 2; ++d0) {
                const i32x2b v2 = (pr == 2) ? vf[2][d0][0] : vf[pr][d0][2], v3 = (pr == 2) ? vf[2][d0][1] : vf[pr][d0][3];
                o[d0] = __builtin_amdgcn_mfma_scale_f32_32x32x64_f8f6f4(pa, (i32x8b){vf[pr][d0][0][0], vf[pr][d0][0][1], vf[pr][d0][1][0], vf[pr][d0][1][1], v2[0], v2[1], v3[0], v3[1]}, o[d0], 0, 0, 0, 0, 0, 0); } }
        const long ostride = 1024L << cur.sh, lstride = 16L << cur.sh;
        if (hi == 0) { wsf[32 + r32] = lsum; cur.L[(long)(qw + r32) * lstride] = mxs + __builtin_amdgcn_logf(lsum); }
        asm volatile("s_waitcnt lgkmcnt(0)" ::: "memory");
        float rli[16];
        #pragma unroll
        for (int r = 0; r < 16; ++r) rli[r] = __builtin_amdgcn_rcpf(wsf[32 + crow(r, hi)]);
#if OG_FP8
        { unsigned char* stg = (unsigned char*)(shm + C_OST) + wid * 2048;
          #pragma unroll
          for (int r = 0; r < 16; ++r) { const int orow = crow(r, hi); const float sc8 = rli[r] * 8.f;
            #pragma unroll
            for (int d0 = 0; d0 < 2; ++d0) { const float x = o[d0][r] * sc8; stg[orow * 64 + d0 * 32 + r32] = (unsigned char)__builtin_amdgcn_cvt_pk_fp8_f32(x, x, 0, false); } }
          asm volatile("s_waitcnt lgkmcnt(0)" ::: "memory");
          unsigned char* Ow = (unsigned char*)cur.O + (long)qw * ostride;
          #pragma unroll
          for (int i = 0; i < 2; ++i) { const int row = i * 16 + (lane >> 2), ch = lane & 3; const u32x4 v = *(const u32x4*)(stg + row * 64 + ch * 16); *(u32x4*)(Ow + (long)row * ostride + ch * 16) = v; } }
#else
        { bf16* stg = (bf16*)(shm + C_OST) + wid * 2048;
          #pragma unroll
          for (int r = 0; r < 16; ++r) { const int orow = crow(r, hi);
            #pragma unroll
            for (int d0 = 0; d0 < 2; ++d0) stg[orow * 64 + d0 * 32 + r32] = __float2bfloat16(o[d0][r] * rli[r]); }
          asm volatile("s_waitcnt lgkmcnt(0)" ::: "memory");
          bf16* Ow = cur.O + (long)qw * ostride;
          #pragma unroll
          for (int i = 0; i < 4; ++i) { const int row = i * 8 + (lane >> 3), ch = lane & 7; const u32x4 v = *(const u32x4*)(stg + row * 64 + ch * 8); *(u32x4*)(Ow + (long)row * ostride + ch * 8) = v; } }
#endif
        cur = nxt;
    }
    asm volatile("s_waitcnt vmcnt(0) lgkmcnt(0)\n\ts_barrier" ::: "memory");
#undef BAND8_LOADQ
}
}
#define XB_TMO      128
#define XB_XCNT(j)  (256  + 64 * (j))
#define XB_XSUB(j)  (1280 + 64 * (j))
#define XB_XGEN(j)  (2304 + 64 * (j))
#define XB_TOP      3328
#define XB_TOPGEN   3392
#define XCD_BAR_WORDS 3456
#define XB_SPIN_CAP (1u << 18)

__device__ __forceinline__ unsigned xb_ld(unsigned* p)              { return __hip_atomic_load(p, __ATOMIC_RELAXED, __HIP_MEMORY_SCOPE_AGENT); }
__device__ __forceinline__ unsigned xb_add(unsigned* p, unsigned v) { return __hip_atomic_fetch_add(p, v, __ATOMIC_RELAXED, __HIP_MEMORY_SCOPE_AGENT); }
__device__ __forceinline__ unsigned xb_xcc_id() { return (unsigned)__builtin_amdgcn_s_getreg((3 << 11) | 20) & 0xFu; }
#define XB_SPIN(cond, bar) do { unsigned _sp = 0; while (cond) { __builtin_amdgcn_s_sleep(1); \
    if ((++_sp & 255u) == 0u) { if (xb_ld(&(bar)[XB_TMO])) break; if (_sp > XB_SPIN_CAP) { atomicAdd(&(bar)[XB_TMO], 1u); break; } } } } while (0)

struct XcdBarrier {
    unsigned* bar; unsigned x;
    volatile LAS unsigned* st;
};

__device__ __forceinline__ XcdBarrier xcd_barrier_post(unsigned* bar, volatile LAS unsigned* st) {
    XcdBarrier b; b.bar = bar; b.x = xb_xcc_id(); b.st = st;
    if (threadIdx.x == 0) (void)xb_add(&bar[XB_XCNT(b.x)], 1u);
    return b;
}
__device__ __forceinline__ void xcd_barrier_complete(unsigned* bar, unsigned x, unsigned& nloc, unsigned& nx) {
    const unsigned G = gridDim.x * gridDim.y * gridDim.z;
    unsigned sum, cnt, mine, sp = 0u;
    for (;;) {
        sum = 0u; cnt = 0u; mine = 0u;
#pragma unroll
        for (unsigned j = 0; j < 16; ++j) { const unsigned c = xb_ld(&bar[XB_XCNT(j)]); sum += c; cnt += (c > 0u) ? 1u : 0u; mine = (j == x) ? c : mine; }
        if (sum == G) break;
        __builtin_amdgcn_s_sleep(1);
        if ((++sp & 255u) == 0u) { if (xb_ld(&bar[XB_TMO])) break; if (sp > XB_SPIN_CAP) { atomicAdd(&bar[XB_TMO], 1u); break; } }
    }
    nloc = mine > 0u ? mine : 1u; nx = cnt > 0u ? cnt : 1u;
}

__device__ __forceinline__ void xcd_barrier(const XcdBarrier& b) {
    asm volatile("s_waitcnt vmcnt(0)" ::: "memory");
    __syncthreads();
    if (threadIdx.x == 0) {
        unsigned* bar = b.bar;
        __builtin_amdgcn_s_waitcnt(0);
        unsigned nloc = b.st[0], nx = b.st[1];
        if (nloc == 0u) { xcd_barrier_complete(bar, b.x, nloc, nx); b.st[0] = nloc; b.st[1] = nx; }
        const unsigned old = xb_add(&bar[XB_XSUB(b.x)], 1u);
        const unsigned gen = old / nloc;
        if (old + 1u == (gen + 1u) * nloc) {
            __builtin_amdgcn_fence(__ATOMIC_RELEASE, "agent");
            asm volatile("s_waitcnt vmcnt(0)" ::: "memory");
            const unsigned og = xb_add(&bar[XB_TOP], 1u);
            const unsigned tg = og / nx;
            if (og + 1u == (tg + 1u) * nx) xb_add(&bar[XB_TOPGEN], 1u);
            else XB_SPIN(xb_ld(&bar[XB_TOPGEN]) == tg, bar);
            __builtin_amdgcn_fence(__ATOMIC_ACQUIRE, "agent");
            xb_add(&bar[XB_XGEN(b.x)], 1u);
            asm volatile("s_waitcnt vmcnt(0)" ::: "memory");
        } else {
            XB_SPIN(xb_ld(&bar[XB_XGEN(b.x)]) == gen, bar);
            __builtin_amdgcn_fence(__ATOMIC_ACQUIRE, "agent");
            asm volatile("s_waitcnt vmcnt(0)" ::: "memory");
        }
    }
    __syncthreads();
}

struct Args { const float* in[21]; float* out; unsigned char* ws; int ph_lo, ph_hi; };
enum { IN_X = 0, IN_C, IN_ADAW, IN_ADAB, IN_NMIX, IN_NFFN, IN_AWQKV, IN_AWO, IN_RELB, IN_KVNG, IN_WKVF, IN_BF, IN_BWQ, IN_BWO, IN_RW, IN_RB, IN_WGU, IN_BGU, IN_WDN, IN_BDN, IN_FNG };

struct Ctx {
    LAS unsigned char* lds; unsigned char* ws; int tid, lane, wave, vcu, G;
};

__device__ __forceinline__ void transpose_item(const float* __restrict__ W, int pitch, int Kd, bf16* WT, int k0, int n0, int row_off, LAS float* scr, int lane) {
#pragma unroll
    for (int i = 0; i < 8; ++i) { const int kk = 8 * i + (lane >> 3), c4 = (lane & 7) * 4;
        const f32x4 v = *(const f32x4*)(W + (size_t)(k0 + kk) * pitch + n0 + c4);
        scr[kk * 33 + c4] = v[0]; scr[kk * 33 + c4 + 1] = v[1]; scr[kk * 33 + c4 + 2] = v[2]; scr[kk * 33 + c4 + 3] = v[3]; }
    LDS_WAIT(); asm volatile("" ::: "memory");
    const int c = lane & 7;
#pragma unroll
    for (int j = 0; j < 4; ++j) { const int n = (lane >> 3) + 8 * j; const LAS float* s = scr + (8 * c) * 33 + n;
        u32x4v o; o.x = pkbf(s[0 * 33], s[1 * 33]); o.y = pkbf(s[2 * 33], s[3 * 33]); o.z = pkbf(s[4 * 33], s[5 * 33]); o.w = pkbf(s[6 * 33], s[7 * 33]);
        *(u32x4v*)(WT + (size_t)(row_off + n0 + n) * Kd + k0 + 8 * c) = o; }
    LDS_WAIT(); asm volatile("" ::: "memory");
}

__device__ __forceinline__ void transpose_item8(const float* __restrict__ W, int pitch, int Kd, unsigned char* WT, int k0, int n0, int row_off, LAS float* scr, int lane) {
#pragma unroll
    for (int i = 0; i < 8; ++i) { const int kk = 8 * i + (lane >> 3), c4 = (lane & 7) * 4;
        const f32x4 v = *(const f32x4*)(W + (size_t)(k0 + kk) * pitch + n0 + c4) * 64.f;
        scr[kk * 33 + c4] = v[0]; scr[kk * 33 + c4 + 1] = v[1]; scr[kk * 33 + c4 + 2] = v[2]; scr[kk * 33 + c4 + 3] = v[3]; }
    LDS_WAIT(); asm volatile("" ::: "memory");
    const int c = lane & 7;
#pragma unroll
    for (int j = 0; j < 4; ++j) { const int n = (lane >> 3) + 8 * j; const LAS float* s = scr + (8 * c) * 33 + n;
        u32x2v o; o.x = pg8::pk4_fp8(s[0 * 33], s[1 * 33], s[2 * 33], s[3 * 33]); o.y = pg8::pk4_fp8(s[4 * 33], s[5 * 33], s[6 * 33], s[7 * 33]);
        *(u32x2v*)(WT + (size_t)(row_off + n0 + n) * Kd + k0 + 8 * c) = o; }
    LDS_WAIT(); asm volatile("" ::: "memory");
}

template <int DEPTH> __device__ __forceinline__ void convert_weights(const Ctx& C, const Args& a, const int part, const int idx, const int cnt) {
    LAS float* scr = (LAS float*)(C.lds + RING_OFF + C.wave * 8704);
    const int gw = idx * NWAVES + C.wave, NGW = cnt * NWAVES;
    constexpr int I_QKV = 16 * 288, I_SQ = 16 * 32, I_KV = 16 * 64, I_GU1 = 16 * 64, I_DN1 = 16 * 32;
    constexpr int O_WO0 = I_QKV, O_KV = O_WO0 + I_SQ, O_WQ = O_KV + I_KV, O_WO1 = O_WQ + I_SQ, O_GU = O_WO1 + I_SQ, O_DN = O_GU + 64 * I_GU1, NITEMS = O_DN + 64 * I_DN1;
    static_assert(QKV_FP8 && KVQ_FP8 && WO_FP8, "the pipelined prologue converts every weight to fp8");
    struct Item { const float* W; unsigned char* WT; int pitch, k0, n0, row_off; };
    auto decode = [&](int it, Item& I) {
        if (it < O_WO0) { const int r = it, kb = r / 288, nb = r % 288; I = {a.in[IN_AWQKV], (unsigned char*)(C.ws + WS_WQKV), NQKV, 64 * kb, 32 * nb, 0}; }
        else if (it < O_KV) { const int r = it - O_WO0, kb = r / 32, nb = r % 32; I = {a.in[IN_AWO], (unsigned char*)(C.ws + WS_WO0), D, 64 * kb, 32 * nb, 0}; }
        else if (it < O_WQ) { const int r = it - O_KV, kb = r / 64, nb = r % 64; I = {a.in[IN_WKVF], (unsigned char*)(C.ws + WS_WKV), 2064, 64 * kb, 32 * nb, 0}; }
        else if (it < O_WO1) { const int r = it - O_WQ, kb = r / 32, nb = r % 32; I = {a.in[IN_BWQ], (unsigned char*)(C.ws + WS_WKV) + (size_t)2048 * D, D, 64 * kb, 32 * nb, 0}; }
        else if (it < O_GU) { const int r = it - O_WO1, kb = r / 32, nb = r % 32; I = {a.in[IN_BWO], (unsigned char*)(C.ws + WS_WO1), D, 64 * kb, 32 * nb, 0}; }
        else if (it < O_DN) { const int r = it - O_GU, mat = r / I_GU1, q = r % I_GU1, kb = q / 64, nb = q % 64;
            const int n0 = 32 * nb, which = n0 >> 10, j0 = n0 & 1023, drow0 = (j0 >> 7) * 256 + which * 128 + (j0 & 127);
            I = {a.in[IN_WGU] + (size_t)mat * D * 2048, (unsigned char*)(C.ws + WS_WGU) + (size_t)mat * 2048 * D, 2048, 64 * kb, n0, drow0 - n0}; }
        else { const int r = it - O_DN, mat = r / I_DN1, q = r % I_DN1, kb = q / 32, nb = q % 32;
            I = {a.in[IN_WDN] + (size_t)mat * D * D, (unsigned char*)(C.ws + WS_WDN) + (size_t)mat * D * D, D, 64 * kb, 32 * nb, 0}; }
    };
    const int lr = C.lane >> 3, c4 = (C.lane & 7) * 4;
#define P0_LOAD(V, I) do { _Pragma("unroll") for (int i = 0; i < 8; ++i) V[i] = NT_P0 ? __builtin_nontemporal_load((const f32x4*)((I).W + (size_t)((I).k0 + 8 * i + lr) * (I).pitch + (I).n0 + c4)) : *(const f32x4*)((I).W + (size_t)((I).k0 + 8 * i + lr) * (I).pitch + (I).n0 + c4); } while (0)
    constexpr int L1GU = 32 * I_GU1, L1DN = 32 * I_DN1;
    const int base = part == 0 ? 0 : (part == 1 ? O_GU : (part == 2 ? O_DN : (part == 3 ? O_GU + L1GU : O_DN + L1DN)));
    const int NV = part == 0 ? O_GU : ((part & 1) ? L1GU : L1DN);
    constexpr int NS = DEPTH + 1;
    f32x4 v[NS][8]; Item I[NS];
#pragma unroll
    for (int s = 0; s < DEPTH; ++s) { const int vp = gw + s * NGW; if (vp < NV) { decode(base + vp, I[s]); P0_LOAD(v[s], I[s]); } }
    for (int vv0 = gw; vv0 < NV; vv0 += NS * NGW) {
#pragma unroll
        for (int s = 0; s < NS; ++s) { const int vv = vv0 + s * NGW;
            if (vv < NV) {
                { const int vp = vv + DEPTH * NGW; constexpr int dummy = 0; (void)dummy; if (vp < NV) { decode(base + vp, I[(s + DEPTH) % NS]); P0_LOAD(v[(s + DEPTH) % NS], I[(s + DEPTH) % NS]); } }
#pragma unroll
                for (int i = 0; i < 8; ++i) { const int kk = 8 * i + lr; const f32x4 x = v[s][i] * 64.f;
                    scr[kk * 33 + c4] = x[0]; scr[kk * 33 + c4 + 1] = x[1]; scr[kk * 33 + c4 + 2] = x[2]; scr[kk * 33 + c4 + 3] = x[3]; }
                LDS_WAIT(); asm volatile("" ::: "memory");
                { const int cc = C.lane & 7;
#pragma unroll
                  for (int j = 0; j < 4; ++j) { const int n = lr + 8 * j; const LAS float* sp = scr + (8 * cc) * 33 + n;
                      u32x2v o; o.x = pg8::pk4_fp8(sp[0 * 33], sp[1 * 33], sp[2 * 33], sp[3 * 33]); o.y = pg8::pk4_fp8(sp[4 * 33], sp[5 * 33], sp[6 * 33], sp[7 * 33]);
                      *(u32x2v*)(I[s].WT + (size_t)(I[s].row_off + I[s].n0 + n) * D + I[s].k0 + 8 * cc) = o; } }
                LDS_WAIT(); asm volatile("" ::: "memory");
            } }
    }
#undef P0_LOAD
    __syncthreads();
}
__device__ __forceinline__ void p0_prologue(const Ctx& C, const Args& a) {
    convert_weights<1>(C, a, 0, C.vcu, C.G);
#if !CONV_X0
    convert_weights<1>(C, a, 1, C.vcu, C.G); convert_weights<1>(C, a, 2, C.vcu, C.G);
#endif
#if !CONV_X1
    convert_weights<1>(C, a, 3, C.vcu, C.G); convert_weights<1>(C, a, 4, C.vcu, C.G);
#endif
    LAS float* cs = (LAS float*)(C.lds + RING_OFF);
    LAS float* red = (LAS float*)(C.lds + RING_OFF + 32768);
    for (int i = C.tid; i < 8192; i += 512) { const float v = a.in[IN_C][i]; cs[i] = v / (1.f + __expf(-v)); }
    __syncthreads();
    float* ADA = (float*)(C.ws + SM_ADA);
    for (int grp = C.vcu; grp < 192; grp += C.G) {
        const int l = grp / 96, col = (grp % 96) * 64 + C.lane;
        const float* w = a.in[IN_ADAW] + (size_t)l * D * 6144 + col;
        float acc[8];
#pragma unroll
        for (int b = 0; b < 8; ++b) acc[b] = 0.f;
        const int kbeg = C.wave * 128;
#pragma unroll 4
        for (int k = kbeg; k < kbeg + 128; k += 4) {
            float wv[4];
#pragma unroll
            for (int j = 0; j < 4; ++j) wv[j] = w[(size_t)(k + j) * 6144];
#pragma unroll
            for (int b = 0; b < 8; ++b) { const f32x4 cv = *(const LAS f32x4*)(cs + b * 1024 + k); acc[b] += cv[0] * wv[0] + cv[1] * wv[1] + cv[2] * wv[2] + cv[3] * wv[3]; }
        }
#pragma unroll
        for (int b = 0; b < 8; ++b) red[(C.wave * 8 + b) * 64 + C.lane] = acc[b];
        __syncthreads();
        { const int b = C.wave; float s = 0.f;
#pragma unroll
          for (int w8 = 0; w8 < 8; ++w8) s += red[(w8 * 8 + b) * 64 + C.lane];
          ADA[(size_t)(l * 8 + b) * 6144 + col] = s + a.in[IN_ADAB][l * 6144 + col]; }
        __syncthreads();
    }
    if (C.vcu == C.G - 1) {
        float* BT = (float*)(C.ws + SM_BIAST);
        for (int i = C.tid; i < 48 * 129; i += 512) { const int gh = i / 129, dl = i % 129, g = gh >> 4, n = dl << (2 * g);
            int bk = n;
            if (n >= 16) { const float nf = (float)n; bk = 16 + (int)(logf(nf / 16.f) / 4.852030263919617f * 16.f); bk = bk > 31 ? 31 : bk; }
            BT[gh * 132 + dl] = a.in[IN_RELB][bk * 48 + gh] * LOG2E; }
    }
}

__device__ __forceinline__ void p1_rows0(const Ctx& C, const Args& a) {
    const float* ADA = (const float*)(C.ws + SM_ADA);
    float* GM = (float*)(C.ws + SM_GM); float* CSH = (float*)(C.ws + SM_CSH);
    const int gt = C.vcu * 512 + C.tid, NGT = C.G * 512;
    for (int i = gt; i < 2 * 2 * 8 * 1024; i += NGT) { const int d = i & 1023, b = (i >> 10) & 7, kind = (i >> 13) & 1, l = i >> 14;
        const float g = kind ? a.in[IN_NFFN][l * D + d] : a.in[IN_NMIX][l * D + d];
        GM[i] = g * (1.f + ADA[(size_t)(l * 8 + b) * 6144 + (kind ? 4 : 1) * 1024 + d]); }
    const int gw = C.vcu * NWAVES + C.wave, NGW = C.G * NWAVES;
    for (int o = gw; o < 512; o += NGW) { const int e = o & 31, b = (o >> 5) & 7, l = o >> 8; float s = 0.f;
        for (int d = C.lane; d < D; d += 64) s += ADA[(size_t)(l * 8 + b) * 6144 + 3 * 1024 + d] * a.in[IN_RW][(size_t)l * D * 32 + d * 32 + e];
        s = wave_sum(s); if (C.lane == 0) CSH[o] = s + a.in[IN_RB][l * 32 + e]; }
    bf16* H = (bf16*)(C.ws + WS_H);
    for (int m = gw; m < T; m += NGW) {
        const int b = m >> 12;
        const f32x4* xr = (const f32x4*)(a.in[IN_X] + (size_t)m * D) + C.lane;
        const f32x4* gr = (const f32x4*)(a.in[IN_NMIX]) + C.lane;
        const f32x4* sc = (const f32x4*)(ADA + (size_t)b * 6144 + 1024) + C.lane;
        const f32x4* sh = (const f32x4*)(ADA + (size_t)b * 6144) + C.lane;
        f32x4 v[4]; float s = 0.f;
#pragma unroll
        for (int j = 0; j < 4; ++j) { v[j] = NT_ROWS ? __builtin_nontemporal_load(xr + 64 * j) : xr[64 * j]; s += (v[j].x * v[j].x + v[j].y * v[j].y) + (v[j].z * v[j].z + v[j].w * v[j].w); }
        const float rstd = 1.f / sqrtf(wave_sum(s) * (1.f / D) + RMS_EPS);
        unsigned long long* o8 = (unsigned long long*)(H + (size_t)m * D) + C.lane; unsigned* o4 = (unsigned*)(C.ws + WS_H8 + (size_t)m * D) + C.lane;
#pragma unroll
        for (int j = 0; j < 4; ++j) { const f32x4 h = v[j] * rstd * gr[64 * j] * (sc[64 * j] + 1.f) + sh[64 * j];
            if (QKV_FP8) o4[64 * j] = pg8::pk4_fp8(h.x, h.y, h.z, h.w);
            else o8[64 * j] = (unsigned long long)pkbf(h.x, h.y) | ((unsigned long long)pkbf(h.z, h.w) << 32); }
    }
}

__device__ __forceinline__ void p3_dilated(const Ctx& C) {
#if BAND_FP8
    attn_body::band8_phase<0>((const unsigned char*)(C.ws + WS_QKV0), (attn_body::bf16*)(C.ws + WS_OG), (float*)(C.ws + SM_LSE), (const float*)(C.ws + SM_BIAST), C.vcu, C.G, 384 * 16, (char*)C.lds + RING_OFF);
    return;
#endif
#if PROBE_BAND
    attn_body::band_phase<PROBE_BAND - 1>((const attn_body::bf16*)(C.ws + WS_QKV0), (attn_body::bf16*)(C.ws + WS_XB), (float*)(C.ws + WS_XB + 200 * MiB), (const float*)(C.ws + SM_BIAST), C.vcu, C.G, 384 * 16, (char*)C.lds + RING_OFF);
#endif
    attn_body::band_phase<0>((const attn_body::bf16*)(C.ws + WS_QKV0), (attn_body::bf16*)(C.ws + WS_OG), (float*)(C.ws + SM_LSE), (const float*)(C.ws + SM_BIAST), C.vcu, C.G, 384 * 16, (char*)C.lds + RING_OFF);
}
template <int MODE> __device__ __forceinline__ void p12_fox(const Ctx& C, size_t o_off, const Args& a) {
#if CONV_X1
    if ((int)blockIdx.x >= C.G - CONV_X1) { const int ci = (int)blockIdx.x - (C.G - CONV_X1);
        convert_weights<CONV_DEPTH>(C, a, 3, ci, CONV_X1); convert_weights<CONV_DEPTH>(C, a, 4, ci, CONV_X1); }
#endif
    const attn_body::bf16* QKV = (const attn_body::bf16*)(C.ws + WS_QKV1);
    attn_body::bf16* O = (attn_body::bf16*)(C.ws + o_off); const float* FC = (const float*)(C.ws + SM_FCUM);
    LAS float* Fl = (LAS float*)(C.lds + RING_OFF + attn_body::T_F);
    LAS int* qslot = (LAS int*)(C.lds + BLK_OFF);
    unsigned* qhead = (unsigned*)(C.ws + WS_CTL) + CW_QUEUE; const unsigned* NRM = (const unsigned*)(C.ws + WS_CTL) + CW_NRM;
    int cur_bh = -1; float thr = 0.f;
    for (;;) {
        int l_; asm volatile("v_mbcnt_lo_u32_b32 %0, -1, 0\n\tv_mbcnt_hi_u32_b32 %0, -1, %0" : "=v"(l_)); const int t_ = C.wave * 64 + l_;
        __syncthreads();
        if (t_ == 0) qslot[0] = (int)__hip_atomic_fetch_add(qhead, 1u, __ATOMIC_RELAXED, __HIP_MEMORY_SCOPE_AGENT);
        __syncthreads();
        const int idx = qslot[0];
        if (idx >= 2048) break;
        const int qb = 15 - (idx >> 7), bh = idx & 127, b = bh >> 4, h = bh & 15, q0 = qb * 256;
        const attn_body::bf16* Qp = QKV + ((size_t)(b * 3 + 0) * 16 + h) * 4096 * 64;
        const attn_body::bf16* Kp = QKV + ((size_t)(b * 3 + 1) * 16 + h) * 4096 * 64;
        const attn_body::bf16* Vp = QKV + ((size_t)(b * 3 + 2) * 16 + h) * 4096 * 64;
        if (bh != cur_bh) {
            { const f32x4* src = (const f32x4*)(FC + (size_t)bh * 4096); LAS f32x4* dst = (LAS f32x4*)Fl; dst[t_] = src[t_]; dst[512 + t_] = src[512 + t_]; }
            const float gq = __uint_as_float(NRM[((b * 2 + 0) * 16 + h) * 2]) + __uint_as_float(NRM[((b * 2 + 0) * 16 + h) * 2 + 1]);
            const float gk = __uint_as_float(NRM[((b * 2 + 1) * 16 + h) * 2]) + __uint_as_float(NRM[((b * 2 + 1) * 16 + h) * 2 + 1]);
            thr = 2.f * (sqrtf(gq) * sqrtf(gk) * 1.001f + 1e-3f) + 152.f;
            cur_bh = bh;
            __syncthreads();
        }
        int tlo = 0;
        if (MODE == 1) {
            const int NTq = 4 * qb;
            const bool dead = (l_ < NTq) && (Fl[q0] - Fl[64 * l_ + 63] <= -thr);
            tlo = __popcll(__ballot(dead)) & ~1;
        }
        attn_body::attn_unit_t<MODE, 64>(Qp + (size_t)q0 * 64, Kp + (size_t)tlo * 4096, Vp + (size_t)tlo * 4096, 4 * qb + 4 - tlo, 64 * tlo, (WO_FP8 && MODE == 1) ? (attn_body::bf16*)((unsigned char*)O + ((size_t)b * 4096 + q0) * D + h * 64) : O + ((size_t)b * 4096 + q0) * D + h * 64, (long)D, nullptr, 0, (char*)C.lds + RING_OFF);
    }
}
__device__ __forceinline__ void p4_merge(const Ctx& C) {
    const bf16* OG = (const bf16*)(C.ws + WS_OG); const float* LSE = (const float*)(C.ws + SM_LSE); bf16* O = (bf16*)(C.ws + WS_O);
    const int gt = C.vcu * 512 + C.tid, NGT = C.G * 512;
    for (int i = gt; i < T * 128; i += NGT) { const int tok = i >> 7, c8 = i & 127, hd = c8 >> 3;
        const float l0 = LSE[(size_t)tok * 16 + hd], l1 = LSE[((size_t)T + tok) * 16 + hd], l2 = LSE[((size_t)2 * T + tok) * 16 + hd];
        const float mx = fmaxf(l0, fmaxf(l1, l2)); float w0 = __builtin_amdgcn_exp2f(l0 - mx), w1 = __builtin_amdgcn_exp2f(l1 - mx), w2 = __builtin_amdgcn_exp2f(l2 - mx);
        const float inv = 1.f / (w0 + w1 + w2); w0 *= inv; w1 *= inv; w2 *= inv;
#if OG_FP8 && BAND_FP8
        const unsigned char* OG8 = (const unsigned char*)OG;
        const u32x2v a0 = __builtin_nontemporal_load((const u32x2v*)(OG8 + (size_t)tok * D + c8 * 8)), a1 = __builtin_nontemporal_load((const u32x2v*)(OG8 + ((size_t)T + tok) * D + c8 * 8)), a2 = __builtin_nontemporal_load((const u32x2v*)(OG8 + ((size_t)2 * T + tok) * D + c8 * 8));
        w0 *= 0.125f; w1 *= 0.125f; w2 *= 0.125f;
        u32x4v o;
#pragma unroll
        for (int wd = 0; wd < 2; ++wd) {
            { const auto f0 = __builtin_amdgcn_cvt_pk_f32_fp8((int)a0[wd], false), f1 = __builtin_amdgcn_cvt_pk_f32_fp8((int)a1[wd], false), f2 = __builtin_amdgcn_cvt_pk_f32_fp8((int)a2[wd], false);
              o[2 * wd] = pkbf(w0 * f0[0] + w1 * f1[0] + w2 * f2[0], w0 * f0[1] + w1 * f1[1] + w2 * f2[1]); }
            { const auto f0 = __builtin_amdgcn_cvt_pk_f32_fp8((int)a0[wd], true), f1 = __builtin_amdgcn_cvt_pk_f32_fp8((int)a1[wd], true), f2 = __builtin_amdgcn_cvt_pk_f32_fp8((int)a2[wd], true);
              o[2 * wd + 1] = pkbf(w0 * f0[0] + w1 * f1[0] + w2 * f2[0], w0 * f0[1] + w1 * f1[1] + w2 * f2[1]); } }
#else
        const u32x4v a0 = NT_ROWS ? __builtin_nontemporal_load((const u32x4v*)(OG + (size_t)tok * D + c8 * 8)) : *(const u32x4v*)(OG + (size_t)tok * D + c8 * 8), a1 = NT_ROWS ? __builtin_nontemporal_load((const u32x4v*)(OG + ((size_t)T + tok) * D + c8 * 8)) : *(const u32x4v*)(OG + ((size_t)T + tok) * D + c8 * 8), a2 = NT_ROWS ? __builtin_nontemporal_load((const u32x4v*)(OG + ((size_t)2 * T + tok) * D + c8 * 8)) : *(const u32x4v*)(OG + ((size_t)2 * T + tok) * D + c8 * 8);
        u32x4v o;
#pragma unroll
        for (int k = 0; k < 4; ++k) { const float lo = w0 * bf2f(a0[k] & 0xffffu) + w1 * bf2f(a1[k] & 0xffffu) + w2 * bf2f(a2[k] & 0xffffu);
            float hi = w0 * bf2f(a0[k] >> 16) + w1 * bf2f(a1[k] >> 16) + w2 * bf2f(a2[k] >> 16); float lo2 = lo;
#if PROBE_SANITIZE
            if (!(fabsf(lo2) < 1e30f)) lo2 = 0.f; if (!(fabsf(hi) < 1e30f)) hi = 0.f;
#endif
            o[k] = pkbf(lo2, hi); }
#endif
        if (WO_FP8) { u32x2v o8; o8.x = pg8::pk4_fp8(bf2f(o[0] & 0xffffu), bf2f(o[0] >> 16), bf2f(o[1] & 0xffffu), bf2f(o[1] >> 16)); o8.y = pg8::pk4_fp8(bf2f(o[2] & 0xffffu), bf2f(o[2] >> 16), bf2f(o[3] & 0xffffu), bf2f(o[3] >> 16));
            *(u32x2v*)((unsigned char*)O + (size_t)tok * D + c8 * 8) = o8; }
        else *(u32x4v*)(O + (size_t)tok * D + c8 * 8) = o; }
}

__device__ __forceinline__ f32x4 bf4_to_f32(u32x2v v) { return (f32x4){bf2f(v.x & 0xffffu), bf2f(v.x >> 16), bf2f(v.y & 0xffffu), bf2f(v.y >> 16)}; }
typedef u32x2v xs4_t;
__device__ __forceinline__ f32x4 xs4_to_f32(xs4_t v) { return bf4_to_f32(v); }
__device__ __forceinline__ xs4_t f32_to_xs4(f32x4 v) { xs4_t r; r.x = pkbf(v.x, v.y); r.y = pkbf(v.z, v.w); return r; }
#if Y_FP8
typedef unsigned yraw4_t;
__device__ __forceinline__ f32x4 y4_to_f32(yraw4_t v) { const auto lo = __builtin_amdgcn_cvt_pk_f32_fp8((int)v, false), hi = __builtin_amdgcn_cvt_pk_f32_fp8((int)v, true); return (f32x4){lo[0], lo[1], hi[0], hi[1]}; }
#define Y_ROWPTR(Yb, slot) ((const yraw4_t*)((const unsigned char*)(Yb) + (size_t)(slot) * D) + C.lane)
#else
typedef u32x2v yraw4_t;
__device__ __forceinline__ f32x4 y4_to_f32(yraw4_t v) { return bf4_to_f32(v); }
#define Y_ROWPTR(Yb, slot) ((const yraw4_t*)((Yb) + (size_t)(slot) * D) + C.lane)
#endif

__device__ __forceinline__ void r1_router(const Ctx& C, const Args& a, int l) {
    LAS float* scrf = (LAS float*)(C.lds + SCR_OFF + C.wave * 2048);
    LAS int* scri = (LAS int*)scrf;
    LAS int* blk = (LAS int*)(C.lds + BLK_OFF);
    const float* rw = a.in[IN_RW] + (size_t)l * D * 32;
    LAS unsigned short* wh = (LAS unsigned short*)(C.lds + RING_OFF); LAS unsigned short* wlo = (LAS unsigned short*)(C.lds + RING_OFF + 65536);
    int tab_b = -1;
    const bf16* XS = (const bf16*)(C.ws + WS_XS); unsigned char* H8 = (unsigned char*)(C.ws + WS_H8);
    const float* ADA = (const float*)(C.ws + SM_ADA) + (size_t)l * 8 * 6144;
    const float* GM = (const float*)(C.ws + SM_GM) + (size_t)(l * 2 + 1) * 8 * 1024;
    const float* CSH = (const float*)(C.ws + SM_CSH) + l * 256;
    int* TOPI = (int*)(C.ws + SM_TOPI); float* TOPG = (float*)(C.ws + SM_TOPG); int* RANK = (int*)(C.ws + SM_RANK); int* BLKCNT = (int*)(C.ws + SM_BLKCNT);
    const int tk = C.lane & 15, q = C.lane >> 4;
    for (int vb = C.vcu; vb < NVB; vb += C.G) {
        const int tok0 = vb * 128 + C.wave * 16, b = tok0 >> 12, tok = tok0 + tk;
        if (b != tab_b) {
            __syncthreads();
            const float* gmb = GM + b * 1024;
            for (int i = C.tid; i < D * 32; i += 512) { const int dd = i >> 5, e = i & 31; const float w = rw[i] * gmb[dd];
                const unsigned hb = pkbf(w, 0.f) & 0xffffu; const float hf = bf2f(hb); const unsigned lb = pkbf(w - hf, 0.f) & 0xffffu;
                const int pos = ((((dd >> 5) * 4 + ((dd >> 3) & 3)) * 32 + e) << 3) + (dd & 7);
                wh[pos] = (unsigned short)hb; wlo[pos] = (unsigned short)lb; }
            __syncthreads();
            tab_b = b;
        }
        const bf16* xrow = XS + (size_t)tok * D + 8 * q;
        f32x4 acc0 = {0.f, 0.f, 0.f, 0.f}, acc1 = {0.f, 0.f, 0.f, 0.f}; float ssq = 0.f;
        typedef short bf16x8r __attribute__((ext_vector_type(8)));
#pragma unroll 4
        for (int kk = 0; kk < 32; ++kk) {
            const u32x4v xr8 = *(const u32x4v*)(xrow + 32 * kk);
#pragma unroll
            for (int e2 = 0; e2 < 4; ++e2) { const float x0 = bf2f(xr8[e2] & 0xffffu), x1 = bf2f(xr8[e2] >> 16); ssq += x0 * x0 + x1 * x1; }
            const bf16x8r xb = __builtin_bit_cast(bf16x8r, xr8);
            const int fo = ((kk * 4 + q) * 32 + tk) << 3;
            const bf16x8r h0 = *(const LAS bf16x8r*)(wh + fo), h1 = *(const LAS bf16x8r*)(wh + fo + 128), l0 = *(const LAS bf16x8r*)(wlo + fo), l1 = *(const LAS bf16x8r*)(wlo + fo + 128);
            acc0 = __builtin_amdgcn_mfma_f32_16x16x32_bf16(h0, xb, acc0, 0, 0, 0); acc1 = __builtin_amdgcn_mfma_f32_16x16x32_bf16(h1, xb, acc1, 0, 0, 0);
            acc0 = __builtin_amdgcn_mfma_f32_16x16x32_bf16(l0, xb, acc0, 0, 0, 0); acc1 = __builtin_amdgcn_mfma_f32_16x16x32_bf16(l1, xb, acc1, 0, 0, 0);
        }
        ssq += __shfl_xor(ssq, 16); ssq += __shfl_xor(ssq, 32);
        const float rstd = 1.f / sqrtf(ssq * (1.f / D) + RMS_EPS);
        { const f32x4 c0 = *(const f32x4*)(CSH + b * 32 + 4 * q), c1 = *(const f32x4*)(CSH + b * 32 + 16 + 4 * q);
          *(LAS f32x4*)(scrf + tk * 32 + 4 * q) = acc0 * rstd + c0; *(LAS f32x4*)(scrf + tk * 32 + 16 + 4 * q) = acc1 * rstd + c1; }
        LDS_WAIT();
        int myidx[4] = {0, 0, 0, 0};
        if (C.lane < 16) {
            float v[32];
#pragma unroll
            for (int j = 0; j < 8; ++j) { const f32x4 t4 = *(const LAS f32x4*)(scrf + C.lane * 32 + 4 * j); v[4 * j] = t4.x; v[4 * j + 1] = t4.y; v[4 * j + 2] = t4.z; v[4 * j + 3] = t4.w; }
            float val[4];
#pragma unroll
            for (int k = 0; k < 4; ++k) { float best = v[0]; int bi = 0;
#pragma unroll
                for (int e = 1; e < 32; ++e) { if (v[e] > best) { best = v[e]; bi = e; } }
                val[k] = best; myidx[k] = bi;
#pragma unroll
                for (int e = 0; e < 32; ++e) v[e] = (e == bi) ? -INFINITY : v[e]; }
            const float e1 = __expf(val[1] - val[0]), e2 = __expf(val[2] - val[0]), e3 = __expf(val[3] - val[0]), inv = 1.f / (1.f + e1 + e2 + e3);
            *(i32x4v*)(TOPI + (size_t)(tok0 + C.lane) * 4) = (i32x4v){myidx[0], myidx[1], myidx[2], myidx[3]};
            *(f32x4*)(TOPG + (size_t)(tok0 + C.lane) * 4) = (f32x4){inv, e1 * inv, e2 * inv, e3 * inv};
        }
        LDS_WAIT();
        if (C.lane < 16) *(LAS i32x4v*)(scri + C.lane * 4) = (i32x4v){myidx[0], myidx[1], myidx[2], myidx[3]};
        LDS_WAIT();
        const int e = scri[C.lane];
        const unsigned long long lt = (1ull << C.lane) - 1ull;
        int rank = 0, mycnt = 0;
#pragma unroll 4
        for (int j = 0; j < 32; ++j) { const unsigned long long mk = __ballot(e == j); if (e == j) rank = __popcll(mk & lt); if (C.lane == j) mycnt = __popcll(mk); }
        if (C.lane < 32) blk[BL_WCNT + C.wave * 32 + C.lane] = mycnt;
        __syncthreads();
        if (C.lane < 32) { int wb = 0;
            for (int w8 = 0; w8 < C.wave; ++w8) wb += blk[BL_WCNT + w8 * 32 + C.lane];
            blk[BL_WBASE + C.wave * 32 + C.lane] = wb;
            if (C.wave == NWAVES - 1) BLKCNT[vb * 32 + C.lane] = wb + mycnt; }
        LDS_WAIT();
        RANK[(size_t)tok0 * 4 + C.lane] = blk[BL_WBASE + C.wave * 32 + e] + rank;
        const f32x4* shf = (const f32x4*)(ADA + (size_t)b * 6144 + 3 * 1024) + C.lane; const f32x4* gm4 = (const f32x4*)(GM + b * 1024) + C.lane;
#pragma unroll 2
        for (int tt = 0; tt < 16; ++tt) { const float rs = __shfl(rstd, tt); const int tkn = tok0 + tt;
            const xs4_t* xr = (const xs4_t*)(XS + (size_t)tkn * D) + C.lane; unsigned* o4 = (unsigned*)(H8 + (size_t)tkn * D) + C.lane;
#pragma unroll
            for (int j = 0; j < 4; ++j) { const f32x4 h = xs4_to_f32(xr[64 * j]) * rs * gm4[64 * j] + shf[64 * j];
                o4[64 * j] = pg8::pk4_fp8(h.x, h.y, h.z, h.w); } }
        __syncthreads();
    }
}

__device__ __forceinline__ void p7_route(const Ctx& C) {
    LAS int* blk = (LAS int*)(C.lds + BLK_OFF);
    const int* BLKCNT = (const int*)(C.ws + SM_BLKCNT); const int* TOPI = (const int*)(C.ws + SM_TOPI); const int* RANK = (const int*)(C.ws + SM_RANK);
    int* SLOT = (int*)(C.ws + SM_SLOT); int* TILEEXP = (int*)(C.ws + SM_TILEEXP); int* TOKSLOT = (int*)(C.ws + SM_TOKSLOT);
    const unsigned char* H8 = (const unsigned char*)(C.ws + WS_H8); unsigned char* XB = (unsigned char*)(C.ws + WS_XB);
    const int e = C.tid & 31, part = C.tid >> 5;
    { int s = 0; for (int k = 0; k < 16; ++k) s += BLKCNT[(part * 16 + k) * 32 + e]; blk[BL_PARTA + part * 32 + e] = s; }
    __syncthreads();
    if (C.tid < 32) { int tot = 0; for (int p = 0; p < 16; ++p) tot += blk[BL_PARTA + p * 32 + C.tid]; blk[BL_TOT + C.tid] = tot; }
    __syncthreads();
    if (C.tid == 0) { int run = 0; for (int k = 0; k < 32; ++k) { blk[BL_PADS + k] = run; run += (blk[BL_TOT + k] + 255) & ~255; } blk[BL_PADS + 32] = run; }
    __syncthreads();
    if (C.vcu == 0) {
        const int nt = blk[BL_PADS + 32] >> 8;
        if (C.tid == 0) TILEEXP[0] = nt;
        for (int i = C.tid; i < nt; i += 512) { int ex = 0; for (int k = 1; k < 32; ++k) ex += (blk[BL_PADS + k] <= i * 256) ? 1 : 0; TILEEXP[16 + i] = ex; }
        if (C.tid < 33) TILEEXP[640 + C.tid] = blk[BL_PADS + C.tid] >> 8;
    }
    for (int vb = C.vcu; vb < NVB; vb += C.G) {
        __syncthreads();
        { int s = 0; for (int k = 0; k < 16; ++k) { const int bb = part * 16 + k; s += (bb < vb) ? BLKCNT[bb * 32 + e] : 0; } blk[BL_PARTB + part * 32 + e] = s; }
        __syncthreads();
        if (C.tid < 32) { int bs = 0; for (int p = 0; p < 16; ++p) bs += blk[BL_PARTB + p * 32 + C.tid]; blk[BL_BASE + C.tid] = bs + blk[BL_PADS + C.tid]; }
        __syncthreads();
        { const int i = vb * 512 + C.tid; const int ex = TOPI[i]; SLOT[i] = blk[BL_BASE + ex] + RANK[i]; }
        VM_WAIT(); __syncthreads();
#if MOE_GATHER
        { const int i = vb * 512 + C.tid; TOKSLOT[SLOT[i]] = i >> 2; }
#else
        for (int tt = 0; tt < 16; ++tt) { const int tok = vb * 128 + C.wave * 16 + tt;
            const i32x4v sl = *(const i32x4v*)(SLOT + (size_t)tok * 4);
            const u32x4v v0 = *((const u32x4v*)(H8 + (size_t)tok * D) + C.lane);
#pragma unroll
            for (int k = 0; k < 4; ++k) { u32x4v* dst = (u32x4v*)(XB + (size_t)sl[k] * D); dst[C.lane] = v0; } }
#endif
    }
#if MOE_GATHER
    for (int ex = C.vcu; ex < 32; ex += C.G) { const int beg = blk[BL_PADS + ex] + blk[BL_TOT + ex], end = blk[BL_PADS + ex + 1];
        for (int s = beg + C.tid; s < end; s += 512) TOKSLOT[s] = 0; }
#endif
}
__device__ __forceinline__ int load_tile_table(const Ctx& C) {
    LAS int* blk = (LAS int*)(C.lds + BLK_OFF); const int* TILEEXP = (const int*)(C.ws + SM_TILEEXP);
    const int nt = TILEEXP[0];
    __syncthreads();
    for (int i = C.tid; i < MAXTILES; i += 512) blk[BL_TILE + i] = (i < nt) ? TILEEXP[16 + i] : 0;
    __syncthreads();
    return __builtin_amdgcn_readfirstlane(nt);
}


__device__ __forceinline__ void r2_seam(const Ctx& C, const Args& a) {
    LAS float* wl = (LAS float*)(C.lds + RING_OFF);
    { const float* wf = a.in[IN_WKVF]; const float* gkv0 = a.in[IN_KVNG];
      for (int i = C.tid; i < D * 16; i += 512) { const int d = i >> 4, h = i & 15, jj = d >> 8, ln = (d >> 2) & 63, c = d & 3;
          wl[((((jj * 4 + c) * 4 + (h >> 2)) * 64 + ln) << 2) + (h & 3)] = wf[(size_t)d * 2064 + 2048 + h] * gkv0[d]; } }
    __syncthreads();
    bf16* XS = (bf16*)(C.ws + WS_XS); bf16* HKV = (bf16*)(C.ws + WS_HKV); const bf16* Y = (const bf16*)(C.ws + WS_Y);
    const float* ADA0 = (const float*)(C.ws + SM_ADA); const float* ADA1 = ADA0 + (size_t)8 * 6144;
    const float* GM1 = (const float*)(C.ws + SM_GM) + (size_t)(1 * 2 + 0) * 8 * 1024;
    const int* SLOT = (const int*)(C.ws + SM_SLOT); const float* TOPG = (const float*)(C.ws + SM_TOPG); float* LOGF = (float*)(C.ws + SM_LOGF);
    const f32x4* gk4 = (const f32x4*)a.in[IN_KVNG] + C.lane;
    const int gw = C.vcu * NWAVES + C.wave, NGW = C.G * NWAVES;
    const float bfh = a.in[IN_BF][(C.lane >> 2) & 15];
    typedef yraw4_t yraw_t;
#define R2_LOADRAW(XR, Y0, Y1, Y2, Y3, MM, SS) do { const xs4_t* xr_ = (const xs4_t*)(XS + (size_t)(MM) * D) + C.lane; \
        const yraw4_t* z0_ = Y_ROWPTR(Y, (SS)[0]); const yraw4_t* z1_ = Y_ROWPTR(Y, (SS)[1]); \
        const yraw4_t* z2_ = Y_ROWPTR(Y, (SS)[2]); const yraw4_t* z3_ = Y_ROWPTR(Y, (SS)[3]); \
        _Pragma("unroll") for (int j = 0; j < 4; ++j) { if (NT_ROWS) { XR[j] = __builtin_nontemporal_load(xr_ + 64 * j); Y0[j] = __builtin_nontemporal_load(z0_ + 64 * j); Y1[j] = __builtin_nontemporal_load(z1_ + 64 * j); Y2[j] = __builtin_nontemporal_load(z2_ + 64 * j); Y3[j] = __builtin_nontemporal_load(z3_ + 64 * j); } else { XR[j] = xr_[64 * j]; Y0[j] = z0_[64 * j]; Y1[j] = z1_[64 * j]; Y2[j] = z2_[64 * j]; Y3[j] = z3_[64 * j]; } } } while (0)
    xs4_t xc[4], xn[4]; yraw_t y0c[4], y1c[4], y2c[4], y3c[4], y0n[4], y1n[4], y2n[4], y3n[4];
    i32x4v s_cur = *(const i32x4v*)(SLOT + (size_t)gw * 4); f32x4 g_cur = *(const f32x4*)(TOPG + (size_t)gw * 4);
    i32x4v s_nxt = s_cur; f32x4 g_nxt = g_cur;
    if (gw + NGW < T) { s_nxt = *(const i32x4v*)(SLOT + (size_t)(gw + NGW) * 4); g_nxt = *(const f32x4*)(TOPG + (size_t)(gw + NGW) * 4); }
    R2_LOADRAW(xc, y0c, y1c, y2c, y3c, gw, s_cur);
    for (int m = gw; m < T; m += NGW) { const int b = m >> 12;
        const int mn = m + NGW, mnn = m + 2 * NGW;
        i32x4v s_nn = s_nxt; f32x4 g_nn = g_nxt;
        if (mnn < T) { s_nn = *(const i32x4v*)(SLOT + (size_t)mnn * 4); g_nn = *(const f32x4*)(TOPG + (size_t)mnn * 4); }
        if (mn < T) R2_LOADRAW(xn, y0n, y1n, y2n, y3n, mn, s_nxt);
        const f32x4* gf4 = (const f32x4*)(ADA0 + (size_t)b * 6144 + 5 * 1024) + C.lane;
        const f32x4* gm4 = (const f32x4*)(GM1 + b * 1024) + C.lane; const f32x4* shm4 = (const f32x4*)(ADA1 + (size_t)b * 6144) + C.lane;
        xs4_t* xw = (xs4_t*)(XS + (size_t)m * D) + C.lane;
        f32x4 v[4]; float s = 0.f;
#pragma unroll
        for (int j = 0; j < 4; ++j) {
            const f32x4 ys = y4_to_f32(y0c[j]) * g_cur[0] + y4_to_f32(y1c[j]) * g_cur[1] + y4_to_f32(y2c[j]) * g_cur[2] + y4_to_f32(y3c[j]) * g_cur[3];
            v[j] = xs4_to_f32(xc[j]) + gf4[64 * j] * ys; xw[64 * j] = f32_to_xs4(v[j]); v[j] = xs4_to_f32(f32_to_xs4(v[j]));
            s += (v[j].x * v[j].x + v[j].y * v[j].y) + (v[j].z * v[j].z + v[j].w * v[j].w); }
        const float rstd = 1.f / sqrtf(wave_sum(s) * (1.f / D) + RMS_EPS);
        float acc[16];
#pragma unroll
        for (int h = 0; h < 16; ++h) acc[h] = 0.f;
#pragma unroll
        for (int j = 0; j < 4; ++j)
#pragma unroll
            for (int c = 0; c < 4; ++c) { const float xv = v[j][c];
#pragma unroll
                for (int h4 = 0; h4 < 4; ++h4) { const f32x4 w = *(const LAS f32x4*)(wl + ((((j * 4 + c) * 4 + h4) * 64 + C.lane) << 2));
                    acc[4 * h4] += xv * w[0]; acc[4 * h4 + 1] += xv * w[1]; acc[4 * h4 + 2] += xv * w[2]; acc[4 * h4 + 3] += xv * w[3]; }
                if (c == 3) __builtin_amdgcn_sched_barrier(0); }
#pragma unroll
        for (int j = 0; j < 4; ++j) { const f32x4 n = v[j] * rstd, h = n * gm4[64 * j] + shm4[64 * j], hk = n * gk4[64 * j];
            if (KVQ_FP8) { ((unsigned*)(C.ws + WS_HKV + (size_t)T * D + (size_t)m * D) + C.lane)[64 * j] = pg8::pk4_fp8(h.x, h.y, h.z, h.w);
                           ((unsigned*)(C.ws + WS_HKV + (size_t)m * D) + C.lane)[64 * j] = pg8::pk4_fp8(hk.x, hk.y, hk.z, hk.w); }
            else { ((unsigned long long*)(HKV + (size_t)T * D + (size_t)m * D) + C.lane)[64 * j] = (unsigned long long)pkbf(h.x, h.y) | ((unsigned long long)pkbf(h.z, h.w) << 32);
                   ((unsigned long long*)(HKV + (size_t)m * D) + C.lane)[64 * j] = (unsigned long long)pkbf(hk.x, hk.y) | ((unsigned long long)pkbf(hk.z, hk.w) << 32); } }
        __builtin_amdgcn_sched_barrier(0);
        float r8[8], r4[4], r2v[2], r1;
        { const bool up = (C.lane & 32) != 0;
#pragma unroll
          for (int i = 0; i < 8; ++i) { const float snd = up ? acc[i] : acc[i + 8], kp = up ? acc[i + 8] : acc[i]; r8[i] = kp + __shfl_xor(snd, 32); } }
        { const bool up = (C.lane & 16) != 0;
#pragma unroll
          for (int i = 0; i < 4; ++i) { const float snd = up ? r8[i] : r8[i + 4], kp = up ? r8[i + 4] : r8[i]; r4[i] = kp + __shfl_xor(snd, 16); } }
        { const bool up = (C.lane & 8) != 0;
#pragma unroll
          for (int i = 0; i < 2; ++i) { const float snd = up ? r4[i] : r4[i + 2], kp = up ? r4[i + 2] : r4[i]; r2v[i] = kp + __shfl_xor(snd, 8); } }
        { const bool up = (C.lane & 4) != 0; const float snd = up ? r2v[0] : r2v[1], kp = up ? r2v[1] : r2v[0]; r1 = kp + __shfl_xor(snd, 4); }
        r1 += __shfl_xor(r1, 2); r1 += __shfl_xor(r1, 1);
        if ((C.lane & 3) == 0) { const float z = r1 * rstd + bfh; LOGF[(size_t)m * 16 + ((C.lane >> 2) & 15)] = (fminf(z, 0.f) - log1pf(__expf(-fabsf(z)))) * LOG2E; }
#pragma unroll
        for (int j = 0; j < 4; ++j) { xc[j] = xn[j]; y0c[j] = y0n[j]; y1c[j] = y1n[j]; y2c[j] = y2n[j]; y3c[j] = y3n[j]; }
        s_cur = s_nxt; g_cur = g_nxt; s_nxt = s_nn; g_nxt = g_nn;
    }
#undef R2_LOADRAW
}
__device__ __forceinline__ void fcum_scan(const Ctx& C) {
    const float* LOGF = (const float*)(C.ws + SM_LOGF); float* FC = (float*)(C.ws + SM_FCUM);
    LAS float* wtot = (LAS float*)(C.lds + BLK_OFF);
    for (int sq = C.vcu; sq < 128; sq += C.G) { const int b = sq >> 4, h = sq & 15;
        const float* src = LOGF + ((size_t)b * 4096 + C.tid * 8) * 16 + h; float* dst = FC + (size_t)sq * 4096 + C.tid * 8;
        float v[8]; float tot = 0.f;
#pragma unroll
        for (int i = 0; i < 8; ++i) { v[i] = src[i * 16]; }
#pragma unroll
        for (int i = 0; i < 8; ++i) { tot += v[i]; v[i] = tot; }
        float inc = tot;
#pragma unroll
        for (int o = 1; o < 64; o <<= 1) { const float t = __shfl_up(inc, o); if (C.lane >= o) inc += t; }
        __syncthreads();
        if (C.lane == 63) wtot[C.wave] = inc;
        __syncthreads();
        float carry = inc - tot;
        for (int w8 = 0; w8 < C.wave; ++w8) carry += wtot[w8];
#pragma unroll
        for (int i = 0; i < 8; ++i) dst[i] = v[i] + carry;
    }
}
__device__ __forceinline__ void r3_final(const Ctx& C, const Args& a, float* XD) {
    const bf16* XS = (const bf16*)(C.ws + WS_XS); const bf16* Y = (const bf16*)(C.ws + WS_Y);
    const float* ADA1 = (const float*)(C.ws + SM_ADA) + (size_t)8 * 6144;
    const int* SLOT = (const int*)(C.ws + SM_SLOT); const float* TOPG = (const float*)(C.ws + SM_TOPG);
    const f32x4* fg4 = (const f32x4*)a.in[IN_FNG] + C.lane;
    const int gw = C.vcu * NWAVES + C.wave, NGW = C.G * NWAVES;
#define R3_LOADRAW(XR, Y0, Y1, Y2, Y3, MM, SS) do { const xs4_t* xr_ = (const xs4_t*)(XS + (size_t)(MM) * D) + C.lane; \
        const yraw4_t* z0_ = Y_ROWPTR(Y, (SS)[0]); const yraw4_t* z1_ = Y_ROWPTR(Y, (SS)[1]); \
        const yraw4_t* z2_ = Y_ROWPTR(Y, (SS)[2]); const yraw4_t* z3_ = Y_ROWPTR(Y, (SS)[3]); \
        _Pragma("unroll") for (int j = 0; j < 4; ++j) { if (NT_ROWS) { XR[j] = __builtin_nontemporal_load(xr_ + 64 * j); Y0[j] = __builtin_nontemporal_load(z0_ + 64 * j); Y1[j] = __builtin_nontemporal_load(z1_ + 64 * j); Y2[j] = __builtin_nontemporal_load(z2_ + 64 * j); Y3[j] = __builtin_nontemporal_load(z3_ + 64 * j); } else { XR[j] = xr_[64 * j]; Y0[j] = z0_[64 * j]; Y1[j] = z1_[64 * j]; Y2[j] = z2_[64 * j]; Y3[j] = z3_[64 * j]; } } } while (0)
    xs4_t xc[4], xn[4]; yraw4_t y0c[4], y1c[4], y2c[4], y3c[4], y0n[4], y1n[4], y2n[4], y3n[4];
    i32x4v s_cur = *(const i32x4v*)(SLOT + (size_t)gw * 4); f32x4 g_cur = *(const f32x4*)(TOPG + (size_t)gw * 4);
    i32x4v s_nxt = s_cur; f32x4 g_nxt = g_cur;
    if (gw + NGW < T) { s_nxt = *(const i32x4v*)(SLOT + (size_t)(gw + NGW) * 4); g_nxt = *(const f32x4*)(TOPG + (size_t)(gw + NGW) * 4); }
    R3_LOADRAW(xc, y0c, y1c, y2c, y3c, gw, s_cur);
    for (int m = gw; m < T; m += NGW) { const int b = m >> 12;
        const int mn = m + NGW, mnn = m + 2 * NGW;
        i32x4v s_nn = s_nxt; f32x4 g_nn = g_nxt;
        if (mnn < T) { s_nn = *(const i32x4v*)(SLOT + (size_t)mnn * 4); g_nn = *(const f32x4*)(TOPG + (size_t)mnn * 4); }
        if (mn < T) R3_LOADRAW(xn, y0n, y1n, y2n, y3n, mn, s_nxt);
        const f32x4* gf4 = (const f32x4*)(ADA1 + (size_t)b * 6144 + 5 * 1024) + C.lane;
        f32x4* xw = (f32x4*)(XD + (size_t)m * D) + C.lane;
        f32x4 v[4]; float s = 0.f;
#pragma unroll
        for (int j = 0; j < 4; ++j) {
            const f32x4 ys = y4_to_f32(y0c[j]) * g_cur[0] + y4_to_f32(y1c[j]) * g_cur[1] + y4_to_f32(y2c[j]) * g_cur[2] + y4_to_f32(y3c[j]) * g_cur[3];
            v[j] = xs4_to_f32(xc[j]) + gf4[64 * j] * ys; s += (v[j].x * v[j].x + v[j].y * v[j].y) + (v[j].z * v[j].z + v[j].w * v[j].w); }
        const float rstd = 1.f / sqrtf(wave_sum(s) * (1.f / D) + RMS_EPS);
#pragma unroll
        for (int j = 0; j < 4; ++j) xw[64 * j] = v[j] * rstd * fg4[64 * j];
#pragma unroll
        for (int j = 0; j < 4; ++j) { xc[j] = xn[j]; y0c[j] = y0n[j]; y1c[j] = y1n[j]; y2c[j] = y2n[j]; y3c[j] = y3n[j]; }
        s_cur = s_nxt; g_cur = g_nxt; s_nxt = s_nn; g_nxt = g_nn;
    }
#undef R3_LOADRAW
}

constexpr int N_PHASES = 19;
__global__ void __launch_bounds__(NWAVES * 64, 2) yoco_fwd(Args args) {
    extern __shared__ __attribute__((aligned(16))) unsigned char lds[];
    Ctx C;
    C.lds = (LAS unsigned char*)lds; C.ws = args.ws;
    C.tid = threadIdx.x; C.lane = C.tid & 63; C.wave = __builtin_amdgcn_readfirstlane(C.tid >> 6);
    C.G = gridDim.x; { const int bx = blockIdx.x; C.vcu = (C.G % 8 == 0) ? (bx % 8) * (C.G / 8) + bx / 8 : bx; }
    volatile LAS unsigned* MISC = (volatile LAS unsigned*)(C.lds + MISC_OFF);
    if (C.tid < 64) MISC[C.tid] = 0u;
    __syncthreads();
    const int lo = args.ph_lo, hi = args.ph_hi;
    const bool one = (hi - lo) > 1;
    unsigned* ctl = (unsigned*)(args.ws + WS_CTL);
    XcdBarrier bar; bar.bar = ctl + CW_BAR; bar.x = 0; bar.st = nullptr;
    if (one) bar = xcd_barrier_post(ctl + CW_BAR, MISC + 8);
#define IN(k) (lo <= (k) && (k) < hi)
#define SEAM(k) do { if (IN(k) && IN((k) + 1)) xcd_barrier(bar); } while (0)
#define FRESH() do { int l_; asm volatile("v_mbcnt_lo_u32_b32 %0, -1, 0\n\tv_mbcnt_hi_u32_b32 %0, -1, %0" : "=v"(l_)); C.lane = l_; C.tid = C.wave * 64 + l_; } while (0)
#define REP(k) _Pragma("unroll") for (int rep_ = 0; rep_ < 1 + ((PROBE_DUP >> (k)) & 1); ++rep_)
    bf16* const Hb = (bf16*)(C.ws + WS_H);
    if (IN(0)) { FRESH(); REP(0) { p0_prologue(C, args); } SEAM(0); }
    if (IN(1)) { FRESH(); REP(1) { p1_rows0(C, args); } SEAM(1); }
    if (IN(2)) { FRESH();
#if PROBE_QKV
        { pg8::Gemm g{(const pg8::bf16_t*)(C.ws + WS_H8), (const pg8::bf16_t*)(C.ws + WS_WQKV), T, NQKV, D}; pg8::StaticOrder S; S.init(T, NQKV, C.G, (int)blockIdx.x);
#if PROBE_QKV == 1
          pg8::EpiQKV0 E{(pg8::bf16_t*)(C.ws + WS_QKV0), 0.015625f};
          pg8::gemm_phase<pg8::EpiQKV0, pg8::StaticOrder, true, true, 1>(C.lds + RING_OFF, g, S, E);
#elif PROBE_QKV == 2
          pg8::EpiQKV0Probe E{(pg8::bf16_t*)(C.ws + WS_XB), 0.015625f, 4};
          pg8::gemm_phase<pg8::EpiQKV0Probe, pg8::StaticOrder, true, true, 1>(C.lds + RING_OFF, g, S, E);
#else
          pg8::EpiNone E{(unsigned char*)(C.ws + WS_XB)};
          pg8::gemm_phase<pg8::EpiNone, pg8::StaticOrder, true, true, 1>(C.lds + RING_OFF, g, S, E);
#endif
        }
#endif
#if STAGGER_QKV
        { const unsigned long long t0 = __builtin_amdgcn_s_memrealtime(); const unsigned long long dl = (unsigned long long)(C.vcu & 7) * STAGGER_QKV;
          while (__builtin_amdgcn_s_memrealtime() - t0 < dl) __builtin_amdgcn_s_sleep(8); }
#endif
        REP(2) {
#if CONV_X0
        if ((int)blockIdx.x >= C.G - CONV_X0) { const int ci = (int)blockIdx.x - (C.G - CONV_X0);
            convert_weights<CONV_DEPTH>(C, args, 1, ci, CONV_X0); convert_weights<CONV_DEPTH>(C, args, 2, ci, CONV_X0); } else
#endif
        {
        pg8::Gemm g{QKV_FP8 ? (const pg8::bf16_t*)(C.ws + WS_H8) : (const pg8::bf16_t*)Hb, (const pg8::bf16_t*)(C.ws + WS_WQKV), T, NQKV, D}; pg8::StaticOrder S; S.init(T, NQKV, C.G - CONV_X0, (int)blockIdx.x);
#if BAND_FP8
#if QKV_WIDE
        pg8::EpiQKV08W E{(unsigned char*)(C.ws + WS_QKV0), QKV_FP8 ? 0.015625f : 1.f};
        pg8::gemm_phase<pg8::EpiQKV08W, pg8::StaticOrder, true, true, QKV_FP8 ? 1 : 2, false, 1>(C.lds + RING_OFF, g, S, E);
#else
        pg8::EpiQKV08 E{(unsigned char*)(C.ws + WS_QKV0), QKV_FP8 ? 0.015625f : 1.f};
        pg8::gemm_phase<pg8::EpiQKV08, pg8::StaticOrder, true, true, QKV_FP8 ? 1 : 2>(C.lds + RING_OFF, g, S, E);
#endif
#else
        pg8::EpiQKV0 E{(pg8::bf16_t*)(C.ws + WS_QKV0), QKV_FP8 ? 0.015625f : 1.f};
        pg8::gemm_phase<pg8::EpiQKV0, pg8::StaticOrder, true, true, QKV_FP8 ? 1 : 2>(C.lds + RING_OFF, g, S, E);
#endif
        } } SEAM(2);
    }
    if (IN(3)) { FRESH(); REP(3) { p3_dilated(C); } SEAM(3); }
    if (IN(4)) { FRESH(); REP(4) { p4_merge(C); } SEAM(4); }
    if (IN(5)) { FRESH(); REP(5) {
        pg8::Gemm g{(const pg8::bf16_t*)(C.ws + WS_O), (const pg8::bf16_t*)(C.ws + WS_WO0), T, D, D}; pg8::StaticOrder S; S.init(T, D, C.G, (int)blockIdx.x);
        pg8::EpiResid<false> E{args.in[IN_X], (pg8::bf16_t*)(C.ws + WS_XS), (const float*)(C.ws + SM_ADA) + 2 * 1024, WO_FP8 ? 0.015625f : 1.f};
        pg8::gemm_phase<pg8::EpiResid<false>, pg8::StaticOrder, true, true, WO_FP8 ? 1 : 2>(C.lds + RING_OFF, g, S, E);
        } SEAM(5);
    }
    if (IN(6)) { FRESH(); REP(6) { r1_router(C, args, 0); } SEAM(6); }
    if (IN(7)) { FRESH(); REP(7) { p7_route(C); } SEAM(7); }
    if (IN(8)) { FRESH();
#if PROBE_GU
        { const int nt = load_tile_table(C);
          pg8::Gemm g{(const pg8::bf16_t*)(C.ws + WS_H8), (const pg8::bf16_t*)(C.ws + WS_WGU), MAXROWS, 32 * 2048, D, (const int*)(C.ws + SM_TOKSLOT)};
          pg8::MoeOrder<8> S{(const LAS int*)(C.lds + BLK_OFF) + BL_TILE, nt, (int)blockIdx.x, C.G};
#if PROBE_GU == 1
          pg8::EpiSwiGLU8 E{(unsigned char*)(C.ws + WS_XB), args.in[IN_BGU]};
          pg8::gemm_phase<pg8::EpiSwiGLU8, pg8::MoeOrder<8>, true, true, 1, true>(C.lds + RING_OFF, g, S, E);
#elif PROBE_GU == 6
          { pg8::MoeOrderProbe S2{(const LAS int*)(C.lds + BLK_OFF) + BL_TILE, nt, (int)blockIdx.x, C.G};
            pg8::EpiProbeGU<2> E{(unsigned char*)(C.ws + WS_XB), args.in[IN_BGU]};
            pg8::gemm_phase<pg8::EpiProbeGU<2>, pg8::MoeOrderProbe, true, true, 1, true>(C.lds + RING_OFF, g, S2, E); }
#else
          pg8::EpiProbeGU<PROBE_GU - 2> E{(unsigned char*)(C.ws + WS_XB), args.in[IN_BGU]};
          pg8::gemm_phase<pg8::EpiProbeGU<PROBE_GU - 2>, pg8::MoeOrder<8>, true, true, 1, true>(C.lds + RING_OFF, g, S, E);
#endif
        }
#endif
        REP(8) {
        const int nt = load_tile_table(C);
        pg8::Gemm g{(const pg8::bf16_t*)(C.ws + (MOE_GATHER ? WS_H8 : WS_XB)), (const pg8::bf16_t*)(C.ws + WS_WGU), MAXROWS, 32 * 2048, D, (const int*)(C.ws + SM_TOKSLOT)};
        pg8::MoeOrder<8> S{(const LAS int*)(C.lds + BLK_OFF) + BL_TILE, nt, (int)blockIdx.x, C.G};
        pg8::EpiSwiGLU8 E{(unsigned char*)(C.ws + WS_ACT), args.in[IN_BGU]};
        pg8::gemm_phase<pg8::EpiSwiGLU8, pg8::MoeOrder<8>, true, true, 1, MOE_GATHER != 0>(C.lds + RING_OFF, g, S, E);
        } SEAM(8);
    }
    if (IN(9)) { FRESH(); REP(9) {
        const int nt = load_tile_table(C);
        pg8::Gemm g{(const pg8::bf16_t*)(C.ws + WS_ACT), (const pg8::bf16_t*)(C.ws + WS_WDN), MAXROWS, 32 * 1024, D};
        pg8::MoeOrder<4> S{(const LAS int*)(C.lds + BLK_OFF) + BL_TILE, nt, (int)blockIdx.x, C.G};
        pg8::EpiDown8 E{(pg8::bf16_t*)(C.ws + WS_Y), args.in[IN_BDN]};
        pg8::gemm_phase<pg8::EpiDown8, pg8::MoeOrder<4>, true, true, 1>(C.lds + RING_OFF, g, S, E);
        } SEAM(9);
    }
    if (IN(10)) { FRESH(); r2_seam(C, args); SEAM(10); }
    if (IN(11)) { FRESH(); REP(11) {
        fcum_scan(C);
        pg8::Gemm g{(const pg8::bf16_t*)(C.ws + WS_HKV), (const pg8::bf16_t*)(C.ws + WS_WKV), T, 3072, D}; pg8::KVQOrder S; S.init(T, 3072, C.G, (int)blockIdx.x);
        pg8::EpiKVQ E{(pg8::bf16_t*)(C.ws + WS_QKV1), KVQ_FP8 ? 0.015625f : 1.f, (unsigned*)(C.ws + WS_CTL) + CW_NRM};
        pg8::gemm_phase<pg8::EpiKVQ, pg8::KVQOrder, true, true, KVQ_FP8 ? 1 : 2>(C.lds + RING_OFF, g, S, E);
        } SEAM(11);
    }
    if (IN(12)) { FRESH(); if (PROBE_FOX == 2) p12_fox<2>(C, WS_OG, args); REP(12) { p12_fox<1>(C, WS_O, args); } SEAM(12); }
    if (IN(13)) { FRESH(); REP(13) {
        pg8::Gemm g{(const pg8::bf16_t*)(C.ws + WS_O), (const pg8::bf16_t*)(C.ws + WS_WO1), T, D, D}; pg8::StaticOrder S; S.init(T, D, C.G, (int)blockIdx.x);
        pg8::EpiResid<true> E{C.ws + WS_XS, (pg8::bf16_t*)(C.ws + WS_XS), (const float*)(C.ws + SM_ADA) + (size_t)8 * 6144 + 2 * 1024, WO_FP8 ? 0.015625f : 1.f};
        pg8::gemm_phase<pg8::EpiResid<true>, pg8::StaticOrder, true, true, WO_FP8 ? 1 : 2>(C.lds + RING_OFF, g, S, E);
        } SEAM(13);
    }
    if (IN(14)) { FRESH(); REP(14) { r1_router(C, args, 1); } SEAM(14); }
    if (IN(15)) { FRESH(); REP(15) { p7_route(C); } SEAM(15); }
    if (IN(16)) { FRESH();
#if PROBE_LATE_QKV
        { pg8::Gemm g{(const pg8::bf16_t*)(C.ws + WS_ACT), (const pg8::bf16_t*)(C.ws + WS_WQKV), T, NQKV, D}; pg8::StaticOrder S; S.init(T, NQKV, C.G, (int)blockIdx.x);
          pg8::EpiNone E{(unsigned char*)(C.ws + WS_XB)};
          pg8::gemm_phase<pg8::EpiNone, pg8::StaticOrder, true, true, 1>(C.lds + RING_OFF, g, S, E); }
#endif
        REP(16) {
        const int nt = load_tile_table(C);
        pg8::Gemm g{(const pg8::bf16_t*)(C.ws + (MOE_GATHER ? WS_H8 : WS_XB)), (const pg8::bf16_t*)(C.ws + WS_WGU + (size_t)32 * 2048 * D), MAXROWS, 32 * 2048, D, (const int*)(C.ws + SM_TOKSLOT)};
        pg8::MoeOrder<8> S{(const LAS int*)(C.lds + BLK_OFF) + BL_TILE, nt, (int)blockIdx.x, C.G};
        pg8::EpiSwiGLU8 E{(unsigned char*)(C.ws + WS_ACT), args.in[IN_BGU] + 32 * 2048};
        pg8::gemm_phase<pg8::EpiSwiGLU8, pg8::MoeOrder<8>, true, true, 1, MOE_GATHER != 0>(C.lds + RING_OFF, g, S, E);
        } SEAM(16);
    }
    if (IN(17)) { FRESH(); REP(17) {
        const int nt = load_tile_table(C);
        pg8::Gemm g{(const pg8::bf16_t*)(C.ws + WS_ACT), (const pg8::bf16_t*)(C.ws + WS_WDN + (size_t)32 * 1024 * D), MAXROWS, 32 * 1024, D};
        pg8::MoeOrder<4> S{(const LAS int*)(C.lds + BLK_OFF) + BL_TILE, nt, (int)blockIdx.x, C.G};
        pg8::EpiDown8 E{(pg8::bf16_t*)(C.ws + WS_Y), args.in[IN_BDN] + 32 * 1024};
        pg8::gemm_phase<pg8::EpiDown8, pg8::MoeOrder<4>, true, true, 1>(C.lds + RING_OFF, g, S, E);
        } SEAM(17);
    }
    if (IN(18)) { FRESH(); r3_final(C, args, args.out); }
#undef IN
#undef SEAM
}

extern "C" void kernel_launch(void* const* d_in, const int* in_sizes, int n_in, void* d_out, int out_size, void* d_ws, size_t ws_size, hipStream_t stream) {
    static int grid = 0;
    if (grid == 0) {
        if (n_in != 21 || in_sizes[0] != T * D || out_size != T * D || ws_size < WS_END) { fprintf(stderr, "kernel_launch: unexpected shapes (n_in %d, in0 %d, out %d, ws %zu)\n", n_in, n_in > 0 ? in_sizes[0] : -1, out_size, ws_size); grid = -1; return; }
        int dev = 0, cus = 0, per_cu = 0;
        if (hipGetDevice(&dev) != hipSuccess || hipDeviceGetAttribute(&cus, hipDeviceAttributeMultiprocessorCount, dev) != hipSuccess) { grid = -1; return; }
        if (hipFuncSetAttribute((const void*)yoco_fwd, hipFuncAttributeMaxDynamicSharedMemorySize, LDS_BYTES) != hipSuccess) { fprintf(stderr, "kernel_launch: hipFuncSetAttribute failed\n"); grid = -1; return; }
        if (hipOccupancyMaxActiveBlocksPerMultiprocessor(&per_cu, (const void*)yoco_fwd, NWAVES * 64, LDS_BYTES) != hipSuccess || per_cu < 1) { fprintf(stderr, "kernel_launch: occupancy query reports %d blocks per CU\n", per_cu); }
        (void)hipGetLastError();
        grid = cus;
    }
    if (grid < 0) return;
    (void)hipMemsetAsync((char*)d_ws + WS_CTL, 0, CTL_ZERO_BYTES, stream);
    Args a{};
    for (int i = 0; i < 21; ++i) a.in[i] = (const float*)d_in[i];
    a.out = (float*)d_out; a.ws = (unsigned char*)d_ws;
#if MK_ONE_LAUNCH
    a.ph_lo = 0; a.ph_hi = N_PHASES;
    hipLaunchKernelGGL(yoco_fwd, dim3(grid), dim3(NWAVES * 64), LDS_BYTES, stream, a);
#else
    for (int p = 0; p < N_PHASES; ++p) { a.ph_lo = p; a.ph_hi = p + 1; hipLaunchKernelGGL(yoco_fwd, dim3(grid), dim3(NWAVES * 64), LDS_BYTES, stream, a); }
#endif
}
```

```cpp
#include <hip/hip_runtime.h>
#include <hip/hip_bf16.h>
#include <cstdio>
#include <cstdint>
#include <cmath>
#ifndef MK_ONE_LAUNCH
#define MK_ONE_LAUNCH 1
#endif
#ifndef PROBE_DUP
#define PROBE_DUP 0
#endif
#ifndef PG8_F8_SCALED
#define PG8_F8_SCALED 0
#endif
#ifndef QKV_FP8
#define QKV_FP8 1
#endif
#ifndef KVQ_FP8
#define KVQ_FP8 1
#endif
#ifndef PROBE_EPI
#define PROBE_EPI 0
#endif
#ifndef PROBE_FOX
#define PROBE_FOX 0
#endif
#ifndef PROBE_SANITIZE
#define PROBE_SANITIZE 0
#endif
#ifndef PROBE_BAND
#define PROBE_BAND 0
#endif
#ifndef Y_FP8
#define Y_FP8 1
#endif
#ifndef WO_FP8
#define WO_FP8 1
#endif
#ifndef MOE_GATHER
#define MOE_GATHER 1
#endif
#ifndef PROBE_QKV
#define PROBE_QKV 0
#endif
#ifndef PROBE_GU
#define PROBE_GU 0
#endif
#ifndef STAGGER_QKV
#define STAGGER_QKV 0
#endif
#ifndef NT_STORE
#define NT_STORE 0
#endif
#ifndef RELAX_STORES
#define RELAX_STORES 0
#endif
#ifndef PROBE_LATE_QKV
#define PROBE_LATE_QKV 0
#endif
#ifndef NT_P0
#define NT_P0 1
#endif
#ifndef NT_ROWS
#define NT_ROWS 1
#endif
#ifndef NT_P0ST
#define NT_P0ST 0
#endif
#ifndef DEFER_L1W
#define DEFER_L1W 0
#endif
#ifndef BAND_FP8
#define BAND_FP8 1
#endif
#ifndef QKV_WIDE
#define QKV_WIDE 1
#endif
#ifndef CONV_X0
#define CONV_X0 0
#endif
#ifndef CONV_X1
#define CONV_X1 40
#endif
#ifndef CONV_DEPTH
#define CONV_DEPTH 5
#endif
#ifndef OG_FP8
#define OG_FP8 1
#endif
#ifndef FOX_PK
#define FOX_PK 0
#endif
#ifndef EPI_LANEPERM
#define EPI_LANEPERM 0
#endif
#ifndef PROBE_BARX
#define PROBE_BARX 0
#endif
#ifndef ROUTER_PREFETCH
#define ROUTER_PREFETCH 1
#endif
#ifndef MOE_CONTIG
#define MOE_CONTIG 0
#endif
#ifndef PROBE_ADA
#define PROBE_ADA 0
#endif
#ifndef P0_SPLIT
#define P0_SPLIT 0
#endif
#ifndef PROBE_OPS
#define PROBE_OPS 0
#endif
#ifndef OG_TR
#define OG_TR 0
#endif
#ifndef WARM_W
#define WARM_W 0
#endif
#ifndef FOX_QPRE
#define FOX_QPRE 1
#endif
#ifndef CONV_X0_BOTH
#define CONV_X0_BOTH 0
#endif
#ifndef DN_WIDE
#define DN_WIDE 1
#endif
#ifndef RESID_BATCH
#define RESID_BATCH 1
#endif
#ifndef EPI_BIAS_INIT
#define EPI_BIAS_INIT 1
#endif
#ifndef GU_PAIR
#define GU_PAIR 0
#endif
#ifndef GU_BMAP
#define GU_BMAP 0
#endif
#ifndef MERGE_BATCH
#define MERGE_BATCH 1
#endif
#ifndef ROUTER_BATCH
#define ROUTER_BATCH 1
#endif
#ifndef R2_VECPRE
#define R2_VECPRE 1
#endif
#ifndef P1_PREFETCH
#define P1_PREFETCH 1
#endif
#ifndef GEMV_PIPE
#define GEMV_PIPE 0
#endif
#ifndef FOX_FASTPRO
#define FOX_FASTPRO 1
#endif
#ifndef GATHER_LAZY
#define GATHER_LAZY 1
#endif
#ifndef ROUTER_IMGV
#define ROUTER_IMGV 1
#endif
#ifndef BAND_TABLATE
#define BAND_TABLATE 1
#endif
#ifndef SWIGLU_PK
#define SWIGLU_PK 1
#endif
#ifndef R2_PKFMA
#define R2_PKFMA 1
#endif
#ifndef BAND_PK
#define BAND_PK 1
#endif
#ifndef KVQ_WIDE
#define KVQ_WIDE 1
#endif
#ifndef CONV_TAIL
#define CONV_TAIL 0
#endif
#ifndef ROW_UNCOND
#define ROW_UNCOND 1
#endif
namespace pg8 {
#define PG8_LAS __attribute__((address_space(3)))
typedef unsigned short bf16_t;
typedef short bf16x8 __attribute__((ext_vector_type(8)));
typedef float f32x4 __attribute__((ext_vector_type(4)));
typedef unsigned u32x4 __attribute__((ext_vector_type(4)));
constexpr int BM = 256, BK = 64, HALF = 128, HTB = HALF * BK * 2  , STAGE_BYTES = 8 * HTB, NXCD = 8, WGM = 8;

__host__ __device__ __forceinline__ int lds_byte(int r, int c) { const int st = (r >> 4) * 2 + (c >> 5), rr = r & 15, cc = c & 31, ob = rr * 64 + cc * 2; return st * 1024 + (ob ^ (((ob >> 9) & 1) << 5)); }
__host__ __device__ __forceinline__ void stage_rc(int b, int& R, int& C) { const int st = b / 1024, sb = b % 1024, swz = sb ^ (((sb >> 9) & 1) << 5); R = (st >> 1) * 16 + swz / 64; C = (st & 1) * 32 + (swz % 64) / 2; }
__host__ __device__ __forceinline__ int perm32(int rho) { const int n = rho >> 4, i = rho & 15; return 8 * (i >> 2) + 4 * n + (i & 3); }

struct Unit { int pm, pn; };
struct Gemm { const bf16_t* A; const bf16_t* Bt; int M, N, K; const int* rows = nullptr; };

struct StaticOrder {
    int nM, nN, nwg, G, c;
    __host__ __device__ void init(int M, int N, int G_, int c_) { nM = M / BM; nN = N / BM; nwg = nM * nN; G = G_; c = c_; }
    __host__ __device__ bool next(int i, Unit& u) const {
        const long L = (long)i * G + c; if (L >= nwg) return false;
        int wgid = (int)L; { const int q = nwg / NXCD, r = nwg % NXCD, xcd = wgid % NXCD, off = wgid / NXCD; wgid = (xcd < r ? xcd * (q + 1) : r * (q + 1) + (xcd - r) * q) + off; }
        const int nig = WGM * nN, gid = wgid / nig, fm = gid * WGM, gsz = (nM - fm) < WGM ? (nM - fm) : WGM;
        u.pm = fm + ((wgid % nig) % gsz); u.pn = (wgid % nig) / gsz; return true;
    }
    __device__ __forceinline__ void a_ready(const Unit&) const {}
    __device__ __forceinline__ void done(const Unit&) const {}
};
__device__ __forceinline__ unsigned cvt_pk_bf16(float lo, float hi) { unsigned r; asm volatile("v_cvt_pk_bf16_f32 %0, %1, %2" : "=v"(r) : "v"(lo), "v"(hi)); return r; }
typedef float f32x2 __attribute__((ext_vector_type(2)));
typedef int i32x8 __attribute__((ext_vector_type(8))); typedef int i32x4p __attribute__((ext_vector_type(4)));
#ifndef PG8_F8_SCALE
#define PG8_F8_SCALE 0x7f7f7f7f
#endif
__device__ __forceinline__ i32x8 pg8_cat(bf16x8 lo, bf16x8 hi) { const i32x4p a = __builtin_bit_cast(i32x4p, lo), b = __builtin_bit_cast(i32x4p, hi); return (i32x8){a.x, a.y, a.z, a.w, b.x, b.y, b.z, b.w}; }
#if PG8_F8_SCALED
__device__ __forceinline__ void pg8_mma8(f32x4& acc, i32x8 b, i32x8 a) { asm volatile("v_mfma_scale_f32_16x16x128_f8f6f4 %0, %1, %2, %0, %3, %3 op_sel_hi:[0,0,0]" : "+v"(acc) : "v"(b), "v"(a), "v"(0x7f7f7f7f)); }
#else
__device__ __forceinline__ void pg8_mma8(f32x4& acc, i32x8 b, i32x8 a) { asm volatile("v_mfma_f32_16x16x128_f8f6f4 %0, %1, %2, %0" : "+v"(acc) : "v"(b), "v"(a)); }
#endif
__device__ __forceinline__ void pg8_mma16(f32x4& acc, bf16x8 b, bf16x8 a) { asm volatile("v_mfma_f32_16x16x32_bf16 %0, %1, %2, %0" : "+v"(acc) : "v"(b), "v"(a)); }
template <class E, class = void> struct epi_bias_init { static constexpr bool value = false; };
template <class E> struct epi_bias_init<E, decltype((void)E::BIAS_INIT)> { static constexpr bool value = E::BIAS_INIT; };
template <class Epi, class Sched, bool ALIGN_EPI = false, bool SP2 = false, int ES = 2  , bool GATHER = false  , int BMAP = 0  >
__device__ __forceinline__ void gemm_phase(PG8_LAS unsigned char* lds, const Gemm g, const Sched& S, const Epi& E) {
    const int tid = threadIdx.x, wid = __builtin_amdgcn_readfirstlane(tid >> 6), lane = tid & 63, wr = wid >> 2, wc = wid & 3, fr = lane & 15, fq = lane >> 4;
    const int K = g.K * ES / 2  , nt = K / BK;
    unsigned voffA[2], voffB[2];
#pragma unroll
    for (int i = 0; i < 2; ++i) { int R, C; stage_rc(tid * 16 + i * 8192, R, C); const int Rb = BMAP == 1 ? ((R >> 5) * 64 + 16 * ((R & 15) >> 2) + 4 * ((R >> 4) & 1) + (R & 3)) : (Epi::PERM ? ((R & ~31) + perm32(R & 31)) : R);
        voffA[i] = (unsigned)(R * K + C) * 2u; voffB[i] = (unsigned)(Rb * K + C) * 2u; }
    const size_t kstep = (size_t)(BK * 2);
    const size_t hstep = (size_t)HALF * K * 2;
    const size_t tstep = 2 * hstep;
    const size_t hstepB = BMAP == 1 ? (size_t)8 * K * 2 : hstep;
    const size_t hstepA = GATHER ? 0 : hstep;
    unsigned cG0[2] = {voffA[0], voffA[1]}, cG1[2] = {voffA[0], voffA[1]}, nG0[2] = {voffA[0], voffA[1]}, nG1[2] = {voffA[0], voffA[1]};
#define PG8_GROWS(G0, G1, PM) do { if constexpr (GATHER) { _Pragma("unroll") for (int i_ = 0; i_ < 2; ++i_) { int R_, C_; stage_rc(tid * 16 + i_ * 8192, R_, C_); \
        const int* rp_ = g.rows + (size_t)(PM) * 256 + R_; G0[i_] = (unsigned)rp_[0] * (unsigned)(K * 2) + (unsigned)(C_ * 2); G1[i_] = (unsigned)rp_[128] * (unsigned)(K * 2) + (unsigned)(C_ * 2); } } } while (0)
#define PG8_GLOAD(R0, R1, PM) do { if constexpr (GATHER) { _Pragma("unroll") for (int i_ = 0; i_ < 2; ++i_) { int R_, C_; stage_rc(tid * 16 + i_ * 8192, R_, C_); \
        const int* rp_ = g.rows + (size_t)(PM) * 256 + R_; R0[i_] = rp_[0]; R1[i_] = rp_[128]; } } } while (0)
#define PG8_GCALC(G0, G1, R0, R1) do { if constexpr (GATHER) { _Pragma("unroll") for (int i_ = 0; i_ < 2; ++i_) { int R_, C_; stage_rc(tid * 16 + i_ * 8192, R_, C_); \
        G0[i_] = (unsigned)R0[i_] * (unsigned)(K * 2) + (unsigned)(C_ * 2); G1[i_] = (unsigned)R1[i_] * (unsigned)(K * 2) + (unsigned)(C_ * 2); } } } while (0)
    int nR0[2] = {0, 0}, nR1[2] = {0, 0};
    const unsigned ldsw = (unsigned)wid * 1024u;
    const int aoff = lds_byte(wr * 64 + fr, fq * 8), boff = lds_byte(wc * 32 + fr, fq * 8);
#define PG8_SA(b, h) (((b) * 2 + (h)) * HTB)
#define PG8_SB(b, h) ((4 + (b) * 2 + (h)) * HTB)
#define PG8_STAGE(bufoff, gbase, voff) do { _Pragma("unroll") for (int _i = 0; _i < 2; ++_i) \
        __builtin_amdgcn_global_load_lds((const unsigned*)((const char*)(gbase) + (voff)[_i]), (PG8_LAS unsigned*)(lds + (bufoff) + ldsw + _i * 8192), 16, 0, 0); } while (0)
#define PG8_LDA(dst, b, h) do { _Pragma("unroll") for (int m = 0; m < 4; ++m) _Pragma("unroll") for (int k = 0; k < 2; ++k) dst[m][k] = *(const PG8_LAS bf16x8*)(lds + PG8_SA(b, h) + aoff + m * 2048 + k * 1024); } while (0)
#define PG8_LDB(dst, b, h) do { _Pragma("unroll") for (int n = 0; n < 2; ++n) _Pragma("unroll") for (int k = 0; k < 2; ++k) dst[n][k] = *(const PG8_LAS bf16x8*)(lds + PG8_SB(b, h) + boff + n * 2048 + k * 1024); } while (0)
#define PG8_MMA(ai, bj, At, Bt) do { __builtin_amdgcn_s_setprio(1); _Pragma("unroll") for (int m = 0; m < 4; ++m) _Pragma("unroll") for (int n = 0; n < 2; ++n) { \
        if constexpr (ES == 2) { _Pragma("unroll") for (int k = 0; k < 2; ++k) acc[ai][bj][m][n] = __builtin_amdgcn_mfma_f32_16x16x32_bf16(Bt[n][k], At[m][k], acc[ai][bj][m][n], 0, 0, 0); } \
        else { pg8_mma8(acc[ai][bj][m][n], pg8_cat(Bt[n][0], Bt[n][1]), pg8_cat(At[m][0], At[m][1])); } } \
        __builtin_amdgcn_s_setprio(0); } while (0)
#define PG8_WAIT_V(n) asm volatile("s_waitcnt vmcnt(" #n ")" ::: "memory")
#define PG8_WAIT_L(n) asm volatile("s_waitcnt lgkmcnt(" #n ")" ::: "memory")
#define PG8_WAIT_V8R do { if (relax_st) { if constexpr (Epi::NSTORE == 16) asm volatile("s_waitcnt vmcnt(24)" ::: "memory"); else if constexpr (Epi::NSTORE == 8) asm volatile("s_waitcnt vmcnt(16)" ::: "memory"); else asm volatile("s_waitcnt vmcnt(8)" ::: "memory"); } \
        else asm volatile("s_waitcnt vmcnt(8)" ::: "memory"); } while (0)
#define PG8_BAR __builtin_amdgcn_s_barrier()
#define PG8_SCHED __builtin_amdgcn_sched_barrier(0)
    Unit cur, nxt; int ui = 0;
    if (!S.next(0, cur)) return;
    f32x4 acc[2][2][4][2];
#pragma unroll
    for (int a = 0; a < 2; ++a)
#pragma unroll
        for (int b = 0; b < 2; ++b)
#pragma unroll
            for (int m = 0; m < 4; ++m)
#pragma unroll
                for (int n = 0; n < 2; ++n) acc[a][b][m][n] = (f32x4){0.f, 0.f, 0.f, 0.f};
    if constexpr (epi_bias_init<Epi>::value) {
        f32x4 bi0[2][2]; E.bias(cur, wc, fq, bi0);
#pragma unroll
        for (int a = 0; a < 2; ++a)
#pragma unroll
            for (int b = 0; b < 2; ++b)
#pragma unroll
                for (int m = 0; m < 4; ++m)
#pragma unroll
                    for (int n = 0; n < 2; ++n) acc[a][b][m][n] = bi0[b][n]; }
    bf16x8 At[4][2], B0[2][2], B1[2][2];
    const char* cA = (const char*)g.A + (GATHER ? (size_t)0 : (size_t)cur.pm * tstep); const char* cB = (const char*)g.Bt + (size_t)cur.pn * tstep;
    PG8_GROWS(cG0, cG1, cur.pm);
    S.a_ready(cur);
    if constexpr (SP2) {
        PG8_STAGE(PG8_SB(0, 0), cB, voffB); PG8_STAGE(PG8_SB(0, 1), cB + hstepB, voffB); PG8_STAGE(PG8_SA(0, 0), cA, cG0); PG8_STAGE(PG8_SA(0, 1), cA + hstepA, cG1);
        if (wr == 1) PG8_BAR;
        PG8_WAIT_V(2); PG8_BAR;
        PG8_STAGE(PG8_SB(1, 0), cB + kstep, voffB); PG8_STAGE(PG8_SA(1, 0), cA + kstep, cG0); PG8_STAGE(PG8_SB(1, 1), cB + hstepB + kstep, voffB);
        PG8_WAIT_V(6); PG8_BAR;
    } else {
        PG8_STAGE(PG8_SB(0, 0), cB, voffB); PG8_STAGE(PG8_SA(0, 0), cA, cG0); PG8_STAGE(PG8_SB(0, 1), cB + hstepB, voffB); PG8_STAGE(PG8_SA(0, 1), cA + hstepA, cG1);
        if (wr == 1) PG8_BAR;
        PG8_WAIT_V(4); PG8_BAR;
        PG8_STAGE(PG8_SB(1, 0), cB + kstep, voffB); PG8_STAGE(PG8_SA(1, 0), cA + kstep, cG0); PG8_STAGE(PG8_SB(1, 1), cB + hstepB + kstep, voffB);
        PG8_WAIT_V(6); PG8_BAR;
    }
    for (;;) {
        const bool has_next = S.next(ui + 1, nxt);
        const char* nA = (has_next && !GATHER) ? (const char*)g.A + (size_t)nxt.pm * tstep : cA; const char* nB = has_next ? (const char*)g.Bt + (size_t)nxt.pn * tstep : cB;
        if constexpr (GATHER && GATHER_LAZY) { if (has_next) PG8_GLOAD(nR0, nR1, nxt.pm); nG0[0] = cG0[0]; nG0[1] = cG0[1]; nG1[0] = cG1[0]; nG1[1] = cG1[1]; }
        else { if (has_next) PG8_GROWS(nG0, nG1, nxt.pm); else { nG0[0] = cG0[0]; nG0[1] = cG0[1]; nG1[0] = cG1[0]; nG1[1] = cG1[1]; } }
#pragma unroll 1
        for (int t = 0; t < nt; t += 2) {
            const bool last = (t == nt - 2);
            const bool relax_st = RELAX_STORES && (t == 0) && (ui > 0);
            const char* a1 = cA + (size_t)(t + 1) * kstep;
            const char* a2 = last ? nA : cA + (size_t)(t + 2) * kstep; const char* b2 = last ? nB : cB + (size_t)(t + 2) * kstep;
            const char* a3 = a2 + kstep; const char* b3 = b2 + kstep;
            if (last && has_next) S.a_ready(nxt);
            if constexpr (GATHER && GATHER_LAZY) { if (last && has_next) { asm volatile("" : "+v"(nR0[0]), "+v"(nR0[1]), "+v"(nR1[0]), "+v"(nR1[1])); PG8_GCALC(nG0, nG1, nR0, nR1); } }
            const unsigned s0[2] = {last ? nG0[0] : cG0[0], last ? nG0[1] : cG0[1]}, s1[2] = {last ? nG1[0] : cG1[0], last ? nG1[1] : cG1[1]};
            if constexpr (SP2) {
            PG8_LDB(B0, 0, 0); PG8_LDB(B1, 0, 1); PG8_SCHED; PG8_LDA(At, 0, 0); PG8_STAGE(PG8_SA(1, 1), a1 + hstepA, cG1);
            PG8_WAIT_V8R; PG8_WAIT_L(0); PG8_BAR; PG8_MMA(0, 0, At, B0); PG8_MMA(0, 1, At, B1); PG8_BAR; PG8_SCHED;
            PG8_LDA(At, 0, 1); PG8_STAGE(PG8_SB(0, 0), b2, voffB); PG8_STAGE(PG8_SB(0, 1), b2 + hstepB, voffB); PG8_STAGE(PG8_SA(0, 0), a2, s0);
            PG8_WAIT_V8R; PG8_WAIT_L(0); PG8_BAR; PG8_MMA(1, 0, At, B0); PG8_MMA(1, 1, At, B1); PG8_BAR; PG8_SCHED;
            PG8_LDB(B0, 1, 0); PG8_LDB(B1, 1, 1); PG8_SCHED; PG8_LDA(At, 1, 0); PG8_STAGE(PG8_SA(0, 1), a2 + hstepA, s1);
            PG8_WAIT_V(8); PG8_WAIT_L(0); PG8_BAR; PG8_MMA(0, 0, At, B0); PG8_MMA(0, 1, At, B1); PG8_BAR; PG8_SCHED;
            PG8_LDA(At, 1, 1); PG8_STAGE(PG8_SB(1, 0), b3, voffB); PG8_STAGE(PG8_SB(1, 1), b3 + hstepB, voffB); PG8_STAGE(PG8_SA(1, 0), a3, s0);
            PG8_WAIT_V(8); PG8_WAIT_L(0); PG8_BAR; PG8_MMA(1, 0, At, B0); PG8_MMA(1, 1, At, B1); PG8_BAR; PG8_SCHED;
            } else {
            PG8_LDB(B0, 0, 0); PG8_SCHED; PG8_LDA(At, 0, 0); PG8_STAGE(PG8_SA(1, 1), a1 + hstepA, cG1);
            PG8_WAIT_L(8); PG8_BAR; PG8_WAIT_L(0); PG8_MMA(0, 0, At, B0); PG8_BAR; PG8_SCHED;
            PG8_LDB(B1, 0, 1); PG8_STAGE(PG8_SB(0, 0), b2, voffB);
            PG8_BAR; PG8_WAIT_L(0); PG8_MMA(0, 1, At, B1); PG8_BAR;
            PG8_LDA(At, 0, 1); PG8_STAGE(PG8_SA(0, 0), a2, s0);
            PG8_BAR; PG8_WAIT_L(0); PG8_MMA(1, 0, At, B0); PG8_BAR; PG8_SCHED;
            PG8_STAGE(PG8_SB(0, 1), b2 + hstepB, voffB);
            PG8_WAIT_V(6); PG8_BAR; PG8_MMA(1, 1, At, B1); PG8_BAR;
            PG8_LDB(B0, 1, 0); PG8_SCHED; PG8_LDA(At, 1, 0); PG8_STAGE(PG8_SA(0, 1), a2 + hstepA, s1);
            PG8_WAIT_L(8); PG8_BAR; PG8_WAIT_L(0); PG8_MMA(0, 0, At, B0); PG8_BAR; PG8_SCHED;
            PG8_LDB(B1, 1, 1); PG8_STAGE(PG8_SB(1, 0), b3, voffB);
            PG8_BAR; PG8_WAIT_L(0); PG8_MMA(0, 1, At, B1); PG8_BAR;
            PG8_LDA(At, 1, 1); PG8_STAGE(PG8_SA(1, 0), a3, s0);
            PG8_BAR; PG8_WAIT_L(0); PG8_MMA(1, 0, At, B0); PG8_BAR; PG8_SCHED;
            PG8_STAGE(PG8_SB(1, 1), b3 + hstepB, voffB);
            PG8_WAIT_V(6); PG8_BAR; PG8_MMA(1, 1, At, B1); PG8_BAR;
            }
        }
        if constexpr (ES == 1) asm volatile("s_nop 15\n\ts_nop 15" ::: "memory");
        if constexpr (ALIGN_EPI) { if (wr == 0) PG8_BAR; }
        f32x4 bnx[2][2];
        if constexpr (epi_bias_init<Epi>::value) { if (has_next) { int lq_; asm volatile("v_mbcnt_lo_u32_b32 %0, -1, 0\n\tv_mbcnt_hi_u32_b32 %0, -1, %0" : "=v"(lq_)); E.bias(nxt, wc, lq_ >> 4, bnx); } }
        if constexpr (!Epi::AFTER_DRAIN) { E(acc, cur, wr, wc, fr, fq); S.done(cur); }
        if (!has_next) break;
#pragma unroll
        for (int a = 0; a < 2; ++a)
#pragma unroll
            for (int b = 0; b < 2; ++b)
#pragma unroll
                for (int m = 0; m < 4; ++m)
#pragma unroll
                    for (int n = 0; n < 2; ++n) { if constexpr (epi_bias_init<Epi>::value) acc[a][b][m][n] = bnx[b][n]; else acc[a][b][m][n] = (f32x4){0.f, 0.f, 0.f, 0.f}; }
        cur = nxt; cA = nA; cB = nB; ++ui; cG0[0] = nG0[0]; cG0[1] = nG0[1]; cG1[0] = nG1[0]; cG1[1] = nG1[1];
        if constexpr (ALIGN_EPI) { if (wr == 1) PG8_BAR; }
    }
    PG8_WAIT_V(0);
    if constexpr (!ALIGN_EPI) { if (wr == 0) PG8_BAR; }
    PG8_BAR;
    if constexpr (Epi::AFTER_DRAIN) { E.fused(acc, cur, wr, wc, fr, fq, lds, wid, lane); S.done(cur); }
#undef PG8_GROWS
#undef PG8_GLOAD
#undef PG8_GCALC
#undef PG8_SA
#undef PG8_SB
#undef PG8_STAGE
#undef PG8_LDA
#undef PG8_LDB
#undef PG8_MMA
#undef PG8_WAIT_V
#undef PG8_WAIT_L
#undef PG8_WAIT_V8R
#undef PG8_BAR
#undef PG8_SCHED
}
}
namespace attn_body {
using bf16=__hip_bfloat16;
using bf16x8=__attribute__((ext_vector_type(8)))short;
using s16x4=__attribute__((ext_vector_type(4)))short;
using f32x16=__attribute__((ext_vector_type(16)))float;
using u32x4=__attribute__((ext_vector_type(4)))unsigned;
__device__ __forceinline__ int crow(int r,int hi){return (r&3)+8*(r>>2)+4*hi;}
#define SBAR() __builtin_amdgcn_sched_barrier(0)
__device__ __forceinline__ void glds16(const void*gsrc,unsigned lds_dst){unsigned keep;
  asm volatile("s_mov_b32 %0, m0\n\ts_mov_b32 m0, %2\n\ts_nop 0\n\tglobal_load_lds_dwordx4 %1, off\n\ts_mov_b32 m0, %0":"=&s"(keep):"v"(gsrc),"s"(lds_dst):"memory");}
__device__ __forceinline__ float max3f(float a,float b,float c){float r;asm("v_max3_f32 %0, %1, %2, %3":"=v"(r):"v"(a),"v"(b),"v"(c));return r;}
__device__ __forceinline__ float max2f(float a,float b){float r;asm("v_max_f32_e32 %0, %1, %2":"=v"(r):"v"(a),"v"(b));return r;}
__device__ __forceinline__ float fadd_s(float a,float b){float r;asm("v_add_f32_e32 %0, %1, %2":"=v"(r):"v"(a),"v"(b));return r;}
__device__ __forceinline__ float fsub_s(float a,float b){float r;asm("v_sub_f32_e32 %0, %1, %2":"=v"(r):"v"(a),"v"(b));return r;}
typedef float f32x2_t __attribute__((ext_vector_type(2))); typedef __bf16 bf16x2_t __attribute__((ext_vector_type(2)));
__device__ __forceinline__ unsigned cvtpk_s(float lo,float hi){f32x2_t v={lo,hi};bf16x2_t b=__builtin_convertvector(v,bf16x2_t);return __builtin_bit_cast(unsigned,b);}
#define WAIT_BAR(N) asm volatile("s_waitcnt vmcnt(" #N ") lgkmcnt(0)\n\ts_barrier":::"memory")
typedef __attribute__((address_space(3))) const char* lds_cptr;
typedef short v4i16_t __attribute__((ext_vector_type(4)));
__device__ __forceinline__ void kload8(bf16x8*kf,lds_cptr kp){
  kf[0]=*(const __attribute__((address_space(3))) bf16x8*)(kp);      kf[1]=*(const __attribute__((address_space(3))) bf16x8*)(kp+512);
  kf[2]=*(const __attribute__((address_space(3))) bf16x8*)(kp+2048); kf[3]=*(const __attribute__((address_space(3))) bf16x8*)(kp+2560);
  kf[4]=*(const __attribute__((address_space(3))) bf16x8*)(kp+4096); kf[5]=*(const __attribute__((address_space(3))) bf16x8*)(kp+4608);
  kf[6]=*(const __attribute__((address_space(3))) bf16x8*)(kp+6144); kf[7]=*(const __attribute__((address_space(3))) bf16x8*)(kp+6656);
}
__device__ __forceinline__ void kload2(bf16x8*kf,lds_cptr kp,int j){ kf[2*j]=*(const __attribute__((address_space(3))) bf16x8*)(kp+j*2048); kf[2*j+1]=*(const __attribute__((address_space(3))) bf16x8*)(kp+j*2048+512); }
__device__ __forceinline__ s16x4 vtr(lds_cptr p){ return __builtin_bit_cast(s16x4,__builtin_amdgcn_ds_read_tr16_b64_v4i16((__attribute__((address_space(3))) v4i16_t*)p)); }
__device__ __forceinline__ float rowmax(const f32x16&p0,const f32x16&p1){
  float a=max3f(p0[0],p0[1],p1[0]),b=max3f(p0[2],p0[3],p1[1]);a=max3f(a,p1[2],p1[3]);
  #pragma unroll
  for(int r=4;r<16;r+=4){a=max3f(a,p0[r],p0[r+1]);b=max3f(b,p0[r+2],p0[r+3]);a=max3f(a,p1[r],p1[r+1]);b=max3f(b,p1[r+2],p1[r+3]);}
  const float m=max2f(a,b);
  auto rr=__builtin_amdgcn_permlane32_swap(__float_as_uint(m),__float_as_uint(m),false,false);
  return max2f(__uint_as_float(rr[0]),__uint_as_float(rr[1]));
}
__device__ __forceinline__ void pv(f32x16*o,int vb,bf16x8 pa0,bf16x8 pa1,bf16x8 pa2,bf16x8 pa3){
  #pragma unroll
  for(int d0=0;d0<2;++d0){s16x4 lo[4],hi[4];
    #pragma unroll
    for(int ks=0;ks<4;++ks){
      asm volatile("ds_read_b64_tr_b16 %0,%1 offset:%c2":"=&v"(lo[ks]):"v"(vb),"i"(d0*4096+ks*1024):"memory");
      asm volatile("ds_read_b64_tr_b16 %0,%1 offset:%c2":"=&v"(hi[ks]):"v"(vb),"i"(d0*4096+ks*1024+512):"memory");}
    asm volatile("s_waitcnt lgkmcnt(0)":::"memory");SBAR();
    #define PK(k) (bf16x8){lo[k][0],lo[k][1],lo[k][2],lo[k][3],hi[k][0],hi[k][1],hi[k][2],hi[k][3]}
    o[d0]=__builtin_amdgcn_mfma_f32_32x32x16_bf16(pa0,PK(0),o[d0],0,0,0);
    o[d0]=__builtin_amdgcn_mfma_f32_32x32x16_bf16(pa1,PK(1),o[d0],0,0,0);
    o[d0]=__builtin_amdgcn_mfma_f32_32x32x16_bf16(pa2,PK(2),o[d0],0,0,0);
    o[d0]=__builtin_amdgcn_mfma_f32_32x32x16_bf16(pa3,PK(3),o[d0],0,0,0);
    #undef PK
  }
}
}

constexpr int BATCH = 8, SEQ = 4096, T = BATCH * SEQ, D = 1024, NE = 32, TOPK = 4, NH = 16, HD = 64;
constexpr int NQKV = 9216;
constexpr int MAXROWS = T * TOPK + NE * 256;
constexpr int MAXTILES = MAXROWS / 256;
constexpr int NVB = T / 128;
constexpr float LOG2E = 1.4426950408889634f;
constexpr float QSCALE = 0.125f * LOG2E;
constexpr float RMS_EPS = 1e-6f;
constexpr int NWAVES = 8;

constexpr size_t MiB = 1ull << 20;
constexpr size_t WS_CTL = 0, CTL_ZERO_BYTES = 1 * MiB;
constexpr size_t WS_SM = 1 * MiB;
constexpr size_t SM_ADA = WS_SM;
constexpr size_t SM_GM = WS_SM + 512 * 1024;
constexpr size_t SM_CSH = WS_SM + 640 * 1024;
constexpr size_t SM_BIAST = WS_SM + 644 * 1024;
constexpr size_t SM_BLKCNT = WS_SM + 704 * 1024;
constexpr size_t SM_TILEEXP = WS_SM + 768 * 1024;
constexpr size_t SM_TOPI = WS_SM + 1 * MiB;
constexpr size_t SM_TOPG = SM_TOPI + 512 * 1024;
constexpr size_t SM_RANK = SM_TOPG + 512 * 1024;
constexpr size_t SM_SLOT = SM_RANK + 512 * 1024;
constexpr size_t SM_TOKSLOT = WS_SM + 3 * MiB;
constexpr size_t SM_LOGF = WS_SM + 4 * MiB;
constexpr size_t SM_FCUM = WS_SM + 6 * MiB;
constexpr size_t SM_LSE = WS_SM + 8 * MiB;
constexpr size_t WS_WQKV = 16 * MiB, WS_WO0 = 34 * MiB, WS_WKV = 36 * MiB, WS_WQ = 40 * MiB, WS_WO1 = 42 * MiB, WS_WGU = 44 * MiB, WS_WDN = 300 * MiB;
constexpr size_t WS_HKV = 428 * MiB, WS_H = 492 * MiB, WS_OG = 556 * MiB, WS_O = 748 * MiB;
constexpr size_t WS_QKV0 = 812 * MiB, WS_ACT = 812 * MiB, WS_Y = 1084 * MiB, WS_QKV1 = 1388 * MiB, WS_XB = 1388 * MiB, WS_H8 = 1524 * MiB, WS_END = 1660 * MiB, WS_XS = WS_H;
static_assert(WS_H == WS_HKV + (size_t)T * D * 2, "H must follow HKV (KVQ GEMM addresses both through one A pointer)");
static_assert(WS_WQ == WS_WKV + (size_t)2048 * 1024 * 2, "Wq_t must follow Wkv_t");
static_assert(SM_LSE + (size_t)3 * T * 16 * 4 <= WS_WQKV, "small region");
static_assert(WS_Y + (size_t)MAXROWS * D * 2 <= WS_QKV1 && WS_XB + (size_t)MAXROWS * D * 2 <= WS_END && WS_QKV0 + (size_t)BATCH * 9 * 16 * SEQ * 64 * 2 <= WS_QKV1, "ws map");
constexpr int CW_TMO = 0, CW_BAR = 4096, CW_QUEUE = 65536  , CW_CONV = 65536 + 1024  , CW_NRM = 131072  ;

constexpr int RING_OFF = 0, RING_BYTES = 131072;
constexpr int SCR_OFF = RING_BYTES, SCR_BYTES = 16384;
constexpr int BLK_OFF = SCR_OFF + SCR_BYTES, BLK_BYTES = 12288;
constexpr int MISC_OFF = BLK_OFF + BLK_BYTES;
constexpr int LDS_BYTES = MISC_OFF + 256;
constexpr int BL_TILE = 0, BL_WCNT = 576, BL_WBASE = 832, BL_PARTA = 1088, BL_PARTB = 1600, BL_TOT = 2112, BL_BASE = 2144, BL_PADS = 2176;

#define LAS __attribute__((address_space(3)))
#define GAS __attribute__((address_space(1)))
typedef unsigned short bf16;
typedef float f32x4 __attribute__((ext_vector_type(4)));
typedef unsigned u32x4v __attribute__((ext_vector_type(4)));
typedef unsigned u32x2v __attribute__((ext_vector_type(2)));
typedef int i32x4v __attribute__((ext_vector_type(4)));
#define LDS_WAIT() asm volatile("s_waitcnt lgkmcnt(0)" ::: "memory")
#define VM_WAIT() asm volatile("s_waitcnt vmcnt(0)" ::: "memory")

__device__ __forceinline__ float bf2f(unsigned v) { return __uint_as_float(v << 16); }
__device__ __forceinline__ unsigned pkbf(float lo, float hi) { return attn_body::cvtpk_s(lo, hi); }
__device__ __forceinline__ float wave_sum(float v) {
#pragma unroll
    for (int o = 1; o < 64; o <<= 1) v += __shfl_xor(v, o);
    return v;
}

namespace pg8 {
struct EpiQKV0 {
    static constexpr bool PERM = true, AFTER_DRAIN = false; static constexpr int NSTORE = 16;
    bf16_t* O; float mul;
    __device__ __forceinline__ void operator()(const f32x4 (&acc)[2][2][4][2], const Unit& u, int wr, int wc, int fr, int fq) const {
        _Pragma("unroll") for (int rep_e = 0; rep_e < 1 + ((PROBE_EPI >> 0) & 1); ++rep_e) {
        asm volatile("" : "+v"(fr), "+v"(fq));
        const int g = u.pn / 12, rem = u.pn - g * 12, which = rem >> 2, h0 = (rem & 3) * 4, sh = 2 * g;
        const float sc = (which == 0 ? QSCALE : 1.f) * mul;
#pragma unroll
        for (int ai = 0; ai < 2; ++ai)
#pragma unroll
            for (int m = 0; m < 4; ++m) {
                const int tok = u.pm * BM + ai * HALF + wr * 64 + m * 16 + fr, b = tok >> 12, s = tok & 4095;
                const int subrow = (s & ((1 << sh) - 1)) * (4096 >> sh) + (s >> sh);
#pragma unroll
                for (int bj = 0; bj < 2; ++bj) {
                    const int head = h0 + 2 * bj + (wc >> 1), dcol = (wc & 1) * 32 + 8 * fq;
                    const size_t plane = (size_t)(((b * 3 + g) * 3 + which) * 16 + head);
                    const f32x4 v0 = acc[ai][bj][m][0] * sc, v1 = acc[ai][bj][m][1] * sc;
                    u32x4 w; w.x = cvt_pk_bf16(v0[0], v0[1]); w.y = cvt_pk_bf16(v0[2], v0[3]); w.z = cvt_pk_bf16(v1[0], v1[1]); w.w = cvt_pk_bf16(v1[2], v1[3]);
#if NT_STORE
                    __builtin_nontemporal_store(w, (u32x4*)(O + (plane * 4096 + subrow) * 64 + dcol));
#else
                    *(u32x4*)(O + (plane * 4096 + subrow) * 64 + dcol) = w;
#endif
                }
            }
        }
    }
};
struct EpiQKV0Probe {
    static constexpr bool PERM = true, AFTER_DRAIN = false; static constexpr int NSTORE = 16;
    bf16_t* O; float mul; int wide;
    __device__ __forceinline__ void operator()(const f32x4 (&acc)[2][2][4][2], const Unit& u, int wr, int wc, int fr, int fq) const {
        asm volatile("" : "+v"(fr), "+v"(fq));
        const int g = u.pn / 12, rem = u.pn - g * 12, which = rem >> 2, h0 = (rem & 3) * 4, sh = 2 * g;
        const float sc = (which == 0 ? QSCALE : 1.f) * mul;
#pragma unroll
        for (int ai = 0; ai < 2; ++ai)
#pragma unroll
            for (int m = 0; m < 4; ++m) {
                const int tok = u.pm * BM + ai * HALF + wr * 64 + m * 16 + fr, b = tok >> 12, s = tok & 4095;
                const int subrow = (s & ((1 << sh) - 1)) * (4096 >> sh) + (s >> sh);
                const int head = h0 + wc, dcol = 16 * fq;
                const size_t plane = (size_t)(((b * 3 + g) * 3 + which) * 16 + head);
#pragma unroll
                for (int bj = 0; bj < 2; ++bj) {
                    const f32x4 v0 = acc[ai][bj][m][0] * sc, v1 = acc[ai][bj][m][1] * sc;
                    u32x4 w; w.x = cvt_pk_bf16(v0[0], v0[1]); w.y = cvt_pk_bf16(v0[2], v0[3]); w.z = cvt_pk_bf16(v1[0], v1[1]); w.w = cvt_pk_bf16(v1[2], v1[3]);
                    if (wide == 4) { const size_t off_ = ((size_t)(u.pm * 36 + u.pn) * 131072 + (size_t)(wr * 4 + wc) * 16384 + (size_t)((ai * 4 + m) * 2 + bj) * 1024 + fr * 64 + fq * 16) & (size_t)0x7fffff;
                        *(u32x4*)((unsigned char*)O + off_) = w; }
                    else if (wide != 3 || m == 0) *(u32x4*)(O + (((plane * 4096 + subrow) * 64 + dcol + 8 * bj) & (size_t)(wide == 2 ? 0x3fffff : 0x7fffffffff)) ) = w; else if (w.x == 0x12345678u) O[0] = 1;
                }
            }
    }
};
struct EpiKVQ {
    static constexpr bool PERM = true, AFTER_DRAIN = false; static constexpr int NSTORE = 16;
    bf16_t* O; float mul; unsigned* nrm;
    __device__ __forceinline__ void operator()(const f32x4 (&acc)[2][2][4][2], const Unit& u, int wr, int wc, int fr, int fq) const {
        asm volatile("" : "+v"(fr), "+v"(fq));
        const int which = u.pn < 4 ? 1 : (u.pn < 8 ? 2 : 0), h0 = (u.pn & 3) * 4, pm = u.pm & 127;
        const float sc = (which == 0 ? QSCALE : 1.f) * mul;
        float nmax[2] = {0.f, 0.f};
#pragma unroll
        for (int ai = 0; ai < 2; ++ai)
#pragma unroll
            for (int m = 0; m < 4; ++m) {
                const int tok = pm * BM + ai * HALF + wr * 64 + m * 16 + fr, b = tok >> 12, s = tok & 4095;
#pragma unroll
                for (int bj = 0; bj < 2; ++bj) {
                    const int head = h0 + 2 * bj + (wc >> 1), dcol = (wc & 1) * 32 + 8 * fq;
                    const size_t plane = (size_t)((b * 3 + which) * 16 + head);
                    const f32x4 v0 = acc[ai][bj][m][0] * sc, v1 = acc[ai][bj][m][1] * sc;
                    u32x4 w; w.x = cvt_pk_bf16(v0[0], v0[1]); w.y = cvt_pk_bf16(v0[2], v0[3]); w.z = cvt_pk_bf16(v1[0], v1[1]); w.w = cvt_pk_bf16(v1[2], v1[3]);
                    *(u32x4*)(O + (plane * 4096 + s) * 64 + dcol) = w;
                    if (which != 2) {
                        float ss = 0.f;
#pragma unroll
                        for (int k4 = 0; k4 < 4; ++k4) { const unsigned pw_ = k4 == 0 ? w.x : (k4 == 1 ? w.y : (k4 == 2 ? w.z : w.w)); const float lo_ = __uint_as_float(pw_ << 16), hi_ = __uint_as_float(pw_ & 0xffff0000u); ss += lo_ * lo_ + hi_ * hi_; }
                        ss += __shfl_xor(ss, 16); ss += __shfl_xor(ss, 32);
                        nmax[bj] = fmaxf(nmax[bj], ss);
                    }
                }
            }
        if (which != 2) {
#pragma unroll
            for (int bj = 0; bj < 2; ++bj) { float v = nmax[bj];
                v = fmaxf(v, __shfl_xor(v, 1)); v = fmaxf(v, __shfl_xor(v, 2)); v = fmaxf(v, __shfl_xor(v, 4)); v = fmaxf(v, __shfl_xor(v, 8));
                if (fr == 0 && fq == 0) { const int b0 = (pm * BM) >> 12, head = h0 + 2 * bj + (wc >> 1);
                    atomicMax(nrm + (((b0 * 2 + which) * 16 + head) * 2 + (wc & 1)), __float_as_uint(v)); } }
        }
    }
};
struct EpiKVQW {
    static constexpr bool PERM = true, AFTER_DRAIN = false; static constexpr int NSTORE = 16;
    bf16_t* O; float mul; unsigned* nrm;
    __device__ __forceinline__ void operator()(const f32x4 (&acc)[2][2][4][2], const Unit& u, int wr, int wc, int fr, int fq) const {
        asm volatile("" : "+v"(fr), "+v"(fq));
        const int which = u.pn < 4 ? 1 : (u.pn < 8 ? 2 : 0), head = (u.pn & 3) * 4 + wc, pm = u.pm & 127;
        const float sc = (which == 0 ? QSCALE : 1.f) * mul;
        float nmax = 0.f;
#pragma unroll
        for (int ai = 0; ai < 2; ++ai)
#pragma unroll
            for (int m = 0; m < 4; ++m) {
                const int tok = pm * BM + ai * HALF + wr * 64 + m * 16 + fr, b = tok >> 12, s = tok & 4095;
                const size_t plane = (size_t)((b * 3 + which) * 16 + head);
                float ss = 0.f;
#pragma unroll
                for (int bj = 0; bj < 2; ++bj) {
                    const f32x4 v0 = acc[ai][bj][m][0] * sc, v1 = acc[ai][bj][m][1] * sc;
                    u32x4 w; w.x = cvt_pk_bf16(v0[0], v0[1]); w.y = cvt_pk_bf16(v0[2], v0[3]); w.z = cvt_pk_bf16(v1[0], v1[1]); w.w = cvt_pk_bf16(v1[2], v1[3]);
                    *(u32x4*)(O + (plane * 4096 + s) * 64 + 16 * fq + 8 * bj) = w;
                    if (which != 2) {
#pragma unroll
                        for (int k4 = 0; k4 < 4; ++k4) { const unsigned pw_ = k4 == 0 ? w.x : (k4 == 1 ? w.y : (k4 == 2 ? w.z : w.w)); const float lo_ = __uint_as_float(pw_ << 16), hi_ = __uint_as_float(pw_ & 0xffff0000u); ss += lo_ * lo_ + hi_ * hi_; } }
                }
                if (which != 2) { ss += __shfl_xor(ss, 16); ss += __shfl_xor(ss, 32); nmax = fmaxf(nmax, ss); }
            }
        if (which != 2) { float v = nmax;
            v = fmaxf(v, __shfl_xor(v, 1)); v = fmaxf(v, __shfl_xor(v, 2)); v = fmaxf(v, __shfl_xor(v, 4)); v = fmaxf(v, __shfl_xor(v, 8));
            if (fr == 0 && fq == 0) { const int b0 = (pm * BM) >> 12; atomicMax(nrm + (((b0 * 2 + which) * 16 + head) * 2), __float_as_uint(v)); } }
    }
};
template <bool SRC_BF16> struct EpiResid {
    static constexpr bool PERM = true, AFTER_DRAIN = false; static constexpr int NSTORE = 16;
    const void* src; bf16_t* dst; const float* gate; float mul;
    __device__ __forceinline__ void operator()(const f32x4 (&acc)[2][2][4][2], const Unit& u, int wr, int wc, int fr, int fq) const {
        asm volatile("" : "+v"(fr), "+v"(fq));
#if RESID_BATCH
        const int b = (u.pm * BM) >> 12;
        f32x4 g[2][2];
#pragma unroll
        for (int bj = 0; bj < 2; ++bj) { const int col = u.pn * BM + bj * HALF + wc * 32 + 8 * fq; g[bj][0] = *(const f32x4*)(gate + b * 6144 + col) * mul; g[bj][1] = *(const f32x4*)(gate + b * 6144 + col + 4) * mul; }
#pragma unroll
        for (int ai = 0; ai < 2; ++ai) {
            u32x4 rb[4][2]; f32x4 rf[4][2][2];
#pragma unroll
            for (int m = 0; m < 4; ++m) { const int row = u.pm * BM + ai * HALF + wr * 64 + m * 16 + fr;
#pragma unroll
                for (int bj = 0; bj < 2; ++bj) { const int col = u.pn * BM + bj * HALF + wc * 32 + 8 * fq;
                    if (SRC_BF16) rb[m][bj] = *(const u32x4*)((const bf16_t*)src + (size_t)row * D + col);
                    else { rf[m][bj][0] = __builtin_nontemporal_load((const f32x4*)((const float*)src + (size_t)row * D + col)); rf[m][bj][1] = __builtin_nontemporal_load((const f32x4*)((const float*)src + (size_t)row * D + col + 4)); } } }
#pragma unroll
            for (int m = 0; m < 4; ++m) { const int row = u.pm * BM + ai * HALF + wr * 64 + m * 16 + fr;
#pragma unroll
                for (int bj = 0; bj < 2; ++bj) { const int col = u.pn * BM + bj * HALF + wc * 32 + 8 * fq;
                    f32x4 x0, x1;
                    if (SRC_BF16) { const u32x4 r = rb[m][bj];
                        x0 = (f32x4){__uint_as_float(r.x << 16), __uint_as_float(r.x & 0xffff0000u), __uint_as_float(r.y << 16), __uint_as_float(r.y & 0xffff0000u)};
                        x1 = (f32x4){__uint_as_float(r.z << 16), __uint_as_float(r.z & 0xffff0000u), __uint_as_float(r.w << 16), __uint_as_float(r.w & 0xffff0000u)}; }
                    else { x0 = rf[m][bj][0]; x1 = rf[m][bj][1]; }
                    const f32x4 v0 = x0 + g[bj][0] * acc[ai][bj][m][0], v1 = x1 + g[bj][1] * acc[ai][bj][m][1];
                    u32x4 w; w.x = cvt_pk_bf16(v0[0], v0[1]); w.y = cvt_pk_bf16(v0[2], v0[3]); w.z = cvt_pk_bf16(v1[0], v1[1]); w.w = cvt_pk_bf16(v1[2], v1[3]);
                    *(u32x4*)(dst + (size_t)row * D + col) = w; } }
        }
#else
#pragma unroll
        for (int ai = 0; ai < 2; ++ai)
#pragma unroll
            for (int m = 0; m < 4; ++m) {
                const int row = u.pm * BM + ai * HALF + wr * 64 + m * 16 + fr, b = row >> 12;
#pragma unroll
                for (int bj = 0; bj < 2; ++bj) {
                    const int col = u.pn * BM + bj * HALF + wc * 32 + 8 * fq;
                    f32x4 x0, x1;
                    if (SRC_BF16) { const u32x4 r = *(const u32x4*)((const bf16_t*)src + (size_t)row * D + col);
                        x0 = (f32x4){__uint_as_float(r.x << 16), __uint_as_float(r.x & 0xffff0000u), __uint_as_float(r.y << 16), __uint_as_float(r.y & 0xffff0000u)};
                        x1 = (f32x4){__uint_as_float(r.z << 16), __uint_as_float(r.z & 0xffff0000u), __uint_as_float(r.w << 16), __uint_as_float(r.w & 0xffff0000u)}; }
                    else if (NT_ROWS) { x0 = __builtin_nontemporal_load((const f32x4*)((const float*)src + (size_t)row * D + col)); x1 = __builtin_nontemporal_load((const f32x4*)((const float*)src + (size_t)row * D + col + 4)); }
                    else { x0 = *(const f32x4*)((const float*)src + (size_t)row * D + col); x1 = *(const f32x4*)((const float*)src + (size_t)row * D + col + 4); }
                    const f32x4 g0 = *(const f32x4*)(gate + b * 6144 + col), g1 = *(const f32x4*)(gate + b * 6144 + col + 4);
                    const f32x4 v0 = x0 + (g0 * mul) * acc[ai][bj][m][0], v1 = x1 + (g1 * mul) * acc[ai][bj][m][1];
                    u32x4 w; w.x = cvt_pk_bf16(v0[0], v0[1]); w.y = cvt_pk_bf16(v0[2], v0[3]); w.z = cvt_pk_bf16(v1[0], v1[1]); w.w = cvt_pk_bf16(v1[2], v1[3]);
                    *(u32x4*)(dst + (size_t)row * D + col) = w;
                }
            }
#endif
    }
};
struct EpiSwiGLU {
    static constexpr bool PERM = true, AFTER_DRAIN = false; static constexpr int NSTORE = 0;
    bf16_t* ACT; const float* bgu;
    __device__ __forceinline__ void operator()(const f32x4 (&acc)[2][2][4][2], const Unit& u, int wr, int wc, int fr, int fq) const {
        const int e = u.pn >> 3, pnl = u.pn & 7, j0 = pnl * 128 + wc * 32 + 8 * fq;
        f32x4 bg[2], bu[2];
#pragma unroll
        for (int n = 0; n < 2; ++n) { bg[n] = *(const f32x4*)(bgu + e * 2048 + j0 + 4 * n); bu[n] = *(const f32x4*)(bgu + e * 2048 + 1024 + j0 + 4 * n); }
#pragma unroll
        for (int ai = 0; ai < 2; ++ai)
#pragma unroll
            for (int m = 0; m < 4; ++m) {
                const int row = u.pm * BM + ai * HALF + wr * 64 + m * 16 + fr;
                float a[8];
#pragma unroll
                for (int n = 0; n < 2; ++n) {
                    const f32x4 gv = acc[ai][0][m][n] + bg[n], uv = acc[ai][1][m][n] + bu[n];
#pragma unroll
                    for (int i = 0; i < 4; ++i) {
                        const float gg = fminf(gv[i], 7.f), uu = fminf(fmaxf(uv[i], -7.f), 7.f);
                        const float sg = __builtin_amdgcn_rcpf(1.f + __builtin_amdgcn_exp2f(-1.702f * LOG2E * gg));
                        a[4 * n + i] = (uu + 1.f) * gg * sg;
                    }
                }
                u32x4 w; w.x = cvt_pk_bf16(a[0], a[1]); w.y = cvt_pk_bf16(a[2], a[3]); w.z = cvt_pk_bf16(a[4], a[5]); w.w = cvt_pk_bf16(a[6], a[7]);
                *(u32x4*)(ACT + (size_t)row * D + j0) = w;
            }
    }
};
struct EpiDown {
    static constexpr bool PERM = true, AFTER_DRAIN = false; static constexpr int NSTORE = 0;
    bf16_t* Y; const float* bdn;
    __device__ __forceinline__ void operator()(const f32x4 (&acc)[2][2][4][2], const Unit& u, int wr, int wc, int fr, int fq) const {
        const int e = u.pn >> 2, pnl = u.pn & 3;
#pragma unroll
        for (int ai = 0; ai < 2; ++ai)
#pragma unroll
            for (int m = 0; m < 4; ++m) {
                const int row = u.pm * BM + ai * HALF + wr * 64 + m * 16 + fr;
#pragma unroll
                for (int bj = 0; bj < 2; ++bj) {
                    const int col = pnl * BM + bj * HALF + wc * 32 + 8 * fq;
                    const f32x4 b0 = *(const f32x4*)(bdn + e * 1024 + col), b1 = *(const f32x4*)(bdn + e * 1024 + col + 4);
                    const f32x4 v0 = acc[ai][bj][m][0] + b0, v1 = acc[ai][bj][m][1] + b1;
                    u32x4 w; w.x = cvt_pk_bf16(v0[0], v0[1]); w.y = cvt_pk_bf16(v0[2], v0[3]); w.z = cvt_pk_bf16(v1[0], v1[1]); w.w = cvt_pk_bf16(v1[2], v1[3]);
                    *(u32x4*)(Y + (size_t)row * D + col) = w;
                }
            }
    }
};
__device__ __forceinline__ unsigned pk4_fp8(float a, float b, float c, float d) { int v = __builtin_amdgcn_cvt_pk_fp8_f32(a, b, 0, false); v = __builtin_amdgcn_cvt_pk_fp8_f32(c, d, v, true); return (unsigned)v; }
struct EpiQKV08 {
    static constexpr bool PERM = true, AFTER_DRAIN = false; static constexpr int NSTORE = 16;
    unsigned char* O; float mul;
    __device__ __forceinline__ void operator()(const f32x4 (&acc)[2][2][4][2], const Unit& u, int wr, int wc, int fr, int fq) const {
        asm volatile("" : "+v"(fr), "+v"(fq));
        const int g = u.pn / 12, rem = u.pn - g * 12, which = rem >> 2, h0 = (rem & 3) * 4, sh = 2 * g;
        const float sc = (which == 0 ? QSCALE : 1.f) * mul;
#pragma unroll
        for (int ai = 0; ai < 2; ++ai)
#pragma unroll
            for (int m = 0; m < 4; ++m) {
                const int tok = u.pm * BM + ai * HALF + wr * 64 + m * 16 + fr, b = tok >> 12, s = tok & 4095;
                const int subrow = (s & ((1 << sh) - 1)) * (4096 >> sh) + (s >> sh);
#pragma unroll
                for (int bj = 0; bj < 2; ++bj) {
                    const int head = h0 + 2 * bj + (wc >> 1), dcol = (wc & 1) * 32 + 8 * fq;
                    const size_t plane = (size_t)(((b * 3 + g) * 3 + which) * 16 + head);
                    const f32x4 v0 = acc[ai][bj][m][0] * sc, v1 = acc[ai][bj][m][1] * sc;
                    typedef unsigned u32x2e __attribute__((ext_vector_type(2)));
                    u32x2e w8; w8.x = pk4_fp8(v0[0], v0[1], v0[2], v0[3]); w8.y = pk4_fp8(v1[0], v1[1], v1[2], v1[3]);
                    *(u32x2e*)(O + (plane * 4096 + subrow) * 64 + dcol) = w8;
                }
            }
    }
};
struct EpiQKV08W {
    static constexpr bool PERM = true, AFTER_DRAIN = false; static constexpr int NSTORE = 8;
    unsigned char* O; float mul;
    __device__ __forceinline__ void operator()(const f32x4 (&acc)[2][2][4][2], const Unit& u, int wr, int wc, int fr, int fq) const {
        _Pragma("unroll") for (int rep_e = 0; rep_e < 1 + ((PROBE_EPI >> 0) & 1); ++rep_e) {
        asm volatile("" : "+v"(fr), "+v"(fq));
        const int g = u.pn / 12, rem = u.pn - g * 12, which = rem >> 2, head = (rem & 3) * 4 + wc, sh = 2 * g;
        const float sc = (which == 0 ? QSCALE : 1.f) * mul;
#pragma unroll
        for (int ai = 0; ai < 2; ++ai)
#pragma unroll
            for (int m = 0; m < 4; ++m) {
                const int rr_ = EPI_LANEPERM ? ((fq * 16 + fr) >> 2) : fr, pp_ = EPI_LANEPERM ? (fr & 3) : fq;
                const int tok = u.pm * BM + ai * HALF + wr * 64 + m * 16 + rr_, b = tok >> 12, s = tok & 4095;
                const int subrow = (s & ((1 << sh) - 1)) * (4096 >> sh) + (s >> sh);
                const size_t plane = (size_t)(((b * 3 + g) * 3 + which) * 16 + head);
                u32x4 w;
                { const f32x4 v0 = acc[ai][0][m][0] * sc, v1 = acc[ai][0][m][1] * sc; w.x = pk4_fp8(v0[0], v0[1], v0[2], v0[3]); w.y = pk4_fp8(v1[0], v1[1], v1[2], v1[3]); }
                { const f32x4 v0 = acc[ai][1][m][0] * sc, v1 = acc[ai][1][m][1] * sc; w.z = pk4_fp8(v0[0], v0[1], v0[2], v0[3]); w.w = pk4_fp8(v1[0], v1[1], v1[2], v1[3]); }
                if (EPI_LANEPERM) { const int src_ = 4 * (pp_ * 16 + rr_);
                    w.x = (unsigned)__builtin_amdgcn_ds_bpermute(src_, (int)w.x); w.y = (unsigned)__builtin_amdgcn_ds_bpermute(src_, (int)w.y); w.z = (unsigned)__builtin_amdgcn_ds_bpermute(src_, (int)w.z); w.w = (unsigned)__builtin_amdgcn_ds_bpermute(src_, (int)w.w); }
                if ((PROBE_EPI & 8) && rep_e == 1) { if (w.x == 0x12345678u && w.y == 0x9abcdef0u) O[0] = 1; }
                else *(u32x4*)(O + (plane * 4096 + subrow) * 64 + 16 * pp_) = w;
            }
        }
    }
};
struct EpiProbeW {
    static constexpr bool PERM = true, AFTER_DRAIN = false; static constexpr int NSTORE = 8;
    unsigned char* O; float mul; int vcu;
    __device__ __forceinline__ void operator()(const f32x4 (&acc)[2][2][4][2], const Unit& u, int wr, int wc, int fr, int fq) const {
        asm volatile("" : "+v"(fr), "+v"(fq));
        const float sc = mul;
#pragma unroll
        for (int ai = 0; ai < 2; ++ai)
#pragma unroll
            for (int m = 0; m < 4; ++m) {
                u32x4 w;
                { const f32x4 v0 = acc[ai][0][m][0] * sc, v1 = acc[ai][0][m][1] * sc; w.x = pk4_fp8(v0[0], v0[1], v0[2], v0[3]); w.y = pk4_fp8(v1[0], v1[1], v1[2], v1[3]); }
                { const f32x4 v0 = acc[ai][1][m][0] * sc, v1 = acc[ai][1][m][1] * sc; w.z = pk4_fp8(v0[0], v0[1], v0[2], v0[3]); w.w = pk4_fp8(v1[0], v1[1], v1[2], v1[3]); }
                *(u32x4*)(O + (size_t)vcu * 65536 + (size_t)((wr * 4 + wc) * 8 + ai * 4 + m) * 1024 + (fq * 16 + fr) * 16) = w;
            }
    }
};
struct EpiSwiGLU8 {
    static constexpr bool PERM = true, AFTER_DRAIN = false, BIAS_INIT = (EPI_BIAS_INIT != 0); static constexpr int NSTORE = GU_PAIR ? 4 : 8;
    unsigned char* ACT; const float* bgu;
    __device__ __forceinline__ void bias(const Unit& u, int wc, int fq, f32x4 (&bi)[2][2]) const {
        const int e = u.pn >> 3, pnl = u.pn & 7, j0 = pnl * 128 + wc * 32 + 8 * fq;
#pragma unroll
        for (int n = 0; n < 2; ++n) { bi[0][n] = *(const f32x4*)(bgu + e * 2048 + j0 + 4 * n) * 64.f; bi[1][n] = *(const f32x4*)(bgu + e * 2048 + 1024 + j0 + 4 * n) * 64.f + 64.f; } }
    __device__ __forceinline__ void operator()(const f32x4 (&acc)[2][2][4][2], const Unit& u, int wr, int wc, int fr, int fq) const {
        _Pragma("unroll") for (int rep_e = 0; rep_e < 1 + ((PROBE_EPI >> 1) & 1); ++rep_e) {
        asm volatile("" : "+v"(fr), "+v"(fq));
        const int e = u.pn >> 3, pnl = u.pn & 7, j0 = pnl * 128 + wc * 32 + 8 * fq;
        f32x4 bg[2], bu[2];
#pragma unroll
        for (int n = 0; n < 2; ++n) { if (BIAS_INIT) { bg[n] = (f32x4){0.f, 0.f, 0.f, 0.f}; bu[n] = bg[n]; } else { bg[n] = *(const f32x4*)(bgu + e * 2048 + j0 + 4 * n) * 64.f; bu[n] = *(const f32x4*)(bgu + e * 2048 + 1024 + j0 + 4 * n) * 64.f + 64.f; } }
#pragma unroll
        for (int ai = 0; ai < 2; ++ai) {
            typedef unsigned u32x2e __attribute__((ext_vector_type(2)));
            u32x2e wq[4];
#pragma unroll
            for (int m = 0; m < 4; ++m) {
                const int row = u.pm * BM + ai * HALF + wr * 64 + m * 16 + fr;
                float a[8];
#pragma unroll
                for (int n = 0; n < 2; ++n) {
#if SWIGLU_PK
                    const f32x4 gv = BIAS_INIT ? acc[ai][0][m][n] : acc[ai][0][m][n] + bg[n], uv = BIAS_INIT ? acc[ai][1][m][n] : acc[ai][1][m][n] + bu[n];
                    f32x4 gg, uu, t, sg;
#pragma unroll
                    for (int i = 0; i < 4; ++i) { gg[i] = __builtin_amdgcn_fmed3f(gv[i], -3.0e38f, 448.f); uu[i] = __builtin_amdgcn_fmed3f(uv[i], -384.f, 512.f); }
                    typedef float f32x2s __attribute__((ext_vector_type(2)));
                    const f32x2s kc = {-1.702f * LOG2E * 0.015625f, -1.702f * LOG2E * 0.015625f}, k4 = {4096.f, 4096.f};
                    const f32x2s cg0 = (f32x2s){gg[0], gg[1]} * kc, cg1 = (f32x2s){gg[2], gg[3]} * kc;
                    t[0] = __builtin_amdgcn_exp2f(cg0[0]); t[1] = __builtin_amdgcn_exp2f(cg0[1]); t[2] = __builtin_amdgcn_exp2f(cg1[0]); t[3] = __builtin_amdgcn_exp2f(cg1[1]);
                    const f32x2s d0 = __builtin_elementwise_fma((f32x2s){t[0], t[1]}, k4, k4), d1 = __builtin_elementwise_fma((f32x2s){t[2], t[3]}, k4, k4);
                    const f32x4 den = {d0[0], d0[1], d1[0], d1[1]};
#pragma unroll
                    for (int i = 0; i < 4; ++i) sg[i] = __builtin_amdgcn_rcpf(den[i]);
                    const f32x4 av = (uu * gg) * sg;
#pragma unroll
                    for (int i = 0; i < 4; ++i) a[4 * n + i] = av[i];
#else
                    const f32x4 gv = acc[ai][0][m][n] + bg[n], uv = acc[ai][1][m][n] + bu[n];
#pragma unroll
                    for (int i = 0; i < 4; ++i) {
                        const float gg = fminf(gv[i], 448.f), uu = fminf(fmaxf(uv[i], -384.f), 512.f);
                        const float t = __builtin_amdgcn_exp2f((-1.702f * LOG2E * 0.015625f) * gg);
                        const float sg = __builtin_amdgcn_rcpf(__builtin_fmaf(t, 4096.f, 4096.f));
                        a[4 * n + i] = (uu * gg) * sg;
                    }
#endif
                }
                u32x2e w; w.x = pk4_fp8(a[0], a[1], a[2], a[3]); w.y = pk4_fp8(a[4], a[5], a[6], a[7]);
                if (GU_PAIR) wq[m] = w;
                else if (NT_STORE & 2) __builtin_nontemporal_store(w, (u32x2e*)(ACT + (size_t)row * D + j0)); else *(u32x2e*)(ACT + (size_t)row * D + j0) = w;
            }
            if (GU_PAIR) {
                const bool odd = (fq & 1) != 0;
#pragma unroll
                for (int mp = 0; mp < 2; ++mp) { const u32x2e mine = odd ? wq[2 * mp + 1] : wq[2 * mp], send = odd ? wq[2 * mp] : wq[2 * mp + 1];
                    u32x2e recv; recv.x = (unsigned)__shfl_xor((int)send.x, 16); recv.y = (unsigned)__shfl_xor((int)send.y, 16);
                    const int row = u.pm * BM + ai * HALF + wr * 64 + (2 * mp + (odd ? 1 : 0)) * 16 + fr;
                    u32x4 o; if (odd) { o.x = recv.x; o.y = recv.y; o.z = mine.x; o.w = mine.y; } else { o.x = mine.x; o.y = mine.y; o.z = recv.x; o.w = recv.y; }
                    *(u32x4*)(ACT + (size_t)row * D + (j0 & ~15)) = o; } }
        }
        }
    }
};
template <int VAR> struct EpiProbeGU {
    static constexpr bool PERM = true, AFTER_DRAIN = false; static constexpr int NSTORE = 0;
    unsigned char* ACT; const float* bgu;
    __device__ __forceinline__ void operator()(const f32x4 (&acc)[2][2][4][2], const Unit& u, int wr, int wc, int fr, int fq) const {
        if (VAR == 2) { if (acc[0][0][0][0][0] == 12345.678f) ACT[0] = 1; return; }
        asm volatile("" : "+v"(fr), "+v"(fq));
        const int pnl = u.pn & 7, j0 = pnl * 128 + wc * 32 + 8 * fq;
#pragma unroll
        for (int ai = 0; ai < 2; ++ai)
#pragma unroll
            for (int m = 0; m < 4; ++m) {
                const int row = u.pm * BM + ai * HALF + wr * 64 + m * 16 + fr;
                const f32x4 g0 = acc[ai][0][m][0] + acc[ai][1][m][0], g1 = acc[ai][0][m][1] + acc[ai][1][m][1];
                typedef unsigned u32x2e __attribute__((ext_vector_type(2)));
                u32x2e w; w.x = pk4_fp8(g0[0], g0[1], g0[2], g0[3]); w.y = pk4_fp8(g1[0], g1[1], g1[2], g1[3]);
                *(u32x2e*)(ACT + (size_t)row * D + j0) = w;
            }
    }
};
struct EpiNone { static constexpr bool PERM = true, AFTER_DRAIN = false; static constexpr int NSTORE = 0; unsigned char* P;
    __device__ __forceinline__ void operator()(const f32x4 (&acc)[2][2][4][2], const Unit& u, int wr, int wc, int fr, int fq) const { if (acc[0][0][0][0][0] == 12345.678f) P[0] = 1; } };
struct EpiDown8 {
    static constexpr bool PERM = true, AFTER_DRAIN = false; static constexpr int NSTORE = 16;
    bf16_t* Y; const float* bdn;
    __device__ __forceinline__ void operator()(const f32x4 (&acc)[2][2][4][2], const Unit& u, int wr, int wc, int fr, int fq) const {
        _Pragma("unroll") for (int rep_e = 0; rep_e < 1 + ((PROBE_EPI >> 2) & 1); ++rep_e) {
        asm volatile("" : "+v"(fr), "+v"(fq));
        const int e = u.pn >> 2, pnl = u.pn & 3;
#pragma unroll
        for (int ai = 0; ai < 2; ++ai)
#pragma unroll
            for (int m = 0; m < 4; ++m) {
                const int row = u.pm * BM + ai * HALF + wr * 64 + m * 16 + fr;
#pragma unroll
                for (int bj = 0; bj < 2; ++bj) {
                    const int col = pnl * BM + bj * HALF + wc * 32 + 8 * fq;
                    const f32x4 b0 = *(const f32x4*)(bdn + e * 1024 + col), b1 = *(const f32x4*)(bdn + e * 1024 + col + 4);
                    const f32x4 v0 = acc[ai][bj][m][0] * 0.015625f + b0, v1 = acc[ai][bj][m][1] * 0.015625f + b1;
                    if (Y_FP8) { typedef unsigned u32x2e __attribute__((ext_vector_type(2))); u32x2e w8; w8.x = pk4_fp8(v0[0], v0[1], v0[2], v0[3]); w8.y = pk4_fp8(v1[0], v1[1], v1[2], v1[3]);
                        if (NT_STORE & 4) __builtin_nontemporal_store(w8, (u32x2e*)((unsigned char*)Y + (size_t)row * D + col)); else *(u32x2e*)((unsigned char*)Y + (size_t)row * D + col) = w8; }
                    else { u32x4 w; w.x = cvt_pk_bf16(v0[0], v0[1]); w.y = cvt_pk_bf16(v0[2], v0[3]); w.z = cvt_pk_bf16(v1[0], v1[1]); w.w = cvt_pk_bf16(v1[2], v1[3]);
                        *(u32x4*)(Y + (size_t)row * D + col) = w; }
                }
            }
        }
    }
};
struct EpiDown8W {
    static constexpr bool PERM = true, AFTER_DRAIN = false, BIAS_INIT = (EPI_BIAS_INIT != 0); static constexpr int NSTORE = 8;
    unsigned char* Y; const float* bdn;
    __device__ __forceinline__ void bias(const Unit& u, int wc, int fq, f32x4 (&bi)[2][2]) const {
        const int e = u.pn >> 2, pnl = u.pn & 3; const float* bp = bdn + e * 1024 + pnl * BM + wc * 64 + 16 * fq;
#pragma unroll
        for (int bj = 0; bj < 2; ++bj)
#pragma unroll
            for (int n = 0; n < 2; ++n) bi[bj][n] = *(const f32x4*)(bp + 8 * bj + 4 * n) * 64.f; }
    __device__ __forceinline__ void operator()(const f32x4 (&acc)[2][2][4][2], const Unit& u, int wr, int wc, int fr, int fq) const {
        asm volatile("" : "+v"(fr), "+v"(fq));
        const int e = u.pn >> 2, pnl = u.pn & 3, col = pnl * BM + wc * 64 + 16 * fq;
        const float* bp = bdn + e * 1024 + col;
        f32x4 b0 = {0.f, 0.f, 0.f, 0.f}, b1 = b0, b2 = b0, b3 = b0;
        if (!BIAS_INIT) { b0 = *(const f32x4*)(bp); b1 = *(const f32x4*)(bp + 4); b2 = *(const f32x4*)(bp + 8); b3 = *(const f32x4*)(bp + 12); }
#pragma unroll
        for (int ai = 0; ai < 2; ++ai)
#pragma unroll
            for (int m = 0; m < 4; ++m) {
                const int row = u.pm * BM + ai * HALF + wr * 64 + m * 16 + fr;
                const f32x4 v0 = acc[ai][0][m][0] * 0.015625f + b0, v1 = acc[ai][0][m][1] * 0.015625f + b1, v2 = acc[ai][1][m][0] * 0.015625f + b2, v3 = acc[ai][1][m][1] * 0.015625f + b3;
                u32x4 w; w.x = pk4_fp8(v0[0], v0[1], v0[2], v0[3]); w.y = pk4_fp8(v1[0], v1[1], v1[2], v1[3]); w.z = pk4_fp8(v2[0], v2[1], v2[2], v2[3]); w.w = pk4_fp8(v3[0], v3[1], v3[2], v3[3]);
                *(u32x4*)(Y + (size_t)row * D + col) = w;
            }
    }
};
struct KVQOrder : StaticOrder {
    __device__ bool next(int i, Unit& u) const { if (!StaticOrder::next(i, u)) return false; if (u.pn >= 8) u.pm += 128; return true; }
};
template <int NN> struct MoeOrder {
    static constexpr int TR = 32 / NN;
    const LAS int* tile_exp; int n_tiles, c, G;
    __device__ __forceinline__ bool next(int i, Unit& u) const {
        int st, j;
        if (G == 256) {
            if (MOE_CONTIG) { const int spx = ((n_tiles + TR - 1) / TR + 7) >> 3;
                if (i >= spx) return false; st = (c & 7) * spx + i; }
            else st = i * 8 + (c & 7);
            j = c >> 3; }
        else { const int L = i * G + c; st = L >> 5; j = L & 31; }
        const int tile = st * TR + (j % TR);
        if (tile >= n_tiles) return false;
        u.pm = tile; u.pn = tile_exp[tile] * NN + j / TR; return true;
    }
    __device__ __forceinline__ void a_ready(const Unit&) const {}
    __device__ __forceinline__ void done(const Unit&) const {}
};
struct MoeOrderProbe { const LAS int* tile_exp; int n_tiles, c, G;
    __device__ __forceinline__ bool next(int i, Unit& u) const { int st, j; if (G == 256) { st = i * 8 + (c & 7); j = c >> 3; } else { const int L = i * G + c; st = L >> 5; j = L & 31; }
        const int tile = st * 4 + (j % 4); if (tile >= n_tiles) return false; u.pm = tile; u.pn = j / 4; return true; }
    __device__ __forceinline__ void a_ready(const Unit&) const {}
    __device__ __forceinline__ void done(const Unit&) const {} };
}

namespace attn_body {
constexpr int KSLOT = 8192;
constexpr int L_K = 0, L_V = 2 * KSLOT, L_WS = 4 * KSLOT, L_OST = L_WS + 8 * 256, L_TAB = L_OST + 8 * 4096, L_ATT_END = L_TAB + 1024;
__device__ __forceinline__ void qkt2(f32x16& p0, f32x16& p1, const char* Kslot, const bf16x8* qr, const f32x16& c0, const f32x16& c1, int r32, int hi) {
  const char* kb = Kslot + hi * 1024 + r32 * 16;
  #pragma unroll
  for (int d0 = 0; d0 < 4; ++d0) {
    const bf16x8 b0 = *reinterpret_cast<const bf16x8*>(kb + d0 * 2048);
    const bf16x8 b1 = *reinterpret_cast<const bf16x8*>(kb + d0 * 2048 + 512);
    if (d0 == 0) { p0 = __builtin_amdgcn_mfma_f32_32x32x16_bf16(b0, qr[0], c0, 0, 0, 0); p1 = __builtin_amdgcn_mfma_f32_32x32x16_bf16(b1, qr[0], c1, 0, 0, 0); }
    else { p0 = __builtin_amdgcn_mfma_f32_32x32x16_bf16(b0, qr[d0], p0, 0, 0, 0); p1 = __builtin_amdgcn_mfma_f32_32x32x16_bf16(b1, qr[d0], p1, 0, 0, 0); } }
}
template <int MODE> __device__ __forceinline__ void attn_unit(const bf16* Qp, const bf16* __restrict__ Kp, const bf16* __restrict__ Vp, int q0, bf16* Ob, long ostride,
                                                               float* lse, long lstride, const float* __restrict__ F2, const float* __restrict__ tabg, char* shm) {
  const int tid = threadIdx.x, lane = tid & 63, r32 = lane & 31, hi = lane >> 5; const int wid = __builtin_amdgcn_readfirstlane(tid >> 6);
  const unsigned lds0 = (unsigned)(uintptr_t)shm;
  float* wsf = (float*)(shm + L_WS) + wid * 64;
  const int tq = q0 >> 6, t_hi = tq + 4;
  const int t_lo = (MODE == 0) ? (tq >= 2 ? tq - 2 : 0) : 0;
  const int w_hi = tq + (wid >> 1);
  const int w_lo = (MODE == 0) ? (w_hi >= 2 ? w_hi - 2 : 0) : 0;
  const bf16* ksrc = Kp + (long)lane * 64 + wid * 8;
  const bf16* vsrc = Vp + (long)(16 * (wid & 3) + (lane >> 2)) * 64 + (wid >> 2) * 32 + (lane & 3) * 8;
  const unsigned kdst = lds0 + L_K + wid * 1024, vdst = lds0 + L_V + wid * 1024;
  #define DMA_KV(t, slot) do { glds16(ksrc + (long)(t) * 4096, (unsigned)__builtin_amdgcn_readfirstlane(kdst + (slot) * KSLOT)); glds16(vsrc + (long)(t) * 4096, (unsigned)__builtin_amdgcn_readfirstlane(vdst + (slot) * KSLOT)); } while (0)
  if (MODE == 0) { float* tab = (float*)(shm + L_TAB); if (tid < 129) tab[tid] = tabg[tid]; }
  const int qi = q0 + wid * 32 + r32;
  f32x4 fk[8];
  #pragma unroll
  for (int g4 = 0; g4 < 8; ++g4) fk[g4] = (f32x4){0.f, 0.f, 0.f, 0.f};
  float Fq = 0.f;
  if (MODE == 1) { Fq = F2[qi];
    #pragma unroll
    for (int g4 = 0; g4 < 4; ++g4) { fk[g4] = *(const f32x4*)(F2 + 64 * t_lo + 4 * hi + 8 * g4); fk[4 + g4] = *(const f32x4*)(F2 + 64 * t_lo + 32 + 4 * hi + 8 * g4); } }
  bf16x8 qr[4];
  { const bf16* Qw = Qp + (long)(q0 + wid * 32) * 64;
    #pragma unroll
    for (int d0 = 0; d0 < 4; ++d0) qr[d0] = *reinterpret_cast<const bf16x8*>(&Qw[(long)r32 * 64 + d0 * 16 + hi * 8]); }
  DMA_KV(t_lo, 0);
  float m_run = -INFINITY, l_run = 0.f; f32x16 o[2]; o[0] = f32x16{}; o[1] = f32x16{};
  const int vb0 = (int)(lds0 + L_V) + ((lane >> 4) & 1) * 32 + (lane & 3) * 8 + (4 * hi + ((lane & 15) >> 2)) * 64;
  for (int t = t_lo; t < t_hi; ++t) {
    const int s = (t - t_lo) & 1;
    asm volatile("s_waitcnt vmcnt(0) lgkmcnt(0)\n\ts_barrier" ::: "memory");
    f32x4 fn[8];
    #pragma unroll
    for (int g4 = 0; g4 < 8; ++g4) fn[g4] = fk[g4];
    if (t + 1 < t_hi) {
      if (MODE == 1) {
        #pragma unroll
        for (int g4 = 0; g4 < 4; ++g4) { fn[g4] = *(const f32x4*)(F2 + 64 * (t + 1) + 4 * hi + 8 * g4); fn[4 + g4] = *(const f32x4*)(F2 + 64 * (t + 1) + 32 + 4 * hi + 8 * g4); } }
      DMA_KV(t + 1, s ^ 1);
    }
    if (t >= w_lo && t <= w_hi) {
      f32x16 c0, c1, p0, p1;
      if (MODE == 1) {
        #pragma unroll
        for (int r = 0; r < 16; ++r) { c0[r] = Fq - fk[r >> 2][r & 3]; c1[r] = Fq - fk[4 + (r >> 2)][r & 3]; }
      } else {
        const float* tab = (const float*)(shm + L_TAB);
        #pragma unroll
        for (int r = 0; r < 16; ++r) { const int d0_ = qi - (64 * t + crow(r, hi)), d1_ = d0_ - 32;
          c0[r] = tab[d0_ < 0 ? 0 : (d0_ > 128 ? 128 : d0_)]; c1[r] = tab[d1_ < 0 ? 0 : (d1_ > 128 ? 128 : d1_)]; }
      }
      qkt2(p0, p1, shm + L_K + s * KSLOT, qr, c0, c1, r32, hi);
      if (MODE == 1) {
        if (t == w_hi) {
          #pragma unroll
          for (int r = 0; r < 16; ++r) { const int kv = 64 * t + crow(r, hi); if (kv > qi) p0[r] = -INFINITY; if (kv + 32 > qi) p1[r] = -INFINITY; } }
      } else {
        #pragma unroll
        for (int r = 0; r < 16; ++r) { const int d0_ = qi - (64 * t + crow(r, hi)), d1_ = d0_ - 32;
          if ((unsigned)d0_ > 128u) p0[r] = -INFINITY; if ((unsigned)d1_ > 128u) p1[r] = -INFINITY; }
      }
      const float rm = rowmax(p0, p1), mnew = fmaxf(m_run, rm), msub = (mnew == -INFINITY) ? 0.f : mnew;
      const float f = __builtin_amdgcn_exp2f(m_run - msub);
      m_run = mnew;
      float sacc = 0.f;
      #pragma unroll
      for (int r = 0; r < 16; ++r) { p0[r] = __builtin_amdgcn_exp2f(p0[r] - msub); p1[r] = __builtin_amdgcn_exp2f(p1[r] - msub); sacc += p0[r] + p1[r]; }
      l_run = l_run * f + sacc;
      if (__any(f != 1.f)) {
        if (hi == 0) wsf[r32] = f;
        asm volatile("s_waitcnt lgkmcnt(0)" ::: "memory");
        #pragma unroll
        for (int r = 0; r < 16; ++r) { const float ff = wsf[crow(r, hi)]; o[0][r] *= ff; o[1][r] *= ff; }
      }
      u32x4 pw0, pw1, pw2, pw3;
      pw0 = (u32x4){cvtpk_s(p0[0], p0[1]), cvtpk_s(p0[2], p0[3]), cvtpk_s(p0[4], p0[5]), cvtpk_s(p0[6], p0[7])};
      pw1 = (u32x4){cvtpk_s(p0[8], p0[9]), cvtpk_s(p0[10], p0[11]), cvtpk_s(p0[12], p0[13]), cvtpk_s(p0[14], p0[15])};
      pw2 = (u32x4){cvtpk_s(p1[0], p1[1]), cvtpk_s(p1[2], p1[3]), cvtpk_s(p1[4], p1[5]), cvtpk_s(p1[6], p1[7])};
      pw3 = (u32x4){cvtpk_s(p1[8], p1[9]), cvtpk_s(p1[10], p1[11]), cvtpk_s(p1[12], p1[13]), cvtpk_s(p1[14], p1[15])};
      SBAR();
      pv(o, vb0 + s * KSLOT, __builtin_bit_cast(bf16x8, pw0), __builtin_bit_cast(bf16x8, pw1), __builtin_bit_cast(bf16x8, pw2), __builtin_bit_cast(bf16x8, pw3));
    }
    #pragma unroll
    for (int g4 = 0; g4 < 8; ++g4) fk[g4] = fn[g4];
  }
  { auto rr = __builtin_amdgcn_permlane32_swap(__float_as_uint(l_run), __float_as_uint(l_run), false, false); l_run = __uint_as_float(rr[0]) + __uint_as_float(rr[1]); }
  if (hi == 0) { wsf[32 + r32] = l_run; if (MODE == 0) lse[(long)qi * lstride] = m_run + __builtin_amdgcn_logf(l_run); }
  asm volatile("s_waitcnt lgkmcnt(0)" ::: "memory");
  float rli[16];
  #pragma unroll
  for (int r = 0; r < 16; ++r) rli[r] = __builtin_amdgcn_rcpf(wsf[32 + crow(r, hi)]);
  { bf16* stg = (bf16*)(shm + L_OST) + wid * 2048;
    #pragma unroll
    for (int r = 0; r < 16; ++r) { const int orow = crow(r, hi);
      #pragma unroll
      for (int d0 = 0; d0 < 2; ++d0) stg[orow * 64 + d0 * 32 + r32] = __float2bfloat16(o[d0][r] * rli[r]); }
    asm volatile("s_waitcnt lgkmcnt(0)" ::: "memory");
    bf16* Ow = Ob + (long)(q0 + wid * 32) * ostride;
    #pragma unroll
    for (int i = 0; i < 4; ++i) { const int row = i * 8 + (lane >> 3), ch = lane & 7; const u32x4 v = *(const u32x4*)(stg + row * 64 + ch * 8); *(u32x4*)(Ow + (long)row * ostride + ch * 8) = v; } }
  asm volatile("s_waitcnt lgkmcnt(0)\n\ts_barrier" ::: "memory");
  #undef DMA_KV
}
#undef SBAR
#undef WAIT_BAR
}

namespace attn_body {
constexpr int NSLOT = 3, SLOTB = 8192;
constexpr int T_K = 0, T_V = NSLOT * SLOTB, T_WS = 2 * NSLOT * SLOTB, T_OST = T_WS + 8 * 256, T_END = T_OST + 8 * 4096;
constexpr int T_F = 90112;
__device__ __forceinline__ void glds16s(unsigned voff,const void*sbase,unsigned lds_dst){unsigned keep;
  asm volatile("s_mov_b32 %0, m0\n\ts_mov_b32 m0, %3\n\ts_nop 0\n\tglobal_load_lds_dwordx4 %1, %2\n\ts_mov_b32 m0, %0":"=&s"(keep):"v"(voff),"s"(sbase),"s"(lds_dst):"memory");}
__device__ __forceinline__ f32x2_t pkadd(f32x2_t a,f32x2_t b){f32x2_t r;asm("v_pk_add_f32 %0, %1, %2":"=v"(r):"v"(a),"v"(b));return r;}
__device__ __forceinline__ f32x2_t pksub(f32x2_t a,f32x2_t b){f32x2_t r;asm("v_pk_add_f32 %0, %1, %2 neg_lo:[0,1] neg_hi:[0,1]":"=v"(r):"v"(a),"v"(b));return r;}
#define SBAR() __builtin_amdgcn_sched_barrier(0)
#define WAIT_BAR(N) asm volatile("s_waitcnt vmcnt(" #N ") lgkmcnt(0)\n\ts_barrier":::"memory")
template<int MODE, int THRL, int VAR=0> __device__ __forceinline__ void attn_unit_t(const bf16* Qw0, const bf16* __restrict__ Kb, const bf16* __restrict__ Vb, const int NT, const int qoff,
                                                                         bf16* Ob, long ostride, float* lse, long lstride, char* shm, unsigned* qhead = nullptr, volatile __attribute__((address_space(3))) int* qnext = nullptr) {
  const int tid=threadIdx.x,lane=tid&63,r32=lane&31,hi=lane>>5; const int wid=__builtin_amdgcn_readfirstlane(tid>>6);
  const unsigned lds0=(unsigned)(uintptr_t)shm;
  float*wsf=(float*)(shm+T_WS)+wid*64;
  typedef __attribute__((address_space(3))) const float* lds_f;
  const lds_f Fl=(lds_f)(shm+T_F)+((MODE==1)?qoff:0);
  const unsigned koff_=(unsigned)(lane*128+wid*16), voff_=(unsigned)((16*(wid&3)+(lane>>2))*128+(wid>>2)*64+(lane&3)*16);
  #define KOFF() koff_
  #define VOFF() voff_
  const unsigned kdst=lds0+T_K+wid*1024, vdst=lds0+T_V+wid*1024;
  #define DMA_K(t,slot) glds16s(KOFF(),(const char*)Kb+(long)(t)*8192,(unsigned)__builtin_amdgcn_readfirstlane(kdst+(slot)))
  #define DMA_V(t,slot) glds16s(VOFF(),(const char*)Vb+(long)(t)*8192,(unsigned)__builtin_amdgcn_readfirstlane(vdst+(slot)))
  const char*Kbase=shm+T_K; bf16x8 kf[8];
  const lds_cptr shm3=(lds_cptr)shm; const lds_cptr kp0=shm3+T_K+hi*1024+r32*16; const lds_cptr vp0=shm3+T_V+((lane>>4)&1)*32+(lane&3)*8+(4*hi+((lane&15)>>2))*64;
  DMA_K(0,0);DMA_V(0,0);DMA_K(1,SLOTB);
  bf16x8 qr[4];
  { const bf16*Qw=Qw0+(long)(wid*32)*64;
    #pragma unroll
    for(int d0=0;d0<4;++d0)qr[d0]=*reinterpret_cast<const bf16x8*>(&Qw[(long)r32*64+d0*16+hi*8]); }
  float mhat=0.f,l_reg=0.f;f32x16 o[2];o[0]=f32x16{};o[1]=f32x16{};
  const int qrel=wid*32+r32;
  const int qpos=(MODE>=1)?(64*(NT-4)+qrel):(qoff+qrel);
  #define FQ() ((MODE==1)?Fl[64*(NT-4)+wid*32+r32]:0.f)
  const int jb0=384-qpos+4*hi;
  #define CINIT(C0,C1,t,MASKED) do{ \
    if(MODE==2){ _Pragma("unroll") for(int r=0;r<16;++r){ C0[r]=-mhat; C1[r]=-mhat; } \
      if(MASKED){ const int jb_=(t)-(NT-4); if(jb_>=0){ const int kb_=64*jb_+4*hi; \
        _Pragma("unroll") for(int r=0;r<16;++r){ const int kv_=kb_+(r&3)+8*(r>>2); if(kv_>qrel)C0[r]=-INFINITY; if(kv_+32>qrel)C1[r]=-INFINITY; } } } \
    } else if(MODE==1){ const float fqm=FQ()-mhat; const lds_f fp_=Fl+64*(t)+4*hi; \
      _Pragma("unroll") for(int g4=0;g4<4;++g4){ const f32x4 a_=*(const __attribute__((address_space(3))) f32x4*)(fp_+8*g4), b_=*(const __attribute__((address_space(3))) f32x4*)(fp_+32+8*g4); \
        if(FOX_PK&1){ const f32x2_t fq2_={fqm,fqm}; const f32x2_t x0_=pksub(fq2_,(f32x2_t){a_[0],a_[1]}), x1_=pksub(fq2_,(f32x2_t){a_[2],a_[3]}), y0_=pksub(fq2_,(f32x2_t){b_[0],b_[1]}), y1_=pksub(fq2_,(f32x2_t){b_[2],b_[3]}); \
          C0[4*g4]=x0_[0]; C0[4*g4+1]=x0_[1]; C0[4*g4+2]=x1_[0]; C0[4*g4+3]=x1_[1]; C1[4*g4]=y0_[0]; C1[4*g4+1]=y0_[1]; C1[4*g4+2]=y1_[0]; C1[4*g4+3]=y1_[1]; } \
        else { _Pragma("unroll") for(int i_=0;i_<4;++i_){ C0[4*g4+i_]=fqm-a_[i_]; C1[4*g4+i_]=fqm-b_[i_]; } } } \
      if(MASKED){ const int jb_=(t)-(NT-4); if(jb_>=0){ const int kb_=64*jb_+4*hi; \
        _Pragma("unroll") for(int r=0;r<16;++r){ const int kv_=kb_+(r&3)+8*(r>>2); if(kv_>qrel)C0[r]=-INFINITY; if(kv_+32>qrel)C1[r]=-INFINITY; } } } \
    } else { const lds_f tp_=Fl+jb0+64*(t); \
      _Pragma("unroll") for(int r=0;r<16;++r){ C0[r]=tp_[(r&3)+8*(r>>2)]-mhat; C1[r]=tp_[32+(r&3)+8*(r>>2)]-mhat; } } \
  }while(0)
  bool resc=false;
  #define START(P0,P1) do{ const float rm=rowmax(P0,P1); resc=false; \
    { const float dl=(rm==-INFINITY)?0.f:rm; mhat=fadd_s(mhat,dl); \
      _Pragma("unroll") for(int r=0;r<16;++r){P0[r]=fsub_s(P0[r],dl);P1[r]=fsub_s(P1[r],dl);} } \
    _Pragma("unroll") for(int r=0;r<16;++r)P0[r]=__builtin_amdgcn_exp2f(P0[r]); }while(0)
  #define RESC() do{ if(resc){ asm volatile("s_waitcnt lgkmcnt(0)":::"memory"); \
      _Pragma("unroll") for(int d_=0;d_<2;++d_) _Pragma("unroll") for(int r=0;r<16;++r)o[d_][r]*=wsf[crow(r,hi)]; } }while(0)
  f32x16 pA0,pA1,pB0,pB1;
  int sl_prev=0,sl_cur=0,sl_next=SLOTB;
  #define ROT() do{sl_prev=sl_cur;sl_cur=sl_next;sl_next=(sl_next==(NSLOT-1)*SLOTB)?0:sl_next+SLOTB;}while(0)
  DMA_K(2,2*SLOTB);
  WAIT_BAR(3);
  CINIT(pA0,pA1,0,true);
  qkt2(pA0,pA1,Kbase,qr,pA0,pA1,r32,hi);asm volatile("s_nop 15\n\ts_nop 7":"+v"(pA0),"+v"(pA1));
  START(pA0,pA1);
  _Pragma("unroll") for(int r=0;r<16;++r)pA1[r]=__builtin_amdgcn_exp2f(pA1[r]);
  WAIT_BAR(0);
  DMA_K(3,0);DMA_V(1,SLOTB);
  ROT();
  kload8(kf,kp0+sl_cur);
  WAIT_BAR(2);
  s16x4 vlo[8],vhi[8]; u32x4 pw0,pw1,pw2,pw3;
  #define PKW(P,B) cvtpk_s(P[B],P[B+1])
  #define PAF(k) __builtin_bit_cast(bf16x8,pw##k)
  #define VFR(i) (bf16x8){vlo[i][0],vlo[i][1],vlo[i][2],vlo[i][3],vhi[i][0],vhi[i][1],vhi[i][2],vhi[i][3]}
  #define PIN(x) asm volatile("":"+v"(x))
  #define MX3(a,b,c) __builtin_fmaxf(__builtin_fmaxf((a),(b)),(c))
  #define GAPA(MF,A0,A1,A2,A3,W0,W1,PW) do{ MF; if(FOX_PK&2){ sacc2=pkadd(sacc2,(f32x2_t){A0,A1}); sacc2=pkadd(sacc2,(f32x2_t){A2,A3}); PIN(sacc2); } else { sacc+=A0; sacc+=A1; sacc+=A2; sacc+=A3; PIN(sacc); } W0; W1; PIN(PW); SBAR(); }while(0)
  #define EX(v) ((VAR==3)?(v):__builtin_amdgcn_exp2f(v))
  #define GAPB(MF,X,B) do{ if(VAR!=4){ MF; } X[B]=EX(X[B]); X[B+1]=EX(X[B+1]); X[B+2]=EX(X[B+2]); X[B+3]=EX(X[B+3]); PIN(X); SBAR(); }while(0)
  #define VRD(i) do{ if(VAR!=4){ vlo[i]=vtr(vp_+(((i)>>2)*4096+((i)&3)*1024)); vhi[i]=vtr(vp_+(((i)>>2)*4096+((i)&3)*1024+512)); } }while(0)
  #define KRD(G,j) do{ if((G)&&!(VAR==1&&(j)>=2)){ kload2(kf,kp0+sl_next,j); SBAR(); } }while(0)
  #define STEP(C0,C1,P0,P1,t,GK,GV,GL,MASKED) do{ SBAR(); \
    CINIT(C0,C1,t,MASKED); \
    const lds_cptr vp_=vp0+sl_prev; \
    VRD(0); SBAR(); float sacc=(FOX_PK&2)?0.f:(P0[0]+P0[1]); f32x2_t sacc2={P0[0],P0[1]}; \
    GAPA(C0=__builtin_amdgcn_mfma_f32_32x32x16_bf16(kf[0],qr[0],C0,0,0,0), P0[2],P0[3],P0[4],P0[5],     pw0[0]=PKW(P0,0), pw0[1]=PKW(P0,2), pw0); \
    VRD(4); SBAR(); GAPA(C1=__builtin_amdgcn_mfma_f32_32x32x16_bf16(kf[1],qr[0],C1,0,0,0), P0[6],P0[7],P0[8],P0[9],     pw0[2]=PKW(P0,4), pw0[3]=PKW(P0,6), pw0); \
    VRD(1); SBAR(); GAPA(C0=__builtin_amdgcn_mfma_f32_32x32x16_bf16(kf[2],qr[1],C0,0,0,0),   P0[10],P0[11],P0[12],P0[13], pw1[0]=PKW(P0,8), pw1[1]=PKW(P0,10), pw1); \
    VRD(5); SBAR(); GAPA(C1=__builtin_amdgcn_mfma_f32_32x32x16_bf16(kf[3],qr[1],C1,0,0,0),   P0[14],P0[15],P1[0],P1[1],   pw1[2]=PKW(P0,12),pw1[3]=PKW(P0,14), pw1); \
    VRD(2); SBAR(); GAPA(C0=(VAR==1)?C0:__builtin_amdgcn_mfma_f32_32x32x16_bf16(kf[4],qr[2],C0,0,0,0),   P1[2],P1[3],P1[4],P1[5],     pw2[0]=PKW(P1,0), pw2[1]=PKW(P1,2), pw2); \
    VRD(6); SBAR(); GAPA(C1=(VAR==1)?C1:__builtin_amdgcn_mfma_f32_32x32x16_bf16(kf[5],qr[2],C1,0,0,0),   P1[6],P1[7],P1[8],P1[9],     pw2[2]=PKW(P1,4), pw2[3]=PKW(P1,6), pw2); \
    VRD(3); SBAR(); GAPA(C0=(VAR==1)?C0:__builtin_amdgcn_mfma_f32_32x32x16_bf16(kf[6],qr[3],C0,0,0,0),   P1[10],P1[11],P1[12],P1[13], pw3[0]=PKW(P1,8), pw3[1]=PKW(P1,10), pw3); \
    VRD(7); SBAR(); GAPA(C1=(VAR==1)?C1:__builtin_amdgcn_mfma_f32_32x32x16_bf16(kf[7],qr[3],C1,0,0,0),   P1[14],P1[15],0.f,0.f,       pw3[2]=PKW(P1,12),pw3[3]=PKW(P1,14), pw3); \
    if(FOX_PK&2) l_reg+=sacc2[0]+sacc2[1]; else l_reg+=sacc; \
    if(VAR!=7){ if(GK){DMA_K((t)+3,sl_cur);} if(GV){DMA_V((t)+1,sl_next);} } \
    { float a=MX3(C0[0],C0[1],C1[0]),b=MX3(C0[2],C0[3],C1[1]); a=MX3(a,C1[2],C1[3]); \
      _Pragma("unroll") for(int r=4;r<16;r+=4){a=MX3(a,C0[r],C0[r+1]);b=MX3(b,C0[r+2],C0[r+3]);a=MX3(a,C1[r],C1[r+1]);b=MX3(b,C1[r+2],C1[r+3]);} \
      float rm=__builtin_fmaxf(a,b); { auto rr=__builtin_amdgcn_permlane32_swap(__float_as_uint(rm),__float_as_uint(rm),false,false); rm=__builtin_fmaxf(__uint_as_float(rr[0]),__uint_as_float(rr[1])); } \
      resc=false; \
      if(__builtin_expect(__any(rm>(float)THRL),0)){ const float dl=__builtin_fmaxf(rm,0.f); mhat+=dl; \
        _Pragma("unroll") for(int r=0;r<16;++r){C0[r]-=dl;C1[r]-=dl;} \
        const float f=__builtin_amdgcn_exp2f(-dl); l_reg*=f; if(hi==0)wsf[r32]=f; resc=true; } } \
    SBAR(); \
    GAPB(o[0]=__builtin_amdgcn_mfma_f32_32x32x16_bf16(PAF(0),VFR(0),o[0],0,0,0), C0,0); \
    GAPB(o[1]=__builtin_amdgcn_mfma_f32_32x32x16_bf16(PAF(0),VFR(4),o[1],0,0,0), C0,4); \
    KRD(GL,0); GAPB(o[0]=__builtin_amdgcn_mfma_f32_32x32x16_bf16(PAF(1),VFR(1),o[0],0,0,0), C0,8); \
    KRD(GL,1); GAPB(o[1]=__builtin_amdgcn_mfma_f32_32x32x16_bf16(PAF(1),VFR(5),o[1],0,0,0), C0,12); \
    KRD(GL,2); GAPB(o[0]=__builtin_amdgcn_mfma_f32_32x32x16_bf16(PAF(2),VFR(2),o[0],0,0,0), C1,0); \
    KRD(GL,3); GAPB(o[1]=__builtin_amdgcn_mfma_f32_32x32x16_bf16(PAF(2),VFR(6),o[1],0,0,0), C1,4); \
    GAPB(o[0]=__builtin_amdgcn_mfma_f32_32x32x16_bf16(PAF(3),VFR(3),o[0],0,0,0), C1,8); \
    GAPB(o[1]=__builtin_amdgcn_mfma_f32_32x32x16_bf16(PAF(3),VFR(7),o[1],0,0,0), C1,12); \
    }while(0)
  int t=1;
  for(;t+5<NT;t+=2){
    STEP(pB0,pB1,pA0,pA1,t,true,true,true,false);     if(VAR==6){asm volatile("s_waitcnt vmcnt(2) lgkmcnt(0)":::"memory");}else{WAIT_BAR(2);} RESC(); ROT();
    STEP(pA0,pA1,pB0,pB1,t+1,true,true,true,false);   if(VAR==6){asm volatile("s_waitcnt vmcnt(2) lgkmcnt(0)":::"memory");}else{WAIT_BAR(2);} RESC(); ROT();
  }
  #define ENDW(tt) do{ if((tt)+3<NT){WAIT_BAR(2);} else if((tt)+2<NT){WAIT_BAR(1);} else {WAIT_BAR(0);} }while(0)
  for(;t+1<NT;t+=2){
    STEP(pB0,pB1,pA0,pA1,t,(t+3<NT),(t+1<NT),(t+1<NT),true);       ENDW(t);   RESC(); ROT();
    STEP(pA0,pA1,pB0,pB1,t+1,(t+4<NT),(t+2<NT),(t+2<NT),true);     ENDW(t+1); RESC(); ROT();
  }
  STEP(pB0,pB1,pA0,pA1,NT-1,false,false,false,true); RESC();
  int pend_=0; if(FOX_QPRE&&MODE==1&&qhead){ if(threadIdx.x==0) pend_=(int)__hip_atomic_fetch_add(qhead,1u,__ATOMIC_RELAXED,__HIP_MEMORY_SCOPE_AGENT); }
  { float sacc=pB0[0]+pB0[1]; _Pragma("unroll") for(int r=2;r<16;++r)sacc+=pB0[r]; _Pragma("unroll") for(int r=0;r<16;++r)sacc+=pB1[r]; l_reg+=sacc;
    pw0=(u32x4){PKW(pB0,0),PKW(pB0,2),PKW(pB0,4),PKW(pB0,6)};pw1=(u32x4){PKW(pB0,8),PKW(pB0,10),PKW(pB0,12),PKW(pB0,14)};pw2=(u32x4){PKW(pB1,0),PKW(pB1,2),PKW(pB1,4),PKW(pB1,6)};pw3=(u32x4){PKW(pB1,8),PKW(pB1,10),PKW(pB1,12),PKW(pB1,14)};
    int ln_=lane; asm volatile("":"+v"(ln_)); const int hi_=ln_>>5; const int vb0=(int)(lds0+T_V)+((ln_>>4)&1)*32+(ln_&3)*8+(4*hi_+((ln_&15)>>2))*64;
    SBAR(); pv(o,vb0+sl_cur,PAF(0),PAF(1),PAF(2),PAF(3)); }
  #undef PKW
  #undef PAF
  #undef VFR
  #undef PIN
  #undef MX3
  #undef GAPA
  #undef GAPB
  #undef EX
  #undef VRD
  #undef KRD
  #undef STEP
  #undef ENDW
  #undef CINIT
  {auto rr=__builtin_amdgcn_permlane32_swap(__float_as_uint(l_reg),__float_as_uint(l_reg),false,false);l_reg=__uint_as_float(rr[0])+__uint_as_float(rr[1]);}
  int r32e=r32,hie=hi; asm volatile("":"+v"(r32e),"+v"(hie));
  if(hie==0){ wsf[32+r32e]=l_reg; if(MODE==0) lse[(long)(wid*32+r32e)*lstride]=mhat+__builtin_amdgcn_logf(l_reg); }
  asm volatile("s_waitcnt lgkmcnt(0)":::"memory");
  float rli[16];
  #pragma unroll
  for(int r=0;r<16;++r)rli[r]=__builtin_amdgcn_rcpf(wsf[32+crow(r,hie)]);
  { bf16*stg=(bf16*)(shm+T_OST)+wid*2048;
    #pragma unroll
    for(int r=0;r<16;++r){const int orow=crow(r,hie);
      #pragma unroll
      for(int d0=0;d0<2;++d0)stg[orow*64+d0*32+r32e]=__float2bfloat16(o[d0][r]*rli[r]);}
    asm volatile("s_waitcnt lgkmcnt(0)":::"memory");
    bf16*Ow=Ob+(long)(wid*32)*ostride;
    int le_=lane; asm volatile("":"+v"(le_));
    #pragma unroll
    for(int i=0;i<4;++i){const int row=i*8+(le_>>3),ch=le_&7; const u32x4 v=*(const u32x4*)(stg+row*64+ch*8);
      if(WO_FP8&&MODE==1){ typedef unsigned u32x2o __attribute__((ext_vector_type(2))); u32x2o w8;
        w8.x=pg8::pk4_fp8(__uint_as_float(v.x<<16),__uint_as_float(v.x&0xffff0000u),__uint_as_float(v.y<<16),__uint_as_float(v.y&0xffff0000u));
        w8.y=pg8::pk4_fp8(__uint_as_float(v.z<<16),__uint_as_float(v.z&0xffff0000u),__uint_as_float(v.w<<16),__uint_as_float(v.w&0xffff0000u));
        *(u32x2o*)((unsigned char*)Ob+(long)(wid*32+row)*ostride+ch*8)=w8; }
      else *(u32x4*)(Ow+(long)row*ostride+ch*8)=v;} }
  if(FOX_QPRE&&MODE==1&&qhead){ if(threadIdx.x==0) qnext[0]=pend_; }
  asm volatile("s_waitcnt lgkmcnt(0)\n\ts_barrier":::"memory");
  #undef DMA_K
  #undef DMA_V
  #undef KOFF
  #undef FQ
  #undef VOFF
  #undef START
  #undef RESC
  #undef ROT
}
#undef SBAR
#undef WAIT_BAR
}

namespace attn_body {
constexpr int B_V = 0, B_VBUF = 49152, B_K = B_VBUF, B_WS = 2 * B_VBUF, B_OST = B_WS + 2048, B_TAB = B_OST + 32768, B_END = B_TAB + 2 * 1024;
struct BandUnit { const bf16* Q; const bf16* K; const bf16* V; bf16* O; float* L; const float* tab; int q0; int sh; };
__device__ __forceinline__ void band_decode(int L, BandUnit& u, const bf16* QKV, bf16* OG, float* LSE, const float* BT) {
    const int tri = L >> 4, u16 = L & 15, b = tri / 48, gh = tri % 48, g = gh >> 4, h = gh & 15;
    const int sh = 2 * g, Ls = 4096 >> sh;
    const int r = (g == 0) ? 0 : (g == 1 ? (u16 >> 2) : u16), uq = (g == 0) ? u16 : (g == 1 ? (u16 & 3) : 0);
    const size_t pl = (size_t)((b * 3 + g) * 3) * 16 + h;
    u.Q = QKV + (pl * 4096 + (size_t)r * Ls) * 64; u.K = u.Q + (size_t)16 * 4096 * 64; u.V = u.Q + (size_t)32 * 4096 * 64;
    const size_t tok0 = (size_t)b * 4096 + r;
    u.O = OG + ((size_t)g * 32768 + tok0) * 1024 + h * 64; u.L = LSE + ((size_t)g * 32768 + tok0) * 16 + h;
    u.tab = BT + gh * 132; u.q0 = uq * 256; u.sh = sh;
}
__device__ __forceinline__ void band_issue_v(const BandUnit& u, unsigned lds0, int lane, int wid) {
    const unsigned voff = (unsigned)((16 * (wid & 3) + (lane >> 2)) * 128 + (wid >> 2) * 64 + (lane & 3) * 16);
    const int w0 = u.q0 - 128;
    #pragma unroll
    for (int t = 0; t < 6; ++t) { const int k0 = w0 + 64 * t;
        if (k0 >= 0) glds16s(voff, (const char*)u.V + (long)k0 * 128, (unsigned)__builtin_amdgcn_readfirstlane(lds0 + B_V + t * 8192 + wid * 1024)); }
}
__device__ __forceinline__ void band_issue_k(const BandUnit& u, int tbuf, unsigned lds0, int tid, int lane, int wid) {
    const unsigned koff = (unsigned)(lane * 128 + wid * 16);
    const int w0 = u.q0 - 128;
    #pragma unroll
    for (int t = 0; t < 6; ++t) { const int k0 = w0 + 64 * t;
        if (k0 >= 0) glds16s(koff, (const char*)u.K + (long)k0 * 128, (unsigned)__builtin_amdgcn_readfirstlane(lds0 + B_K + t * 8192 + wid * 1024)); }
    if (tid < 192) { __attribute__((address_space(3))) float* tb = (__attribute__((address_space(3))) float*)(uintptr_t)(lds0 + B_TAB + tbuf * 1024);
        tb[tid] = (tid >= 32 && tid <= 160) ? u.tab[tid - 32] : -INFINITY; }
}
template <int VAR> __device__ __forceinline__ void band_phase(const bf16* QKV, bf16* OG, float* LSE, const float* BT, int first, int step, int NU, char* shm) {
    const int tid = threadIdx.x, lane = tid & 63, r32 = lane & 31, hi = lane >> 5; const int wid = __builtin_amdgcn_readfirstlane(tid >> 6);
    const unsigned lds0 = (unsigned)(uintptr_t)shm;
    float* wsf = (float*)(shm + B_WS) + wid * 64;
    typedef __attribute__((address_space(3))) const float* lds_f;
    BandUnit cur, nxt;
    int L = first, buf = 0;
#define BAND_LOADQ(U) do { const bf16* Qw_ = (U).Q + (long)((U).q0 + 32 * wid) * 64; \
        _Pragma("unroll") for (int d0 = 0; d0 < 4; ++d0) qn[d0] = *reinterpret_cast<const bf16x8*>(&Qw_[(long)r32 * 64 + d0 * 16 + hi * 8]); } while (0)
    bf16x8 qn[4];
    #pragma unroll
    for (int d0 = 0; d0 < 4; ++d0) qn[d0] = (bf16x8){0, 0, 0, 0, 0, 0, 0, 0};
    if (L < NU) { band_decode(L, cur, QKV, OG, LSE, BT); band_issue_k(cur, 0, lds0, tid, lane, wid); BAND_LOADQ(cur); }
    for (; L < NU; L += step, buf ^= 1) {
        const bool has_next = (L + step) < NU;
        if (has_next) band_decode(L + step, nxt, QKV, OG, LSE, BT); else nxt = cur;
        const int qw = cur.q0 + 32 * wid;
        const int jlo = (qw >= 128) ? 0 : ((128 - qw) >> 5);
        if (L == first) asm volatile("s_waitcnt vmcnt(0) lgkmcnt(0)\n\ts_barrier" ::: "memory");
        else asm volatile("s_waitcnt vmcnt(5) lgkmcnt(0)\n\ts_barrier" ::: "memory");
        bf16x8 qr[4];
        #pragma unroll
        for (int d0 = 0; d0 < 4; ++d0) qr[d0] = qn[d0];
        band_issue_v(cur, lds0, lane, wid);
        f32x16 S[5];
        { const lds_f tb = (lds_f)(uintptr_t)(lds0 + B_TAB + buf * 1024) + (5 + r32 - 4 * hi);
          #pragma unroll
          for (int j = 0; j < 5; ++j) {
              #pragma unroll
              for (int r = 0; r < 16; ++r) S[j][r] = (VAR == 2) ? 0.f : ((j >= jlo) ? tb[(128 - 32 * j) + 27 - ((r & 3) + 8 * (r >> 2))] : -INFINITY);
              if (VAR != 2 && j >= jlo) { const int wj = wid + j;
                  const __attribute__((address_space(3))) char* kp = (const __attribute__((address_space(3))) char*)(uintptr_t)(lds0 + B_K + (wj >> 1) * 8192 + hi * 1024 + ((wj & 1) * 32 + r32) * 16);
                  #pragma unroll
                  for (int d0 = 0; d0 < 4; ++d0) { const bf16x8 kf = *(const __attribute__((address_space(3))) bf16x8*)(kp + d0 * 2048);
                      S[j] = __builtin_amdgcn_mfma_f32_32x32x16_bf16(kf, qr[d0], S[j], 0, 0, 0); } } } }
        asm volatile("s_waitcnt vmcnt(0) lgkmcnt(0)\n\ts_barrier" ::: "memory");
        if (has_next) { band_issue_k(nxt, buf ^ 1, lds0, tid, lane, wid); BAND_LOADQ(nxt); }
        float mx = -INFINITY;
        #pragma unroll
        for (int j = 0; j < 5; ++j)
            #pragma unroll
            for (int r = 0; r < 16; ++r) mx = fmaxf(mx, S[j][r]);
        { auto rr = __builtin_amdgcn_permlane32_swap(__float_as_uint(mx), __float_as_uint(mx), false, false); mx = fmaxf(__uint_as_float(rr[0]), __uint_as_float(rr[1])); }
        float lsum = 0.f; u32x4 pw[5][2];
        #pragma unroll
        for (int j = 0; j < 5; ++j) {
            #pragma unroll
            for (int r = 0; r < 16; ++r) { if (VAR != 3) S[j][r] = __builtin_amdgcn_exp2f(S[j][r] - mx); lsum += S[j][r]; }
            pw[j][0] = (u32x4){cvtpk_s(S[j][0], S[j][1]), cvtpk_s(S[j][2], S[j][3]), cvtpk_s(S[j][4], S[j][5]), cvtpk_s(S[j][6], S[j][7])};
            pw[j][1] = (u32x4){cvtpk_s(S[j][8], S[j][9]), cvtpk_s(S[j][10], S[j][11]), cvtpk_s(S[j][12], S[j][13]), cvtpk_s(S[j][14], S[j][15])}; }
        { auto rr = __builtin_amdgcn_permlane32_swap(__float_as_uint(lsum), __float_as_uint(lsum), false, false); lsum = __uint_as_float(rr[0]) + __uint_as_float(rr[1]); }
        f32x16 o[2]; o[0] = f32x16{}; o[1] = f32x16{};
        const int vlane = ((lane >> 4) & 1) * 32 + (lane & 3) * 8 + (4 * hi + ((lane & 15) >> 2)) * 64;
        #pragma unroll
        for (int j = 0; j < 5; ++j) if (VAR != 1 && j >= jlo) {
            const int wj = wid + j;
            const int vb = (int)(lds0 + B_V) + (wj >> 1) * 8192 + (wj & 1) * 2048 + vlane;
            s16x4 l0[2], h0[2], l1[2], h1[2];
            #pragma unroll
            for (int d0 = 0; d0 < 2; ++d0) {
                asm volatile("ds_read_b64_tr_b16 %0,%1 offset:%c2" : "=&v"(l0[d0]) : "v"(vb), "i"(d0 * 4096) : "memory");
                asm volatile("ds_read_b64_tr_b16 %0,%1 offset:%c2" : "=&v"(h0[d0]) : "v"(vb), "i"(d0 * 4096 + 512) : "memory");
                asm volatile("ds_read_b64_tr_b16 %0,%1 offset:%c2" : "=&v"(l1[d0]) : "v"(vb), "i"(d0 * 4096 + 1024) : "memory");
                asm volatile("ds_read_b64_tr_b16 %0,%1 offset:%c2" : "=&v"(h1[d0]) : "v"(vb), "i"(d0 * 4096 + 1536) : "memory"); }
            asm volatile("s_waitcnt lgkmcnt(0)" : "+v"(l0[0]), "+v"(h0[0]), "+v"(l1[0]), "+v"(h1[0]), "+v"(l0[1]), "+v"(h0[1]), "+v"(l1[1]), "+v"(h1[1]) :: "memory"); __builtin_amdgcn_sched_barrier(0);
            #pragma unroll
            for (int d0 = 0; d0 < 2; ++d0) {
                o[d0] = __builtin_amdgcn_mfma_f32_32x32x16_bf16(__builtin_bit_cast(bf16x8, pw[j][0]), (bf16x8){l0[d0][0], l0[d0][1], l0[d0][2], l0[d0][3], h0[d0][0], h0[d0][1], h0[d0][2], h0[d0][3]}, o[d0], 0, 0, 0);
                o[d0] = __builtin_amdgcn_mfma_f32_32x32x16_bf16(__builtin_bit_cast(bf16x8, pw[j][1]), (bf16x8){l1[d0][0], l1[d0][1], l1[d0][2], l1[d0][3], h1[d0][0], h1[d0][1], h1[d0][2], h1[d0][3]}, o[d0], 0, 0, 0); } }
        const long ostride = 1024L << cur.sh, lstride = 16L << cur.sh;
        if (hi == 0) { wsf[32 + r32] = lsum; cur.L[(long)(qw + r32) * lstride] = mx + __builtin_amdgcn_logf(lsum); }
        asm volatile("s_waitcnt lgkmcnt(0)" ::: "memory");
        float rli[16];
        #pragma unroll
        for (int r = 0; r < 16; ++r) rli[r] = __builtin_amdgcn_rcpf(wsf[32 + crow(r, hi)]);
        { bf16* stg = (bf16*)(shm + B_OST) + wid * 2048;
          #pragma unroll
          for (int r = 0; r < 16; ++r) { const int orow = crow(r, hi);
            #pragma unroll
            for (int d0 = 0; d0 < 2; ++d0) stg[orow * 64 + d0 * 32 + r32] = __float2bfloat16(o[d0][r] * rli[r]); }
          asm volatile("s_waitcnt lgkmcnt(0)" ::: "memory");
          bf16* Ow = cur.O + (long)qw * ostride;
          #pragma unroll
          for (int i = 0; i < 4; ++i) { const int row = i * 8 + (lane >> 3), ch = lane & 7; const u32x4 v = *(const u32x4*)(stg + row * 64 + ch * 8); *(u32x4*)(Ow + (long)row * ostride + ch * 8) = v; } }
        cur = nxt;
    }
    asm volatile("s_waitcnt vmcnt(0) lgkmcnt(0)\n\ts_barrier" ::: "memory");
#undef BAND_LOADQ
}
}

namespace attn_body {
typedef int i32x8b __attribute__((ext_vector_type(8)));
typedef int i32x4b __attribute__((ext_vector_type(4)));
typedef int i32x2b __attribute__((ext_vector_type(2)));
constexpr int C_KV = 0, C_KVBUF = 49152  , C_WS = 2 * C_KVBUF, C_OST = C_WS + 2048, C_TAB = C_OST + 32768, C_END = C_TAB + 2 * 1024;
struct Band8Unit { const unsigned char* Q; const unsigned char* K; const unsigned char* V; bf16* O; float* L; const float* tab; int q0; int sh; };
__device__ __forceinline__ void band8_decode(int L, Band8Unit& u, const unsigned char* QKV, bf16* OG, float* LSE, const float* BT) {
    const int tri = L >> 4, u16 = L & 15, b = tri / 48, gh = tri % 48, g = gh >> 4, h = gh & 15;
    const int sh = 2 * g, Ls = 4096 >> sh;
    const int r = (g == 0) ? 0 : (g == 1 ? (u16 >> 2) : u16), uq = (g == 0) ? u16 : (g == 1 ? (u16 & 3) : 0);
    const size_t pl = (size_t)((b * 3 + g) * 3) * 16 + h;
    u.Q = QKV + (pl * 4096 + (size_t)r * Ls) * 64; u.K = u.Q + (size_t)16 * 4096 * 64; u.V = u.Q + (size_t)32 * 4096 * 64;
    const size_t tok0 = (size_t)b * 4096 + r;
    u.O = OG_FP8 ? (bf16*)((unsigned char*)OG + ((size_t)g * 32768 + tok0) * 1024 + h * 64) : OG + ((size_t)g * 32768 + tok0) * 1024 + h * 64; u.L = LSE + ((size_t)g * 32768 + tok0) * 16 + h;
    u.tab = BT + gh * 132; u.q0 = uq * 256; u.sh = sh;
}
template <bool WITH_TAB = true> __device__ __forceinline__ void band8_issue(const Band8Unit& u, int b, unsigned lds0, int tid, int lane, int wid) {
    const unsigned lane64 = (unsigned)lane * 64u;
    const int w0 = u.q0 - 128;
    #pragma unroll
    for (int i = 0; i < 3; ++i) { const int p = wid * 3 + i, k0 = w0 + 64 * (p >> 2);
        if (k0 >= 0) { const long go = (long)k0 * 64 + (p & 3) * 16;
            glds16s(lane64, (const char*)u.K + go, (unsigned)__builtin_amdgcn_readfirstlane(lds0 + C_KV + b * C_KVBUF + p * 1024));
            glds16s(lane64, (const char*)u.V + go, (unsigned)__builtin_amdgcn_readfirstlane(lds0 + C_KV + b * C_KVBUF + 24576 + p * 1024)); } }
    if (WITH_TAB && tid < 192) { __attribute__((address_space(3))) float* tb = (__attribute__((address_space(3))) float*)(uintptr_t)(lds0 + C_TAB + b * 1024);
        tb[tid] = (tid >= 32 && tid <= 160) ? u.tab[tid - 32] : -INFINITY; }
}
__device__ __forceinline__ unsigned pk4_e4m3(float a, float b, float c, float d) { int v = __builtin_amdgcn_cvt_pk_fp8_f32(a, b, 0, false); v = __builtin_amdgcn_cvt_pk_fp8_f32(c, d, v, true); return (unsigned)v; }
template <int VAR> __device__ __forceinline__ void band8_phase(const unsigned char* QKV, bf16* OG, float* LSE, const float* BT, int first, int step, int NU, char* shm) {
    const int tid = threadIdx.x, lane = tid & 63, r32 = lane & 31, hi = lane >> 5; const int wid = __builtin_amdgcn_readfirstlane(tid >> 6);
    const unsigned lds0 = (unsigned)(uintptr_t)shm;
    float* wsf = (float*)(shm + C_WS) + wid * 64;
    typedef __attribute__((address_space(3))) const float* lds_f;
    typedef __attribute__((address_space(3))) const i32x4b* lds_q;
    Band8Unit cur, nxt;
    int L = first, buf = 0;
#define BAND8_LOADQ(U) do { const unsigned char* Qw_ = (U).Q + (long)((U).q0 + 32 * wid + r32) * 64 + hi * 32; \
        qn[0] = *reinterpret_cast<const i32x4b*>(Qw_); qn[1] = *reinterpret_cast<const i32x4b*>(Qw_ + 16); } while (0)
    i32x4b qn[2]; qn[0] = (i32x4b){0, 0, 0, 0}; qn[1] = qn[0];
    if (L < NU) { band8_decode(L, cur, QKV, OG, LSE, BT); band8_issue(cur, 0, lds0, tid, lane, wid); BAND8_LOADQ(cur); }
    const int vlane8 = ((lane >> 4) & 1) * 1024 + ((((lane & 15) >> 3) & 1) * 8 + (((lane & 15) >> 1) & 3) + 4 * hi) * 16 + (lane & 1) * 8;
    for (; L < NU; L += step, buf ^= 1) {
        const bool has_next = (L + step) < NU;
        if (has_next) band8_decode(L + step, nxt, QKV, OG, LSE, BT); else nxt = cur;
        const int qw = cur.q0 + 32 * wid;
        const int jlo = (qw >= 128) ? 0 : ((128 - qw) >> 5);
        if (L == first) asm volatile("s_waitcnt vmcnt(0) lgkmcnt(0)\n\ts_barrier" ::: "memory");
        else if (OG_FP8) asm volatile("s_waitcnt vmcnt(3) lgkmcnt(0)\n\ts_barrier" ::: "memory");
        else asm volatile("s_waitcnt vmcnt(5) lgkmcnt(0)\n\ts_barrier" ::: "memory");
        const i32x8b qf = (i32x8b){qn[0][0], qn[0][1], qn[0][2], qn[0][3], qn[1][0], qn[1][1], qn[1][2], qn[1][3]};
#if BAND_TABLATE
        float tabv = -INFINITY; if (has_next && tid >= 32 && tid <= 160) tabv = nxt.tab[tid - 32];
        if (has_next) { band8_issue<false>(nxt, buf ^ 1, lds0, tid, lane, wid); BAND8_LOADQ(nxt); }
#else
        if (has_next) { band8_issue(nxt, buf ^ 1, lds0, tid, lane, wid); BAND8_LOADQ(nxt); }
#endif
        const unsigned kvb = lds0 + C_KV + buf * C_KVBUF;
        f32x16 S[5];
        { const lds_f tb = (lds_f)(uintptr_t)(lds0 + C_TAB + buf * 1024) + (5 + r32 - 4 * hi);
          #pragma unroll
          for (int j = 0; j < 5; ++j) {
              if (j < jlo) {
                  #pragma unroll
                  for (int r = 0; r < 16; ++r) S[j][r] = -INFINITY;
              } else { const int wj = wid + j;
                  #pragma unroll
                  for (int r = 0; r < 16; ++r) S[j][r] = tb[(128 - 32 * j) + 27 - ((r & 3) + 8 * (r >> 2))];
                  const lds_q kp = (lds_q)(uintptr_t)(kvb + (wj >> 1) * 4096 + hi * 2048 + ((wj & 1) * 32 + r32) * 16);
                  const i32x4b k0 = kp[0], k1 = kp[64];
                  S[j] = __builtin_amdgcn_mfma_scale_f32_32x32x64_f8f6f4((i32x8b){k0[0], k0[1], k0[2], k0[3], k1[0], k1[1], k1[2], k1[3]}, qf, S[j], 0, 0, 0, 0, 0, 0); } } }
        float mx = -INFINITY;
        #pragma unroll
        for (int j = 0; j < 5; ++j)
            #pragma unroll
            for (int r = 0; r < 16; ++r) mx = fmaxf(mx, S[j][r]);
        { auto rr = __builtin_amdgcn_permlane32_swap(__float_as_uint(mx), __float_as_uint(mx), false, false); mx = fmaxf(__uint_as_float(rr[0]), __uint_as_float(rr[1])); }
        const float mxs = mx - 7.f;
        float lsum = 0.f; unsigned pw[5][4];
#if BAND_PK
        typedef float f32x2b __attribute__((ext_vector_type(2)));
        f32x2b l2 = {0.f, 0.f}; const float nmxs_ = -mxs;
        #pragma unroll
        for (int j = 0; j < 5; ++j) {
            S[j] = S[j] + nmxs_;
            #pragma unroll
            for (int r = 0; r < 16; ++r) S[j][r] = __builtin_amdgcn_exp2f(S[j][r]);
            #pragma unroll
            for (int r = 0; r < 16; r += 2) l2 += (f32x2b){S[j][r], S[j][r + 1]};
#else
        #pragma unroll
        for (int j = 0; j < 5; ++j) {
            #pragma unroll
            for (int r = 0; r < 16; ++r) { S[j][r] = __builtin_amdgcn_exp2f(S[j][r] - mxs); lsum += S[j][r]; }
#endif
            #pragma unroll
            for (int q4 = 0; q4 < 4; ++q4) pw[j][q4] = pk4_e4m3(S[j][4 * q4], S[j][4 * q4 + 1], S[j][4 * q4 + 2], S[j][4 * q4 + 3]); }
#if BAND_PK
        lsum = l2[0] + l2[1];
#endif
        { auto rr = __builtin_amdgcn_permlane32_swap(__float_as_uint(lsum), __float_as_uint(lsum), false, false); lsum = __uint_as_float(rr[0]) + __uint_as_float(rr[1]); }
        f32x16 o[2]; o[0] = f32x16{}; o[1] = f32x16{};
        i32x2b vf[3][2][4];
        #pragma unroll
        for (int pr = 0; pr < 3; ++pr)
            #pragma unroll
            for (int c = 0; c < (pr == 2 ? 2 : 4); ++c) {
                const int j = 2 * pr + (c >> 1), je = j > jlo ? j : jlo, wj = wid + je;
                const int vb = (int)(kvb + 24576) + (wj >> 1) * 4096 + (wj & 1) * 512 + vlane8;
                asm volatile("ds_read_b64_tr_b8 %0,%1 offset:%c2" : "=&v"(vf[pr][0][c]) : "v"(vb), "i"((c & 1) * 256) : "memory");
                asm volatile("ds_read_b64_tr_b8 %0,%1 offset:%c2" : "=&v"(vf[pr][1][c]) : "v"(vb), "i"(2048 + (c & 1) * 256) : "memory"); }
        asm volatile("s_waitcnt lgkmcnt(0)" : "+v"(vf[0][0][0]), "+v"(vf[0][0][1]), "+v"(vf[0][0][2]), "+v"(vf[0][0][3]), "+v"(vf[0][1][0]), "+v"(vf[0][1][1]), "+v"(vf[0][1][2]), "+v"(vf[0][1][3]),
                     "+v"(vf[1][0][0]), "+v"(vf[1][0][1]), "+v"(vf[1][0][2]), "+v"(vf[1][0][3]), "+v"(vf[1][1][0]), "+v"(vf[1][1][1]), "+v"(vf[1][1][2]), "+v"(vf[1][1][3]),
                     "+v"(vf[2][0][0]), "+v"(vf[2][0][1]), "+v"(vf[2][1][0]), "+v"(vf[2][1][1]) :: "memory"); __builtin_amdgcn_sched_barrier(0);
        #pragma unroll
        for (int pr = 0; pr < 3; ++pr) {
            const i32x8b pa = (pr == 2) ? (i32x8b){(int)pw[4][0], (int)pw[4][1], (int)pw[4][2], (int)pw[4][3], 0, 0, 0, 0}
                                        : (i32x8b){(int)pw[2 * pr][0], (int)pw[2 * pr][1], (int)pw[2 * pr][2], (int)pw[2 * pr][3], (int)pw[2 * pr + 1][0], (int)pw[2 * pr + 1][1], (int)pw[2 * pr + 1][2], (int)pw[2 * pr + 1][3]};
            #pragma unroll
            for (int d0 = 0; d0 < 2; ++d0) {
                const i32x2b v2 = (pr == 2) ? vf[2][d0][0] : vf[pr][d0][2], v3 = (pr == 2) ? vf[2][d0][1] : vf[pr][d0][3];
                o[d0] = __builtin_amdgcn_mfma_scale_f32_32x32x64_f8f6f4(pa, (i32x8b){vf[pr][d0][0][0], vf[pr][d0][0][1], vf[pr][d0][1][0], vf[pr][d0][1][1], v2[0], v2[1], v3[0], v3[1]}, o[d0], 0, 0, 0, 0, 0, 0); } }
        const long ostride = 1024L << cur.sh, lstride = 16L << cur.sh;
        if (hi == 0) { wsf[32 + r32] = __builtin_amdgcn_rcpf(lsum); cur.L[(long)(qw + r32) * lstride] = mxs + __builtin_amdgcn_logf(lsum); }
        asm volatile("s_waitcnt lgkmcnt(0)" ::: "memory");
        float rli[16];
        #pragma unroll
        for (int r = 0; r < 16; ++r) rli[r] = wsf[32 + crow(r, hi)];
#if OG_FP8 && OG_TR
        {
          __attribute__((address_space(3))) unsigned char* stg = (__attribute__((address_space(3))) unsigned char*)(uintptr_t)(lds0 + C_OST + wid * 2048);
          #pragma unroll
          for (int d0 = 0; d0 < 2; ++d0)
            #pragma unroll
            for (int rq = 0; rq < 4; ++rq)
              *(__attribute__((address_space(3))) unsigned*)(stg + (d0 * 32 + r32) * 32 + 8 * rq + 4 * hi) =
                  pk4_e4m3(o[d0][4 * rq] * (rli[4 * rq] * 8.f), o[d0][4 * rq + 1] * (rli[4 * rq + 1] * 8.f), o[d0][4 * rq + 2] * (rli[4 * rq + 2] * 8.f), o[d0][4 * rq + 3] * (rli[4 * rq + 3] * 8.f));
          asm volatile("s_waitcnt lgkmcnt(0)" ::: "memory");
          const int g16 = lane >> 4;
          const int ta = (int)(lds0 + C_OST + wid * 2048) + ((lane & 15) >> 1) * 32 + (lane & 1) * 8 + 16 * (g16 & 1) + (g16 >> 1) * 512;
          i32x2b a0, b0, a1, b1;
          asm volatile("ds_read_b64_tr_b8 %0,%1" : "=&v"(a0) : "v"(ta) : "memory");
          asm volatile("ds_read_b64_tr_b8 %0,%1 offset:256" : "=&v"(b0) : "v"(ta) : "memory");
          asm volatile("ds_read_b64_tr_b8 %0,%1 offset:1024" : "=&v"(a1) : "v"(ta) : "memory");
          asm volatile("ds_read_b64_tr_b8 %0,%1 offset:1280" : "=&v"(b1) : "v"(ta) : "memory");
          asm volatile("s_waitcnt lgkmcnt(0)" : "+v"(a0), "+v"(b0), "+v"(a1), "+v"(b1) :: "memory");
          unsigned char* Ow = (unsigned char*)cur.O + (long)(qw + 16 * (g16 & 1) + (lane & 15)) * ostride + (g16 >> 1) * 16;
          *(u32x4*)(Ow) = (u32x4){(unsigned)a0[0], (unsigned)a0[1], (unsigned)b0[0], (unsigned)b0[1]};
          *(u32x4*)(Ow + 32) = (u32x4){(unsigned)a1[0], (unsigned)a1[1], (unsigned)b1[0], (unsigned)b1[1]}; }
#elif OG_FP8
        { unsigned char* stg = (unsigned char*)(shm + C_OST) + wid * 2048;
          #pragma unroll
          for (int r = 0; r < 16; ++r) { const int orow = crow(r, hi); const float sc8 = rli[r] * 8.f;
            #pragma unroll
            for (int d0 = 0; d0 < 2; ++d0) { const float x = o[d0][r] * sc8; stg[orow * 64 + d0 * 32 + r32] = (unsigned char)__builtin_amdgcn_cvt_pk_fp8_f32(x, x, 0, false); } }
          asm volatile("s_waitcnt lgkmcnt(0)" ::: "memory");
          unsigned char* Ow = (unsigned char*)cur.O + (long)qw * ostride;
          #pragma unroll
          for (int i = 0; i < 2; ++i) { const int row = i * 16 + (lane >> 2), ch = lane & 3; const u32x4 v = *(const u32x4*)(stg + row * 64 + ch * 16); *(u32x4*)(Ow + (long)row * ostride + ch * 16) = v; } }
#else
        { bf16* stg = (bf16*)(shm + C_OST) + wid * 2048;
          #pragma unroll
          for (int r = 0; r < 16; ++r) { const int orow = crow(r, hi);
            #pragma unroll
            for (int d0 = 0; d0 < 2; ++d0) stg[orow * 64 + d0 * 32 + r32] = __float2bfloat16(o[d0][r] * rli[r]); }
          asm volatile("s_waitcnt lgkmcnt(0)" ::: "memory");
          bf16* Ow = cur.O + (long)qw * ostride;
          #pragma unroll
          for (int i = 0; i < 4; ++i) { const int row = i * 8 + (lane >> 3), ch = lane & 7; const u32x4 v = *(const u32x4*)(stg + row * 64 + ch * 8); *(u32x4*)(Ow + (long)row * ostride + ch * 8) = v; } }
#endif
#if BAND_TABLATE
        if (has_next && tid < 192) { __attribute__((address_space(3))) float* tbn = (__attribute__((address_space(3))) float*)(uintptr_t)(lds0 + C_TAB + (buf ^ 1) * 1024); tbn[tid] = tabv; }
#endif
        cur = nxt;
    }
    asm volatile("s_waitcnt vmcnt(0) lgkmcnt(0)\n\ts_barrier" ::: "memory");
#undef BAND8_LOADQ
}
}
#define XB_TMO      128
#define XB_XCNT(j)  (256  + 64 * (j))
#define XB_XSUB(j)  (1280 + 64 * (j))
#define XB_XGEN(j)  (2304 + 64 * (j))
#define XB_TOP      3328
#define XB_TOPGEN   3392
#define XCD_BAR_WORDS 3456
#define XB_SPIN_CAP (1u << 18)

__device__ __forceinline__ unsigned xb_ld(unsigned* p)              { return __hip_atomic_load(p, __ATOMIC_RELAXED, __HIP_MEMORY_SCOPE_AGENT); }
__device__ __forceinline__ unsigned xb_add(unsigned* p, unsigned v) { return __hip_atomic_fetch_add(p, v, __ATOMIC_RELAXED, __HIP_MEMORY_SCOPE_AGENT); }
__device__ __forceinline__ unsigned xb_xcc_id() { return (unsigned)__builtin_amdgcn_s_getreg((3 << 11) | 20) & 0xFu; }
#define XB_SPIN(cond, bar) do { unsigned _sp = 0; while (cond) { __builtin_amdgcn_s_sleep(1); \
    if ((++_sp & 255u) == 0u) { if (xb_ld(&(bar)[XB_TMO])) break; if (_sp > XB_SPIN_CAP) { atomicAdd(&(bar)[XB_TMO], 1u); break; } } } } while (0)

struct XcdBarrier {
    unsigned* bar; unsigned x;
    volatile LAS unsigned* st;
};

__device__ __forceinline__ XcdBarrier xcd_barrier_post(unsigned* bar, volatile LAS unsigned* st) {
    XcdBarrier b; b.bar = bar; b.x = xb_xcc_id(); b.st = st;
    if (threadIdx.x == 0) (void)xb_add(&bar[XB_XCNT(b.x)], 1u);
    return b;
}
__device__ __forceinline__ void xcd_barrier_complete(unsigned* bar, unsigned x, unsigned& nloc, unsigned& nx) {
    const unsigned G = gridDim.x * gridDim.y * gridDim.z;
    unsigned sum, cnt, mine, sp = 0u;
    for (;;) {
        sum = 0u; cnt = 0u; mine = 0u;
#pragma unroll
        for (unsigned j = 0; j < 16; ++j) { const unsigned c = xb_ld(&bar[XB_XCNT(j)]); sum += c; cnt += (c > 0u) ? 1u : 0u; mine = (j == x) ? c : mine; }
        if (sum == G) break;
        __builtin_amdgcn_s_sleep(1);
        if ((++sp & 255u) == 0u) { if (xb_ld(&bar[XB_TMO])) break; if (sp > XB_SPIN_CAP) { atomicAdd(&bar[XB_TMO], 1u); break; } }
    }
    nloc = mine > 0u ? mine : 1u; nx = cnt > 0u ? cnt : 1u;
}

__device__ __forceinline__ void xcd_barrier(const XcdBarrier& b) {
    asm volatile("s_waitcnt vmcnt(0)" ::: "memory");
    __syncthreads();
    if (threadIdx.x == 0) {
        unsigned* bar = b.bar;
        __builtin_amdgcn_s_waitcnt(0);
        unsigned nloc = b.st[0], nx = b.st[1];
        if (nloc == 0u) { xcd_barrier_complete(bar, b.x, nloc, nx); b.st[0] = nloc; b.st[1] = nx; }
        const unsigned old = xb_add(&bar[XB_XSUB(b.x)], 1u);
        const unsigned gen = old / nloc;
        if (old + 1u == (gen + 1u) * nloc) {
            __builtin_amdgcn_fence(__ATOMIC_RELEASE, "agent");
            asm volatile("s_waitcnt vmcnt(0)" ::: "memory");
            const unsigned og = xb_add(&bar[XB_TOP], 1u);
            const unsigned tg = og / nx;
            if (og + 1u == (tg + 1u) * nx) xb_add(&bar[XB_TOPGEN], 1u);
            else XB_SPIN(xb_ld(&bar[XB_TOPGEN]) == tg, bar);
            __builtin_amdgcn_fence(__ATOMIC_ACQUIRE, "agent");
            xb_add(&bar[XB_XGEN(b.x)], 1u);
            asm volatile("s_waitcnt vmcnt(0)" ::: "memory");
        } else {
            XB_SPIN(xb_ld(&bar[XB_XGEN(b.x)]) == gen, bar);
            __builtin_amdgcn_fence(__ATOMIC_ACQUIRE, "agent");
            asm volatile("s_waitcnt vmcnt(0)" ::: "memory");
        }
    }
    __syncthreads();
}

struct Args { const float* in[21]; float* out; unsigned char* ws; int ph_lo, ph_hi; };
enum { IN_X = 0, IN_C, IN_ADAW, IN_ADAB, IN_NMIX, IN_NFFN, IN_AWQKV, IN_AWO, IN_RELB, IN_KVNG, IN_WKVF, IN_BF, IN_BWQ, IN_BWO, IN_RW, IN_RB, IN_WGU, IN_BGU, IN_WDN, IN_BDN, IN_FNG };

struct Ctx {
    LAS unsigned char* lds; unsigned char* ws; int tid, lane, wave, vcu, G;
};

__device__ __forceinline__ void transpose_item(const float* __restrict__ W, int pitch, int Kd, bf16* WT, int k0, int n0, int row_off, LAS float* scr, int lane) {
#pragma unroll
    for (int i = 0; i < 8; ++i) { const int kk = 8 * i + (lane >> 3), c4 = (lane & 7) * 4;
        const f32x4 v = *(const f32x4*)(W + (size_t)(k0 + kk) * pitch + n0 + c4);
        scr[kk * 33 + c4] = v[0]; scr[kk * 33 + c4 + 1] = v[1]; scr[kk * 33 + c4 + 2] = v[2]; scr[kk * 33 + c4 + 3] = v[3]; }
    LDS_WAIT(); asm volatile("" ::: "memory");
    const int c = lane & 7;
#pragma unroll
    for (int j = 0; j < 4; ++j) { const int n = (lane >> 3) + 8 * j; const LAS float* s = scr + (8 * c) * 33 + n;
        u32x4v o; o.x = pkbf(s[0 * 33], s[1 * 33]); o.y = pkbf(s[2 * 33], s[3 * 33]); o.z = pkbf(s[4 * 33], s[5 * 33]); o.w = pkbf(s[6 * 33], s[7 * 33]);
        *(u32x4v*)(WT + (size_t)(row_off + n0 + n) * Kd + k0 + 8 * c) = o; }
    LDS_WAIT(); asm volatile("" ::: "memory");
}

__device__ __forceinline__ void transpose_item8(const float* __restrict__ W, int pitch, int Kd, unsigned char* WT, int k0, int n0, int row_off, LAS float* scr, int lane) {
#pragma unroll
    for (int i = 0; i < 8; ++i) { const int kk = 8 * i + (lane >> 3), c4 = (lane & 7) * 4;
        const f32x4 v = *(const f32x4*)(W + (size_t)(k0 + kk) * pitch + n0 + c4) * 64.f;
        scr[kk * 33 + c4] = v[0]; scr[kk * 33 + c4 + 1] = v[1]; scr[kk * 33 + c4 + 2] = v[2]; scr[kk * 33 + c4 + 3] = v[3]; }
    LDS_WAIT(); asm volatile("" ::: "memory");
    const int c = lane & 7;
#pragma unroll
    for (int j = 0; j < 4; ++j) { const int n = (lane >> 3) + 8 * j; const LAS float* s = scr + (8 * c) * 33 + n;
        u32x2v o; o.x = pg8::pk4_fp8(s[0 * 33], s[1 * 33], s[2 * 33], s[3 * 33]); o.y = pg8::pk4_fp8(s[4 * 33], s[5 * 33], s[6 * 33], s[7 * 33]);
        *(u32x2v*)(WT + (size_t)(row_off + n0 + n) * Kd + k0 + 8 * c) = o; }
    LDS_WAIT(); asm volatile("" ::: "memory");
}

template <int DEPTH> __device__ __forceinline__ void convert_weights(const Ctx& C, const Args& a, const int part, const int idx, const int cnt, const int lo = 0, const int hi = 0) {
    LAS float* scr = (LAS float*)(C.lds + RING_OFF + C.wave * 8704);
    const int gw = idx * NWAVES + C.wave, NGW = cnt * NWAVES;
    constexpr int I_QKV = 16 * 288, I_SQ = 16 * 32, I_KV = 16 * 64, I_GU1 = 16 * 64, I_DN1 = 16 * 32;
    constexpr int O_WO0 = I_QKV, O_KV = O_WO0 + I_SQ, O_WQ = O_KV + I_KV, O_WO1 = O_WQ + I_SQ, O_GU = O_WO1 + I_SQ, O_DN = O_GU + 64 * I_GU1, NITEMS = O_DN + 64 * I_DN1;
    static_assert(QKV_FP8 && KVQ_FP8 && WO_FP8, "the pipelined prologue converts every weight to fp8");
    struct Item { const float* W; unsigned char* WT; int pitch, k0, n0, row_off; int rs = 8; };
    auto decode = [&](int it, Item& I) {
        if (it < O_WO0) { const int r = it, kb = r / 288, nb = r % 288; I = {a.in[IN_AWQKV], (unsigned char*)(C.ws + WS_WQKV), NQKV, 64 * kb, 32 * nb, 0}; }
        else if (it < O_KV) { const int r = it - O_WO0, kb = r / 32, nb = r % 32; I = {a.in[IN_AWO], (unsigned char*)(C.ws + WS_WO0), D, 64 * kb, 32 * nb, 0}; }
        else if (it < O_WQ) { const int r = it - O_KV, kb = r / 64, nb = r % 64; I = {a.in[IN_WKVF], (unsigned char*)(C.ws + WS_WKV), 2064, 64 * kb, 32 * nb, 0}; }
        else if (it < O_WO1) { const int r = it - O_WQ, kb = r / 32, nb = r % 32; I = {a.in[IN_BWQ], (unsigned char*)(C.ws + WS_WKV) + (size_t)2048 * D, D, 64 * kb, 32 * nb, 0}; }
        else if (it < O_GU) { const int r = it - O_WO1, kb = r / 32, nb = r % 32; I = {a.in[IN_BWO], (unsigned char*)(C.ws + WS_WO1), D, 64 * kb, 32 * nb, 0}; }
        else if (it < O_DN) { const int r = it - O_GU, mat = r / I_GU1, q = r % I_GU1, kb = q / 64, nb = q % 64;
            const int n0 = 32 * nb, which = n0 >> 10, j0 = n0 & 1023;
            const int drow0 = GU_BMAP ? (j0 >> 7) * 256 + ((j0 & 127) >> 5) * 64 + which * 8 : (j0 >> 7) * 256 + which * 128 + (j0 & 127);
            I = {a.in[IN_WGU] + (size_t)mat * D * 2048, (unsigned char*)(C.ws + WS_WGU) + (size_t)mat * 2048 * D, 2048, 64 * kb, n0, drow0 - n0, GU_BMAP ? 16 : 8}; }
        else { const int r = it - O_DN, mat = r / I_DN1, q = r % I_DN1, kb = q / 32, nb = q % 32;
            I = {a.in[IN_WDN] + (size_t)mat * D * D, (unsigned char*)(C.ws + WS_WDN) + (size_t)mat * D * D, D, 64 * kb, 32 * nb, 0}; }
    };
    const int lr = C.lane >> 3, c4 = (C.lane & 7) * 4;
#define P0_LOAD(V, I) do { _Pragma("unroll") for (int i = 0; i < 8; ++i) V[i] = NT_P0 ? __builtin_nontemporal_load((const f32x4*)((I).W + (size_t)((I).k0 + 8 * i + lr) * (I).pitch + (I).n0 + c4)) : *(const f32x4*)((I).W + (size_t)((I).k0 + 8 * i + lr) * (I).pitch + (I).n0 + c4); } while (0)
    constexpr int L1GU = 32 * I_GU1, L1DN = 32 * I_DN1;
    const int base_ = part == 0 ? 0 : (part == 1 ? O_GU : (part == 2 ? O_DN : (part == 3 ? O_GU + L1GU : O_DN + L1DN)));
    const int NV = part == 5 ? (hi > lo ? hi - lo : 0) : (part == 0 ? O_GU : ((part & 1) ? L1GU : L1DN));
    auto gidx = [&](int x) -> int { if (part != 5) return base_ + x; const int L_ = lo + x; return L_ < L1GU ? O_GU + L1GU + L_ : O_DN + L1DN + (L_ - L1GU); };
    constexpr int NS = DEPTH + 1;
    f32x4 v[NS][8]; Item I[NS];
#pragma unroll
    for (int s = 0; s < DEPTH; ++s) { const int vp = gw + s * NGW; if (vp < NV) { decode(gidx(vp), I[s]); P0_LOAD(v[s], I[s]); } }
    for (int vv0 = gw; vv0 < NV; vv0 += NS * NGW) {
#pragma unroll
        for (int s = 0; s < NS; ++s) { const int vv = vv0 + s * NGW;
            if (vv < NV) {
                { const int vp = vv + DEPTH * NGW; constexpr int dummy = 0; (void)dummy; if (vp < NV) { decode(gidx(vp), I[(s + DEPTH) % NS]); P0_LOAD(v[(s + DEPTH) % NS], I[(s + DEPTH) % NS]); } }
#pragma unroll
                for (int i = 0; i < 8; ++i) { const int kk = 8 * i + lr; const f32x4 x = v[s][i] * 64.f;
                    scr[kk * 33 + c4] = x[0]; scr[kk * 33 + c4 + 1] = x[1]; scr[kk * 33 + c4 + 2] = x[2]; scr[kk * 33 + c4 + 3] = x[3]; }
                LDS_WAIT(); asm volatile("" ::: "memory");
                { const int cc = C.lane & 7;
#pragma unroll
                  for (int j = 0; j < 4; ++j) { const int n = lr + 8 * j; const LAS float* sp = scr + (8 * cc) * 33 + n;
                      u32x2v o; o.x = pg8::pk4_fp8(sp[0 * 33], sp[1 * 33], sp[2 * 33], sp[3 * 33]); o.y = pg8::pk4_fp8(sp[4 * 33], sp[5 * 33], sp[6 * 33], sp[7 * 33]);
                      *(u32x2v*)(I[s].WT + (size_t)(I[s].row_off + I[s].n0 + j * I[s].rs + lr) * D + I[s].k0 + 8 * cc) = o; } }
                LDS_WAIT(); asm volatile("" ::: "memory");
            } }
    }
#undef P0_LOAD
    __syncthreads();
}
template <int TR> __device__ __forceinline__ void tail_convert(const Ctx& C, const Args& a, int n_tiles) {
#if CONV_TAIL
    if (C.G != 256) return;
    const int c = (int)blockIdx.x, j = c >> 3, first = (c & 7) * TR + (j % TR);
    const int mine = first < n_tiles ? (n_tiles - first + 8 * TR - 1) / (8 * TR) : 0, most = (n_tiles + 8 * TR - 1) / (8 * TR);
    if (mine >= most) return;
    LAS int* slot = (LAS int*)(C.lds + BLK_OFF) + 2300;
    __syncthreads();
    if (C.tid == 0) slot[0] = (int)__hip_atomic_fetch_add((unsigned*)(C.ws + WS_CTL) + CW_CONV, 1u, __ATOMIC_RELAXED, __HIP_MEMORY_SCOPE_AGENT);
    __syncthreads();
    const int lo = slot[0] * CONV_TAIL, hi = lo + CONV_TAIL < 49152 ? lo + CONV_TAIL : 49152;
    if (lo < 49152) convert_weights<3>(C, a, 5, 0, 1, lo, hi);
#endif
}
__device__ __forceinline__ void p0_prologue(const Ctx& C, const Args& a) {
    const int NGV = (P0_SPLIT && C.G >= 128) ? 32 : 0;
    if (C.vcu >= NGV) { const int ci = C.vcu - NGV, cn = C.G - NGV;
    convert_weights<1>(C, a, 0, ci, cn);
#if !CONV_X0
    convert_weights<1>(C, a, 1, ci, cn); convert_weights<1>(C, a, 2, ci, cn);
#elif !CONV_X0_BOTH
    convert_weights<1>(C, a, 2, ci, cn);
#endif
#if !CONV_X1
    convert_weights<1>(C, a, 3, ci, cn); convert_weights<1>(C, a, 4, ci, cn);
#endif
    }
    if (NGV == 0 || C.vcu < NGV) {
    LAS float* cs = (LAS float*)(C.lds + RING_OFF);
    LAS float* red = (LAS float*)(C.lds + RING_OFF + 32768);
    for (int i = C.tid; i < 8192; i += 512) { const float v = a.in[IN_C][i]; cs[i] = v / (1.f + __expf(-v)); }
    __syncthreads();
    float* ADA = (float*)(C.ws + SM_ADA);
    for (int rep_a = 0; rep_a < 1 + PROBE_ADA; ++rep_a)
    for (int grp = C.vcu; grp < 192; grp += (NGV ? NGV : C.G)) {
        const int l = grp / 96, col = (grp % 96) * 64 + C.lane;
        const float* w = a.in[IN_ADAW] + (size_t)l * D * 6144 + col;
        float acc[8];
#pragma unroll
        for (int b = 0; b < 8; ++b) acc[b] = 0.f;
        const int kbeg = C.wave * 128;
#if GEMV_PIPE
        float wc8[8], wn8[8];
#pragma unroll
        for (int j = 0; j < 8; ++j) wc8[j] = w[(size_t)(kbeg + j) * 6144];
        for (int k = kbeg; k < kbeg + 128; k += 8) {
            if (k + 8 < kbeg + 128) {
#pragma unroll
                for (int j = 0; j < 8; ++j) wn8[j] = w[(size_t)(k + 8 + j) * 6144]; }
#pragma unroll
            for (int b = 0; b < 8; ++b) { const f32x4 c0 = *(const LAS f32x4*)(cs + b * 1024 + k), c1 = *(const LAS f32x4*)(cs + b * 1024 + k + 4);
                acc[b] += (c0[0] * wc8[0] + c0[1] * wc8[1] + c0[2] * wc8[2] + c0[3] * wc8[3]) + (c1[0] * wc8[4] + c1[1] * wc8[5] + c1[2] * wc8[6] + c1[3] * wc8[7]); }
#pragma unroll
            for (int j = 0; j < 8; ++j) wc8[j] = wn8[j];
        }
#else
#pragma unroll 4
        for (int k = kbeg; k < kbeg + 128; k += 4) {
            float wv[4];
#pragma unroll
            for (int j = 0; j < 4; ++j) wv[j] = w[(size_t)(k + j) * 6144];
#pragma unroll
            for (int b = 0; b < 8; ++b) { const f32x4 cv = *(const LAS f32x4*)(cs + b * 1024 + k); acc[b] += cv[0] * wv[0] + cv[1] * wv[1] + cv[2] * wv[2] + cv[3] * wv[3]; }
        }
#endif
#pragma unroll
        for (int b = 0; b < 8; ++b) red[(C.wave * 8 + b) * 64 + C.lane] = acc[b];
        __syncthreads();
        { const int b = C.wave; float s = 0.f;
#pragma unroll
          for (int w8 = 0; w8 < 8; ++w8) s += red[(w8 * 8 + b) * 64 + C.lane];
          ADA[(size_t)(l * 8 + b) * 6144 + col] = s + a.in[IN_ADAB][l * 6144 + col]; }
        __syncthreads();
    }
    }
    if (C.vcu == C.G - 1) {
        float* BT = (float*)(C.ws + SM_BIAST);
        for (int i = C.tid; i < 48 * 129; i += 512) { const int gh = i / 129, dl = i % 129, g = gh >> 4, n = dl << (2 * g);
            int bk = n;
            if (n >= 16) { const float nf = (float)n; bk = 16 + (int)(logf(nf / 16.f) / 4.852030263919617f * 16.f); bk = bk > 31 ? 31 : bk; }
            BT[gh * 132 + dl] = a.in[IN_RELB][bk * 48 + gh] * LOG2E; }
    }
}

__device__ __forceinline__ void p1_rows0(const Ctx& C, const Args& a) {
    const float* ADA = (const float*)(C.ws + SM_ADA);
    float* GM = (float*)(C.ws + SM_GM); float* CSH = (float*)(C.ws + SM_CSH);
    const int gt = C.vcu * 512 + C.tid, NGT = C.G * 512;
    for (int i = gt; i < 2 * 2 * 8 * 1024; i += NGT) { const int d = i & 1023, b = (i >> 10) & 7, kind = (i >> 13) & 1, l = i >> 14;
        const float g = kind ? a.in[IN_NFFN][l * D + d] : a.in[IN_NMIX][l * D + d];
        GM[i] = g * (1.f + ADA[(size_t)(l * 8 + b) * 6144 + (kind ? 4 : 1) * 1024 + d]); }
    const int gw = C.vcu * NWAVES + C.wave, NGW = C.G * NWAVES;
    for (int o = gw; o < 512; o += NGW) { const int e = o & 31, b = (o >> 5) & 7, l = o >> 8; float s = 0.f;
        for (int d = C.lane; d < D; d += 64) s += ADA[(size_t)(l * 8 + b) * 6144 + 3 * 1024 + d] * a.in[IN_RW][(size_t)l * D * 32 + d * 32 + e];
        s = wave_sum(s); if (C.lane == 0) CSH[o] = s + a.in[IN_RB][l * 32 + e]; }
    bf16* H = (bf16*)(C.ws + WS_H);
#if P1_PREFETCH && QKV_FP8
    {
        const f32x4* gr = (const f32x4*)(a.in[IN_NMIX]) + C.lane;
        f32x4 vc[4], vn[4], scc[4], shc[4], scn[4], shn[4], grr[4];
#define P1_LOAD(V, SC, SH, MM) do { const f32x4* xr_ = (const f32x4*)(a.in[IN_X] + (size_t)(MM) * D) + C.lane; const int b_ = (MM) >> 12; \
        const f32x4* sc_ = (const f32x4*)(ADA + (size_t)b_ * 6144 + 1024) + C.lane; const f32x4* sh_ = (const f32x4*)(ADA + (size_t)b_ * 6144) + C.lane; \
        _Pragma("unroll") for (int j = 0; j < 4; ++j) { V[j] = __builtin_nontemporal_load(xr_ + 64 * j); SC[j] = sc_[64 * j]; SH[j] = sh_[64 * j]; } } while (0)
#pragma unroll
        for (int j = 0; j < 4; ++j) grr[j] = gr[64 * j];
        if (gw < T) P1_LOAD(vc, scc, shc, gw);
        for (int m = gw; m < T; m += NGW) {
            const int mn = m + NGW;
            { const int mn_c = (ROW_UNCOND && !(mn < T)) ? m : mn; if (ROW_UNCOND || mn < T) P1_LOAD(vn, scn, shn, mn_c); }
            float s = 0.f;
#pragma unroll
            for (int j = 0; j < 4; ++j) s += (vc[j].x * vc[j].x + vc[j].y * vc[j].y) + (vc[j].z * vc[j].z + vc[j].w * vc[j].w);
            const float rstd = 1.f / sqrtf(wave_sum(s) * (1.f / D) + RMS_EPS);
            unsigned* o4 = (unsigned*)(C.ws + WS_H8 + (size_t)m * D) + C.lane;
#pragma unroll
            for (int j = 0; j < 4; ++j) { const f32x4 h = vc[j] * rstd * grr[j] * (scc[j] + 1.f) + shc[j]; o4[64 * j] = pg8::pk4_fp8(h.x, h.y, h.z, h.w); }
#pragma unroll
            for (int j = 0; j < 4; ++j) { vc[j] = vn[j]; scc[j] = scn[j]; shc[j] = shn[j]; }
        }
#undef P1_LOAD
    }
}
#else
    for (int m = gw; m < T; m += NGW) {
        const int b = m >> 12;
        const f32x4* xr = (const f32x4*)(a.in[IN_X] + (size_t)m * D) + C.lane;
        const f32x4* gr = (const f32x4*)(a.in[IN_NMIX]) + C.lane;
        const f32x4* sc = (const f32x4*)(ADA + (size_t)b * 6144 + 1024) + C.lane;
        const f32x4* sh = (const f32x4*)(ADA + (size_t)b * 6144) + C.lane;
        f32x4 v[4]; float s = 0.f;
#pragma unroll
        for (int j = 0; j < 4; ++j) { v[j] = NT_ROWS ? __builtin_nontemporal_load(xr + 64 * j) : xr[64 * j]; s += (v[j].x * v[j].x + v[j].y * v[j].y) + (v[j].z * v[j].z + v[j].w * v[j].w); }
        const float rstd = 1.f / sqrtf(wave_sum(s) * (1.f / D) + RMS_EPS);
        unsigned long long* o8 = (unsigned long long*)(H + (size_t)m * D) + C.lane; unsigned* o4 = (unsigned*)(C.ws + WS_H8 + (size_t)m * D) + C.lane;
#pragma unroll
        for (int j = 0; j < 4; ++j) { const f32x4 h = v[j] * rstd * gr[64 * j] * (sc[64 * j] + 1.f) + sh[64 * j];
            if (QKV_FP8) o4[64 * j] = pg8::pk4_fp8(h.x, h.y, h.z, h.w);
            else o8[64 * j] = (unsigned long long)pkbf(h.x, h.y) | ((unsigned long long)pkbf(h.z, h.w) << 32); }
    }
}
#endif

__device__ __forceinline__ void p3_dilated(const Ctx& C) {
#if BAND_FP8
    attn_body::band8_phase<0>((const unsigned char*)(C.ws + WS_QKV0), (attn_body::bf16*)(C.ws + WS_OG), (float*)(C.ws + SM_LSE), (const float*)(C.ws + SM_BIAST), C.vcu, C.G, 384 * 16, (char*)C.lds + RING_OFF);
    return;
#endif
#if PROBE_BAND
    attn_body::band_phase<PROBE_BAND - 1>((const attn_body::bf16*)(C.ws + WS_QKV0), (attn_body::bf16*)(C.ws + WS_XB), (float*)(C.ws + WS_XB + 200 * MiB), (const float*)(C.ws + SM_BIAST), C.vcu, C.G, 384 * 16, (char*)C.lds + RING_OFF);
#endif
    attn_body::band_phase<0>((const attn_body::bf16*)(C.ws + WS_QKV0), (attn_body::bf16*)(C.ws + WS_OG), (float*)(C.ws + SM_LSE), (const float*)(C.ws + SM_BIAST), C.vcu, C.G, 384 * 16, (char*)C.lds + RING_OFF);
}
template <int MODE, int VAR = 0> __device__ __forceinline__ void p12_fox(const Ctx& C, size_t o_off, const Args& a) {
#if CONV_X1
    if (VAR == 0) { const int nh = C.G >= 4 * CONV_X1 ? CONV_X1 : C.G;
      if ((int)blockIdx.x >= C.G - nh) { const int ci = (int)blockIdx.x - (C.G - nh);
#if CONV_TAIL
        { const unsigned done_ = __hip_atomic_load((unsigned*)(C.ws + WS_CTL) + CW_CONV, __ATOMIC_RELAXED, __HIP_MEMORY_SCOPE_AGENT);
          const int lo0 = (int)done_ * CONV_TAIL < 49152 ? (int)done_ * CONV_TAIL : 49152;
          convert_weights<CONV_DEPTH>(C, a, 5, ci, nh, lo0, 49152); }
#else
        convert_weights<CONV_DEPTH>(C, a, 3, ci, nh); convert_weights<CONV_DEPTH>(C, a, 4, ci, nh);
#endif
      } }
#endif
    const attn_body::bf16* QKV = (const attn_body::bf16*)(C.ws + WS_QKV1);
    attn_body::bf16* O = (attn_body::bf16*)(C.ws + o_off); const float* FC = (const float*)(C.ws + SM_FCUM);
    LAS float* Fl = (LAS float*)(C.lds + RING_OFF + attn_body::T_F);
    LAS int* qslot = (LAS int*)(C.lds + BLK_OFF);
    unsigned* qhead = (unsigned*)(C.ws + WS_CTL) + CW_QUEUE + (VAR ? 64 * VAR : 0); const unsigned* NRM = (const unsigned*)(C.ws + WS_CTL) + CW_NRM;
    int cur_bh = -1; float thr = 0.f; bool first_u = true;
    for (;;) {
        int l_; asm volatile("v_mbcnt_lo_u32_b32 %0, -1, 0\n\tv_mbcnt_hi_u32_b32 %0, -1, %0" : "=v"(l_)); const int t_ = C.wave * 64 + l_;
        __syncthreads();
        if (!(FOX_QPRE && MODE == 1) || first_u) {
            if (t_ == 0) qslot[0] = (int)__hip_atomic_fetch_add(qhead, 1u, __ATOMIC_RELAXED, __HIP_MEMORY_SCOPE_AGENT);
            __syncthreads(); first_u = false; }
        const int idx = ((volatile LAS int*)qslot)[0];
        if (idx >= 2048) break;
        const int qb = 15 - (idx >> 7), bh = idx & 127, b = bh >> 4, h = bh & 15, q0 = qb * 256;
        const attn_body::bf16* Qp = QKV + ((size_t)(b * 3 + 0) * 16 + h) * 4096 * 64;
        const attn_body::bf16* Kp = QKV + ((size_t)(b * 3 + 1) * 16 + h) * 4096 * 64;
        const attn_body::bf16* Vp = QKV + ((size_t)(b * 3 + 2) * 16 + h) * 4096 * 64;
#if FOX_FASTPRO
        int tlo = 0;
        {
            const float* Fg = FC + (size_t)bh * 4096; const int NTq = 4 * qb;
            const f32x4 fa = ((const f32x4*)Fg)[t_], fb = ((const f32x4*)Fg)[512 + t_];
            const float fq0 = Fg[q0], fe = (MODE == 1 && l_ < NTq) ? Fg[64 * l_ + 63] : 0.f;
            const float gq = __uint_as_float(NRM[((b * 2 + 0) * 16 + h) * 2]) + __uint_as_float(NRM[((b * 2 + 0) * 16 + h) * 2 + 1]);
            const float gk = __uint_as_float(NRM[((b * 2 + 1) * 16 + h) * 2]) + __uint_as_float(NRM[((b * 2 + 1) * 16 + h) * 2 + 1]);
            thr = 2.f * (sqrtf(gq) * sqrtf(gk) * 1.001f + 1e-3f) + 152.f;
            if (MODE == 1) { const bool dead = (l_ < NTq) && (fq0 - fe <= -thr); tlo = __popcll(__ballot(dead)) & ~1; if (VAR == 8) tlo = NTq; }
            LAS f32x4* dst = (LAS f32x4*)Fl; dst[t_] = fa; dst[512 + t_] = fb; cur_bh = bh;
        }
#else
        if (bh != cur_bh) {
            { const f32x4* src = (const f32x4*)(FC + (size_t)bh * 4096); LAS f32x4* dst = (LAS f32x4*)Fl; dst[t_] = src[t_]; dst[512 + t_] = src[512 + t_]; }
            const float gq = __uint_as_float(NRM[((b * 2 + 0) * 16 + h) * 2]) + __uint_as_float(NRM[((b * 2 + 0) * 16 + h) * 2 + 1]);
            const float gk = __uint_as_float(NRM[((b * 2 + 1) * 16 + h) * 2]) + __uint_as_float(NRM[((b * 2 + 1) * 16 + h) * 2 + 1]);
            thr = 2.f * (sqrtf(gq) * sqrtf(gk) * 1.001f + 1e-3f) + 152.f;
            cur_bh = bh;
            __syncthreads();
        }
        int tlo = 0;
        if (MODE == 1) {
            const int NTq = 4 * qb;
            const bool dead = (l_ < NTq) && (Fl[q0] - Fl[64 * l_ + 63] <= -thr);
            tlo = __popcll(__ballot(dead)) & ~1;
            if (VAR == 8) tlo = NTq;
        }
#endif
        attn_body::attn_unit_t<MODE, 64, VAR>(Qp + (size_t)q0 * 64, Kp + (size_t)tlo * 4096, Vp + (size_t)tlo * 4096, 4 * qb + 4 - tlo, 64 * tlo, (WO_FP8 && MODE == 1) ? (attn_body::bf16*)((unsigned char*)O + ((size_t)b * 4096 + q0) * D + h * 64) : O + ((size_t)b * 4096 + q0) * D + h * 64, (long)D, nullptr, 0, (char*)C.lds + RING_OFF, qhead, (volatile LAS int*)qslot);
    }
}
__device__ __forceinline__ void p4_merge(const Ctx& C) {
    const bf16* OG = (const bf16*)(C.ws + WS_OG); const float* LSE = (const float*)(C.ws + SM_LSE); bf16* O = (bf16*)(C.ws + WS_O);
    const int gt = C.vcu * 512 + C.tid, NGT = C.G * 512;
#if MERGE_BATCH && OG_FP8 && BAND_FP8 && WO_FP8
    if ((T * 128) % (4 * NGT) == 0) {
        const unsigned char* OG8 = (const unsigned char*)OG;
        for (int i0 = gt; i0 < T * 128; i0 += 4 * NGT) {
            float l[4][3]; u32x2v a[4][3];
#pragma unroll
            for (int q = 0; q < 4; ++q) { const int i = i0 + q * NGT, tok = i >> 7, c8 = i & 127, hd = c8 >> 3;
#pragma unroll
                for (int g = 0; g < 3; ++g) { l[q][g] = LSE[((size_t)g * T + tok) * 16 + hd]; a[q][g] = __builtin_nontemporal_load((const u32x2v*)(OG8 + ((size_t)g * T + tok) * D + c8 * 8)); } }
#pragma unroll
            for (int q = 0; q < 4; ++q) { const int i = i0 + q * NGT, tok = i >> 7, c8 = i & 127;
                const float mx = fmaxf(l[q][0], fmaxf(l[q][1], l[q][2])); float w0 = __builtin_amdgcn_exp2f(l[q][0] - mx), w1 = __builtin_amdgcn_exp2f(l[q][1] - mx), w2 = __builtin_amdgcn_exp2f(l[q][2] - mx);
                const float inv = 0.125f / (w0 + w1 + w2); w0 *= inv; w1 *= inv; w2 *= inv;
                unsigned o[4];
#pragma unroll
                for (int wd = 0; wd < 2; ++wd) {
                    { const auto f0 = __builtin_amdgcn_cvt_pk_f32_fp8((int)a[q][0][wd], false), f1 = __builtin_amdgcn_cvt_pk_f32_fp8((int)a[q][1][wd], false), f2 = __builtin_amdgcn_cvt_pk_f32_fp8((int)a[q][2][wd], false);
                      o[2 * wd] = pkbf(w0 * f0[0] + w1 * f1[0] + w2 * f2[0], w0 * f0[1] + w1 * f1[1] + w2 * f2[1]); }
                    { const auto f0 = __builtin_amdgcn_cvt_pk_f32_fp8((int)a[q][0][wd], true), f1 = __builtin_amdgcn_cvt_pk_f32_fp8((int)a[q][1][wd], true), f2 = __builtin_amdgcn_cvt_pk_f32_fp8((int)a[q][2][wd], true);
                      o[2 * wd + 1] = pkbf(w0 * f0[0] + w1 * f1[0] + w2 * f2[0], w0 * f0[1] + w1 * f1[1] + w2 * f2[1]); } }
                u32x2v o8; o8.x = pg8::pk4_fp8(bf2f(o[0] & 0xffffu), bf2f(o[0] >> 16), bf2f(o[1] & 0xffffu), bf2f(o[1] >> 16)); o8.y = pg8::pk4_fp8(bf2f(o[2] & 0xffffu), bf2f(o[2] >> 16), bf2f(o[3] & 0xffffu), bf2f(o[3] >> 16));
                *(u32x2v*)((unsigned char*)O + (size_t)tok * D + c8 * 8) = o8; }
        }
        return;
    }
#endif
#pragma unroll 4
    for (int i = gt; i < T * 128; i += NGT) { const int tok = i >> 7, c8 = i & 127, hd = c8 >> 3;
        const float l0 = LSE[(size_t)tok * 16 + hd], l1 = LSE[((size_t)T + tok) * 16 + hd], l2 = LSE[((size_t)2 * T + tok) * 16 + hd];
        const float mx = fmaxf(l0, fmaxf(l1, l2)); float w0 = __builtin_amdgcn_exp2f(l0 - mx), w1 = __builtin_amdgcn_exp2f(l1 - mx), w2 = __builtin_amdgcn_exp2f(l2 - mx);
        const float inv = 1.f / (w0 + w1 + w2); w0 *= inv; w1 *= inv; w2 *= inv;
#if OG_FP8 && BAND_FP8
        const unsigned char* OG8 = (const unsigned char*)OG;
        const u32x2v a0 = __builtin_nontemporal_load((const u32x2v*)(OG8 + (size_t)tok * D + c8 * 8)), a1 = __builtin_nontemporal_load((const u32x2v*)(OG8 + ((size_t)T + tok) * D + c8 * 8)), a2 = __builtin_nontemporal_load((const u32x2v*)(OG8 + ((size_t)2 * T + tok) * D + c8 * 8));
        w0 *= 0.125f; w1 *= 0.125f; w2 *= 0.125f;
        u32x4v o;
#pragma unroll
        for (int wd = 0; wd < 2; ++wd) {
            { const auto f0 = __builtin_amdgcn_cvt_pk_f32_fp8((int)a0[wd], false), f1 = __builtin_amdgcn_cvt_pk_f32_fp8((int)a1[wd], false), f2 = __builtin_amdgcn_cvt_pk_f32_fp8((int)a2[wd], false);
              o[2 * wd] = pkbf(w0 * f0[0] + w1 * f1[0] + w2 * f2[0], w0 * f0[1] + w1 * f1[1] + w2 * f2[1]); }
            { const auto f0 = __builtin_amdgcn_cvt_pk_f32_fp8((int)a0[wd], true), f1 = __builtin_amdgcn_cvt_pk_f32_fp8((int)a1[wd], true), f2 = __builtin_amdgcn_cvt_pk_f32_fp8((int)a2[wd], true);
              o[2 * wd + 1] = pkbf(w0 * f0[0] + w1 * f1[0] + w2 * f2[0], w0 * f0[1] + w1 * f1[1] + w2 * f2[1]); } }
#else
        const u32x4v a0 = NT_ROWS ? __builtin_nontemporal_load((const u32x4v*)(OG + (size_t)tok * D + c8 * 8)) : *(const u32x4v*)(OG + (size_t)tok * D + c8 * 8), a1 = NT_ROWS ? __builtin_nontemporal_load((const u32x4v*)(OG + ((size_t)T + tok) * D + c8 * 8)) : *(const u32x4v*)(OG + ((size_t)T + tok) * D + c8 * 8), a2 = NT_ROWS ? __builtin_nontemporal_load((const u32x4v*)(OG + ((size_t)2 * T + tok) * D + c8 * 8)) : *(const u32x4v*)(OG + ((size_t)2 * T + tok) * D + c8 * 8);
        u32x4v o;
#pragma unroll
        for (int k = 0; k < 4; ++k) { const float lo = w0 * bf2f(a0[k] & 0xffffu) + w1 * bf2f(a1[k] & 0xffffu) + w2 * bf2f(a2[k] & 0xffffu);
            float hi = w0 * bf2f(a0[k] >> 16) + w1 * bf2f(a1[k] >> 16) + w2 * bf2f(a2[k] >> 16); float lo2 = lo;
#if PROBE_SANITIZE
            if (!(fabsf(lo2) < 1e30f)) lo2 = 0.f; if (!(fabsf(hi) < 1e30f)) hi = 0.f;
#endif
            o[k] = pkbf(lo2, hi); }
#endif
        if (WO_FP8) { u32x2v o8; o8.x = pg8::pk4_fp8(bf2f(o[0] & 0xffffu), bf2f(o[0] >> 16), bf2f(o[1] & 0xffffu), bf2f(o[1] >> 16)); o8.y = pg8::pk4_fp8(bf2f(o[2] & 0xffffu), bf2f(o[2] >> 16), bf2f(o[3] & 0xffffu), bf2f(o[3] >> 16));
            *(u32x2v*)((unsigned char*)O + (size_t)tok * D + c8 * 8) = o8; }
        else *(u32x4v*)(O + (size_t)tok * D + c8 * 8) = o; }
}

__device__ __forceinline__ f32x4 bf4_to_f32(u32x2v v) { return (f32x4){bf2f(v.x & 0xffffu), bf2f(v.x >> 16), bf2f(v.y & 0xffffu), bf2f(v.y >> 16)}; }
typedef u32x2v xs4_t;
__device__ __forceinline__ f32x4 xs4_to_f32(xs4_t v) { return bf4_to_f32(v); }
__device__ __forceinline__ xs4_t f32_to_xs4(f32x4 v) { xs4_t r; r.x = pkbf(v.x, v.y); r.y = pkbf(v.z, v.w); return r; }
#if Y_FP8
typedef unsigned yraw4_t;
__device__ __forceinline__ f32x4 y4_to_f32(yraw4_t v) { const auto lo = __builtin_amdgcn_cvt_pk_f32_fp8((int)v, false), hi = __builtin_amdgcn_cvt_pk_f32_fp8((int)v, true); return (f32x4){lo[0], lo[1], hi[0], hi[1]}; }
#define Y_ROWPTR(Yb, slot) ((const yraw4_t*)((const unsigned char*)(Yb) + (size_t)(slot) * D) + C.lane)
#else
typedef u32x2v yraw4_t;
__device__ __forceinline__ f32x4 y4_to_f32(yraw4_t v) { return bf4_to_f32(v); }
#define Y_ROWPTR(Yb, slot) ((const yraw4_t*)((Yb) + (size_t)(slot) * D) + C.lane)
#endif

__device__ __forceinline__ void r1_router(const Ctx& C, const Args& a, int l) {
    LAS float* scrf = (LAS float*)(C.lds + SCR_OFF + C.wave * 2048);
    LAS int* scri = (LAS int*)scrf;
    LAS int* blk = (LAS int*)(C.lds + BLK_OFF);
    const float* rw = a.in[IN_RW] + (size_t)l * D * 32;
    LAS unsigned short* wh = (LAS unsigned short*)(C.lds + RING_OFF); LAS unsigned short* wlo = (LAS unsigned short*)(C.lds + RING_OFF + 65536);
    int tab_b = -1;
    const bf16* XS = (const bf16*)(C.ws + WS_XS); unsigned char* H8 = (unsigned char*)(C.ws + WS_H8);
    const float* ADA = (const float*)(C.ws + SM_ADA) + (size_t)l * 8 * 6144;
    const float* GM = (const float*)(C.ws + SM_GM) + (size_t)(l * 2 + 1) * 8 * 1024;
    const float* CSH = (const float*)(C.ws + SM_CSH) + l * 256;
    int* TOPI = (int*)(C.ws + SM_TOPI); float* TOPG = (float*)(C.ws + SM_TOPG); int* RANK = (int*)(C.ws + SM_RANK); int* BLKCNT = (int*)(C.ws + SM_BLKCNT);
    const int tk = C.lane & 15, q = C.lane >> 4;
    for (int vb = C.vcu; vb < NVB; vb += C.G) {
        const int tok0 = vb * 128 + C.wave * 16, b = tok0 >> 12, tok = tok0 + tk;
        if (b != tab_b) {
            __syncthreads();
            const float* gmb = GM + b * 1024;
#if ROUTER_IMGV
#pragma unroll 1
            for (int it0 = 0; it0 < 16; it0 += 4) { f32x4 wv4[4]; float gv_[4];
#pragma unroll
              for (int it = 0; it < 4; ++it) { const int i4 = (it0 + it) * 512 + C.tid; wv4[it] = ((const f32x4*)rw)[i4]; gv_[it] = gmb[i4 >> 3]; }
#pragma unroll
              for (int it = 0; it < 4; ++it) { const int i4 = (it0 + it) * 512 + C.tid, dd = i4 >> 3, e0 = (i4 & 7) * 4;
#pragma unroll
                  for (int c = 0; c < 4; ++c) { const float w = wv4[it][c] * gv_[it];
                      const unsigned hb = pkbf(w, 0.f) & 0xffffu; const float hf = bf2f(hb); const unsigned lb = pkbf(w - hf, 0.f) & 0xffffu;
                      const int pos = ((((dd >> 5) * 4 + ((dd >> 3) & 3)) * 32 + e0 + c) << 3) + (dd & 7);
                      wh[pos] = (unsigned short)hb; wlo[pos] = (unsigned short)lb; } } }
#else
            for (int i = C.tid; i < D * 32; i += 512) { const int dd = i >> 5, e = i & 31; const float w = rw[i] * gmb[dd];
                const unsigned hb = pkbf(w, 0.f) & 0xffffu; const float hf = bf2f(hb); const unsigned lb = pkbf(w - hf, 0.f) & 0xffffu;
                const int pos = ((((dd >> 5) * 4 + ((dd >> 3) & 3)) * 32 + e) << 3) + (dd & 7);
                wh[pos] = (unsigned short)hb; wlo[pos] = (unsigned short)lb; }
#endif
            __syncthreads();
            tab_b = b;
        }
        const bf16* xrow = XS + (size_t)tok * D + 8 * q;
        f32x4 acc0 = {0.f, 0.f, 0.f, 0.f}, acc1 = {0.f, 0.f, 0.f, 0.f}; float ssq = 0.f;
        typedef short bf16x8r __attribute__((ext_vector_type(8)));
#if ROUTER_PREFETCH
        u32x4v xall[32];
#pragma unroll
        for (int kk = 0; kk < 32; ++kk) xall[kk] = *(const u32x4v*)(xrow + 32 * kk);
#pragma unroll
#else
#pragma unroll 4
#endif
        for (int kk = 0; kk < 32; ++kk) {
#if ROUTER_PREFETCH
            const u32x4v xr8 = xall[kk];
#else
            const u32x4v xr8 = *(const u32x4v*)(xrow + 32 * kk);
#endif
#pragma unroll
            for (int e2 = 0; e2 < 4; ++e2) { const float x0 = bf2f(xr8[e2] & 0xffffu), x1 = bf2f(xr8[e2] >> 16); ssq += x0 * x0 + x1 * x1; }
            const bf16x8r xb = __builtin_bit_cast(bf16x8r, xr8);
            const int fo = ((kk * 4 + q) * 32 + tk) << 3;
            const bf16x8r h0 = *(const LAS bf16x8r*)(wh + fo), h1 = *(const LAS bf16x8r*)(wh + fo + 128), l0 = *(const LAS bf16x8r*)(wlo + fo), l1 = *(const LAS bf16x8r*)(wlo + fo + 128);
            acc0 = __builtin_amdgcn_mfma_f32_16x16x32_bf16(h0, xb, acc0, 0, 0, 0); acc1 = __builtin_amdgcn_mfma_f32_16x16x32_bf16(h1, xb, acc1, 0, 0, 0);
            acc0 = __builtin_amdgcn_mfma_f32_16x16x32_bf16(l0, xb, acc0, 0, 0, 0); acc1 = __builtin_amdgcn_mfma_f32_16x16x32_bf16(l1, xb, acc1, 0, 0, 0);
        }
        ssq += __shfl_xor(ssq, 16); ssq += __shfl_xor(ssq, 32);
        const float rstd = 1.f / sqrtf(ssq * (1.f / D) + RMS_EPS);
        { const f32x4 c0 = *(const f32x4*)(CSH + b * 32 + 4 * q), c1 = *(const f32x4*)(CSH + b * 32 + 16 + 4 * q);
          *(LAS f32x4*)(scrf + tk * 32 + 4 * q) = acc0 * rstd + c0; *(LAS f32x4*)(scrf + tk * 32 + 16 + 4 * q) = acc1 * rstd + c1; }
        LDS_WAIT();
        int myidx[4] = {0, 0, 0, 0};
        if (C.lane < 16) {
            float v[32];
#pragma unroll
            for (int j = 0; j < 8; ++j) { const f32x4 t4 = *(const LAS f32x4*)(scrf + C.lane * 32 + 4 * j); v[4 * j] = t4.x; v[4 * j + 1] = t4.y; v[4 * j + 2] = t4.z; v[4 * j + 3] = t4.w; }
            float val[4];
#pragma unroll
            for (int k = 0; k < 4; ++k) { float best = v[0]; int bi = 0;
#pragma unroll
                for (int e = 1; e < 32; ++e) { if (v[e] > best) { best = v[e]; bi = e; } }
                val[k] = best; myidx[k] = bi;
#pragma unroll
                for (int e = 0; e < 32; ++e) v[e] = (e == bi) ? -INFINITY : v[e]; }
            const float e1 = __expf(val[1] - val[0]), e2 = __expf(val[2] - val[0]), e3 = __expf(val[3] - val[0]), inv = 1.f / (1.f + e1 + e2 + e3);
            *(i32x4v*)(TOPI + (size_t)(tok0 + C.lane) * 4) = (i32x4v){myidx[0], myidx[1], myidx[2], myidx[3]};
            *(f32x4*)(TOPG + (size_t)(tok0 + C.lane) * 4) = (f32x4){inv, e1 * inv, e2 * inv, e3 * inv};
        }
        LDS_WAIT();
        if (C.lane < 16) *(LAS i32x4v*)(scri + C.lane * 4) = (i32x4v){myidx[0], myidx[1], myidx[2], myidx[3]};
        LDS_WAIT();
        const int e = scri[C.lane];
        const unsigned long long lt = (1ull << C.lane) - 1ull;
        int rank = 0, mycnt = 0;
#pragma unroll 4
        for (int j = 0; j < 32; ++j) { const unsigned long long mk = __ballot(e == j); if (e == j) rank = __popcll(mk & lt); if (C.lane == j) mycnt = __popcll(mk); }
        if (C.lane < 32) blk[BL_WCNT + C.wave * 32 + C.lane] = mycnt;
        __syncthreads();
        if (C.lane < 32) { int wb = 0;
            for (int w8 = 0; w8 < C.wave; ++w8) wb += blk[BL_WCNT + w8 * 32 + C.lane];
            blk[BL_WBASE + C.wave * 32 + C.lane] = wb;
            if (C.wave == NWAVES - 1) BLKCNT[vb * 32 + C.lane] = wb + mycnt; }
        LDS_WAIT();
        RANK[(size_t)tok0 * 4 + C.lane] = blk[BL_WBASE + C.wave * 32 + e] + rank;
        const f32x4* shf = (const f32x4*)(ADA + (size_t)b * 6144 + 3 * 1024) + C.lane; const f32x4* gm4 = (const f32x4*)(GM + b * 1024) + C.lane;
#if ROUTER_BATCH
        { f32x4 gmr[4], shr[4];
#pragma unroll
          for (int j = 0; j < 4; ++j) { gmr[j] = gm4[64 * j]; shr[j] = shf[64 * j]; }
          for (int tt0 = 0; tt0 < 16; tt0 += 4) {
              xs4_t xq[4][4];
#pragma unroll
              for (int q4 = 0; q4 < 4; ++q4) { const xs4_t* xr = (const xs4_t*)(XS + (size_t)(tok0 + tt0 + q4) * D) + C.lane;
#pragma unroll
                  for (int j = 0; j < 4; ++j) xq[q4][j] = xr[64 * j]; }
#pragma unroll
              for (int q4 = 0; q4 < 4; ++q4) { const float rs = __shfl(rstd, tt0 + q4); unsigned* o4 = (unsigned*)(H8 + (size_t)(tok0 + tt0 + q4) * D) + C.lane;
#pragma unroll
                  for (int j = 0; j < 4; ++j) { const f32x4 h = xs4_to_f32(xq[q4][j]) * rs * gmr[j] + shr[j]; o4[64 * j] = pg8::pk4_fp8(h.x, h.y, h.z, h.w); } } } }
#else
#pragma unroll 2
        for (int tt = 0; tt < 16; ++tt) { const float rs = __shfl(rstd, tt); const int tkn = tok0 + tt;
            const xs4_t* xr = (const xs4_t*)(XS + (size_t)tkn * D) + C.lane; unsigned* o4 = (unsigned*)(H8 + (size_t)tkn * D) + C.lane;
#pragma unroll
            for (int j = 0; j < 4; ++j) { const f32x4 h = xs4_to_f32(xr[64 * j]) * rs * gm4[64 * j] + shf[64 * j];
                o4[64 * j] = pg8::pk4_fp8(h.x, h.y, h.z, h.w); } }
#endif
        __syncthreads();
    }
}

__device__ __forceinline__ void p7_route(const Ctx& C) {
    LAS int* blk = (LAS int*)(C.lds + BLK_OFF);
    const int* BLKCNT = (const int*)(C.ws + SM_BLKCNT); const int* TOPI = (const int*)(C.ws + SM_TOPI); const int* RANK = (const int*)(C.ws + SM_RANK);
    int* SLOT = (int*)(C.ws + SM_SLOT); int* TILEEXP = (int*)(C.ws + SM_TILEEXP); int* TOKSLOT = (int*)(C.ws + SM_TOKSLOT);
    const unsigned char* H8 = (const unsigned char*)(C.ws + WS_H8); unsigned char* XB = (unsigned char*)(C.ws + WS_XB);
    const int e = C.tid & 31, part = C.tid >> 5;
    { int cv[16];
#pragma unroll
      for (int k = 0; k < 16; ++k) cv[k] = BLKCNT[(part * 16 + k) * 32 + e];
      int s = 0;
#pragma unroll
      for (int k = 0; k < 16; ++k) s += cv[k];
      blk[BL_PARTA + part * 32 + e] = s; }
    __syncthreads();
    if (C.tid < 32) { int tot = 0; for (int p = 0; p < 16; ++p) tot += blk[BL_PARTA + p * 32 + C.tid]; blk[BL_TOT + C.tid] = tot; }
    __syncthreads();
    if (C.tid == 0) { int run = 0; for (int k = 0; k < 32; ++k) { blk[BL_PADS + k] = run; run += (blk[BL_TOT + k] + 255) & ~255; } blk[BL_PADS + 32] = run; }
    __syncthreads();
    if (C.vcu == 0) {
        const int nt = blk[BL_PADS + 32] >> 8;
        if (C.tid == 0) TILEEXP[0] = nt;
        for (int i = C.tid; i < nt; i += 512) { int ex = 0; for (int k = 1; k < 32; ++k) ex += (blk[BL_PADS + k] <= i * 256) ? 1 : 0; TILEEXP[16 + i] = ex; }
        if (C.tid < 33) TILEEXP[640 + C.tid] = blk[BL_PADS + C.tid] >> 8;
    }
    for (int vb = C.vcu; vb < NVB; vb += C.G) {
        const int ex_pre = TOPI[vb * 512 + C.tid], rk_pre = RANK[vb * 512 + C.tid];
        __syncthreads();
        { int cv[16];
#pragma unroll
          for (int k = 0; k < 16; ++k) cv[k] = BLKCNT[(part * 16 + k) * 32 + e];
          int s = 0;
#pragma unroll
          for (int k = 0; k < 16; ++k) s += (part * 16 + k < vb) ? cv[k] : 0;
          blk[BL_PARTB + part * 32 + e] = s; }
        __syncthreads();
        if (C.tid < 32) { int bs = 0; for (int p = 0; p < 16; ++p) bs += blk[BL_PARTB + p * 32 + C.tid]; blk[BL_BASE + C.tid] = bs + blk[BL_PADS + C.tid]; }
        __syncthreads();
#if MOE_GATHER
        { const int i = vb * 512 + C.tid; const int sl_ = blk[BL_BASE + ex_pre] + rk_pre; SLOT[i] = sl_; TOKSLOT[sl_] = i >> 2; }
#else
        { const int i = vb * 512 + C.tid; const int ex = TOPI[i]; SLOT[i] = blk[BL_BASE + ex] + RANK[i]; }
        VM_WAIT(); __syncthreads();
        for (int tt = 0; tt < 16; ++tt) { const int tok = vb * 128 + C.wave * 16 + tt;
            const i32x4v sl = *(const i32x4v*)(SLOT + (size_t)tok * 4);
            const u32x4v v0 = *((const u32x4v*)(H8 + (size_t)tok * D) + C.lane);
#pragma unroll
            for (int k = 0; k < 4; ++k) { u32x4v* dst = (u32x4v*)(XB + (size_t)sl[k] * D); dst[C.lane] = v0; } }
#endif
    }
#if MOE_GATHER
    for (int ex = C.vcu; ex < 32; ex += C.G) { const int beg = blk[BL_PADS + ex] + blk[BL_TOT + ex], end = blk[BL_PADS + ex + 1];
        for (int s = beg + C.tid; s < end; s += 512) TOKSLOT[s] = 0; }
#endif
}
__device__ __forceinline__ int load_tile_table(const Ctx& C) {
    LAS int* blk = (LAS int*)(C.lds + BLK_OFF); const int* TILEEXP = (const int*)(C.ws + SM_TILEEXP);
    const int nt = TILEEXP[0];
    const int e0_ = TILEEXP[16 + C.tid], e1_ = (C.tid + 512 < MAXTILES) ? TILEEXP[16 + 512 + C.tid] : 0;
    __syncthreads();
    blk[BL_TILE + C.tid] = (C.tid < nt) ? e0_ : 0; if (C.tid + 512 < MAXTILES) blk[BL_TILE + 512 + C.tid] = (C.tid + 512 < nt) ? e1_ : 0;
    __syncthreads();
    return __builtin_amdgcn_readfirstlane(nt);
}


__device__ __forceinline__ void r2_seam(const Ctx& C, const Args& a) {
    LAS float* wl = (LAS float*)(C.lds + RING_OFF);
    { const float* wf = a.in[IN_WKVF]; const float* gkv0 = a.in[IN_KVNG];
      for (int i = C.tid; i < D * 16; i += 512) { const int d = i >> 4, h = i & 15, jj = d >> 8, ln = (d >> 2) & 63, c = d & 3;
          wl[((((jj * 4 + c) * 4 + (h >> 2)) * 64 + ln) << 2) + (h & 3)] = wf[(size_t)d * 2064 + 2048 + h] * gkv0[d]; } }
    __syncthreads();
    bf16* XS = (bf16*)(C.ws + WS_XS); bf16* HKV = (bf16*)(C.ws + WS_HKV); const bf16* Y = (const bf16*)(C.ws + WS_Y);
    const float* ADA0 = (const float*)(C.ws + SM_ADA); const float* ADA1 = ADA0 + (size_t)8 * 6144;
    const float* GM1 = (const float*)(C.ws + SM_GM) + (size_t)(1 * 2 + 0) * 8 * 1024;
    const int* SLOT = (const int*)(C.ws + SM_SLOT); const float* TOPG = (const float*)(C.ws + SM_TOPG); float* LOGF = (float*)(C.ws + SM_LOGF);
    const f32x4* gk4 = (const f32x4*)a.in[IN_KVNG] + C.lane;
    const int gw = C.vcu * NWAVES + C.wave, NGW = C.G * NWAVES;
    const float bfh = a.in[IN_BF][(C.lane >> 2) & 15];
    typedef yraw4_t yraw_t;
#define R2_LOADRAW(XR, Y0, Y1, Y2, Y3, MM, SS) do { const xs4_t* xr_ = (const xs4_t*)(XS + (size_t)(MM) * D) + C.lane; \
        const yraw4_t* z0_ = Y_ROWPTR(Y, (SS)[0]); const yraw4_t* z1_ = Y_ROWPTR(Y, (SS)[1]); \
        const yraw4_t* z2_ = Y_ROWPTR(Y, (SS)[2]); const yraw4_t* z3_ = Y_ROWPTR(Y, (SS)[3]); \
        _Pragma("unroll") for (int j = 0; j < 4; ++j) { if (NT_ROWS) { XR[j] = __builtin_nontemporal_load(xr_ + 64 * j); Y0[j] = __builtin_nontemporal_load(z0_ + 64 * j); Y1[j] = __builtin_nontemporal_load(z1_ + 64 * j); Y2[j] = __builtin_nontemporal_load(z2_ + 64 * j); Y3[j] = __builtin_nontemporal_load(z3_ + 64 * j); } else { XR[j] = xr_[64 * j]; Y0[j] = z0_[64 * j]; Y1[j] = z1_[64 * j]; Y2[j] = z2_[64 * j]; Y3[j] = z3_[64 * j]; } } } while (0)
    xs4_t xc[4], xn[4]; yraw_t y0c[4], y1c[4], y2c[4], y3c[4], y0n[4], y1n[4], y2n[4], y3n[4];
    i32x4v s_cur = *(const i32x4v*)(SLOT + (size_t)gw * 4); f32x4 g_cur = *(const f32x4*)(TOPG + (size_t)gw * 4);
    i32x4v s_nxt = s_cur; f32x4 g_nxt = g_cur;
    if (gw + NGW < T) { s_nxt = *(const i32x4v*)(SLOT + (size_t)(gw + NGW) * 4); g_nxt = *(const f32x4*)(TOPG + (size_t)(gw + NGW) * 4); }
    R2_LOADRAW(xc, y0c, y1c, y2c, y3c, gw, s_cur);
#if R2_VECPRE
    f32x4 gfc[4], gmc[4], shc[4], gfn[4], gmn[4], shn[4], gkr[4];
#define R2_LOADVEC(GF, GM, SH, MM) do { const int b_ = (MM) >> 12; const f32x4* gf_ = (const f32x4*)(ADA0 + (size_t)b_ * 6144 + 5 * 1024) + C.lane; \
        const f32x4* gm_ = (const f32x4*)(GM1 + b_ * 1024) + C.lane; const f32x4* sh_ = (const f32x4*)(ADA1 + (size_t)b_ * 6144) + C.lane; \
        _Pragma("unroll") for (int j = 0; j < 4; ++j) { GF[j] = gf_[64 * j]; GM[j] = gm_[64 * j]; SH[j] = sh_[64 * j]; } } while (0)
    R2_LOADVEC(gfc, gmc, shc, gw < T ? gw : 0);
#pragma unroll
    for (int j = 0; j < 4; ++j) { gkr[j] = gk4[64 * j]; gfn[j] = gfc[j]; gmn[j] = gmc[j]; shn[j] = shc[j]; }
#endif
    for (int m = gw; m < T; m += NGW) { const int b = m >> 12;
        const int mn = m + NGW, mnn = m + 2 * NGW;
        i32x4v s_nn = s_nxt; f32x4 g_nn = g_nxt;
#if ROW_UNCOND
        { const int mnn_c = mnn < T ? mnn : m, mn_c = mn < T ? mn : m;
          s_nn = *(const i32x4v*)(SLOT + (size_t)mnn_c * 4); g_nn = *(const f32x4*)(TOPG + (size_t)mnn_c * 4);
          R2_LOADRAW(xn, y0n, y1n, y2n, y3n, mn_c, s_nxt);
#if R2_VECPRE
          R2_LOADVEC(gfn, gmn, shn, mn_c);
#endif
        }
#else
        if (mnn < T) { s_nn = *(const i32x4v*)(SLOT + (size_t)mnn * 4); g_nn = *(const f32x4*)(TOPG + (size_t)mnn * 4); }
        if (mn < T) { R2_LOADRAW(xn, y0n, y1n, y2n, y3n, mn, s_nxt);
#if R2_VECPRE
            R2_LOADVEC(gfn, gmn, shn, mn);
#endif
        }
#endif
        const f32x4* gf4 = (const f32x4*)(ADA0 + (size_t)b * 6144 + 5 * 1024) + C.lane;
        const f32x4* gm4 = (const f32x4*)(GM1 + b * 1024) + C.lane; const f32x4* shm4 = (const f32x4*)(ADA1 + (size_t)b * 6144) + C.lane;
        xs4_t* xw = (xs4_t*)(XS + (size_t)m * D) + C.lane;
        f32x4 v[4]; float s = 0.f;
#pragma unroll
        for (int j = 0; j < 4; ++j) {
            const f32x4 ys = y4_to_f32(y0c[j]) * g_cur[0] + y4_to_f32(y1c[j]) * g_cur[1] + y4_to_f32(y2c[j]) * g_cur[2] + y4_to_f32(y3c[j]) * g_cur[3];
            v[j] = xs4_to_f32(xc[j]) + (R2_VECPRE ? gfc[j] : gf4[64 * j]) * ys; xw[64 * j] = f32_to_xs4(v[j]); v[j] = xs4_to_f32(f32_to_xs4(v[j]));
            s += (v[j].x * v[j].x + v[j].y * v[j].y) + (v[j].z * v[j].z + v[j].w * v[j].w); }
        const float rstd = 1.f / sqrtf(wave_sum(s) * (1.f / D) + RMS_EPS);
        float acc[16];
#pragma unroll
        for (int h = 0; h < 16; ++h) acc[h] = 0.f;
#pragma unroll
        for (int j = 0; j < 4; ++j)
#pragma unroll
            for (int c = 0; c < 4; ++c) { const float xv = v[j][c];
#pragma unroll
                for (int h4 = 0; h4 < 4; ++h4) { const f32x4 w = *(const LAS f32x4*)(wl + ((((j * 4 + c) * 4 + h4) * 64 + C.lane) << 2));
#if R2_PKFMA
                    const f32x4 xv4 = {xv, xv, xv, xv}; f32x4 a4 = {acc[4 * h4], acc[4 * h4 + 1], acc[4 * h4 + 2], acc[4 * h4 + 3]};
                    a4 = __builtin_elementwise_fma(w, xv4, a4);
                    acc[4 * h4] = a4[0]; acc[4 * h4 + 1] = a4[1]; acc[4 * h4 + 2] = a4[2]; acc[4 * h4 + 3] = a4[3]; }
#else
                    acc[4 * h4] += xv * w[0]; acc[4 * h4 + 1] += xv * w[1]; acc[4 * h4 + 2] += xv * w[2]; acc[4 * h4 + 3] += xv * w[3]; }
#endif
                if (c == 3) __builtin_amdgcn_sched_barrier(0); }
#pragma unroll
        for (int j = 0; j < 4; ++j) { const f32x4 n = v[j] * rstd, h = R2_VECPRE ? n * gmc[j] + shc[j] : n * gm4[64 * j] + shm4[64 * j], hk = R2_VECPRE ? n * gkr[j] : n * gk4[64 * j];
            if (KVQ_FP8) { ((unsigned*)(C.ws + WS_HKV + (size_t)T * D + (size_t)m * D) + C.lane)[64 * j] = pg8::pk4_fp8(h.x, h.y, h.z, h.w);
                           ((unsigned*)(C.ws + WS_HKV + (size_t)m * D) + C.lane)[64 * j] = pg8::pk4_fp8(hk.x, hk.y, hk.z, hk.w); }
            else { ((unsigned long long*)(HKV + (size_t)T * D + (size_t)m * D) + C.lane)[64 * j] = (unsigned long long)pkbf(h.x, h.y) | ((unsigned long long)pkbf(h.z, h.w) << 32);
                   ((unsigned long long*)(HKV + (size_t)m * D) + C.lane)[64 * j] = (unsigned long long)pkbf(hk.x, hk.y) | ((unsigned long long)pkbf(hk.z, hk.w) << 32); } }
        __builtin_amdgcn_sched_barrier(0);
        float r8[8], r4[4], r2v[2], r1;
        { const bool up = (C.lane & 32) != 0;
#pragma unroll
          for (int i = 0; i < 8; ++i) { const float snd = up ? acc[i] : acc[i + 8], kp = up ? acc[i + 8] : acc[i]; r8[i] = kp + __shfl_xor(snd, 32); } }
        { const bool up = (C.lane & 16) != 0;
#pragma unroll
          for (int i = 0; i < 4; ++i) { const float snd = up ? r8[i] : r8[i + 4], kp = up ? r8[i + 4] : r8[i]; r4[i] = kp + __shfl_xor(snd, 16); } }
        { const bool up = (C.lane & 8) != 0;
#pragma unroll
          for (int i = 0; i < 2; ++i) { const float snd = up ? r4[i] : r4[i + 2], kp = up ? r4[i + 2] : r4[i]; r2v[i] = kp + __shfl_xor(snd, 8); } }
        { const bool up = (C.lane & 4) != 0; const float snd = up ? r2v[0] : r2v[1], kp = up ? r2v[1] : r2v[0]; r1 = kp + __shfl_xor(snd, 4); }
        r1 += __shfl_xor(r1, 2); r1 += __shfl_xor(r1, 1);
        if ((C.lane & 3) == 0) { const float z = r1 * rstd + bfh; LOGF[(size_t)m * 16 + ((C.lane >> 2) & 15)] = (fminf(z, 0.f) - log1pf(__expf(-fabsf(z)))) * LOG2E; }
#pragma unroll
        for (int j = 0; j < 4; ++j) { xc[j] = xn[j]; y0c[j] = y0n[j]; y1c[j] = y1n[j]; y2c[j] = y2n[j]; y3c[j] = y3n[j];
#if R2_VECPRE
            gfc[j] = gfn[j]; gmc[j] = gmn[j]; shc[j] = shn[j];
#endif
        }
        s_cur = s_nxt; g_cur = g_nxt; s_nxt = s_nn; g_nxt = g_nn;
    }
#undef R2_LOADRAW
#if R2_VECPRE
#undef R2_LOADVEC
#endif
}
__device__ __forceinline__ void fcum_scan(const Ctx& C) {
    const float* LOGF = (const float*)(C.ws + SM_LOGF); float* FC = (float*)(C.ws + SM_FCUM);
    LAS float* wtot = (LAS float*)(C.lds + BLK_OFF);
    for (int sq = C.vcu; sq < 128; sq += C.G) { const int b = sq >> 4, h = sq & 15;
        const float* src = LOGF + ((size_t)b * 4096 + C.tid * 8) * 16 + h; float* dst = FC + (size_t)sq * 4096 + C.tid * 8;
        float v[8]; float tot = 0.f;
#pragma unroll
        for (int i = 0; i < 8; ++i) { v[i] = src[i * 16]; }
#pragma unroll
        for (int i = 0; i < 8; ++i) { tot += v[i]; v[i] = tot; }
        float inc = tot;
#pragma unroll
        for (int o = 1; o < 64; o <<= 1) { const float t = __shfl_up(inc, o); if (C.lane >= o) inc += t; }
        __syncthreads();
        if (C.lane == 63) wtot[C.wave] = inc;
        __syncthreads();
        float carry = inc - tot;
        for (int w8 = 0; w8 < C.wave; ++w8) carry += wtot[w8];
#pragma unroll
        for (int i = 0; i < 8; ++i) dst[i] = v[i] + carry;
    }
}
__device__ __forceinline__ void r3_final(const Ctx& C, const Args& a, float* XD) {
    const bf16* XS = (const bf16*)(C.ws + WS_XS); const bf16* Y = (const bf16*)(C.ws + WS_Y);
    const float* ADA1 = (const float*)(C.ws + SM_ADA) + (size_t)8 * 6144;
    const int* SLOT = (const int*)(C.ws + SM_SLOT); const float* TOPG = (const float*)(C.ws + SM_TOPG);
    const f32x4* fg4 = (const f32x4*)a.in[IN_FNG] + C.lane;
    const int gw = C.vcu * NWAVES + C.wave, NGW = C.G * NWAVES;
#define R3_LOADRAW(XR, Y0, Y1, Y2, Y3, MM, SS) do { const xs4_t* xr_ = (const xs4_t*)(XS + (size_t)(MM) * D) + C.lane; \
        const yraw4_t* z0_ = Y_ROWPTR(Y, (SS)[0]); const yraw4_t* z1_ = Y_ROWPTR(Y, (SS)[1]); \
        const yraw4_t* z2_ = Y_ROWPTR(Y, (SS)[2]); const yraw4_t* z3_ = Y_ROWPTR(Y, (SS)[3]); \
        _Pragma("unroll") for (int j = 0; j < 4; ++j) { if (NT_ROWS) { XR[j] = __builtin_nontemporal_load(xr_ + 64 * j); Y0[j] = __builtin_nontemporal_load(z0_ + 64 * j); Y1[j] = __builtin_nontemporal_load(z1_ + 64 * j); Y2[j] = __builtin_nontemporal_load(z2_ + 64 * j); Y3[j] = __builtin_nontemporal_load(z3_ + 64 * j); } else { XR[j] = xr_[64 * j]; Y0[j] = z0_[64 * j]; Y1[j] = z1_[64 * j]; Y2[j] = z2_[64 * j]; Y3[j] = z3_[64 * j]; } } } while (0)
    xs4_t xc[4], xn[4]; yraw4_t y0c[4], y1c[4], y2c[4], y3c[4], y0n[4], y1n[4], y2n[4], y3n[4];
    i32x4v s_cur = *(const i32x4v*)(SLOT + (size_t)gw * 4); f32x4 g_cur = *(const f32x4*)(TOPG + (size_t)gw * 4);
    i32x4v s_nxt = s_cur; f32x4 g_nxt = g_cur;
    if (gw + NGW < T) { s_nxt = *(const i32x4v*)(SLOT + (size_t)(gw + NGW) * 4); g_nxt = *(const f32x4*)(TOPG + (size_t)(gw + NGW) * 4); }
    R3_LOADRAW(xc, y0c, y1c, y2c, y3c, gw, s_cur);
#if R2_VECPRE
    f32x4 gfc[4], gfn[4], fgr[4];
#define R3_LOADVEC(GF, MM) do { const f32x4* gf_ = (const f32x4*)(ADA1 + (size_t)((MM) >> 12) * 6144 + 5 * 1024) + C.lane; _Pragma("unroll") for (int j = 0; j < 4; ++j) GF[j] = gf_[64 * j]; } while (0)
    R3_LOADVEC(gfc, gw < T ? gw : 0);
#pragma unroll
    for (int j = 0; j < 4; ++j) { fgr[j] = fg4[64 * j]; gfn[j] = gfc[j]; }
#endif
    for (int m = gw; m < T; m += NGW) { const int b = m >> 12;
        const int mn = m + NGW, mnn = m + 2 * NGW;
        i32x4v s_nn = s_nxt; f32x4 g_nn = g_nxt;
#if ROW_UNCOND
        { const int mnn_c = mnn < T ? mnn : m, mn_c = mn < T ? mn : m;
          s_nn = *(const i32x4v*)(SLOT + (size_t)mnn_c * 4); g_nn = *(const f32x4*)(TOPG + (size_t)mnn_c * 4);
          R3_LOADRAW(xn, y0n, y1n, y2n, y3n, mn_c, s_nxt);
#if R2_VECPRE
          R3_LOADVEC(gfn, mn_c);
#endif
        }
#else
        if (mnn < T) { s_nn = *(const i32x4v*)(SLOT + (size_t)mnn * 4); g_nn = *(const f32x4*)(TOPG + (size_t)mnn * 4); }
        if (mn < T) { R3_LOADRAW(xn, y0n, y1n, y2n, y3n, mn, s_nxt);
#if R2_VECPRE
            R3_LOADVEC(gfn, mn);
#endif
        }
#endif
        const f32x4* gf4 = (const f32x4*)(ADA1 + (size_t)b * 6144 + 5 * 1024) + C.lane;
        f32x4* xw = (f32x4*)(XD + (size_t)m * D) + C.lane;
        f32x4 v[4]; float s = 0.f;
#pragma unroll
        for (int j = 0; j < 4; ++j) {
            const f32x4 ys = y4_to_f32(y0c[j]) * g_cur[0] + y4_to_f32(y1c[j]) * g_cur[1] + y4_to_f32(y2c[j]) * g_cur[2] + y4_to_f32(y3c[j]) * g_cur[3];
            v[j] = xs4_to_f32(xc[j]) + (R2_VECPRE ? gfc[j] : gf4[64 * j]) * ys; s += (v[j].x * v[j].x + v[j].y * v[j].y) + (v[j].z * v[j].z + v[j].w * v[j].w); }
        const float rstd = 1.f / sqrtf(wave_sum(s) * (1.f / D) + RMS_EPS);
#pragma unroll
        for (int j = 0; j < 4; ++j) xw[64 * j] = v[j] * rstd * (R2_VECPRE ? fgr[j] : fg4[64 * j]);
#pragma unroll
        for (int j = 0; j < 4; ++j) { xc[j] = xn[j]; y0c[j] = y0n[j]; y1c[j] = y1n[j]; y2c[j] = y2n[j]; y3c[j] = y3n[j];
#if R2_VECPRE
            gfc[j] = gfn[j];
#endif
        }
        s_cur = s_nxt; g_cur = g_nxt; s_nxt = s_nn; g_nxt = g_nn;
    }
#undef R3_LOADRAW
#if R2_VECPRE
#undef R3_LOADVEC
#endif
}

__device__ __forceinline__ void warm_weights(const Ctx& C, int l) {
    const u32x4v* gu = (const u32x4v*)(C.ws + WS_WGU + (size_t)l * 32 * 2048 * D); const u32x4v* dn = (const u32x4v*)(C.ws + WS_WDN + (size_t)l * 32 * D * D);
    const int gt = C.vcu * 512 + C.tid, NGT = C.G * 512; unsigned acc = 0u;
    constexpr int NGU = 32 * 2048 * D / 16, NDN = 32 * D * D / 16;
#pragma unroll 8
    for (int i = gt; i < NGU; i += NGT) { const u32x4v v = gu[i]; acc ^= v.x ^ v.w; }
#pragma unroll 8
    for (int i = gt; i < NDN; i += NGT) { const u32x4v v = dn[i]; acc ^= v.x ^ v.w; }
    if (acc == 0x12345679u) ((unsigned*)(C.ws + WS_CTL))[CW_TMO + 64 + (C.tid & 7)] = acc;
}
constexpr int N_PHASES = 19;
__global__ void __launch_bounds__(NWAVES * 64, 2) yoco_fwd(Args args) {
    extern __shared__ __attribute__((aligned(16))) unsigned char lds[];
    Ctx C;
    C.lds = (LAS unsigned char*)lds; C.ws = args.ws;
    C.tid = threadIdx.x; C.lane = C.tid & 63; C.wave = __builtin_amdgcn_readfirstlane(C.tid >> 6);
    C.G = gridDim.x; { const int bx = blockIdx.x; C.vcu = (C.G % 8 == 0) ? (bx % 8) * (C.G / 8) + bx / 8 : bx; }
    volatile LAS unsigned* MISC = (volatile LAS unsigned*)(C.lds + MISC_OFF);
    if (C.tid < 64) MISC[C.tid] = 0u;
    __syncthreads();
    const int lo = args.ph_lo, hi = args.ph_hi;
    const bool one = (hi - lo) > 1;
    unsigned* ctl = (unsigned*)(args.ws + WS_CTL);
    XcdBarrier bar; bar.bar = ctl + CW_BAR; bar.x = 0; bar.st = nullptr;
    if (one) bar = xcd_barrier_post(ctl + CW_BAR, MISC + 8);
#define IN(k) (lo <= (k) && (k) < hi)
#define SEAM(k) do { if (IN(k) && IN((k) + 1)) { xcd_barrier(bar); if (PROBE_BARX && (k) == 4) { _Pragma("unroll 1") for (int xb_ = 0; xb_ < PROBE_BARX; ++xb_) xcd_barrier(bar); } } } while (0)
#define FRESH() do { int l_; asm volatile("v_mbcnt_lo_u32_b32 %0, -1, 0\n\tv_mbcnt_hi_u32_b32 %0, -1, %0" : "=v"(l_)); C.lane = l_; C.tid = C.wave * 64 + l_; } while (0)
#define REP(k) _Pragma("unroll") for (int rep_ = 0; rep_ < 1 + ((PROBE_DUP >> (k)) & 1); ++rep_)
    bf16* const Hb = (bf16*)(C.ws + WS_H);
    if (IN(0)) { FRESH(); REP(0) { p0_prologue(C, args); } SEAM(0); }
#if PROBE_OPS
    {
        float r0 = 0.5f + C.lane * 0.001f, r1 = r0 + 1.f, r2 = r0 + 2.f, r3 = r0 + 3.f, r4 = r0 + 4.f, r5 = r0 + 5.f, r6 = r0 + 6.f, r7 = r0 + 7.f;
        typedef float f2 __attribute__((ext_vector_type(2)));
        f2 p0 = {r0, r1}, p1 = {r2, r3}, p2 = {r4, r5}, p3 = {r6, r7}, p4 = {r1, r0}, p5 = {r3, r2}, p6 = {r5, r4}, p7 = {r7, r6}; const f2 pc = {0.999f, 1.001f};
        _Pragma("unroll 1") for (int it = 0; it < 2048; ++it) {
#if PROBE_OPS == 1
            asm volatile("v_exp_f32 %0, %0\n\tv_exp_f32 %1, %1\n\tv_exp_f32 %2, %2\n\tv_exp_f32 %3, %3\n\tv_exp_f32 %4, %4\n\tv_exp_f32 %5, %5\n\tv_exp_f32 %6, %6\n\tv_exp_f32 %7, %7" : "+v"(r0), "+v"(r1), "+v"(r2), "+v"(r3), "+v"(r4), "+v"(r5), "+v"(r6), "+v"(r7));
#elif PROBE_OPS == 2
            asm volatile("v_fma_f32 %0, %0, %0, %0\n\tv_fma_f32 %1, %1, %1, %1\n\tv_fma_f32 %2, %2, %2, %2\n\tv_fma_f32 %3, %3, %3, %3\n\tv_fma_f32 %4, %4, %4, %4\n\tv_fma_f32 %5, %5, %5, %5\n\tv_fma_f32 %6, %6, %6, %6\n\tv_fma_f32 %7, %7, %7, %7" : "+v"(r0), "+v"(r1), "+v"(r2), "+v"(r3), "+v"(r4), "+v"(r5), "+v"(r6), "+v"(r7));
#elif PROBE_OPS == 3
            asm volatile("v_pk_fma_f32 %0, %0, %8, %0\n\tv_pk_fma_f32 %1, %1, %8, %1\n\tv_pk_fma_f32 %2, %2, %8, %2\n\tv_pk_fma_f32 %3, %3, %8, %3\n\tv_pk_fma_f32 %4, %4, %8, %4\n\tv_pk_fma_f32 %5, %5, %8, %5\n\tv_pk_fma_f32 %6, %6, %8, %6\n\tv_pk_fma_f32 %7, %7, %8, %7" : "+v"(p0), "+v"(p1), "+v"(p2), "+v"(p3), "+v"(p4), "+v"(p5), "+v"(p6), "+v"(p7) : "v"(pc));
#elif PROBE_OPS == 4
            asm volatile("v_ldexp_f32 %0, %0, 1\n\tv_ldexp_f32 %1, %1, 1\n\tv_ldexp_f32 %2, %2, 1\n\tv_ldexp_f32 %3, %3, 1\n\tv_cvt_i32_f32 %4, %4\n\tv_cvt_i32_f32 %5, %5\n\tv_fract_f32 %6, %6\n\tv_fract_f32 %7, %7" : "+v"(r0), "+v"(r1), "+v"(r2), "+v"(r3), "+v"(r4), "+v"(r5), "+v"(r6), "+v"(r7));
#endif
        }
        if (r0 + r1 + r2 + r3 + r4 + r5 + r6 + r7 + p0[0] + p1[1] + p2[0] + p3[1] + p4[0] + p5[1] + p6[0] + p7[1] == 12345.678f) ((float*)(C.ws + WS_XB))[0] = 1.f;
    }
#endif
    if (IN(1)) { FRESH(); REP(1) { p1_rows0(C, args); } SEAM(1); }
    if (IN(2)) { FRESH();
#if PROBE_QKV
        { pg8::Gemm g{(const pg8::bf16_t*)(C.ws + WS_H8), (const pg8::bf16_t*)(C.ws + WS_WQKV), T, NQKV, D}; pg8::StaticOrder S; S.init(T, NQKV, C.G, (int)blockIdx.x);
#if PROBE_QKV == 1
          pg8::EpiQKV0 E{(pg8::bf16_t*)(C.ws + WS_QKV0), 0.015625f};
          pg8::gemm_phase<pg8::EpiQKV0, pg8::StaticOrder, true, true, 1>(C.lds + RING_OFF, g, S, E);
#elif PROBE_QKV == 4
          pg8::EpiProbeW E{(unsigned char*)(C.ws + WS_XB), 0.015625f, C.vcu};
          pg8::gemm_phase<pg8::EpiProbeW, pg8::StaticOrder, true, true, 1, false, 1>(C.lds + RING_OFF, g, S, E);
#elif PROBE_QKV == 2
          pg8::EpiQKV0Probe E{(pg8::bf16_t*)(C.ws + WS_XB), 0.015625f, 4};
          pg8::gemm_phase<pg8::EpiQKV0Probe, pg8::StaticOrder, true, true, 1>(C.lds + RING_OFF, g, S, E);
#else
          pg8::EpiNone E{(unsigned char*)(C.ws + WS_XB)};
          pg8::gemm_phase<pg8::EpiNone, pg8::StaticOrder, true, true, 1>(C.lds + RING_OFF, g, S, E);
#endif
        }
#endif
#if STAGGER_QKV
        { const unsigned long long t0 = __builtin_amdgcn_s_memrealtime(); const unsigned long long dl = (unsigned long long)(C.vcu & 7) * STAGGER_QKV;
          while (__builtin_amdgcn_s_memrealtime() - t0 < dl) __builtin_amdgcn_s_sleep(8); }
#endif
        REP(2) {
#if CONV_X0
        if ((int)blockIdx.x >= C.G - CONV_X0) { const int ci = (int)blockIdx.x - (C.G - CONV_X0);
            convert_weights<CONV_DEPTH>(C, args, 1, ci, CONV_X0); if (CONV_X0_BOTH) convert_weights<CONV_DEPTH>(C, args, 2, ci, CONV_X0); } else
#endif
        {
        pg8::Gemm g{QKV_FP8 ? (const pg8::bf16_t*)(C.ws + WS_H8) : (const pg8::bf16_t*)Hb, (const pg8::bf16_t*)(C.ws + WS_WQKV), T, NQKV, D}; pg8::StaticOrder S; S.init(T, NQKV, C.G - CONV_X0, (int)blockIdx.x);
#if BAND_FP8
#if QKV_WIDE
        pg8::EpiQKV08W E{(unsigned char*)(C.ws + WS_QKV0), QKV_FP8 ? 0.015625f : 1.f};
        pg8::gemm_phase<pg8::EpiQKV08W, pg8::StaticOrder, true, true, QKV_FP8 ? 1 : 2, false, 1>(C.lds + RING_OFF, g, S, E);
#else
        pg8::EpiQKV08 E{(unsigned char*)(C.ws + WS_QKV0), QKV_FP8 ? 0.015625f : 1.f};
        pg8::gemm_phase<pg8::EpiQKV08, pg8::StaticOrder, true, true, QKV_FP8 ? 1 : 2>(C.lds + RING_OFF, g, S, E);
#endif
#else
        pg8::EpiQKV0 E{(pg8::bf16_t*)(C.ws + WS_QKV0), QKV_FP8 ? 0.015625f : 1.f};
        pg8::gemm_phase<pg8::EpiQKV0, pg8::StaticOrder, true, true, QKV_FP8 ? 1 : 2>(C.lds + RING_OFF, g, S, E);
#endif
        } } SEAM(2);
    }
    if (IN(3)) { FRESH(); REP(3) { p3_dilated(C); } SEAM(3); }
    if (IN(4)) { FRESH(); REP(4) { p4_merge(C); } SEAM(4); }
    if (IN(5)) { FRESH(); REP(5) {
        pg8::Gemm g{(const pg8::bf16_t*)(C.ws + WS_O), (const pg8::bf16_t*)(C.ws + WS_WO0), T, D, D}; pg8::StaticOrder S; S.init(T, D, C.G, (int)blockIdx.x);
        pg8::EpiResid<false> E{args.in[IN_X], (pg8::bf16_t*)(C.ws + WS_XS), (const float*)(C.ws + SM_ADA) + 2 * 1024, WO_FP8 ? 0.015625f : 1.f};
        pg8::gemm_phase<pg8::EpiResid<false>, pg8::StaticOrder, true, true, WO_FP8 ? 1 : 2>(C.lds + RING_OFF, g, S, E);
        } SEAM(5);
    }
    if (IN(6)) { FRESH(); REP(6) { r1_router(C, args, 0); } SEAM(6); }
    if (IN(7)) { FRESH(); REP(7) { p7_route(C); } if (WARM_W & 1) warm_weights(C, 0); SEAM(7); }
    if (IN(8)) { FRESH();
#if PROBE_GU
        { const int nt = load_tile_table(C);
          pg8::Gemm g{(const pg8::bf16_t*)(C.ws + WS_H8), (const pg8::bf16_t*)(C.ws + WS_WGU), MAXROWS, 32 * 2048, D, (const int*)(C.ws + SM_TOKSLOT)};
          pg8::MoeOrder<8> S{(const LAS int*)(C.lds + BLK_OFF) + BL_TILE, nt, (int)blockIdx.x, C.G};
#if PROBE_GU == 1
          pg8::EpiSwiGLU8 E{(unsigned char*)(C.ws + WS_XB), args.in[IN_BGU]};
          pg8::gemm_phase<pg8::EpiSwiGLU8, pg8::MoeOrder<8>, true, true, 1, true>(C.lds + RING_OFF, g, S, E);
#elif PROBE_GU == 6
          { pg8::MoeOrderProbe S2{(const LAS int*)(C.lds + BLK_OFF) + BL_TILE, nt, (int)blockIdx.x, C.G};
            pg8::EpiProbeGU<2> E{(unsigned char*)(C.ws + WS_XB), args.in[IN_BGU]};
            pg8::gemm_phase<pg8::EpiProbeGU<2>, pg8::MoeOrderProbe, true, true, 1, true>(C.lds + RING_OFF, g, S2, E); }
#else
          pg8::EpiProbeGU<PROBE_GU - 2> E{(unsigned char*)(C.ws + WS_XB), args.in[IN_BGU]};
          pg8::gemm_phase<pg8::EpiProbeGU<PROBE_GU - 2>, pg8::MoeOrder<8>, true, true, 1, true>(C.lds + RING_OFF, g, S, E);
#endif
        }
#endif
        REP(8) {
        const int nt = load_tile_table(C);
        pg8::Gemm g{(const pg8::bf16_t*)(C.ws + (MOE_GATHER ? WS_H8 : WS_XB)), (const pg8::bf16_t*)(C.ws + WS_WGU), MAXROWS, 32 * 2048, D, (const int*)(C.ws + SM_TOKSLOT)};
        pg8::MoeOrder<8> S{(const LAS int*)(C.lds + BLK_OFF) + BL_TILE, nt, (int)blockIdx.x, C.G};
        pg8::EpiSwiGLU8 E{(unsigned char*)(C.ws + WS_ACT), args.in[IN_BGU]};
        pg8::gemm_phase<pg8::EpiSwiGLU8, pg8::MoeOrder<8>, true, true, 1, MOE_GATHER != 0, GU_BMAP>(C.lds + RING_OFF, g, S, E);
        if (CONV_TAIL & 0xffff) tail_convert<4>(C, args, nt);
        } SEAM(8);
    }
    if (IN(9)) { FRESH(); REP(9) {
        const int nt = load_tile_table(C);
        pg8::Gemm g{(const pg8::bf16_t*)(C.ws + WS_ACT), (const pg8::bf16_t*)(C.ws + WS_WDN), MAXROWS, 32 * 1024, D};
        pg8::MoeOrder<4> S{(const LAS int*)(C.lds + BLK_OFF) + BL_TILE, nt, (int)blockIdx.x, C.G};
#if DN_WIDE && Y_FP8
        pg8::EpiDown8W E{(unsigned char*)(C.ws + WS_Y), args.in[IN_BDN]};
        pg8::gemm_phase<pg8::EpiDown8W, pg8::MoeOrder<4>, true, true, 1, false, 1>(C.lds + RING_OFF, g, S, E);
#else
        pg8::EpiDown8 E{(pg8::bf16_t*)(C.ws + WS_Y), args.in[IN_BDN]};
        pg8::gemm_phase<pg8::EpiDown8, pg8::MoeOrder<4>, true, true, 1>(C.lds + RING_OFF, g, S, E);
#endif
        if (CONV_TAIL & 0xffff) tail_convert<8>(C, args, nt);
        } SEAM(9);
    }
    if (IN(10)) { FRESH(); r2_seam(C, args); SEAM(10); }
    if (IN(11)) { FRESH(); REP(11) {
        fcum_scan(C);
        pg8::Gemm g{(const pg8::bf16_t*)(C.ws + WS_HKV), (const pg8::bf16_t*)(C.ws + WS_WKV), T, 3072, D}; pg8::KVQOrder S; S.init(T, 3072, C.G, (int)blockIdx.x);
#if KVQ_WIDE
        pg8::EpiKVQW E{(pg8::bf16_t*)(C.ws + WS_QKV1), KVQ_FP8 ? 0.015625f : 1.f, (unsigned*)(C.ws + WS_CTL) + CW_NRM};
        pg8::gemm_phase<pg8::EpiKVQW, pg8::KVQOrder, true, true, KVQ_FP8 ? 1 : 2, false, 1>(C.lds + RING_OFF, g, S, E);
#else
        pg8::EpiKVQ E{(pg8::bf16_t*)(C.ws + WS_QKV1), KVQ_FP8 ? 0.015625f : 1.f, (unsigned*)(C.ws + WS_CTL) + CW_NRM};
        pg8::gemm_phase<pg8::EpiKVQ, pg8::KVQOrder, true, true, KVQ_FP8 ? 1 : 2>(C.lds + RING_OFF, g, S, E);
#endif
        } SEAM(11);
    }
    if (IN(12)) { FRESH(); if (PROBE_FOX == 2) p12_fox<2>(C, WS_OG, args); if (PROBE_FOX == 3) p12_fox<1, 2>(C, WS_OG, args); if (PROBE_FOX == 4) p12_fox<1, 1>(C, WS_OG, args); if (PROBE_FOX >= 13) p12_fox<1, PROBE_FOX - 10>(C, WS_OG, args); REP(12) { p12_fox<1>(C, WS_O, args); } SEAM(12); }
    if (IN(13)) { FRESH(); REP(13) {
        pg8::Gemm g{(const pg8::bf16_t*)(C.ws + WS_O), (const pg8::bf16_t*)(C.ws + WS_WO1), T, D, D}; pg8::StaticOrder S; S.init(T, D, C.G, (int)blockIdx.x);
        pg8::EpiResid<true> E{C.ws + WS_XS, (pg8::bf16_t*)(C.ws + WS_XS), (const float*)(C.ws + SM_ADA) + (size_t)8 * 6144 + 2 * 1024, WO_FP8 ? 0.015625f : 1.f};
        pg8::gemm_phase<pg8::EpiResid<true>, pg8::StaticOrder, true, true, WO_FP8 ? 1 : 2>(C.lds + RING_OFF, g, S, E);
        } SEAM(13);
    }
    if (IN(14)) { FRESH(); REP(14) { r1_router(C, args, 1); } SEAM(14); }
    if (IN(15)) { FRESH(); REP(15) { p7_route(C); } if (WARM_W & 2) warm_weights(C, 1); SEAM(15); }
    if (IN(16)) { FRESH();
#if PROBE_LATE_QKV
        { pg8::Gemm g{(const pg8::bf16_t*)(C.ws + WS_ACT), (const pg8::bf16_t*)(C.ws + WS_WQKV), T, NQKV, D}; pg8::StaticOrder S; S.init(T, NQKV, C.G, (int)blockIdx.x);
          pg8::EpiNone E{(unsigned char*)(C.ws + WS_XB)};
          pg8::gemm_phase<pg8::EpiNone, pg8::StaticOrder, true, true, 1>(C.lds + RING_OFF, g, S, E); }
#endif
        REP(16) {
        const int nt = load_tile_table(C);
        pg8::Gemm g{(const pg8::bf16_t*)(C.ws + (MOE_GATHER ? WS_H8 : WS_XB)), (const pg8::bf16_t*)(C.ws + WS_WGU + (size_t)32 * 2048 * D), MAXROWS, 32 * 2048, D, (const int*)(C.ws + SM_TOKSLOT)};
        pg8::MoeOrder<8> S{(const LAS int*)(C.lds + BLK_OFF) + BL_TILE, nt, (int)blockIdx.x, C.G};
        pg8::EpiSwiGLU8 E{(unsigned char*)(C.ws + WS_ACT), args.in[IN_BGU] + 32 * 2048};
        pg8::gemm_phase<pg8::EpiSwiGLU8, pg8::MoeOrder<8>, true, true, 1, MOE_GATHER != 0, GU_BMAP>(C.lds + RING_OFF, g, S, E);
        } SEAM(16);
    }
    if (IN(17)) { FRESH(); REP(17) {
        const int nt = load_tile_table(C);
        pg8::Gemm g{(const pg8::bf16_t*)(C.ws + WS_ACT), (const pg8::bf16_t*)(C.ws + WS_WDN + (size_t)32 * 1024 * D), MAXROWS, 32 * 1024, D};
        pg8::MoeOrder<4> S{(const LAS int*)(C.lds + BLK_OFF) + BL_TILE, nt, (int)blockIdx.x, C.G};
#if DN_WIDE && Y_FP8
        pg8::EpiDown8W E{(unsigned char*)(C.ws + WS_Y), args.in[IN_BDN] + 32 * 1024};
        pg8::gemm_phase<pg8::EpiDown8W, pg8::MoeOrder<4>, true, true, 1, false, 1>(C.lds + RING_OFF, g, S, E);
#else
        pg8::EpiDown8 E{(pg8::bf16_t*)(C.ws + WS_Y), args.in[IN_BDN] + 32 * 1024};
        pg8::gemm_phase<pg8::EpiDown8, pg8::MoeOrder<4>, true, true, 1>(C.lds + RING_OFF, g, S, E);
#endif
        } SEAM(17);
    }
    if (IN(18)) { FRESH(); r3_final(C, args, args.out); }
#undef IN
#undef SEAM
}

extern "C" void kernel_launch(void* const* d_in, const int* in_sizes, int n_in, void* d_out, int out_size, void* d_ws, size_t ws_size, hipStream_t stream) {
    static int grid = 0;
    if (grid == 0) {
        if (n_in != 21 || in_sizes[0] != T * D || out_size != T * D || ws_size < WS_END) { fprintf(stderr, "kernel_launch: unexpected shapes (n_in %d, in0 %d, out %d, ws %zu)\n", n_in, n_in > 0 ? in_sizes[0] : -1, out_size, ws_size); grid = -1; return; }
        int dev = 0, cus = 0, per_cu = 0;
        if (hipGetDevice(&dev) != hipSuccess || hipDeviceGetAttribute(&cus, hipDeviceAttributeMultiprocessorCount, dev) != hipSuccess) { grid = -1; return; }
        if (hipFuncSetAttribute((const void*)yoco_fwd, hipFuncAttributeMaxDynamicSharedMemorySize, LDS_BYTES) != hipSuccess) { fprintf(stderr, "kernel_launch: hipFuncSetAttribute failed\n"); grid = -1; return; }
        if (hipOccupancyMaxActiveBlocksPerMultiprocessor(&per_cu, (const void*)yoco_fwd, NWAVES * 64, LDS_BYTES) != hipSuccess || per_cu < 1) { fprintf(stderr, "kernel_launch: occupancy query reports %d blocks per CU\n", per_cu); }
        (void)hipGetLastError();
        grid = cus;
    }
    if (grid < 0) return;
    (void)hipMemsetAsync((char*)d_ws + WS_CTL, 0, CTL_ZERO_BYTES, stream);
    Args a{};
    for (int i = 0; i < 21; ++i) a.in[i] = (const float*)d_in[i];
    a.out = (float*)d_out; a.ws = (unsigned char*)d_ws;
#if MK_ONE_LAUNCH
    a.ph_lo = 0; a.ph_hi = N_PHASES;
    hipLaunchKernelGGL(yoco_fwd, dim3(grid), dim3(NWAVES * 64), LDS_BYTES, stream, a);
#else
    for (int p = 0; p < N_PHASES; ++p) { a.ph_lo = p; a.ph_hi = p + 1; hipLaunchKernelGGL(yoco_fwd, dim3(grid), dim3(NWAVES * 64), LDS_BYTES, stream, a); }
#endif
}
```
